# Optimizing an MI355X kernel written in HIP

```python
import math
import jax, jax.numpy as jnp
from jax import lax
import numpy as np

D_MODEL = 1024
BATCH = 16
SEQ = 2048
DEPTH = 4

GRID_W = 64
CTX_LEN = 256
N_MIXERS = 4
D_INNER = 2 * D_MODEL
RMS_EPS = 1e-6
ROPE_THETA = 10000.0
Q_BLOCK = 128

MLSTM_HEADS = 8
MLSTM_HEAD_DIM = D_INNER // MLSTM_HEADS
MLSTM_QKV_BLOCK = 4
MLSTM_CONV = 5
MLSTM_CHUNK = 128
MLSTM_F_BIAS_LO = 3.0
MLSTM_F_BIAS_HI = 6.0

DIFF_HEADS = 16
DIFF_HEAD_DIM = D_INNER // (2 * DIFF_HEADS)

NA_HEADS = 32
NA_HEAD_DIM = D_INNER // NA_HEADS
NA_WIN_ROWS = 8
NA_WIN_COLS = 16
NA_QCOL_BLOCK = 16
NA_KCOL_BLOCK = NA_QCOL_BLOCK + NA_WIN_COLS

SWA_Q_HEADS = 32
SWA_KV_HEADS = 4
SWA_HEAD_DIM = D_INNER // SWA_Q_HEADS
SWA_WINDOW = 128

kernel_name = 'hybrid_mlstm_diffattn_natten_swa_dit'

F32 = jnp.float32


def _rmsnorm(x, g):
    xf = x.astype(F32)
    y = xf * lax.rsqrt(jnp.mean(xf * xf, axis=-1, keepdims=True) + RMS_EPS)
    return (y * g.astype(F32)).astype(x.dtype)


def _rope_1d(x, ang):
    cos = jnp.cos(ang)[None, :, None, :].astype(x.dtype)
    sin = jnp.sin(ang)[None, :, None, :].astype(x.dtype)
    x1, x2 = jnp.split(x, 2, axis=-1)
    return jnp.concatenate([x1 * cos - x2 * sin, x2 * cos + x1 * sin], axis=-1)


def _rope_2d(x):
    T, dh = x.shape[1], x.shape[-1]
    half = dh // 2
    t = jnp.arange(T)
    inv = jnp.power(ROPE_THETA, -jnp.arange(0, half, 2, dtype=F32) / half)
    ang_r = (t // GRID_W).astype(F32)[:, None] * inv
    ang_c = (t % GRID_W).astype(F32)[:, None] * inv
    xr, xc = jnp.split(x, 2, axis=-1)
    return jnp.concatenate([_rope_1d(xr, ang_r), _rope_1d(xc, ang_c)], axis=-1)


def _dwconv(u, w, b):
    K, C = w.shape
    out = lax.conv_general_dilated(u, w[:, None, :].astype(u.dtype), window_strides=(1,),
                                   padding=[(K // 2, K // 2)], dimension_numbers=('NWC', 'WIO', 'NWC'),
                                   feature_group_count=C)
    return out + b


def _blockdiag(u, w):
    B, T, C = u.shape
    ub = u.reshape(B, T, w.shape[0], w.shape[1])
    return jnp.einsum('btgi,gij->btgj', ub, w).reshape(B, T, C)


def _sink_softmax(s, sink):
    sk = jnp.broadcast_to(sink[:, :, None, None], s.shape[:-1] + (1,))
    return jax.nn.softmax(jnp.concatenate([s, sk], axis=-1), axis=-1)[..., :-1]


def _mlstm_scan(q, k, v, log_i, log_f, state):
    L = MLSTM_CHUNK
    nc = q.shape[2] // L

    def chunks(a):
        return jnp.moveaxis(a.reshape(a.shape[:2] + (nc, L) + a.shape[3:]), 2, 0)

    tril = jnp.tril(jnp.ones((L, L), dtype=bool))

    def step(carry, inp):
        C, n, m = carry
        qc, kc, vc, ic, fc = inp
        b = jnp.cumsum(fc, axis=-1)
        d = jnp.where(tril, b[..., :, None] - b[..., None, :] + ic[..., None, :], -jnp.inf)
        inter = b + m[..., None]
        m_t = jnp.maximum(jnp.max(d, axis=-1), inter)
        w_intra = jnp.exp(d - m_t[..., None])
        w_state = jnp.exp(inter - m_t)
        s = jnp.einsum('bhtd,bhsd->bhts', qc, kc) * w_intra
        num = w_state[..., None] * jnp.einsum('bhtd,bhde->bhte', qc, C) + jnp.einsum('bhts,bhse->bhte', s, vc)
        den = w_state * jnp.einsum('bhtd,bhd->bht', qc, n) + jnp.sum(s, axis=-1)
        h = num / jnp.maximum(jnp.abs(den), jnp.exp(-m_t))[..., None]
        b_end = b[..., -1]
        g = b_end[..., None] - b + ic
        m_new = jnp.maximum(b_end + m, jnp.max(g, axis=-1))
        w_s = jnp.exp(g - m_new[..., None])
        decay = jnp.exp(b_end + m - m_new)
        C = decay[..., None, None] * C + jnp.einsum('bhs,bhsd,bhse->bhde', w_s, kc, vc)
        n = decay[..., None] * n + jnp.einsum('bhs,bhsd->bhd', w_s, kc)
        return (C, n, m_new), h

    state, hs = lax.scan(step, state, tuple(chunks(a) for a in (q, k, v, log_i, log_f)))
    return jnp.moveaxis(hs, 0, 2).reshape(q.shape[:3] + (v.shape[-1],)), state


def _mlstm_project(h, w_in, conv_w, conv_b, wq, wk, wv, w_gate, b_gate):
    B, T, _ = h.shape
    xm, z = jnp.split(h @ w_in, 2, axis=-1)
    xc = jax.nn.silu(_dwconv(xm, conv_w, conv_b))
    q, k, v = _blockdiag(xc, wq), _blockdiag(xc, wk), _blockdiag(xm, wv)
    gates = (q @ w_gate[:D_INNER] + k @ w_gate[D_INNER:2 * D_INNER] + v @ w_gate[2 * D_INNER:] + b_gate)
    gates = jnp.moveaxis(gates.reshape(B, T, 4, MLSTM_HEADS), 1, 3).astype(F32)

    def heads(a):
        return jnp.moveaxis(a.reshape(B, T, MLSTM_HEADS, MLSTM_HEAD_DIM), 2, 1).astype(F32)

    return xc, z, heads(q), heads(k) * (MLSTM_HEAD_DIM ** -0.5), heads(v), gates


def _mlstm_out(h, xc, z, norm_g, skip, w_out):
    B, H, T, dv = h.shape
    mu = jnp.mean(h, axis=-1, keepdims=True)
    hn = (h - mu) * lax.rsqrt(jnp.mean(jnp.square(h - mu), axis=-1, keepdims=True) + RMS_EPS)
    hn = jnp.moveaxis(hn, 1, 2).reshape(B, T, H * dv).astype(xc.dtype) * norm_g
    return ((hn + skip * xc) * jax.nn.silu(z)) @ w_out


def _mlstm_mixer(h_lat, h_ctx, w_in, conv_w, conv_b, wq, wk, wv, w_gate, b_gate, norm_g, skip, w_out, need_ctx):
    prm = (w_in, conv_w, conv_b, wq, wk, wv, w_gate, b_gate)
    xc_l, z_l, q_l, k_l, v_l, g_l = _mlstm_project(h_lat, *prm)
    xc_c, z_c, q_c, k_c, v_c, g_c = _mlstm_project(h_ctx, *prm)
    B = h_lat.shape[0]
    dh = MLSTM_HEAD_DIM
    zero = (jnp.zeros((B, MLSTM_HEADS, dh, dh), F32), jnp.zeros((B, MLSTM_HEADS, dh), F32),
            jnp.zeros((B, MLSTM_HEADS), F32))
    lat_dirs, ctx_dirs = [], []
    for d, rev in ((0, False), (1, True)):
        tr = (lambda a: jnp.flip(a, axis=2)) if rev else (lambda a: a)
        hc, st = _mlstm_scan(tr(q_c), tr(k_c), tr(v_c), tr(g_c[:, 2 * d]),
                             jax.nn.log_sigmoid(tr(g_c[:, 2 * d + 1])), zero)
        hl, _ = _mlstm_scan(tr(q_l), tr(k_l), tr(v_l), tr(g_l[:, 2 * d]),
                            jax.nn.log_sigmoid(tr(g_l[:, 2 * d + 1])), st)
        lat_dirs.append(tr(hl))
        ctx_dirs.append(tr(hc))
    y_lat = _mlstm_out(lat_dirs[0] + lat_dirs[1], xc_l, z_l, norm_g, skip, w_out)
    y_ctx = _mlstm_out(ctx_dirs[0] + ctx_dirs[1], xc_c, z_c, norm_g, skip, w_out) if need_ctx else None
    return y_lat, y_ctx


def _diff_mixer(h_lat, h_ctx, w_in, lq1, lk1, lq2, lk2, subln_g, w_out, layer_idx, need_ctx):
    lam_init = 0.8 - 0.6 * math.exp(-0.3 * layer_idx)
    lam = (jnp.exp(jnp.sum(lq1 * lk1)) - jnp.exp(jnp.sum(lq2 * lk2))).astype(F32) + lam_init
    H, d = DIFF_HEADS, DIFF_HEAD_DIM

    def proj(h, rope):
        B, T, _ = h.shape
        q, k, v, z = jnp.split(h @ w_in, 4, axis=-1)
        q = q.reshape(B, T, 2 * H, d)
        k = k.reshape(B, T, 2 * H, d)
        if rope:
            q, k = _rope_2d(q), _rope_2d(k)
        q = q.reshape(B, T, H, 2, d) * (d ** -0.5)
        k = k.reshape(B, T, H, 2, d)
        return q, k, v.reshape(B, T, H, 2 * d), z

    def attend(q, k, v):
        p = jax.nn.softmax(jnp.einsum('bqhcd,bkhcd->bhcqk', q, k).astype(F32), axis=-1)
        a = (p[:, :, 0] - lam * p[:, :, 1]).astype(v.dtype)
        return jnp.einsum('bhqk,bkhe->bqhe', a, v)

    def finish(o, z):
        B, T = o.shape[:2]
        o = _rmsnorm(o, subln_g) * (1.0 - lam_init)
        return (o.reshape(B, T, D_INNER) * jax.nn.silu(z)) @ w_out

    q_l, k_l, v_l, z_l = proj(h_lat, True)
    q_c, k_c, v_c, z_c = proj(h_ctx, False)
    B, S = h_lat.shape[:2]
    nb = S // Q_BLOCK
    k_all = jnp.concatenate([k_l, k_c], axis=1)
    v_all = jnp.concatenate([v_l, v_c], axis=1)
    q_blocks = jnp.moveaxis(q_l.reshape(B, nb, Q_BLOCK, H, 2, d), 1, 0)
    o = lax.map(lambda qb: attend(qb, k_all, v_all), q_blocks)
    o = jnp.moveaxis(o, 0, 1).reshape(B, S, H, 2 * d)
    y_lat = finish(o, z_l)
    y_ctx = finish(attend(q_c, k_c, v_c), z_c) if need_ctx else None
    return y_lat, y_ctx


def _na_mixer(h_lat, h_ctx, w_in, rpb, w_out, need_ctx):
    H, dh = NA_HEADS, NA_HEAD_DIM

    def proj(h):
        B, T, _ = h.shape
        q, k, v, z = jnp.split(h @ w_in, 4, axis=-1)
        return (q.reshape(B, T, H, dh) * (dh ** -0.5), k.reshape(B, T, H, dh), v.reshape(B, T, H, dh), z)

    q_l, k_l, v_l, z_l = proj(h_lat)
    q_c, k_c, v_c, z_c = proj(h_ctx)
    B, S = h_lat.shape[:2]
    rows = S // GRID_W
    wr = min(NA_WIN_ROWS, rows)
    n_cb = GRID_W // NA_QCOL_BLOCK
    jb = np.arange(n_cb)
    kc0 = np.clip(jb * NA_QCOL_BLOCK - NA_WIN_COLS // 2, 0, GRID_W - NA_KCOL_BLOCK)
    key_cols = kc0[:, None] + np.arange(NA_KCOL_BLOCK)
    q_cols = jb[:, None] * NA_QCOL_BLOCK + np.arange(NA_QCOL_BLOCK)
    cs = np.clip(q_cols - NA_WIN_COLS // 2, 0, GRID_W - NA_WIN_COLS)
    col_ok = (key_cols[:, None, :] >= cs[:, :, None]) & (key_cols[:, None, :] < cs[:, :, None] + NA_WIN_COLS)
    dc_idx = np.clip(key_cols[:, None, :] - q_cols[:, :, None], -(NA_WIN_COLS - 1), NA_WIN_COLS - 1) + NA_WIN_COLS - 1
    k_grid = k_l.reshape(B, rows, GRID_W, H, dh)
    v_grid = v_l.reshape(B, rows, GRID_W, H, dh)
    q_rows = jnp.moveaxis(q_l.reshape(B, rows, n_cb, NA_QCOL_BLOCK, H, dh), 1, 0)
    nk = wr * NA_KCOL_BLOCK

    def row_block(args):
        r, qr = args
        rs = jnp.clip(r - wr // 2, 0, rows - wr)
        kb = lax.dynamic_slice_in_dim(k_grid, rs, wr, axis=1)[:, :, key_cols]
        vb = lax.dynamic_slice_in_dim(v_grid, rs, wr, axis=1)[:, :, key_cols]
        dr_idx = rs + jnp.arange(wr) - r + NA_WIN_ROWS - 1
        bias = jnp.moveaxis(rpb[:, dr_idx][:, :, dc_idx], 1, 3).astype(F32)
        s_lat = jnp.einsum('bjuhd,bajwhd->bhjuaw', qr, kb).astype(F32) + bias
        s_lat = jnp.where(col_ok[:, :, None, :], s_lat, -jnp.inf)
        s_ctx = jnp.einsum('bjuhd,bkhd->bhjuk', qr, k_c).astype(F32)
        p = jax.nn.softmax(jnp.concatenate([s_lat.reshape(B, H, n_cb, NA_QCOL_BLOCK, nk), s_ctx], axis=-1), axis=-1)
        p = p.astype(vb.dtype)
        p_lat = p[..., :nk].reshape(B, H, n_cb, NA_QCOL_BLOCK, wr, NA_KCOL_BLOCK)
        return (jnp.einsum('bhjuaw,bajwhe->bjuhe', p_lat, vb)
                + jnp.einsum('bhjuk,bkhe->bjuhe', p[..., nk:], v_c))

    o = lax.map(row_block, (jnp.arange(rows), q_rows))
    o = jnp.moveaxis(o, 0, 1).reshape(B, S, D_INNER)
    y_lat = (o * jax.nn.silu(z_l)) @ w_out
    y_ctx = None
    if need_ctx:
        pc = jax.nn.softmax(jnp.einsum('bqhd,bkhd->bhqk', q_c, k_c).astype(F32), axis=-1).astype(v_c.dtype)
        oc = jnp.einsum('bhqk,bkhd->bqhd', pc, v_c).reshape(B, h_ctx.shape[1], D_INNER)
        y_ctx = (oc * jax.nn.silu(z_c)) @ w_out
    return y_lat, y_ctx


def _swa_mixer(h_lat, h_ctx, w_in, sink, w_out, need_ctx):
    Hkv, G, dh = SWA_KV_HEADS, SWA_Q_HEADS // SWA_KV_HEADS, SWA_HEAD_DIM
    kvw = Hkv * dh
    sink_hg = sink.reshape(Hkv, G).astype(F32)

    def proj(h, rope):
        B, T, _ = h.shape
        q, k, v, z = jnp.split(h @ w_in, [D_INNER, D_INNER + kvw, D_INNER + 2 * kvw], axis=-1)
        q = q.reshape(B, T, SWA_Q_HEADS, dh)
        k = k.reshape(B, T, Hkv, dh)
        if rope:
            q, k = _rope_2d(q), _rope_2d(k)
        return (q * (dh ** -0.5)).reshape(B, T, Hkv, G, dh), k, v.reshape(B, T, Hkv, dh), z

    q_l, k_l, v_l, z_l = proj(h_lat, True)
    q_c, k_c, v_c, z_c = proj(h_ctx, False)
    B, S = h_lat.shape[:2]
    nb = S // Q_BLOCK
    band = Q_BLOCK + 2 * SWA_WINDOW
    pad = ((0, 0), (SWA_WINDOW, SWA_WINDOW), (0, 0), (0, 0))
    kp, vp = jnp.pad(k_l, pad), jnp.pad(v_l, pad)
    u = np.arange(Q_BLOCK)[:, None]
    w = np.arange(band)[None, :]
    in_win = np.abs(u + SWA_WINDOW - w) <= SWA_WINDOW
    q_blocks = jnp.moveaxis(q_l.reshape(B, nb, Q_BLOCK, Hkv, G, dh), 1, 0)

    def block(args):
        bi, qb = args
        kb = lax.dynamic_slice_in_dim(kp, bi * Q_BLOCK, band, axis=1)
        vb = lax.dynamic_slice_in_dim(vp, bi * Q_BLOCK, band, axis=1)
        s_pos = bi * Q_BLOCK - SWA_WINDOW + jnp.arange(band)
        ok = in_win & ((s_pos >= 0) & (s_pos < S))[None, :]
        s_lat = jnp.where(ok, jnp.einsum('bqhgd,bkhd->bhgqk', qb, kb).astype(F32), -jnp.inf)
        s_ctx = jnp.einsum('bqhgd,bkhd->bhgqk', qb, k_c).astype(F32)
        p = _sink_softmax(jnp.concatenate([s_lat, s_ctx], axis=-1), sink_hg).astype(vb.dtype)
        return (jnp.einsum('bhgqk,bkhd->bqhgd', p[..., :band], vb)
                + jnp.einsum('bhgqk,bkhd->bqhgd', p[..., band:], v_c))

    o = lax.map(block, (jnp.arange(nb), q_blocks))
    o = jnp.moveaxis(o, 0, 1).reshape(B, S, D_INNER)
    y_lat = (o * jax.nn.silu(z_l)) @ w_out
    y_ctx = None
    if need_ctx:
        pc = _sink_softmax(jnp.einsum('bqhgd,bkhd->bhgqk', q_c, k_c).astype(F32), sink_hg).astype(v_c.dtype)
        oc = jnp.einsum('bhgqk,bkhd->bqhgd', pc, v_c).reshape(B, h_ctx.shape[1], D_INNER)
        y_ctx = (oc * jax.nn.silu(z_c)) @ w_out
    return y_lat, y_ctx


def setup_inputs(seed: int = 0) -> dict:
    key = jax.random.key(seed)
    ks = iter(jax.random.split(key, 48))

    def nrm(shape, scale):
        return jax.random.normal(next(ks), shape, F32) * scale

    nA, nB, nC, nD = (len(range(m, DEPTH, N_MIXERS)) for m in range(N_MIXERS))
    H = MLSTM_HEADS
    gate_base = jnp.concatenate([jnp.zeros((H,), F32), jnp.linspace(MLSTM_F_BIAS_LO, MLSTM_F_BIAS_HI, H),
                                 jnp.zeros((H,), F32), jnp.linspace(MLSTM_F_BIAS_LO, MLSTM_F_BIAS_HI, H)])
    nblk = D_INNER // MLSTM_QKV_BLOCK
    bs = MLSTM_QKV_BLOCK
    kvw = SWA_KV_HEADS * SWA_HEAD_DIM
    return {
        'x': nrm((BATCH, SEQ, D_MODEL), 1.0),
        'c': nrm((BATCH, D_MODEL), 1.0),
        'ctx': nrm((BATCH, CTX_LEN, D_MODEL), 1.0),
        'c_ctx': nrm((D_MODEL,), 1.0),
        'norm_g': 1.0 + nrm((DEPTH, D_MODEL), 0.02),
        'w_ada': nrm((DEPTH, D_MODEL, 3 * D_MODEL), 0.5 * D_MODEL ** -0.5),
        'b_ada': nrm((DEPTH, 3 * D_MODEL), 0.02),
        'final_g': 1.0 + nrm((D_MODEL,), 0.02),
        'mlstm_w_in': nrm((nA, D_MODEL, 2 * D_INNER), D_MODEL ** -0.5),
        'mlstm_conv_w': nrm((nA, MLSTM_CONV, D_INNER), MLSTM_CONV ** -0.5),
        'mlstm_conv_b': nrm((nA, D_INNER), 0.02),
        'mlstm_wq': nrm((nA, nblk, bs, bs), bs ** -0.5),
        'mlstm_wk': nrm((nA, nblk, bs, bs), bs ** -0.5),
        'mlstm_wv': nrm((nA, nblk, bs, bs), bs ** -0.5),
        'mlstm_w_gate': nrm((nA, 3 * D_INNER, 4 * H), (3 * D_INNER) ** -0.5),
        'mlstm_b_gate': gate_base[None, :] + nrm((nA, 4 * H), 0.1),
        'mlstm_norm_g': 1.0 + nrm((nA, D_INNER), 0.02),
        'mlstm_skip': 1.0 + nrm((nA, D_INNER), 0.02),
        'mlstm_w_out': nrm((nA, D_INNER, D_MODEL), D_INNER ** -0.5),
        'diff_w_in': nrm((nB, D_MODEL, 4 * D_INNER), D_MODEL ** -0.5),
        'diff_lq1': nrm((nB, DIFF_HEAD_DIM), 0.1),
        'diff_lk1': nrm((nB, DIFF_HEAD_DIM), 0.1),
        'diff_lq2': nrm((nB, DIFF_HEAD_DIM), 0.1),
        'diff_lk2': nrm((nB, DIFF_HEAD_DIM), 0.1),
        'diff_subln_g': 1.0 + nrm((nB, 2 * DIFF_HEAD_DIM), 0.02),
        'diff_w_out': nrm((nB, D_INNER, D_MODEL), D_INNER ** -0.5),
        'na_w_in': nrm((nC, D_MODEL, 4 * D_INNER), D_MODEL ** -0.5),
        'na_rpb': nrm((nC, NA_HEADS, 2 * NA_WIN_ROWS - 1, 2 * NA_WIN_COLS - 1), 0.1),
        'na_w_out': nrm((nC, D_INNER, D_MODEL), D_INNER ** -0.5),
        'swa_w_in': nrm((nD, D_MODEL, 2 * D_INNER + 2 * kvw), D_MODEL ** -0.5),
        'swa_sink': nrm((nD, SWA_Q_HEADS), 1.0),
        'swa_w_out': nrm((nD, D_INNER, D_MODEL), D_INNER ** -0.5),
    }


def reference(x, c, ctx, c_ctx, norm_g, w_ada, b_ada, final_g,
              mlstm_w_in, mlstm_conv_w, mlstm_conv_b, mlstm_wq, mlstm_wk, mlstm_wv, mlstm_w_gate, mlstm_b_gate,
              mlstm_norm_g, mlstm_skip, mlstm_w_out,
              diff_w_in, diff_lq1, diff_lk1, diff_lq2, diff_lk2, diff_subln_g, diff_w_out,
              na_w_in, na_rpb, na_w_out,
              swa_w_in, swa_sink, swa_w_out):
    s_c = jax.nn.silu(c)
    s_ctx = jax.nn.silu(c_ctx)
    ctx_s = ctx
    for i in range(DEPTH):
        mixer, j = i % N_MIXERS, i // N_MIXERS
        need_ctx = i < DEPTH - 1
        sh, scl, gt = jnp.split((s_c @ w_ada[i] + b_ada[i])[:, None, :], 3, axis=-1)
        sh_c, scl_c, gt_c = jnp.split(s_ctx @ w_ada[i] + b_ada[i], 3)
        h_lat = _rmsnorm(x, norm_g[i]) * (1.0 + scl) + sh
        h_ctx = _rmsnorm(ctx_s, norm_g[i]) * (1.0 + scl_c) + sh_c
        if mixer == 0:
            y_lat, y_ctx = _mlstm_mixer(h_lat, h_ctx, mlstm_w_in[j], mlstm_conv_w[j], mlstm_conv_b[j], mlstm_wq[j],
                                        mlstm_wk[j], mlstm_wv[j], mlstm_w_gate[j], mlstm_b_gate[j],
                                        mlstm_norm_g[j], mlstm_skip[j], mlstm_w_out[j], need_ctx)
        elif mixer == 1:
            y_lat, y_ctx = _diff_mixer(h_lat, h_ctx, diff_w_in[j], diff_lq1[j], diff_lk1[j], diff_lq2[j],
                                       diff_lk2[j], diff_subln_g[j], diff_w_out[j], i, need_ctx)
        elif mixer == 2:
            y_lat, y_ctx = _na_mixer(h_lat, h_ctx, na_w_in[j], na_rpb[j], na_w_out[j], need_ctx)
        else:
            y_lat, y_ctx = _swa_mixer(h_lat, h_ctx, swa_w_in[j], swa_sink[j], swa_w_out[j], need_ctx)
        x = x + gt * y_lat
        if need_ctx:
            ctx_s = ctx_s + gt_c * y_ctx
    return _rmsnorm(x, final_g)
```

```cpp
#include <hip/hip_runtime.h>
#include <cstdint>
#include <cstdio>
#include <cmath>
namespace nv {
constexpr int NB = 16, S = 2048, D = 1024, CT = 256, R = S + CT, DI = 2048;
constexpr float EPS = 1e-6f;
constexpr size_t MiB = 1u << 20;
constexpr size_t WS_CTXS = 0, WS_MOD = 16 * MiB, WS_H = 17 * MiB, WS_PROJ = 26 * MiB;
constexpr size_t WS_B0 = 98 * MiB, WS_B1 = 116 * MiB, WS_B2 = 134 * MiB, WS_B3 = 152 * MiB, WS_B4 = 170 * MiB, WS_B5 = 188 * MiB;
constexpr size_t WS_OC = 206 * MiB, WS_GATES = 242 * MiB;

__device__ __forceinline__ float silu(float x) { return x / (1.f + expf(-x)); }

__global__ __launch_bounds__(256) void k_mod(const float* __restrict__ c, const float* __restrict__ cctx, const float* __restrict__ w_ada, const float* __restrict__ b_ada, float* __restrict__ mod) {
    __shared__ float s[17][256];
    const int n = blockIdx.x * 256 + threadIdx.x, l = blockIdx.y;
    float acc[17];
#pragma unroll
    for (int r = 0; r < 17; ++r) acc[r] = 0.f;
    for (int kc = 0; kc < 4; ++kc) {
        for (int idx = threadIdx.x; idx < 17 * 256; idx += 256) { const int r = idx >> 8, kk = idx & 255; const float v = r < 16 ? c[r * 1024 + kc * 256 + kk] : cctx[kc * 256 + kk]; s[r][kk] = silu(v); }
        __syncthreads();
        for (int kk = 0; kk < 256; ++kk) { const float w = w_ada[((size_t)l * 1024 + kc * 256 + kk) * 3072 + n];
#pragma unroll
            for (int r = 0; r < 17; ++r) acc[r] += s[r][kk] * w; }
        __syncthreads();
    }
#pragma unroll
    for (int r = 0; r < 17; ++r) mod[((size_t)l * 17 + r) * 3072 + n] = acc[r] + b_ada[l * 3072 + n];
}

__device__ __forceinline__ float block_sum_256(float v, float* red) {
#pragma unroll
    for (int o = 32; o > 0; o >>= 1) v += __shfl_xor(v, o);
    __syncthreads();
    if ((threadIdx.x & 63) == 0) red[threadIdx.x >> 6] = v;
    __syncthreads();
    return red[0] + red[1] + red[2] + red[3];
}

__global__ __launch_bounds__(256) void k_norm(const float* __restrict__ xs, const float* __restrict__ ctxs, const float* __restrict__ g, const float* __restrict__ mod_l  , int b, float* __restrict__ h) {
    __shared__ float red[4];
    const int r = blockIdx.x, t = threadIdx.x;
    const float* src = r < CT ? ctxs + ((size_t)b * CT + r) * D : xs + ((size_t)b * S + (r - CT)) * D;
    const float4 v = *(const float4*)(src + t * 4);
    const float ss = block_sum_256(v.x * v.x + v.y * v.y + v.z * v.z + v.w * v.w, red);
    const float rstd = rsqrtf(ss * (1.f / D) + EPS);
    const float* m = mod_l + (size_t)(r < CT ? 16 : b) * 3072;
    float o[4]; const float xv[4] = {v.x, v.y, v.z, v.w};
#pragma unroll
    for (int i = 0; i < 4; ++i) { const int cidx = t * 4 + i; o[i] = xv[i] * rstd * g[cidx] * (1.f + m[1024 + cidx]) + m[cidx]; }
    *(float4*)(h + (size_t)r * D + t * 4) = make_float4(o[0], o[1], o[2], o[3]);
}

struct EpiRes { float* xs; float* ctxs; const float* mod_l; int b; int need_ctx; };
template <int EPI>
__global__ __launch_bounds__(256) void k_gemm(const float* __restrict__ A, int lda, const float* __restrict__ Bm, int ldb, float* __restrict__ C, int ldc, int K, EpiRes er) {
    __shared__ float As[16][132], Bs[16][132];
    const int bm = blockIdx.y * 128, bn = blockIdx.x * 128, tid = threadIdx.x, ty = tid >> 4, tx = tid & 15;
    float acc[8][8];
#pragma unroll
    for (int i = 0; i < 8; ++i)
#pragma unroll
        for (int j = 0; j < 8; ++j) acc[i][j] = 0.f;
    for (int k0 = 0; k0 < K; k0 += 16) {
#pragma unroll
        for (int i = 0; i < 2; ++i) {
            const int idx = tid + i * 256;
            { const int row = idx >> 2, kq = idx & 3; const float4 v = *(const float4*)(A + (size_t)(bm + row) * lda + k0 + kq * 4);
              As[kq * 4 + 0][row] = v.x; As[kq * 4 + 1][row] = v.y; As[kq * 4 + 2][row] = v.z; As[kq * 4 + 3][row] = v.w; }
            { const int kr = idx >> 5, nq = idx & 31; const float4 v = *(const float4*)(Bm + (size_t)(k0 + kr) * ldb + bn + nq * 4);
              *(float4*)&Bs[kr][nq * 4] = v; }
        }
        __syncthreads();
#pragma unroll
        for (int kk = 0; kk < 16; ++kk) {
            float a[8], bb[8];
            *(float4*)&a[0] = *(const float4*)&As[kk][ty * 8]; *(float4*)&a[4] = *(const float4*)&As[kk][ty * 8 + 4];
            *(float4*)&bb[0] = *(const float4*)&Bs[kk][tx * 8]; *(float4*)&bb[4] = *(const float4*)&Bs[kk][tx * 8 + 4];
#pragma unroll
            for (int i = 0; i < 8; ++i)
#pragma unroll
                for (int j = 0; j < 8; ++j) acc[i][j] += a[i] * bb[j];
        }
        __syncthreads();
    }
#pragma unroll
    for (int i = 0; i < 8; ++i) {
        const int r = bm + ty * 8 + i;
        if (EPI == 0) {
            *(float4*)(C + (size_t)r * ldc + bn + tx * 8) = make_float4(acc[i][0], acc[i][1], acc[i][2], acc[i][3]);
            *(float4*)(C + (size_t)r * ldc + bn + tx * 8 + 4) = make_float4(acc[i][4], acc[i][5], acc[i][6], acc[i][7]);
        } else {
            if (r < CT) { if (er.need_ctx) { float* dst = er.ctxs + ((size_t)er.b * CT + r) * D + bn + tx * 8; const float* gt = er.mod_l + 16 * 3072 + 2048 + bn + tx * 8;
#pragma unroll
                for (int j = 0; j < 8; ++j) dst[j] += gt[j] * acc[i][j]; } }
            else { float* dst = er.xs + ((size_t)er.b * S + (r - CT)) * D + bn + tx * 8; const float* gt = er.mod_l + (size_t)er.b * 3072 + 2048 + bn + tx * 8;
#pragma unroll
                for (int j = 0; j < 8; ++j) dst[j] += gt[j] * acc[i][j]; }
        }
    }
}

__global__ __launch_bounds__(256) void k_mlstm_qkv(const float* __restrict__ proj  , const float* __restrict__ cw, const float* __restrict__ cb, const float* __restrict__ wq, const float* __restrict__ wk, const float* __restrict__ wv,
                                                  float* __restrict__ XC, float* __restrict__ Q, float* __restrict__ Kb, float* __restrict__ V) {
    const int r = blockIdx.x, g = blockIdx.y * 256 + threadIdx.x;
    const int seq0 = r < CT ? 0 : CT, len = r < CT ? CT : S, t = r - seq0;
    float xm[4], xc[4];
#pragma unroll
    for (int i = 0; i < 4; ++i) { const int c = g * 4 + i; float a = cb[c];
#pragma unroll
        for (int j = 0; j < 5; ++j) { const int tt = t + j - 2; if (tt >= 0 && tt < len) a += proj[(size_t)(seq0 + tt) * 4096 + c] * cw[j * 2048 + c]; }
        xc[i] = silu(a); xm[i] = proj[(size_t)r * 4096 + c]; }
    float q[4], k[4], v[4];
#pragma unroll
    for (int j = 0; j < 4; ++j) { float aq = 0.f, ak = 0.f, av = 0.f;
#pragma unroll
        for (int i = 0; i < 4; ++i) { aq += xc[i] * wq[(g * 4 + i) * 4 + j]; ak += xc[i] * wk[(g * 4 + i) * 4 + j]; av += xm[i] * wv[(g * 4 + i) * 4 + j]; }
        q[j] = aq; k[j] = ak; v[j] = av; }
    const size_t o = (size_t)r * 2048 + g * 4;
    *(float4*)(XC + o) = make_float4(xc[0], xc[1], xc[2], xc[3]); *(float4*)(Q + o) = make_float4(q[0], q[1], q[2], q[3]);
    *(float4*)(Kb + o) = make_float4(k[0], k[1], k[2], k[3]); *(float4*)(V + o) = make_float4(v[0], v[1], v[2], v[3]);
}
__global__ __launch_bounds__(256) void k_mlstm_gates(const float* __restrict__ Q, const float* __restrict__ Kb, const float* __restrict__ V, const float* __restrict__ wg, const float* __restrict__ bg, float* __restrict__ gates) {
    __shared__ float red[8][32];
    const int r = blockIdx.x, n = threadIdx.x & 31, part = threadIdx.x >> 5;
    float a = 0.f;
    for (int c = part; c < 2048; c += 8) a += Q[(size_t)r * 2048 + c] * wg[(size_t)c * 32 + n] + Kb[(size_t)r * 2048 + c] * wg[(size_t)(2048 + c) * 32 + n] + V[(size_t)r * 2048 + c] * wg[(size_t)(4096 + c) * 32 + n];
    red[part][n] = a; __syncthreads();
    if (threadIdx.x < 32) { float s = bg[n]; for (int p = 0; p < 8; ++p) s += red[p][n]; gates[(size_t)r * 32 + n] = s; }
}
__global__ __launch_bounds__(1024) void k_mlstm_scan(const float* __restrict__ Q, const float* __restrict__ Kb, const float* __restrict__ V, const float* __restrict__ gates, float* __restrict__ Hfw, float* __restrict__ Hbw) {
    __shared__ float qs[256], ks[256], nump[4][256], red[4];
    const int h = blockIdx.x, dir = blockIdx.y, tid = threadIdx.x, j = tid & 255, part = tid >> 8;
    float* Hout = dir == 0 ? Hfw : Hbw;
    float creg[64];
#pragma unroll
    for (int i = 0; i < 64; ++i) creg[i] = 0.f;
    float nreg = 0.f;
    for (int s = 0; s < R; ++s) {
        const int row = dir == 0 ? s : (s < CT ? CT - 1 - s : CT + (S - 1) - (s - CT));
        if (tid < 256) qs[tid] = Q[(size_t)row * 2048 + h * 256 + tid]; else if (tid < 512) ks[tid - 256] = Kb[(size_t)row * 2048 + h * 256 + tid - 256] * 0.0625f;
        const float vj = V[(size_t)row * 2048 + h * 256 + j];
        const float ig = expf(gates[(size_t)row * 32 + (2 * dir) * 8 + h]);
        const float fg = 1.f / (1.f + expf(-gates[(size_t)row * 32 + (2 * dir + 1) * 8 + h]));
        __syncthreads();
        float np = 0.f; const float iv = ig * vj;
#pragma unroll
        for (int i = 0; i < 64; ++i) { const float c = fg * creg[i] + iv * ks[part * 64 + i]; creg[i] = c; np += qs[part * 64 + i] * c; }
        nump[part][j] = np;
        if (tid < 256) { nreg = fg * nreg + ig * ks[tid]; float dp = qs[tid] * nreg;
#pragma unroll
            for (int o = 32; o > 0; o >>= 1) dp += __shfl_xor(dp, o);
            if ((tid & 63) == 0) red[tid >> 6] = dp; }
        __syncthreads();
        if (tid < 256) { const float num = nump[0][tid] + nump[1][tid] + nump[2][tid] + nump[3][tid]; const float den = red[0] + red[1] + red[2] + red[3];
            Hout[(size_t)row * 2048 + h * 256 + tid] = num / fmaxf(fabsf(den), 1.f); }
    }
}
__global__ __launch_bounds__(256) void k_mlstm_out(const float* __restrict__ Hfw, const float* __restrict__ Hbw, const float* __restrict__ XC, const float* __restrict__ proj, const float* __restrict__ ng, const float* __restrict__ skip, float* __restrict__ G) {
    __shared__ float red[4];
    const int r = blockIdx.x, h = blockIdx.y, t = threadIdx.x, c = h * 256 + t;
    const float v = Hfw[(size_t)r * 2048 + c] + Hbw[(size_t)r * 2048 + c];
    const float mu = block_sum_256(v, red) * (1.f / 256.f);
    const float d = v - mu;
    const float var = block_sum_256(d * d, red) * (1.f / 256.f);
    const float hn = d * rsqrtf(var + EPS) * ng[c];
    const float z = proj[(size_t)r * 4096 + 2048 + c];
    G[(size_t)r * 2048 + c] = (hn + skip[c] * XC[(size_t)r * 2048 + c]) * silu(z);
}

__global__ __launch_bounds__(256) void k_rope(float* __restrict__ proj, int ld, int coloff, int nitems  ) {
    const int t = blockIdx.x, it = blockIdx.y * 256 + threadIdx.x; if (it >= nitems) return;
    const int head = it >> 5, half = (it >> 4) & 1, j = it & 15;
    const float inv = powf(10000.f, -(float)j / 16.f);
    const float pos = half == 0 ? (float)(t >> 6) : (float)(t & 63);
    const float ang = pos * inv, cs = cosf(ang), sn = sinf(ang);
    float* p = proj + (size_t)(CT + t) * ld + coloff + head * 64 + half * 32 + j;
    const float x1 = p[0], x2 = p[16];
    p[0] = x1 * cs - x2 * sn; p[16] = x2 * cs + x1 * sn;
}

template <int DV> __device__ __forceinline__ void att_step(const float (&q)[64], float (&o)[DV], float& m, float& l, const float* __restrict__ kp, const float* __restrict__ vp, float bias) {
    float s = 0.f;
#pragma unroll
    for (int d = 0; d < 64; d += 4) { const float4 kv = *(const float4*)(kp + d); s += q[d] * kv.x + q[d + 1] * kv.y + q[d + 2] * kv.z + q[d + 3] * kv.w; }
    s += bias;
    const float mn = fmaxf(m, s), corr = expf(m - mn), p = expf(s - mn);
    l = l * corr + p; m = mn;
#pragma unroll
    for (int e = 0; e < DV; e += 4) { const float4 vv = *(const float4*)(vp + e); o[e] = o[e] * corr + p * vv.x; o[e + 1] = o[e + 1] * corr + p * vv.y; o[e + 2] = o[e + 2] * corr + p * vv.z; o[e + 3] = o[e + 3] * corr + p * vv.w; }
}
template <int DV, int MODE>
__global__ __launch_bounds__(64) void k_attn(const float* __restrict__ P, int ld, int qcol, int kcol, int vcol, int kv_div, int v_div, float* __restrict__ O, int ldo, int row0, float scale, int kr0, int kr1,
                                             const float* __restrict__ rpb, const float* __restrict__ sink) {
    const int hq = blockIdx.y, r = row0 + blockIdx.x * 64 + threadIdx.x;
    float q[64];
    { const float* qp = P + (size_t)r * ld + qcol + hq * 64;
#pragma unroll
      for (int d = 0; d < 64; ++d) q[d] = qp[d] * scale; }
    const float* kb = P + kcol + (hq / kv_div) * 64; const float* vb = P + vcol + (hq / v_div) * DV;
    float m = -INFINITY, l = 0.f, o[DV];
#pragma unroll
    for (int e = 0; e < DV; ++e) o[e] = 0.f;
    if (MODE == 0) { for (int kr = kr0; kr < kr1; ++kr) att_step<DV>(q, o, m, l, kb + (size_t)kr * ld, vb + (size_t)kr * ld, 0.f); }
    else if (MODE == 1) {
        const int t = r - CT, gr = t >> 6, gc = t & 63; const int rs = min(max(gr - 4, 0), 24), cs = min(max(gc - 8, 0), 48);
        for (int a = 0; a < 8; ++a) for (int w = 0; w < 16; ++w) { const int kr = CT + (rs + a) * 64 + cs + w; const float bias = rpb[(hq * 15 + (rs + a - gr + 7)) * 31 + (cs + w - gc + 15)];
            att_step<DV>(q, o, m, l, kb + (size_t)kr * ld, vb + (size_t)kr * ld, bias); }
        for (int kr = 0; kr < CT; ++kr) att_step<DV>(q, o, m, l, kb + (size_t)kr * ld, vb + (size_t)kr * ld, 0.f);
    } else {
        const int t = r - CT; const int lo = max(t - 128, 0), hi = min(t + 128, S - 1);
        for (int tk = lo; tk <= hi; ++tk) { const int kr = CT + tk; att_step<DV>(q, o, m, l, kb + (size_t)kr * ld, vb + (size_t)kr * ld, 0.f); }
        for (int kr = 0; kr < CT; ++kr) att_step<DV>(q, o, m, l, kb + (size_t)kr * ld, vb + (size_t)kr * ld, 0.f);
        const float sk = sink[hq]; const float mn = fmaxf(m, sk), corr = expf(m - mn); l = l * corr + expf(sk - mn);
#pragma unroll
        for (int e = 0; e < DV; ++e) o[e] *= corr;
    }
    const float il = 1.f / l; float* op = O + (size_t)r * ldo + hq * DV;
#pragma unroll
    for (int e = 0; e < DV; ++e) op[e] = o[e] * il;
}
__global__ __launch_bounds__(128) void k_diff_finish(const float* __restrict__ OC  , const float* __restrict__ proj  , const float* __restrict__ lq1, const float* __restrict__ lk1, const float* __restrict__ lq2, const float* __restrict__ lk2,
                                                    const float* __restrict__ sg, float lam_init, float* __restrict__ G) {
    __shared__ float red[2]; __shared__ float lam_s;
    const int r = blockIdx.x, h = blockIdx.y, e = threadIdx.x;
    if (e == 0) { float a = 0.f, b = 0.f; for (int i = 0; i < 64; ++i) { a += lq1[i] * lk1[i]; b += lq2[i] * lk2[i]; } lam_s = expf(a) - expf(b) + lam_init; }
    __syncthreads();
    const float lam = lam_s;
    const float o = OC[(size_t)r * 4096 + (2 * h) * 128 + e] - lam * OC[(size_t)r * 4096 + (2 * h + 1) * 128 + e];
    float ss = o * o;
#pragma unroll
    for (int k = 32; k > 0; k >>= 1) ss += __shfl_xor(ss, k);
    if ((e & 63) == 0) red[e >> 6] = ss; __syncthreads();
    const float rstd = rsqrtf((red[0] + red[1]) * (1.f / 128.f) + EPS);
    const float z = proj[(size_t)r * 8192 + 6144 + h * 128 + e];
    G[(size_t)r * 2048 + h * 128 + e] = o * rstd * sg[e] * (1.f - lam_init) * silu(z);
}
__global__ __launch_bounds__(256) void k_gate(const float* __restrict__ O, const float* __restrict__ proj, int ld, int zcol, float* __restrict__ G) {
    const int r = blockIdx.x; for (int c = threadIdx.x; c < 2048; c += 256) G[(size_t)r * 2048 + c] = O[(size_t)r * 2048 + c] * silu(proj[(size_t)r * ld + zcol + c]);
}
__global__ __launch_bounds__(256) void k_final(float* __restrict__ xs, const float* __restrict__ g) {
    __shared__ float red[4];
    float* p = xs + (size_t)blockIdx.x * D + threadIdx.x * 4; const float4 v = *(const float4*)p;
    const float ss = block_sum_256(v.x * v.x + v.y * v.y + v.z * v.z + v.w * v.w, red); const float rstd = rsqrtf(ss * (1.f / D) + EPS);
    const float4 gg = *(const float4*)(g + threadIdx.x * 4);
    *(float4*)p = make_float4(v.x * rstd * gg.x, v.y * rstd * gg.y, v.z * rstd * gg.z, v.w * rstd * gg.w);
}

inline void run_layer(int i, void* const* d_in, float* xs, unsigned char* ws, hipStream_t st) {
    float* ctxs = (float*)(ws + WS_CTXS); float* mod = (float*)(ws + WS_MOD); float* H = (float*)(ws + WS_H); float* PROJ = (float*)(ws + WS_PROJ);
    float* B0 = (float*)(ws + WS_B0); float* B1 = (float*)(ws + WS_B1); float* B2 = (float*)(ws + WS_B2); float* B3 = (float*)(ws + WS_B3); float* B4 = (float*)(ws + WS_B4); float* B5 = (float*)(ws + WS_B5);
    float* OC = (float*)(ws + WS_OC); float* GATES = (float*)(ws + WS_GATES);
    const float* mod_l = mod + (size_t)i * 17 * 3072; const float* ng = (const float*)d_in[4] + i * 1024;
    const int need_ctx = i < 3;
    auto F = [&](int k) { return (const float*)d_in[k]; };
    for (int b = 0; b < NB; ++b) {
        EpiRes er{xs, ctxs, mod_l, b, need_ctx}; EpiRes e0{};
        k_norm<<<R, 256, 0, st>>>(xs, ctxs, ng, mod_l, b, H);
        if (i == 0) {
            k_gemm<0><<<dim3(4096 / 128, R / 128), 256, 0, st>>>(H, 1024, F(8), 4096, PROJ, 4096, 1024, e0);
            k_mlstm_qkv<<<dim3(R, 2), 256, 0, st>>>(PROJ, F(9), F(10), F(11), F(12), F(13), B0, B1, B2, B3);
            k_mlstm_gates<<<R, 256, 0, st>>>(B1, B2, B3, F(14), F(15), GATES);
            k_mlstm_scan<<<dim3(8, 2), 1024, 0, st>>>(B1, B2, B3, GATES, B4, B5);
            k_mlstm_out<<<dim3(R, 8), 256, 0, st>>>(B4, B5, B0, PROJ, F(16), F(17), B1);
            k_gemm<1><<<dim3(1024 / 128, R / 128), 256, 0, st>>>(B1, 2048, F(18), 1024, nullptr, 0, 2048, er);
        } else if (i == 1) {
            k_gemm<0><<<dim3(8192 / 128, R / 128), 256, 0, st>>>(H, 1024, F(19), 8192, PROJ, 8192, 1024, e0);
            k_rope<<<dim3(S, 4), 256, 0, st>>>(PROJ, 8192, 0, 32 * 32);
            k_rope<<<dim3(S, 4), 256, 0, st>>>(PROJ, 8192, 2048, 32 * 32);
            k_attn<128, 0><<<dim3(S / 64, 32), 64, 0, st>>>(PROJ, 8192, 0, 2048, 4096, 1, 2, OC, 4096, CT, 0.125f, 0, R, nullptr, nullptr);
            k_attn<128, 0><<<dim3(CT / 64, 32), 64, 0, st>>>(PROJ, 8192, 0, 2048, 4096, 1, 2, OC, 4096, 0, 0.125f, 0, CT, nullptr, nullptr);
            const float lam_init = 0.8f - 0.6f * expf(-0.3f * 1.0f);
            k_diff_finish<<<dim3(R, 16), 128, 0, st>>>(OC, PROJ, F(20), F(21), F(22), F(23), F(24), lam_init, B1);
            k_gemm<1><<<dim3(1024 / 128, R / 128), 256, 0, st>>>(B1, 2048, F(25), 1024, nullptr, 0, 2048, er);
        } else if (i == 2) {
            k_gemm<0><<<dim3(8192 / 128, R / 128), 256, 0, st>>>(H, 1024, F(26), 8192, PROJ, 8192, 1024, e0);
            k_attn<64, 1><<<dim3(S / 64, 32), 64, 0, st>>>(PROJ, 8192, 0, 2048, 4096, 1, 1, B0, 2048, CT, 0.125f, 0, 0, F(27), nullptr);
            k_attn<64, 0><<<dim3(CT / 64, 32), 64, 0, st>>>(PROJ, 8192, 0, 2048, 4096, 1, 1, B0, 2048, 0, 0.125f, 0, CT, nullptr, nullptr);
            k_gate<<<R, 256, 0, st>>>(B0, PROJ, 8192, 6144, B1);
            k_gemm<1><<<dim3(1024 / 128, R / 128), 256, 0, st>>>(B1, 2048, F(28), 1024, nullptr, 0, 2048, er);
        } else {
            k_gemm<0><<<dim3(4608 / 128, R / 128), 256, 0, st>>>(H, 1024, F(29), 4608, PROJ, 4608, 1024, e0);
            k_rope<<<dim3(S, 4), 256, 0, st>>>(PROJ, 4608, 0, 32 * 32);
            k_rope<<<dim3(S, 1), 256, 0, st>>>(PROJ, 4608, 2048, 4 * 32);
            k_attn<64, 2><<<dim3(S / 64, 32), 64, 0, st>>>(PROJ, 4608, 0, 2048, 2304, 8, 8, B0, 2048, CT, 0.125f, 0, 0, nullptr, F(30));
            hipMemsetAsync(B0, 0, (size_t)CT * 2048 * 4, st);
            k_gate<<<R, 256, 0, st>>>(B0, PROJ, 4608, 2560, B1);
            k_gemm<1><<<dim3(1024 / 128, R / 128), 256, 0, st>>>(B1, 2048, F(31), 1024, nullptr, 0, 2048, er);
        }
    }
}
inline void prologue(void* const* d_in, float* xs, unsigned char* ws, hipStream_t st) {
    hipMemcpyAsync(xs, d_in[0], (size_t)NB * S * D * 4, hipMemcpyDeviceToDevice, st);
    hipMemcpyAsync(ws + WS_CTXS, d_in[2], (size_t)NB * CT * D * 4, hipMemcpyDeviceToDevice, st);
    k_mod<<<dim3(12, 4), 256, 0, st>>>((const float*)d_in[1], (const float*)d_in[3], (const float*)d_in[5], (const float*)d_in[6], (float*)(ws + WS_MOD));
}
inline void finale(void* const* d_in, float* xs, hipStream_t st) { k_final<<<NB * S, 256, 0, st>>>(xs, (const float*)d_in[7]); }
}
extern "C" void kernel_launch(void* const* d_in, const int* in_sizes, int n_in, void* d_out, int out_size, void* d_ws, size_t ws_size, hipStream_t stream) {
    float* xs = (float*)d_out; unsigned char* ws = (unsigned char*)d_ws;
    nv::prologue(d_in, xs, ws, stream);
    for (int i = 0; i < 4; ++i) nv::run_layer(i, d_in, xs, ws, stream);
    nv::finale(d_in, xs, stream);
}
```

```cpp
#include <hip/hip_runtime.h>
#include <cstdint>
#include <cstdio>
#include <cmath>
#define MK_HAVE_L0 1
namespace pg8 {
#define PG8_LAS __attribute__((address_space(3)))
typedef unsigned short bf16_t;
typedef short bf16x8 __attribute__((ext_vector_type(8)));
typedef float f32x4 __attribute__((ext_vector_type(4)));
typedef unsigned u32x4 __attribute__((ext_vector_type(4)));
__device__ __forceinline__ int hw_lane() { int l; asm volatile("v_mbcnt_lo_u32_b32 %0, -1, 0\n\tv_mbcnt_hi_u32_b32 %0, -1, %0" : "=v"(l)); return l; }
constexpr int BM = 256, BK = 64, HALF = 128, HTB = HALF * BK * 2  , STAGE_BYTES = 8 * HTB, NXCD = 8, WGM = 8;

__host__ __device__ __forceinline__ int lds_byte(int r, int c) { const int st = (r >> 4) * 2 + (c >> 5), rr = r & 15, cc = c & 31, ob = rr * 64 + cc * 2; return st * 1024 + (ob ^ (((ob >> 9) & 1) << 5)); }
__host__ __device__ __forceinline__ void stage_rc(int b, int& R, int& C) { const int st = b / 1024, sb = b % 1024, swz = sb ^ (((sb >> 9) & 1) << 5); R = (st >> 1) * 16 + swz / 64; C = (st & 1) * 32 + (swz % 64) / 2; }
__host__ __device__ __forceinline__ int perm32(int rho) { const int n = rho >> 4, i = rho & 15; return 8 * (i >> 2) + 4 * n + (i & 3); }

struct Unit { int pm, pn; };
struct Gemm { const bf16_t* A; const bf16_t* Bt; int M, N, K; };

struct StaticOrder {
    int nM, nN, nwg, G, c;
    __host__ __device__ void init(int M, int N, int G_, int c_) { nM = M / BM; nN = N / BM; nwg = nM * nN; G = G_; c = c_; }
    __host__ __device__ bool next(int i, Unit& u) const {
        const long L = (long)i * G + c; if (L >= nwg) return false;
        int wgid = (int)L; { const int q = nwg / NXCD, r = nwg % NXCD, xcd = wgid % NXCD, off = wgid / NXCD; wgid = (xcd < r ? xcd * (q + 1) : r * (q + 1) + (xcd - r) * q) + off; }
        const int nig = WGM * nN, gid = wgid / nig, fm = gid * WGM, gsz = (nM - fm) < WGM ? (nM - fm) : WGM;
        u.pm = fm + ((wgid % nig) % gsz); u.pn = (wgid % nig) / gsz; return true;
    }
    __device__ __forceinline__ void a_ready(const Unit&) const {}
    __device__ __forceinline__ void done(const Unit&) const {}
};

__device__ __forceinline__ unsigned cvt_pk_bf16(float lo, float hi) { unsigned r; asm volatile("v_cvt_pk_bf16_f32 %0, %1, %2" : "=v"(r) : "v"(lo), "v"(hi)); return r; }
typedef float f32x2 __attribute__((ext_vector_type(2)));
template <class Epi, class Sched, bool ALIGN_EPI = false, bool SP2 = false>
__device__ __forceinline__ void gemm_phase(PG8_LAS unsigned char* lds, const Gemm g, const Sched& S, const Epi& E, int wave_id) {
    int tid_ = wave_id * 64 + hw_lane(); asm volatile("" : "+v"(tid_));
    const int tid = tid_, wid = __builtin_amdgcn_readfirstlane(tid >> 6), lane = tid & 63, wr = wid >> 2, wc = wid & 3, fr = lane & 15, fq = lane >> 4;
    const int K = g.K, nt = K / BK;
    unsigned voffA[2], voffB[2];
#pragma unroll
    for (int i = 0; i < 2; ++i) { int R, C; stage_rc(tid * 16 + i * 8192, R, C); const int Rb = Epi::PERM ? ((R & ~31) + perm32(R & 31)) : R;
        voffA[i] = (unsigned)(R * K + C) * 2u; voffB[i] = (unsigned)(Rb * K + C) * 2u; }
    const size_t kstep = (size_t)(BK * 2);
    const size_t hstep = (size_t)HALF * K * 2;
    const size_t tstep = 2 * hstep;
    const unsigned ldsw = (unsigned)wid * 1024u;
    const int aoff = lds_byte(wr * 64 + fr, fq * 8), boff = lds_byte(wc * 32 + fr, fq * 8);
#define PG8_SA(b, h) (((b) * 2 + (h)) * HTB)
#define PG8_SB(b, h) ((4 + (b) * 2 + (h)) * HTB)
#define PG8_STAGE(bufoff, gbase, voff) do { _Pragma("unroll") for (int _i = 0; _i < 2; ++_i) \
        __builtin_amdgcn_global_load_lds((const unsigned*)((const char*)(gbase) + (voff)[_i]), (PG8_LAS unsigned*)(lds + (bufoff) + ldsw + _i * 8192), 16, 0, 0); } while (0)
#define PG8_LDA(dst, b, h) do { _Pragma("unroll") for (int m = 0; m < 4; ++m) _Pragma("unroll") for (int k = 0; k < 2; ++k) dst[m][k] = *(const PG8_LAS bf16x8*)(lds + PG8_SA(b, h) + aoff + m * 2048 + k * 1024); } while (0)
#define PG8_LDB(dst, b, h) do { _Pragma("unroll") for (int n = 0; n < 2; ++n) _Pragma("unroll") for (int k = 0; k < 2; ++k) dst[n][k] = *(const PG8_LAS bf16x8*)(lds + PG8_SB(b, h) + boff + n * 2048 + k * 1024); } while (0)
#define PG8_MMA(ai, bj, At, Bt) do { __builtin_amdgcn_s_setprio(1); _Pragma("unroll") for (int m = 0; m < 4; ++m) _Pragma("unroll") for (int n = 0; n < 2; ++n) _Pragma("unroll") for (int k = 0; k < 2; ++k) \
        acc[ai][bj][m][n] = __builtin_amdgcn_mfma_f32_16x16x32_bf16(Bt[n][k], At[m][k], acc[ai][bj][m][n], 0, 0, 0); __builtin_amdgcn_s_setprio(0); } while (0)
#define PG8_WAIT_V(n) asm volatile("s_waitcnt vmcnt(" #n ")" ::: "memory")
#define PG8_WAIT_L(n) asm volatile("s_waitcnt lgkmcnt(" #n ")" ::: "memory")
#define PG8_BAR __builtin_amdgcn_s_barrier()
#define PG8_SCHED __builtin_amdgcn_sched_barrier(0)
    Unit cur, nxt; int ui = 0;
    if (!S.next(0, cur)) return;
    f32x4 acc[2][2][4][2];
#pragma unroll
    for (int a = 0; a < 2; ++a)
#pragma unroll
        for (int b = 0; b < 2; ++b)
#pragma unroll
            for (int m = 0; m < 4; ++m)
#pragma unroll
                for (int n = 0; n < 2; ++n) acc[a][b][m][n] = (f32x4){0.f, 0.f, 0.f, 0.f};
    bf16x8 At[4][2], B0[2][2], B1[2][2];
    const char* cA = (const char*)g.A + (size_t)cur.pm * tstep; const char* cB = (const char*)g.Bt + (size_t)cur.pn * tstep;
    S.a_ready(cur);
    if constexpr (SP2) {
        PG8_STAGE(PG8_SB(0, 0), cB, voffB); PG8_STAGE(PG8_SB(0, 1), cB + hstep, voffB); PG8_STAGE(PG8_SA(0, 0), cA, voffA); PG8_STAGE(PG8_SA(0, 1), cA + hstep, voffA);
        if (wr == 1) PG8_BAR;
        PG8_WAIT_V(2); PG8_BAR;
        PG8_STAGE(PG8_SB(1, 0), cB + kstep, voffB); PG8_STAGE(PG8_SA(1, 0), cA + kstep, voffA); PG8_STAGE(PG8_SB(1, 1), cB + hstep + kstep, voffB);
        PG8_WAIT_V(6); PG8_BAR;
    } else {
        PG8_STAGE(PG8_SB(0, 0), cB, voffB); PG8_STAGE(PG8_SA(0, 0), cA, voffA); PG8_STAGE(PG8_SB(0, 1), cB + hstep, voffB); PG8_STAGE(PG8_SA(0, 1), cA + hstep, voffA);
        if (wr == 1) PG8_BAR;
        PG8_WAIT_V(4); PG8_BAR;
        PG8_STAGE(PG8_SB(1, 0), cB + kstep, voffB); PG8_STAGE(PG8_SA(1, 0), cA + kstep, voffA); PG8_STAGE(PG8_SB(1, 1), cB + hstep + kstep, voffB);
        PG8_WAIT_V(6); PG8_BAR;
    }
    for (;;) {
        const bool has_next = S.next(ui + 1, nxt);
        const char* nA = has_next ? (const char*)g.A + (size_t)nxt.pm * tstep : cA; const char* nB = has_next ? (const char*)g.Bt + (size_t)nxt.pn * tstep : cB;
        for (int t = 0; t < nt; t += 2) {
            const bool last = (t == nt - 2);
            const char* a1 = cA + (size_t)(t + 1) * kstep;
            const char* a2 = last ? nA : cA + (size_t)(t + 2) * kstep; const char* b2 = last ? nB : cB + (size_t)(t + 2) * kstep;
            const char* a3 = a2 + kstep; const char* b3 = b2 + kstep;
            if (last && has_next) S.a_ready(nxt);
            if constexpr (SP2) {
            PG8_LDB(B0, 0, 0); PG8_LDB(B1, 0, 1); PG8_SCHED; PG8_LDA(At, 0, 0); PG8_STAGE(PG8_SA(1, 1), a1 + hstep, voffA);
            PG8_WAIT_V(8); PG8_WAIT_L(0); PG8_BAR; PG8_MMA(0, 0, At, B0); PG8_MMA(0, 1, At, B1); PG8_BAR; PG8_SCHED;
            PG8_LDA(At, 0, 1); PG8_STAGE(PG8_SB(0, 0), b2, voffB); PG8_STAGE(PG8_SB(0, 1), b2 + hstep, voffB); PG8_STAGE(PG8_SA(0, 0), a2, voffA);
            PG8_WAIT_V(8); PG8_WAIT_L(0); PG8_BAR; PG8_MMA(1, 0, At, B0); PG8_MMA(1, 1, At, B1); PG8_BAR; PG8_SCHED;
            PG8_LDB(B0, 1, 0); PG8_LDB(B1, 1, 1); PG8_SCHED; PG8_LDA(At, 1, 0); PG8_STAGE(PG8_SA(0, 1), a2 + hstep, voffA);
            PG8_WAIT_V(8); PG8_WAIT_L(0); PG8_BAR; PG8_MMA(0, 0, At, B0); PG8_MMA(0, 1, At, B1); PG8_BAR; PG8_SCHED;
            PG8_LDA(At, 1, 1); PG8_STAGE(PG8_SB(1, 0), b3, voffB); PG8_STAGE(PG8_SB(1, 1), b3 + hstep, voffB); PG8_STAGE(PG8_SA(1, 0), a3, voffA);
            PG8_WAIT_V(8); PG8_WAIT_L(0); PG8_BAR; PG8_MMA(1, 0, At, B0); PG8_MMA(1, 1, At, B1); PG8_BAR; PG8_SCHED;
            } else {
            PG8_LDB(B0, 0, 0); PG8_SCHED; PG8_LDA(At, 0, 0); PG8_STAGE(PG8_SA(1, 1), a1 + hstep, voffA);
            PG8_WAIT_L(8); PG8_BAR; PG8_WAIT_L(0); PG8_MMA(0, 0, At, B0); PG8_BAR; PG8_SCHED;
            PG8_LDB(B1, 0, 1); PG8_STAGE(PG8_SB(0, 0), b2, voffB);
            PG8_BAR; PG8_WAIT_L(0); PG8_MMA(0, 1, At, B1); PG8_BAR;
            PG8_LDA(At, 0, 1); PG8_STAGE(PG8_SA(0, 0), a2, voffA);
            PG8_BAR; PG8_WAIT_L(0); PG8_MMA(1, 0, At, B0); PG8_BAR; PG8_SCHED;
            PG8_STAGE(PG8_SB(0, 1), b2 + hstep, voffB);
            PG8_WAIT_V(6); PG8_BAR; PG8_MMA(1, 1, At, B1); PG8_BAR;
            PG8_LDB(B0, 1, 0); PG8_SCHED; PG8_LDA(At, 1, 0); PG8_STAGE(PG8_SA(0, 1), a2 + hstep, voffA);
            PG8_WAIT_L(8); PG8_BAR; PG8_WAIT_L(0); PG8_MMA(0, 0, At, B0); PG8_BAR; PG8_SCHED;
            PG8_LDB(B1, 1, 1); PG8_STAGE(PG8_SB(1, 0), b3, voffB);
            PG8_BAR; PG8_WAIT_L(0); PG8_MMA(0, 1, At, B1); PG8_BAR;
            PG8_LDA(At, 1, 1); PG8_STAGE(PG8_SA(1, 0), a3, voffA);
            PG8_BAR; PG8_WAIT_L(0); PG8_MMA(1, 0, At, B0); PG8_BAR; PG8_SCHED;
            PG8_STAGE(PG8_SB(1, 1), b3 + hstep, voffB);
            PG8_WAIT_V(6); PG8_BAR; PG8_MMA(1, 1, At, B1); PG8_BAR;
            }
        }
        if constexpr (ALIGN_EPI) { if (wr == 0) PG8_BAR; }
#if defined(MK_EXP_EPI2)
        if constexpr (!Epi::AFTER_DRAIN && Epi::PERM) { E.template run<(MK_EXP_EPI2 == 2)>(acc, cur, wr, wc, fr, fq); }
#endif
        if constexpr (!Epi::AFTER_DRAIN) { E(acc, cur, wr, wc, fr, fq); S.done(cur); }
        if (!has_next) break;
#pragma unroll
        for (int a = 0; a < 2; ++a)
#pragma unroll
            for (int b = 0; b < 2; ++b)
#pragma unroll
                for (int m = 0; m < 4; ++m)
#pragma unroll
                    for (int n = 0; n < 2; ++n) acc[a][b][m][n] = (f32x4){0.f, 0.f, 0.f, 0.f};
        cur = nxt; cA = nA; cB = nB; ++ui;
        if constexpr (ALIGN_EPI) { if (wr == 1) PG8_BAR; }
    }
    PG8_WAIT_V(0);
    if constexpr (!ALIGN_EPI) { if (wr == 0) PG8_BAR; }
    PG8_BAR;
    if constexpr (Epi::AFTER_DRAIN) { E.fused(acc, cur, wr, wc, fr, fq, lds, wid, lane); S.done(cur); }
#undef PG8_SA
#undef PG8_SB
#undef PG8_STAGE
#undef PG8_LDA
#undef PG8_LDB
#undef PG8_MMA
#undef PG8_WAIT_V
#undef PG8_WAIT_L
#undef PG8_BAR
#undef PG8_SCHED
}
}
#define GAS __attribute__((address_space(1)))
#define LAS __attribute__((address_space(3)))
typedef unsigned short bf16;
typedef unsigned v4u __attribute__((ext_vector_type(4)));
typedef float f32x4 __attribute__((ext_vector_type(4)));
typedef short bf16x8 __attribute__((ext_vector_type(8)));
typedef GAS unsigned gu32;
typedef GAS unsigned long long gu64;
#define RLX_AGENT __ATOMIC_RELAXED, __HIP_MEMORY_SCOPE_AGENT
#define LDS_WAIT() asm volatile("s_waitcnt lgkmcnt(0)" ::: "memory")
#define VM_WAIT() asm volatile("s_waitcnt vmcnt(0)" ::: "memory")
__device__ __forceinline__ unsigned long long rt() { return __builtin_amdgcn_s_memrealtime(); }
__device__ __forceinline__ unsigned f2bf(float f) { unsigned u = __builtin_bit_cast(unsigned, f); return (u + 0x7fffu + ((u >> 16) & 1u)) >> 16; }
__device__ __forceinline__ unsigned pk2(float lo, float hi) { return f2bf(lo) | (f2bf(hi) << 16); }
#define XB_TMO      128
#define XB_XCNT(j)  (256  + 64 * (j))
#define XB_XSUB(j)  (1280 + 64 * (j))
#define XB_XGEN(j)  (2304 + 64 * (j))
#define XB_TOP      3328
#define XB_TOPGEN   3392
#define XCD_BAR_WORDS 3456
#define XB_SPIN_CAP (1u << 18)

__device__ __forceinline__ unsigned xb_ld(unsigned* p)              { return __hip_atomic_load(p, __ATOMIC_RELAXED, __HIP_MEMORY_SCOPE_AGENT); }
__device__ __forceinline__ unsigned xb_add(unsigned* p, unsigned v) { return __hip_atomic_fetch_add(p, v, __ATOMIC_RELAXED, __HIP_MEMORY_SCOPE_AGENT); }
__device__ __forceinline__ unsigned xb_xcc_id() { return (unsigned)__builtin_amdgcn_s_getreg((3 << 11) | 20) & 0xFu; }
#define XB_SPIN(cond, bar) do { unsigned _sp = 0; while (cond) { __builtin_amdgcn_s_sleep(1); \
    if ((++_sp & 255u) == 0u) { if (xb_ld(&(bar)[XB_TMO])) break; if (_sp > XB_SPIN_CAP) { atomicAdd(&(bar)[XB_TMO], 1u); break; } } } } while (0)

struct XcdBarrier {
    unsigned* bar; unsigned x; unsigned w;
    volatile LAS unsigned* st;
};

__device__ __forceinline__ XcdBarrier xcd_barrier_post(unsigned* bar, volatile LAS unsigned* st, unsigned wave) {
    XcdBarrier b; b.bar = bar; b.x = xb_xcc_id(); b.st = st; b.w = wave;
    if (b.w == 0u && pg8::hw_lane() == 0) (void)xb_add(&bar[XB_XCNT(b.x)], 1u);
    return b;
}
__device__ __forceinline__ void xcd_barrier_complete(unsigned* bar, unsigned x, unsigned& nloc, unsigned& nx) {
    const unsigned G = gridDim.x * gridDim.y * gridDim.z;
    unsigned sum, cnt, mine, sp = 0u;
    for (;;) {
        sum = 0u; cnt = 0u; mine = 0u;
#pragma unroll
        for (unsigned j = 0; j < 16; ++j) { const unsigned c = xb_ld(&bar[XB_XCNT(j)]); sum += c; cnt += (c > 0u) ? 1u : 0u; mine = (j == x) ? c : mine; }
        if (sum == G) break;
        __builtin_amdgcn_s_sleep(1);
        if ((++sp & 255u) == 0u) { if (xb_ld(&bar[XB_TMO])) break; if (sp > XB_SPIN_CAP) { atomicAdd(&bar[XB_TMO], 1u); break; } }
    }
    nloc = mine > 0u ? mine : 1u; nx = cnt > 0u ? cnt : 1u;
}

__device__ __forceinline__ void xcd_barrier(const XcdBarrier& b) {
    asm volatile("s_waitcnt vmcnt(0)" ::: "memory");
    __syncthreads();
    if (b.w == 0u && pg8::hw_lane() == 0) {
        unsigned* bar = b.bar;
        __builtin_amdgcn_s_waitcnt(0);
        unsigned nloc = b.st[0], nx = b.st[1];
        if (nloc == 0u) { xcd_barrier_complete(bar, b.x, nloc, nx); b.st[0] = nloc; b.st[1] = nx; }
        const unsigned old = xb_add(&bar[XB_XSUB(b.x)], 1u);
        const unsigned gen = old / nloc;
        if (old + 1u == (gen + 1u) * nloc) {
            __builtin_amdgcn_fence(__ATOMIC_RELEASE, "agent");
            asm volatile("s_waitcnt vmcnt(0)" ::: "memory");
            const unsigned og = xb_add(&bar[XB_TOP], 1u);
            const unsigned tg = og / nx;
            if (og + 1u == (tg + 1u) * nx) xb_add(&bar[XB_TOPGEN], 1u);
            else XB_SPIN(xb_ld(&bar[XB_TOPGEN]) == tg, bar);
            __builtin_amdgcn_fence(__ATOMIC_ACQUIRE, "agent");
            xb_add(&bar[XB_XGEN(b.x)], 1u);
            asm volatile("s_waitcnt vmcnt(0)" ::: "memory");
        } else {
            XB_SPIN(xb_ld(&bar[XB_XGEN(b.x)]) == gen, bar);
            __builtin_amdgcn_fence(__ATOMIC_ACQUIRE, "agent");
            asm volatile("s_waitcnt vmcnt(0)" ::: "memory");
        }
    }
    __syncthreads();
}
namespace mk {
constexpr int NWAVES = 8, NTHR = 512;
constexpr int NB = 16, S = 2048, D = 1024, CT = 256, RB = S + CT  , MT = NB * RB, HB = 8  , MH = HB * RB, DI = 2048;
constexpr float EPS = 1e-6f, LOG2E = 1.4426950408889634f;
constexpr size_t MiB = 1u << 20;
constexpr size_t WS_CTXS = 0, WS_MOD = 16 * MiB, WS_CTL = 17 * MiB, CTL_BYTES = 64 * 1024;
constexpr size_t WS_ROPE = 18 * MiB, WS_WG2 = 18 * MiB + 64 * 1024, WS_GATES = 19 * MiB;
constexpr size_t WS_WIN = 22 * MiB, WS_WOUT = 38 * MiB, WS_H = 42 * MiB, WS_QG = 114 * MiB, WS_S2 = 258 * MiB, WS_S3 = 330 * MiB, WS_S4 = 402 * MiB, WS_END = 474 * MiB, WS_GATES2 = 474 * MiB  ,
    WS_SSQ = 477 * MiB  , WS_W2 = 480 * MiB  , WS_SHW = 500 * MiB  , WS_GATES3 = 503 * MiB, WS_GATES4 = 506 * MiB  ;
constexpr int CW_BAR = 1024;
constexpr int RING_BYTES = 131072, MISC_OFF = RING_BYTES + 320, LDS_BYTES = 147456;

typedef unsigned short bf16;
typedef float f32x4 __attribute__((ext_vector_type(4)));
typedef float f32x16 __attribute__((ext_vector_type(16)));
typedef short bf16x8 __attribute__((ext_vector_type(8)));
typedef short s16x4 __attribute__((ext_vector_type(4)));
typedef unsigned u32x4 __attribute__((ext_vector_type(4)));
typedef unsigned u32x2 __attribute__((ext_vector_type(2)));

__device__ __forceinline__ float silu(float x) { return x / (1.f + __expf(-x)); }
__device__ __forceinline__ float bf2f(unsigned short b) { return __uint_as_float((unsigned)b << 16); }
__device__ __forceinline__ float bflo(unsigned w) { return __uint_as_float(w << 16); }
__device__ __forceinline__ float bfhi(unsigned w) { return __uint_as_float(w & 0xffff0000u); }
__device__ __forceinline__ float wave_sum(float v) {
#pragma unroll
    for (int o = 1; o < 64; o <<= 1) v += __shfl_xor(v, o);
    return v;
}

struct Frame {
    LAS unsigned char* lds;
    int tid, lane, wave, vcu, G;
    void* const* dummy;
};
__device__ __forceinline__ Frame fresh(const Frame& F0) { Frame F = F0; const int l = pg8::hw_lane(); F.lane = l; F.tid = F0.wave * 64 + l; return F; }
struct Args { const float* in[32]; float* out; unsigned char* ws; int ph_lo, ph_hi; };

template <bool ROPE, bool AFFINE = false> struct EpiProj {
    static constexpr bool PERM = true, AFTER_DRAIN = false;
    bf16 *d0, *d1, *d2, *d3; int l0, l1, l2, l3; int t1, t2, t3; unsigned ropemask; float sc0; const float* rope;
    const float* ssq; const float* shw; int row_base;
    __device__ __forceinline__ void operator()(const pg8::f32x4 (&acc)[2][2][4][2], const pg8::Unit& u, int wr, int wc, int fr, int fq) const { run<false>(acc, u, wr, wc, fr, fq); }
    template <bool NOSTORE> __device__ __forceinline__ void run(const pg8::f32x4 (&acc)[2][2][4][2], const pg8::Unit& u, int wr, int wc, int fr, int fq) const {
        asm volatile("" : "+v"(fr), "+v"(fq));
        const int pn = u.pn;
        long long off = 0; int ld = l0, tb = 0, s = 0;
        if (pn >= t1) { off += (long long)(d1 - d0); ld += l1 - l0; tb = t1; s = 1; }
        if (pn >= t2) { off += (long long)(d2 - d1); ld += l2 - l1; tb = t2; s = 2; }
        if (pn >= t3) { off += (long long)(d3 - d2); ld += l3 - l2; tb = t3; s = 3; }
        bf16* base = d0 + off;
        const float sc = (pn >= t1) ? 1.f : sc0;
        const int rr0 = (u.pm * 256) % RB;
        const bool do_rope = ROPE && ((ropemask >> s) & 1u) && rr0 != 0;
        const int col0 = (pn - tb) * 256 + wc * 32 + 8 * fq;
        const int rloc = wr * 64 + fr;
        pg8::f32x4 sw[2][2];
        if (AFFINE) { const int gr0 = row_base + u.pm * 256; const float* sp = shw + (size_t)(rr0 == 0 ? 16 : gr0 / RB) * 8192 + pn * 256 + wc * 32 + 8 * fq;
#pragma unroll
            for (int bj = 0; bj < 2; ++bj) { sw[bj][0] = *(const pg8::f32x4*)(sp + bj * 128); sw[bj][1] = *(const pg8::f32x4*)(sp + bj * 128 + 4); } }
#pragma unroll
        for (int ai = 0; ai < 2; ++ai)
#pragma unroll
            for (int m = 0; m < 4; ++m) {
                const int rt = rloc + ai * 128 + m * 16;
                bf16* rowp = base + (size_t)(u.pm * 256 + rt) * ld + col0;
                float rstd = 1.f;
                if (AFFINE) { const pg8::f32x4* qp = (const pg8::f32x4*)(ssq + (size_t)(row_base + u.pm * 256 + rt) * 16); const pg8::f32x4 a0 = qp[0], a1 = qp[1], a2 = qp[2], a3 = qp[3];
                    const float tot = ((a0[0] + a0[1]) + (a0[2] + a0[3])) + ((a1[0] + a1[1]) + (a1[2] + a1[3])) + ((a2[0] + a2[1]) + (a2[2] + a2[3])) + ((a3[0] + a3[1]) + (a3[2] + a3[3]));
                    rstd = rsqrtf(tot * (1.f / D) + EPS); }
                f32x4 cs0 = {}, cs1 = {}, cs2 = {}, cs3 = {};
                if (ROPE && do_rope) { const int t = rr0 - CT + rt; const int pos = (wc & 1) ? (t & 63) : (t >> 6); const f32x4* tp = (const f32x4*)(rope + pos * 32 + 16 * (fq & 1));
                    cs0 = tp[0]; cs1 = tp[1]; cs2 = tp[2]; cs3 = tp[3]; }
#pragma unroll
                for (int bj = 0; bj < 2; ++bj) {
                    pg8::f32x4 v0 = acc[ai][bj][m][0], v1 = acc[ai][bj][m][1];
                    if (AFFINE) { v0 = v0 * rstd + sw[bj][0]; v1 = v1 * rstd + sw[bj][1]; }
                    if (ROPE && do_rope) {
                        const float sg = (fq & 2) ? 1.f : -1.f;
                        pg8::f32x4 p0, p1;
#pragma unroll
                        for (int i = 0; i < 4; ++i) { p0[i] = __shfl_xor(v0[i], 32); p1[i] = __shfl_xor(v1[i], 32); }
                        v0[0] = v0[0] * cs0[0] + sg * p0[0] * cs0[1]; v0[1] = v0[1] * cs0[2] + sg * p0[1] * cs0[3];
                        v0[2] = v0[2] * cs1[0] + sg * p0[2] * cs1[1]; v0[3] = v0[3] * cs1[2] + sg * p0[3] * cs1[3];
                        v1[0] = v1[0] * cs2[0] + sg * p1[0] * cs2[1]; v1[1] = v1[1] * cs2[2] + sg * p1[1] * cs2[3];
                        v1[2] = v1[2] * cs3[0] + sg * p1[2] * cs3[1]; v1[3] = v1[3] * cs3[2] + sg * p1[3] * cs3[3];
                    }
                    v0 = v0 * sc; v1 = v1 * sc;
                    pg8::u32x4 w; w.x = pg8::cvt_pk_bf16(v0[0], v0[1]); w.y = pg8::cvt_pk_bf16(v0[2], v0[3]); w.z = pg8::cvt_pk_bf16(v1[0], v1[1]); w.w = pg8::cvt_pk_bf16(v1[2], v1[3]);
                    if (NOSTORE) asm volatile("" :: "v"(w)); else { *(pg8::u32x4*)(rowp + bj * 128) = w;
#ifdef MK_EXP_ST2
                        asm volatile("" ::: "memory"); *(volatile pg8::u32x4*)(rowp + bj * 128) = w;
#endif
                    }
                }
            }
    }
};
__device__ __forceinline__ pg8::f32x4 ld4(const float* p) { return *(const pg8::f32x4*)p; }
__device__ __forceinline__ pg8::f32x4 ld4(const bf16* p) { const u32x2 w = *(const u32x2*)p; pg8::f32x4 v; v[0] = bflo(w.x); v[1] = bfhi(w.x); v[2] = bflo(w.y); v[3] = bfhi(w.y); return v; }
__device__ __forceinline__ void st4(float* p, const pg8::f32x4& v) { *(pg8::f32x4*)p = v; }
__device__ __forceinline__ void st4(bf16* p, const pg8::f32x4& v) { u32x2 w; w.x = pg8::cvt_pk_bf16(v[0], v[1]); w.y = pg8::cvt_pk_bf16(v[2], v[3]); *(u32x2*)p = w; }
template <class BT = float, class OT = float> struct EpiResidT {
    static constexpr bool PERM = false, AFTER_DRAIN = false;
    const BT* base_lat; const BT* base_ctx; OT* out_lat; OT* out_ctx; const float* mod_l; int need_ctx; int dry;
    bf16* Hn; const float* gnext; const float* modn; float* ssq;
    __device__ __forceinline__ void operator()(const pg8::f32x4 (&acc)[2][2][4][2], const pg8::Unit& u, int wr, int wc, int fr, int fq) const {
        asm volatile("" : "+v"(fr), "+v"(fq));
        const int r0 = u.pm * 256, b = r0 / RB, rr0 = r0 % RB; const bool ctx = rr0 == 0;
        if ((ctx && !need_ctx) || dry) return;
        const size_t ro = ctx ? (size_t)b * CT * D : ((size_t)b * S + (rr0 - CT)) * D;
        const BT* bp = (ctx ? base_ctx : base_lat) + ro; OT* op = (ctx ? out_ctx : out_lat) + ro;
        const float* gt = mod_l + (size_t)(ctx ? 16 : b) * 3072 + 2048;
        const int col0 = u.pn * 256 + wc * 32 + 4 * fq;
        pg8::f32x4 g[2][2];
#pragma unroll
        for (int bj = 0; bj < 2; ++bj)
#pragma unroll
            for (int n = 0; n < 2; ++n) g[bj][n] = *(const pg8::f32x4*)(gt + col0 + bj * 128 + n * 16);
        pg8::f32x4 gm[2][2];
        if (Hn) { const float* sn = modn + (size_t)(ctx ? 16 : b) * 3072 + 1024;
#pragma unroll
            for (int bj = 0; bj < 2; ++bj)
#pragma unroll
                for (int n = 0; n < 2; ++n) gm[bj][n] = *(const pg8::f32x4*)(gnext + col0 + bj * 128 + n * 16) * (*(const pg8::f32x4*)(sn + col0 + bj * 128 + n * 16) + 1.0f); }
#pragma unroll
        for (int ai = 0; ai < 2; ++ai)
#pragma unroll
            for (int m = 0; m < 4; ++m) { const size_t off = (size_t)(ai * 128 + wr * 64 + m * 16 + fr) * D + col0; float sq = 0.f;
#pragma unroll
                for (int bj = 0; bj < 2; ++bj)
#pragma unroll
                    for (int n = 0; n < 2; ++n) { const pg8::f32x4 bs = ld4(bp + off + bj * 128 + n * 16); const pg8::f32x4 xn = bs + g[bj][n] * acc[ai][bj][m][n]; st4(op + off + bj * 128 + n * 16, xn);
                        if (Hn) { sq += (xn[0] * xn[0] + xn[1] * xn[1]) + (xn[2] * xn[2] + xn[3] * xn[3]); const pg8::f32x4 hv = xn * gm[bj][n];
                            u32x2 w; w.x = pg8::cvt_pk_bf16(hv[0], hv[1]); w.y = pg8::cvt_pk_bf16(hv[2], hv[3]); *(u32x2*)(Hn + (size_t)(r0 + ai * 128 + wr * 64 + m * 16 + fr) * D + col0 + bj * 128 + n * 16) = w; } }
                if (Hn) { sq += __shfl_xor(sq, 16); sq += __shfl_xor(sq, 32); if (fq == 0) ssq[(size_t)(r0 + ai * 128 + wr * 64 + m * 16 + fr) * 16 + u.pn * 4 + wc] = sq; } }
    }
};
using EpiResid = EpiResidT<float, float>;

struct LatOnlyOrder {
    pg8::StaticOrder lat;
    __device__ void init(int G_, int c_) { lat.init(128 * 256, D, G_, c_); }
    __device__ bool next(int i, pg8::Unit& u) const { const bool ok = lat.next(i, u); u.pm = (u.pm >> 3) * 9 + 1 + (u.pm & 7); return ok; }
    __device__ __forceinline__ void a_ready(const pg8::Unit&) const {}
    __device__ __forceinline__ void done(const pg8::Unit&) const {}
};
struct OutTailOrder {
    int c;
    __device__ void init(int, int c_) { c = c_; }
    __device__ bool next(int i, pg8::Unit& u) const { if (i > 0 || c >= 64) return false; const int x = c & 7, j = c >> 3; u.pm = 128 + 2 * x + (j >> 2); u.pn = j & 3; return true; }
    __device__ __forceinline__ void a_ready(const pg8::Unit&) const {}
    __device__ __forceinline__ void done(const pg8::Unit&) const {}
};
struct L3Order {
    pg8::StaticOrder lat; int G, c;
    __device__ void init(int G_, int c_) { lat.init(64 * 256, 18 * 256, G_, c_); G = G_; c = c_; }
    __device__ bool next(int i, pg8::Unit& u) const {
        const long L = (long)i * G + c;
        if (L < 1152) { const bool ok = lat.next(i, u); u.pm = (u.pm >> 3) * 9 + 1 + (u.pm & 7); return ok; }
        if (L >= 1168) return false;
        const int j = (int)L - 1152; u.pm = (j >> 1) * 9; u.pn = 8 + (j & 1); return true;
    }
    __device__ __forceinline__ void a_ready(const pg8::Unit&) const {}
    __device__ __forceinline__ void done(const pg8::Unit&) const {}
};

__device__ __forceinline__ void transpose_item(const float* W, int K, int N, bf16* WT, LAS float* scr, int item, int lane) {
    const int nblk = N / 32, kb = item / nblk, nb = item % nblk, k0 = 64 * kb, n0 = 32 * nb;
#pragma unroll 8
    for (int i = 0; i < 32; ++i) { const int kk = 2 * i + (lane >> 5); scr[kk * 33 + (lane & 31)] = W[(size_t)(k0 + kk) * N + n0 + (lane & 31)]; }
    LDS_WAIT(); asm volatile("" ::: "memory");
    const int c = lane & 7;
#pragma unroll
    for (int j = 0; j < 4; ++j) { const int n = (lane >> 3) + 8 * j; const LAS float* s = scr + (8 * c) * 33 + n;
        v4u o; o.x = pk2(s[0 * 33], s[1 * 33]); o.y = pk2(s[2 * 33], s[3 * 33]); o.z = pk2(s[4 * 33], s[5 * 33]); o.w = pk2(s[6 * 33], s[7 * 33]);
        *(GAS v4u*)(WT + (size_t)(n0 + n) * K + k0 + 8 * c) = o; }
    LDS_WAIT(); asm volatile("" ::: "memory");
}
__device__ __forceinline__ void wconv(Frame& F0, const float* Win, int Nin, const float* Wout, bf16* WinT, bf16* WoutT, int gw, int NGW) {
    Frame F = fresh(F0);
    LAS float* scr = (LAS float*)(F.lds + F.wave * 16384);
    const int I1 = (D / 64) * (Nin / 32), I2 = (DI / 64) * (D / 32);
    for (int it = gw; it < I1 + I2; it += NGW) { if (it < I1) transpose_item(Win, D, Nin, WinT, scr, it, F.lane); else transpose_item(Wout, DI, D, WoutT, scr, it - I1, F.lane); }
}
template <class XT>
__device__ __forceinline__ void norm_phase(Frame& F0, const XT* xlat, const XT* xctx, const float* g, const float* mod_l, bf16* H, int row_lo = 0, int row_hi = MT, int wg0 = 0) {
    Frame F = fresh(F0);
    const int gw = (wg0 ? (int)blockIdx.x - wg0 : F.vcu) * NWAVES + F.wave, NGW = (F.G - wg0) * NWAVES;
    f32x4 gg[4];
#pragma unroll
    for (int j = 0; j < 4; ++j) gg[j] = *(const f32x4*)(g + F.lane * 4 + 256 * j);
    for (int row0 = row_lo + gw; row0 < row_hi; row0 += 2 * NGW) {
        f32x4 v[2][4]; const float* mrow[2]; float ss[2] = {0.f, 0.f}; int rowi[2];
#pragma unroll
        for (int u = 0; u < 2; ++u) { int row = row0 + u * NGW; if (row >= row_hi) row = row0; rowi[u] = row;
            const int b = row / RB, rr = row % RB;
            const XT* src = rr < CT ? xctx + ((size_t)b * CT + rr) * D : xlat + ((size_t)b * S + (rr - CT)) * D;
            mrow[u] = mod_l + (size_t)(rr < CT ? 16 : b) * 3072;
#pragma unroll
            for (int j = 0; j < 4; ++j) v[u][j] = ld4(src + F.lane * 4 + 256 * j); }
#pragma unroll
        for (int u = 0; u < 2; ++u) {
#pragma unroll
            for (int j = 0; j < 4; ++j) ss[u] += (v[u][j].x * v[u][j].x + v[u][j].y * v[u][j].y) + (v[u][j].z * v[u][j].z + v[u][j].w * v[u][j].w);
            const float rstd = rsqrtf(wave_sum(ss[u]) * (1.f / D) + EPS);
#pragma unroll
            for (int j = 0; j < 4; ++j) { const int c = F.lane * 4 + 256 * j; const f32x4 sc = *(const f32x4*)(mrow[u] + 1024 + c), sh = *(const f32x4*)(mrow[u] + c);
                const f32x4 o = v[u][j] * rstd * gg[j] * (sc + 1.0f) + sh;
                u32x2 w; w.x = pk2(o.x, o.y); w.y = pk2(o.z, o.w); *(u32x2*)(H + (size_t)rowi[u] * D + c) = w; }
        }
    }
}
__device__ __forceinline__ void final_norm_phase(Frame& F0, float* xs, const float* g) {
    Frame F = fresh(F0);
    const int gw = F.vcu * NWAVES + F.wave, NGW = F.G * NWAVES;
    f32x4 gg[4];
#pragma unroll
    for (int j = 0; j < 4; ++j) gg[j] = *(const f32x4*)(g + F.lane * 4 + 256 * j);
    for (int row0 = gw; row0 < NB * S; row0 += 2 * NGW) {
        f32x4 v[2][4]; float* p[2];
#pragma unroll
        for (int u = 0; u < 2; ++u) { int row = row0 + u * NGW; if (row >= NB * S) row = row0; p[u] = xs + (size_t)row * D;
#pragma unroll
            for (int j = 0; j < 4; ++j) v[u][j] = *(const f32x4*)(p[u] + F.lane * 4 + 256 * j); }
#pragma unroll
        for (int u = 0; u < 2; ++u) { float ss = 0.f;
#pragma unroll
            for (int j = 0; j < 4; ++j) ss += (v[u][j].x * v[u][j].x + v[u][j].y * v[u][j].y) + (v[u][j].z * v[u][j].z + v[u][j].w * v[u][j].w);
            const float rstd = rsqrtf(wave_sum(ss) * (1.f / D) + EPS);
#pragma unroll
            for (int j = 0; j < 4; ++j) { const int c = F.lane * 4 + 256 * j; *(f32x4*)(p[u] + c) = v[u][j] * rstd * gg[j]; } }
    }
}
__device__ __forceinline__ void shw_phase(Frame& F0, const Args& a) {
    Frame F = fresh(F0);
    const float* mod = (const float*)(a.ws + WS_MOD); float* shw = (float*)(a.ws + WS_SHW);
    LAS float* sh = (LAS float*)F.lds;
    LAS float* red = (LAS float*)(F.lds + 69632);
    int cur_l = -1;
    for (int it = blockIdx.x; it < 128 + 128 + 72; it += F.G) {
        const int l = it < 128 ? 0 : (it < 256 ? 1 : 2), cg = it - (l == 0 ? 0 : (l == 1 ? 128 : 256));
        const int N = l == 2 ? 4608 : 8192; const float* W = a.in[l == 0 ? 19 : (l == 1 ? 26 : 29)];
        __syncthreads();
        if (l != cur_l) { for (int i = F.tid; i < 17 * 1024; i += NTHR) sh[i] = mod[((size_t)(l + 1) * 17 + (i >> 10)) * 3072 + (i & 1023)]; cur_l = l; __syncthreads(); }
        float acc[17];
#pragma unroll
        for (int r = 0; r < 17; ++r) acc[r] = 0.f;
        const float* wp = W + (size_t)(F.wave * 128) * N + cg * 64 + F.lane;
#pragma unroll 8
        for (int kk = 0; kk < 128; ++kk) { const float w = wp[(size_t)kk * N];
#pragma unroll
            for (int r = 0; r < 17; ++r) acc[r] += sh[r * 1024 + F.wave * 128 + kk] * w; }
#pragma unroll
        for (int r = 0; r < 17; ++r) red[(F.wave * 17 + r) * 64 + F.lane] = acc[r];
        __syncthreads();
        for (int i = F.tid; i < 17 * 64; i += NTHR) { float sacc = 0.f;
#pragma unroll
            for (int w8 = 0; w8 < 8; ++w8) sacc += red[(w8 * 17 + (i >> 6)) * 64 + (i & 63)];
            shw[((size_t)l * 17 + (i >> 6)) * 8192 + cg * 64 + (i & 63)] = sacc; }
    }
    __syncthreads();
}
__device__ __forceinline__ void prologue_phase(Frame& F0, const Args& a) {
    Frame F = fresh(F0);
    const float* c = a.in[1]; const float* cctx = a.in[3]; const float* w_ada = a.in[5];
    float* part = (float*)(a.ws + WS_QG);
    {
        LAS float* st = (LAS float*)F.lds;
        const int wg = blockIdx.x, l = wg >> 6, sl = wg & 63, k0 = sl * 16;
        if (F.tid < 17 * 16) { const int r = F.tid >> 4, k = F.tid & 15; st[F.tid] = silu(r < 16 ? c[r * 1024 + k0 + k] : cctx[k0 + k]); }
        __syncthreads();
        float acc[17][6];
#pragma unroll
        for (int r = 0; r < 17; ++r)
#pragma unroll
            for (int i = 0; i < 6; ++i) acc[r][i] = 0.f;
        const float* wp = w_ada + ((size_t)l * 1024 + k0) * 3072 + F.tid;
#pragma unroll
        for (int k8 = 0; k8 < 16; k8 += 8) { float w[8][6];
#pragma unroll
            for (int kk = 0; kk < 8; ++kk)
#pragma unroll
                for (int i = 0; i < 6; ++i) w[kk][i] = wp[(size_t)(k8 + kk) * 3072 + 512 * i];
#pragma unroll
            for (int kk = 0; kk < 8; ++kk)
#pragma unroll
                for (int r = 0; r < 17; ++r) { const float sv = st[r * 16 + k8 + kk];
#pragma unroll
                    for (int i = 0; i < 6; ++i) acc[r][i] += sv * w[kk][i]; } }
        float* pp = part + (size_t)wg * 17 * 3072 + F.tid;
#pragma unroll
        for (int r = 0; r < 17; ++r)
#pragma unroll
            for (int i = 0; i < 6; ++i) pp[r * 3072 + 512 * i] = acc[r][i];
    }
#ifdef MK_TOUCH
    {
        const int xg = blockIdx.x >> 3; unsigned accv = 0u;
        for (size_t off = ((size_t)xg * NTHR + F.tid) * 4096; off < WS_END; off += (size_t)32 * NTHR * 4096) accv += *(const unsigned*)(a.ws + off);
        for (size_t off = ((size_t)xg * NTHR + F.tid) * 4096; off < (size_t)NB * S * D * 4; off += (size_t)32 * NTHR * 4096) accv += *(const unsigned*)((const unsigned char*)a.out + off) + *(const unsigned*)((const unsigned char*)a.in[0] + off);
        asm volatile("" :: "v"(accv));
    }
#endif
    if (blockIdx.x == 0) {
        float* rope = (float*)(a.ws + WS_ROPE);
        for (int i = F.tid; i < 64 * 16; i += NTHR) { const int pos = i >> 4, j = i & 15; const float inv = powf(10000.f, -(float)j / 16.f), ang = (float)pos * inv; rope[2 * i] = cosf(ang); rope[2 * i + 1] = sinf(ang); }
    } else if (blockIdx.x < 33) {
        bf16* W2 = (bf16*)(a.ws + WS_WG2); const float* wq = a.in[11]; const float* wk = a.in[12]; const float* wv = a.in[13]; const float* wg = a.in[14];
        for (int i = (blockIdx.x - 1) * NTHR + F.tid; i < 32 * 4096; i += 32 * NTHR) { const int n = i >> 12, k = i & 4095; float s = 0.f;
            if (k < 2048) { const int gq = k >> 2, ii = k & 3;
#pragma unroll
                for (int j = 0; j < 4; ++j) s += wq[(gq * 4 + ii) * 4 + j] * wg[(size_t)(gq * 4 + j) * 32 + n] + wk[(gq * 4 + ii) * 4 + j] * wg[(size_t)(2048 + gq * 4 + j) * 32 + n]; }
            else { const int kk = k - 2048, gq = kk >> 2, ii = kk & 3;
#pragma unroll
                for (int j = 0; j < 4; ++j) s += wv[(gq * 4 + ii) * 4 + j] * wg[(size_t)(4096 + gq * 4 + j) * 32 + n]; }
            W2[i] = (bf16)f2bf(s); }
    }
}
__device__ __forceinline__ void prologue2_phase(Frame& F0, const Args& a) {
    Frame F = fresh(F0);
    const float* part = (const float*)(a.ws + WS_QG); const float* b_ada = a.in[6]; float* mod = (float*)(a.ws + WS_MOD);
    for (int o = blockIdx.x * NTHR + F.tid; o < 4 * 17 * 3072; o += F.G * NTHR) {
        const int l = o / (17 * 3072), rn = o % (17 * 3072), n = rn % 3072;
        const float* pp = part + (size_t)l * 64 * 17 * 3072 + rn; float s0 = 0.f, s1 = 0.f, s2 = 0.f, s3 = 0.f;
#pragma unroll
        for (int sl = 0; sl < 64; sl += 16) { float v[16];
#pragma unroll
            for (int j = 0; j < 16; ++j) v[j] = pp[(size_t)(sl + j) * 17 * 3072];
#pragma unroll
            for (int j = 0; j < 16; j += 4) { s0 += v[j]; s1 += v[j + 1]; s2 += v[j + 2]; s3 += v[j + 3]; } }
        mod[o] = ((s0 + s1) + (s2 + s3)) + b_ada[l * 3072 + n];
    }
}
}
namespace att {
using mk::bf16; using mk::bf16x8; using mk::s16x4; using mk::f32x16; using mk::u32x4; using mk::u32x2;
typedef short v4i16_t __attribute__((ext_vector_type(4)));
typedef float f32x2_t __attribute__((ext_vector_type(2))); typedef __bf16 bf16x2_t __attribute__((ext_vector_type(2)));
__device__ __forceinline__ int crow(int r, int hi) { return (r & 3) + 8 * (r >> 2) + 4 * hi; }
__device__ __forceinline__ unsigned cvtpk(float lo, float hi) { f32x2_t v = {lo, hi}; bf16x2_t b = __builtin_convertvector(v, bf16x2_t); return __builtin_bit_cast(unsigned, b); }
__device__ __forceinline__ s16x4 vtr(LAS const unsigned char* p) { return __builtin_bit_cast(s16x4, __builtin_amdgcn_ds_read_tr16_b64_v4i16((LAS v4i16_t*)p)); }
__device__ __forceinline__ float ex2(float x) { return __builtin_amdgcn_exp2f(x); }
__device__ __forceinline__ float max3f(float a, float b, float c) { float r; asm("v_max3_f32 %0, %1, %2, %3" : "=v"(r) : "v"(a), "v"(b), "v"(c)); return r; }
#define ATT_SB() __builtin_amdgcn_sched_barrier(0)

struct Src { const bf16* K[2]; const bf16* V; int ldk, ldv; };

template <int DV, int NCOMP> struct Stage { u32x4 kr[NCOMP]; u32x4 vr[DV / 64]; };
template <int DV, int NCOMP>
__device__ __forceinline__ void stage_load(Stage<DV, NCOMP>& st, const Src& s, size_t row, int wid, int lane) {
#pragma unroll
    for (int c = 0; c < NCOMP; ++c) st.kr[c] = *(const u32x4*)(s.K[c] + (row + lane) * s.ldk + wid * 8);
#pragma unroll
    for (int i = 0; i < DV / 64; ++i) { const int p = wid + 8 * i, d0 = p >> 2, kg = p & 3; st.vr[i] = *(const u32x4*)(s.V + (row + 16 * kg + (lane >> 2)) * s.ldv + d0 * 32 + (lane & 3) * 8); }
}
template <int DV, int NCOMP>
__device__ __forceinline__ void stage_store(const Stage<DV, NCOMP>& st, LAS unsigned char* buf, int wid, int lane) {
#pragma unroll
    for (int c = 0; c < NCOMP; ++c) *(LAS u32x4*)(buf + c * 8192 + wid * 1024 + lane * 16) = st.kr[c];
#pragma unroll
    for (int i = 0; i < DV / 64; ++i) *(LAS u32x4*)(buf + NCOMP * 8192 + (wid + 8 * i) * 1024 + lane * 16) = st.vr[i];
}
__device__ __forceinline__ void glds16(const void* gsrc, unsigned lds_dst) { unsigned keep;
    asm volatile("s_mov_b32 %0, m0\n\ts_mov_b32 m0, %2\n\ts_nop 0\n\tglobal_load_lds_dwordx4 %1, off\n\ts_mov_b32 m0, %0" : "=&s"(keep) : "v"(gsrc), "s"(lds_dst) : "memory"); }
__device__ __forceinline__ unsigned long long uni64(const void* p) { const unsigned long long a = (unsigned long long)p;
    return ((unsigned long long)(unsigned)__builtin_amdgcn_readfirstlane((unsigned)(a >> 32)) << 32) | (unsigned)__builtin_amdgcn_readfirstlane((unsigned)a); }
__device__ __forceinline__ void glds16s(const void* sbase_, unsigned voff, unsigned lds_dst) { unsigned keep; const unsigned long long sbase = uni64(sbase_);
    asm volatile("s_mov_b32 %0, m0\n\ts_mov_b32 m0, %3\n\ts_nop 0\n\tglobal_load_lds_dwordx4 %1, %2\n\ts_mov_b32 m0, %0" : "=&s"(keep) : "v"(voff), "s"(sbase), "s"(lds_dst) : "memory"); }
template <int DV, int NCOMP>
__device__ __forceinline__ void dma_issue(const Src& s, size_t row, LAS unsigned char* buf, int wid, int lane) {
    const unsigned b0 = (unsigned)(size_t)buf;
    const unsigned ko = (unsigned)(lane * s.ldk + wid * 8) * 2u, vo = (unsigned)((16 * (wid & 3) + (lane >> 2)) * s.ldv + (lane & 3) * 8) * 2u;
#pragma unroll
    for (int c = 0; c < NCOMP; ++c) glds16s(s.K[c] + row * s.ldk, ko, (unsigned)__builtin_amdgcn_readfirstlane(b0 + c * 8192 + wid * 1024));
#pragma unroll
    for (int i = 0; i < DV / 64; ++i) { const int p = wid + 8 * i, d0 = p >> 2;
        glds16s(s.V + row * s.ldv + d0 * 32, vo, (unsigned)__builtin_amdgcn_readfirstlane(b0 + NCOMP * 8192 + p * 1024)); }
}
#define ATT_WAIT_BAR(N) asm volatile("s_waitcnt vmcnt(" #N ") lgkmcnt(0)\n\ts_barrier" ::: "memory")
template <int NL> __device__ __forceinline__ void wait_bar_keep() { if constexpr (NL == 2) ATT_WAIT_BAR(2); else if constexpr (NL == 4) ATT_WAIT_BAR(4); else static_assert(NL == 2 || NL == 4, "pieces per wave"); }
__device__ __forceinline__ void qk_tile(LAS const unsigned char* kimg, const bf16x8 (&qf)[4], int r32, int hi, f32x16& p0, f32x16& p1, const f32x16& z, const f32x16& z1  ) {
    LAS const unsigned char* kb = kimg + hi * 1024 + r32 * 16;
#define ATT_KRD(i) (*(LAS const bf16x8*)(kb + ((i) >> 1) * 2048 + ((i) & 1) * 512))
    bf16x8 f0 = ATT_KRD(0), f1 = ATT_KRD(1), f2;
    f2 = ATT_KRD(2); ATT_SB(); p0 = __builtin_amdgcn_mfma_f32_32x32x16_bf16(f0, qf[0], z, 0, 0, 0);
    f0 = ATT_KRD(3); ATT_SB(); p1 = __builtin_amdgcn_mfma_f32_32x32x16_bf16(f1, qf[0], z1, 0, 0, 0);
    f1 = ATT_KRD(4); ATT_SB(); p0 = __builtin_amdgcn_mfma_f32_32x32x16_bf16(f2, qf[1], p0, 0, 0, 0);
    f2 = ATT_KRD(5); ATT_SB(); p1 = __builtin_amdgcn_mfma_f32_32x32x16_bf16(f0, qf[1], p1, 0, 0, 0);
    f0 = ATT_KRD(6); ATT_SB(); p0 = __builtin_amdgcn_mfma_f32_32x32x16_bf16(f1, qf[2], p0, 0, 0, 0);
    f1 = ATT_KRD(7); ATT_SB(); p1 = __builtin_amdgcn_mfma_f32_32x32x16_bf16(f2, qf[2], p1, 0, 0, 0);
    ATT_SB(); p0 = __builtin_amdgcn_mfma_f32_32x32x16_bf16(f0, qf[3], p0, 0, 0, 0);
    ATT_SB(); p1 = __builtin_amdgcn_mfma_f32_32x32x16_bf16(f1, qf[3], p1, 0, 0, 0);
#undef ATT_KRD
}
template <int DV>
__device__ __forceinline__ void softmax_tile(f32x16& p0, f32x16& p1, f32x16 (&o)[DV / 32], float& m, float& l, u32x4 (&pw)[4]) {
    float mxa = max3f(p0[0], p0[1], p1[0]), mxb = max3f(p0[2], p0[3], p1[1]); mxa = max3f(mxa, p1[2], p1[3]);
#pragma unroll
    for (int r = 4; r < 16; r += 4) { mxa = max3f(mxa, p0[r], p0[r + 1]); mxb = max3f(mxb, p0[r + 2], p0[r + 3]); mxa = max3f(mxa, p1[r], p1[r + 1]); mxb = max3f(mxb, p1[r + 2], p1[r + 3]); }
    const float mx0 = max3f(mxa, mxb, mxb);
    const float mn = max3f(m, mx0, __shfl_xor(mx0, 32)), alpha = ex2(m - mn);
    float ls = 0.f;
#pragma unroll
    for (int r = 0; r < 16; ++r) { p0[r] = ex2(p0[r] - mn); p1[r] = ex2(p1[r] - mn); ls += p0[r] + p1[r]; }
    l = l * alpha + ls;
    if (__any(mn != m)) {
#pragma unroll
        for (int d0 = 0; d0 < DV / 32; ++d0)
#pragma unroll
            for (int r = 0; r < 16; ++r) o[d0][r] *= alpha;
    }
    m = mn;
#pragma unroll
    for (int ks = 0; ks < 4; ++ks) { const int b = 8 * (ks & 1);
        if (ks < 2) { pw[ks].x = cvtpk(p0[b], p0[b + 1]); pw[ks].y = cvtpk(p0[b + 2], p0[b + 3]); pw[ks].z = cvtpk(p0[b + 4], p0[b + 5]); pw[ks].w = cvtpk(p0[b + 6], p0[b + 7]); }
        else { pw[ks].x = cvtpk(p1[b], p1[b + 1]); pw[ks].y = cvtpk(p1[b + 2], p1[b + 3]); pw[ks].z = cvtpk(p1[b + 4], p1[b + 5]); pw[ks].w = cvtpk(p1[b + 6], p1[b + 7]); } }
}
template <int DV>
__device__ __forceinline__ void pv_tile(LAS const unsigned char* vimg, int lane, int hi, const u32x4 (&pw)[4], f32x16 (&o)[DV / 32]) {
    LAS const unsigned char* vb = vimg + ((lane >> 4) & 1) * 32 + (lane & 3) * 8 + (4 * hi + ((lane & 15) >> 2)) * 64;
    constexpr int ND = DV / 32, NF = 4 * ND;
    constexpr int PD = 4, NB_ = PD + 1;
    s16x4 lo[NB_], hi4[NB_];
#define ATT_VRD(i, b) do { lo[b] = vtr(vb + ((i) % ND) * 4096 + ((i) / ND) * 1024); hi4[b] = vtr(vb + ((i) % ND) * 4096 + ((i) / ND) * 1024 + 512); } while (0)
#pragma unroll
    for (int i = 0; i < PD; ++i) ATT_VRD(i, i);
#pragma unroll
    for (int i = 0; i < NF; ++i) {
        if (i + PD < NF) ATT_VRD(i + PD, (i + PD) % NB_);
        ATT_SB();
        const int b = i % NB_;
        const bf16x8 vf = {lo[b][0], lo[b][1], lo[b][2], lo[b][3], hi4[b][0], hi4[b][1], hi4[b][2], hi4[b][3]};
        o[i % ND] = __builtin_amdgcn_mfma_f32_32x32x16_bf16(vf, __builtin_bit_cast(bf16x8, pw[i / ND]), o[i % ND], 0, 0, 0);
    }
#undef ATT_VRD
}

struct SmState { float mxa, mxb, mn, alpha, ls, delta; bool resc; };
template <int NM>
__device__ __forceinline__ void negm_shift(f32x16 (&negm)[NM], float delta) {
#pragma unroll
    for (int i = 0; i < NM; ++i)
#pragma unroll
        for (int r = 0; r < 16; ++r) negm[i][r] -= delta;
}
__device__ __forceinline__ float xmax32(float v) { auto rr = __builtin_amdgcn_permlane32_swap(__float_as_uint(v), __float_as_uint(v), false, false); return max3f(__uint_as_float(rr[0]), __uint_as_float(rr[1]), v); }
template <int SK> __device__ __forceinline__ constexpr bool sm_live0(int r) { return SK != 2 || r >= 12; }
template <int SK> __device__ __forceinline__ constexpr bool sm_live1(int r) { return SK != 1 || r < 4; }
template <int SK = 0>
__device__ __forceinline__ void sm_slice(int k, f32x16& p0, f32x16& p1, float& m, float& l, SmState& s, u32x4 (&pwn)[4]) {
    if (k <= 3) { const int r = 4 * k;
        if (SK == 0 && k == 0) { s.mxa = max3f(p0[0], p0[1], p1[0]); s.mxb = max3f(p0[2], p0[3], p1[1]); s.mxa = max3f(s.mxa, p1[2], p1[3]); }
        else { if (k == 0) { s.mxa = -INFINITY; s.mxb = -INFINITY; }
            if (sm_live0<SK>(r)) { s.mxa = max3f(s.mxa, p0[r], p0[r + 1]); s.mxb = max3f(s.mxb, p0[r + 2], p0[r + 3]); }
            if (sm_live1<SK>(r)) { s.mxa = max3f(s.mxa, p1[r], p1[r + 1]); s.mxb = max3f(s.mxb, p1[r + 2], p1[r + 3]); } }
        asm volatile("" : "+v"(s.mxa), "+v"(s.mxb)); }
    else if (k == 4) { const float mx0 = xmax32(max3f(s.mxa, s.mxb, s.mxb)); const bool first = m == -INFINITY;
        const float delta = (first || mx0 > 8.f) ? mx0 : 0.f; s.delta = delta; s.mn = first ? mx0 : m + delta; s.alpha = ex2(-delta); s.resc = __any(delta != 0.f); l *= s.alpha; s.ls = 0.f;
        if (s.resc) {
#pragma unroll
            for (int r = 0; r < 16; ++r) { p0[r] -= delta; p1[r] -= delta; }
        }
        asm volatile("" : "+v"(s.mn), "+v"(s.alpha), "+v"(l)); }
    else if (k <= 12) { const int j = 2 * (k - 5);
        if (sm_live0<SK>(j)) { p0[j] = ex2(p0[j]); p0[j + 1] = ex2(p0[j + 1]); s.ls += p0[j] + p0[j + 1]; }
        if (sm_live1<SK>(j)) { p1[j] = ex2(p1[j]); p1[j + 1] = ex2(p1[j + 1]); s.ls += p1[j] + p1[j + 1]; }
        asm volatile("" : "+v"(p0), "+v"(p1), "+v"(s.ls)); }
    else if (k == 13) {
        if (SK == 2) { pwn[0] = u32x4{0u, 0u, 0u, 0u}; pwn[1].x = 0u; pwn[1].y = 0u; }
        else { pwn[0].x = cvtpk(p0[0], p0[1]); pwn[0].y = cvtpk(p0[2], p0[3]); pwn[0].z = cvtpk(p0[4], p0[5]); pwn[0].w = cvtpk(p0[6], p0[7]); pwn[1].x = cvtpk(p0[8], p0[9]); pwn[1].y = cvtpk(p0[10], p0[11]); }
        pwn[1].z = cvtpk(p0[12], p0[13]); pwn[1].w = cvtpk(p0[14], p0[15]); asm volatile("" : "+v"(pwn[0]), "+v"(pwn[1])); }
    else if (k == 14) { pwn[2].x = cvtpk(p1[0], p1[1]); pwn[2].y = cvtpk(p1[2], p1[3]);
        if (SK == 1) { pwn[2].z = 0u; pwn[2].w = 0u; pwn[3] = u32x4{0u, 0u, 0u, 0u}; }
        else { pwn[2].z = cvtpk(p1[4], p1[5]); pwn[2].w = cvtpk(p1[6], p1[7]); pwn[3].x = cvtpk(p1[8], p1[9]); pwn[3].y = cvtpk(p1[10], p1[11]); pwn[3].z = cvtpk(p1[12], p1[13]); pwn[3].w = cvtpk(p1[14], p1[15]); }
        asm volatile("" : "+v"(pwn[2]), "+v"(pwn[3])); }
    else { l += s.ls; asm volatile("" : "+v"(l)); }
}
template <int DV, int NM, int SK = 0>
__device__ __forceinline__ void sm_alone(f32x16& p0, f32x16& p1, f32x16 (&o)[DV / 32], float& m, float& l, u32x4 (&pwn)[4], f32x16 (&negm)[NM]) {
    SmState s;
#pragma unroll
    for (int k = 0; k < 16; ++k) sm_slice<SK>(k, p0, p1, m, l, s, pwn);
    if (s.resc) {
#pragma unroll
        for (int d0 = 0; d0 < DV / 32; ++d0)
#pragma unroll
            for (int r = 0; r < 16; ++r) o[d0][r] *= s.alpha;
        negm_shift<NM>(negm, s.delta);
    }
    m = s.mn;
}
template <int DV, int NM, int SK = 0>
__device__ __forceinline__ void pv_sm_tile(LAS const unsigned char* vimg, int lane, int hi, const u32x4 (&pw)[4], f32x16 (&o)[DV / 32], f32x16& p0, f32x16& p1, float& m, float& l, u32x4 (&pwn)[4], f32x16 (&negm)[NM]) {
    LAS const unsigned char* vb = vimg + ((lane >> 4) & 1) * 32 + (lane & 3) * 8 + (4 * hi + ((lane & 15) >> 2)) * 64;
    constexpr int ND = DV / 32, NF = 4 * ND, PD = 3, NB_ = PD + 1, SPM = 16 / NF;
    s16x4 lo[NB_], hi4[NB_];
    SmState s;
#define ATT_VRD(i, b) do { lo[b] = vtr(vb + ((i) % ND) * 4096 + ((i) / ND) * 1024); hi4[b] = vtr(vb + ((i) % ND) * 4096 + ((i) / ND) * 1024 + 512); } while (0)
#pragma unroll
    for (int i = 0; i < PD; ++i) ATT_VRD(i, i);
#pragma unroll
    for (int i = 0; i < NF; ++i) {
        if (i + PD < NF) ATT_VRD(i + PD, (i + PD) % NB_);
        ATT_SB();
        const int b = i % NB_;
        const bf16x8 vf = {lo[b][0], lo[b][1], lo[b][2], lo[b][3], hi4[b][0], hi4[b][1], hi4[b][2], hi4[b][3]};
        o[i % ND] = __builtin_amdgcn_mfma_f32_32x32x16_bf16(vf, __builtin_bit_cast(bf16x8, pw[i / ND]), o[i % ND], 0, 0, 0);
#pragma unroll
        for (int k = i * SPM; k < (i + 1) * SPM; ++k) sm_slice<SK>(k, p0, p1, m, l, s, pwn);
        ATT_SB();
    }
#undef ATT_VRD
    if (s.resc) {
#pragma unroll
        for (int d0 = 0; d0 < ND; ++d0)
#pragma unroll
            for (int r = 0; r < 16; ++r) o[d0][r] *= s.alpha;
        negm_shift<NM>(negm, s.delta);
    }
    m = s.mn;
}

__device__ __forceinline__ void wait_bar_tiles2(int c) {
    if (c >= 5) ATT_WAIT_BAR(10); else if (c == 4) ATT_WAIT_BAR(8); else if (c == 3) ATT_WAIT_BAR(6); else if (c == 2) ATT_WAIT_BAR(4); else if (c == 1) ATT_WAIT_BAR(2); else ATT_WAIT_BAR(0);
}
template <int DV, class Pol, int NS = 4>
__device__ __forceinline__ void run_unit1(LAS unsigned char* lds, const Pol& P, const Src& src, const bf16* Q, int ldq, int wid, int lane) {
    const int r32 = lane & 31, hi = lane >> 5;
    constexpr int STG = 8192 + DV * 128, NL = 1 + DV / 64, LA = NS - 2;
    static_assert(NL == 2 && LA <= 6, "wait_bar_tiles2 counts two-piece tiles");
    const int nt = P.ntiles();
#pragma unroll
    for (int t = 0; t < LA; ++t) if (t < nt) dma_issue<DV, 1>(src, P.tile_row(t), lds + t * STG, wid, lane);
    bf16x8 qf[4];
    { const bf16* qp = Q + (size_t)(wid * 32 + r32) * ldq + hi * 8;
#pragma unroll
      for (int d0 = 0; d0 < 4; ++d0) qf[d0] = *(const bf16x8*)(qp + d0 * 16); }
    f32x16 o[DV / 32];
#pragma unroll
    for (int d0 = 0; d0 < DV / 32; ++d0) o[d0] = f32x16{};
    float m = -INFINITY, l = 0.f; f32x16 negm[1] = {f32x16{}};
    u32x4 pw[4], pwn[4]; bool pend = false;
    asm volatile("" : "+v"(qf[0]), "+v"(qf[1]), "+v"(qf[2]), "+v"(qf[3]));
    ATT_WAIT_BAR(0);
    int ic = 0;
    for (int ti = 0; ti < nt; ++ti) {
        LAS unsigned char* cur = lds + ic * STG; LAS unsigned char* prv = lds + ((ic + NS - 1) & (NS - 1)) * STG;
        if (ti + LA < nt) dma_issue<DV, 1>(src, P.tile_row(ti + LA), lds + ((ic + LA) & (NS - 1)) * STG, wid, lane);
        if (P.needs(ti, wid)) {
            f32x16 p0, p1;
            qk_tile(cur, qf, r32, hi, p0, p1, negm[0], negm[0]);
            P.mask(ti, wid, r32, hi, p0, p1);
            if (pend) pv_sm_tile<DV, 1>(prv + 8192, lane, hi, pw, o, p0, p1, m, l, pwn, negm); else sm_alone<DV, 1>(p0, p1, o, m, l, pwn, negm);
#pragma unroll
            for (int k = 0; k < 4; ++k) pw[k] = pwn[k];
            pend = true;
        } else if (pend) { pv_tile<DV>(prv + 8192, lane, hi, pw, o); pend = false; }
        wait_bar_tiles2(min(ti + LA, nt - 1) - (ti + 1));
        ic = (ic + 1) & (NS - 1);
    }
    if (pend) pv_tile<DV>(lds + ((ic + NS - 1) & (NS - 1)) * STG + 8192, lane, hi, pw, o);
    P.finish(o, m, l, wid, r32, hi);
    ATT_WAIT_BAR(0);
}
constexpr int ZQ_Z = 65536, ZQ_Q = 98304;
__device__ __forceinline__ void glds4s(const void* sbase_, unsigned voff, unsigned lds_dst) { unsigned keep; const unsigned long long sbase = uni64(sbase_);
    asm volatile("s_mov_b32 %0, m0\n\ts_mov_b32 m0, %3\n\ts_nop 0\n\tglobal_load_lds_dword %1, %2\n\ts_mov_b32 m0, %0" : "=&s"(keep) : "v"(voff), "s"(sbase), "s"(lds_dst) : "memory"); }
__device__ __forceinline__ void dma_rows64(const bf16* base, int ld, LAS unsigned char* dst, int lane) {
    const unsigned vo = (unsigned)((lane & 31) * ld + (lane >> 5) * 8) * 2u;
    const unsigned b0 = (unsigned)(size_t)dst;
#pragma unroll
    for (int j = 0; j < 4; ++j) glds16s(base + j * 16, vo, (unsigned)__builtin_amdgcn_readfirstlane(b0 + j * 1024));
}
template <class Pol, int SKL  , class Ctx, class Gen>
__device__ __forceinline__ void run_stream1(LAS unsigned char* lds, const Ctx& C, const Gen& gen, int wid_, int lane_) {
    constexpr int DV = 64, STG = 16384, EX = Pol::EXTRA;
    static_assert(EX == 4 || EX == 5, "first-step wait counts");
    int lane = lane_, wid = wid_;
#define ZL_ (lds + ZQ_Z + wid * 4096)
#define QL_ (lds + ZQ_Q + wid * 4096)
    Pol P;
    if (!gen(0, P)) return;
    dma_rows64(P.qrow(C, wid), mk::DI, QL_, lane);
    dma_issue<DV, 1>(P.src(C), P.tile_row(0), lds, wid, lane);
    dma_issue<DV, 1>(P.src(C), P.tile_row(1), lds + STG, wid, lane);
    ATT_WAIT_BAR(0);
    int ic = 0;
    for (int i = 0;; ++i) {
        Pol Pn; const bool hn = gen(i + 1, Pn);
        asm volatile("" : "+v"(lane), "+s"(wid));
        bf16x8 qf[4];
#pragma unroll
        for (int d0 = 0; d0 < 4; ++d0) qf[d0] = *(LAS const bf16x8*)(QL_ + d0 * 1024 + lane * 16);
        asm volatile("" : "+v"(qf[0]), "+v"(qf[1]), "+v"(qf[2]), "+v"(qf[3]));
        const int nt = P.ntiles();
        f32x16 o[2] = {f32x16{}, f32x16{}};
        float m = -INFINITY, l = 0.f; f32x16 negm[Pol::NM];
#pragma unroll
        for (int i_ = 0; i_ < Pol::NM; ++i_) negm[i_] = f32x16{};
        u32x4 pw[4], pwn[4]; bool pend = false;
        auto steps = [&](auto skc, int t0, int t1) {
          constexpr int SK_ = decltype(skc)::value;
          for (int ti = t0; ti < t1; ++ti) {
            LAS unsigned char* cur = lds + ic * STG; LAS unsigned char* prv = lds + ((ic + 3) & 3) * STG; LAS unsigned char* nxt = lds + ((ic + 2) & 3) * STG;
            asm volatile("" : "+v"(lane), "+s"(wid)); const int r32 = lane & 31, hi = lane >> 5;
            if (ti == 0) { P.stage_extra(C, ZL_, wid, lane); if (hn) dma_rows64(Pn.qrow(C, wid), mk::DI, QL_, lane); }
            bool issued = true;
            if (ti + 2 < nt) dma_issue<DV, 1>(P.src(C), P.tile_row(ti + 2), nxt, wid, lane);
            else if (hn) dma_issue<DV, 1>(Pn.src(C), Pn.tile_row(ti + 2 - nt), nxt, wid, lane);
            else issued = false;
            P.prep(ti, wid, r32, hi, negm);
            if (P.needs(ti, wid)) {
                f32x16 p0, p1;
                qk_tile(cur, qf, r32, hi, p0, p1, negm[0], negm[Pol::NM - 1]);
                P.template mask<SK_>(C, ti, wid, r32, hi, p0, p1);
                if (pend) pv_sm_tile<DV, Pol::NM, SK_>(prv + 8192, lane, hi, pw, o, p0, p1, m, l, pwn, negm); else sm_alone<DV, Pol::NM, SK_>(p0, p1, o, m, l, pwn, negm);
#pragma unroll
                for (int k = 0; k < 4; ++k) pw[k] = pwn[k];
                pend = true;
            } else if (pend) { pv_tile<DV>(prv + 8192, lane, hi, pw, o); pend = false; }
            if (ti == 0) { if constexpr (EX == 4) { if (hn) ATT_WAIT_BAR(10); else ATT_WAIT_BAR(6); } else { if (hn) ATT_WAIT_BAR(11); else ATT_WAIT_BAR(7); } }
            else if (issued) ATT_WAIT_BAR(2); else ATT_WAIT_BAR(0);
            ic = (ic + 1) & 3;
          }
        };
        if constexpr (SKL == 0) steps(std::integral_constant<int, 0>{}, 0, nt);
        else { steps(std::integral_constant<int, 0>{}, 0, 4);
            steps(std::integral_constant<int, SKL>{}, 4, nt); }
        asm volatile("" : "+v"(lane), "+s"(wid)); const int r32 = lane & 31, hi = lane >> 5;
        if (pend) pv_tile<DV>(lds + ((ic + 3) & 3) * STG + 8192, lane, hi, pw, o);
        P.finish(C, o, m, l, wid, r32, hi, ZL_);
        if (!hn) break;
        P = Pn;
    }
    ATT_WAIT_BAR(0);
#undef ZL_
#undef QL_
}
}
namespace mk {
using att::Src; using att::crow; using att::ex2;

template <int DV>
__device__ __forceinline__ void store_gated(const f32x16 (&o)[DV / 32], float inv, const bf16* zrow, bf16* grow, int hi) {
#pragma unroll
    for (int d0 = 0; d0 < DV / 32; ++d0)
#pragma unroll
        for (int i = 0; i < 4; ++i) { const int d = 32 * d0 + 8 * i + 4 * hi;
            const u32x2 zw = *(const u32x2*)(zrow + d);
            const float v0 = o[d0][4 * i] * inv * silu(bflo(zw.x)), v1 = o[d0][4 * i + 1] * inv * silu(bfhi(zw.x)), v2 = o[d0][4 * i + 2] * inv * silu(bflo(zw.y)), v3 = o[d0][4 * i + 3] * inv * silu(bfhi(zw.y));
            u32x2 w; w.x = att::cvtpk(v0, v1); w.y = att::cvtpk(v2, v3); *(u32x2*)(grow + d) = w; }
}

__device__ __forceinline__ void store_gated_l(const f32x16 (&o)[2], float inv, LAS const unsigned char* zl, bf16* grow, int r32, int hi) {
#pragma unroll
    for (int d0 = 0; d0 < 2; ++d0)
#pragma unroll
        for (int i = 0; i < 4; ++i) { const int d = 32 * d0 + 8 * i + 4 * hi;
            const u32x2 zw = *(LAS const u32x2*)(zl + (2 * d0 + (i >> 1)) * 1024 + (r32 + 32 * (i & 1)) * 16 + 8 * hi);
            const float v0 = o[d0][4 * i] * inv * silu(bflo(zw.x)), v1 = o[d0][4 * i + 1] * inv * silu(bfhi(zw.x)), v2 = o[d0][4 * i + 2] * inv * silu(bflo(zw.y)), v3 = o[d0][4 * i + 3] * inv * silu(bfhi(zw.y));
            u32x2 w; w.x = att::cvtpk(v0, v1); w.y = att::cvtpk(v2, v3); *(u32x2*)(grow + d) = w; }
}

struct AttCtx { const bf16* QG; const bf16* Kb; const bf16* Vb; const bf16* Zb; const float* aux; LAS const float* tab; int dry; };
struct SwaPol {
    static constexpr int EXTRA = 4, NM = 1;
    int bl, hq, qb, tl0, ntl; float sinkl2;
    __device__ __forceinline__ size_t off() const { return ((size_t)bl * RB + CT + qb * 256) * DI + hq * 64; }
    __device__ __forceinline__ Src src(const AttCtx& C) const { Src s; s.K[0] = C.Kb + (hq >> 3) * 64; s.K[1] = nullptr; s.V = C.Vb + (hq >> 3) * 64; s.ldk = 256; s.ldv = 256; return s; }
    __device__ __forceinline__ void prep(int, int, int, int, f32x16 (&)[1]) const {}
    __device__ __forceinline__ int ntiles() const { return 4 + ntl; }
    __device__ __forceinline__ const bf16* qrow(const AttCtx& C, int wid) const { return C.QG + off() + (size_t)(wid * 32) * DI; }
    __device__ __forceinline__ void stage_extra(const AttCtx& C, LAS unsigned char* zl, int wid, int lane) const { att::dma_rows64(C.Zb + off() + (size_t)(wid * 32) * DI, DI, zl, lane); }
    __device__ __forceinline__ size_t tile_row(int ti) const { return (size_t)bl * RB + (ti < 4 ? 64 * ti : CT + 64 * (tl0 + ti - 4)); }
    __device__ __forceinline__ bool needs(int ti, int wid) const { if (ti < 4) return true; const int kt0 = 64 * (tl0 + ti - 4), qw0 = qb * 256 + 32 * wid; return kt0 <= qw0 + 31 + 128 && kt0 + 63 >= qw0 - 128; }
    __device__ __forceinline__ int skip(int, int) const { return 0; }
    template <int SK> __device__ __forceinline__ void mask(const AttCtx&, int ti, int wid, int r32, int hi, f32x16& p0, f32x16& p1) const {
        if (ti < 4) return;
        const int kt0 = 64 * (tl0 + ti - 4), qw0 = qb * 256 + 32 * wid;
        if (kt0 >= qw0 + 31 - 128 && kt0 + 63 <= qw0 + 128) return;
        const int qt = qw0 + r32;
#pragma unroll
        for (int r = 0; r < 16; ++r) { const int kt = kt0 + crow(r, hi); int d0 = kt - qt; d0 = d0 < 0 ? -d0 : d0; int d1 = kt + 32 - qt; d1 = d1 < 0 ? -d1 : d1;
            if (d0 > 128) p0[r] = -INFINITY; if (d1 > 128) p1[r] = -INFINITY; }
    }
    __device__ __forceinline__ void finish(const AttCtx& C, f32x16 (&o)[2], float m, float l, int wid, int r32, int hi, LAS const unsigned char* zl) const {
        const float mn = fmaxf(m, sinkl2), alpha = ex2(m - mn);
        const float lt = (l + __shfl_xor(l, 32)) * alpha + ex2(sinkl2 - mn);
        const float inv = alpha / lt;
        if (!C.dry) store_gated_l(o, inv, zl, (bf16*)C.QG + off() + (size_t)(wid * 32 + r32) * DI, r32, hi);
    }
};
__device__ __forceinline__ void swa_phase(Frame& F, const Args& a, int g, int dry) {
    int lane_ = pg8::hw_lane(), wave_ = F.wave; asm volatile("" : "+v"(lane_), "+s"(wave_));
    AttCtx C; C.QG = (const bf16*)(a.ws + WS_QG) + (size_t)g * MH * DI; C.Kb = (const bf16*)(a.ws + WS_S2); C.Vb = C.Kb + (size_t)MH * 256; C.Zb = (const bf16*)(a.ws + WS_S4); C.aux = a.in[30]; C.tab = nullptr; C.dry = dry;
    const int G = F.G, vcu = F.vcu;
    auto gen = [&](int i, SwaPol& P) -> bool {
        const int id = i * G + vcu; if (id >= HB * 32 * 8) return false;
        P.qb = (id + i) & 7; P.hq = (id >> 3) & 31; P.bl = id >> 8;
        P.tl0 = max(0, 4 * P.qb - 2); P.ntl = min(31, 4 * P.qb + 5) - P.tl0 + 1; P.sinkl2 = C.aux[P.hq] * LOG2E;
        return true; };
    att::run_stream1<SwaPol, 0>(F.lds, C, gen, wave_, lane_);
}

constexpr int NA_TAB_OFF = RING_BYTES + 512;
struct NaPol {
    static constexpr int EXTRA = 5, NM = 2;
    int bl, hq, qb, krow0, ntl, isctx;
    __device__ __forceinline__ size_t off() const { return ((size_t)bl * RB + (isctx ? 0 : CT + qb * 256)) * DI + hq * 64; }
    __device__ __forceinline__ Src src(const AttCtx& C) const { Src s; s.K[0] = C.Kb + hq * 64; s.K[1] = nullptr; s.V = C.Vb + hq * 64; s.ldk = DI; s.ldv = DI; return s; }
    __device__ __forceinline__ void prep(int ti, int wid, int r32, int hi, f32x16 (&negm)[2]) const {
        if (ti != 4) return;
        const int gc = 32 * (wid & 1) + r32, cs = min(max(gc - 8, 0), 48);
#pragma unroll
        for (int r = 0; r < 16; ++r) { const int kc = crow(r, hi);
            if (!(kc >= cs && kc < cs + 16)) negm[0][r] = -INFINITY;
            if (!(kc + 32 >= cs && kc + 32 < cs + 16)) negm[1][r] = -INFINITY; }
    }
    __device__ __forceinline__ int ntiles() const { return 4 + ntl; }
    __device__ __forceinline__ const bf16* qrow(const AttCtx& C, int wid) const { return C.QG + off() + (size_t)(wid * 32) * DI; }
    __device__ __forceinline__ void stage_extra(const AttCtx& C, LAS unsigned char* zl, int wid, int lane) const {
        att::dma_rows64(C.Zb + off() + (size_t)(wid * 32) * DI, DI, zl, lane);
        att::glds4s(C.aux + hq * 465, (unsigned)min(wid * 64 + lane, 464) * 4u, (unsigned)__builtin_amdgcn_readfirstlane((unsigned)(size_t)C.tab + wid * 256));
    }
    __device__ __forceinline__ size_t tile_row(int ti) const { return (size_t)bl * RB + (ti < 4 ? 64 * ti : CT + 64 * (krow0 + ti - 4)); }
    __device__ __forceinline__ bool needs(int ti, int wid) const { if (ti < 4) return true; const int gr = 4 * qb + (wid >> 1), rs = min(max(gr - 4, 0), 24), kr = krow0 + ti - 4; return kr >= rs && kr < rs + 8; }
    __device__ __forceinline__ int skip(int ti, int wid) const { return ti < 4 ? 0 : 1 + (wid & 1); }
    template <int SK> __device__ __forceinline__ void mask(const AttCtx& C, int ti, int wid, int r32, int hi, f32x16& p0, f32x16& p1) const {
        if (ti < 4) return;
        const int gr = 4 * qb + (wid >> 1), gc = 32 * (wid & 1) + r32, kr = krow0 + ti - 4;
        LAS const float* trow = C.tab + (kr - gr + 7) * 31 + 15 - gc;
#pragma unroll
        for (int r = 0; r < 16; ++r) { const int kc = crow(r, hi);
            if (att::sm_live0<SK>(r)) p0[r] = fmaf(trow[kc], LOG2E, p0[r]);
            if (att::sm_live1<SK>(r)) p1[r] = fmaf(trow[kc + 32], LOG2E, p1[r]);
            if ((r & 3) == 3) __builtin_amdgcn_sched_barrier(0); }
    }
    __device__ __forceinline__ void finish(const AttCtx& C, f32x16 (&o)[2], float m, float l, int wid, int r32, int hi, LAS const unsigned char* zl) const {
        const float inv = 1.f / (l + __shfl_xor(l, 32));
        if (!C.dry) store_gated_l(o, inv, zl, (bf16*)C.QG + off() + (size_t)(wid * 32 + r32) * DI, r32, hi);
    }
};
__device__ __forceinline__ void na_phase(Frame& F, const Args& a, int g, int dry) {
    int lane_ = pg8::hw_lane(), wave_ = F.wave; asm volatile("" : "+v"(lane_), "+s"(wave_));
    AttCtx C; C.QG = (const bf16*)(a.ws + WS_QG) + (size_t)g * MH * DI; C.Kb = (const bf16*)(a.ws + WS_S2); C.Vb = (const bf16*)(a.ws + WS_S3); C.Zb = (const bf16*)(a.ws + WS_S4); C.aux = a.in[27]; C.tab = (LAS const float*)(F.lds + NA_TAB_OFF); C.dry = dry;
    constexpr int NLAT = HB * 32 * 8, NCTX = HB * 32;
    const int G = F.G, vcu = F.vcu;
    auto gen = [&](int i, NaPol& P) -> bool {
        const int id = i * G + vcu; if (id >= NLAT + NCTX) return false;
        if (id < NLAT) { P.isctx = 0; P.qb = (id + i) & 7; P.hq = (id >> 3) & 31; P.bl = id >> 8; P.krow0 = min(max(4 * P.qb - 4, 0), 24); P.ntl = min(max(4 * P.qb + 3 - 4, 0), 24) + 7 - P.krow0 + 1; }
        else { const int j = id - NLAT; P.isctx = 1; P.qb = 0; P.hq = j & 31; P.bl = j >> 5; P.krow0 = 0; P.ntl = 0; }
        return true; };
    if (wave_ & 1) att::run_stream1<NaPol, 2>(F.lds, C, gen, wave_, lane_); else att::run_stream1<NaPol, 1>(F.lds, C, gen, wave_, lane_);
}

template <int COMP>
__device__ __forceinline__ void diff_unit(LAS unsigned char* lds, const Src& src, const bf16* Q  , const bf16* zb, bf16* gb, size_t trow0, int nt, float lam, float lam_init, const float* sg, int wid, int lane, int dry) {
    const int r32 = lane & 31, hi = lane >> 5, wq = wid & 3; constexpr int comp = COMP;
    constexpr int STG = 32768;
    att::dma_issue<128, 2>(src, trow0, lds, wid, lane);
    if (nt > 1) att::dma_issue<128, 2>(src, trow0 + 64, lds + STG, wid, lane);
    bf16x8 qf[4];
    { const bf16* qp = Q + (size_t)(wq * 32 + r32) * DI + comp * 64 + hi * 8;
#pragma unroll
      for (int d0 = 0; d0 < 4; ++d0) qf[d0] = *(const bf16x8*)(qp + d0 * 16); }
    f32x16 o[4];
#pragma unroll
    for (int d0 = 0; d0 < 4; ++d0) o[d0] = f32x16{};
    float m = -INFINITY, l = 0.f; f32x16 negm[1] = {f32x16{}};
    u32x4 pw[4], pwn[4];
    asm volatile("" : "+v"(qf[0]), "+v"(qf[1]), "+v"(qf[2]), "+v"(qf[3]));
    ATT_WAIT_BAR(0);
    if constexpr (COMP == 0) {
        int ic = 0;
        for (int ti = 0; ti < nt; ++ti) {
            LAS unsigned char* cur = lds + ic * STG; LAS unsigned char* prv = lds + ((ic + 3) & 3) * STG;
            if (ti >= 1 && ti + 1 < nt) att::dma_issue<128, 2>(src, trow0 + 64 * (ti + 1), lds + ((ic + 1) & 3) * STG, wid, lane);
            { f32x16 p0, p1; att::qk_tile(cur, qf, r32, hi, p0, p1, negm[0], negm[0]);
              if (ti > 0) att::pv_sm_tile<128, 1>(prv + 16384, lane, hi, pw, o, p0, p1, m, l, pwn, negm); else att::sm_alone<128, 1>(p0, p1, o, m, l, pwn, negm); }
#pragma unroll
            for (int k = 0; k < 4; ++k) pw[k] = pwn[k];
            ATT_WAIT_BAR(0);
            ic = (ic + 1) & 3;
        }
        att::pv_tile<128>(lds + ((ic + 3) & 3) * STG + 16384, lane, hi, pw, o);
    } else {
        f32x16 p0, p1;
        att::qk_tile(lds + 8192, qf, r32, hi, p0, p1, negm[0], negm[0]);
        ATT_WAIT_BAR(0);
        int ic = 1;
        for (int ti = 1; ti < nt; ++ti) {
            LAS unsigned char* cur = lds + ic * STG; LAS unsigned char* pv2 = lds + ((ic + 2) & 3) * STG;
            if (ti + 1 < nt) att::dma_issue<128, 2>(src, trow0 + 64 * (ti + 1), lds + ((ic + 1) & 3) * STG, wid, lane);
            if (ti >= 2) att::pv_sm_tile<128, 1>(pv2 + 16384, lane, hi, pw, o, p0, p1, m, l, pwn, negm); else att::sm_alone<128, 1>(p0, p1, o, m, l, pwn, negm);
#pragma unroll
            for (int k = 0; k < 4; ++k) pw[k] = pwn[k];
            att::qk_tile(cur + 8192, qf, r32, hi, p0, p1, negm[0], negm[0]);
            ATT_WAIT_BAR(0);
            ic = (ic + 1) & 3;
        }
        if (nt >= 2) att::pv_sm_tile<128, 1>(lds + ((ic + 2) & 3) * STG + 16384, lane, hi, pw, o, p0, p1, m, l, pwn, negm); else att::sm_alone<128, 1>(p0, p1, o, m, l, pwn, negm);
#pragma unroll
        for (int k = 0; k < 4; ++k) pw[k] = pwn[k];
        att::pv_tile<128>(lds + ((ic + 3) & 3) * STG + 16384, lane, hi, pw, o);
    }
    ATT_WAIT_BAR(0);
    const float inv = 1.f / (l + __shfl_xor(l, 32));
    LAS float* xb = (LAS float*)lds;
    if (comp == 1) {
#pragma unroll
        for (int d0 = 0; d0 < 4; ++d0)
#pragma unroll
            for (int r = 0; r < 16; ++r) xb[((wq * 64 + d0 * 16 + r) * 64) + lane] = o[d0][r] * inv;
    }
    __syncthreads();
    if (comp == 0 && !dry) {
        float ss = 0.f;
#pragma unroll
        for (int d0 = 0; d0 < 4; ++d0)
#pragma unroll
            for (int r = 0; r < 16; ++r) { const float v = o[d0][r] * inv - lam * xb[((wq * 64 + d0 * 16 + r) * 64) + lane]; o[d0][r] = v; ss += v * v; }
        ss += __shfl_xor(ss, 32);
        const float rs = rsqrtf(ss * (1.f / 128.f) + EPS) * (1.f - lam_init);
        const size_t ro = (size_t)(wq * 32 + r32) * DI;
#pragma unroll
        for (int d0 = 0; d0 < 4; ++d0)
#pragma unroll
            for (int i = 0; i < 4; ++i) { const int d = 32 * d0 + 8 * i + 4 * hi; const f32x4 gg = *(const f32x4*)(sg + d); const u32x2 zw = *(const u32x2*)(zb + ro + d);
                const float v0 = o[d0][4 * i] * rs * gg.x * silu(bflo(zw.x)), v1 = o[d0][4 * i + 1] * rs * gg.y * silu(bfhi(zw.x)), v2 = o[d0][4 * i + 2] * rs * gg.z * silu(bflo(zw.y)), v3 = o[d0][4 * i + 3] * rs * gg.w * silu(bfhi(zw.y));
                u32x2 w; w.x = att::cvtpk(v0, v1); w.y = att::cvtpk(v2, v3); *(u32x2*)(gb + ro + d) = w; }
    }
    asm volatile("s_waitcnt lgkmcnt(0)\n\ts_barrier" ::: "memory");
}
__device__ __forceinline__ void diff_phase(Frame& F, const Args& a, int g, int dry) {
#ifdef MK_TOUCH2
    {
        const int j = F.vcu & 31; unsigned accv = 0u;
        for (size_t off = ((size_t)j * NTHR + F.wave * 64 + pg8::hw_lane()) * 4096; off < (size_t)216 * MiB; off += (size_t)32 * NTHR * 4096) accv += *(const unsigned*)(a.ws + WS_S2 + off);
        for (size_t off = ((size_t)j * NTHR + F.wave * 64 + pg8::hw_lane()) * 4096; off < (size_t)72 * MiB; off += (size_t)32 * NTHR * 4096) accv += *(const unsigned*)(a.ws + WS_QG + (size_t)g * MH * DI * 2 + off);
        asm volatile("" :: "v"(accv));
    }
#endif
    int lane_ = pg8::hw_lane(), wave_ = F.wave; asm volatile("" : "+v"(lane_), "+s"(wave_));
    const bf16* QG = (const bf16*)(a.ws + WS_QG) + (size_t)g * MH * DI; const bf16* Kb = (const bf16*)(a.ws + WS_S2); const bf16* Vb = (const bf16*)(a.ws + WS_S3); const bf16* Zb = (const bf16*)(a.ws + WS_S4);
    const float lam_init = 0.8f - 0.6f * expf(-0.3f);
    float sa = 0.f, sb = 0.f;
    for (int i = 0; i < 64; ++i) { sa += a.in[20][i] * a.in[21][i]; sb += a.in[22][i] * a.in[23][i]; }
    const float lam = expf(sa) - expf(sb) + lam_init;
    constexpr int NLAT = HB * 16 * 16, NCTX = HB * 16 * 2;
    const int G = F.G, vcu = F.vcu; LAS unsigned char* lds = F.lds; const float* sg = a.in[24];
    auto units = [&](auto cc) {
        constexpr int COMP = decltype(cc)::value;
        for (int i = 0;; ++i) {
            const int id = i * G + vcu; if (id >= NLAT + NCTX) break;
            int bl, h, qb, nt; size_t row0;
            if (id < NLAT) { qb = id & 15; h = (id >> 4) & 15; bl = id >> 8; nt = RB / 64; row0 = (size_t)bl * RB + CT + qb * 128; }
            else { const int j = id - NLAT; qb = j & 1; h = (j >> 1) & 15; bl = j >> 5; nt = CT / 64; row0 = (size_t)bl * RB + qb * 128; }
            Src s; s.K[0] = Kb + (2 * h) * 64; s.K[1] = Kb + (2 * h + 1) * 64; s.V = Vb + h * 128; s.ldk = DI; s.ldv = DI;
            diff_unit<COMP>(lds, s, QG + row0 * DI + h * 128, Zb + row0 * DI + h * 128, (bf16*)QG + row0 * DI + h * 128, (size_t)bl * RB, nt, lam, lam_init, sg, wave_, lane_, dry);
        }
    };
    if (wave_ >> 2) units(std::integral_constant<int, 1>{}); else units(std::integral_constant<int, 0>{});
}
}
namespace mk {
typedef float f32x4v __attribute__((ext_vector_type(4)));
__device__ __forceinline__ void seq_bounds(int row, int& lo, int& hi) { const int rr = row % RB, b0 = row - rr; if (rr < CT) { lo = b0; hi = b0 + CT; } else { lo = b0 + CT; hi = b0 + RB; } }

#ifndef MK_GATES_Q
#define MK_GATES_Q 4
#endif
__device__ __forceinline__ void mlstm_gates_phase(Frame& F, const Args& a, int g) {
    int lane = pg8::hw_lane(), wave = F.wave; asm volatile("" : "+v"(lane), "+s"(wave));
    const bf16* XM = (const bf16*)(a.ws + WS_S2); const bf16* W2 = (const bf16*)(a.ws + WS_WG2);
    bf16* XC = g == 0 ? (bf16*)(a.ws + WS_QG) + (size_t)MH * DI : (bf16*)(a.ws + WS_H);
    const float* cw = a.in[9]; const float* cb = a.in[10]; const float* bg = a.in[15];
    LAS float* T = (LAS float*)F.lds;
    { const int tid = wave * 64 + lane;
      for (int i = tid; i < 5 * 2048 / 4; i += NTHR) *(LAS f32x4v*)(T + 4 * i) = *(const f32x4v*)(cw + 4 * i);
      for (int i = tid; i < 2048 / 4; i += NTHR) *(LAS f32x4v*)(T + 10240 + 4 * i) = *(const f32x4v*)(cb + 4 * i);
      __syncthreads(); }
    const int r = lane & 15, kq = lane >> 4;
    constexpr int GQ = MK_GATES_Q;
    const int gw = F.vcu * NWAVES + wave, NGW = F.G * NWAVES;
    for (int item = gw; item < 4 * (MH / 16); item += NGW) {
        const int grp = item >> 2, kh = item & 3;
        float* gates = (float*)(a.ws + (kh == 0 ? WS_GATES : kh == 1 ? WS_GATES2 : kh == 2 ? WS_GATES3 : WS_GATES4));
        const int row = grp * 16 + r; int lo, hi; seq_bounds(row, lo, hi);
        pg8::f32x4 acc0 = {0.f, 0.f, 0.f, 0.f}, acc1 = {0.f, 0.f, 0.f, 0.f};
        for (int sb = 0; sb < 16 / GQ; ++sb) {
            u32x4 xr[GQ][5];
#pragma unroll
            for (int q = 0; q < GQ; ++q) { const int c0 = kh * 512 + (sb * GQ + q) * 32 + 8 * kq;
#pragma unroll
                for (int j = 0; j < 5; ++j) { const int tt = row + j - 2; xr[q][j] = (tt >= lo && tt < hi) ? *(const u32x4*)(XM + (size_t)tt * DI + c0) : (u32x4){0u, 0u, 0u, 0u}; }
            }
#pragma unroll
            for (int q = 0; q < GQ; ++q) { const int c0 = kh * 512 + (sb * GQ + q) * 32 + 8 * kq;
                const bf16x8 wf0 = *(const bf16x8*)(W2 + (size_t)r * 4096 + c0), wf1 = *(const bf16x8*)(W2 + (size_t)(r + 16) * 4096 + c0), wf2 = *(const bf16x8*)(W2 + (size_t)r * 4096 + 2048 + c0), wf3 = *(const bf16x8*)(W2 + (size_t)(r + 16) * 4096 + 2048 + c0);
                const f32x4v b0 = *(LAS const f32x4v*)(T + 10240 + c0), b1 = *(LAS const f32x4v*)(T + 10240 + c0 + 4);
                float av[8] = {b0.x, b0.y, b0.z, b0.w, b1.x, b1.y, b1.z, b1.w};
#pragma unroll
                for (int j = 0; j < 5; ++j) { const u32x4 x = xr[q][j];
                    const f32x4v w0 = *(LAS const f32x4v*)(T + j * DI + c0), w1 = *(LAS const f32x4v*)(T + j * DI + c0 + 4);
                    av[0] += bflo(x.x) * w0.x; av[1] += bfhi(x.x) * w0.y; av[2] += bflo(x.y) * w0.z; av[3] += bfhi(x.y) * w0.w;
                    av[4] += bflo(x.z) * w1.x; av[5] += bfhi(x.z) * w1.y; av[6] += bflo(x.w) * w1.z; av[7] += bfhi(x.w) * w1.w; }
                u32x4 xcw; xcw.x = att::cvtpk(silu(av[0]), silu(av[1])); xcw.y = att::cvtpk(silu(av[2]), silu(av[3])); xcw.z = att::cvtpk(silu(av[4]), silu(av[5])); xcw.w = att::cvtpk(silu(av[6]), silu(av[7]));
                *(u32x4*)(XC + (size_t)row * DI + c0) = xcw;
                const bf16x8 axc = __builtin_bit_cast(bf16x8, xcw), axm = __builtin_bit_cast(bf16x8, xr[q][2]);
                acc0 = __builtin_amdgcn_mfma_f32_16x16x32_bf16(axc, wf0, acc0, 0, 0, 0); acc1 = __builtin_amdgcn_mfma_f32_16x16x32_bf16(axc, wf1, acc1, 0, 0, 0);
                acc0 = __builtin_amdgcn_mfma_f32_16x16x32_bf16(axm, wf2, acc0, 0, 0, 0); acc1 = __builtin_amdgcn_mfma_f32_16x16x32_bf16(axm, wf3, acc1, 0, 0, 0); }
        }
        const float bg0 = kh == 0 ? bg[r] : 0.f, bg1 = kh == 0 ? bg[16 + r] : 0.f;
#pragma unroll
        for (int rg = 0; rg < 4; ++rg) { const size_t tk = (size_t)grp * 16 + 4 * kq + rg; gates[tk * 32 + r] = acc0[rg] + bg0; gates[tk * 32 + 16 + r] = acc1[rg] + bg1; }
    }
    __syncthreads();
}

#define ML_BAR() asm volatile("s_waitcnt lgkmcnt(0)\n\ts_barrier" ::: "memory")
#ifndef MK_SC_A
#define MK_SC_A 1
#endif
#ifndef MK_SC_B
#define MK_SC_B 1
#endif
constexpr int ML_QS = 0, ML_KS = 33792, ML_VS = 67584, ML_P = 84992, ML_HO = 94208, ML_F = 110592;
constexpr int ML_W1 = RING_BYTES + 512  , ML_WV = 115200  ;
constexpr int ML_KSTR = 528, ML_VSTR = 272, ML_PSTR = 144;
__device__ __forceinline__ int ml_row(int base, int dir, int s) { return base + (dir == 0 ? s : (s < CT ? CT - 1 - s : CT + (S - 1) - (s - CT))); }
__device__ __forceinline__ s16x4 ml_tr(LAS const unsigned char* p) { return __builtin_bit_cast(s16x4, __builtin_amdgcn_ds_read_tr16_b64_v4i16((LAS att::v4i16_t*)p)); }
__device__ __forceinline__ void mlstm_scan_phase(Frame& F, const Args& a, int g) {
    int tid0 = F.wave * 64 + pg8::hw_lane(); asm volatile("" : "+v"(tid0));
    const int wid = __builtin_amdgcn_readfirstlane(tid0 >> 6);
    const int u = F.vcu; if (u >= HB * 8 * 2 * 2) return;
    const int dvh = u & 1, dir = (u >> 1) & 1, h = (u >> 2) & 7, bl = u >> 5;
    const bf16* XM = (const bf16*)(a.ws + WS_S2); const float* gates = (const float*)(a.ws + WS_GATES); const float* gates2 = (const float*)(a.ws + WS_GATES2); const float* gates3 = (const float*)(a.ws + WS_GATES3); const float* gates4 = (const float*)(a.ws + WS_GATES4);
    const bf16* XC = g == 0 ? (const bf16*)(a.ws + WS_QG) + (size_t)MH * DI : (const bf16*)(a.ws + WS_H);
    bf16* Hd = dir == 0 ? (bf16*)(a.ws + WS_QG) + (size_t)g * MH * DI : (bf16*)(a.ws + WS_S4);
    const float* cw = a.in[9]; const float* cb = a.in[10]; const float* wq = a.in[11]; const float* wk = a.in[12]; const float* wv = a.in[13];
    LAS unsigned char* L = F.lds; LAS float* Ff = (LAS float*)(L + ML_F);
    pg8::f32x4 C[16];
#pragma unroll
    for (int i = 0; i < 16; ++i) C[i] = (pg8::f32x4){0.f, 0.f, 0.f, 0.f};
    int tid = tid0;
    if (tid < 256) { Ff[640 + tid] = 0.f; }
    {
        LAS float* W1 = (LAS float*)(L + ML_W1); LAS float* WV = (LAS float*)(L + ML_WV);
        for (int i = tid; i < 5 * 256; i += NTHR) W1[i] = cw[(i >> 8) * DI + h * 256 + (i & 255)];
        if (tid < 256) W1[1280 + tid] = cb[h * 256 + tid];
        for (int i = tid; i < 1024; i += NTHR) { W1[1536 + i] = wq[h * 1024 + i]; W1[2560 + i] = wk[h * 1024 + i]; WV[i] = wv[h * 1024 + i]; }
        __syncthreads();
    }
    LAS const float* W1 = (LAS const float*)(L + ML_W1); LAS const float* WV = (LAS const float*)(L + ML_WV);
    bf16x8 aq[2], ak[2], av_[2], aql[2], akl[2], avl[2];
    { const int o = tid0 & 15, g4 = (tid0 >> 4) & 3;
#pragma unroll
      for (int n = 0; n < 2; ++n) { const int bo = 4 * n + (o >> 2); u32x4 fq, fk, fv, lq, lk, lv; unsigned* pq = (unsigned*)&fq; unsigned* pk_ = (unsigned*)&fk; unsigned* pv_ = (unsigned*)&fv; unsigned* qq_ = (unsigned*)&lq; unsigned* qk_ = (unsigned*)&lk; unsigned* qv_ = (unsigned*)&lv;
#pragma unroll
          for (int jp = 0; jp < 4; ++jp) { float q2[2], k2[2], v2[2], q2l[2], k2l[2], v2l[2];
#pragma unroll
              for (int e = 0; e < 2; ++e) { const int j = 2 * jp + e, bi = 2 * g4 + (j >> 2); const bool nz = bi == bo; const int gb = wid * 8 + bo, idx = gb * 16 + (j & 3) * 4 + (o & 3);
                  q2[e] = nz ? W1[1536 + idx] : 0.f; k2[e] = nz ? W1[2560 + idx] * 0.0625f : 0.f; v2[e] = nz ? WV[idx] : 0.f;
                  q2l[e] = q2[e] - bf2f((unsigned short)f2bf(q2[e])); k2l[e] = k2[e] - bf2f((unsigned short)f2bf(k2[e])); v2l[e] = v2[e] - bf2f((unsigned short)f2bf(v2[e])); }
              pq[jp] = pk2(q2[0], q2[1]); pk_[jp] = pk2(k2[0], k2[1]); pv_[jp] = pk2(v2[0], v2[1]);
              qq_[jp] = pk2(q2l[0], q2l[1]); qk_[jp] = pk2(k2l[0], k2l[1]); qv_[jp] = pk2(v2l[0], v2l[1]); }
          aq[n] = __builtin_bit_cast(bf16x8, fq); ak[n] = __builtin_bit_cast(bf16x8, fk); av_[n] = __builtin_bit_cast(bf16x8, fv);
          aql[n] = __builtin_bit_cast(bf16x8, lq); akl[n] = __builtin_bit_cast(bf16x8, lk); avl[n] = __builtin_bit_cast(bf16x8, lv); } }
    const int base = bl * RB;
    u32x4 xw[8];
#define ML_LOADX(cc) do { const int rlo_ = dir ? ml_row(base, 1, (cc) * 64 + 63) : ml_row(base, 0, (cc) * 64); \
        const size_t o_ = (size_t)(rlo_ + (tid0 & 15)) * DI + h * 256 + wid * 32 + ((tid0 >> 4) & 3) * 8; \
        _Pragma("unroll") for (int i_ = 0; i_ < 4; ++i_) { xw[i_] = *(const u32x4*)(XM + o_ + (size_t)(16 * i_) * DI); xw[4 + i_] = *(const u32x4*)(XC + o_ + (size_t)(16 * i_) * DI); } } while (0)
    float gpre[8] = {0.f, 0.f, 0.f, 0.f, 0.f, 0.f, 0.f, 0.f};
#define ML_LOADG(cc) do { if (wid == 0) { const size_t gi_ = (size_t)ml_row(base, dir, (cc) * 64 + (tid0 & 63)) * 32 + (2 * dir) * 8 + h; \
        gpre[0] = gates[gi_]; gpre[1] = gates2[gi_]; gpre[2] = gates3[gi_]; gpre[3] = gates4[gi_]; gpre[4] = gates[gi_ + 8]; gpre[5] = gates2[gi_ + 8]; gpre[6] = gates3[gi_ + 8]; gpre[7] = gates4[gi_ + 8]; } } while (0)
    ML_LOADX(0); ML_LOADG(0);
    for (int c = 0; c < RB / 64; ++c) {
        const int par = c & 1;
        tid = tid0; asm volatile("" : "+v"(tid));
        const int lane = tid & 63, l15 = lane & 15, gq = lane >> 4;
#pragma unroll 1
        for (int repA_ = 0; repA_ < MK_SC_A; ++repA_) {
        {
            const bool hasv = (wid >> 2) == dvh;
            const pg8::f32x4 z4 = {0.f, 0.f, 0.f, 0.f};
#pragma unroll
            for (int tt = 0; tt < 4; ++tt) {
                const bf16x8 bxm = __builtin_bit_cast(bf16x8, xw[tt]), bxc = __builtin_bit_cast(bf16x8, xw[4 + tt]);
                const int mrow = 16 * tt + l15, t = dir ? 63 - mrow : mrow;
#pragma unroll
                for (int n = 0; n < 2; ++n) {
                    const pg8::f32x4 dq = __builtin_amdgcn_mfma_f32_16x16x32_bf16(aq[n], bxc, __builtin_amdgcn_mfma_f32_16x16x32_bf16(aql[n], bxc, z4, 0, 0, 0), 0, 0, 0), dk = __builtin_amdgcn_mfma_f32_16x16x32_bf16(ak[n], bxc, __builtin_amdgcn_mfma_f32_16x16x32_bf16(akl[n], bxc, z4, 0, 0, 0), 0, 0, 0);
                    const int cl = wid * 32 + 16 * n + 4 * gq;
                    u32x2 w2; w2.x = att::cvtpk(dq[0], dq[1]); w2.y = att::cvtpk(dq[2], dq[3]); *(LAS u32x2*)(L + ML_QS + t * ML_KSTR + cl * 2) = w2;
                    w2.x = att::cvtpk(dk[0], dk[1]); w2.y = att::cvtpk(dk[2], dk[3]); *(LAS u32x2*)(L + ML_KS + t * ML_KSTR + cl * 2) = w2;
                    if (hasv) { const pg8::f32x4 dv = __builtin_amdgcn_mfma_f32_16x16x32_bf16(av_[n], bxm, __builtin_amdgcn_mfma_f32_16x16x32_bf16(avl[n], bxm, z4, 0, 0, 0), 0, 0, 0);
                        w2.x = att::cvtpk(dv[0], dv[1]); w2.y = att::cvtpk(dv[2], dv[3]); *(LAS u32x2*)(L + ML_VS + t * ML_VSTR + (cl & 127) * 2) = w2; }
                }
            }
        }
#if defined(MK_SC_G2)
        for (int repg_ = 0; repg_ < 2; ++repg_)
#endif
        if (wid == 0) {
            const float gi = (gpre[0] + gpre[1]) + (gpre[2] + gpre[3]), gf = (gpre[4] + gpre[5]) + (gpre[6] + gpre[7]);
            const float lf = fminf(gf, 0.f) - log1pf(__expf(-fabsf(gf)));
            float b = lf;
#pragma unroll
            for (int o = 1; o < 64; o <<= 1) { const float y = __shfl_up(b, o); if (lane >= o) b += y; }
            const float bend = __shfl(b, 63);
            Ff[lane] = b * LOG2E; Ff[64 + lane] = (gi - b) * LOG2E; Ff[128 + lane] = __expf(b); Ff[192 + lane] = __expf(bend - b + gi);
            if (lane == 0) Ff[576] = __expf(bend);
        }
        }
        ML_BAR();
#if defined(MK_SC_L2)
        if (c + 1 < RB / 64) { ML_LOADX(c + 1); ML_LOADG(c + 1); asm volatile("" : "+v"(xw[0]), "+v"(xw[1]), "+v"(xw[2]), "+v"(xw[3]), "+v"(xw[4]), "+v"(xw[5]), "+v"(xw[6]), "+v"(xw[7])); }
#endif
        if (c + 1 < RB / 64) { ML_LOADX(c + 1); ML_LOADG(c + 1); }
        for (int repB_ = 0; repB_ < MK_SC_B; ++repB_) {
        {
            const int si = wid >> 1;
            pg8::f32x4 st[2] = {{0.f, 0.f, 0.f, 0.f}, {0.f, 0.f, 0.f, 0.f}};
            LAS const unsigned char* kp = L + ML_KS + (16 * si + l15) * ML_KSTR + gq * 16;
            LAS const unsigned char* qp0 = L + ML_QS + (16 * (2 * (wid & 1)) + l15) * ML_KSTR + gq * 16;
#pragma unroll
            for (int ks = 0; ks < 8; ++ks) {
                const bf16x8 ka = *(LAS const bf16x8*)(kp + ks * 64);
                const bf16x8 q0 = *(LAS const bf16x8*)(qp0 + ks * 64), q1 = *(LAS const bf16x8*)(qp0 + 16 * ML_KSTR + ks * 64);
                st[0] = __builtin_amdgcn_mfma_f32_16x16x32_bf16(ka, q0, st[0], 0, 0, 0);
                st[1] = __builtin_amdgcn_mfma_f32_16x16x32_bf16(ka, q1, st[1], 0, 0, 0);
            }
            const f32x4v al = *(LAS const f32x4v*)(Ff + 64 + 16 * si + 4 * gq);
            const float alv[4] = {al.x, al.y, al.z, al.w};
#pragma unroll
            for (int e = 0; e < 2; ++e) {
                const int ti = 2 * (wid & 1) + e, t = 16 * ti + l15; const float bt = Ff[t];
                float pv[4], rsum = 0.f;
#pragma unroll
                for (int r = 0; r < 4; ++r) { const int s = 16 * si + 4 * gq + r; const float wgt = (s <= t) ? att::ex2(bt + alv[r]) : 0.f; pv[r] = st[e][r] * wgt; rsum += pv[r]; }
                u32x2 w2; w2.x = att::cvtpk(pv[0], pv[1]); w2.y = att::cvtpk(pv[2], pv[3]);
                *(LAS u32x2*)(L + ML_P + t * ML_PSTR + (16 * si + 4 * gq) * 2) = w2;
                rsum += __shfl_xor(rsum, 16); rsum += __shfl_xor(rsum, 32);
                if (gq == 0) Ff[320 + si * 64 + t] = rsum;
            }
        }
        {
            const int t = tid >> 3, part = tid & 7; LAS const float* np_ = Ff + 640 + par * 256 + part * 32; LAS const unsigned char* qrow = L + ML_QS + t * ML_KSTR + part * 64;
            float acc = 0.f;
#pragma unroll
            for (int i = 0; i < 4; ++i) { const u32x4 qw = *(LAS const u32x4*)(qrow + i * 16); const f32x4v n0 = *(LAS const f32x4v*)(np_ + i * 8), n1 = *(LAS const f32x4v*)(np_ + i * 8 + 4);
                acc += bflo(qw.x) * n0.x + bfhi(qw.x) * n0.y + bflo(qw.y) * n0.z + bfhi(qw.y) * n0.w + bflo(qw.z) * n1.x + bfhi(qw.z) * n1.y + bflo(qw.w) * n1.z + bfhi(qw.w) * n1.w; }
            acc += __shfl_xor(acc, 1); acc += __shfl_xor(acc, 2); acc += __shfl_xor(acc, 4);
            if (part == 0) Ff[256 + t] = acc * Ff[128 + t];
        }
        if (tid < 256) {
            float nn = Ff[576] * Ff[640 + par * 256 + tid];
#pragma unroll
            for (int s = 0; s < 64; s += 4) { const f32x4v w4 = *(LAS const f32x4v*)(Ff + 192 + s); LAS const unsigned char* kc = L + ML_KS + s * ML_KSTR + tid * 2;
                nn += (w4.x * bf2f(*(LAS const unsigned short*)kc) + w4.y * bf2f(*(LAS const unsigned short*)(kc + ML_KSTR))) + (w4.z * bf2f(*(LAS const unsigned short*)(kc + 2 * ML_KSTR)) + w4.w * bf2f(*(LAS const unsigned short*)(kc + 3 * ML_KSTR))); }
            Ff[640 + (par ^ 1) * 256 + tid] = nn;
        }
        }
        ML_BAR();
        {
            pg8::f32x4 y[4];
#if defined(MK_SC_SYNC)
            ML_BAR(); __syncthreads(); __syncthreads();
#endif
#if defined(MK_SC_QC2)
            for (int repq_ = 0; repq_ < 2; ++repq_)
#endif
            {
#pragma unroll
            for (int tt = 0; tt < 4; ++tt) y[tt] = (pg8::f32x4){0.f, 0.f, 0.f, 0.f};
            {
                u32x2 qa[2][4], qb[2][4];
#define ML_QRD(ks_, b_) do { _Pragma("unroll") for (int tt = 0; tt < 4; ++tt) { LAS const unsigned char* qp = L + ML_QS + (16 * tt + l15) * ML_KSTR + (32 * (ks_) + 4 * gq) * 2; qa[b_][tt] = *(LAS const u32x2*)qp; qb[b_][tt] = *(LAS const u32x2*)(qp + 32); } } while (0)
                ML_QRD(0, 0);
#pragma unroll
                for (int ks = 0; ks < 8; ++ks) {
                    if (ks + 1 < 8) ML_QRD(ks + 1, (ks + 1) & 1);
                    u32x4 cw4; cw4.x = att::cvtpk(C[2 * ks][0], C[2 * ks][1]); cw4.y = att::cvtpk(C[2 * ks][2], C[2 * ks][3]); cw4.z = att::cvtpk(C[2 * ks + 1][0], C[2 * ks + 1][1]); cw4.w = att::cvtpk(C[2 * ks + 1][2], C[2 * ks + 1][3]);
                    const bf16x8 cf = __builtin_bit_cast(bf16x8, cw4);
                    __builtin_amdgcn_sched_barrier(0);
#pragma unroll
                    for (int tt = 0; tt < 4; ++tt) { const u32x4 qq = {qa[ks & 1][tt].x, qa[ks & 1][tt].y, qb[ks & 1][tt].x, qb[ks & 1][tt].y};
                        y[tt] = __builtin_amdgcn_mfma_f32_16x16x32_bf16(__builtin_bit_cast(bf16x8, qq), cf, y[tt], 0, 0, 0); }
                    __builtin_amdgcn_sched_barrier(0);
                }
#undef ML_QRD
            }
            }
#pragma unroll
            for (int tt = 0; tt < 4; ++tt) { const f32x4v e4 = *(LAS const f32x4v*)(Ff + 128 + 16 * tt + 4 * gq); y[tt][0] *= e4.x; y[tt][1] *= e4.y; y[tt][2] *= e4.z; y[tt][3] *= e4.w; }
            bf16x8 vf[2];
            { LAS const unsigned char* vb = L + ML_VS + (8 * gq + (l15 >> 2)) * ML_VSTR + (16 * wid + 4 * (lane & 3)) * 2;
#pragma unroll
              for (int k2 = 0; k2 < 2; ++k2) { const s16x4 lo = ml_tr(vb + k2 * 32 * ML_VSTR), hi4 = ml_tr(vb + k2 * 32 * ML_VSTR + 4 * ML_VSTR); vf[k2] = (bf16x8){lo[0], lo[1], lo[2], lo[3], hi4[0], hi4[1], hi4[2], hi4[3]}; } }
#pragma unroll
            for (int k2 = 0; k2 < 2; ++k2)
#pragma unroll
                for (int tt = 0; tt < 4; ++tt) { const bf16x8 pa = *(LAS const bf16x8*)(L + ML_P + (16 * tt + l15) * ML_PSTR + (32 * k2 + 8 * gq) * 2);
                    y[tt] = __builtin_amdgcn_mfma_f32_16x16x32_bf16(pa, vf[k2], y[tt], 0, 0, 0); }
#pragma unroll
            for (int tt = 0; tt < 4; ++tt)
#pragma unroll
                for (int r = 0; r < 4; ++r) { const int t = 16 * tt + 4 * gq + r;
                    *(LAS unsigned short*)(L + ML_HO + t * 256 + (16 * wid + l15) * 2) = (unsigned short)f2bf(y[tt][r]); }
            const float ebend = Ff[576];
#pragma unroll
            for (int i = 0; i < 16; ++i) C[i] = C[i] * ebend;
            bf16x8 vw[2];
#pragma unroll
            for (int k2 = 0; k2 < 2; ++k2) { const f32x4v w0 = *(LAS const f32x4v*)(Ff + 192 + 32 * k2 + 8 * gq), w1 = *(LAS const f32x4v*)(Ff + 192 + 32 * k2 + 8 * gq + 4);
                const u32x4 vv = __builtin_bit_cast(u32x4, vf[k2]); u32x4 o;
                o.x = att::cvtpk(bflo(vv.x) * w0.x, bfhi(vv.x) * w0.y); o.y = att::cvtpk(bflo(vv.y) * w0.z, bfhi(vv.y) * w0.w); o.z = att::cvtpk(bflo(vv.z) * w1.x, bfhi(vv.z) * w1.y); o.w = att::cvtpk(bflo(vv.w) * w1.z, bfhi(vv.w) * w1.w);
                vw[k2] = __builtin_bit_cast(bf16x8, o); }
            LAS const unsigned char* kb = L + ML_KS + (8 * gq + (l15 >> 2)) * ML_KSTR + (4 * (lane & 3)) * 2;
            {
                s16x4 klo[2][2], khi[2][2];
#define ML_KRD(dt_, b_) do { _Pragma("unroll") for (int k2 = 0; k2 < 2; ++k2) { klo[b_][k2] = ml_tr(kb + k2 * 32 * ML_KSTR + (dt_) * 32); khi[b_][k2] = ml_tr(kb + k2 * 32 * ML_KSTR + 4 * ML_KSTR + (dt_) * 32); } } while (0)
                ML_KRD(0, 0);
#pragma unroll
                for (int dt = 0; dt < 16; ++dt) {
                    if (dt + 1 < 16) ML_KRD(dt + 1, (dt + 1) & 1);
                    __builtin_amdgcn_sched_barrier(0);
#pragma unroll
                    for (int k2 = 0; k2 < 2; ++k2) { const s16x4 lo = klo[dt & 1][k2], hi4 = khi[dt & 1][k2];
                        const bf16x8 ka = {lo[0], lo[1], lo[2], lo[3], hi4[0], hi4[1], hi4[2], hi4[3]};
                        C[dt] = __builtin_amdgcn_mfma_f32_16x16x32_bf16(ka, vw[k2], C[dt], 0, 0, 0); }
                    __builtin_amdgcn_sched_barrier(0);
                }
#undef ML_KRD
            }
        }
        ML_BAR();
#if defined(MK_SC_W2)
        for (int repw_ = 0; repw_ < 2; ++repw_)
#endif
#pragma unroll
        for (int it = 0; it < 2; ++it) { const int idx = tid + it * NTHR, t = idx >> 4, pc = idx & 15; const int row = ml_row(base, dir, c * 64 + t);
            const float den = Ff[256 + t] + (Ff[320 + t] + Ff[384 + t]) + (Ff[448 + t] + Ff[512 + t]);
            const float rd = 1.f / fmaxf(fabsf(den), 1.f);
            const u32x4 yv = *(LAS const u32x4*)(L + ML_HO + t * 256 + pc * 16); u32x4 hv;
            hv.x = att::cvtpk(bflo(yv.x) * rd, bfhi(yv.x) * rd); hv.y = att::cvtpk(bflo(yv.y) * rd, bfhi(yv.y) * rd); hv.z = att::cvtpk(bflo(yv.z) * rd, bfhi(yv.z) * rd); hv.w = att::cvtpk(bflo(yv.w) * rd, bfhi(yv.w) * rd);
            *(u32x4*)(Hd + (size_t)row * DI + h * 256 + dvh * 128 + pc * 8) = hv; }
    }
}

__device__ __forceinline__ void mlstm_out_phase(Frame& F, const Args& a, int g, int dry) {
    int lane = pg8::hw_lane(), wave = F.wave; asm volatile("" : "+v"(lane), "+s"(wave));
    const bf16* XC = g == 0 ? (const bf16*)(a.ws + WS_QG) + (size_t)MH * DI : (const bf16*)(a.ws + WS_H); const bf16* Z = (const bf16*)(a.ws + WS_S3); const bf16* HB2 = (const bf16*)(a.ws + WS_S4); bf16* HF = (bf16*)(a.ws + WS_QG) + (size_t)g * MH * DI;
    const float* ng = a.in[16]; const float* skip = a.in[17];
    const int gw = F.vcu * NWAVES + wave, NGW = F.G * NWAVES;
    for (int it0 = gw; it0 < MH * 8; it0 += 2 * NGW) {
        u32x2 hf[2], hb[2], xcw[2], zw[2]; f32x4v gg[2], sk[2]; size_t o[2];
#pragma unroll
        for (int u = 0; u < 2; ++u) { int it = it0 + u * NGW; if (it >= MH * 8) it = it0; const int row = it >> 3, h = it & 7, ch = h * 256 + lane * 4; o[u] = (size_t)row * DI + ch;
            hf[u] = *(const u32x2*)(HF + o[u]); hb[u] = *(const u32x2*)(HB2 + o[u]); xcw[u] = *(const u32x2*)(XC + o[u]); zw[u] = *(const u32x2*)(Z + o[u]);
            gg[u] = *(const f32x4v*)(ng + ch); sk[u] = *(const f32x4v*)(skip + ch); }
#pragma unroll
        for (int u = 0; u < 2; ++u) {
            const float hs[4] = {bflo(hf[u].x) + bflo(hb[u].x), bfhi(hf[u].x) + bfhi(hb[u].x), bflo(hf[u].y) + bflo(hb[u].y), bfhi(hf[u].y) + bfhi(hb[u].y)};
            const float mu = wave_sum((hs[0] + hs[1]) + (hs[2] + hs[3])) * (1.f / 256.f);
            const float d[4] = {hs[0] - mu, hs[1] - mu, hs[2] - mu, hs[3] - mu};
            const float rstd = rsqrtf(wave_sum((d[0] * d[0] + d[1] * d[1]) + (d[2] * d[2] + d[3] * d[3])) * (1.f / 256.f) + EPS);
            const float xcv[4] = {bflo(xcw[u].x), bfhi(xcw[u].x), bflo(xcw[u].y), bfhi(xcw[u].y)}, z[4] = {bflo(zw[u].x), bfhi(zw[u].x), bflo(zw[u].y), bfhi(zw[u].y)};
            const float ggv[4] = {gg[u].x, gg[u].y, gg[u].z, gg[u].w}, skv[4] = {sk[u].x, sk[u].y, sk[u].z, sk[u].w};
            float ov[4];
#pragma unroll
            for (int i = 0; i < 4; ++i) ov[i] = (d[i] * rstd * ggv[i] + skv[i] * xcv[i]) * silu(z[i]);
            u32x2 w; w.x = att::cvtpk(ov[0], ov[1]); w.y = att::cvtpk(ov[2], ov[3]); if (!dry && (u == 0 || it0 + NGW < MH * 8)) *(u32x2*)(HF + o[u]) = w;
        }
    }
}
}
namespace mk {
enum { P_PRO = 0, P_PRO2 = 1, P_NORM0 = 2, P_L0 = 3  , P_OUT0 = 11, P_NORM1 = 12, P_L1 = 13  , P_OUT1 = 17, P_NORM2 = 18, P_L2 = 19  , P_OUT2 = 23, P_NORM3 = 24, P_L3 = 25  , P_OUT3 = 29, P_FINAL = 30, P_END = 31 };

__global__ void __launch_bounds__(NTHR, 2) mega(Args a) {
    extern __shared__ __attribute__((aligned(16))) unsigned char lds_raw[];
    Frame F;
    F.lds = (LAS unsigned char*)lds_raw;
    F.wave = __builtin_amdgcn_readfirstlane((int)threadIdx.x >> 6); F.lane = pg8::hw_lane(); F.tid = F.wave * 64 + F.lane;
    F.G = gridDim.x; { const int bx = blockIdx.x; F.vcu = (F.G % 8 == 0) ? (bx % 8) * (F.G / 8) + bx / 8 : bx; }
    volatile LAS unsigned* MISC = (volatile LAS unsigned*)(F.lds + MISC_OFF);
    for (int u = F.tid; u < (LDS_BYTES - RING_BYTES) / 4; u += NTHR) ((LAS unsigned*)(F.lds + RING_BYTES))[u] = 0u;
    __syncthreads();
    XcdBarrier bar = xcd_barrier_post((unsigned*)(a.ws + WS_CTL) + CW_BAR, MISC + 8, (unsigned)F.wave);
    const int lo = a.ph_lo, hi = a.ph_hi;
#ifndef MK_REP_GEMM
#define MK_REP_GEMM 1
#endif
#ifndef MK_REP_ATT
#define MK_REP_ATT 1
#endif
#ifndef MK_REP_MISC
#define MK_REP_MISC 1
#endif
#ifndef MK_GEMM_ALIGN
#define MK_GEMM_ALIGN true
#endif
#ifndef MK_GEMM_SP2
#define MK_GEMM_SP2 true
#endif
#ifndef MK_REP_WC
#define MK_REP_WC 1
#endif
#ifndef MK_REP_SYNC
#define MK_REP_SYNC 0
#endif
#ifndef MK_REP_DIFF
#define MK_REP_DIFF MK_REP_ATT
#endif
#ifndef MK_REP_NA
#define MK_REP_NA MK_REP_ATT
#endif
#ifndef MK_REP_SWA
#define MK_REP_SWA MK_REP_ATT
#endif
#ifndef MK_REP_SCAN
#define MK_REP_SCAN 1
#endif
#ifndef MK_REP_GATES
#define MK_REP_GATES MK_REP_SCAN
#endif
#ifndef MK_SITES
#define MK_SITES 0xFFFFFFFFu
#endif
#define ON(b) (((MK_SITES) >> (b)) & 1u)
#ifdef MK_PARTIAL
#define IN(k) (lo <= (k) && (k) < hi)
#else
#define IN(k) true
#endif
#ifndef MK_REP_BAR
#define MK_REP_BAR 1
#endif
#ifdef MK_TP
    long long tp_acc = 0, tp_prev = wall_clock64(), tp_t0 = 0;
#define TP_PRE(k) tp_t0 = wall_clock64();
#define TP_POST(k) { long long n_ = wall_clock64(); if ((MK_TP_MASK >> (k)) & 1u) tp_acc += n_ - (MK_TP == 1 ? tp_t0 : tp_prev); tp_prev = n_; }
#else
#define TP_PRE(k)
#define TP_POST(k)
#endif
#define SEAM(k) do { if (IN(k) && IN((k) + 1)) { TP_PRE(k) for (int rb_ = 0; rb_ < MK_REP_BAR; ++rb_) xcd_barrier(bar); TP_POST(k) } } while (0)
    const int gw = F.vcu * NWAVES + F.wave, NGW = F.G * NWAVES;
#define WSB ([&]() { unsigned char* p_ = a.ws; asm volatile("" : "+s"(p_)); return p_; }())
#define xs (a.out)
#define ctxs ((float*)(WSB + WS_CTXS))
#define xsb ((bf16*)a.out)
#define ctxb ((bf16*)(WSB + WS_CTXS))
#define x3b ((bf16*)(WSB + WS_S3))
#define mod ((const float*)(WSB + WS_MOD))
#define WinA ((bf16*)(WSB + WS_WIN))
#define WoutA ((bf16*)(WSB + WS_WOUT))
#define WinB ((bf16*)(WSB + WS_W2))
#define WoutB ((bf16*)(WSB + WS_W2 + 16 * MiB))
#define H ((bf16*)(WSB + WS_H))
#define QG ((bf16*)(WSB + WS_QG))
#define ssq ((float*)(WSB + WS_SSQ))
#define shw ((const float*)(WSB + WS_SHW))
#define S2 ((bf16*)(WSB + WS_S2))
#define S3 ((bf16*)(WSB + WS_S3))
#define S4 ((bf16*)(WSB + WS_S4))
#define rope ((const float*)(WSB + WS_ROPE))
    const float QSC = 0.125f * LOG2E;

    if (ON(0) && IN(P_PRO)) prologue_phase(F, a);
    SEAM(P_PRO);
    if (ON(0) && IN(P_PRO2)) { prologue2_phase(F, a); for (int rw_ = 0; rw_ < MK_REP_WC; ++rw_) wconv(F, a.in[8], 4096, a.in[18], WinA, WoutA, gw, NGW); }
    SEAM(P_PRO2);
    if (ON(1) && IN(P_NORM0)) { for (int rep = 0; rep < MK_REP_MISC; ++rep) norm_phase(F, a.in[0], a.in[2], a.in[4], mod, H); }
    SEAM(P_NORM0);
#if MK_HAVE_L0
    for (int g = 0; g < 2; ++g) {
        if (ON(2) && IN(P_L0 + 4 * g)) {
            pg8::Gemm gm{H + (size_t)g * MH * D, WinA, MH, 4096, D}; pg8::StaticOrder So; So.init(MH, 4096, F.G, (int)blockIdx.x);
            EpiProj<false> E{S2, S3, S3, S3, DI, DI, DI, DI, 8, 16, 16, 0u, 1.f, rope, nullptr, nullptr, 0};
            for (int rep = 0; rep < MK_REP_GEMM; ++rep) { if (MK_REP_SYNC && rep) xcd_barrier(bar); pg8::gemm_phase<EpiProj<false>, pg8::StaticOrder, MK_GEMM_ALIGN, MK_GEMM_SP2>(F.lds, gm, So, E, F.wave); }
        }
        SEAM(P_L0 + 4 * g);
        if (ON(17) && IN(P_L0 + 4 * g + 1)) for (int rep = 0; rep < MK_REP_GATES; ++rep) mlstm_gates_phase(F, a, g);
        SEAM(P_L0 + 4 * g + 1);
        if (ON(18) && IN(P_L0 + 4 * g + 2)) for (int rep = 0; rep < MK_REP_SCAN; ++rep) mlstm_scan_phase(F, a, g);
        SEAM(P_L0 + 4 * g + 2);
        if (ON(19) && IN(P_L0 + 4 * g + 3)) for (int rep = 0; rep < MK_REP_MISC; ++rep) mlstm_out_phase(F, a, g, rep + 1 < MK_REP_MISC);
        SEAM(P_L0 + 4 * g + 3);
    }
#endif
    constexpr int RHEAD = 128 * 256;
    if (ON(3) && IN(P_OUT0)) {
        pg8::Gemm gm{QG, WoutA, MT, D, DI}; pg8::StaticOrder So; So.init(RHEAD, D, F.G, (int)blockIdx.x);
        for (int rep = 0; rep < MK_REP_GEMM; ++rep) { if (MK_REP_SYNC && rep) xcd_barrier(bar); EpiResidT<float, bf16> E{a.in[0], a.in[2], xsb, ctxb, mod, 1, rep + 1 < MK_REP_GEMM, nullptr, nullptr, nullptr, nullptr};
        pg8::gemm_phase<EpiResidT<float, bf16>, pg8::StaticOrder, MK_GEMM_ALIGN, MK_GEMM_SP2>(F.lds, gm, So, E, F.wave); }
    }
    SEAM(P_OUT0);
    if (ON(3) && IN(P_OUT0)) {
        if (blockIdx.x < 64) { pg8::Gemm gm{QG, WoutA, MT, D, DI}; OutTailOrder So; So.init(F.G, (int)blockIdx.x); EpiResidT<float, bf16> E{a.in[0], a.in[2], xsb, ctxb, mod, 1, 0, nullptr, nullptr, nullptr, nullptr};
            pg8::gemm_phase<EpiResidT<float, bf16>, OutTailOrder, MK_GEMM_ALIGN, MK_GEMM_SP2>(F.lds, gm, So, E, F.wave); }
        else { wconv(F, a.in[19], 8192, a.in[25], WinB, WoutB, ((int)blockIdx.x - 64) * NWAVES + F.wave, (F.G - 64) * NWAVES);
            if (ON(4)) norm_phase(F, xsb, ctxb, a.in[4] + 1024, mod + 17 * 3072, H, 0, RHEAD, 64); }
    }
    SEAM(P_OUT0);
    for (int g = 0; g < 2; ++g) {
        if (ON(5) && IN(P_L1 + 2 * g)) {
            if (g == 0 && ON(4)) norm_phase(F, xsb, ctxb, a.in[4] + 1024, mod + 17 * 3072, H, RHEAD, MT);
            pg8::Gemm gm{H + (size_t)g * MH * D, WinB, MH, 8192, D}; pg8::StaticOrder So; So.init(MH, 8192, F.G, (int)blockIdx.x);
            EpiProj<true, false> E{QG + (size_t)g * MH * DI, S2, S3, S4, DI, DI, DI, DI, 8, 16, 24, 3u, QSC, rope, ssq, shw, g * MH};
#ifdef MK_STAGGER
            if (blockIdx.x >= 128) { const long long t0_ = wall_clock64(); while (wall_clock64() - t0_ < MK_STAGGER) __builtin_amdgcn_s_sleep(8); }
#endif
            for (int rep = 0; rep < MK_REP_GEMM; ++rep) { if (MK_REP_SYNC && rep) xcd_barrier(bar); pg8::gemm_phase<EpiProj<true, false>, pg8::StaticOrder, MK_GEMM_ALIGN, MK_GEMM_SP2>(F.lds, gm, So, E, F.wave); }
        }
        SEAM(P_L1 + 2 * g);
        if (ON(6) && IN(P_L1 + 2 * g + 1)) for (int rep = 0; rep < MK_REP_DIFF; ++rep) { if (MK_REP_SYNC && rep) xcd_barrier(bar); diff_phase(F, a, g, rep + 1 < MK_REP_DIFF); }
        SEAM(P_L1 + 2 * g + 1);
    }
    if (ON(7) && IN(P_OUT1)) {
        pg8::Gemm gm{QG, WoutB, MT, D, DI}; pg8::StaticOrder So; So.init(RHEAD, D, F.G, (int)blockIdx.x);
        for (int rep = 0; rep < MK_REP_GEMM; ++rep) { if (MK_REP_SYNC && rep) xcd_barrier(bar); EpiResidT<bf16, bf16> E{xsb, ctxb, xsb, ctxb, mod + 17 * 3072, 1, rep + 1 < MK_REP_GEMM, nullptr, nullptr, nullptr, nullptr};
        pg8::gemm_phase<EpiResidT<bf16, bf16>, pg8::StaticOrder, MK_GEMM_ALIGN, MK_GEMM_SP2>(F.lds, gm, So, E, F.wave); }
    }
    SEAM(P_OUT1);
    if (ON(7) && IN(P_OUT1)) {
        if (blockIdx.x < 64) { pg8::Gemm gm{QG, WoutB, MT, D, DI}; OutTailOrder So; So.init(F.G, (int)blockIdx.x); EpiResidT<bf16, bf16> E{xsb, ctxb, xsb, ctxb, mod + 17 * 3072, 1, 0, nullptr, nullptr, nullptr, nullptr};
            pg8::gemm_phase<EpiResidT<bf16, bf16>, OutTailOrder, MK_GEMM_ALIGN, MK_GEMM_SP2>(F.lds, gm, So, E, F.wave); }
        else { wconv(F, a.in[26], 8192, a.in[28], WinA, WoutA, ((int)blockIdx.x - 64) * NWAVES + F.wave, (F.G - 64) * NWAVES);
            if (ON(8)) norm_phase(F, xsb, ctxb, a.in[4] + 2048, mod + 2 * 17 * 3072, H, 0, RHEAD, 64); }
    }
    SEAM(P_OUT1);
    for (int g = 0; g < 2; ++g) {
        if (ON(9) && IN(P_L2 + 2 * g)) {
            if (g == 0 && ON(8)) norm_phase(F, xsb, ctxb, a.in[4] + 2048, mod + 2 * 17 * 3072, H, RHEAD, MT);
            pg8::Gemm gm{H + (size_t)g * MH * D, WinA, MH, 8192, D}; pg8::StaticOrder So; So.init(MH, 8192, F.G, (int)blockIdx.x);
            EpiProj<false, false> E{QG + (size_t)g * MH * DI, S2, S3, S4, DI, DI, DI, DI, 8, 16, 24, 0u, QSC, rope, ssq, shw + 17 * 8192, g * MH};
#ifdef MK_STAGGER
            if (blockIdx.x >= 128) { const long long t0_ = wall_clock64(); while (wall_clock64() - t0_ < MK_STAGGER) __builtin_amdgcn_s_sleep(8); }
#endif
            for (int rep = 0; rep < MK_REP_GEMM; ++rep) { if (MK_REP_SYNC && rep) xcd_barrier(bar); pg8::gemm_phase<EpiProj<false, false>, pg8::StaticOrder, MK_GEMM_ALIGN, MK_GEMM_SP2>(F.lds, gm, So, E, F.wave); }
        }
        SEAM(P_L2 + 2 * g);
        if (ON(10) && IN(P_L2 + 2 * g + 1)) for (int rep = 0; rep < MK_REP_NA; ++rep) { if (MK_REP_SYNC && rep) xcd_barrier(bar); na_phase(F, a, g, rep + 1 < MK_REP_NA); }
        SEAM(P_L2 + 2 * g + 1);
    }
    if (ON(11) && IN(P_OUT2)) {
        pg8::Gemm gm{QG, WoutA, MT, D, DI}; pg8::StaticOrder So; So.init(RHEAD, D, F.G, (int)blockIdx.x);
        for (int rep = 0; rep < MK_REP_GEMM; ++rep) { if (MK_REP_SYNC && rep) xcd_barrier(bar); EpiResidT<bf16, bf16> E{xsb, ctxb, x3b, ctxb, mod + 2 * 17 * 3072, 1, rep + 1 < MK_REP_GEMM, nullptr, nullptr, nullptr, nullptr};
        pg8::gemm_phase<EpiResidT<bf16, bf16>, pg8::StaticOrder, MK_GEMM_ALIGN, MK_GEMM_SP2>(F.lds, gm, So, E, F.wave); }
    }
    SEAM(P_OUT2);
    if (ON(11) && IN(P_OUT2)) {
        if (blockIdx.x < 64) { pg8::Gemm gm{QG, WoutA, MT, D, DI}; OutTailOrder So; So.init(F.G, (int)blockIdx.x); EpiResidT<bf16, bf16> E{xsb, ctxb, x3b, ctxb, mod + 2 * 17 * 3072, 1, 0, nullptr, nullptr, nullptr, nullptr};
            pg8::gemm_phase<EpiResidT<bf16, bf16>, OutTailOrder, MK_GEMM_ALIGN, MK_GEMM_SP2>(F.lds, gm, So, E, F.wave); }
        else { wconv(F, a.in[29], 4608, a.in[31], WinB, WoutB, ((int)blockIdx.x - 64) * NWAVES + F.wave, (F.G - 64) * NWAVES);
            if (ON(12)) norm_phase(F, x3b, ctxb, a.in[4] + 3072, mod + 3 * 17 * 3072, H, 0, RHEAD, 64); }
    }
    SEAM(P_OUT2);
    for (int g = 0; g < 2; ++g) {
        if (ON(13) && IN(P_L3 + 2 * g)) {
            if (g == 0 && ON(12)) norm_phase(F, x3b, ctxb, a.in[4] + 3072, mod + 3 * 17 * 3072, H, RHEAD, MT);
            pg8::Gemm gm{H + (size_t)g * MH * D, WinB, MH, 4608, D}; L3Order So; So.init(F.G, (int)blockIdx.x);
            EpiProj<true, false> E{QG + (size_t)g * MH * DI, S2, S2 + (size_t)MH * 256, S4, DI, 256, 256, DI, 8, 9, 10, 3u, QSC, rope, ssq, shw + 2 * 17 * 8192, g * MH};
            for (int rep = 0; rep < MK_REP_GEMM; ++rep) { if (MK_REP_SYNC && rep) xcd_barrier(bar); pg8::gemm_phase<EpiProj<true, false>, L3Order, MK_GEMM_ALIGN, MK_GEMM_SP2>(F.lds, gm, So, E, F.wave); }
        }
        SEAM(P_L3 + 2 * g);
        if (ON(14) && IN(P_L3 + 2 * g + 1)) for (int rep = 0; rep < MK_REP_SWA; ++rep) { if (MK_REP_SYNC && rep) xcd_barrier(bar); swa_phase(F, a, g, rep + 1 < MK_REP_SWA); }
        SEAM(P_L3 + 2 * g + 1);
    }
    if (ON(15) && IN(P_OUT3)) {
        pg8::Gemm gm{QG, WoutB, MT, D, DI}; LatOnlyOrder So; So.init(F.G, (int)blockIdx.x);
        for (int rep = 0; rep < MK_REP_GEMM; ++rep) { if (MK_REP_SYNC && rep) xcd_barrier(bar); EpiResidT<bf16, float> E{x3b, ctxb, xs, ctxs, mod + 3 * 17 * 3072, 0, rep + 1 < MK_REP_GEMM, nullptr, nullptr, nullptr, nullptr};
        pg8::gemm_phase<EpiResidT<bf16, float>, LatOnlyOrder, MK_GEMM_ALIGN, MK_GEMM_SP2>(F.lds, gm, So, E, F.wave); }
    }
    SEAM(P_OUT3);
    if (ON(16) && IN(P_FINAL)) final_norm_phase(F, xs, a.in[7]);
#ifdef MK_TP
    {
        if (MK_TP == 2) TP_POST(P_FINAL)
        unsigned long long* tpw = (unsigned long long*)(a.ws + WS_CTL + 32768);
        if (F.wave == 0 && pg8::hw_lane() == 0) __hip_atomic_fetch_add(tpw, (unsigned long long)tp_acc, __ATOMIC_RELAXED, __HIP_MEMORY_SCOPE_AGENT);
        xcd_barrier(bar);
        const unsigned long long sum = __hip_atomic_load(tpw, __ATOMIC_RELAXED, __HIP_MEMORY_SCOPE_AGENT);
        const long long wait = (long long)(sum / 256) * MK_TP_K, ts = wall_clock64();
        while (wall_clock64() - ts < wait) __builtin_amdgcn_s_sleep(32);
    }
#endif
#undef IN
#undef SEAM
#undef WSB
#undef xs
#undef ctxs
#undef xsb
#undef ctxb
#undef x3b
#undef mod
#undef WinA
#undef WoutA
#undef WinB
#undef WoutB
#undef H
#undef QG
#undef ssq
#undef shw
#undef S2
#undef S3
#undef S4
#undef rope
}

inline void launch_mega(void* const* d_in, void* d_out, void* d_ws, int lo, int hi, hipStream_t stream) {
    static int inited = 0;
    if (!inited) { (void)hipFuncSetAttribute((const void*)mega, hipFuncAttributeMaxDynamicSharedMemorySize, LDS_BYTES); inited = 1; }
    (void)hipMemsetAsync((char*)d_ws + WS_CTL, 0, CTL_BYTES, stream);
    Args a{};
    for (int i = 0; i < 32; ++i) a.in[i] = (const float*)d_in[i];
    a.out = (float*)d_out; a.ws = (unsigned char*)d_ws; a.ph_lo = lo; a.ph_hi = hi;
    hipLaunchKernelGGL(mega, dim3(256), dim3(NTHR), LDS_BYTES, stream, a);
}
}
extern "C" void kernel_launch(void* const* d_in, const int* in_sizes, int n_in, void* d_out, int out_size, void* d_ws, size_t ws_size, hipStream_t stream) {
    mk::launch_mega(d_in, d_out, d_ws, mk::P_PRO, mk::P_END, stream);
}
```

```cpp
#include <hip/hip_runtime.h>
#include <cstdint>
#include <cstdio>
#include <cmath>
#define MK_HAVE_L0 1
namespace pg8 {
#define PG8_LAS __attribute__((address_space(3)))
typedef unsigned short bf16_t;
typedef short bf16x8 __attribute__((ext_vector_type(8)));
typedef float f32x4 __attribute__((ext_vector_type(4)));
typedef unsigned u32x4 __attribute__((ext_vector_type(4)));
__device__ __forceinline__ int hw_lane() { int l; asm volatile("v_mbcnt_lo_u32_b32 %0, -1, 0\n\tv_mbcnt_hi_u32_b32 %0, -1, %0" : "=v"(l)); return l; }
constexpr int BM = 256, BK = 64, HALF = 128, HTB = HALF * BK * 2  , STAGE_BYTES = 8 * HTB, NXCD = 8, WGM = 8;

__host__ __device__ __forceinline__ int lds_byte(int r, int c) { const int st = (r >> 4) * 2 + (c >> 5), rr = r & 15, cc = c & 31, ob = rr * 64 + cc * 2; return st * 1024 + (ob ^ (((ob >> 9) & 1) << 5)); }
__host__ __device__ __forceinline__ void stage_rc(int b, int& R, int& C) { const int st = b / 1024, sb = b % 1024, swz = sb ^ (((sb >> 9) & 1) << 5); R = (st >> 1) * 16 + swz / 64; C = (st & 1) * 32 + (swz % 64) / 2; }
__host__ __device__ __forceinline__ int perm32(int rho) { const int n = rho >> 4, i = rho & 15; return 8 * (i >> 2) + 4 * n + (i & 3); }

struct Unit { int pm, pn; };
struct Gemm { const bf16_t* A; const bf16_t* Bt; int M, N, K; };

struct StaticOrder {
    int nM, nN, nwg, G, c;
    __host__ __device__ void init(int M, int N, int G_, int c_) { nM = M / BM; nN = N / BM; nwg = nM * nN; G = G_; c = c_; }
    __host__ __device__ bool next(int i, Unit& u) const {
        const long L = (long)i * G + c; if (L >= nwg) return false;
        int wgid = (int)L; { const int q = nwg / NXCD, r = nwg % NXCD, xcd = wgid % NXCD, off = wgid / NXCD; wgid = (xcd < r ? xcd * (q + 1) : r * (q + 1) + (xcd - r) * q) + off; }
        const int nig = WGM * nN, gid = wgid / nig, fm = gid * WGM, gsz = (nM - fm) < WGM ? (nM - fm) : WGM;
        u.pm = fm + ((wgid % nig) % gsz); u.pn = (wgid % nig) / gsz; return true;
    }
    __device__ __forceinline__ void a_ready(const Unit&) const {}
    __device__ __forceinline__ void done(const Unit&) const {}
};

__device__ __forceinline__ unsigned cvt_pk_bf16(float lo, float hi) { unsigned r; asm volatile("v_cvt_pk_bf16_f32 %0, %1, %2" : "=v"(r) : "v"(lo), "v"(hi)); return r; }
typedef float f32x2 __attribute__((ext_vector_type(2)));
template <class Epi, class Sched, bool ALIGN_EPI = false, bool SP2 = false>
__device__ __forceinline__ void gemm_phase(PG8_LAS unsigned char* lds, const Gemm g, const Sched& S, const Epi& E, int wave_id) {
    int tid_ = wave_id * 64 + hw_lane(); asm volatile("" : "+v"(tid_));
    const int tid = tid_, wid = __builtin_amdgcn_readfirstlane(tid >> 6), lane = tid & 63, wr = wid >> 2, wc = wid & 3, fr = lane & 15, fq = lane >> 4;
    const int K = g.K, nt = K / BK;
    unsigned voffA[2], voffB[2];
#pragma unroll
    for (int i = 0; i < 2; ++i) { int R, C; stage_rc(tid * 16 + i * 8192, R, C); const int Rb = Epi::PERM ? ((R & ~31) + perm32(R & 31)) : R;
        voffA[i] = (unsigned)(R * K + C) * 2u; voffB[i] = (unsigned)(Rb * K + C) * 2u; }
    const size_t kstep = (size_t)(BK * 2);
    const size_t hstep = (size_t)HALF * K * 2;
    const size_t tstep = 2 * hstep;
    const unsigned ldsw = (unsigned)wid * 1024u;
    const int aoff = lds_byte(wr * 64 + fr, fq * 8), boff = lds_byte(wc * 32 + fr, fq * 8);
#define PG8_SA(b, h) (((b) * 2 + (h)) * HTB)
#define PG8_SB(b, h) ((4 + (b) * 2 + (h)) * HTB)
#define PG8_STAGE(bufoff, gbase, voff) do { _Pragma("unroll") for (int _i = 0; _i < 2; ++_i) \
        __builtin_amdgcn_global_load_lds((const unsigned*)((const char*)(gbase) + (voff)[_i]), (PG8_LAS unsigned*)(lds + (bufoff) + ldsw + _i * 8192), 16, 0, 0); } while (0)
#define PG8_LDA(dst, b, h) do { _Pragma("unroll") for (int m = 0; m < 4; ++m) _Pragma("unroll") for (int k = 0; k < 2; ++k) dst[m][k] = *(const PG8_LAS bf16x8*)(lds + PG8_SA(b, h) + aoff + m * 2048 + k * 1024); } while (0)
#define PG8_LDB(dst, b, h) do { _Pragma("unroll") for (int n = 0; n < 2; ++n) _Pragma("unroll") for (int k = 0; k < 2; ++k) dst[n][k] = *(const PG8_LAS bf16x8*)(lds + PG8_SB(b, h) + boff + n * 2048 + k * 1024); } while (0)
#define PG8_MMA(ai, bj, At, Bt) do { __builtin_amdgcn_s_setprio(1); _Pragma("unroll") for (int m = 0; m < 4; ++m) _Pragma("unroll") for (int n = 0; n < 2; ++n) _Pragma("unroll") for (int k = 0; k < 2; ++k) \
        acc[ai][bj][m][n] = __builtin_amdgcn_mfma_f32_16x16x32_bf16(Bt[n][k], At[m][k], acc[ai][bj][m][n], 0, 0, 0); __builtin_amdgcn_s_setprio(0); } while (0)
#define PG8_WAIT_V(n) asm volatile("s_waitcnt vmcnt(" #n ")" ::: "memory")
#define PG8_WAIT_L(n) asm volatile("s_waitcnt lgkmcnt(" #n ")" ::: "memory")
#define PG8_BAR __builtin_amdgcn_s_barrier()
#define PG8_SCHED __builtin_amdgcn_sched_barrier(0)
    Unit cur, nxt; int ui = 0;
    if (!S.next(0, cur)) return;
    f32x4 acc[2][2][4][2];
#pragma unroll
    for (int a = 0; a < 2; ++a)
#pragma unroll
        for (int b = 0; b < 2; ++b)
#pragma unroll
            for (int m = 0; m < 4; ++m)
#pragma unroll
                for (int n = 0; n < 2; ++n) acc[a][b][m][n] = (f32x4){0.f, 0.f, 0.f, 0.f};
    bf16x8 At[4][2], B0[2][2], B1[2][2];
    const char* cA = (const char*)g.A + (size_t)cur.pm * tstep; const char* cB = (const char*)g.Bt + (size_t)cur.pn * tstep;
    S.a_ready(cur);
    if constexpr (SP2) {
        PG8_STAGE(PG8_SB(0, 0), cB, voffB); PG8_STAGE(PG8_SB(0, 1), cB + hstep, voffB); PG8_STAGE(PG8_SA(0, 0), cA, voffA); PG8_STAGE(PG8_SA(0, 1), cA + hstep, voffA);
        if (wr == 1) PG8_BAR;
        PG8_WAIT_V(2); PG8_BAR;
        PG8_STAGE(PG8_SB(1, 0), cB + kstep, voffB); PG8_STAGE(PG8_SA(1, 0), cA + kstep, voffA); PG8_STAGE(PG8_SB(1, 1), cB + hstep + kstep, voffB);
        PG8_WAIT_V(6); PG8_BAR;
    } else {
        PG8_STAGE(PG8_SB(0, 0), cB, voffB); PG8_STAGE(PG8_SA(0, 0), cA, voffA); PG8_STAGE(PG8_SB(0, 1), cB + hstep, voffB); PG8_STAGE(PG8_SA(0, 1), cA + hstep, voffA);
        if (wr == 1) PG8_BAR;
        PG8_WAIT_V(4); PG8_BAR;
        PG8_STAGE(PG8_SB(1, 0), cB + kstep, voffB); PG8_STAGE(PG8_SA(1, 0), cA + kstep, voffA); PG8_STAGE(PG8_SB(1, 1), cB + hstep + kstep, voffB);
        PG8_WAIT_V(6); PG8_BAR;
    }
    for (;;) {
        const bool has_next = S.next(ui + 1, nxt);
        const char* nA = has_next ? (const char*)g.A + (size_t)nxt.pm * tstep : cA; const char* nB = has_next ? (const char*)g.Bt + (size_t)nxt.pn * tstep : cB;
        for (int t = 0; t < nt; t += 2) {
            const bool last = (t == nt - 2);
            const char* a1 = cA + (size_t)(t + 1) * kstep;
            const char* a2 = last ? nA : cA + (size_t)(t + 2) * kstep; const char* b2 = last ? nB : cB + (size_t)(t + 2) * kstep;
            const char* a3 = a2 + kstep; const char* b3 = b2 + kstep;
            if (last && has_next) S.a_ready(nxt);
            if constexpr (SP2) {
            PG8_LDB(B0, 0, 0); PG8_LDB(B1, 0, 1); PG8_SCHED; PG8_LDA(At, 0, 0); PG8_STAGE(PG8_SA(1, 1), a1 + hstep, voffA);
            PG8_WAIT_V(8); PG8_WAIT_L(0); PG8_BAR; PG8_MMA(0, 0, At, B0); PG8_MMA(0, 1, At, B1); PG8_BAR; PG8_SCHED;
            PG8_LDA(At, 0, 1); PG8_STAGE(PG8_SB(0, 0), b2, voffB); PG8_STAGE(PG8_SB(0, 1), b2 + hstep, voffB); PG8_STAGE(PG8_SA(0, 0), a2, voffA);
            PG8_WAIT_V(8); PG8_WAIT_L(0); PG8_BAR; PG8_MMA(1, 0, At, B0); PG8_MMA(1, 1, At, B1); PG8_BAR; PG8_SCHED;
            PG8_LDB(B0, 1, 0); PG8_LDB(B1, 1, 1); PG8_SCHED; PG8_LDA(At, 1, 0); PG8_STAGE(PG8_SA(0, 1), a2 + hstep, voffA);
            PG8_WAIT_V(8); PG8_WAIT_L(0); PG8_BAR; PG8_MMA(0, 0, At, B0); PG8_MMA(0, 1, At, B1); PG8_BAR; PG8_SCHED;
            PG8_LDA(At, 1, 1); PG8_STAGE(PG8_SB(1, 0), b3, voffB); PG8_STAGE(PG8_SB(1, 1), b3 + hstep, voffB); PG8_STAGE(PG8_SA(1, 0), a3, voffA);
            PG8_WAIT_V(8); PG8_WAIT_L(0); PG8_BAR; PG8_MMA(1, 0, At, B0); PG8_MMA(1, 1, At, B1); PG8_BAR; PG8_SCHED;
            } else {
            PG8_LDB(B0, 0, 0); PG8_SCHED; PG8_LDA(At, 0, 0); PG8_STAGE(PG8_SA(1, 1), a1 + hstep, voffA);
            PG8_WAIT_L(8); PG8_BAR; PG8_WAIT_L(0); PG8_MMA(0, 0, At, B0); PG8_BAR; PG8_SCHED;
            PG8_LDB(B1, 0, 1); PG8_STAGE(PG8_SB(0, 0), b2, voffB);
            PG8_BAR; PG8_WAIT_L(0); PG8_MMA(0, 1, At, B1); PG8_BAR;
            PG8_LDA(At, 0, 1); PG8_STAGE(PG8_SA(0, 0), a2, voffA);
            PG8_BAR; PG8_WAIT_L(0); PG8_MMA(1, 0, At, B0); PG8_BAR; PG8_SCHED;
            PG8_STAGE(PG8_SB(0, 1), b2 + hstep, voffB);
            PG8_WAIT_V(6); PG8_BAR; PG8_MMA(1, 1, At, B1); PG8_BAR;
            PG8_LDB(B0, 1, 0); PG8_SCHED; PG8_LDA(At, 1, 0); PG8_STAGE(PG8_SA(0, 1), a2 + hstep, voffA);
            PG8_WAIT_L(8); PG8_BAR; PG8_WAIT_L(0); PG8_MMA(0, 0, At, B0); PG8_BAR; PG8_SCHED;
            PG8_LDB(B1, 1, 1); PG8_STAGE(PG8_SB(1, 0), b3, voffB);
            PG8_BAR; PG8_WAIT_L(0); PG8_MMA(0, 1, At, B1); PG8_BAR;
            PG8_LDA(At, 1, 1); PG8_STAGE(PG8_SA(1, 0), a3, voffA);
            PG8_BAR; PG8_WAIT_L(0); PG8_MMA(1, 0, At, B0); PG8_BAR; PG8_SCHED;
            PG8_STAGE(PG8_SB(1, 1), b3 + hstep, voffB);
            PG8_WAIT_V(6); PG8_BAR; PG8_MMA(1, 1, At, B1); PG8_BAR;
            }
        }
        if constexpr (ALIGN_EPI) { if (wr == 0) PG8_BAR; }
#if defined(MK_EXP_EPI2)
        if constexpr (!Epi::AFTER_DRAIN && Epi::PERM) { E.template run<(MK_EXP_EPI2 == 2)>(acc, cur, wr, wc, fr, fq); }
#endif
        if constexpr (!Epi::AFTER_DRAIN) { E(acc, cur, wr, wc, fr, fq); S.done(cur); }
        if (!has_next) break;
#pragma unroll
        for (int a = 0; a < 2; ++a)
#pragma unroll
            for (int b = 0; b < 2; ++b)
#pragma unroll
                for (int m = 0; m < 4; ++m)
#pragma unroll
                    for (int n = 0; n < 2; ++n) acc[a][b][m][n] = (f32x4){0.f, 0.f, 0.f, 0.f};
        cur = nxt; cA = nA; cB = nB; ++ui;
        if constexpr (ALIGN_EPI) { if (wr == 1) PG8_BAR; }
    }
    PG8_WAIT_V(0);
    if constexpr (!ALIGN_EPI) { if (wr == 0) PG8_BAR; }
    PG8_BAR;
    if constexpr (Epi::AFTER_DRAIN) { E.fused(acc, cur, wr, wc, fr, fq, lds, wid, lane); S.done(cur); }
#undef PG8_SA
#undef PG8_SB
#undef PG8_STAGE
#undef PG8_LDA
#undef PG8_LDB
#undef PG8_MMA
#undef PG8_WAIT_V
#undef PG8_WAIT_L
#undef PG8_BAR
#undef PG8_SCHED
}
}
#define GAS __attribute__((address_space(1)))
#define LAS __attribute__((address_space(3)))
typedef unsigned short bf16;
typedef unsigned v4u __attribute__((ext_vector_type(4)));
typedef float f32x4 __attribute__((ext_vector_type(4)));
typedef short bf16x8 __attribute__((ext_vector_type(8)));
typedef GAS unsigned gu32;
typedef GAS unsigned long long gu64;
#define RLX_AGENT __ATOMIC_RELAXED, __HIP_MEMORY_SCOPE_AGENT
#define LDS_WAIT() asm volatile("s_waitcnt lgkmcnt(0)" ::: "memory")
#define VM_WAIT() asm volatile("s_waitcnt vmcnt(0)" ::: "memory")
__device__ __forceinline__ unsigned long long rt() { return __builtin_amdgcn_s_memrealtime(); }
__device__ __forceinline__ unsigned f2bf(float f) { unsigned u = __builtin_bit_cast(unsigned, f); return (u + 0x7fffu + ((u >> 16) & 1u)) >> 16; }
__device__ __forceinline__ unsigned pk2(float lo, float hi) { return f2bf(lo) | (f2bf(hi) << 16); }
#define XB_TMO      128
#define XB_XCNT(j)  (256  + 64 * (j))
#define XB_XSUB(j)  (1280 + 64 * (j))
#define XB_XGEN(j)  (2304 + 64 * (j))
#define XB_TOP      3328
#define XB_TOPGEN   3392
#define XCD_BAR_WORDS 3456
#define XB_SPIN_CAP (1u << 18)

__device__ __forceinline__ unsigned xb_ld(unsigned* p)              { return __hip_atomic_load(p, __ATOMIC_RELAXED, __HIP_MEMORY_SCOPE_AGENT); }
__device__ __forceinline__ unsigned xb_add(unsigned* p, unsigned v) { return __hip_atomic_fetch_add(p, v, __ATOMIC_RELAXED, __HIP_MEMORY_SCOPE_AGENT); }
__device__ __forceinline__ unsigned xb_xcc_id() { return (unsigned)__builtin_amdgcn_s_getreg((3 << 11) | 20) & 0xFu; }
#define XB_SPIN(cond, bar) do { unsigned _sp = 0; while (cond) { __builtin_amdgcn_s_sleep(1); \
    if ((++_sp & 255u) == 0u) { if (xb_ld(&(bar)[XB_TMO])) break; if (_sp > XB_SPIN_CAP) { atomicAdd(&(bar)[XB_TMO], 1u); break; } } } } while (0)

struct XcdBarrier {
    unsigned* bar; unsigned x; unsigned w;
    volatile LAS unsigned* st;
};

__device__ __forceinline__ XcdBarrier xcd_barrier_post(unsigned* bar, volatile LAS unsigned* st, unsigned wave) {
    XcdBarrier b; b.bar = bar; b.x = xb_xcc_id(); b.st = st; b.w = wave;
    if (b.w == 0u && pg8::hw_lane() == 0) (void)xb_add(&bar[XB_XCNT(b.x)], 1u);
    return b;
}
__device__ __forceinline__ void xcd_barrier_complete(unsigned* bar, unsigned x, unsigned& nloc, unsigned& nx) {
    const unsigned G = gridDim.x * gridDim.y * gridDim.z;
    unsigned sum, cnt, mine, sp = 0u;
    for (;;) {
        sum = 0u; cnt = 0u; mine = 0u;
#pragma unroll
        for (unsigned j = 0; j < 16; ++j) { const unsigned c = xb_ld(&bar[XB_XCNT(j)]); sum += c; cnt += (c > 0u) ? 1u : 0u; mine = (j == x) ? c : mine; }
        if (sum == G) break;
        __builtin_amdgcn_s_sleep(1);
        if ((++sp & 255u) == 0u) { if (xb_ld(&bar[XB_TMO])) break; if (sp > XB_SPIN_CAP) { atomicAdd(&bar[XB_TMO], 1u); break; } }
    }
    nloc = mine > 0u ? mine : 1u; nx = cnt > 0u ? cnt : 1u;
}

__device__ __forceinline__ void xcd_barrier(const XcdBarrier& b) {
    asm volatile("s_waitcnt vmcnt(0)" ::: "memory");
    __syncthreads();
    if (b.w == 0u && pg8::hw_lane() == 0) {
        unsigned* bar = b.bar;
        __builtin_amdgcn_s_waitcnt(0);
        unsigned nloc = b.st[0], nx = b.st[1];
        if (nloc == 0u) { xcd_barrier_complete(bar, b.x, nloc, nx); b.st[0] = nloc; b.st[1] = nx; }
        const unsigned old = xb_add(&bar[XB_XSUB(b.x)], 1u);
        const unsigned gen = old / nloc;
        if (old + 1u == (gen + 1u) * nloc) {
            __builtin_amdgcn_fence(__ATOMIC_RELEASE, "agent");
            asm volatile("s_waitcnt vmcnt(0)" ::: "memory");
            const unsigned og = xb_add(&bar[XB_TOP], 1u);
            const unsigned tg = og / nx;
            if (og + 1u == (tg + 1u) * nx) xb_add(&bar[XB_TOPGEN], 1u);
            else XB_SPIN(xb_ld(&bar[XB_TOPGEN]) == tg, bar);
            __builtin_amdgcn_fence(__ATOMIC_ACQUIRE, "agent");
            xb_add(&bar[XB_XGEN(b.x)], 1u);
            asm volatile("s_waitcnt vmcnt(0)" ::: "memory");
        } else {
            XB_SPIN(xb_ld(&bar[XB_XGEN(b.x)]) == gen, bar);
            __builtin_amdgcn_fence(__ATOMIC_ACQUIRE, "agent");
            asm volatile("s_waitcnt vmcnt(0)" ::: "memory");
        }
    }
    __syncthreads();
}
namespace mk {
constexpr int NWAVES = 8, NTHR = 512;
constexpr int NB = 16, S = 2048, D = 1024, CT = 256, RB = S + CT  , MT = NB * RB, HB = 8  , MH = HB * RB, DI = 2048;
constexpr float EPS = 1e-6f, LOG2E = 1.4426950408889634f;
constexpr size_t MiB = 1u << 20;
constexpr size_t WS_CTXS = 0, WS_MOD = 16 * MiB, WS_CTL = 17 * MiB, CTL_BYTES = 64 * 1024;
constexpr size_t WS_GATES5 = 480 * MiB, WS_GATES6 = 483 * MiB, WS_GATES7 = 486 * MiB, WS_GATES8 = 489 * MiB;
constexpr size_t WS_ROPE = 18 * MiB, WS_WG2 = 18 * MiB + 64 * 1024, WS_GATES = 19 * MiB;
constexpr size_t WS_WIN = 22 * MiB, WS_WOUT = 38 * MiB, WS_H = 42 * MiB, WS_QG = 114 * MiB, WS_S2 = 258 * MiB, WS_S3 = 330 * MiB, WS_S4 = 402 * MiB, WS_END = 474 * MiB, WS_GATES2 = 474 * MiB  ,
    WS_SSQ = 477 * MiB  , WS_W2 = 480 * MiB  , WS_SHW = 500 * MiB  , WS_GATES3 = 503 * MiB, WS_GATES4 = 506 * MiB  ;
constexpr int CW_BAR = 1024;
constexpr int RING_BYTES = 131072, MISC_OFF = RING_BYTES + 320, LDS_BYTES = 147456;

typedef unsigned short bf16;
typedef float f32x4 __attribute__((ext_vector_type(4)));
typedef float f32x16 __attribute__((ext_vector_type(16)));
typedef short bf16x8 __attribute__((ext_vector_type(8)));
typedef short s16x4 __attribute__((ext_vector_type(4)));
typedef unsigned u32x4 __attribute__((ext_vector_type(4)));
typedef unsigned u32x2 __attribute__((ext_vector_type(2)));

__device__ __forceinline__ float silu(float x) { return x / (1.f + __expf(-x)); }
__device__ __forceinline__ float bf2f(unsigned short b) { return __uint_as_float((unsigned)b << 16); }
__device__ __forceinline__ float bflo(unsigned w) { return __uint_as_float(w << 16); }
__device__ __forceinline__ float bfhi(unsigned w) { return __uint_as_float(w & 0xffff0000u); }
__device__ __forceinline__ float wave_sum(float v) {
#pragma unroll
    for (int o = 1; o < 64; o <<= 1) v += __shfl_xor(v, o);
    return v;
}

struct Frame {
    LAS unsigned char* lds;
    int tid, lane, wave, vcu, G;
    void* const* dummy;
};
__device__ __forceinline__ Frame fresh(const Frame& F0) { Frame F = F0; const int l = pg8::hw_lane(); F.lane = l; F.tid = F0.wave * 64 + l; return F; }
struct Args { const float* in[32]; float* out; unsigned char* ws; int ph_lo, ph_hi; };

template <bool ROPE, bool AFFINE = false> struct EpiProj {
    static constexpr bool PERM = true, AFTER_DRAIN = false;
    bf16 *d0, *d1, *d2, *d3; int l0, l1, l2, l3; int t1, t2, t3; unsigned ropemask; float sc0; const float* rope;
    const float* ssq; const float* shw; int row_base;
    __device__ __forceinline__ void operator()(const pg8::f32x4 (&acc)[2][2][4][2], const pg8::Unit& u, int wr, int wc, int fr, int fq) const { run<false>(acc, u, wr, wc, fr, fq); }
    template <bool NOSTORE> __device__ __forceinline__ void run(const pg8::f32x4 (&acc)[2][2][4][2], const pg8::Unit& u, int wr, int wc, int fr, int fq) const {
        asm volatile("" : "+v"(fr), "+v"(fq));
        const int pn = u.pn;
        long long off = 0; int ld = l0, tb = 0, s = 0;
        if (pn >= t1) { off += (long long)(d1 - d0); ld += l1 - l0; tb = t1; s = 1; }
        if (pn >= t2) { off += (long long)(d2 - d1); ld += l2 - l1; tb = t2; s = 2; }
        if (pn >= t3) { off += (long long)(d3 - d2); ld += l3 - l2; tb = t3; s = 3; }
        bf16* base = d0 + off;
        const float sc = (pn >= t1) ? 1.f : sc0;
        const int rr0 = (u.pm * 256) % RB;
        const bool do_rope = ROPE && ((ropemask >> s) & 1u) && rr0 != 0;
        const int col0 = (pn - tb) * 256 + wc * 32 + 8 * fq;
        const int rloc = wr * 64 + fr;
        pg8::f32x4 sw[2][2];
        if (AFFINE) { const int gr0 = row_base + u.pm * 256; const float* sp = shw + (size_t)(rr0 == 0 ? 16 : gr0 / RB) * 8192 + pn * 256 + wc * 32 + 8 * fq;
#pragma unroll
            for (int bj = 0; bj < 2; ++bj) { sw[bj][0] = *(const pg8::f32x4*)(sp + bj * 128); sw[bj][1] = *(const pg8::f32x4*)(sp + bj * 128 + 4); } }
#pragma unroll
        for (int ai = 0; ai < 2; ++ai)
#pragma unroll
            for (int m = 0; m < 4; ++m) {
                const int rt = rloc + ai * 128 + m * 16;
                bf16* rowp = base + (size_t)(u.pm * 256 + rt) * ld + col0;
                float rstd = 1.f;
                if (AFFINE) { const pg8::f32x4* qp = (const pg8::f32x4*)(ssq + (size_t)(row_base + u.pm * 256 + rt) * 16); const pg8::f32x4 a0 = qp[0], a1 = qp[1], a2 = qp[2], a3 = qp[3];
                    const float tot = ((a0[0] + a0[1]) + (a0[2] + a0[3])) + ((a1[0] + a1[1]) + (a1[2] + a1[3])) + ((a2[0] + a2[1]) + (a2[2] + a2[3])) + ((a3[0] + a3[1]) + (a3[2] + a3[3]));
                    rstd = rsqrtf(tot * (1.f / D) + EPS); }
                f32x4 cs0 = {}, cs1 = {}, cs2 = {}, cs3 = {};
                if (ROPE && do_rope) { const int t = rr0 - CT + rt; const int pos = (wc & 1) ? (t & 63) : (t >> 6); const f32x4* tp = (const f32x4*)(rope + pos * 32 + 16 * (fq & 1));
                    cs0 = tp[0]; cs1 = tp[1]; cs2 = tp[2]; cs3 = tp[3]; }
#pragma unroll
                for (int bj = 0; bj < 2; ++bj) {
                    pg8::f32x4 v0 = acc[ai][bj][m][0], v1 = acc[ai][bj][m][1];
                    if (AFFINE) { v0 = v0 * rstd + sw[bj][0]; v1 = v1 * rstd + sw[bj][1]; }
                    if (ROPE && do_rope) {
                        const float sg = (fq & 2) ? 1.f : -1.f;
                        pg8::f32x4 p0, p1;
#pragma unroll
                        for (int i = 0; i < 4; ++i) { p0[i] = __shfl_xor(v0[i], 32); p1[i] = __shfl_xor(v1[i], 32); }
                        v0[0] = v0[0] * cs0[0] + sg * p0[0] * cs0[1]; v0[1] = v0[1] * cs0[2] + sg * p0[1] * cs0[3];
                        v0[2] = v0[2] * cs1[0] + sg * p0[2] * cs1[1]; v0[3] = v0[3] * cs1[2] + sg * p0[3] * cs1[3];
                        v1[0] = v1[0] * cs2[0] + sg * p1[0] * cs2[1]; v1[1] = v1[1] * cs2[2] + sg * p1[1] * cs2[3];
                        v1[2] = v1[2] * cs3[0] + sg * p1[2] * cs3[1]; v1[3] = v1[3] * cs3[2] + sg * p1[3] * cs3[3];
                    }
                    v0 = v0 * sc; v1 = v1 * sc;
                    pg8::u32x4 w; w.x = pg8::cvt_pk_bf16(v0[0], v0[1]); w.y = pg8::cvt_pk_bf16(v0[2], v0[3]); w.z = pg8::cvt_pk_bf16(v1[0], v1[1]); w.w = pg8::cvt_pk_bf16(v1[2], v1[3]);
                    if (NOSTORE) asm volatile("" :: "v"(w)); else { *(pg8::u32x4*)(rowp + bj * 128) = w;
#ifdef MK_EXP_ST2
                        asm volatile("" ::: "memory"); *(volatile pg8::u32x4*)(rowp + bj * 128) = w;
#endif
                    }
                }
            }
    }
};
__device__ __forceinline__ pg8::f32x4 ld4(const float* p) { return *(const pg8::f32x4*)p; }
__device__ __forceinline__ pg8::f32x4 ld4(const bf16* p) { const u32x2 w = *(const u32x2*)p; pg8::f32x4 v; v[0] = bflo(w.x); v[1] = bfhi(w.x); v[2] = bflo(w.y); v[3] = bfhi(w.y); return v; }
__device__ __forceinline__ void st4(float* p, const pg8::f32x4& v) { *(pg8::f32x4*)p = v; }
__device__ __forceinline__ void st4(bf16* p, const pg8::f32x4& v) { u32x2 w; w.x = pg8::cvt_pk_bf16(v[0], v[1]); w.y = pg8::cvt_pk_bf16(v[2], v[3]); *(u32x2*)p = w; }
template <class BT = float, class OT = float> struct EpiResidT {
    static constexpr bool PERM = false, AFTER_DRAIN = false;
    const BT* base_lat; const BT* base_ctx; OT* out_lat; OT* out_ctx; const float* mod_l; int need_ctx; int dry;
    bf16* Hn; const float* gnext; const float* modn; float* ssq;
    __device__ __forceinline__ void operator()(const pg8::f32x4 (&acc)[2][2][4][2], const pg8::Unit& u, int wr, int wc, int fr, int fq) const {
        asm volatile("" : "+v"(fr), "+v"(fq));
        const int r0 = u.pm * 256, b = r0 / RB, rr0 = r0 % RB; const bool ctx = rr0 == 0;
        if ((ctx && !need_ctx) || dry) return;
        const size_t ro = ctx ? (size_t)b * CT * D : ((size_t)b * S + (rr0 - CT)) * D;
        const BT* bp = (ctx ? base_ctx : base_lat) + ro; OT* op = (ctx ? out_ctx : out_lat) + ro;
        const float* gt = mod_l + (size_t)(ctx ? 16 : b) * 3072 + 2048;
        const int col0 = u.pn * 256 + wc * 32 + 4 * fq;
        pg8::f32x4 g[2][2];
#pragma unroll
        for (int bj = 0; bj < 2; ++bj)
#pragma unroll
            for (int n = 0; n < 2; ++n) g[bj][n] = *(const pg8::f32x4*)(gt + col0 + bj * 128 + n * 16);
        pg8::f32x4 gm[2][2];
        if (Hn) { const float* sn = modn + (size_t)(ctx ? 16 : b) * 3072 + 1024;
#pragma unroll
            for (int bj = 0; bj < 2; ++bj)
#pragma unroll
                for (int n = 0; n < 2; ++n) gm[bj][n] = *(const pg8::f32x4*)(gnext + col0 + bj * 128 + n * 16) * (*(const pg8::f32x4*)(sn + col0 + bj * 128 + n * 16) + 1.0f); }
#pragma unroll
        for (int ai = 0; ai < 2; ++ai)
#pragma unroll
            for (int m = 0; m < 4; ++m) { const size_t off = (size_t)(ai * 128 + wr * 64 + m * 16 + fr) * D + col0; float sq = 0.f;
#pragma unroll
                for (int bj = 0; bj < 2; ++bj)
#pragma unroll
                    for (int n = 0; n < 2; ++n) { const pg8::f32x4 bs = ld4(bp + off + bj * 128 + n * 16); const pg8::f32x4 xn = bs + g[bj][n] * acc[ai][bj][m][n]; st4(op + off + bj * 128 + n * 16, xn);
                        if (Hn) { sq += (xn[0] * xn[0] + xn[1] * xn[1]) + (xn[2] * xn[2] + xn[3] * xn[3]); const pg8::f32x4 hv = xn * gm[bj][n];
                            u32x2 w; w.x = pg8::cvt_pk_bf16(hv[0], hv[1]); w.y = pg8::cvt_pk_bf16(hv[2], hv[3]); *(u32x2*)(Hn + (size_t)(r0 + ai * 128 + wr * 64 + m * 16 + fr) * D + col0 + bj * 128 + n * 16) = w; } }
                if (Hn) { sq += __shfl_xor(sq, 16); sq += __shfl_xor(sq, 32); if (fq == 0) ssq[(size_t)(r0 + ai * 128 + wr * 64 + m * 16 + fr) * 16 + u.pn * 4 + wc] = sq; } }
    }
};
using EpiResid = EpiResidT<float, float>;

struct LatOnlyOrder {
    pg8::StaticOrder lat;
    __device__ void init(int G_, int c_) { lat.init(128 * 256, D, G_, c_); }
    __device__ bool next(int i, pg8::Unit& u) const { const bool ok = lat.next(i, u); u.pm = (u.pm >> 3) * 9 + 1 + (u.pm & 7); return ok; }
    __device__ __forceinline__ void a_ready(const pg8::Unit&) const {}
    __device__ __forceinline__ void done(const pg8::Unit&) const {}
};
struct OutTailOrder {
    int c;
    __device__ void init(int, int c_) { c = c_; }
    __device__ bool next(int i, pg8::Unit& u) const { if (i > 0 || c >= 64) return false; const int x = c & 7, j = c >> 3; u.pm = 128 + 2 * x + (j >> 2); u.pn = j & 3; return true; }
    __device__ __forceinline__ void a_ready(const pg8::Unit&) const {}
    __device__ __forceinline__ void done(const pg8::Unit&) const {}
};
struct L3Order {
    pg8::StaticOrder lat; int G, c;
    __device__ void init(int G_, int c_) { lat.init(64 * 256, 18 * 256, G_, c_); G = G_; c = c_; }
    __device__ bool next(int i, pg8::Unit& u) const {
        const long L = (long)i * G + c;
        if (L < 1152) { const bool ok = lat.next(i, u); u.pm = (u.pm >> 3) * 9 + 1 + (u.pm & 7); return ok; }
        if (L >= 1168) return false;
        const int j = (int)L - 1152; u.pm = (j >> 1) * 9; u.pn = 8 + (j & 1); return true;
    }
    __device__ __forceinline__ void a_ready(const pg8::Unit&) const {}
    __device__ __forceinline__ void done(const pg8::Unit&) const {}
};

__device__ __forceinline__ void transpose_item(const float* W, int K, int N, bf16* WT, LAS float* scr, int item, int lane) {
    const int nblk = N / 32, kb = item / nblk, nb = item % nblk, k0 = 64 * kb, n0 = 32 * nb;
#pragma unroll 8
    for (int i = 0; i < 32; ++i) { const int kk = 2 * i + (lane >> 5); scr[kk * 33 + (lane & 31)] = W[(size_t)(k0 + kk) * N + n0 + (lane & 31)]; }
    LDS_WAIT(); asm volatile("" ::: "memory");
    const int c = lane & 7;
#pragma unroll
    for (int j = 0; j < 4; ++j) { const int n = (lane >> 3) + 8 * j; const LAS float* s = scr + (8 * c) * 33 + n;
        v4u o; o.x = pk2(s[0 * 33], s[1 * 33]); o.y = pk2(s[2 * 33], s[3 * 33]); o.z = pk2(s[4 * 33], s[5 * 33]); o.w = pk2(s[6 * 33], s[7 * 33]);
        *(GAS v4u*)(WT + (size_t)(n0 + n) * K + k0 + 8 * c) = o; }
    LDS_WAIT(); asm volatile("" ::: "memory");
}
__device__ __forceinline__ void wconv(Frame& F0, const float* Win, int Nin, const float* Wout, bf16* WinT, bf16* WoutT, int gw, int NGW) {
    Frame F = fresh(F0);
    LAS float* scr = (LAS float*)(F.lds + F.wave * 16384);
    const int I1 = (D / 64) * (Nin / 32), I2 = (DI / 64) * (D / 32);
    for (int it = gw; it < I1 + I2; it += NGW) { if (it < I1) transpose_item(Win, D, Nin, WinT, scr, it, F.lane); else transpose_item(Wout, DI, D, WoutT, scr, it - I1, F.lane); }
}
template <class XT>
__device__ __forceinline__ void norm_phase(Frame& F0, const XT* xlat, const XT* xctx, const float* g, const float* mod_l, bf16* H, int row_lo = 0, int row_hi = MT, int wg0 = 0) {
    Frame F = fresh(F0);
    const int gw = (wg0 ? (int)blockIdx.x - wg0 : F.vcu) * NWAVES + F.wave, NGW = (F.G - wg0) * NWAVES;
    f32x4 gg[4];
#pragma unroll
    for (int j = 0; j < 4; ++j) gg[j] = *(const f32x4*)(g + F.lane * 4 + 256 * j);
    for (int row0 = row_lo + gw; row0 < row_hi; row0 += 2 * NGW) {
        f32x4 v[2][4]; const float* mrow[2]; float ss[2] = {0.f, 0.f}; int rowi[2];
#pragma unroll
        for (int u = 0; u < 2; ++u) { int row = row0 + u * NGW; if (row >= row_hi) row = row0; rowi[u] = row;
            const int b = row / RB, rr = row % RB;
            const XT* src = rr < CT ? xctx + ((size_t)b * CT + rr) * D : xlat + ((size_t)b * S + (rr - CT)) * D;
            mrow[u] = mod_l + (size_t)(rr < CT ? 16 : b) * 3072;
#pragma unroll
            for (int j = 0; j < 4; ++j) v[u][j] = ld4(src + F.lane * 4 + 256 * j); }
#pragma unroll
        for (int u = 0; u < 2; ++u) {
#pragma unroll
            for (int j = 0; j < 4; ++j) ss[u] += (v[u][j].x * v[u][j].x + v[u][j].y * v[u][j].y) + (v[u][j].z * v[u][j].z + v[u][j].w * v[u][j].w);
            const float rstd = rsqrtf(wave_sum(ss[u]) * (1.f / D) + EPS);
#pragma unroll
            for (int j = 0; j < 4; ++j) { const int c = F.lane * 4 + 256 * j; const f32x4 sc = *(const f32x4*)(mrow[u] + 1024 + c), sh = *(const f32x4*)(mrow[u] + c);
                const f32x4 o = v[u][j] * rstd * gg[j] * (sc + 1.0f) + sh;
                u32x2 w; w.x = pk2(o.x, o.y); w.y = pk2(o.z, o.w); *(u32x2*)(H + (size_t)rowi[u] * D + c) = w; }
        }
    }
}
__device__ __forceinline__ void final_norm_phase(Frame& F0, float* xs, const float* g) {
    Frame F = fresh(F0);
    const int gw = F.vcu * NWAVES + F.wave, NGW = F.G * NWAVES;
    f32x4 gg[4];
#pragma unroll
    for (int j = 0; j < 4; ++j) gg[j] = *(const f32x4*)(g + F.lane * 4 + 256 * j);
    for (int row0 = gw; row0 < NB * S; row0 += 2 * NGW) {
        f32x4 v[2][4]; float* p[2];
#pragma unroll
        for (int u = 0; u < 2; ++u) { int row = row0 + u * NGW; if (row >= NB * S) row = row0; p[u] = xs + (size_t)row * D;
#pragma unroll
            for (int j = 0; j < 4; ++j) v[u][j] = *(const f32x4*)(p[u] + F.lane * 4 + 256 * j); }
#pragma unroll
        for (int u = 0; u < 2; ++u) { float ss = 0.f;
#pragma unroll
            for (int j = 0; j < 4; ++j) ss += (v[u][j].x * v[u][j].x + v[u][j].y * v[u][j].y) + (v[u][j].z * v[u][j].z + v[u][j].w * v[u][j].w);
            const float rstd = rsqrtf(wave_sum(ss) * (1.f / D) + EPS);
#pragma unroll
            for (int j = 0; j < 4; ++j) { const int c = F.lane * 4 + 256 * j; *(f32x4*)(p[u] + c) = v[u][j] * rstd * gg[j]; } }
    }
}
__device__ __forceinline__ void shw_phase(Frame& F0, const Args& a) {
    Frame F = fresh(F0);
    const float* mod = (const float*)(a.ws + WS_MOD); float* shw = (float*)(a.ws + WS_SHW);
    LAS float* sh = (LAS float*)F.lds;
    LAS float* red = (LAS float*)(F.lds + 69632);
    int cur_l = -1;
    for (int it = blockIdx.x; it < 128 + 128 + 72; it += F.G) {
        const int l = it < 128 ? 0 : (it < 256 ? 1 : 2), cg = it - (l == 0 ? 0 : (l == 1 ? 128 : 256));
        const int N = l == 2 ? 4608 : 8192; const float* W = a.in[l == 0 ? 19 : (l == 1 ? 26 : 29)];
        __syncthreads();
        if (l != cur_l) { for (int i = F.tid; i < 17 * 1024; i += NTHR) sh[i] = mod[((size_t)(l + 1) * 17 + (i >> 10)) * 3072 + (i & 1023)]; cur_l = l; __syncthreads(); }
        float acc[17];
#pragma unroll
        for (int r = 0; r < 17; ++r) acc[r] = 0.f;
        const float* wp = W + (size_t)(F.wave * 128) * N + cg * 64 + F.lane;
#pragma unroll 8
        for (int kk = 0; kk < 128; ++kk) { const float w = wp[(size_t)kk * N];
#pragma unroll
            for (int r = 0; r < 17; ++r) acc[r] += sh[r * 1024 + F.wave * 128 + kk] * w; }
#pragma unroll
        for (int r = 0; r < 17; ++r) red[(F.wave * 17 + r) * 64 + F.lane] = acc[r];
        __syncthreads();
        for (int i = F.tid; i < 17 * 64; i += NTHR) { float sacc = 0.f;
#pragma unroll
            for (int w8 = 0; w8 < 8; ++w8) sacc += red[(w8 * 17 + (i >> 6)) * 64 + (i & 63)];
            shw[((size_t)l * 17 + (i >> 6)) * 8192 + cg * 64 + (i & 63)] = sacc; }
    }
    __syncthreads();
}
__device__ __forceinline__ void prologue_phase(Frame& F0, const Args& a) {
    Frame F = fresh(F0);
    const float* c = a.in[1]; const float* cctx = a.in[3]; const float* w_ada = a.in[5];
    float* part = (float*)(a.ws + WS_QG);
    {
        LAS float* st = (LAS float*)F.lds;
        const int wg = blockIdx.x, l = wg >> 6, sl = wg & 63, k0 = sl * 16;
        if (F.tid < 17 * 16) { const int r = F.tid >> 4, k = F.tid & 15; st[F.tid] = silu(r < 16 ? c[r * 1024 + k0 + k] : cctx[k0 + k]); }
        __syncthreads();
        float acc[17][6];
#pragma unroll
        for (int r = 0; r < 17; ++r)
#pragma unroll
            for (int i = 0; i < 6; ++i) acc[r][i] = 0.f;
        const float* wp = w_ada + ((size_t)l * 1024 + k0) * 3072 + F.tid;
#pragma unroll 2
        for (int kk = 0; kk < 16; ++kk) { float w[6];
#pragma unroll
            for (int i = 0; i < 6; ++i) w[i] = wp[(size_t)kk * 3072 + 512 * i];
#pragma unroll
            for (int r = 0; r < 17; ++r) { const float sv = st[r * 16 + kk];
#pragma unroll
                for (int i = 0; i < 6; ++i) acc[r][i] += sv * w[i]; } }
        float* pp = part + (size_t)wg * 17 * 3072 + F.tid;
#pragma unroll
        for (int r = 0; r < 17; ++r)
#pragma unroll
            for (int i = 0; i < 6; ++i) pp[r * 3072 + 512 * i] = acc[r][i];
    }
#ifdef MK_TOUCH
    {
        const int xg = blockIdx.x >> 3; unsigned accv = 0u;
        for (size_t off = ((size_t)xg * NTHR + F.tid) * 4096; off < WS_END; off += (size_t)32 * NTHR * 4096) accv += *(const unsigned*)(a.ws + off);
        for (size_t off = ((size_t)xg * NTHR + F.tid) * 4096; off < (size_t)NB * S * D * 4; off += (size_t)32 * NTHR * 4096) accv += *(const unsigned*)((const unsigned char*)a.out + off) + *(const unsigned*)((const unsigned char*)a.in[0] + off);
        asm volatile("" :: "v"(accv));
    }
#endif
    if (blockIdx.x == 0) {
        float* rope = (float*)(a.ws + WS_ROPE);
        for (int i = F.tid; i < 64 * 16; i += NTHR) { const int pos = i >> 4, j = i & 15; const float inv = powf(10000.f, -(float)j / 16.f), ang = (float)pos * inv; rope[2 * i] = cosf(ang); rope[2 * i + 1] = sinf(ang); }
    } else if (blockIdx.x < 33) {
        bf16* W2 = (bf16*)(a.ws + WS_WG2); const float* wq = a.in[11]; const float* wk = a.in[12]; const float* wv = a.in[13]; const float* wg = a.in[14];
        for (int i = (blockIdx.x - 1) * NTHR + F.tid; i < 32 * 4096; i += 32 * NTHR) { const int n = i >> 12, k = i & 4095; float s = 0.f;
            if (k < 2048) { const int gq = k >> 2, ii = k & 3;
#pragma unroll
                for (int j = 0; j < 4; ++j) s += wq[(gq * 4 + ii) * 4 + j] * wg[(size_t)(gq * 4 + j) * 32 + n] + wk[(gq * 4 + ii) * 4 + j] * wg[(size_t)(2048 + gq * 4 + j) * 32 + n]; }
            else { const int kk = k - 2048, gq = kk >> 2, ii = kk & 3;
#pragma unroll
                for (int j = 0; j < 4; ++j) s += wv[(gq * 4 + ii) * 4 + j] * wg[(size_t)(4096 + gq * 4 + j) * 32 + n]; }
            W2[i] = (bf16)f2bf(s); }
    }
}
__device__ __forceinline__ void prologue2_phase(Frame& F0, const Args& a) {
    Frame F = fresh(F0);
    const float* part = (const float*)(a.ws + WS_QG); const float* b_ada = a.in[6]; float* mod = (float*)(a.ws + WS_MOD);
    for (int o = blockIdx.x * NTHR + F.tid; o < 4 * 17 * 3072; o += F.G * NTHR) {
        const int l = o / (17 * 3072), rn = o % (17 * 3072), n = rn % 3072;
        const float* pp = part + (size_t)l * 64 * 17 * 3072 + rn; float s0 = 0.f, s1 = 0.f, s2 = 0.f, s3 = 0.f;
#pragma unroll
        for (int sl = 0; sl < 64; sl += 16) { float v[16];
#pragma unroll
            for (int j = 0; j < 16; ++j) v[j] = pp[(size_t)(sl + j) * 17 * 3072];
#pragma unroll
            for (int j = 0; j < 16; j += 4) { s0 += v[j]; s1 += v[j + 1]; s2 += v[j + 2]; s3 += v[j + 3]; } }
        mod[o] = ((s0 + s1) + (s2 + s3)) + b_ada[l * 3072 + n];
    }
}
}
namespace att {
using mk::bf16; using mk::bf16x8; using mk::s16x4; using mk::f32x16; using mk::u32x4; using mk::u32x2;
typedef short v4i16_t __attribute__((ext_vector_type(4)));
typedef float f32x2_t __attribute__((ext_vector_type(2))); typedef __bf16 bf16x2_t __attribute__((ext_vector_type(2)));
__device__ __forceinline__ int crow(int r, int hi) { return (r & 3) + 8 * (r >> 2) + 4 * hi; }
__device__ __forceinline__ unsigned cvtpk(float lo, float hi) { f32x2_t v = {lo, hi}; bf16x2_t b = __builtin_convertvector(v, bf16x2_t); return __builtin_bit_cast(unsigned, b); }
__device__ __forceinline__ s16x4 vtr(LAS const unsigned char* p) { return __builtin_bit_cast(s16x4, __builtin_amdgcn_ds_read_tr16_b64_v4i16((LAS v4i16_t*)p)); }
__device__ __forceinline__ float ex2(float x) { return __builtin_amdgcn_exp2f(x); }
__device__ __forceinline__ float max3f(float a, float b, float c) { float r; asm("v_max3_f32 %0, %1, %2, %3" : "=v"(r) : "v"(a), "v"(b), "v"(c)); return r; }
#define ATT_SB() __builtin_amdgcn_sched_barrier(0)

struct Src { const bf16* K[2]; const bf16* V; int ldk, ldv; };

template <int DV, int NCOMP> struct Stage { u32x4 kr[NCOMP]; u32x4 vr[DV / 64]; };
template <int DV, int NCOMP>
__device__ __forceinline__ void stage_load(Stage<DV, NCOMP>& st, const Src& s, size_t row, int wid, int lane) {
#pragma unroll
    for (int c = 0; c < NCOMP; ++c) st.kr[c] = *(const u32x4*)(s.K[c] + (row + lane) * s.ldk + wid * 8);
#pragma unroll
    for (int i = 0; i < DV / 64; ++i) { const int p = wid + 8 * i, d0 = p >> 2, kg = p & 3; st.vr[i] = *(const u32x4*)(s.V + (row + 16 * kg + (lane >> 2)) * s.ldv + d0 * 32 + (lane & 3) * 8); }
}
template <int DV, int NCOMP>
__device__ __forceinline__ void stage_store(const Stage<DV, NCOMP>& st, LAS unsigned char* buf, int wid, int lane) {
#pragma unroll
    for (int c = 0; c < NCOMP; ++c) *(LAS u32x4*)(buf + c * 8192 + wid * 1024 + lane * 16) = st.kr[c];
#pragma unroll
    for (int i = 0; i < DV / 64; ++i) *(LAS u32x4*)(buf + NCOMP * 8192 + (wid + 8 * i) * 1024 + lane * 16) = st.vr[i];
}
__device__ __forceinline__ void glds16(const void* gsrc, unsigned lds_dst) { unsigned keep;
    asm volatile("s_mov_b32 %0, m0\n\ts_mov_b32 m0, %2\n\ts_nop 0\n\tglobal_load_lds_dwordx4 %1, off\n\ts_mov_b32 m0, %0" : "=&s"(keep) : "v"(gsrc), "s"(lds_dst) : "memory"); }
__device__ __forceinline__ unsigned long long uni64(const void* p) { const unsigned long long a = (unsigned long long)p;
    return ((unsigned long long)(unsigned)__builtin_amdgcn_readfirstlane((unsigned)(a >> 32)) << 32) | (unsigned)__builtin_amdgcn_readfirstlane((unsigned)a); }
__device__ __forceinline__ void glds16s(const void* sbase_, unsigned voff, unsigned lds_dst) { unsigned keep; const unsigned long long sbase = uni64(sbase_);
    asm volatile("s_mov_b32 %0, m0\n\ts_mov_b32 m0, %3\n\ts_nop 0\n\tglobal_load_lds_dwordx4 %1, %2\n\ts_mov_b32 m0, %0" : "=&s"(keep) : "v"(voff), "s"(sbase), "s"(lds_dst) : "memory"); }
template <int DV, int NCOMP>
__device__ __forceinline__ void dma_issue(const Src& s, size_t row, LAS unsigned char* buf, int wid, int lane) {
    const unsigned b0 = (unsigned)(size_t)buf;
    const unsigned ko = (unsigned)(lane * s.ldk + wid * 8) * 2u, vo = (unsigned)((16 * (wid & 3) + (lane >> 2)) * s.ldv + (lane & 3) * 8) * 2u;
#pragma unroll
    for (int c = 0; c < NCOMP; ++c) glds16s(s.K[c] + row * s.ldk, ko, (unsigned)__builtin_amdgcn_readfirstlane(b0 + c * 8192 + wid * 1024));
#pragma unroll
    for (int i = 0; i < DV / 64; ++i) { const int p = wid + 8 * i, d0 = p >> 2;
        glds16s(s.V + row * s.ldv + d0 * 32, vo, (unsigned)__builtin_amdgcn_readfirstlane(b0 + NCOMP * 8192 + p * 1024)); }
}
#define ATT_WAIT_BAR(N) asm volatile("s_waitcnt vmcnt(" #N ") lgkmcnt(0)\n\ts_barrier" ::: "memory")
template <int NL> __device__ __forceinline__ void wait_bar_keep() { if constexpr (NL == 2) ATT_WAIT_BAR(2); else if constexpr (NL == 4) ATT_WAIT_BAR(4); else static_assert(NL == 2 || NL == 4, "pieces per wave"); }
__device__ __forceinline__ void qk_tile(LAS const unsigned char* kimg, const bf16x8 (&qf)[4], int r32, int hi, f32x16& p0, f32x16& p1, const f32x16& z, const f32x16& z1  ) {
    LAS const unsigned char* kb = kimg + hi * 1024 + r32 * 16;
#define ATT_KRD(i) (*(LAS const bf16x8*)(kb + ((i) >> 1) * 2048 + ((i) & 1) * 512))
    bf16x8 f0 = ATT_KRD(0), f1 = ATT_KRD(1), f2;
    f2 = ATT_KRD(2); ATT_SB(); p0 = __builtin_amdgcn_mfma_f32_32x32x16_bf16(f0, qf[0], z, 0, 0, 0);
    f0 = ATT_KRD(3); ATT_SB(); p1 = __builtin_amdgcn_mfma_f32_32x32x16_bf16(f1, qf[0], z1, 0, 0, 0);
    f1 = ATT_KRD(4); ATT_SB(); p0 = __builtin_amdgcn_mfma_f32_32x32x16_bf16(f2, qf[1], p0, 0, 0, 0);
    f2 = ATT_KRD(5); ATT_SB(); p1 = __builtin_amdgcn_mfma_f32_32x32x16_bf16(f0, qf[1], p1, 0, 0, 0);
    f0 = ATT_KRD(6); ATT_SB(); p0 = __builtin_amdgcn_mfma_f32_32x32x16_bf16(f1, qf[2], p0, 0, 0, 0);
    f1 = ATT_KRD(7); ATT_SB(); p1 = __builtin_amdgcn_mfma_f32_32x32x16_bf16(f2, qf[2], p1, 0, 0, 0);
    ATT_SB(); p0 = __builtin_amdgcn_mfma_f32_32x32x16_bf16(f0, qf[3], p0, 0, 0, 0);
    ATT_SB(); p1 = __builtin_amdgcn_mfma_f32_32x32x16_bf16(f1, qf[3], p1, 0, 0, 0);
#undef ATT_KRD
}
template <int DV>
__device__ __forceinline__ void softmax_tile(f32x16& p0, f32x16& p1, f32x16 (&o)[DV / 32], float& m, float& l, u32x4 (&pw)[4]) {
    float mxa = max3f(p0[0], p0[1], p1[0]), mxb = max3f(p0[2], p0[3], p1[1]); mxa = max3f(mxa, p1[2], p1[3]);
#pragma unroll
    for (int r = 4; r < 16; r += 4) { mxa = max3f(mxa, p0[r], p0[r + 1]); mxb = max3f(mxb, p0[r + 2], p0[r + 3]); mxa = max3f(mxa, p1[r], p1[r + 1]); mxb = max3f(mxb, p1[r + 2], p1[r + 3]); }
    const float mx0 = max3f(mxa, mxb, mxb);
    const float mn = max3f(m, mx0, __shfl_xor(mx0, 32)), alpha = ex2(m - mn);
    float ls = 0.f;
#pragma unroll
    for (int r = 0; r < 16; ++r) { p0[r] = ex2(p0[r] - mn); p1[r] = ex2(p1[r] - mn); ls += p0[r] + p1[r]; }
    l = l * alpha + ls;
    if (__any(mn != m)) {
#pragma unroll
        for (int d0 = 0; d0 < DV / 32; ++d0)
#pragma unroll
            for (int r = 0; r < 16; ++r) o[d0][r] *= alpha;
    }
    m = mn;
#pragma unroll
    for (int ks = 0; ks < 4; ++ks) { const int b = 8 * (ks & 1);
        if (ks < 2) { pw[ks].x = cvtpk(p0[b], p0[b + 1]); pw[ks].y = cvtpk(p0[b + 2], p0[b + 3]); pw[ks].z = cvtpk(p0[b + 4], p0[b + 5]); pw[ks].w = cvtpk(p0[b + 6], p0[b + 7]); }
        else { pw[ks].x = cvtpk(p1[b], p1[b + 1]); pw[ks].y = cvtpk(p1[b + 2], p1[b + 3]); pw[ks].z = cvtpk(p1[b + 4], p1[b + 5]); pw[ks].w = cvtpk(p1[b + 6], p1[b + 7]); } }
}
template <int DV>
__device__ __forceinline__ void pv_tile(LAS const unsigned char* vimg, int lane, int hi, const u32x4 (&pw)[4], f32x16 (&o)[DV / 32]) {
    LAS const unsigned char* vb = vimg + ((lane >> 4) & 1) * 32 + (lane & 3) * 8 + (4 * hi + ((lane & 15) >> 2)) * 64;
    constexpr int ND = DV / 32, NF = 4 * ND;
    constexpr int PD = 4, NB_ = PD + 1;
    s16x4 lo[NB_], hi4[NB_];
#define ATT_VRD(i, b) do { lo[b] = vtr(vb + ((i) % ND) * 4096 + ((i) / ND) * 1024); hi4[b] = vtr(vb + ((i) % ND) * 4096 + ((i) / ND) * 1024 + 512); } while (0)
#pragma unroll
    for (int i = 0; i < PD; ++i) ATT_VRD(i, i);
#pragma unroll
    for (int i = 0; i < NF; ++i) {
        if (i + PD < NF) ATT_VRD(i + PD, (i + PD) % NB_);
        ATT_SB();
        const int b = i % NB_;
        const bf16x8 vf = {lo[b][0], lo[b][1], lo[b][2], lo[b][3], hi4[b][0], hi4[b][1], hi4[b][2], hi4[b][3]};
        o[i % ND] = __builtin_amdgcn_mfma_f32_32x32x16_bf16(vf, __builtin_bit_cast(bf16x8, pw[i / ND]), o[i % ND], 0, 0, 0);
    }
#undef ATT_VRD
}

struct SmState { float mxa, mxb, mn, alpha, ls, delta; bool resc; };
template <int NM>
__device__ __forceinline__ void negm_shift(f32x16 (&negm)[NM], float delta) {
#pragma unroll
    for (int i = 0; i < NM; ++i)
#pragma unroll
        for (int r = 0; r < 16; ++r) negm[i][r] -= delta;
}
__device__ __forceinline__ float xmax32(float v) { auto rr = __builtin_amdgcn_permlane32_swap(__float_as_uint(v), __float_as_uint(v), false, false); return max3f(__uint_as_float(rr[0]), __uint_as_float(rr[1]), v); }
template <int SK> __device__ __forceinline__ constexpr bool sm_live0(int r) { return SK != 2 || r >= 12; }
template <int SK> __device__ __forceinline__ constexpr bool sm_live1(int r) { return SK != 1 || r < 4; }
template <int SK = 0>
__device__ __forceinline__ void sm_slice(int k, f32x16& p0, f32x16& p1, float& m, float& l, SmState& s, u32x4 (&pwn)[4]) {
    if (k <= 3) { const int r = 4 * k;
        if (SK == 0 && k == 0) { s.mxa = max3f(p0[0], p0[1], p1[0]); s.mxb = max3f(p0[2], p0[3], p1[1]); s.mxa = max3f(s.mxa, p1[2], p1[3]); }
        else { if (k == 0) { s.mxa = -INFINITY; s.mxb = -INFINITY; }
            if (sm_live0<SK>(r)) { s.mxa = max3f(s.mxa, p0[r], p0[r + 1]); s.mxb = max3f(s.mxb, p0[r + 2], p0[r + 3]); }
            if (sm_live1<SK>(r)) { s.mxa = max3f(s.mxa, p1[r], p1[r + 1]); s.mxb = max3f(s.mxb, p1[r + 2], p1[r + 3]); } }
        asm volatile("" : "+v"(s.mxa), "+v"(s.mxb)); }
    else if (k == 4) { const float mx0 = xmax32(max3f(s.mxa, s.mxb, s.mxb)); const bool first = m == -INFINITY;
        const float delta = (first || mx0 > 8.f) ? mx0 : 0.f; s.delta = delta; s.mn = first ? mx0 : m + delta; s.alpha = ex2(-delta); s.resc = __any(delta != 0.f); l *= s.alpha; s.ls = 0.f;
        if (s.resc) {
#pragma unroll
            for (int r = 0; r < 16; ++r) { p0[r] -= delta; p1[r] -= delta; }
        }
        asm volatile("" : "+v"(s.mn), "+v"(s.alpha), "+v"(l)); }
    else if (k <= 12) { const int j = 2 * (k - 5);
        if (sm_live0<SK>(j)) { p0[j] = ex2(p0[j]); p0[j + 1] = ex2(p0[j + 1]); s.ls += p0[j] + p0[j + 1]; }
        if (sm_live1<SK>(j)) { p1[j] = ex2(p1[j]); p1[j + 1] = ex2(p1[j + 1]); s.ls += p1[j] + p1[j + 1]; }
        asm volatile("" : "+v"(p0), "+v"(p1), "+v"(s.ls)); }
    else if (k == 13) {
        if (SK == 2) { pwn[0] = u32x4{0u, 0u, 0u, 0u}; pwn[1].x = 0u; pwn[1].y = 0u; }
        else { pwn[0].x = cvtpk(p0[0], p0[1]); pwn[0].y = cvtpk(p0[2], p0[3]); pwn[0].z = cvtpk(p0[4], p0[5]); pwn[0].w = cvtpk(p0[6], p0[7]); pwn[1].x = cvtpk(p0[8], p0[9]); pwn[1].y = cvtpk(p0[10], p0[11]); }
        pwn[1].z = cvtpk(p0[12], p0[13]); pwn[1].w = cvtpk(p0[14], p0[15]); asm volatile("" : "+v"(pwn[0]), "+v"(pwn[1])); }
    else if (k == 14) { pwn[2].x = cvtpk(p1[0], p1[1]); pwn[2].y = cvtpk(p1[2], p1[3]);
        if (SK == 1) { pwn[2].z = 0u; pwn[2].w = 0u; pwn[3] = u32x4{0u, 0u, 0u, 0u}; }
        else { pwn[2].z = cvtpk(p1[4], p1[5]); pwn[2].w = cvtpk(p1[6], p1[7]); pwn[3].x = cvtpk(p1[8], p1[9]); pwn[3].y = cvtpk(p1[10], p1[11]); pwn[3].z = cvtpk(p1[12], p1[13]); pwn[3].w = cvtpk(p1[14], p1[15]); }
        asm volatile("" : "+v"(pwn[2]), "+v"(pwn[3])); }
    else { l += s.ls; asm volatile("" : "+v"(l)); }
}
template <int DV, int NM, int SK = 0>
__device__ __forceinline__ void sm_alone(f32x16& p0, f32x16& p1, f32x16 (&o)[DV / 32], float& m, float& l, u32x4 (&pwn)[4], f32x16 (&negm)[NM]) {
    SmState s;
#pragma unroll
    for (int k = 0; k < 16; ++k) sm_slice<SK>(k, p0, p1, m, l, s, pwn);
    if (s.resc) {
#pragma unroll
        for (int d0 = 0; d0 < DV / 32; ++d0)
#pragma unroll
            for (int r = 0; r < 16; ++r) o[d0][r] *= s.alpha;
        negm_shift<NM>(negm, s.delta);
    }
    m = s.mn;
}
template <int DV, int NM, int SK = 0>
__device__ __forceinline__ void pv_sm_tile(LAS const unsigned char* vimg, int lane, int hi, const u32x4 (&pw)[4], f32x16 (&o)[DV / 32], f32x16& p0, f32x16& p1, float& m, float& l, u32x4 (&pwn)[4], f32x16 (&negm)[NM]) {
    LAS const unsigned char* vb = vimg + ((lane >> 4) & 1) * 32 + (lane & 3) * 8 + (4 * hi + ((lane & 15) >> 2)) * 64;
    constexpr int ND = DV / 32, NF = 4 * ND, PD = 3, NB_ = PD + 1, SPM = 16 / NF;
    s16x4 lo[NB_], hi4[NB_];
    SmState s;
#define ATT_VRD(i, b) do { lo[b] = vtr(vb + ((i) % ND) * 4096 + ((i) / ND) * 1024); hi4[b] = vtr(vb + ((i) % ND) * 4096 + ((i) / ND) * 1024 + 512); } while (0)
#pragma unroll
    for (int i = 0; i < PD; ++i) ATT_VRD(i, i);
#pragma unroll
    for (int i = 0; i < NF; ++i) {
        if (i + PD < NF) ATT_VRD(i + PD, (i + PD) % NB_);
        ATT_SB();
        const int b = i % NB_;
        const bf16x8 vf = {lo[b][0], lo[b][1], lo[b][2], lo[b][3], hi4[b][0], hi4[b][1], hi4[b][2], hi4[b][3]};
        o[i % ND] = __builtin_amdgcn_mfma_f32_32x32x16_bf16(vf, __builtin_bit_cast(bf16x8, pw[i / ND]), o[i % ND], 0, 0, 0);
#pragma unroll
        for (int k = i * SPM; k < (i + 1) * SPM; ++k) sm_slice<SK>(k, p0, p1, m, l, s, pwn);
        ATT_SB();
    }
#undef ATT_VRD
    if (s.resc) {
#pragma unroll
        for (int d0 = 0; d0 < ND; ++d0)
#pragma unroll
            for (int r = 0; r < 16; ++r) o[d0][r] *= s.alpha;
        negm_shift<NM>(negm, s.delta);
    }
    m = s.mn;
}

__device__ __forceinline__ void wait_bar_tiles2(int c) {
    if (c >= 5) ATT_WAIT_BAR(10); else if (c == 4) ATT_WAIT_BAR(8); else if (c == 3) ATT_WAIT_BAR(6); else if (c == 2) ATT_WAIT_BAR(4); else if (c == 1) ATT_WAIT_BAR(2); else ATT_WAIT_BAR(0);
}
template <int DV, class Pol, int NS = 4>
__device__ __forceinline__ void run_unit1(LAS unsigned char* lds, const Pol& P, const Src& src, const bf16* Q, int ldq, int wid, int lane) {
    const int r32 = lane & 31, hi = lane >> 5;
    constexpr int STG = 8192 + DV * 128, NL = 1 + DV / 64, LA = NS - 2;
    static_assert(NL == 2 && LA <= 6, "wait_bar_tiles2 counts two-piece tiles");
    const int nt = P.ntiles();
#pragma unroll
    for (int t = 0; t < LA; ++t) if (t < nt) dma_issue<DV, 1>(src, P.tile_row(t), lds + t * STG, wid, lane);
    bf16x8 qf[4];
    { const bf16* qp = Q + (size_t)(wid * 32 + r32) * ldq + hi * 8;
#pragma unroll
      for (int d0 = 0; d0 < 4; ++d0) qf[d0] = *(const bf16x8*)(qp + d0 * 16); }
    f32x16 o[DV / 32];
#pragma unroll
    for (int d0 = 0; d0 < DV / 32; ++d0) o[d0] = f32x16{};
    float m = -INFINITY, l = 0.f; f32x16 negm[1] = {f32x16{}};
    u32x4 pw[4], pwn[4]; bool pend = false;
    asm volatile("" : "+v"(qf[0]), "+v"(qf[1]), "+v"(qf[2]), "+v"(qf[3]));
    ATT_WAIT_BAR(0);
    int ic = 0;
    for (int ti = 0; ti < nt; ++ti) {
        LAS unsigned char* cur = lds + ic * STG; LAS unsigned char* prv = lds + ((ic + NS - 1) & (NS - 1)) * STG;
        if (ti + LA < nt) dma_issue<DV, 1>(src, P.tile_row(ti + LA), lds + ((ic + LA) & (NS - 1)) * STG, wid, lane);
        if (P.needs(ti, wid)) {
            f32x16 p0, p1;
            qk_tile(cur, qf, r32, hi, p0, p1, negm[0], negm[0]);
            P.mask(ti, wid, r32, hi, p0, p1);
            if (pend) pv_sm_tile<DV, 1>(prv + 8192, lane, hi, pw, o, p0, p1, m, l, pwn, negm); else sm_alone<DV, 1>(p0, p1, o, m, l, pwn, negm);
#pragma unroll
            for (int k = 0; k < 4; ++k) pw[k] = pwn[k];
            pend = true;
        } else if (pend) { pv_tile<DV>(prv + 8192, lane, hi, pw, o); pend = false; }
        wait_bar_tiles2(min(ti + LA, nt - 1) - (ti + 1));
        ic = (ic + 1) & (NS - 1);
    }
    if (pend) pv_tile<DV>(lds + ((ic + NS - 1) & (NS - 1)) * STG + 8192, lane, hi, pw, o);
    P.finish(o, m, l, wid, r32, hi);
    ATT_WAIT_BAR(0);
}
constexpr int ZQ_Z = 65536, ZQ_Q = 98304;
__device__ __forceinline__ void glds4s(const void* sbase_, unsigned voff, unsigned lds_dst) { unsigned keep; const unsigned long long sbase = uni64(sbase_);
    asm volatile("s_mov_b32 %0, m0\n\ts_mov_b32 m0, %3\n\ts_nop 0\n\tglobal_load_lds_dword %1, %2\n\ts_mov_b32 m0, %0" : "=&s"(keep) : "v"(voff), "s"(sbase), "s"(lds_dst) : "memory"); }
__device__ __forceinline__ void dma_rows64(const bf16* base, int ld, LAS unsigned char* dst, int lane) {
    const unsigned vo = (unsigned)((lane & 31) * ld + (lane >> 5) * 8) * 2u;
    const unsigned b0 = (unsigned)(size_t)dst;
#pragma unroll
    for (int j = 0; j < 4; ++j) glds16s(base + j * 16, vo, (unsigned)__builtin_amdgcn_readfirstlane(b0 + j * 1024));
}
template <class Pol, int SKL  , class Ctx, class Gen>
__device__ __forceinline__ void run_stream1(LAS unsigned char* lds, const Ctx& C, const Gen& gen, int wid_, int lane_) {
    constexpr int DV = 64, STG = 16384, EX = Pol::EXTRA;
    static_assert(EX == 4 || EX == 5, "first-step wait counts");
    int lane = lane_, wid = wid_;
#define ZL_ (lds + ZQ_Z + wid * 4096)
#define QL_ (lds + ZQ_Q + wid * 4096)
    Pol P;
    if (!gen(0, P)) return;
    dma_rows64(P.qrow(C, wid), mk::DI, QL_, lane);
    dma_issue<DV, 1>(P.src(C), P.tile_row(0), lds, wid, lane);
    dma_issue<DV, 1>(P.src(C), P.tile_row(1), lds + STG, wid, lane);
    ATT_WAIT_BAR(0);
    int ic = 0;
    for (int i = 0;; ++i) {
        Pol Pn; const bool hn = gen(i + 1, Pn);
        asm volatile("" : "+v"(lane), "+s"(wid));
        bf16x8 qf[4];
#pragma unroll
        for (int d0 = 0; d0 < 4; ++d0) qf[d0] = *(LAS const bf16x8*)(QL_ + d0 * 1024 + lane * 16);
        asm volatile("" : "+v"(qf[0]), "+v"(qf[1]), "+v"(qf[2]), "+v"(qf[3]));
        const int nt = P.ntiles();
        f32x16 o[2] = {f32x16{}, f32x16{}};
        float m = -INFINITY, l = 0.f; f32x16 negm[Pol::NM];
#pragma unroll
        for (int i_ = 0; i_ < Pol::NM; ++i_) negm[i_] = f32x16{};
        u32x4 pw[4], pwn[4]; bool pend = false;
        auto steps = [&](auto skc, int t0, int t1) {
          constexpr int SK_ = decltype(skc)::value;
          for (int ti = t0; ti < t1; ++ti) {
            LAS unsigned char* cur = lds + ic * STG; LAS unsigned char* prv = lds + ((ic + 3) & 3) * STG; LAS unsigned char* nxt = lds + ((ic + 2) & 3) * STG;
            asm volatile("" : "+v"(lane), "+s"(wid)); const int r32 = lane & 31, hi = lane >> 5;
            if (ti == 0) { P.stage_extra(C, ZL_, wid, lane); if (hn) dma_rows64(Pn.qrow(C, wid), mk::DI, QL_, lane); }
            bool issued = true;
            if (ti + 2 < nt) dma_issue<DV, 1>(P.src(C), P.tile_row(ti + 2), nxt, wid, lane);
            else if (hn) dma_issue<DV, 1>(Pn.src(C), Pn.tile_row(ti + 2 - nt), nxt, wid, lane);
            else issued = false;
            P.prep(ti, wid, r32, hi, negm);
            if (P.needs(ti, wid)) {
                f32x16 p0, p1;
                qk_tile(cur, qf, r32, hi, p0, p1, negm[0], negm[Pol::NM - 1]);
                P.template mask<SK_>(C, ti, wid, r32, hi, p0, p1);
                if (pend) pv_sm_tile<DV, Pol::NM, SK_>(prv + 8192, lane, hi, pw, o, p0, p1, m, l, pwn, negm); else sm_alone<DV, Pol::NM, SK_>(p0, p1, o, m, l, pwn, negm);
#pragma unroll
                for (int k = 0; k < 4; ++k) pw[k] = pwn[k];
                pend = true;
            } else if (pend) { pv_tile<DV>(prv + 8192, lane, hi, pw, o); pend = false; }
            if (ti == 0) { if constexpr (EX == 4) { if (hn) ATT_WAIT_BAR(10); else ATT_WAIT_BAR(6); } else { if (hn) ATT_WAIT_BAR(11); else ATT_WAIT_BAR(7); } }
            else if (issued) ATT_WAIT_BAR(2); else ATT_WAIT_BAR(0);
            ic = (ic + 1) & 3;
          }
        };
        if constexpr (SKL == 0) steps(std::integral_constant<int, 0>{}, 0, nt);
        else { steps(std::integral_constant<int, 0>{}, 0, 4);
            steps(std::integral_constant<int, SKL>{}, 4, nt); }
        asm volatile("" : "+v"(lane), "+s"(wid)); const int r32 = lane & 31, hi = lane >> 5;
        if (pend) pv_tile<DV>(lds + ((ic + 3) & 3) * STG + 8192, lane, hi, pw, o);
        P.finish(C, o, m, l, wid, r32, hi, ZL_);
        if (!hn) break;
        P = Pn;
    }
    ATT_WAIT_BAR(0);
#undef ZL_
#undef QL_
}
}
namespace mk {
using att::Src; using att::crow; using att::ex2;

template <int DV>
__device__ __forceinline__ void store_gated(const f32x16 (&o)[DV / 32], float inv, const bf16* zrow, bf16* grow, int hi) {
#pragma unroll
    for (int d0 = 0; d0 < DV / 32; ++d0)
#pragma unroll
        for (int i = 0; i < 4; ++i) { const int d = 32 * d0 + 8 * i + 4 * hi;
            const u32x2 zw = *(const u32x2*)(zrow + d);
            const float v0 = o[d0][4 * i] * inv * silu(bflo(zw.x)), v1 = o[d0][4 * i + 1] * inv * silu(bfhi(zw.x)), v2 = o[d0][4 * i + 2] * inv * silu(bflo(zw.y)), v3 = o[d0][4 * i + 3] * inv * silu(bfhi(zw.y));
            u32x2 w; w.x = att::cvtpk(v0, v1); w.y = att::cvtpk(v2, v3); *(u32x2*)(grow + d) = w; }
}

__device__ __forceinline__ void store_gated_l(const f32x16 (&o)[2], float inv, LAS const unsigned char* zl, bf16* grow, int r32, int hi) {
#pragma unroll
    for (int d0 = 0; d0 < 2; ++d0)
#pragma unroll
        for (int i = 0; i < 4; ++i) { const int d = 32 * d0 + 8 * i + 4 * hi;
            const u32x2 zw = *(LAS const u32x2*)(zl + (2 * d0 + (i >> 1)) * 1024 + (r32 + 32 * (i & 1)) * 16 + 8 * hi);
            const float v0 = o[d0][4 * i] * inv * silu(bflo(zw.x)), v1 = o[d0][4 * i + 1] * inv * silu(bfhi(zw.x)), v2 = o[d0][4 * i + 2] * inv * silu(bflo(zw.y)), v3 = o[d0][4 * i + 3] * inv * silu(bfhi(zw.y));
            u32x2 w; w.x = att::cvtpk(v0, v1); w.y = att::cvtpk(v2, v3); *(u32x2*)(grow + d) = w; }
}

struct AttCtx { const bf16* QG; const bf16* Kb; const bf16* Vb; const bf16* Zb; const float* aux; LAS const float* tab; int dry; };
struct SwaPol {
    static constexpr int EXTRA = 4, NM = 1;
    int bl, hq, qb, tl0, ntl; float sinkl2;
    __device__ __forceinline__ size_t off() const { return ((size_t)bl * RB + CT + qb * 256) * DI + hq * 64; }
    __device__ __forceinline__ Src src(const AttCtx& C) const { Src s; s.K[0] = C.Kb + (hq >> 3) * 64; s.K[1] = nullptr; s.V = C.Vb + (hq >> 3) * 64; s.ldk = 256; s.ldv = 256; return s; }
    __device__ __forceinline__ void prep(int, int, int, int, f32x16 (&)[1]) const {}
    __device__ __forceinline__ int ntiles() const { return 4 + ntl; }
    __device__ __forceinline__ const bf16* qrow(const AttCtx& C, int wid) const { return C.QG + off() + (size_t)(wid * 32) * DI; }
    __device__ __forceinline__ void stage_extra(const AttCtx& C, LAS unsigned char* zl, int wid, int lane) const { att::dma_rows64(C.Zb + off() + (size_t)(wid * 32) * DI, DI, zl, lane); }
    __device__ __forceinline__ size_t tile_row(int ti) const { return (size_t)bl * RB + (ti < 4 ? 64 * ti : CT + 64 * (tl0 + ti - 4)); }
    __device__ __forceinline__ bool needs(int ti, int wid) const { if (ti < 4) return true; const int kt0 = 64 * (tl0 + ti - 4), qw0 = qb * 256 + 32 * wid; return kt0 <= qw0 + 31 + 128 && kt0 + 63 >= qw0 - 128; }
    __device__ __forceinline__ int skip(int, int) const { return 0; }
    template <int SK> __device__ __forceinline__ void mask(const AttCtx&, int ti, int wid, int r32, int hi, f32x16& p0, f32x16& p1) const {
        if (ti < 4) return;
        const int kt0 = 64 * (tl0 + ti - 4), qw0 = qb * 256 + 32 * wid;
        if (kt0 >= qw0 + 31 - 128 && kt0 + 63 <= qw0 + 128) return;
        const int qt = qw0 + r32;
#pragma unroll
        for (int r = 0; r < 16; ++r) { const int kt = kt0 + crow(r, hi); int d0 = kt - qt; d0 = d0 < 0 ? -d0 : d0; int d1 = kt + 32 - qt; d1 = d1 < 0 ? -d1 : d1;
            if (d0 > 128) p0[r] = -INFINITY; if (d1 > 128) p1[r] = -INFINITY; }
    }
    __device__ __forceinline__ void finish(const AttCtx& C, f32x16 (&o)[2], float m, float l, int wid, int r32, int hi, LAS const unsigned char* zl) const {
        const float mn = fmaxf(m, sinkl2), alpha = ex2(m - mn);
        const float lt = (l + __shfl_xor(l, 32)) * alpha + ex2(sinkl2 - mn);
        const float inv = alpha / lt;
        if (!C.dry) store_gated_l(o, inv, zl, (bf16*)C.QG + off() + (size_t)(wid * 32 + r32) * DI, r32, hi);
    }
};
__device__ __forceinline__ void swa_phase(Frame& F, const Args& a, int g, int dry) {
    int lane_ = pg8::hw_lane(), wave_ = F.wave; asm volatile("" : "+v"(lane_), "+s"(wave_));
    AttCtx C; C.QG = (const bf16*)(a.ws + WS_QG) + (size_t)g * MH * DI; C.Kb = (const bf16*)(a.ws + WS_S2); C.Vb = C.Kb + (size_t)MH * 256; C.Zb = (const bf16*)(a.ws + WS_S4); C.aux = a.in[30]; C.tab = nullptr; C.dry = dry;
    const int G = F.G, vcu = F.vcu;
    auto gen = [&](int i, SwaPol& P) -> bool {
        const int id = i * G + vcu; if (id >= HB * 32 * 8) return false;
        P.qb = (id + i) & 7; P.hq = (id >> 3) & 31; P.bl = id >> 8;
        P.tl0 = max(0, 4 * P.qb - 2); P.ntl = min(31, 4 * P.qb + 5) - P.tl0 + 1; P.sinkl2 = C.aux[P.hq] * LOG2E;
        return true; };
    att::run_stream1<SwaPol, 0>(F.lds, C, gen, wave_, lane_);
}

constexpr int NA_TAB_OFF = RING_BYTES + 512;
struct NaPol {
    static constexpr int EXTRA = 5, NM = 2;
    int bl, hq, qb, krow0, ntl, isctx;
    __device__ __forceinline__ size_t off() const { return ((size_t)bl * RB + (isctx ? 0 : CT + qb * 256)) * DI + hq * 64; }
    __device__ __forceinline__ Src src(const AttCtx& C) const { Src s; s.K[0] = C.Kb + hq * 64; s.K[1] = nullptr; s.V = C.Vb + hq * 64; s.ldk = DI; s.ldv = DI; return s; }
    __device__ __forceinline__ void prep(int ti, int wid, int r32, int hi, f32x16 (&negm)[2]) const {
        if (ti != 4) return;
        const int gc = 32 * (wid & 1) + r32, cs = min(max(gc - 8, 0), 48);
#pragma unroll
        for (int r = 0; r < 16; ++r) { const int kc = crow(r, hi);
            if (!(kc >= cs && kc < cs + 16)) negm[0][r] = -INFINITY;
            if (!(kc + 32 >= cs && kc + 32 < cs + 16)) negm[1][r] = -INFINITY; }
    }
    __device__ __forceinline__ int ntiles() const { return 4 + ntl; }
    __device__ __forceinline__ const bf16* qrow(const AttCtx& C, int wid) const { return C.QG + off() + (size_t)(wid * 32) * DI; }
    __device__ __forceinline__ void stage_extra(const AttCtx& C, LAS unsigned char* zl, int wid, int lane) const {
        att::dma_rows64(C.Zb + off() + (size_t)(wid * 32) * DI, DI, zl, lane);
        att::glds4s(C.aux + hq * 465, (unsigned)min(wid * 64 + lane, 464) * 4u, (unsigned)__builtin_amdgcn_readfirstlane((unsigned)(size_t)C.tab + wid * 256));
    }
    __device__ __forceinline__ size_t tile_row(int ti) const { return (size_t)bl * RB + (ti < 4 ? 64 * ti : CT + 64 * (krow0 + ti - 4)); }
    __device__ __forceinline__ bool needs(int ti, int wid) const { if (ti < 4) return true; const int gr = 4 * qb + (wid >> 1), rs = min(max(gr - 4, 0), 24), kr = krow0 + ti - 4; return kr >= rs && kr < rs + 8; }
    __device__ __forceinline__ int skip(int ti, int wid) const { return ti < 4 ? 0 : 1 + (wid & 1); }
    template <int SK> __device__ __forceinline__ void mask(const AttCtx& C, int ti, int wid, int r32, int hi, f32x16& p0, f32x16& p1) const {
        if (ti < 4) return;
        const int gr = 4 * qb + (wid >> 1), gc = 32 * (wid & 1) + r32, kr = krow0 + ti - 4;
        LAS const float* trow = C.tab + (kr - gr + 7) * 31 + 15 - gc;
#pragma unroll
        for (int r = 0; r < 16; ++r) { const int kc = crow(r, hi);
            if (att::sm_live0<SK>(r)) p0[r] = fmaf(trow[kc], LOG2E, p0[r]);
            if (att::sm_live1<SK>(r)) p1[r] = fmaf(trow[kc + 32], LOG2E, p1[r]);
            if ((r & 3) == 3) __builtin_amdgcn_sched_barrier(0); }
    }
    __device__ __forceinline__ void finish(const AttCtx& C, f32x16 (&o)[2], float m, float l, int wid, int r32, int hi, LAS const unsigned char* zl) const {
        const float inv = 1.f / (l + __shfl_xor(l, 32));
        if (!C.dry) store_gated_l(o, inv, zl, (bf16*)C.QG + off() + (size_t)(wid * 32 + r32) * DI, r32, hi);
    }
};
__device__ __forceinline__ void na_phase(Frame& F, const Args& a, int g, int dry) {
    int lane_ = pg8::hw_lane(), wave_ = F.wave; asm volatile("" : "+v"(lane_), "+s"(wave_));
    AttCtx C; C.QG = (const bf16*)(a.ws + WS_QG) + (size_t)g * MH * DI; C.Kb = (const bf16*)(a.ws + WS_S2); C.Vb = (const bf16*)(a.ws + WS_S3); C.Zb = (const bf16*)(a.ws + WS_S4); C.aux = a.in[27]; C.tab = (LAS const float*)(F.lds + NA_TAB_OFF); C.dry = dry;
    constexpr int NLAT = HB * 32 * 8, NCTX = HB * 32;
    const int G = F.G, vcu = F.vcu;
    auto gen = [&](int i, NaPol& P) -> bool {
        const int id = i * G + vcu; if (id >= NLAT + NCTX) return false;
        if (id < NLAT) { P.isctx = 0; P.qb = (id + i) & 7; P.hq = (id >> 3) & 31; P.bl = id >> 8; P.krow0 = min(max(4 * P.qb - 4, 0), 24); P.ntl = min(max(4 * P.qb + 3 - 4, 0), 24) + 7 - P.krow0 + 1; }
        else { const int j = id - NLAT; P.isctx = 1; P.qb = 0; P.hq = j & 31; P.bl = j >> 5; P.krow0 = 0; P.ntl = 0; }
        return true; };
    if (wave_ & 1) att::run_stream1<NaPol, 2>(F.lds, C, gen, wave_, lane_); else att::run_stream1<NaPol, 1>(F.lds, C, gen, wave_, lane_);
}

template <int COMP>
__device__ __forceinline__ void diff_unit(LAS unsigned char* lds, const Src& src, const bf16* Q  , const bf16* zb, bf16* gb, size_t trow0, int nt, float lam, float lam_init, const float* sg, int wid, int lane, int dry) {
    const int r32 = lane & 31, hi = lane >> 5, wq = wid & 3; constexpr int comp = COMP;
    constexpr int STG = 32768;
    att::dma_issue<128, 2>(src, trow0, lds, wid, lane);
    if (nt > 1) att::dma_issue<128, 2>(src, trow0 + 64, lds + STG, wid, lane);
    bf16x8 qf[4];
    { const bf16* qp = Q + (size_t)(wq * 32 + r32) * DI + comp * 64 + hi * 8;
#pragma unroll
      for (int d0 = 0; d0 < 4; ++d0) qf[d0] = *(const bf16x8*)(qp + d0 * 16); }
    f32x16 o[4];
#pragma unroll
    for (int d0 = 0; d0 < 4; ++d0) o[d0] = f32x16{};
    float m = -INFINITY, l = 0.f; f32x16 negm[1] = {f32x16{}};
    u32x4 pw[4], pwn[4];
    asm volatile("" : "+v"(qf[0]), "+v"(qf[1]), "+v"(qf[2]), "+v"(qf[3]));
    ATT_WAIT_BAR(0);
    if constexpr (COMP == 0) {
        int ic = 0;
        for (int ti = 0; ti < nt; ++ti) {
            LAS unsigned char* cur = lds + ic * STG; LAS unsigned char* prv = lds + ((ic + 3) & 3) * STG;
            if (ti >= 1 && ti + 1 < nt) att::dma_issue<128, 2>(src, trow0 + 64 * (ti + 1), lds + ((ic + 1) & 3) * STG, wid, lane);
            { f32x16 p0, p1; att::qk_tile(cur, qf, r32, hi, p0, p1, negm[0], negm[0]);
              if (ti > 0) att::pv_sm_tile<128, 1>(prv + 16384, lane, hi, pw, o, p0, p1, m, l, pwn, negm); else att::sm_alone<128, 1>(p0, p1, o, m, l, pwn, negm); }
#pragma unroll
            for (int k = 0; k < 4; ++k) pw[k] = pwn[k];
            ATT_WAIT_BAR(0);
            ic = (ic + 1) & 3;
        }
        att::pv_tile<128>(lds + ((ic + 3) & 3) * STG + 16384, lane, hi, pw, o);
    } else {
        f32x16 p0, p1;
        att::qk_tile(lds + 8192, qf, r32, hi, p0, p1, negm[0], negm[0]);
        ATT_WAIT_BAR(0);
        int ic = 1;
        for (int ti = 1; ti < nt; ++ti) {
            LAS unsigned char* cur = lds + ic * STG; LAS unsigned char* pv2 = lds + ((ic + 2) & 3) * STG;
            if (ti + 1 < nt) att::dma_issue<128, 2>(src, trow0 + 64 * (ti + 1), lds + ((ic + 1) & 3) * STG, wid, lane);
            if (ti >= 2) att::pv_sm_tile<128, 1>(pv2 + 16384, lane, hi, pw, o, p0, p1, m, l, pwn, negm); else att::sm_alone<128, 1>(p0, p1, o, m, l, pwn, negm);
#pragma unroll
            for (int k = 0; k < 4; ++k) pw[k] = pwn[k];
            att::qk_tile(cur + 8192, qf, r32, hi, p0, p1, negm[0], negm[0]);
            ATT_WAIT_BAR(0);
            ic = (ic + 1) & 3;
        }
        if (nt >= 2) att::pv_sm_tile<128, 1>(lds + ((ic + 2) & 3) * STG + 16384, lane, hi, pw, o, p0, p1, m, l, pwn, negm); else att::sm_alone<128, 1>(p0, p1, o, m, l, pwn, negm);
#pragma unroll
        for (int k = 0; k < 4; ++k) pw[k] = pwn[k];
        att::pv_tile<128>(lds + ((ic + 3) & 3) * STG + 16384, lane, hi, pw, o);
    }
    ATT_WAIT_BAR(0);
    const float inv = 1.f / (l + __shfl_xor(l, 32));
    LAS float* xb = (LAS float*)lds;
    if (comp == 1) {
#pragma unroll
        for (int d0 = 0; d0 < 4; ++d0)
#pragma unroll
            for (int r = 0; r < 16; ++r) xb[((wq * 64 + d0 * 16 + r) * 64) + lane] = o[d0][r] * inv;
    }
    __syncthreads();
    if (comp == 0 && !dry) {
        float ss = 0.f;
#pragma unroll
        for (int d0 = 0; d0 < 4; ++d0)
#pragma unroll
            for (int r = 0; r < 16; ++r) { const float v = o[d0][r] * inv - lam * xb[((wq * 64 + d0 * 16 + r) * 64) + lane]; o[d0][r] = v; ss += v * v; }
        ss += __shfl_xor(ss, 32);
        const float rs = rsqrtf(ss * (1.f / 128.f) + EPS) * (1.f - lam_init);
        const size_t ro = (size_t)(wq * 32 + r32) * DI;
#pragma unroll
        for (int d0 = 0; d0 < 4; ++d0)
#pragma unroll
            for (int i = 0; i < 4; ++i) { const int d = 32 * d0 + 8 * i + 4 * hi; const f32x4 gg = *(const f32x4*)(sg + d); const u32x2 zw = *(const u32x2*)(zb + ro + d);
                const float v0 = o[d0][4 * i] * rs * gg.x * silu(bflo(zw.x)), v1 = o[d0][4 * i + 1] * rs * gg.y * silu(bfhi(zw.x)), v2 = o[d0][4 * i + 2] * rs * gg.z * silu(bflo(zw.y)), v3 = o[d0][4 * i + 3] * rs * gg.w * silu(bfhi(zw.y));
                u32x2 w; w.x = att::cvtpk(v0, v1); w.y = att::cvtpk(v2, v3); *(u32x2*)(gb + ro + d) = w; }
    }
    asm volatile("s_waitcnt lgkmcnt(0)\n\ts_barrier" ::: "memory");
}
__device__ __forceinline__ void diff_phase(Frame& F, const Args& a, int g, int dry) {
#ifdef MK_TOUCH2
    {
        const int j = F.vcu & 31; unsigned accv = 0u;
        for (size_t off = ((size_t)j * NTHR + F.wave * 64 + pg8::hw_lane()) * 4096; off < (size_t)216 * MiB; off += (size_t)32 * NTHR * 4096) accv += *(const unsigned*)(a.ws + WS_S2 + off);
        for (size_t off = ((size_t)j * NTHR + F.wave * 64 + pg8::hw_lane()) * 4096; off < (size_t)72 * MiB; off += (size_t)32 * NTHR * 4096) accv += *(const unsigned*)(a.ws + WS_QG + (size_t)g * MH * DI * 2 + off);
        asm volatile("" :: "v"(accv));
    }
#endif
    int lane_ = pg8::hw_lane(), wave_ = F.wave; asm volatile("" : "+v"(lane_), "+s"(wave_));
    const bf16* QG = (const bf16*)(a.ws + WS_QG) + (size_t)g * MH * DI; const bf16* Kb = (const bf16*)(a.ws + WS_S2); const bf16* Vb = (const bf16*)(a.ws + WS_S3); const bf16* Zb = (const bf16*)(a.ws + WS_S4);
    const float lam_init = 0.8f - 0.6f * expf(-0.3f);
    float sa = 0.f, sb = 0.f;
    for (int i = 0; i < 64; ++i) { sa += a.in[20][i] * a.in[21][i]; sb += a.in[22][i] * a.in[23][i]; }
    const float lam = expf(sa) - expf(sb) + lam_init;
    constexpr int NLAT = HB * 16 * 16, NCTX = HB * 16 * 2;
    const int G = F.G, vcu = F.vcu; LAS unsigned char* lds = F.lds; const float* sg = a.in[24];
    auto units = [&](auto cc) {
        constexpr int COMP = decltype(cc)::value;
        for (int i = 0;; ++i) {
            const int id = i * G + vcu; if (id >= NLAT + NCTX) break;
            int bl, h, qb, nt; size_t row0;
            if (id < NLAT) { qb = id & 15; h = (id >> 4) & 15; bl = id >> 8; nt = RB / 64; row0 = (size_t)bl * RB + CT + qb * 128; }
            else { const int j = id - NLAT; qb = j & 1; h = (j >> 1) & 15; bl = j >> 5; nt = CT / 64; row0 = (size_t)bl * RB + qb * 128; }
            Src s; s.K[0] = Kb + (2 * h) * 64; s.K[1] = Kb + (2 * h + 1) * 64; s.V = Vb + h * 128; s.ldk = DI; s.ldv = DI;
            diff_unit<COMP>(lds, s, QG + row0 * DI + h * 128, Zb + row0 * DI + h * 128, (bf16*)QG + row0 * DI + h * 128, (size_t)bl * RB, nt, lam, lam_init, sg, wave_, lane_, dry);
        }
    };
    if (wave_ >> 2) units(std::integral_constant<int, 1>{}); else units(std::integral_constant<int, 0>{});
}
}
namespace mk {
typedef float f32x4v __attribute__((ext_vector_type(4)));
__device__ __forceinline__ void seq_bounds(int row, int& lo, int& hi) { const int rr = row % RB, b0 = row - rr; if (rr < CT) { lo = b0; hi = b0 + CT; } else { lo = b0 + CT; hi = b0 + RB; } }

#ifndef MK_GATES_Q
#define MK_GATES_Q 4
#endif
__device__ __forceinline__ void mlstm_gates_phase(Frame& F, const Args& a, int g) {
    int lane = pg8::hw_lane(), wave = F.wave; asm volatile("" : "+v"(lane), "+s"(wave));
    const bf16* XM = (const bf16*)(a.ws + WS_S2); const bf16* W2 = (const bf16*)(a.ws + WS_WG2);
    bf16* XC = g == 0 ? (bf16*)(a.ws + WS_QG) + (size_t)MH * DI : (bf16*)(a.ws + WS_H);
    const float* cw = a.in[9]; const float* cb = a.in[10]; const float* bg = a.in[15];
    LAS float* T = (LAS float*)F.lds;
    { const int tid = wave * 64 + lane;
      for (int i = tid; i < 5 * 2048 / 4; i += NTHR) *(LAS f32x4v*)(T + 4 * i) = *(const f32x4v*)(cw + 4 * i);
      for (int i = tid; i < 2048 / 4; i += NTHR) *(LAS f32x4v*)(T + 10240 + 4 * i) = *(const f32x4v*)(cb + 4 * i);
      __syncthreads(); }
    const int r = lane & 15, kq = lane >> 4;
    constexpr int GQ = MK_GATES_Q;
    const int gw = F.vcu * NWAVES + wave, NGW = F.G * NWAVES;
    for (int item = gw; item < 8 * (MH / 16); item += NGW) {
        const int grp = item >> 3, kh = item & 7;
        size_t goff = WS_GATES; if (kh == 1) goff = WS_GATES2; if (kh == 2) goff = WS_GATES3; if (kh == 3) goff = WS_GATES4; if (kh == 4) goff = WS_GATES5; if (kh == 5) goff = WS_GATES6; if (kh == 6) goff = WS_GATES7; if (kh == 7) goff = WS_GATES8;
        float* gates = (float*)(a.ws + goff);
        const int row = grp * 16 + r; int lo, hi; seq_bounds(row, lo, hi);
        pg8::f32x4 acc0 = {0.f, 0.f, 0.f, 0.f}, acc1 = {0.f, 0.f, 0.f, 0.f};
        for (int sb = 0; sb < 8 / GQ; ++sb) {
            u32x4 xr[GQ][5];
#pragma unroll
            for (int q = 0; q < GQ; ++q) { const int c0 = kh * 256 + (sb * GQ + q) * 32 + 8 * kq;
#pragma unroll
                for (int j = 0; j < 5; ++j) { const int tt = row + j - 2; xr[q][j] = (tt >= lo && tt < hi) ? *(const u32x4*)(XM + (size_t)tt * DI + c0) : (u32x4){0u, 0u, 0u, 0u}; }
            }
#pragma unroll
            for (int q = 0; q < GQ; ++q) { const int c0 = kh * 256 + (sb * GQ + q) * 32 + 8 * kq;
                const bf16x8 wf0 = *(const bf16x8*)(W2 + (size_t)r * 4096 + c0), wf1 = *(const bf16x8*)(W2 + (size_t)(r + 16) * 4096 + c0), wf2 = *(const bf16x8*)(W2 + (size_t)r * 4096 + 2048 + c0), wf3 = *(const bf16x8*)(W2 + (size_t)(r + 16) * 4096 + 2048 + c0);
                const f32x4v b0 = *(LAS const f32x4v*)(T + 10240 + c0), b1 = *(LAS const f32x4v*)(T + 10240 + c0 + 4);
                float av[8] = {b0.x, b0.y, b0.z, b0.w, b1.x, b1.y, b1.z, b1.w};
#pragma unroll
                for (int j = 0; j < 5; ++j) { const u32x4 x = xr[q][j];
                    const f32x4v w0 = *(LAS const f32x4v*)(T + j * DI + c0), w1 = *(LAS const f32x4v*)(T + j * DI + c0 + 4);
                    av[0] += bflo(x.x) * w0.x; av[1] += bfhi(x.x) * w0.y; av[2] += bflo(x.y) * w0.z; av[3] += bfhi(x.y) * w0.w;
                    av[4] += bflo(x.z) * w1.x; av[5] += bfhi(x.z) * w1.y; av[6] += bflo(x.w) * w1.z; av[7] += bfhi(x.w) * w1.w; }
                u32x4 xcw; xcw.x = att::cvtpk(silu(av[0]), silu(av[1])); xcw.y = att::cvtpk(silu(av[2]), silu(av[3])); xcw.z = att::cvtpk(silu(av[4]), silu(av[5])); xcw.w = att::cvtpk(silu(av[6]), silu(av[7]));
                *(u32x4*)(XC + (size_t)row * DI + c0) = xcw;
                const bf16x8 axc = __builtin_bit_cast(bf16x8, xcw), axm = __builtin_bit_cast(bf16x8, xr[q][2]);
                acc0 = __builtin_amdgcn_mfma_f32_16x16x32_bf16(axc, wf0, acc0, 0, 0, 0); acc1 = __builtin_amdgcn_mfma_f32_16x16x32_bf16(axc, wf1, acc1, 0, 0, 0);
                acc0 = __builtin_amdgcn_mfma_f32_16x16x32_bf16(axm, wf2, acc0, 0, 0, 0); acc1 = __builtin_amdgcn_mfma_f32_16x16x32_bf16(axm, wf3, acc1, 0, 0, 0); }
        }
        const float bg0 = kh == 0 ? bg[r] : 0.f, bg1 = kh == 0 ? bg[16 + r] : 0.f;
#pragma unroll
        for (int rg = 0; rg < 4; ++rg) { const size_t tk = (size_t)grp * 16 + 4 * kq + rg; gates[tk * 32 + r] = acc0[rg] + bg0; gates[tk * 32 + 16 + r] = acc1[rg] + bg1; }
    }
    __syncthreads();
}

#define ML_BAR() asm volatile("s_waitcnt lgkmcnt(0)\n\ts_barrier" ::: "memory")
#ifndef MK_SC_A
#define MK_SC_A 1
#endif
#ifndef MK_SC_B
#define MK_SC_B 1
#endif
constexpr int ML_QS = 0, ML_KS = 33792, ML_VS = 67584, ML_P = 84992, ML_HO = 94208, ML_F = 110592;
constexpr int ML_W1 = RING_BYTES + 512  , ML_WV = 115200  ;
constexpr int ML_KSTR = 528, ML_VSTR = 272, ML_PSTR = 144;
__device__ __forceinline__ int ml_row(int base, int dir, int s) { return base + (dir == 0 ? s : (s < CT ? CT - 1 - s : CT + (S - 1) - (s - CT))); }
__device__ __forceinline__ s16x4 ml_tr(LAS const unsigned char* p) { return __builtin_bit_cast(s16x4, __builtin_amdgcn_ds_read_tr16_b64_v4i16((LAS att::v4i16_t*)p)); }
__device__ __forceinline__ void mlstm_scan_phase(Frame& F, const Args& a, int g) {
    int tid0 = F.wave * 64 + pg8::hw_lane(); asm volatile("" : "+v"(tid0));
    const int wid = __builtin_amdgcn_readfirstlane(tid0 >> 6);
    const int u = F.vcu; if (u >= HB * 8 * 2 * 2) return;
    const int dvh = u & 1, dir = (u >> 1) & 1, h = (u >> 2) & 7, bl = u >> 5;
    const bf16* XM = (const bf16*)(a.ws + WS_S2); const float* gates = (const float*)(a.ws + WS_GATES); const float* gates2 = (const float*)(a.ws + WS_GATES2); const float* gates3 = (const float*)(a.ws + WS_GATES3); const float* gates4 = (const float*)(a.ws + WS_GATES4); const float* gates5 = (const float*)(a.ws + WS_GATES5); const float* gates6 = (const float*)(a.ws + WS_GATES6); const float* gates7 = (const float*)(a.ws + WS_GATES7); const float* gates8 = (const float*)(a.ws + WS_GATES8);
    const bf16* XC = g == 0 ? (const bf16*)(a.ws + WS_QG) + (size_t)MH * DI : (const bf16*)(a.ws + WS_H);
    bf16* Hd = dir == 0 ? (bf16*)(a.ws + WS_QG) + (size_t)g * MH * DI : (bf16*)(a.ws + WS_S4);
    const float* cw = a.in[9]; const float* cb = a.in[10]; const float* wq = a.in[11]; const float* wk = a.in[12]; const float* wv = a.in[13];
    LAS unsigned char* L = F.lds; LAS float* Ff = (LAS float*)(L + ML_F);
    pg8::f32x4 C[16];
#pragma unroll
    for (int i = 0; i < 16; ++i) C[i] = (pg8::f32x4){0.f, 0.f, 0.f, 0.f};
    int tid = tid0;
    if (tid < 256) { Ff[640 + tid] = 0.f; }
    {
        LAS float* W1 = (LAS float*)(L + ML_W1); LAS float* WV = (LAS float*)(L + ML_WV);
        for (int i = tid; i < 5 * 256; i += NTHR) W1[i] = cw[(i >> 8) * DI + h * 256 + (i & 255)];
        if (tid < 256) W1[1280 + tid] = cb[h * 256 + tid];
        for (int i = tid; i < 1024; i += NTHR) { W1[1536 + i] = wq[h * 1024 + i]; W1[2560 + i] = wk[h * 1024 + i]; WV[i] = wv[h * 1024 + i]; }
        __syncthreads();
    }
    LAS const float* W1 = (LAS const float*)(L + ML_W1); LAS const float* WV = (LAS const float*)(L + ML_WV);
    bf16x8 aq[2], ak[2], av_[2], aql[2], akl[2], avl[2];
    { const int o = tid0 & 15, g4 = (tid0 >> 4) & 3;
#pragma unroll
      for (int n = 0; n < 2; ++n) { const int bo = 4 * n + (o >> 2); u32x4 fq, fk, fv, lq, lk, lv; unsigned* pq = (unsigned*)&fq; unsigned* pk_ = (unsigned*)&fk; unsigned* pv_ = (unsigned*)&fv; unsigned* qq_ = (unsigned*)&lq; unsigned* qk_ = (unsigned*)&lk; unsigned* qv_ = (unsigned*)&lv;
#pragma unroll
          for (int jp = 0; jp < 4; ++jp) { float q2[2], k2[2], v2[2], q2l[2], k2l[2], v2l[2];
#pragma unroll
              for (int e = 0; e < 2; ++e) { const int j = 2 * jp + e, bi = 2 * g4 + (j >> 2); const bool nz = bi == bo; const int gb = wid * 8 + bo, idx = gb * 16 + (j & 3) * 4 + (o & 3);
                  q2[e] = nz ? W1[1536 + idx] : 0.f; k2[e] = nz ? W1[2560 + idx] * 0.0625f : 0.f; v2[e] = nz ? WV[idx] : 0.f;
                  q2l[e] = q2[e] - bf2f((unsigned short)f2bf(q2[e])); k2l[e] = k2[e] - bf2f((unsigned short)f2bf(k2[e])); v2l[e] = v2[e] - bf2f((unsigned short)f2bf(v2[e])); }
              pq[jp] = pk2(q2[0], q2[1]); pk_[jp] = pk2(k2[0], k2[1]); pv_[jp] = pk2(v2[0], v2[1]);
              qq_[jp] = pk2(q2l[0], q2l[1]); qk_[jp] = pk2(k2l[0], k2l[1]); qv_[jp] = pk2(v2l[0], v2l[1]); }
          aq[n] = __builtin_bit_cast(bf16x8, fq); ak[n] = __builtin_bit_cast(bf16x8, fk); av_[n] = __builtin_bit_cast(bf16x8, fv);
          aql[n] = __builtin_bit_cast(bf16x8, lq); akl[n] = __builtin_bit_cast(bf16x8, lk); avl[n] = __builtin_bit_cast(bf16x8, lv); } }
    const int base = bl * RB;
    u32x4 xw[8];
#define ML_LOADX(cc) do { const int rlo_ = dir ? ml_row(base, 1, (cc) * 64 + 63) : ml_row(base, 0, (cc) * 64); \
        const size_t o_ = (size_t)(rlo_ + (tid0 & 15)) * DI + h * 256 + wid * 32 + ((tid0 >> 4) & 3) * 8; \
        _Pragma("unroll") for (int i_ = 0; i_ < 4; ++i_) { xw[i_] = *(const u32x4*)(XM + o_ + (size_t)(16 * i_) * DI); xw[4 + i_] = *(const u32x4*)(XC + o_ + (size_t)(16 * i_) * DI); } } while (0)
    float gpre[16] = {0.f, 0.f, 0.f, 0.f, 0.f, 0.f, 0.f, 0.f, 0.f, 0.f, 0.f, 0.f, 0.f, 0.f, 0.f, 0.f};
#define ML_LOADG(cc) do { if (wid == 0) { const size_t gi_ = (size_t)ml_row(base, dir, (cc) * 64 + (tid0 & 63)) * 32 + (2 * dir) * 8 + h; \
        gpre[0] = gates[gi_]; gpre[1] = gates2[gi_]; gpre[2] = gates3[gi_]; gpre[3] = gates4[gi_]; gpre[4] = gates[gi_ + 8]; gpre[5] = gates2[gi_ + 8]; gpre[6] = gates3[gi_ + 8]; gpre[7] = gates4[gi_ + 8]; \
        gpre[8] = gates5[gi_]; gpre[9] = gates6[gi_]; gpre[10] = gates7[gi_]; gpre[11] = gates8[gi_]; gpre[12] = gates5[gi_ + 8]; gpre[13] = gates6[gi_ + 8]; gpre[14] = gates7[gi_ + 8]; gpre[15] = gates8[gi_ + 8]; } } while (0)
    ML_LOADX(0); ML_LOADG(0);
    for (int c = 0; c < RB / 64; ++c) {
        const int par = c & 1;
        tid = tid0; asm volatile("" : "+v"(tid));
        const int lane = tid & 63, l15 = lane & 15, gq = lane >> 4;
#pragma unroll 1
        for (int repA_ = 0; repA_ < MK_SC_A; ++repA_) {
        {
            const bool hasv = (wid >> 2) == dvh;
            const pg8::f32x4 z4 = {0.f, 0.f, 0.f, 0.f};
#pragma unroll
            for (int tt = 0; tt < 4; ++tt) {
                const bf16x8 bxm = __builtin_bit_cast(bf16x8, xw[tt]), bxc = __builtin_bit_cast(bf16x8, xw[4 + tt]);
                const int mrow = 16 * tt + l15, t = dir ? 63 - mrow : mrow;
#pragma unroll
                for (int n = 0; n < 2; ++n) {
                    const pg8::f32x4 dq = __builtin_amdgcn_mfma_f32_16x16x32_bf16(aq[n], bxc, __builtin_amdgcn_mfma_f32_16x16x32_bf16(aql[n], bxc, z4, 0, 0, 0), 0, 0, 0), dk = __builtin_amdgcn_mfma_f32_16x16x32_bf16(ak[n], bxc, __builtin_amdgcn_mfma_f32_16x16x32_bf16(akl[n], bxc, z4, 0, 0, 0), 0, 0, 0);
                    const int cl = wid * 32 + 16 * n + 4 * gq;
                    u32x2 w2; w2.x = att::cvtpk(dq[0], dq[1]); w2.y = att::cvtpk(dq[2], dq[3]); *(LAS u32x2*)(L + ML_QS + t * ML_KSTR + cl * 2) = w2;
                    w2.x = att::cvtpk(dk[0], dk[1]); w2.y = att::cvtpk(dk[2], dk[3]); *(LAS u32x2*)(L + ML_KS + t * ML_KSTR + cl * 2) = w2;
                    if (hasv) { const pg8::f32x4 dv = __builtin_amdgcn_mfma_f32_16x16x32_bf16(av_[n], bxm, __builtin_amdgcn_mfma_f32_16x16x32_bf16(avl[n], bxm, z4, 0, 0, 0), 0, 0, 0);
                        w2.x = att::cvtpk(dv[0], dv[1]); w2.y = att::cvtpk(dv[2], dv[3]); *(LAS u32x2*)(L + ML_VS + t * ML_VSTR + (cl & 127) * 2) = w2; }
                }
            }
        }
#if defined(MK_SC_G2)
        for (int repg_ = 0; repg_ < 2; ++repg_)
#endif
        if (wid == 0) {
            const float gi = ((gpre[0] + gpre[1]) + (gpre[2] + gpre[3])) + ((gpre[8] + gpre[9]) + (gpre[10] + gpre[11])), gf = ((gpre[4] + gpre[5]) + (gpre[6] + gpre[7])) + ((gpre[12] + gpre[13]) + (gpre[14] + gpre[15]));
            const float lf = fminf(gf, 0.f) - log1pf(__expf(-fabsf(gf)));
            float b = lf;
#pragma unroll
            for (int o = 1; o < 64; o <<= 1) { const float y = __shfl_up(b, o); if (lane >= o) b += y; }
            const float bend = __shfl(b, 63);
            Ff[lane] = b * LOG2E; Ff[64 + lane] = (gi - b) * LOG2E; Ff[128 + lane] = __expf(b); Ff[192 + lane] = __expf(bend - b + gi);
            if (lane == 0) Ff[576] = __expf(bend);
        }
        }
        ML_BAR();
#if defined(MK_SC_L2)
        if (c + 1 < RB / 64) { ML_LOADX(c + 1); ML_LOADG(c + 1); asm volatile("" : "+v"(xw[0]), "+v"(xw[1]), "+v"(xw[2]), "+v"(xw[3]), "+v"(xw[4]), "+v"(xw[5]), "+v"(xw[6]), "+v"(xw[7])); }
#endif
        if (c + 1 < RB / 64) { ML_LOADX(c + 1); ML_LOADG(c + 1); }
        for (int repB_ = 0; repB_ < MK_SC_B; ++repB_) {
        {
            const int si = wid >> 1;
            pg8::f32x4 st[2] = {{0.f, 0.f, 0.f, 0.f}, {0.f, 0.f, 0.f, 0.f}};
            LAS const unsigned char* kp = L + ML_KS + (16 * si + l15) * ML_KSTR + gq * 16;
            LAS const unsigned char* qp0 = L + ML_QS + (16 * (2 * (wid & 1)) + l15) * ML_KSTR + gq * 16;
#pragma unroll
            for (int ks = 0; ks < 8; ++ks) {
                const bf16x8 ka = *(LAS const bf16x8*)(kp + ks * 64);
                const bf16x8 q0 = *(LAS const bf16x8*)(qp0 + ks * 64), q1 = *(LAS const bf16x8*)(qp0 + 16 * ML_KSTR + ks * 64);
                st[0] = __builtin_amdgcn_mfma_f32_16x16x32_bf16(ka, q0, st[0], 0, 0, 0);
                st[1] = __builtin_amdgcn_mfma_f32_16x16x32_bf16(ka, q1, st[1], 0, 0, 0);
            }
            const f32x4v al = *(LAS const f32x4v*)(Ff + 64 + 16 * si + 4 * gq);
            const float alv[4] = {al.x, al.y, al.z, al.w};
#pragma unroll
            for (int e = 0; e < 2; ++e) {
                const int ti = 2 * (wid & 1) + e, t = 16 * ti + l15; const float bt = Ff[t];
                float pv[4], rsum = 0.f;
#pragma unroll
                for (int r = 0; r < 4; ++r) { const int s = 16 * si + 4 * gq + r; const float wgt = (s <= t) ? att::ex2(bt + alv[r]) : 0.f; pv[r] = st[e][r] * wgt; rsum += pv[r]; }
                u32x2 w2; w2.x = att::cvtpk(pv[0], pv[1]); w2.y = att::cvtpk(pv[2], pv[3]);
                *(LAS u32x2*)(L + ML_P + t * ML_PSTR + (16 * si + 4 * gq) * 2) = w2;
                rsum += __shfl_xor(rsum, 16); rsum += __shfl_xor(rsum, 32);
                if (gq == 0) Ff[320 + si * 64 + t] = rsum;
            }
        }
        {
            const int t = tid >> 3, part = tid & 7; LAS const float* np_ = Ff + 640 + par * 256 + part * 32; LAS const unsigned char* qrow = L + ML_QS + t * ML_KSTR + part * 64;
            float acc = 0.f;
#pragma unroll
            for (int i = 0; i < 4; ++i) { const u32x4 qw = *(LAS const u32x4*)(qrow + i * 16); const f32x4v n0 = *(LAS const f32x4v*)(np_ + i * 8), n1 = *(LAS const f32x4v*)(np_ + i * 8 + 4);
                acc += bflo(qw.x) * n0.x + bfhi(qw.x) * n0.y + bflo(qw.y) * n0.z + bfhi(qw.y) * n0.w + bflo(qw.z) * n1.x + bfhi(qw.z) * n1.y + bflo(qw.w) * n1.z + bfhi(qw.w) * n1.w; }
            acc += __shfl_xor(acc, 1); acc += __shfl_xor(acc, 2); acc += __shfl_xor(acc, 4);
            if (part == 0) Ff[256 + t] = acc * Ff[128 + t];
        }
        if (tid < 256) {
            float nn = Ff[576] * Ff[640 + par * 256 + tid];
#pragma unroll
            for (int s = 0; s < 64; s += 4) { const f32x4v w4 = *(LAS const f32x4v*)(Ff + 192 + s); LAS const unsigned char* kc = L + ML_KS + s * ML_KSTR + tid * 2;
                nn += (w4.x * bf2f(*(LAS const unsigned short*)kc) + w4.y * bf2f(*(LAS const unsigned short*)(kc + ML_KSTR))) + (w4.z * bf2f(*(LAS const unsigned short*)(kc + 2 * ML_KSTR)) + w4.w * bf2f(*(LAS const unsigned short*)(kc + 3 * ML_KSTR))); }
            Ff[640 + (par ^ 1) * 256 + tid] = nn;
        }
        }
        ML_BAR();
        {
            pg8::f32x4 y[4];
#if defined(MK_SC_SYNC)
            ML_BAR(); __syncthreads(); __syncthreads();
#endif
#if defined(MK_SC_QC2)
            for (int repq_ = 0; repq_ < 2; ++repq_)
#endif
            {
#pragma unroll
            for (int tt = 0; tt < 4; ++tt) y[tt] = (pg8::f32x4){0.f, 0.f, 0.f, 0.f};
            {
                u32x2 qa[2][4], qb[2][4];
#define ML_QRD(ks_, b_) do { _Pragma("unroll") for (int tt = 0; tt < 4; ++tt) { LAS const unsigned char* qp = L + ML_QS + (16 * tt + l15) * ML_KSTR + (32 * (ks_) + 4 * gq) * 2; qa[b_][tt] = *(LAS const u32x2*)qp; qb[b_][tt] = *(LAS const u32x2*)(qp + 32); } } while (0)
                ML_QRD(0, 0);
#pragma unroll
                for (int ks = 0; ks < 8; ++ks) {
                    if (ks + 1 < 8) ML_QRD(ks + 1, (ks + 1) & 1);
                    u32x4 cw4; cw4.x = att::cvtpk(C[2 * ks][0], C[2 * ks][1]); cw4.y = att::cvtpk(C[2 * ks][2], C[2 * ks][3]); cw4.z = att::cvtpk(C[2 * ks + 1][0], C[2 * ks + 1][1]); cw4.w = att::cvtpk(C[2 * ks + 1][2], C[2 * ks + 1][3]);
                    const bf16x8 cf = __builtin_bit_cast(bf16x8, cw4);
                    __builtin_amdgcn_sched_barrier(0);
#pragma unroll
                    for (int tt = 0; tt < 4; ++tt) { const u32x4 qq = {qa[ks & 1][tt].x, qa[ks & 1][tt].y, qb[ks & 1][tt].x, qb[ks & 1][tt].y};
                        y[tt] = __builtin_amdgcn_mfma_f32_16x16x32_bf16(__builtin_bit_cast(bf16x8, qq), cf, y[tt], 0, 0, 0); }
                    __builtin_amdgcn_sched_barrier(0);
                }
#undef ML_QRD
            }
            }
#pragma unroll
            for (int tt = 0; tt < 4; ++tt) { const f32x4v e4 = *(LAS const f32x4v*)(Ff + 128 + 16 * tt + 4 * gq); y[tt][0] *= e4.x; y[tt][1] *= e4.y; y[tt][2] *= e4.z; y[tt][3] *= e4.w; }
            bf16x8 vf[2];
            { LAS const unsigned char* vb = L + ML_VS + (8 * gq + (l15 >> 2)) * ML_VSTR + (16 * wid + 4 * (lane & 3)) * 2;
#pragma unroll
              for (int k2 = 0; k2 < 2; ++k2) { const s16x4 lo = ml_tr(vb + k2 * 32 * ML_VSTR), hi4 = ml_tr(vb + k2 * 32 * ML_VSTR + 4 * ML_VSTR); vf[k2] = (bf16x8){lo[0], lo[1], lo[2], lo[3], hi4[0], hi4[1], hi4[2], hi4[3]}; } }
#pragma unroll
            for (int k2 = 0; k2 < 2; ++k2)
#pragma unroll
                for (int tt = 0; tt < 4; ++tt) { const bf16x8 pa = *(LAS const bf16x8*)(L + ML_P + (16 * tt + l15) * ML_PSTR + (32 * k2 + 8 * gq) * 2);
                    y[tt] = __builtin_amdgcn_mfma_f32_16x16x32_bf16(pa, vf[k2], y[tt], 0, 0, 0); }
#pragma unroll
            for (int tt = 0; tt < 4; ++tt)
#pragma unroll
                for (int r = 0; r < 4; ++r) { const int t = 16 * tt + 4 * gq + r;
                    *(LAS unsigned short*)(L + ML_HO + t * 256 + (16 * wid + l15) * 2) = (unsigned short)f2bf(y[tt][r]); }
            const float ebend = Ff[576];
#pragma unroll
            for (int i = 0; i < 16; ++i) C[i] = C[i] * ebend;
            bf16x8 vw[2];
#pragma unroll
            for (int k2 = 0; k2 < 2; ++k2) { const f32x4v w0 = *(LAS const f32x4v*)(Ff + 192 + 32 * k2 + 8 * gq), w1 = *(LAS const f32x4v*)(Ff + 192 + 32 * k2 + 8 * gq + 4);
                const u32x4 vv = __builtin_bit_cast(u32x4, vf[k2]); u32x4 o;
                o.x = att::cvtpk(bflo(vv.x) * w0.x, bfhi(vv.x) * w0.y); o.y = att::cvtpk(bflo(vv.y) * w0.z, bfhi(vv.y) * w0.w); o.z = att::cvtpk(bflo(vv.z) * w1.x, bfhi(vv.z) * w1.y); o.w = att::cvtpk(bflo(vv.w) * w1.z, bfhi(vv.w) * w1.w);
                vw[k2] = __builtin_bit_cast(bf16x8, o); }
            LAS const unsigned char* kb = L + ML_KS + (8 * gq + (l15 >> 2)) * ML_KSTR + (4 * (lane & 3)) * 2;
            {
                s16x4 klo[2][2], khi[2][2];
#define ML_KRD(dt_, b_) do { _Pragma("unroll") for (int k2 = 0; k2 < 2; ++k2) { klo[b_][k2] = ml_tr(kb + k2 * 32 * ML_KSTR + (dt_) * 32); khi[b_][k2] = ml_tr(kb + k2 * 32 * ML_KSTR + 4 * ML_KSTR + (dt_) * 32); } } while (0)
                ML_KRD(0, 0);
#pragma unroll
                for (int dt = 0; dt < 16; ++dt) {
                    if (dt + 1 < 16) ML_KRD(dt + 1, (dt + 1) & 1);
                    __builtin_amdgcn_sched_barrier(0);
#pragma unroll
                    for (int k2 = 0; k2 < 2; ++k2) { const s16x4 lo = klo[dt & 1][k2], hi4 = khi[dt & 1][k2];
                        const bf16x8 ka = {lo[0], lo[1], lo[2], lo[3], hi4[0], hi4[1], hi4[2], hi4[3]};
                        C[dt] = __builtin_amdgcn_mfma_f32_16x16x32_bf16(ka, vw[k2], C[dt], 0, 0, 0); }
                    __builtin_amdgcn_sched_barrier(0);
                }
#undef ML_KRD
            }
        }
        ML_BAR();
#if defined(MK_SC_W2)
        for (int repw_ = 0; repw_ < 2; ++repw_)
#endif
#pragma unroll
        for (int it = 0; it < 2; ++it) { const int idx = tid + it * NTHR, t = idx >> 4, pc = idx & 15; const int row = ml_row(base, dir, c * 64 + t);
            const float den = Ff[256 + t] + (Ff[320 + t] + Ff[384 + t]) + (Ff[448 + t] + Ff[512 + t]);
            const float rd = 1.f / fmaxf(fabsf(den), 1.f);
            const u32x4 yv = *(LAS const u32x4*)(L + ML_HO + t * 256 + pc * 16); u32x4 hv;
            hv.x = att::cvtpk(bflo(yv.x) * rd, bfhi(yv.x) * rd); hv.y = att::cvtpk(bflo(yv.y) * rd, bfhi(yv.y) * rd); hv.z = att::cvtpk(bflo(yv.z) * rd, bfhi(yv.z) * rd); hv.w = att::cvtpk(bflo(yv.w) * rd, bfhi(yv.w) * rd);
            *(u32x4*)(Hd + (size_t)row * DI + h * 256 + dvh * 128 + pc * 8) = hv; }
    }
}

__device__ __forceinline__ void mlstm_out_phase(Frame& F, const Args& a, int g, int dry) {
    int lane = pg8::hw_lane(), wave = F.wave; asm volatile("" : "+v"(lane), "+s"(wave));
    const bf16* XC = g == 0 ? (const bf16*)(a.ws + WS_QG) + (size_t)MH * DI : (const bf16*)(a.ws + WS_H); const bf16* Z = (const bf16*)(a.ws + WS_S3); const bf16* HB2 = (const bf16*)(a.ws + WS_S4); bf16* HF = (bf16*)(a.ws + WS_QG) + (size_t)g * MH * DI;
    const float* ng = a.in[16]; const float* skip = a.in[17];
    const int gw = F.vcu * NWAVES + wave, NGW = F.G * NWAVES;
    for (int it0 = gw; it0 < MH * 8; it0 += 2 * NGW) {
        u32x2 hf[2], hb[2], xcw[2], zw[2]; f32x4v gg[2], sk[2]; size_t o[2];
#pragma unroll
        for (int u = 0; u < 2; ++u) { int it = it0 + u * NGW; if (it >= MH * 8) it = it0; const int row = it >> 3, h = it & 7, ch = h * 256 + lane * 4; o[u] = (size_t)row * DI + ch;
            hf[u] = *(const u32x2*)(HF + o[u]); hb[u] = *(const u32x2*)(HB2 + o[u]); xcw[u] = *(const u32x2*)(XC + o[u]); zw[u] = *(const u32x2*)(Z + o[u]);
            gg[u] = *(const f32x4v*)(ng + ch); sk[u] = *(const f32x4v*)(skip + ch); }
#pragma unroll
        for (int u = 0; u < 2; ++u) {
            const float hs[4] = {bflo(hf[u].x) + bflo(hb[u].x), bfhi(hf[u].x) + bfhi(hb[u].x), bflo(hf[u].y) + bflo(hb[u].y), bfhi(hf[u].y) + bfhi(hb[u].y)};
            const float mu = wave_sum((hs[0] + hs[1]) + (hs[2] + hs[3])) * (1.f / 256.f);
            const float d[4] = {hs[0] - mu, hs[1] - mu, hs[2] - mu, hs[3] - mu};
            const float rstd = rsqrtf(wave_sum((d[0] * d[0] + d[1] * d[1]) + (d[2] * d[2] + d[3] * d[3])) * (1.f / 256.f) + EPS);
            const float xcv[4] = {bflo(xcw[u].x), bfhi(xcw[u].x), bflo(xcw[u].y), bfhi(xcw[u].y)}, z[4] = {bflo(zw[u].x), bfhi(zw[u].x), bflo(zw[u].y), bfhi(zw[u].y)};
            const float ggv[4] = {gg[u].x, gg[u].y, gg[u].z, gg[u].w}, skv[4] = {sk[u].x, sk[u].y, sk[u].z, sk[u].w};
            float ov[4];
#pragma unroll
            for (int i = 0; i < 4; ++i) ov[i] = (d[i] * rstd * ggv[i] + skv[i] * xcv[i]) * silu(z[i]);
            u32x2 w; w.x = att::cvtpk(ov[0], ov[1]); w.y = att::cvtpk(ov[2], ov[3]); if (!dry && (u == 0 || it0 + NGW < MH * 8)) *(u32x2*)(HF + o[u]) = w;
        }
    }
}
}
namespace mk {
enum { P_PRO = 0, P_PRO2 = 1, P_NORM0 = 2, P_L0 = 3  , P_OUT0 = 11, P_NORM1 = 12, P_L1 = 13  , P_OUT1 = 17, P_NORM2 = 18, P_L2 = 19  , P_OUT2 = 23, P_NORM3 = 24, P_L3 = 25  , P_OUT3 = 29, P_FINAL = 30, P_END = 31 };

__global__ void __launch_bounds__(NTHR, 2) mega(Args a) {
    extern __shared__ __attribute__((aligned(16))) unsigned char lds_raw[];
    Frame F;
    F.lds = (LAS unsigned char*)lds_raw;
    F.wave = __builtin_amdgcn_readfirstlane((int)threadIdx.x >> 6); F.lane = pg8::hw_lane(); F.tid = F.wave * 64 + F.lane;
    F.G = gridDim.x; { const int bx = blockIdx.x; F.vcu = (F.G % 8 == 0) ? (bx % 8) * (F.G / 8) + bx / 8 : bx; }
    volatile LAS unsigned* MISC = (volatile LAS unsigned*)(F.lds + MISC_OFF);
    for (int u = F.tid; u < (LDS_BYTES - RING_BYTES) / 4; u += NTHR) ((LAS unsigned*)(F.lds + RING_BYTES))[u] = 0u;
    __syncthreads();
    XcdBarrier bar = xcd_barrier_post((unsigned*)(a.ws + WS_CTL) + CW_BAR, MISC + 8, (unsigned)F.wave);
    const int lo = a.ph_lo, hi = a.ph_hi;
#ifndef MK_REP_GEMM
#define MK_REP_GEMM 1
#endif
#ifndef MK_REP_ATT
#define MK_REP_ATT 1
#endif
#ifndef MK_REP_MISC
#define MK_REP_MISC 1
#endif
#ifndef MK_GEMM_ALIGN
#define MK_GEMM_ALIGN true
#endif
#ifndef MK_GEMM_SP2
#define MK_GEMM_SP2 true
#endif
#ifndef MK_REP_WC
#define MK_REP_WC 1
#endif
#ifndef MK_REP_SYNC
#define MK_REP_SYNC 0
#endif
#ifndef MK_REP_DIFF
#define MK_REP_DIFF MK_REP_ATT
#endif
#ifndef MK_REP_NA
#define MK_REP_NA MK_REP_ATT
#endif
#ifndef MK_REP_SWA
#define MK_REP_SWA MK_REP_ATT
#endif
#ifndef MK_REP_SCAN
#define MK_REP_SCAN 1
#endif
#ifndef MK_REP_GATES
#define MK_REP_GATES MK_REP_SCAN
#endif
#ifndef MK_SITES
#define MK_SITES 0xFFFFFFFFu
#endif
#define ON(b) (((MK_SITES) >> (b)) & 1u)
#ifdef MK_PARTIAL
#define IN(k) (lo <= (k) && (k) < hi)
#else
#define IN(k) true
#endif
#ifndef MK_REP_BAR
#define MK_REP_BAR 1
#endif
#ifdef MK_TP
    long long tp_acc = 0, tp_prev = wall_clock64(), tp_t0 = 0;
#define TP_PRE(k) tp_t0 = wall_clock64();
#define TP_POST(k) { long long n_ = wall_clock64(); if ((MK_TP_MASK >> (k)) & 1u) tp_acc += n_ - (MK_TP == 1 ? tp_t0 : tp_prev); tp_prev = n_; }
#else
#define TP_PRE(k)
#define TP_POST(k)
#endif
#define SEAM(k) do { if (IN(k) && IN((k) + 1)) { TP_PRE(k) for (int rb_ = 0; rb_ < MK_REP_BAR; ++rb_) xcd_barrier(bar); TP_POST(k) } } while (0)
    const int gw = F.vcu * NWAVES + F.wave, NGW = F.G * NWAVES;
#define WSB ([&]() { unsigned char* p_ = a.ws; asm volatile("" : "+s"(p_)); return p_; }())
#define xs (a.out)
#define ctxs ((float*)(WSB + WS_CTXS))
#define xsb ((bf16*)a.out)
#define ctxb ((bf16*)(WSB + WS_CTXS))
#define x3b ((bf16*)(WSB + WS_S3))
#define mod ((const float*)(WSB + WS_MOD))
#define WinA ((bf16*)(WSB + WS_WIN))
#define WoutA ((bf16*)(WSB + WS_WOUT))
#define WinB ((bf16*)(WSB + WS_W2))
#define WoutB ((bf16*)(WSB + WS_W2 + 16 * MiB))
#define H ((bf16*)(WSB + WS_H))
#define QG ((bf16*)(WSB + WS_QG))
#define ssq ((float*)(WSB + WS_SSQ))
#define shw ((const float*)(WSB + WS_SHW))
#define S2 ((bf16*)(WSB + WS_S2))
#define S3 ((bf16*)(WSB + WS_S3))
#define S4 ((bf16*)(WSB + WS_S4))
#define rope ((const float*)(WSB + WS_ROPE))
    const float QSC = 0.125f * LOG2E;

    if (ON(0) && IN(P_PRO)) prologue_phase(F, a);
    SEAM(P_PRO);
    if (ON(0) && IN(P_PRO2)) { prologue2_phase(F, a); for (int rw_ = 0; rw_ < MK_REP_WC; ++rw_) wconv(F, a.in[8], 4096, a.in[18], WinA, WoutA, gw, NGW); }
    SEAM(P_PRO2);
    if (ON(1) && IN(P_NORM0)) { for (int rep = 0; rep < MK_REP_MISC; ++rep) norm_phase(F, a.in[0], a.in[2], a.in[4], mod, H); }
    SEAM(P_NORM0);
#if MK_HAVE_L0
    for (int g = 0; g < 2; ++g) {
        if (ON(2) && IN(P_L0 + 4 * g)) {
            pg8::Gemm gm{H + (size_t)g * MH * D, WinA, MH, 4096, D}; pg8::StaticOrder So; So.init(MH, 4096, F.G, (int)blockIdx.x);
            EpiProj<false> E{S2, S3, S3, S3, DI, DI, DI, DI, 8, 16, 16, 0u, 1.f, rope, nullptr, nullptr, 0};
            for (int rep = 0; rep < MK_REP_GEMM; ++rep) { if (MK_REP_SYNC && rep) xcd_barrier(bar); pg8::gemm_phase<EpiProj<false>, pg8::StaticOrder, MK_GEMM_ALIGN, MK_GEMM_SP2>(F.lds, gm, So, E, F.wave); }
        }
        SEAM(P_L0 + 4 * g);
        if (ON(17) && IN(P_L0 + 4 * g + 1)) for (int rep = 0; rep < MK_REP_GATES; ++rep) mlstm_gates_phase(F, a, g);
        SEAM(P_L0 + 4 * g + 1);
        if (ON(18) && IN(P_L0 + 4 * g + 2)) for (int rep = 0; rep < MK_REP_SCAN; ++rep) mlstm_scan_phase(F, a, g);
        SEAM(P_L0 + 4 * g + 2);
        if (ON(19) && IN(P_L0 + 4 * g + 3)) for (int rep = 0; rep < MK_REP_MISC; ++rep) mlstm_out_phase(F, a, g, rep + 1 < MK_REP_MISC);
        SEAM(P_L0 + 4 * g + 3);
    }
#endif
    constexpr int RHEAD = 128 * 256;
    if (ON(3) && IN(P_OUT0)) {
        pg8::Gemm gm{QG, WoutA, MT, D, DI}; pg8::StaticOrder So; So.init(RHEAD, D, F.G, (int)blockIdx.x);
        for (int rep = 0; rep < MK_REP_GEMM; ++rep) { if (MK_REP_SYNC && rep) xcd_barrier(bar); EpiResidT<float, bf16> E{a.in[0], a.in[2], xsb, ctxb, mod, 1, rep + 1 < MK_REP_GEMM, nullptr, nullptr, nullptr, nullptr};
        pg8::gemm_phase<EpiResidT<float, bf16>, pg8::StaticOrder, MK_GEMM_ALIGN, MK_GEMM_SP2>(F.lds, gm, So, E, F.wave); }
    }
    SEAM(P_OUT0);
    if (ON(3) && IN(P_OUT0)) {
        if (blockIdx.x < 64) { pg8::Gemm gm{QG, WoutA, MT, D, DI}; OutTailOrder So; So.init(F.G, (int)blockIdx.x); EpiResidT<float, bf16> E{a.in[0], a.in[2], xsb, ctxb, mod, 1, 0, nullptr, nullptr, nullptr, nullptr};
            pg8::gemm_phase<EpiResidT<float, bf16>, OutTailOrder, MK_GEMM_ALIGN, MK_GEMM_SP2>(F.lds, gm, So, E, F.wave); }
        else { wconv(F, a.in[19], 8192, a.in[25], WinB, WoutB, ((int)blockIdx.x - 64) * NWAVES + F.wave, (F.G - 64) * NWAVES);
            if (ON(4)) norm_phase(F, xsb, ctxb, a.in[4] + 1024, mod + 17 * 3072, H, 0, RHEAD, 64); }
    }
    SEAM(P_OUT0);
    for (int g = 0; g < 2; ++g) {
        if (ON(5) && IN(P_L1 + 2 * g)) {
            if (g == 0 && ON(4)) norm_phase(F, xsb, ctxb, a.in[4] + 1024, mod + 17 * 3072, H, RHEAD, MT);
            pg8::Gemm gm{H + (size_t)g * MH * D, WinB, MH, 8192, D}; pg8::StaticOrder So; So.init(MH, 8192, F.G, (int)blockIdx.x);
            EpiProj<true, false> E{QG + (size_t)g * MH * DI, S2, S3, S4, DI, DI, DI, DI, 8, 16, 24, 3u, QSC, rope, ssq, shw, g * MH};
#ifdef MK_STAGGER
            if (blockIdx.x >= 128) { const long long t0_ = wall_clock64(); while (wall_clock64() - t0_ < MK_STAGGER) __builtin_amdgcn_s_sleep(8); }
#endif
            for (int rep = 0; rep < MK_REP_GEMM; ++rep) { if (MK_REP_SYNC && rep) xcd_barrier(bar); pg8::gemm_phase<EpiProj<true, false>, pg8::StaticOrder, MK_GEMM_ALIGN, MK_GEMM_SP2>(F.lds, gm, So, E, F.wave); }
        }
        SEAM(P_L1 + 2 * g);
        if (ON(6) && IN(P_L1 + 2 * g + 1)) for (int rep = 0; rep < MK_REP_DIFF; ++rep) { if (MK_REP_SYNC && rep) xcd_barrier(bar); diff_phase(F, a, g, rep + 1 < MK_REP_DIFF); }
        SEAM(P_L1 + 2 * g + 1);
    }
    if (ON(7) && IN(P_OUT1)) {
        pg8::Gemm gm{QG, WoutB, MT, D, DI}; pg8::StaticOrder So; So.init(RHEAD, D, F.G, (int)blockIdx.x);
        for (int rep = 0; rep < MK_REP_GEMM; ++rep) { if (MK_REP_SYNC && rep) xcd_barrier(bar); EpiResidT<bf16, bf16> E{xsb, ctxb, xsb, ctxb, mod + 17 * 3072, 1, rep + 1 < MK_REP_GEMM, nullptr, nullptr, nullptr, nullptr};
        pg8::gemm_phase<EpiResidT<bf16, bf16>, pg8::StaticOrder, MK_GEMM_ALIGN, MK_GEMM_SP2>(F.lds, gm, So, E, F.wave); }
    }
    SEAM(P_OUT1);
    if (ON(7) && IN(P_OUT1)) {
        if (blockIdx.x < 64) { pg8::Gemm gm{QG, WoutB, MT, D, DI}; OutTailOrder So; So.init(F.G, (int)blockIdx.x); EpiResidT<bf16, bf16> E{xsb, ctxb, xsb, ctxb, mod + 17 * 3072, 1, 0, nullptr, nullptr, nullptr, nullptr};
            pg8::gemm_phase<EpiResidT<bf16, bf16>, OutTailOrder, MK_GEMM_ALIGN, MK_GEMM_SP2>(F.lds, gm, So, E, F.wave); }
        else { wconv(F, a.in[26], 8192, a.in[28], WinA, WoutA, ((int)blockIdx.x - 64) * NWAVES + F.wave, (F.G - 64) * NWAVES);
            if (ON(8)) norm_phase(F, xsb, ctxb, a.in[4] + 2048, mod + 2 * 17 * 3072, H, 0, RHEAD, 64); }
    }
    SEAM(P_OUT1);
    for (int g = 0; g < 2; ++g) {
        if (ON(9) && IN(P_L2 + 2 * g)) {
            if (g == 0 && ON(8)) norm_phase(F, xsb, ctxb, a.in[4] + 2048, mod + 2 * 17 * 3072, H, RHEAD, MT);
            pg8::Gemm gm{H + (size_t)g * MH * D, WinA, MH, 8192, D}; pg8::StaticOrder So; So.init(MH, 8192, F.G, (int)blockIdx.x);
            EpiProj<false, false> E{QG + (size_t)g * MH * DI, S2, S3, S4, DI, DI, DI, DI, 8, 16, 24, 0u, QSC, rope, ssq, shw + 17 * 8192, g * MH};
#ifdef MK_STAGGER
            if (blockIdx.x >= 128) { const long long t0_ = wall_clock64(); while (wall_clock64() - t0_ < MK_STAGGER) __builtin_amdgcn_s_sleep(8); }
#endif
            for (int rep = 0; rep < MK_REP_GEMM; ++rep) { if (MK_REP_SYNC && rep) xcd_barrier(bar); pg8::gemm_phase<EpiProj<false, false>, pg8::StaticOrder, MK_GEMM_ALIGN, MK_GEMM_SP2>(F.lds, gm, So, E, F.wave); }
        }
        SEAM(P_L2 + 2 * g);
        if (ON(10) && IN(P_L2 + 2 * g + 1)) for (int rep = 0; rep < MK_REP_NA; ++rep) { if (MK_REP_SYNC && rep) xcd_barrier(bar); na_phase(F, a, g, rep + 1 < MK_REP_NA); }
        SEAM(P_L2 + 2 * g + 1);
    }
    if (ON(11) && IN(P_OUT2)) {
        pg8::Gemm gm{QG, WoutA, MT, D, DI}; pg8::StaticOrder So; So.init(RHEAD, D, F.G, (int)blockIdx.x);
        for (int rep = 0; rep < MK_REP_GEMM; ++rep) { if (MK_REP_SYNC && rep) xcd_barrier(bar); EpiResidT<bf16, bf16> E{xsb, ctxb, x3b, ctxb, mod + 2 * 17 * 3072, 1, rep + 1 < MK_REP_GEMM, nullptr, nullptr, nullptr, nullptr};
        pg8::gemm_phase<EpiResidT<bf16, bf16>, pg8::StaticOrder, MK_GEMM_ALIGN, MK_GEMM_SP2>(F.lds, gm, So, E, F.wave); }
    }
    SEAM(P_OUT2);
    if (ON(11) && IN(P_OUT2)) {
        if (blockIdx.x < 64) { pg8::Gemm gm{QG, WoutA, MT, D, DI}; OutTailOrder So; So.init(F.G, (int)blockIdx.x); EpiResidT<bf16, bf16> E{xsb, ctxb, x3b, ctxb, mod + 2 * 17 * 3072, 1, 0, nullptr, nullptr, nullptr, nullptr};
            pg8::gemm_phase<EpiResidT<bf16, bf16>, OutTailOrder, MK_GEMM_ALIGN, MK_GEMM_SP2>(F.lds, gm, So, E, F.wave); }
        else { wconv(F, a.in[29], 4608, a.in[31], WinB, WoutB, ((int)blockIdx.x - 64) * NWAVES + F.wave, (F.G - 64) * NWAVES);
            if (ON(12)) norm_phase(F, x3b, ctxb, a.in[4] + 3072, mod + 3 * 17 * 3072, H, 0, RHEAD, 64); }
    }
    SEAM(P_OUT2);
    for (int g = 0; g < 2; ++g) {
        if (ON(13) && IN(P_L3 + 2 * g)) {
            if (g == 0 && ON(12)) norm_phase(F, x3b, ctxb, a.in[4] + 3072, mod + 3 * 17 * 3072, H, RHEAD, MT);
            pg8::Gemm gm{H + (size_t)g * MH * D, WinB, MH, 4608, D}; L3Order So; So.init(F.G, (int)blockIdx.x);
            EpiProj<true, false> E{QG + (size_t)g * MH * DI, S2, S2 + (size_t)MH * 256, S4, DI, 256, 256, DI, 8, 9, 10, 3u, QSC, rope, ssq, shw + 2 * 17 * 8192, g * MH};
            for (int rep = 0; rep < MK_REP_GEMM; ++rep) { if (MK_REP_SYNC && rep) xcd_barrier(bar); pg8::gemm_phase<EpiProj<true, false>, L3Order, MK_GEMM_ALIGN, MK_GEMM_SP2>(F.lds, gm, So, E, F.wave); }
        }
        SEAM(P_L3 + 2 * g);
        if (ON(14) && IN(P_L3 + 2 * g + 1)) for (int rep = 0; rep < MK_REP_SWA; ++rep) { if (MK_REP_SYNC && rep) xcd_barrier(bar); swa_phase(F, a, g, rep + 1 < MK_REP_SWA); }
        SEAM(P_L3 + 2 * g + 1);
    }
    if (ON(15) && IN(P_OUT3)) {
        pg8::Gemm gm{QG, WoutB, MT, D, DI}; LatOnlyOrder So; So.init(F.G, (int)blockIdx.x);
        for (int rep = 0; rep < MK_REP_GEMM; ++rep) { if (MK_REP_SYNC && rep) xcd_barrier(bar); EpiResidT<bf16, float> E{x3b, ctxb, xs, ctxs, mod + 3 * 17 * 3072, 0, rep + 1 < MK_REP_GEMM, nullptr, nullptr, nullptr, nullptr};
        pg8::gemm_phase<EpiResidT<bf16, float>, LatOnlyOrder, MK_GEMM_ALIGN, MK_GEMM_SP2>(F.lds, gm, So, E, F.wave); }
    }
    SEAM(P_OUT3);
    if (ON(16) && IN(P_FINAL)) final_norm_phase(F, xs, a.in[7]);
#ifdef MK_TP
    {
        if (MK_TP == 2) TP_POST(P_FINAL)
        unsigned long long* tpw = (unsigned long long*)(a.ws + WS_CTL + 32768);
        if (F.wave == 0 && pg8::hw_lane() == 0) __hip_atomic_fetch_add(tpw, (unsigned long long)tp_acc, __ATOMIC_RELAXED, __HIP_MEMORY_SCOPE_AGENT);
        xcd_barrier(bar);
        const unsigned long long sum = __hip_atomic_load(tpw, __ATOMIC_RELAXED, __HIP_MEMORY_SCOPE_AGENT);
        const long long wait = (long long)(sum / 256) * MK_TP_K, ts = wall_clock64();
        while (wall_clock64() - ts < wait) __builtin_amdgcn_s_sleep(32);
    }
#endif
#undef IN
#undef SEAM
#undef WSB
#undef xs
#undef ctxs
#undef xsb
#undef ctxb
#undef x3b
#undef mod
#undef WinA
#undef WoutA
#undef WinB
#undef WoutB
#undef H
#undef QG
#undef ssq
#undef shw
#undef S2
#undef S3
#undef S4
#undef rope
}

inline void launch_mega(void* const* d_in, void* d_out, void* d_ws, int lo, int hi, hipStream_t stream) {
    static int inited = 0;
    if (!inited) { (void)hipFuncSetAttribute((const void*)mega, hipFuncAttributeMaxDynamicSharedMemorySize, LDS_BYTES); inited = 1; }
    (void)hipMemsetAsync((char*)d_ws + WS_CTL, 0, CTL_BYTES, stream);
    Args a{};
    for (int i = 0; i < 32; ++i) a.in[i] = (const float*)d_in[i];
    a.out = (float*)d_out; a.ws = (unsigned char*)d_ws; a.ph_lo = lo; a.ph_hi = hi;
    hipLaunchKernelGGL(mega, dim3(256), dim3(NTHR), LDS_BYTES, stream, a);
}
}
extern "C" void kernel_launch(void* const* d_in, const int* in_sizes, int n_in, void* d_out, int out_size, void* d_ws, size_t ws_size, hipStream_t stream) {
    mk::launch_mega(d_in, d_out, d_ws, mk::P_PRO, mk::P_END, stream);
}
```

```cpp
#include <hip/hip_runtime.h>
#include <cstdint>
#include <cstdio>
#include <cmath>
#define MK_HAVE_L0 1
namespace pg8 {
#define PG8_LAS __attribute__((address_space(3)))
typedef unsigned short bf16_t;
typedef short bf16x8 __attribute__((ext_vector_type(8)));
typedef float f32x4 __attribute__((ext_vector_type(4)));
typedef unsigned u32x4 __attribute__((ext_vector_type(4)));
__device__ __forceinline__ int hw_lane() { int l; asm volatile("v_mbcnt_lo_u32_b32 %0, -1, 0\n\tv_mbcnt_hi_u32_b32 %0, -1, %0" : "=v"(l)); return l; }
constexpr int BM = 256, BK = 64, HALF = 128, HTB = HALF * BK * 2  , STAGE_BYTES = 8 * HTB, NXCD = 8, WGM = 8;

__host__ __device__ __forceinline__ int lds_byte(int r, int c) { const int st = (r >> 4) * 2 + (c >> 5), rr = r & 15, cc = c & 31, ob = rr * 64 + cc * 2; return st * 1024 + (ob ^ (((ob >> 9) & 1) << 5)); }
__host__ __device__ __forceinline__ void stage_rc(int b, int& R, int& C) { const int st = b / 1024, sb = b % 1024, swz = sb ^ (((sb >> 9) & 1) << 5); R = (st >> 1) * 16 + swz / 64; C = (st & 1) * 32 + (swz % 64) / 2; }
__host__ __device__ __forceinline__ int perm32(int rho) { const int n = rho >> 4, i = rho & 15; return 8 * (i >> 2) + 4 * n + (i & 3); }

struct Unit { int pm, pn; };
struct Gemm { const bf16_t* A; const bf16_t* Bt; int M, N, K; };

struct StaticOrder {
    int nM, nN, nwg, G, c;
    __host__ __device__ void init(int M, int N, int G_, int c_) { nM = M / BM; nN = N / BM; nwg = nM * nN; G = G_; c = c_; }
    __host__ __device__ bool next(int i, Unit& u) const {
        const long L = (long)i * G + c; if (L >= nwg) return false;
        int wgid = (int)L; { const int q = nwg / NXCD, r = nwg % NXCD, xcd = wgid % NXCD, off = wgid / NXCD; wgid = (xcd < r ? xcd * (q + 1) : r * (q + 1) + (xcd - r) * q) + off; }
        const int nig = WGM * nN, gid = wgid / nig, fm = gid * WGM, gsz = (nM - fm) < WGM ? (nM - fm) : WGM;
        u.pm = fm + ((wgid % nig) % gsz); u.pn = (wgid % nig) / gsz; return true;
    }
    __device__ __forceinline__ void a_ready(const Unit&) const {}
    __device__ __forceinline__ void done(const Unit&) const {}
};

__device__ __forceinline__ unsigned cvt_pk_bf16(float lo, float hi) { unsigned r; asm volatile("v_cvt_pk_bf16_f32 %0, %1, %2" : "=v"(r) : "v"(lo), "v"(hi)); return r; }
typedef float f32x2 __attribute__((ext_vector_type(2)));
template <class Epi, class Sched, bool ALIGN_EPI = false, bool SP2 = false>
__device__ __forceinline__ void gemm_phase(PG8_LAS unsigned char* lds, const Gemm g, const Sched& S, const Epi& E, int wave_id) {
    int tid_ = wave_id * 64 + hw_lane(); asm volatile("" : "+v"(tid_));
    const int tid = tid_, wid = __builtin_amdgcn_readfirstlane(tid >> 6), lane = tid & 63, wr = wid >> 2, wc = wid & 3, fr = lane & 15, fq = lane >> 4;
    const int K = g.K, nt = K / BK;
    unsigned voffA[2], voffB[2];
#pragma unroll
    for (int i = 0; i < 2; ++i) { int R, C; stage_rc(tid * 16 + i * 8192, R, C); const int Rb = Epi::PERM ? ((R & ~31) + perm32(R & 31)) : R;
        voffA[i] = (unsigned)(R * K + C) * 2u; voffB[i] = (unsigned)(Rb * K + C) * 2u; }
    const size_t kstep = (size_t)(BK * 2);
    const size_t hstep = (size_t)HALF * K * 2;
    const size_t tstep = 2 * hstep;
    const unsigned ldsw = (unsigned)wid * 1024u;
    const int aoff = lds_byte(wr * 64 + fr, fq * 8), boff = lds_byte(wc * 32 + fr, fq * 8);
#define PG8_SA(b, h) (((b) * 2 + (h)) * HTB)
#define PG8_SB(b, h) ((4 + (b) * 2 + (h)) * HTB)
#define PG8_STAGE(bufoff, gbase, voff) do { _Pragma("unroll") for (int _i = 0; _i < 2; ++_i) \
        __builtin_amdgcn_global_load_lds((const unsigned*)((const char*)(gbase) + (voff)[_i]), (PG8_LAS unsigned*)(lds + (bufoff) + ldsw + _i * 8192), 16, 0, 0); } while (0)
#define PG8_LDA(dst, b, h) do { _Pragma("unroll") for (int m = 0; m < 4; ++m) _Pragma("unroll") for (int k = 0; k < 2; ++k) dst[m][k] = *(const PG8_LAS bf16x8*)(lds + PG8_SA(b, h) + aoff + m * 2048 + k * 1024); } while (0)
#define PG8_LDB(dst, b, h) do { _Pragma("unroll") for (int n = 0; n < 2; ++n) _Pragma("unroll") for (int k = 0; k < 2; ++k) dst[n][k] = *(const PG8_LAS bf16x8*)(lds + PG8_SB(b, h) + boff + n * 2048 + k * 1024); } while (0)
#define PG8_MMA(ai, bj, At, Bt) do { __builtin_amdgcn_s_setprio(1); _Pragma("unroll") for (int m = 0; m < 4; ++m) _Pragma("unroll") for (int n = 0; n < 2; ++n) _Pragma("unroll") for (int k = 0; k < 2; ++k) \
        acc[ai][bj][m][n] = __builtin_amdgcn_mfma_f32_16x16x32_bf16(Bt[n][k], At[m][k], acc[ai][bj][m][n], 0, 0, 0); __builtin_amdgcn_s_setprio(0); } while (0)
#define PG8_WAIT_V(n) asm volatile("s_waitcnt vmcnt(" #n ")" ::: "memory")
#define PG8_WAIT_L(n) asm volatile("s_waitcnt lgkmcnt(" #n ")" ::: "memory")
#define PG8_BAR __builtin_amdgcn_s_barrier()
#define PG8_SCHED __builtin_amdgcn_sched_barrier(0)
    Unit cur, nxt; int ui = 0;
    if (!S.next(0, cur)) return;
    f32x4 acc[2][2][4][2];
#pragma unroll
    for (int a = 0; a < 2; ++a)
#pragma unroll
        for (int b = 0; b < 2; ++b)
#pragma unroll
            for (int m = 0; m < 4; ++m)
#pragma unroll
                for (int n = 0; n < 2; ++n) acc[a][b][m][n] = (f32x4){0.f, 0.f, 0.f, 0.f};
    bf16x8 At[4][2], B0[2][2], B1[2][2];
    const char* cA = (const char*)g.A + (size_t)cur.pm * tstep; const char* cB = (const char*)g.Bt + (size_t)cur.pn * tstep;
    S.a_ready(cur);
    if constexpr (SP2) {
        PG8_STAGE(PG8_SB(0, 0), cB, voffB); PG8_STAGE(PG8_SB(0, 1), cB + hstep, voffB); PG8_STAGE(PG8_SA(0, 0), cA, voffA); PG8_STAGE(PG8_SA(0, 1), cA + hstep, voffA);
        if (wr == 1) PG8_BAR;
        PG8_WAIT_V(2); PG8_BAR;
        PG8_STAGE(PG8_SB(1, 0), cB + kstep, voffB); PG8_STAGE(PG8_SA(1, 0), cA + kstep, voffA); PG8_STAGE(PG8_SB(1, 1), cB + hstep + kstep, voffB);
        PG8_WAIT_V(6); PG8_BAR;
    } else {
        PG8_STAGE(PG8_SB(0, 0), cB, voffB); PG8_STAGE(PG8_SA(0, 0), cA, voffA); PG8_STAGE(PG8_SB(0, 1), cB + hstep, voffB); PG8_STAGE(PG8_SA(0, 1), cA + hstep, voffA);
        if (wr == 1) PG8_BAR;
        PG8_WAIT_V(4); PG8_BAR;
        PG8_STAGE(PG8_SB(1, 0), cB + kstep, voffB); PG8_STAGE(PG8_SA(1, 0), cA + kstep, voffA); PG8_STAGE(PG8_SB(1, 1), cB + hstep + kstep, voffB);
        PG8_WAIT_V(6); PG8_BAR;
    }
    for (;;) {
        const bool has_next = S.next(ui + 1, nxt);
        const char* nA = has_next ? (const char*)g.A + (size_t)nxt.pm * tstep : cA; const char* nB = has_next ? (const char*)g.Bt + (size_t)nxt.pn * tstep : cB;
        for (int t = 0; t < nt; t += 2) {
            const bool last = (t == nt - 2);
            const char* a1 = cA + (size_t)(t + 1) * kstep;
            const char* a2 = last ? nA : cA + (size_t)(t + 2) * kstep; const char* b2 = last ? nB : cB + (size_t)(t + 2) * kstep;
            const char* a3 = a2 + kstep; const char* b3 = b2 + kstep;
            if (last && has_next) S.a_ready(nxt);
            if constexpr (SP2) {
            PG8_LDB(B0, 0, 0); PG8_LDB(B1, 0, 1); PG8_SCHED; PG8_LDA(At, 0, 0); PG8_STAGE(PG8_SA(1, 1), a1 + hstep, voffA);
            PG8_WAIT_V(8); PG8_WAIT_L(0); PG8_BAR; PG8_MMA(0, 0, At, B0); PG8_MMA(0, 1, At, B1); PG8_BAR; PG8_SCHED;
            PG8_LDA(At, 0, 1); PG8_STAGE(PG8_SB(0, 0), b2, voffB); PG8_STAGE(PG8_SB(0, 1), b2 + hstep, voffB); PG8_STAGE(PG8_SA(0, 0), a2, voffA);
            PG8_WAIT_V(8); PG8_WAIT_L(0); PG8_BAR; PG8_MMA(1, 0, At, B0); PG8_MMA(1, 1, At, B1); PG8_BAR; PG8_SCHED;
            PG8_LDB(B0, 1, 0); PG8_LDB(B1, 1, 1); PG8_SCHED; PG8_LDA(At, 1, 0); PG8_STAGE(PG8_SA(0, 1), a2 + hstep, voffA);
            PG8_WAIT_V(8); PG8_WAIT_L(0); PG8_BAR; PG8_MMA(0, 0, At, B0); PG8_MMA(0, 1, At, B1); PG8_BAR; PG8_SCHED;
            PG8_LDA(At, 1, 1); PG8_STAGE(PG8_SB(1, 0), b3, voffB); PG8_STAGE(PG8_SB(1, 1), b3 + hstep, voffB); PG8_STAGE(PG8_SA(1, 0), a3, voffA);
            PG8_WAIT_V(8); PG8_WAIT_L(0); PG8_BAR; PG8_MMA(1, 0, At, B0); PG8_MMA(1, 1, At, B1); PG8_BAR; PG8_SCHED;
            } else {
            PG8_LDB(B0, 0, 0); PG8_SCHED; PG8_LDA(At, 0, 0); PG8_STAGE(PG8_SA(1, 1), a1 + hstep, voffA);
            PG8_WAIT_L(8); PG8_BAR; PG8_WAIT_L(0); PG8_MMA(0, 0, At, B0); PG8_BAR; PG8_SCHED;
            PG8_LDB(B1, 0, 1); PG8_STAGE(PG8_SB(0, 0), b2, voffB);
            PG8_BAR; PG8_WAIT_L(0); PG8_MMA(0, 1, At, B1); PG8_BAR;
            PG8_LDA(At, 0, 1); PG8_STAGE(PG8_SA(0, 0), a2, voffA);
            PG8_BAR; PG8_WAIT_L(0); PG8_MMA(1, 0, At, B0); PG8_BAR; PG8_SCHED;
            PG8_STAGE(PG8_SB(0, 1), b2 + hstep, voffB);
            PG8_WAIT_V(6); PG8_BAR; PG8_MMA(1, 1, At, B1); PG8_BAR;
            PG8_LDB(B0, 1, 0); PG8_SCHED; PG8_LDA(At, 1, 0); PG8_STAGE(PG8_SA(0, 1), a2 + hstep, voffA);
            PG8_WAIT_L(8); PG8_BAR; PG8_WAIT_L(0); PG8_MMA(0, 0, At, B0); PG8_BAR; PG8_SCHED;
            PG8_LDB(B1, 1, 1); PG8_STAGE(PG8_SB(1, 0), b3, voffB);
            PG8_BAR; PG8_WAIT_L(0); PG8_MMA(0, 1, At, B1); PG8_BAR;
            PG8_LDA(At, 1, 1); PG8_STAGE(PG8_SA(1, 0), a3, voffA);
            PG8_BAR; PG8_WAIT_L(0); PG8_MMA(1, 0, At, B0); PG8_BAR; PG8_SCHED;
            PG8_STAGE(PG8_SB(1, 1), b3 + hstep, voffB);
            PG8_WAIT_V(6); PG8_BAR; PG8_MMA(1, 1, At, B1); PG8_BAR;
            }
        }
        if constexpr (ALIGN_EPI) { if (wr == 0) PG8_BAR; }
#if defined(MK_EXP_EPI2)
        if constexpr (!Epi::AFTER_DRAIN && Epi::PERM) { E.template run<(MK_EXP_EPI2 == 2)>(acc, cur, wr, wc, fr, fq); }
#endif
        if constexpr (!Epi::AFTER_DRAIN) { E(acc, cur, wr, wc, fr, fq); S.done(cur); }
        if (!has_next) break;
#pragma unroll
        for (int a = 0; a < 2; ++a)
#pragma unroll
            for (int b = 0; b < 2; ++b)
#pragma unroll
                for (int m = 0; m < 4; ++m)
#pragma unroll
                    for (int n = 0; n < 2; ++n) acc[a][b][m][n] = (f32x4){0.f, 0.f, 0.f, 0.f};
        cur = nxt; cA = nA; cB = nB; ++ui;
        if constexpr (ALIGN_EPI) { if (wr == 1) PG8_BAR; }
    }
    PG8_WAIT_V(0);
    if constexpr (!ALIGN_EPI) { if (wr == 0) PG8_BAR; }
    PG8_BAR;
    if constexpr (Epi::AFTER_DRAIN) { E.fused(acc, cur, wr, wc, fr, fq, lds, wid, lane); S.done(cur); }
#undef PG8_SA
#undef PG8_SB
#undef PG8_STAGE
#undef PG8_LDA
#undef PG8_LDB
#undef PG8_MMA
#undef PG8_WAIT_V
#undef PG8_WAIT_L
#undef PG8_BAR
#undef PG8_SCHED
}
}
#define GAS __attribute__((address_space(1)))
#define LAS __attribute__((address_space(3)))
typedef unsigned short bf16;
typedef unsigned v4u __attribute__((ext_vector_type(4)));
typedef float f32x4 __attribute__((ext_vector_type(4)));
typedef short bf16x8 __attribute__((ext_vector_type(8)));
typedef GAS unsigned gu32;
typedef GAS unsigned long long gu64;
#define RLX_AGENT __ATOMIC_RELAXED, __HIP_MEMORY_SCOPE_AGENT
#define LDS_WAIT() asm volatile("s_waitcnt lgkmcnt(0)" ::: "memory")
#define VM_WAIT() asm volatile("s_waitcnt vmcnt(0)" ::: "memory")
__device__ __forceinline__ unsigned long long rt() { return __builtin_amdgcn_s_memrealtime(); }
__device__ __forceinline__ unsigned f2bf(float f) { unsigned u = __builtin_bit_cast(unsigned, f); return (u + 0x7fffu + ((u >> 16) & 1u)) >> 16; }
__device__ __forceinline__ unsigned pk2(float lo, float hi) { return f2bf(lo) | (f2bf(hi) << 16); }
#define XB_TMO      128
#define XB_XCNT(j)  (256  + 64 * (j))
#define XB_XSUB(j)  (1280 + 64 * (j))
#define XB_XGEN(j)  (2304 + 64 * (j))
#define XB_TOP      3328
#define XB_TOPGEN   3392
#define XCD_BAR_WORDS 3456
#define XB_SPIN_CAP (1u << 18)

__device__ __forceinline__ unsigned xb_ld(unsigned* p)              { return __hip_atomic_load(p, __ATOMIC_RELAXED, __HIP_MEMORY_SCOPE_AGENT); }
__device__ __forceinline__ unsigned xb_add(unsigned* p, unsigned v) { return __hip_atomic_fetch_add(p, v, __ATOMIC_RELAXED, __HIP_MEMORY_SCOPE_AGENT); }
__device__ __forceinline__ unsigned xb_xcc_id() { return (unsigned)__builtin_amdgcn_s_getreg((3 << 11) | 20) & 0xFu; }
#define XB_SPIN(cond, bar) do { unsigned _sp = 0; while (cond) { __builtin_amdgcn_s_sleep(1); \
    if ((++_sp & 255u) == 0u) { if (xb_ld(&(bar)[XB_TMO])) break; if (_sp > XB_SPIN_CAP) { atomicAdd(&(bar)[XB_TMO], 1u); break; } } } } while (0)

struct XcdBarrier {
    unsigned* bar; unsigned x; unsigned w;
    volatile LAS unsigned* st;
};

__device__ __forceinline__ XcdBarrier xcd_barrier_post(unsigned* bar, volatile LAS unsigned* st, unsigned wave) {
    XcdBarrier b; b.bar = bar; b.x = xb_xcc_id(); b.st = st; b.w = wave;
    if (b.w == 0u && pg8::hw_lane() == 0) (void)xb_add(&bar[XB_XCNT(b.x)], 1u);
    return b;
}
__device__ __forceinline__ void xcd_barrier_complete(unsigned* bar, unsigned x, unsigned& nloc, unsigned& nx) {
    const unsigned G = gridDim.x * gridDim.y * gridDim.z;
    unsigned sum, cnt, mine, sp = 0u;
    for (;;) {
        sum = 0u; cnt = 0u; mine = 0u;
#pragma unroll
        for (unsigned j = 0; j < 16; ++j) { const unsigned c = xb_ld(&bar[XB_XCNT(j)]); sum += c; cnt += (c > 0u) ? 1u : 0u; mine = (j == x) ? c : mine; }
        if (sum == G) break;
        __builtin_amdgcn_s_sleep(1);
        if ((++sp & 255u) == 0u) { if (xb_ld(&bar[XB_TMO])) break; if (sp > XB_SPIN_CAP) { atomicAdd(&bar[XB_TMO], 1u); break; } }
    }
    nloc = mine > 0u ? mine : 1u; nx = cnt > 0u ? cnt : 1u;
}

__device__ __forceinline__ void xcd_barrier(const XcdBarrier& b) {
    asm volatile("s_waitcnt vmcnt(0)" ::: "memory");
    __syncthreads();
    if (b.w == 0u && pg8::hw_lane() == 0) {
        unsigned* bar = b.bar;
        __builtin_amdgcn_s_waitcnt(0);
        unsigned nloc = b.st[0], nx = b.st[1];
        if (nloc == 0u) { xcd_barrier_complete(bar, b.x, nloc, nx); b.st[0] = nloc; b.st[1] = nx; }
        const unsigned old = xb_add(&bar[XB_XSUB(b.x)], 1u);
        const unsigned gen = old / nloc;
        if (old + 1u == (gen + 1u) * nloc) {
            __builtin_amdgcn_fence(__ATOMIC_RELEASE, "agent");
            asm volatile("s_waitcnt vmcnt(0)" ::: "memory");
            const unsigned og = xb_add(&bar[XB_TOP], 1u);
            const unsigned tg = og / nx;
            if (og + 1u == (tg + 1u) * nx) xb_add(&bar[XB_TOPGEN], 1u);
            else XB_SPIN(xb_ld(&bar[XB_TOPGEN]) == tg, bar);
            __builtin_amdgcn_fence(__ATOMIC_ACQUIRE, "agent");
            xb_add(&bar[XB_XGEN(b.x)], 1u);
            asm volatile("s_waitcnt vmcnt(0)" ::: "memory");
        } else {
            XB_SPIN(xb_ld(&bar[XB_XGEN(b.x)]) == gen, bar);
            __builtin_amdgcn_fence(__ATOMIC_ACQUIRE, "agent");
            asm volatile("s_waitcnt vmcnt(0)" ::: "memory");
        }
    }
    __syncthreads();
}
namespace mk {
constexpr int NWAVES = 8, NTHR = 512;
constexpr int NB = 16, S = 2048, D = 1024, CT = 256, RB = S + CT  , MT = NB * RB, HB = 8  , MH = HB * RB, DI = 2048;
constexpr float EPS = 1e-6f, LOG2E = 1.4426950408889634f;
constexpr size_t MiB = 1u << 20;
constexpr size_t WS_CTXS = 0, WS_MOD = 16 * MiB, WS_CTL = 17 * MiB, CTL_BYTES = 64 * 1024;
constexpr size_t WS_ROPE = 18 * MiB, WS_WG2 = 18 * MiB + 64 * 1024, WS_GATES = 19 * MiB;
constexpr size_t WS_WIN = 22 * MiB, WS_WOUT = 38 * MiB, WS_H = 42 * MiB, WS_QG = 114 * MiB, WS_S2 = 258 * MiB, WS_S3 = 330 * MiB, WS_S4 = 402 * MiB, WS_END = 474 * MiB, WS_GATES2 = 474 * MiB  ,
    WS_SSQ = 477 * MiB  , WS_W2 = 480 * MiB  , WS_SHW = 500 * MiB  , WS_GATES3 = 503 * MiB, WS_GATES4 = 506 * MiB  ;
constexpr int CW_BAR = 1024;
constexpr int RING_BYTES = 131072, MISC_OFF = RING_BYTES + 320, LDS_BYTES = 147456;

typedef unsigned short bf16;
typedef float f32x4 __attribute__((ext_vector_type(4)));
typedef float f32x16 __attribute__((ext_vector_type(16)));
typedef short bf16x8 __attribute__((ext_vector_type(8)));
typedef short s16x4 __attribute__((ext_vector_type(4)));
typedef unsigned u32x4 __attribute__((ext_vector_type(4)));
typedef unsigned u32x2 __attribute__((ext_vector_type(2)));

__device__ __forceinline__ float silu(float x) { return x / (1.f + __expf(-x)); }
__device__ __forceinline__ float bf2f(unsigned short b) { return __uint_as_float((unsigned)b << 16); }
__device__ __forceinline__ float bflo(unsigned w) { return __uint_as_float(w << 16); }
__device__ __forceinline__ float bfhi(unsigned w) { return __uint_as_float(w & 0xffff0000u); }
__device__ __forceinline__ float wave_sum(float v) {
#pragma unroll
    for (int o = 1; o < 64; o <<= 1) v += __shfl_xor(v, o);
    return v;
}

struct Frame {
    LAS unsigned char* lds;
    int tid, lane, wave, vcu, G;
    void* const* dummy;
};
__device__ __forceinline__ Frame fresh(const Frame& F0) { Frame F = F0; const int l = pg8::hw_lane(); F.lane = l; F.tid = F0.wave * 64 + l; return F; }
struct Args { const float* in[32]; float* out; unsigned char* ws; int ph_lo, ph_hi; };

template <bool ROPE, bool AFFINE = false> struct EpiProj {
    static constexpr bool PERM = true, AFTER_DRAIN = false;
    bf16 *d0, *d1, *d2, *d3; int l0, l1, l2, l3; int t1, t2, t3; unsigned ropemask; float sc0; const float* rope;
    const float* ssq; const float* shw; int row_base;
    __device__ __forceinline__ void operator()(const pg8::f32x4 (&acc)[2][2][4][2], const pg8::Unit& u, int wr, int wc, int fr, int fq) const { run<false>(acc, u, wr, wc, fr, fq); }
    template <bool NOSTORE> __device__ __forceinline__ void run(const pg8::f32x4 (&acc)[2][2][4][2], const pg8::Unit& u, int wr, int wc, int fr, int fq) const {
        asm volatile("" : "+v"(fr), "+v"(fq));
        const int pn = u.pn;
        long long off = 0; int ld = l0, tb = 0, s = 0;
        if (pn >= t1) { off += (long long)(d1 - d0); ld += l1 - l0; tb = t1; s = 1; }
        if (pn >= t2) { off += (long long)(d2 - d1); ld += l2 - l1; tb = t2; s = 2; }
        if (pn >= t3) { off += (long long)(d3 - d2); ld += l3 - l2; tb = t3; s = 3; }
        bf16* base = d0 + off;
        const float sc = (pn >= t1) ? 1.f : sc0;
        const int rr0 = (u.pm * 256) % RB;
        const bool do_rope = ROPE && ((ropemask >> s) & 1u) && rr0 != 0;
        const int col0 = (pn - tb) * 256 + wc * 32 + 8 * fq;
        const int rloc = wr * 64 + fr;
        pg8::f32x4 sw[2][2];
        if (AFFINE) { const int gr0 = row_base + u.pm * 256; const float* sp = shw + (size_t)(rr0 == 0 ? 16 : gr0 / RB) * 8192 + pn * 256 + wc * 32 + 8 * fq;
#pragma unroll
            for (int bj = 0; bj < 2; ++bj) { sw[bj][0] = *(const pg8::f32x4*)(sp + bj * 128); sw[bj][1] = *(const pg8::f32x4*)(sp + bj * 128 + 4); } }
#pragma unroll
        for (int ai = 0; ai < 2; ++ai)
#pragma unroll
            for (int m = 0; m < 4; ++m) {
                const int rt = rloc + ai * 128 + m * 16;
                bf16* rowp = base + (size_t)(u.pm * 256 + rt) * ld + col0;
                float rstd = 1.f;
                if (AFFINE) { const pg8::f32x4* qp = (const pg8::f32x4*)(ssq + (size_t)(row_base + u.pm * 256 + rt) * 16); const pg8::f32x4 a0 = qp[0], a1 = qp[1], a2 = qp[2], a3 = qp[3];
                    const float tot = ((a0[0] + a0[1]) + (a0[2] + a0[3])) + ((a1[0] + a1[1]) + (a1[2] + a1[3])) + ((a2[0] + a2[1]) + (a2[2] + a2[3])) + ((a3[0] + a3[1]) + (a3[2] + a3[3]));
                    rstd = rsqrtf(tot * (1.f / D) + EPS); }
                f32x4 cs0 = {}, cs1 = {}, cs2 = {}, cs3 = {};
                if (ROPE && do_rope) { const int t = rr0 - CT + rt; const int pos = (wc & 1) ? (t & 63) : (t >> 6); const f32x4* tp = (const f32x4*)(rope + pos * 32 + 16 * (fq & 1));
                    cs0 = tp[0]; cs1 = tp[1]; cs2 = tp[2]; cs3 = tp[3]; }
#pragma unroll
                for (int bj = 0; bj < 2; ++bj) {
                    pg8::f32x4 v0 = acc[ai][bj][m][0], v1 = acc[ai][bj][m][1];
                    if (AFFINE) { v0 = v0 * rstd + sw[bj][0]; v1 = v1 * rstd + sw[bj][1]; }
                    if (ROPE && do_rope) {
                        const float sg = (fq & 2) ? 1.f : -1.f;
                        pg8::f32x4 p0, p1;
#pragma unroll
                        for (int i = 0; i < 4; ++i) { p0[i] = __shfl_xor(v0[i], 32); p1[i] = __shfl_xor(v1[i], 32); }
                        v0[0] = v0[0] * cs0[0] + sg * p0[0] * cs0[1]; v0[1] = v0[1] * cs0[2] + sg * p0[1] * cs0[3];
                        v0[2] = v0[2] * cs1[0] + sg * p0[2] * cs1[1]; v0[3] = v0[3] * cs1[2] + sg * p0[3] * cs1[3];
                        v1[0] = v1[0] * cs2[0] + sg * p1[0] * cs2[1]; v1[1] = v1[1] * cs2[2] + sg * p1[1] * cs2[3];
                        v1[2] = v1[2] * cs3[0] + sg * p1[2] * cs3[1]; v1[3] = v1[3] * cs3[2] + sg * p1[3] * cs3[3];
                    }
                    v0 = v0 * sc; v1 = v1 * sc;
                    pg8::u32x4 w; w.x = pg8::cvt_pk_bf16(v0[0], v0[1]); w.y = pg8::cvt_pk_bf16(v0[2], v0[3]); w.z = pg8::cvt_pk_bf16(v1[0], v1[1]); w.w = pg8::cvt_pk_bf16(v1[2], v1[3]);
                    if (NOSTORE) asm volatile("" :: "v"(w)); else { *(pg8::u32x4*)(rowp + bj * 128) = w;
#ifdef MK_EXP_ST2
                        asm volatile("" ::: "memory"); *(volatile pg8::u32x4*)(rowp + bj * 128) = w;
#endif
                    }
                }
            }
    }
};
__device__ __forceinline__ pg8::f32x4 ld4(const float* p) { return *(const pg8::f32x4*)p; }
__device__ __forceinline__ pg8::f32x4 ld4(const bf16* p) { const u32x2 w = *(const u32x2*)p; pg8::f32x4 v; v[0] = bflo(w.x); v[1] = bfhi(w.x); v[2] = bflo(w.y); v[3] = bfhi(w.y); return v; }
__device__ __forceinline__ void st4(float* p, const pg8::f32x4& v) { *(pg8::f32x4*)p = v; }
__device__ __forceinline__ void st4(bf16* p, const pg8::f32x4& v) { u32x2 w; w.x = pg8::cvt_pk_bf16(v[0], v[1]); w.y = pg8::cvt_pk_bf16(v[2], v[3]); *(u32x2*)p = w; }
template <class BT = float, class OT = float> struct EpiResidT {
    static constexpr bool PERM = false, AFTER_DRAIN = false;
    const BT* base_lat; const BT* base_ctx; OT* out_lat; OT* out_ctx; const float* mod_l; int need_ctx; int dry;
    bf16* Hn; const float* gnext; const float* modn; float* ssq;
    __device__ __forceinline__ void operator()(const pg8::f32x4 (&acc)[2][2][4][2], const pg8::Unit& u, int wr, int wc, int fr, int fq) const {
        asm volatile("" : "+v"(fr), "+v"(fq));
        const int r0 = u.pm * 256, b = r0 / RB, rr0 = r0 % RB; const bool ctx = rr0 == 0;
        if ((ctx && !need_ctx) || dry) return;
        const size_t ro = ctx ? (size_t)b * CT * D : ((size_t)b * S + (rr0 - CT)) * D;
        const BT* bp = (ctx ? base_ctx : base_lat) + ro; OT* op = (ctx ? out_ctx : out_lat) + ro;
        const float* gt = mod_l + (size_t)(ctx ? 16 : b) * 3072 + 2048;
        const int col0 = u.pn * 256 + wc * 32 + 4 * fq;
        pg8::f32x4 g[2][2];
#pragma unroll
        for (int bj = 0; bj < 2; ++bj)
#pragma unroll
            for (int n = 0; n < 2; ++n) g[bj][n] = *(const pg8::f32x4*)(gt + col0 + bj * 128 + n * 16);
        pg8::f32x4 gm[2][2];
        if (Hn) { const float* sn = modn + (size_t)(ctx ? 16 : b) * 3072 + 1024;
#pragma unroll
            for (int bj = 0; bj < 2; ++bj)
#pragma unroll
                for (int n = 0; n < 2; ++n) gm[bj][n] = *(const pg8::f32x4*)(gnext + col0 + bj * 128 + n * 16) * (*(const pg8::f32x4*)(sn + col0 + bj * 128 + n * 16) + 1.0f); }
#pragma unroll
        for (int ai = 0; ai < 2; ++ai)
#pragma unroll
            for (int m = 0; m < 4; ++m) { const size_t off = (size_t)(ai * 128 + wr * 64 + m * 16 + fr) * D + col0; float sq = 0.f;
#pragma unroll
                for (int bj = 0; bj < 2; ++bj)
#pragma unroll
                    for (int n = 0; n < 2; ++n) { const pg8::f32x4 bs = ld4(bp + off + bj * 128 + n * 16); const pg8::f32x4 xn = bs + g[bj][n] * acc[ai][bj][m][n]; st4(op + off + bj * 128 + n * 16, xn);
                        if (Hn) { sq += (xn[0] * xn[0] + xn[1] * xn[1]) + (xn[2] * xn[2] + xn[3] * xn[3]); const pg8::f32x4 hv = xn * gm[bj][n];
                            u32x2 w; w.x = pg8::cvt_pk_bf16(hv[0], hv[1]); w.y = pg8::cvt_pk_bf16(hv[2], hv[3]); *(u32x2*)(Hn + (size_t)(r0 + ai * 128 + wr * 64 + m * 16 + fr) * D + col0 + bj * 128 + n * 16) = w; } }
                if (Hn) { sq += __shfl_xor(sq, 16); sq += __shfl_xor(sq, 32); if (fq == 0) ssq[(size_t)(r0 + ai * 128 + wr * 64 + m * 16 + fr) * 16 + u.pn * 4 + wc] = sq; } }
    }
};
using EpiResid = EpiResidT<float, float>;

struct LatOnlyOrder {
    pg8::StaticOrder lat;
    __device__ void init(int G_, int c_) { lat.init(128 * 256, D, G_, c_); }
    __device__ bool next(int i, pg8::Unit& u) const { const bool ok = lat.next(i, u); u.pm = (u.pm >> 3) * 9 + 1 + (u.pm & 7); return ok; }
    __device__ __forceinline__ void a_ready(const pg8::Unit&) const {}
    __device__ __forceinline__ void done(const pg8::Unit&) const {}
};
struct OutTailOrder {
    int c;
    __device__ void init(int, int c_) { c = c_; }
    __device__ bool next(int i, pg8::Unit& u) const { if (i > 0 || c >= 64) return false; const int x = c & 7, j = c >> 3; u.pm = 128 + 2 * x + (j >> 2); u.pn = j & 3; return true; }
    __device__ __forceinline__ void a_ready(const pg8::Unit&) const {}
    __device__ __forceinline__ void done(const pg8::Unit&) const {}
};
struct L3Order {
    pg8::StaticOrder lat; int G, c;
    __device__ void init(int G_, int c_) { lat.init(64 * 256, 18 * 256, G_, c_); G = G_; c = c_; }
    __device__ bool next(int i, pg8::Unit& u) const {
        const long L = (long)i * G + c;
        if (L < 1152) { const bool ok = lat.next(i, u); u.pm = (u.pm >> 3) * 9 + 1 + (u.pm & 7); return ok; }
        if (L >= 1168) return false;
        const int j = (int)L - 1152; u.pm = (j >> 1) * 9; u.pn = 8 + (j & 1); return true;
    }
    __device__ __forceinline__ void a_ready(const pg8::Unit&) const {}
    __device__ __forceinline__ void done(const pg8::Unit&) const {}
};

__device__ __forceinline__ void transpose_item(const float* W, int K, int N, bf16* WT, LAS float* scr, int item, int lane) {
    const int nblk = N / 32, kb = item / nblk, nb = item % nblk, k0 = 64 * kb, n0 = 32 * nb;
#pragma unroll 8
    for (int i = 0; i < 32; ++i) { const int kk = 2 * i + (lane >> 5); scr[kk * 33 + (lane & 31)] = W[(size_t)(k0 + kk) * N + n0 + (lane & 31)]; }
    LDS_WAIT(); asm volatile("" ::: "memory");
    const int c = lane & 7;
#pragma unroll
    for (int j = 0; j < 4; ++j) { const int n = (lane >> 3) + 8 * j; const LAS float* s = scr + (8 * c) * 33 + n;
        v4u o; o.x = pk2(s[0 * 33], s[1 * 33]); o.y = pk2(s[2 * 33], s[3 * 33]); o.z = pk2(s[4 * 33], s[5 * 33]); o.w = pk2(s[6 * 33], s[7 * 33]);
        *(GAS v4u*)(WT + (size_t)(n0 + n) * K + k0 + 8 * c) = o; }
    LDS_WAIT(); asm volatile("" ::: "memory");
}
__device__ __forceinline__ void wconv(Frame& F0, const float* Win, int Nin, const float* Wout, bf16* WinT, bf16* WoutT, int gw, int NGW) {
    Frame F = fresh(F0);
    LAS float* scr = (LAS float*)(F.lds + F.wave * 16384);
    const int I1 = (D / 64) * (Nin / 32), I2 = (DI / 64) * (D / 32);
    for (int it = gw; it < I1 + I2; it += NGW) { if (it < I1) transpose_item(Win, D, Nin, WinT, scr, it, F.lane); else transpose_item(Wout, DI, D, WoutT, scr, it - I1, F.lane); }
}
template <class XT>
__device__ __forceinline__ void norm_phase(Frame& F0, const XT* xlat, const XT* xctx, const float* g, const float* mod_l, bf16* H, int row_lo = 0, int row_hi = MT, int wg0 = 0) {
    Frame F = fresh(F0);
    const int gw = (wg0 ? (int)blockIdx.x - wg0 : F.vcu) * NWAVES + F.wave, NGW = (F.G - wg0) * NWAVES;
    f32x4 gg[4];
#pragma unroll
    for (int j = 0; j < 4; ++j) gg[j] = *(const f32x4*)(g + F.lane * 4 + 256 * j);
    for (int row0 = row_lo + gw; row0 < row_hi; row0 += 2 * NGW) {
        f32x4 v[2][4]; const float* mrow[2]; float ss[2] = {0.f, 0.f}; int rowi[2];
#pragma unroll
        for (int u = 0; u < 2; ++u) { int row = row0 + u * NGW; if (row >= row_hi) row = row0; rowi[u] = row;
            const int b = row / RB, rr = row % RB;
            const XT* src = rr < CT ? xctx + ((size_t)b * CT + rr) * D : xlat + ((size_t)b * S + (rr - CT)) * D;
            mrow[u] = mod_l + (size_t)(rr < CT ? 16 : b) * 3072;
#pragma unroll
            for (int j = 0; j < 4; ++j) v[u][j] = ld4(src + F.lane * 4 + 256 * j); }
#pragma unroll
        for (int u = 0; u < 2; ++u) {
#pragma unroll
            for (int j = 0; j < 4; ++j) ss[u] += (v[u][j].x * v[u][j].x + v[u][j].y * v[u][j].y) + (v[u][j].z * v[u][j].z + v[u][j].w * v[u][j].w);
            const float rstd = rsqrtf(wave_sum(ss[u]) * (1.f / D) + EPS);
#pragma unroll
            for (int j = 0; j < 4; ++j) { const int c = F.lane * 4 + 256 * j; const f32x4 sc = *(const f32x4*)(mrow[u] + 1024 + c), sh = *(const f32x4*)(mrow[u] + c);
                const f32x4 o = v[u][j] * rstd * gg[j] * (sc + 1.0f) + sh;
                u32x2 w; w.x = pk2(o.x, o.y); w.y = pk2(o.z, o.w); *(u32x2*)(H + (size_t)rowi[u] * D + c) = w; }
        }
    }
}
__device__ __forceinline__ void final_norm_phase(Frame& F0, float* xs, const float* g) {
    Frame F = fresh(F0);
    const int gw = F.vcu * NWAVES + F.wave, NGW = F.G * NWAVES;
    f32x4 gg[4];
#pragma unroll
    for (int j = 0; j < 4; ++j) gg[j] = *(const f32x4*)(g + F.lane * 4 + 256 * j);
    for (int row0 = gw; row0 < NB * S; row0 += 2 * NGW) {
        f32x4 v[2][4]; float* p[2];
#pragma unroll
        for (int u = 0; u < 2; ++u) { int row = row0 + u * NGW; if (row >= NB * S) row = row0; p[u] = xs + (size_t)row * D;
#pragma unroll
            for (int j = 0; j < 4; ++j) v[u][j] = *(const f32x4*)(p[u] + F.lane * 4 + 256 * j); }
#pragma unroll
        for (int u = 0; u < 2; ++u) { float ss = 0.f;
#pragma unroll
            for (int j = 0; j < 4; ++j) ss += (v[u][j].x * v[u][j].x + v[u][j].y * v[u][j].y) + (v[u][j].z * v[u][j].z + v[u][j].w * v[u][j].w);
            const float rstd = rsqrtf(wave_sum(ss) * (1.f / D) + EPS);
#pragma unroll
            for (int j = 0; j < 4; ++j) { const int c = F.lane * 4 + 256 * j; *(f32x4*)(p[u] + c) = v[u][j] * rstd * gg[j]; } }
    }
}
__device__ __forceinline__ void shw_phase(Frame& F0, const Args& a) {
    Frame F = fresh(F0);
    const float* mod = (const float*)(a.ws + WS_MOD); float* shw = (float*)(a.ws + WS_SHW);
    LAS float* sh = (LAS float*)F.lds;
    LAS float* red = (LAS float*)(F.lds + 69632);
    int cur_l = -1;
    for (int it = blockIdx.x; it < 128 + 128 + 72; it += F.G) {
        const int l = it < 128 ? 0 : (it < 256 ? 1 : 2), cg = it - (l == 0 ? 0 : (l == 1 ? 128 : 256));
        const int N = l == 2 ? 4608 : 8192; const float* W = a.in[l == 0 ? 19 : (l == 1 ? 26 : 29)];
        __syncthreads();
        if (l != cur_l) { for (int i = F.tid; i < 17 * 1024; i += NTHR) sh[i] = mod[((size_t)(l + 1) * 17 + (i >> 10)) * 3072 + (i & 1023)]; cur_l = l; __syncthreads(); }
        float acc[17];
#pragma unroll
        for (int r = 0; r < 17; ++r) acc[r] = 0.f;
        const float* wp = W + (size_t)(F.wave * 128) * N + cg * 64 + F.lane;
#pragma unroll 8
        for (int kk = 0; kk < 128; ++kk) { const float w = wp[(size_t)kk * N];
#pragma unroll
            for (int r = 0; r < 17; ++r) acc[r] += sh[r * 1024 + F.wave * 128 + kk] * w; }
#pragma unroll
        for (int r = 0; r < 17; ++r) red[(F.wave * 17 + r) * 64 + F.lane] = acc[r];
        __syncthreads();
        for (int i = F.tid; i < 17 * 64; i += NTHR) { float sacc = 0.f;
#pragma unroll
            for (int w8 = 0; w8 < 8; ++w8) sacc += red[(w8 * 17 + (i >> 6)) * 64 + (i & 63)];
            shw[((size_t)l * 17 + (i >> 6)) * 8192 + cg * 64 + (i & 63)] = sacc; }
    }
    __syncthreads();
}
__device__ __forceinline__ void prologue_phase(Frame& F0, const Args& a) {
    Frame F = fresh(F0);
    const float* c = a.in[1]; const float* cctx = a.in[3]; const float* w_ada = a.in[5];
    float* part = (float*)(a.ws + WS_QG);
    {
        LAS float* st = (LAS float*)F.lds;
        const int wg = blockIdx.x, l = wg >> 6, sl = wg & 63, k0 = sl * 16;
        if (F.tid < 17 * 16) { const int r = F.tid >> 4, k = F.tid & 15; st[F.tid] = silu(r < 16 ? c[r * 1024 + k0 + k] : cctx[k0 + k]); }
        __syncthreads();
        float acc[17][6];
#pragma unroll
        for (int r = 0; r < 17; ++r)
#pragma unroll
            for (int i = 0; i < 6; ++i) acc[r][i] = 0.f;
        const float* wp = w_ada + ((size_t)l * 1024 + k0) * 3072 + F.tid;
#pragma unroll 2
        for (int kk = 0; kk < 16; ++kk) { float w[6];
#pragma unroll
            for (int i = 0; i < 6; ++i) w[i] = wp[(size_t)kk * 3072 + 512 * i];
#pragma unroll
            for (int r = 0; r < 17; ++r) { const float sv = st[r * 16 + kk];
#pragma unroll
                for (int i = 0; i < 6; ++i) acc[r][i] += sv * w[i]; } }
        float* pp = part + (size_t)wg * 17 * 3072 + F.tid;
#pragma unroll
        for (int r = 0; r < 17; ++r)
#pragma unroll
            for (int i = 0; i < 6; ++i) pp[r * 3072 + 512 * i] = acc[r][i];
    }
#ifdef MK_TOUCH
    {
        const int xg = blockIdx.x >> 3; unsigned accv = 0u;
        for (size_t off = ((size_t)xg * NTHR + F.tid) * 4096; off < WS_END; off += (size_t)32 * NTHR * 4096) accv += *(const unsigned*)(a.ws + off);
        for (size_t off = ((size_t)xg * NTHR + F.tid) * 4096; off < (size_t)NB * S * D * 4; off += (size_t)32 * NTHR * 4096) accv += *(const unsigned*)((const unsigned char*)a.out + off) + *(const unsigned*)((const unsigned char*)a.in[0] + off);
        asm volatile("" :: "v"(accv));
    }
#endif
    if (blockIdx.x == 0) {
        float* rope = (float*)(a.ws + WS_ROPE);
        for (int i = F.tid; i < 64 * 16; i += NTHR) { const int pos = i >> 4, j = i & 15; const float inv = powf(10000.f, -(float)j / 16.f), ang = (float)pos * inv; rope[2 * i] = cosf(ang); rope[2 * i + 1] = sinf(ang); }
    } else if (blockIdx.x < 33) {
        bf16* W2 = (bf16*)(a.ws + WS_WG2); const float* wq = a.in[11]; const float* wk = a.in[12]; const float* wv = a.in[13]; const float* wg = a.in[14];
        for (int i = (blockIdx.x - 1) * NTHR + F.tid; i < 32 * 4096; i += 32 * NTHR) { const int n = i >> 12, k = i & 4095; float s = 0.f;
            if (k < 2048) { const int gq = k >> 2, ii = k & 3;
#pragma unroll
                for (int j = 0; j < 4; ++j) s += wq[(gq * 4 + ii) * 4 + j] * wg[(size_t)(gq * 4 + j) * 32 + n] + wk[(gq * 4 + ii) * 4 + j] * wg[(size_t)(2048 + gq * 4 + j) * 32 + n]; }
            else { const int kk = k - 2048, gq = kk >> 2, ii = kk & 3;
#pragma unroll
                for (int j = 0; j < 4; ++j) s += wv[(gq * 4 + ii) * 4 + j] * wg[(size_t)(4096 + gq * 4 + j) * 32 + n]; }
            W2[i] = (bf16)f2bf(s); }
    }
}
__device__ __forceinline__ void prologue2_phase(Frame& F0, const Args& a) {
    Frame F = fresh(F0);
    const float* part = (const float*)(a.ws + WS_QG); const float* b_ada = a.in[6]; float* mod = (float*)(a.ws + WS_MOD);
    for (int o = blockIdx.x * NTHR + F.tid; o < 4 * 17 * 3072; o += F.G * NTHR) {
        const int l = o / (17 * 3072), rn = o % (17 * 3072), n = rn % 3072;
        const float* pp = part + (size_t)l * 64 * 17 * 3072 + rn; float s0 = 0.f, s1 = 0.f, s2 = 0.f, s3 = 0.f;
#pragma unroll
        for (int sl = 0; sl < 64; sl += 16) { float v[16];
#pragma unroll
            for (int j = 0; j < 16; ++j) v[j] = pp[(size_t)(sl + j) * 17 * 3072];
#pragma unroll
            for (int j = 0; j < 16; j += 4) { s0 += v[j]; s1 += v[j + 1]; s2 += v[j + 2]; s3 += v[j + 3]; } }
        mod[o] = ((s0 + s1) + (s2 + s3)) + b_ada[l * 3072 + n];
    }
}
}
namespace att {
using mk::bf16; using mk::bf16x8; using mk::s16x4; using mk::f32x16; using mk::u32x4; using mk::u32x2;
typedef short v4i16_t __attribute__((ext_vector_type(4)));
typedef float f32x2_t __attribute__((ext_vector_type(2))); typedef __bf16 bf16x2_t __attribute__((ext_vector_type(2)));
__device__ __forceinline__ int crow(int r, int hi) { return (r & 3) + 8 * (r >> 2) + 4 * hi; }
__device__ __forceinline__ unsigned cvtpk(float lo, float hi) { f32x2_t v = {lo, hi}; bf16x2_t b = __builtin_convertvector(v, bf16x2_t); return __builtin_bit_cast(unsigned, b); }
__device__ __forceinline__ s16x4 vtr(LAS const unsigned char* p) { return __builtin_bit_cast(s16x4, __builtin_amdgcn_ds_read_tr16_b64_v4i16((LAS v4i16_t*)p)); }
__device__ __forceinline__ float ex2(float x) { return __builtin_amdgcn_exp2f(x); }
__device__ __forceinline__ float max3f(float a, float b, float c) { float r; asm("v_max3_f32 %0, %1, %2, %3" : "=v"(r) : "v"(a), "v"(b), "v"(c)); return r; }
#define ATT_SB() __builtin_amdgcn_sched_barrier(0)

struct Src { const bf16* K[2]; const bf16* V; int ldk, ldv; };

template <int DV, int NCOMP> struct Stage { u32x4 kr[NCOMP]; u32x4 vr[DV / 64]; };
template <int DV, int NCOMP>
__device__ __forceinline__ void stage_load(Stage<DV, NCOMP>& st, const Src& s, size_t row, int wid, int lane) {
#pragma unroll
    for (int c = 0; c < NCOMP; ++c) st.kr[c] = *(const u32x4*)(s.K[c] + (row + lane) * s.ldk + wid * 8);
#pragma unroll
    for (int i = 0; i < DV / 64; ++i) { const int p = wid + 8 * i, d0 = p >> 2, kg = p & 3; st.vr[i] = *(const u32x4*)(s.V + (row + 16 * kg + (lane >> 2)) * s.ldv + d0 * 32 + (lane & 3) * 8); }
}
template <int DV, int NCOMP>
__device__ __forceinline__ void stage_store(const Stage<DV, NCOMP>& st, LAS unsigned char* buf, int wid, int lane) {
#pragma unroll
    for (int c = 0; c < NCOMP; ++c) *(LAS u32x4*)(buf + c * 8192 + wid * 1024 + lane * 16) = st.kr[c];
#pragma unroll
    for (int i = 0; i < DV / 64; ++i) *(LAS u32x4*)(buf + NCOMP * 8192 + (wid + 8 * i) * 1024 + lane * 16) = st.vr[i];
}
__device__ __forceinline__ void glds16(const void* gsrc, unsigned lds_dst) { unsigned keep;
    asm volatile("s_mov_b32 %0, m0\n\ts_mov_b32 m0, %2\n\ts_nop 0\n\tglobal_load_lds_dwordx4 %1, off\n\ts_mov_b32 m0, %0" : "=&s"(keep) : "v"(gsrc), "s"(lds_dst) : "memory"); }
__device__ __forceinline__ unsigned long long uni64(const void* p) { const unsigned long long a = (unsigned long long)p;
    return ((unsigned long long)(unsigned)__builtin_amdgcn_readfirstlane((unsigned)(a >> 32)) << 32) | (unsigned)__builtin_amdgcn_readfirstlane((unsigned)a); }
__device__ __forceinline__ void glds16s(const void* sbase_, unsigned voff, unsigned lds_dst) { unsigned keep; const unsigned long long sbase = uni64(sbase_);
    asm volatile("s_mov_b32 %0, m0\n\ts_mov_b32 m0, %3\n\ts_nop 0\n\tglobal_load_lds_dwordx4 %1, %2\n\ts_mov_b32 m0, %0" : "=&s"(keep) : "v"(voff), "s"(sbase), "s"(lds_dst) : "memory"); }
template <int DV, int NCOMP>
__device__ __forceinline__ void dma_issue(const Src& s, size_t row, LAS unsigned char* buf, int wid, int lane) {
    const unsigned b0 = (unsigned)(size_t)buf;
    const unsigned ko = (unsigned)(lane * s.ldk + wid * 8) * 2u, vo = (unsigned)((16 * (wid & 3) + (lane >> 2)) * s.ldv + (lane & 3) * 8) * 2u;
#pragma unroll
    for (int c = 0; c < NCOMP; ++c) glds16s(s.K[c] + row * s.ldk, ko, (unsigned)__builtin_amdgcn_readfirstlane(b0 + c * 8192 + wid * 1024));
#pragma unroll
    for (int i = 0; i < DV / 64; ++i) { const int p = wid + 8 * i, d0 = p >> 2;
        glds16s(s.V + row * s.ldv + d0 * 32, vo, (unsigned)__builtin_amdgcn_readfirstlane(b0 + NCOMP * 8192 + p * 1024)); }
}
#define ATT_WAIT_BAR(N) asm volatile("s_waitcnt vmcnt(" #N ") lgkmcnt(0)\n\ts_barrier" ::: "memory")
template <int NL> __device__ __forceinline__ void wait_bar_keep() { if constexpr (NL == 2) ATT_WAIT_BAR(2); else if constexpr (NL == 4) ATT_WAIT_BAR(4); else static_assert(NL == 2 || NL == 4, "pieces per wave"); }
__device__ __forceinline__ void qk_tile(LAS const unsigned char* kimg, const bf16x8 (&qf)[4], int r32, int hi, f32x16& p0, f32x16& p1, const f32x16& z, const f32x16& z1  ) {
    LAS const unsigned char* kb = kimg + hi * 1024 + r32 * 16;
#define ATT_KRD(i) (*(LAS const bf16x8*)(kb + ((i) >> 1) * 2048 + ((i) & 1) * 512))
    bf16x8 f0 = ATT_KRD(0), f1 = ATT_KRD(1), f2;
    f2 = ATT_KRD(2); ATT_SB(); p0 = __builtin_amdgcn_mfma_f32_32x32x16_bf16(f0, qf[0], z, 0, 0, 0);
    f0 = ATT_KRD(3); ATT_SB(); p1 = __builtin_amdgcn_mfma_f32_32x32x16_bf16(f1, qf[0], z1, 0, 0, 0);
    f1 = ATT_KRD(4); ATT_SB(); p0 = __builtin_amdgcn_mfma_f32_32x32x16_bf16(f2, qf[1], p0, 0, 0, 0);
    f2 = ATT_KRD(5); ATT_SB(); p1 = __builtin_amdgcn_mfma_f32_32x32x16_bf16(f0, qf[1], p1, 0, 0, 0);
    f0 = ATT_KRD(6); ATT_SB(); p0 = __builtin_amdgcn_mfma_f32_32x32x16_bf16(f1, qf[2], p0, 0, 0, 0);
    f1 = ATT_KRD(7); ATT_SB(); p1 = __builtin_amdgcn_mfma_f32_32x32x16_bf16(f2, qf[2], p1, 0, 0, 0);
    ATT_SB(); p0 = __builtin_amdgcn_mfma_f32_32x32x16_bf16(f0, qf[3], p0, 0, 0, 0);
    ATT_SB(); p1 = __builtin_amdgcn_mfma_f32_32x32x16_bf16(f1, qf[3], p1, 0, 0, 0);
#undef ATT_KRD
}
template <int DV>
__device__ __forceinline__ void softmax_tile(f32x16& p0, f32x16& p1, f32x16 (&o)[DV / 32], float& m, float& l, u32x4 (&pw)[4]) {
    float mxa = max3f(p0[0], p0[1], p1[0]), mxb = max3f(p0[2], p0[3], p1[1]); mxa = max3f(mxa, p1[2], p1[3]);
#pragma unroll
    for (int r = 4; r < 16; r += 4) { mxa = max3f(mxa, p0[r], p0[r + 1]); mxb = max3f(mxb, p0[r + 2], p0[r + 3]); mxa = max3f(mxa, p1[r], p1[r + 1]); mxb = max3f(mxb, p1[r + 2], p1[r + 3]); }
    const float mx0 = max3f(mxa, mxb, mxb);
    const float mn = max3f(m, mx0, __shfl_xor(mx0, 32)), alpha = ex2(m - mn);
    float ls = 0.f;
#pragma unroll
    for (int r = 0; r < 16; ++r) { p0[r] = ex2(p0[r] - mn); p1[r] = ex2(p1[r] - mn); ls += p0[r] + p1[r]; }
    l = l * alpha + ls;
    if (__any(mn != m)) {
#pragma unroll
        for (int d0 = 0; d0 < DV / 32; ++d0)
#pragma unroll
            for (int r = 0; r < 16; ++r) o[d0][r] *= alpha;
    }
    m = mn;
#pragma unroll
    for (int ks = 0; ks < 4; ++ks) { const int b = 8 * (ks & 1);
        if (ks < 2) { pw[ks].x = cvtpk(p0[b], p0[b + 1]); pw[ks].y = cvtpk(p0[b + 2], p0[b + 3]); pw[ks].z = cvtpk(p0[b + 4], p0[b + 5]); pw[ks].w = cvtpk(p0[b + 6], p0[b + 7]); }
        else { pw[ks].x = cvtpk(p1[b], p1[b + 1]); pw[ks].y = cvtpk(p1[b + 2], p1[b + 3]); pw[ks].z = cvtpk(p1[b + 4], p1[b + 5]); pw[ks].w = cvtpk(p1[b + 6], p1[b + 7]); } }
}
template <int DV>
__device__ __forceinline__ void pv_tile(LAS const unsigned char* vimg, int lane, int hi, const u32x4 (&pw)[4], f32x16 (&o)[DV / 32]) {
    LAS const unsigned char* vb = vimg + ((lane >> 4) & 1) * 32 + (lane & 3) * 8 + (4 * hi + ((lane & 15) >> 2)) * 64;
    constexpr int ND = DV / 32, NF = 4 * ND;
    constexpr int PD = 4, NB_ = PD + 1;
    s16x4 lo[NB_], hi4[NB_];
#define ATT_VRD(i, b) do { lo[b] = vtr(vb + ((i) % ND) * 4096 + ((i) / ND) * 1024); hi4[b] = vtr(vb + ((i) % ND) * 4096 + ((i) / ND) * 1024 + 512); } while (0)
#pragma unroll
    for (int i = 0; i < PD; ++i) ATT_VRD(i, i);
#pragma unroll
    for (int i = 0; i < NF; ++i) {
        if (i + PD < NF) ATT_VRD(i + PD, (i + PD) % NB_);
        ATT_SB();
        const int b = i % NB_;
        const bf16x8 vf = {lo[b][0], lo[b][1], lo[b][2], lo[b][3], hi4[b][0], hi4[b][1], hi4[b][2], hi4[b][3]};
        o[i % ND] = __builtin_amdgcn_mfma_f32_32x32x16_bf16(vf, __builtin_bit_cast(bf16x8, pw[i / ND]), o[i % ND], 0, 0, 0);
    }
#undef ATT_VRD
}

struct SmState { float mxa, mxb, mn, alpha, ls, delta; bool resc; };
template <int NM>
__device__ __forceinline__ void negm_shift(f32x16 (&negm)[NM], float delta) {
#pragma unroll
    for (int i = 0; i < NM; ++i)
#pragma unroll
        for (int r = 0; r < 16; ++r) negm[i][r] -= delta;
}
__device__ __forceinline__ float xmax32(float v) { auto rr = __builtin_amdgcn_permlane32_swap(__float_as_uint(v), __float_as_uint(v), false, false); return max3f(__uint_as_float(rr[0]), __uint_as_float(rr[1]), v); }
template <int SK> __device__ __forceinline__ constexpr bool sm_live0(int r) { return SK != 2 || r >= 12; }
template <int SK> __device__ __forceinline__ constexpr bool sm_live1(int r) { return SK != 1 || r < 4; }
template <int SK = 0>
__device__ __forceinline__ void sm_slice(int k, f32x16& p0, f32x16& p1, float& m, float& l, SmState& s, u32x4 (&pwn)[4]) {
    if (k <= 3) { const int r = 4 * k;
        if (SK == 0 && k == 0) { s.mxa = max3f(p0[0], p0[1], p1[0]); s.mxb = max3f(p0[2], p0[3], p1[1]); s.mxa = max3f(s.mxa, p1[2], p1[3]); }
        else { if (k == 0) { s.mxa = -INFINITY; s.mxb = -INFINITY; }
            if (sm_live0<SK>(r)) { s.mxa = max3f(s.mxa, p0[r], p0[r + 1]); s.mxb = max3f(s.mxb, p0[r + 2], p0[r + 3]); }
            if (sm_live1<SK>(r)) { s.mxa = max3f(s.mxa, p1[r], p1[r + 1]); s.mxb = max3f(s.mxb, p1[r + 2], p1[r + 3]); } }
        asm volatile("" : "+v"(s.mxa), "+v"(s.mxb)); }
    else if (k == 4) { const float mx0 = xmax32(max3f(s.mxa, s.mxb, s.mxb)); const bool first = m == -INFINITY;
        const float delta = (first || mx0 > 8.f) ? mx0 : 0.f; s.delta = delta; s.mn = first ? mx0 : m + delta; s.alpha = ex2(-delta); s.resc = __any(delta != 0.f); l *= s.alpha; s.ls = 0.f;
        if (s.resc) {
#pragma unroll
            for (int r = 0; r < 16; ++r) { p0[r] -= delta; p1[r] -= delta; }
        }
        asm volatile("" : "+v"(s.mn), "+v"(s.alpha), "+v"(l)); }
    else if (k <= 12) { const int j = 2 * (k - 5);
        if (sm_live0<SK>(j)) { p0[j] = ex2(p0[j]); p0[j + 1] = ex2(p0[j + 1]); s.ls += p0[j] + p0[j + 1]; }
        if (sm_live1<SK>(j)) { p1[j] = ex2(p1[j]); p1[j + 1] = ex2(p1[j + 1]); s.ls += p1[j] + p1[j + 1]; }
        asm volatile("" : "+v"(p0), "+v"(p1), "+v"(s.ls)); }
    else if (k == 13) {
        if (SK == 2) { pwn[0] = u32x4{0u, 0u, 0u, 0u}; pwn[1].x = 0u; pwn[1].y = 0u; }
        else { pwn[0].x = cvtpk(p0[0], p0[1]); pwn[0].y = cvtpk(p0[2], p0[3]); pwn[0].z = cvtpk(p0[4], p0[5]); pwn[0].w = cvtpk(p0[6], p0[7]); pwn[1].x = cvtpk(p0[8], p0[9]); pwn[1].y = cvtpk(p0[10], p0[11]); }
        pwn[1].z = cvtpk(p0[12], p0[13]); pwn[1].w = cvtpk(p0[14], p0[15]); asm volatile("" : "+v"(pwn[0]), "+v"(pwn[1])); }
    else if (k == 14) { pwn[2].x = cvtpk(p1[0], p1[1]); pwn[2].y = cvtpk(p1[2], p1[3]);
        if (SK == 1) { pwn[2].z = 0u; pwn[2].w = 0u; pwn[3] = u32x4{0u, 0u, 0u, 0u}; }
        else { pwn[2].z = cvtpk(p1[4], p1[5]); pwn[2].w = cvtpk(p1[6], p1[7]); pwn[3].x = cvtpk(p1[8], p1[9]); pwn[3].y = cvtpk(p1[10], p1[11]); pwn[3].z = cvtpk(p1[12], p1[13]); pwn[3].w = cvtpk(p1[14], p1[15]); }
        asm volatile("" : "+v"(pwn[2]), "+v"(pwn[3])); }
    else { l += s.ls; asm volatile("" : "+v"(l)); }
}
template <int DV, int NM, int SK = 0>
__device__ __forceinline__ void sm_alone(f32x16& p0, f32x16& p1, f32x16 (&o)[DV / 32], float& m, float& l, u32x4 (&pwn)[4], f32x16 (&negm)[NM]) {
    SmState s;
#pragma unroll
    for (int k = 0; k < 16; ++k) sm_slice<SK>(k, p0, p1, m, l, s, pwn);
    if (s.resc) {
#pragma unroll
        for (int d0 = 0; d0 < DV / 32; ++d0)
#pragma unroll
            for (int r = 0; r < 16; ++r) o[d0][r] *= s.alpha;
        negm_shift<NM>(negm, s.delta);
    }
    m = s.mn;
}
template <int DV, int NM, int SK = 0>
__device__ __forceinline__ void pv_sm_tile(LAS const unsigned char* vimg, int lane, int hi, const u32x4 (&pw)[4], f32x16 (&o)[DV / 32], f32x16& p0, f32x16& p1, float& m, float& l, u32x4 (&pwn)[4], f32x16 (&negm)[NM]) {
    LAS const unsigned char* vb = vimg + ((lane >> 4) & 1) * 32 + (lane & 3) * 8 + (4 * hi + ((lane & 15) >> 2)) * 64;
    constexpr int ND = DV / 32, NF = 4 * ND, PD = 3, NB_ = PD + 1, SPM = 16 / NF;
    s16x4 lo[NB_], hi4[NB_];
    SmState s;
#define ATT_VRD(i, b) do { lo[b] = vtr(vb + ((i) % ND) * 4096 + ((i) / ND) * 1024); hi4[b] = vtr(vb + ((i) % ND) * 4096 + ((i) / ND) * 1024 + 512); } while (0)
#pragma unroll
    for (int i = 0; i < PD; ++i) ATT_VRD(i, i);
#pragma unroll
    for (int i = 0; i < NF; ++i) {
        if (i + PD < NF) ATT_VRD(i + PD, (i + PD) % NB_);
        ATT_SB();
        const int b = i % NB_;
        const bf16x8 vf = {lo[b][0], lo[b][1], lo[b][2], lo[b][3], hi4[b][0], hi4[b][1], hi4[b][2], hi4[b][3]};
        o[i % ND] = __builtin_amdgcn_mfma_f32_32x32x16_bf16(vf, __builtin_bit_cast(bf16x8, pw[i / ND]), o[i % ND], 0, 0, 0);
#pragma unroll
        for (int k = i * SPM; k < (i + 1) * SPM; ++k) sm_slice<SK>(k, p0, p1, m, l, s, pwn);
        ATT_SB();
    }
#undef ATT_VRD
    if (s.resc) {
#pragma unroll
        for (int d0 = 0; d0 < ND; ++d0)
#pragma unroll
            for (int r = 0; r < 16; ++r) o[d0][r] *= s.alpha;
        negm_shift<NM>(negm, s.delta);
    }
    m = s.mn;
}

__device__ __forceinline__ void wait_bar_tiles2(int c) {
    if (c >= 5) ATT_WAIT_BAR(10); else if (c == 4) ATT_WAIT_BAR(8); else if (c == 3) ATT_WAIT_BAR(6); else if (c == 2) ATT_WAIT_BAR(4); else if (c == 1) ATT_WAIT_BAR(2); else ATT_WAIT_BAR(0);
}
template <int DV, class Pol, int NS = 4>
__device__ __forceinline__ void run_unit1(LAS unsigned char* lds, const Pol& P, const Src& src, const bf16* Q, int ldq, int wid, int lane) {
    const int r32 = lane & 31, hi = lane >> 5;
    constexpr int STG = 8192 + DV * 128, NL = 1 + DV / 64, LA = NS - 2;
    static_assert(NL == 2 && LA <= 6, "wait_bar_tiles2 counts two-piece tiles");
    const int nt = P.ntiles();
#pragma unroll
    for (int t = 0; t < LA; ++t) if (t < nt) dma_issue<DV, 1>(src, P.tile_row(t), lds + t * STG, wid, lane);
    bf16x8 qf[4];
    { const bf16* qp = Q + (size_t)(wid * 32 + r32) * ldq + hi * 8;
#pragma unroll
      for (int d0 = 0; d0 < 4; ++d0) qf[d0] = *(const bf16x8*)(qp + d0 * 16); }
    f32x16 o[DV / 32];
#pragma unroll
    for (int d0 = 0; d0 < DV / 32; ++d0) o[d0] = f32x16{};
    float m = -INFINITY, l = 0.f; f32x16 negm[1] = {f32x16{}};
    u32x4 pw[4], pwn[4]; bool pend = false;
    asm volatile("" : "+v"(qf[0]), "+v"(qf[1]), "+v"(qf[2]), "+v"(qf[3]));
    ATT_WAIT_BAR(0);
    int ic = 0;
    for (int ti = 0; ti < nt; ++ti) {
        LAS unsigned char* cur = lds + ic * STG; LAS unsigned char* prv = lds + ((ic + NS - 1) & (NS - 1)) * STG;
        if (ti + LA < nt) dma_issue<DV, 1>(src, P.tile_row(ti + LA), lds + ((ic + LA) & (NS - 1)) * STG, wid, lane);
        if (P.needs(ti, wid)) {
            f32x16 p0, p1;
            qk_tile(cur, qf, r32, hi, p0, p1, negm[0], negm[0]);
            P.mask(ti, wid, r32, hi, p0, p1);
            if (pend) pv_sm_tile<DV, 1>(prv + 8192, lane, hi, pw, o, p0, p1, m, l, pwn, negm); else sm_alone<DV, 1>(p0, p1, o, m, l, pwn, negm);
#pragma unroll
            for (int k = 0; k < 4; ++k) pw[k] = pwn[k];
            pend = true;
        } else if (pend) { pv_tile<DV>(prv + 8192, lane, hi, pw, o); pend = false; }
        wait_bar_tiles2(min(ti + LA, nt - 1) - (ti + 1));
        ic = (ic + 1) & (NS - 1);
    }
    if (pend) pv_tile<DV>(lds + ((ic + NS - 1) & (NS - 1)) * STG + 8192, lane, hi, pw, o);
    P.finish(o, m, l, wid, r32, hi);
    ATT_WAIT_BAR(0);
}
constexpr int ZQ_Z = 65536, ZQ_Q = 98304;
__device__ __forceinline__ void glds4s(const void* sbase_, unsigned voff, unsigned lds_dst) { unsigned keep; const unsigned long long sbase = uni64(sbase_);
    asm volatile("s_mov_b32 %0, m0\n\ts_mov_b32 m0, %3\n\ts_nop 0\n\tglobal_load_lds_dword %1, %2\n\ts_mov_b32 m0, %0" : "=&s"(keep) : "v"(voff), "s"(sbase), "s"(lds_dst) : "memory"); }
__device__ __forceinline__ void dma_rows64(const bf16* base, int ld, LAS unsigned char* dst, int lane) {
    const unsigned vo = (unsigned)((lane & 31) * ld + (lane >> 5) * 8) * 2u;
    const unsigned b0 = (unsigned)(size_t)dst;
#pragma unroll
    for (int j = 0; j < 4; ++j) glds16s(base + j * 16, vo, (unsigned)__builtin_amdgcn_readfirstlane(b0 + j * 1024));
}
template <class Pol, int SKL  , class Ctx, class Gen>
__device__ __forceinline__ void run_stream1(LAS unsigned char* lds, const Ctx& C, const Gen& gen, int wid_, int lane_) {
    constexpr int DV = 64, STG = 16384, EX = Pol::EXTRA;
    static_assert(EX == 4 || EX == 5, "first-step wait counts");
    int lane = lane_, wid = wid_;
#define ZL_ (lds + ZQ_Z + wid * 4096)
#define QL_ (lds + ZQ_Q + wid * 4096)
    Pol P;
    if (!gen(0, P)) return;
    dma_rows64(P.qrow(C, wid), mk::DI, QL_, lane);
    dma_issue<DV, 1>(P.src(C), P.tile_row(0), lds, wid, lane);
    dma_issue<DV, 1>(P.src(C), P.tile_row(1), lds + STG, wid, lane);
    ATT_WAIT_BAR(0);
    int ic = 0;
    for (int i = 0;; ++i) {
        Pol Pn; const bool hn = gen(i + 1, Pn);
        asm volatile("" : "+v"(lane), "+s"(wid));
        bf16x8 qf[4];
#pragma unroll
        for (int d0 = 0; d0 < 4; ++d0) qf[d0] = *(LAS const bf16x8*)(QL_ + d0 * 1024 + lane * 16);
        asm volatile("" : "+v"(qf[0]), "+v"(qf[1]), "+v"(qf[2]), "+v"(qf[3]));
        const int nt = P.ntiles();
        f32x16 o[2] = {f32x16{}, f32x16{}};
        float m = -INFINITY, l = 0.f; f32x16 negm[Pol::NM];
#pragma unroll
        for (int i_ = 0; i_ < Pol::NM; ++i_) negm[i_] = f32x16{};
        u32x4 pw[4], pwn[4]; bool pend = false;
        auto steps = [&](auto skc, int t0, int t1) {
          constexpr int SK_ = decltype(skc)::value;
          for (int ti = t0; ti < t1; ++ti) {
            LAS unsigned char* cur = lds + ic * STG; LAS unsigned char* prv = lds + ((ic + 3) & 3) * STG; LAS unsigned char* nxt = lds + ((ic + 2) & 3) * STG;
            asm volatile("" : "+v"(lane), "+s"(wid)); const int r32 = lane & 31, hi = lane >> 5;
            if (ti == 0) { P.stage_extra(C, ZL_, wid, lane); if (hn) dma_rows64(Pn.qrow(C, wid), mk::DI, QL_, lane); }
            bool issued = true;
            if (ti + 2 < nt) dma_issue<DV, 1>(P.src(C), P.tile_row(ti + 2), nxt, wid, lane);
            else if (hn) dma_issue<DV, 1>(Pn.src(C), Pn.tile_row(ti + 2 - nt), nxt, wid, lane);
            else issued = false;
            P.prep(ti, wid, r32, hi, negm);
            if (P.needs(ti, wid)) {
                f32x16 p0, p1;
                qk_tile(cur, qf, r32, hi, p0, p1, negm[0], negm[Pol::NM - 1]);
                P.template mask<SK_>(C, ti, wid, r32, hi, p0, p1);
                if (pend) pv_sm_tile<DV, Pol::NM, SK_>(prv + 8192, lane, hi, pw, o, p0, p1, m, l, pwn, negm); else sm_alone<DV, Pol::NM, SK_>(p0, p1, o, m, l, pwn, negm);
#pragma unroll
                for (int k = 0; k < 4; ++k) pw[k] = pwn[k];
                pend = true;
            } else if (pend) { pv_tile<DV>(prv + 8192, lane, hi, pw, o); pend = false; }
            if (ti == 0) { if constexpr (EX == 4) { if (hn) ATT_WAIT_BAR(10); else ATT_WAIT_BAR(6); } else { if (hn) ATT_WAIT_BAR(11); else ATT_WAIT_BAR(7); } }
            else if (issued) ATT_WAIT_BAR(2); else ATT_WAIT_BAR(0);
            ic = (ic + 1) & 3;
          }
        };
        if constexpr (SKL == 0) steps(std::integral_constant<int, 0>{}, 0, nt);
        else { steps(std::integral_constant<int, 0>{}, 0, 4);
            steps(std::integral_constant<int, SKL>{}, 4, nt); }
        asm volatile("" : "+v"(lane), "+s"(wid)); const int r32 = lane & 31, hi = lane >> 5;
        if (pend) pv_tile<DV>(lds + ((ic + 3) & 3) * STG + 8192, lane, hi, pw, o);
        P.finish(C, o, m, l, wid, r32, hi, ZL_);
        if (!hn) break;
        P = Pn;
    }
    ATT_WAIT_BAR(0);
#undef ZL_
#undef QL_
}
}
namespace mk {
using att::Src; using att::crow; using att::ex2;

template <int DV>
__device__ __forceinline__ void store_gated(const f32x16 (&o)[DV / 32], float inv, const bf16* zrow, bf16* grow, int hi) {
#pragma unroll
    for (int d0 = 0; d0 < DV / 32; ++d0)
#pragma unroll
        for (int i = 0; i < 4; ++i) { const int d = 32 * d0 + 8 * i + 4 * hi;
            const u32x2 zw = *(const u32x2*)(zrow + d);
            const float v0 = o[d0][4 * i] * inv * silu(bflo(zw.x)), v1 = o[d0][4 * i + 1] * inv * silu(bfhi(zw.x)), v2 = o[d0][4 * i + 2] * inv * silu(bflo(zw.y)), v3 = o[d0][4 * i + 3] * inv * silu(bfhi(zw.y));
            u32x2 w; w.x = att::cvtpk(v0, v1); w.y = att::cvtpk(v2, v3); *(u32x2*)(grow + d) = w; }
}

__device__ __forceinline__ void store_gated_l(const f32x16 (&o)[2], float inv, LAS const unsigned char* zl, bf16* grow, int r32, int hi) {
#pragma unroll
    for (int d0 = 0; d0 < 2; ++d0)
#pragma unroll
        for (int i = 0; i < 4; ++i) { const int d = 32 * d0 + 8 * i + 4 * hi;
            const u32x2 zw = *(LAS const u32x2*)(zl + (2 * d0 + (i >> 1)) * 1024 + (r32 + 32 * (i & 1)) * 16 + 8 * hi);
            const float v0 = o[d0][4 * i] * inv * silu(bflo(zw.x)), v1 = o[d0][4 * i + 1] * inv * silu(bfhi(zw.x)), v2 = o[d0][4 * i + 2] * inv * silu(bflo(zw.y)), v3 = o[d0][4 * i + 3] * inv * silu(bfhi(zw.y));
            u32x2 w; w.x = att::cvtpk(v0, v1); w.y = att::cvtpk(v2, v3); *(u32x2*)(grow + d) = w; }
}

struct AttCtx { const bf16* QG; const bf16* Kb; const bf16* Vb; const bf16* Zb; const float* aux; LAS const float* tab; int dry; };
struct SwaPol {
    static constexpr int EXTRA = 4, NM = 1;
    int bl, hq, qb, tl0, ntl; float sinkl2;
    __device__ __forceinline__ size_t off() const { return ((size_t)bl * RB + CT + qb * 256) * DI + hq * 64; }
    __device__ __forceinline__ Src src(const AttCtx& C) const { Src s; s.K[0] = C.Kb + (hq >> 3) * 64; s.K[1] = nullptr; s.V = C.Vb + (hq >> 3) * 64; s.ldk = 256; s.ldv = 256; return s; }
    __device__ __forceinline__ void prep(int, int, int, int, f32x16 (&)[1]) const {}
    __device__ __forceinline__ int ntiles() const { return 4 + ntl; }
    __device__ __forceinline__ const bf16* qrow(const AttCtx& C, int wid) const { return C.QG + off() + (size_t)(wid * 32) * DI; }
    __device__ __forceinline__ void stage_extra(const AttCtx& C, LAS unsigned char* zl, int wid, int lane) const { att::dma_rows64(C.Zb + off() + (size_t)(wid * 32) * DI, DI, zl, lane); }
    __device__ __forceinline__ size_t tile_row(int ti) const { return (size_t)bl * RB + (ti < 4 ? 64 * ti : CT + 64 * (tl0 + ti - 4)); }
    __device__ __forceinline__ bool needs(int ti, int wid) const { if (ti < 4) return true; const int kt0 = 64 * (tl0 + ti - 4), qw0 = qb * 256 + 32 * wid; return kt0 <= qw0 + 31 + 128 && kt0 + 63 >= qw0 - 128; }
    __device__ __forceinline__ int skip(int, int) const { return 0; }
    template <int SK> __device__ __forceinline__ void mask(const AttCtx&, int ti, int wid, int r32, int hi, f32x16& p0, f32x16& p1) const {
        if (ti < 4) return;
        const int kt0 = 64 * (tl0 + ti - 4), qw0 = qb * 256 + 32 * wid;
        if (kt0 >= qw0 + 31 - 128 && kt0 + 63 <= qw0 + 128) return;
        const int qt = qw0 + r32;
#pragma unroll
        for (int r = 0; r < 16; ++r) { const int kt = kt0 + crow(r, hi); int d0 = kt - qt; d0 = d0 < 0 ? -d0 : d0; int d1 = kt + 32 - qt; d1 = d1 < 0 ? -d1 : d1;
            if (d0 > 128) p0[r] = -INFINITY; if (d1 > 128) p1[r] = -INFINITY; }
    }
    __device__ __forceinline__ void finish(const AttCtx& C, f32x16 (&o)[2], float m, float l, int wid, int r32, int hi, LAS const unsigned char* zl) const {
        const float mn = fmaxf(m, sinkl2), alpha = ex2(m - mn);
        const float lt = (l + __shfl_xor(l, 32)) * alpha + ex2(sinkl2 - mn);
        const float inv = alpha / lt;
        if (!C.dry) store_gated_l(o, inv, zl, (bf16*)C.QG + off() + (size_t)(wid * 32 + r32) * DI, r32, hi);
    }
};
__device__ __forceinline__ void swa_phase(Frame& F, const Args& a, int g, int dry) {
    int lane_ = pg8::hw_lane(), wave_ = F.wave; asm volatile("" : "+v"(lane_), "+s"(wave_));
    AttCtx C; C.QG = (const bf16*)(a.ws + WS_QG) + (size_t)g * MH * DI; C.Kb = (const bf16*)(a.ws + WS_S2); C.Vb = C.Kb + (size_t)MH * 256; C.Zb = (const bf16*)(a.ws + WS_S4); C.aux = a.in[30]; C.tab = nullptr; C.dry = dry;
    const int G = F.G, vcu = F.vcu;
    auto gen = [&](int i, SwaPol& P) -> bool {
        const int id = i * G + vcu; if (id >= HB * 32 * 8) return false;
        P.qb = (id + i) & 7; P.hq = (id >> 3) & 31; P.bl = id >> 8;
        P.tl0 = max(0, 4 * P.qb - 2); P.ntl = min(31, 4 * P.qb + 5) - P.tl0 + 1; P.sinkl2 = C.aux[P.hq] * LOG2E;
        return true; };
    att::run_stream1<SwaPol, 0>(F.lds, C, gen, wave_, lane_);
}

constexpr int NA_TAB_OFF = RING_BYTES + 512;
struct NaPol {
    static constexpr int EXTRA = 5, NM = 2;
    int bl, hq, qb, krow0, ntl, isctx;
    __device__ __forceinline__ size_t off() const { return ((size_t)bl * RB + (isctx ? 0 : CT + qb * 256)) * DI + hq * 64; }
    __device__ __forceinline__ Src src(const AttCtx& C) const { Src s; s.K[0] = C.Kb + hq * 64; s.K[1] = nullptr; s.V = C.Vb + hq * 64; s.ldk = DI; s.ldv = DI; return s; }
    __device__ __forceinline__ void prep(int ti, int wid, int r32, int hi, f32x16 (&negm)[2]) const {
        if (ti != 4) return;
        const int gc = 32 * (wid & 1) + r32, cs = min(max(gc - 8, 0), 48);
#pragma unroll
        for (int r = 0; r < 16; ++r) { const int kc = crow(r, hi);
            if (!(kc >= cs && kc < cs + 16)) negm[0][r] = -INFINITY;
            if (!(kc + 32 >= cs && kc + 32 < cs + 16)) negm[1][r] = -INFINITY; }
    }
    __device__ __forceinline__ int ntiles() const { return 4 + ntl; }
    __device__ __forceinline__ const bf16* qrow(const AttCtx& C, int wid) const { return C.QG + off() + (size_t)(wid * 32) * DI; }
    __device__ __forceinline__ void stage_extra(const AttCtx& C, LAS unsigned char* zl, int wid, int lane) const {
        att::dma_rows64(C.Zb + off() + (size_t)(wid * 32) * DI, DI, zl, lane);
        att::glds4s(C.aux + hq * 465, (unsigned)min(wid * 64 + lane, 464) * 4u, (unsigned)__builtin_amdgcn_readfirstlane((unsigned)(size_t)C.tab + wid * 256));
    }
    __device__ __forceinline__ size_t tile_row(int ti) const { return (size_t)bl * RB + (ti < 4 ? 64 * ti : CT + 64 * (krow0 + ti - 4)); }
    __device__ __forceinline__ bool needs(int ti, int wid) const { if (ti < 4) return true; const int gr = 4 * qb + (wid >> 1), rs = min(max(gr - 4, 0), 24), kr = krow0 + ti - 4; return kr >= rs && kr < rs + 8; }
    __device__ __forceinline__ int skip(int ti, int wid) const { return ti < 4 ? 0 : 1 + (wid & 1); }
    template <int SK> __device__ __forceinline__ void mask(const AttCtx& C, int ti, int wid, int r32, int hi, f32x16& p0, f32x16& p1) const {
        if (ti < 4) return;
        const int gr = 4 * qb + (wid >> 1), gc = 32 * (wid & 1) + r32, kr = krow0 + ti - 4;
        LAS const float* trow = C.tab + (kr - gr + 7) * 31 + 15 - gc;
#pragma unroll
        for (int r = 0; r < 16; ++r) { const int kc = crow(r, hi);
            if (att::sm_live0<SK>(r)) p0[r] = fmaf(trow[kc], LOG2E, p0[r]);
            if (att::sm_live1<SK>(r)) p1[r] = fmaf(trow[kc + 32], LOG2E, p1[r]);
            if ((r & 3) == 3) __builtin_amdgcn_sched_barrier(0); }
    }
    __device__ __forceinline__ void finish(const AttCtx& C, f32x16 (&o)[2], float m, float l, int wid, int r32, int hi, LAS const unsigned char* zl) const {
        const float inv = 1.f / (l + __shfl_xor(l, 32));
        if (!C.dry) store_gated_l(o, inv, zl, (bf16*)C.QG + off() + (size_t)(wid * 32 + r32) * DI, r32, hi);
    }
};
__device__ __forceinline__ void na_phase(Frame& F, const Args& a, int g, int dry) {
    int lane_ = pg8::hw_lane(), wave_ = F.wave; asm volatile("" : "+v"(lane_), "+s"(wave_));
    AttCtx C; C.QG = (const bf16*)(a.ws + WS_QG) + (size_t)g * MH * DI; C.Kb = (const bf16*)(a.ws + WS_S2); C.Vb = (const bf16*)(a.ws + WS_S3); C.Zb = (const bf16*)(a.ws + WS_S4); C.aux = a.in[27]; C.tab = (LAS const float*)(F.lds + NA_TAB_OFF); C.dry = dry;
    constexpr int NLAT = HB * 32 * 8, NCTX = HB * 32;
    const int G = F.G, vcu = F.vcu;
    auto gen = [&](int i, NaPol& P) -> bool {
        const int id = i * G + vcu; if (id >= NLAT + NCTX) return false;
        if (id < NLAT) { P.isctx = 0; P.qb = (id + i) & 7; P.hq = (id >> 3) & 31; P.bl = id >> 8; P.krow0 = min(max(4 * P.qb - 4, 0), 24); P.ntl = min(max(4 * P.qb + 3 - 4, 0), 24) + 7 - P.krow0 + 1; }
        else { const int j = id - NLAT; P.isctx = 1; P.qb = 0; P.hq = j & 31; P.bl = j >> 5; P.krow0 = 0; P.ntl = 0; }
        return true; };
    if (wave_ & 1) att::run_stream1<NaPol, 2>(F.lds, C, gen, wave_, lane_); else att::run_stream1<NaPol, 1>(F.lds, C, gen, wave_, lane_);
}

template <int COMP>
__device__ __forceinline__ void diff_unit(LAS unsigned char* lds, const Src& src, const bf16* Q  , const bf16* zb, bf16* gb, size_t trow0, int nt, float lam, float lam_init, const float* sg, int wid, int lane, int dry) {
    const int r32 = lane & 31, hi = lane >> 5, wq = wid & 3; constexpr int comp = COMP;
    constexpr int STG = 32768;
    att::dma_issue<128, 2>(src, trow0, lds, wid, lane);
    if (nt > 1) att::dma_issue<128, 2>(src, trow0 + 64, lds + STG, wid, lane);
    bf16x8 qf[4];
    { const bf16* qp = Q + (size_t)(wq * 32 + r32) * DI + comp * 64 + hi * 8;
#pragma unroll
      for (int d0 = 0; d0 < 4; ++d0) qf[d0] = *(const bf16x8*)(qp + d0 * 16); }
    f32x16 o[4];
#pragma unroll
    for (int d0 = 0; d0 < 4; ++d0) o[d0] = f32x16{};
    float m = -INFINITY, l = 0.f; f32x16 negm[1] = {f32x16{}};
    u32x4 pw[4], pwn[4];
    asm volatile("" : "+v"(qf[0]), "+v"(qf[1]), "+v"(qf[2]), "+v"(qf[3]));
    ATT_WAIT_BAR(0);
    if constexpr (COMP == 0) {
        int ic = 0;
        for (int ti = 0; ti < nt; ++ti) {
            LAS unsigned char* cur = lds + ic * STG; LAS unsigned char* prv = lds + ((ic + 3) & 3) * STG;
            if (ti >= 1 && ti + 1 < nt) att::dma_issue<128, 2>(src, trow0 + 64 * (ti + 1), lds + ((ic + 1) & 3) * STG, wid, lane);
            { f32x16 p0, p1; att::qk_tile(cur, qf, r32, hi, p0, p1, negm[0], negm[0]);
              if (ti > 0) att::pv_sm_tile<128, 1>(prv + 16384, lane, hi, pw, o, p0, p1, m, l, pwn, negm); else att::sm_alone<128, 1>(p0, p1, o, m, l, pwn, negm); }
#pragma unroll
            for (int k = 0; k < 4; ++k) pw[k] = pwn[k];
            ATT_WAIT_BAR(0);
            ic = (ic + 1) & 3;
        }
        att::pv_tile<128>(lds + ((ic + 3) & 3) * STG + 16384, lane, hi, pw, o);
    } else {
        f32x16 p0, p1;
        att::qk_tile(lds + 8192, qf, r32, hi, p0, p1, negm[0], negm[0]);
        ATT_WAIT_BAR(0);
        int ic = 1;
        for (int ti = 1; ti < nt; ++ti) {
            LAS unsigned char* cur = lds + ic * STG; LAS unsigned char* pv2 = lds + ((ic + 2) & 3) * STG;
            if (ti + 1 < nt) att::dma_issue<128, 2>(src, trow0 + 64 * (ti + 1), lds + ((ic + 1) & 3) * STG, wid, lane);
            if (ti >= 2) att::pv_sm_tile<128, 1>(pv2 + 16384, lane, hi, pw, o, p0, p1, m, l, pwn, negm); else att::sm_alone<128, 1>(p0, p1, o, m, l, pwn, negm);
#pragma unroll
            for (int k = 0; k < 4; ++k) pw[k] = pwn[k];
            att::qk_tile(cur + 8192, qf, r32, hi, p0, p1, negm[0], negm[0]);
            ATT_WAIT_BAR(0);
            ic = (ic + 1) & 3;
        }
        if (nt >= 2) att::pv_sm_tile<128, 1>(lds + ((ic + 2) & 3) * STG + 16384, lane, hi, pw, o, p0, p1, m, l, pwn, negm); else att::sm_alone<128, 1>(p0, p1, o, m, l, pwn, negm);
#pragma unroll
        for (int k = 0; k < 4; ++k) pw[k] = pwn[k];
        att::pv_tile<128>(lds + ((ic + 3) & 3) * STG + 16384, lane, hi, pw, o);
    }
    ATT_WAIT_BAR(0);
    const float inv = 1.f / (l + __shfl_xor(l, 32));
    LAS float* xb = (LAS float*)lds;
    if (comp == 1) {
#pragma unroll
        for (int d0 = 0; d0 < 4; ++d0)
#pragma unroll
            for (int r = 0; r < 16; ++r) xb[((wq * 64 + d0 * 16 + r) * 64) + lane] = o[d0][r] * inv;
    }
    __syncthreads();
    if (comp == 0 && !dry) {
        float ss = 0.f;
#pragma unroll
        for (int d0 = 0; d0 < 4; ++d0)
#pragma unroll
            for (int r = 0; r < 16; ++r) { const float v = o[d0][r] * inv - lam * xb[((wq * 64 + d0 * 16 + r) * 64) + lane]; o[d0][r] = v; ss += v * v; }
        ss += __shfl_xor(ss, 32);
        const float rs = rsqrtf(ss * (1.f / 128.f) + EPS) * (1.f - lam_init);
        const size_t ro = (size_t)(wq * 32 + r32) * DI;
#pragma unroll
        for (int d0 = 0; d0 < 4; ++d0)
#pragma unroll
            for (int i = 0; i < 4; ++i) { const int d = 32 * d0 + 8 * i + 4 * hi; const f32x4 gg = *(const f32x4*)(sg + d); const u32x2 zw = *(const u32x2*)(zb + ro + d);
                const float v0 = o[d0][4 * i] * rs * gg.x * silu(bflo(zw.x)), v1 = o[d0][4 * i + 1] * rs * gg.y * silu(bfhi(zw.x)), v2 = o[d0][4 * i + 2] * rs * gg.z * silu(bflo(zw.y)), v3 = o[d0][4 * i + 3] * rs * gg.w * silu(bfhi(zw.y));
                u32x2 w; w.x = att::cvtpk(v0, v1); w.y = att::cvtpk(v2, v3); *(u32x2*)(gb + ro + d) = w; }
    }
    asm volatile("s_waitcnt lgkmcnt(0)\n\ts_barrier" ::: "memory");
}
__device__ __forceinline__ void diff_phase(Frame& F, const Args& a, int g, int dry) {
#ifdef MK_TOUCH2
    {
        const int j = F.vcu & 31; unsigned accv = 0u;
        for (size_t off = ((size_t)j * NTHR + F.wave * 64 + pg8::hw_lane()) * 4096; off < (size_t)216 * MiB; off += (size_t)32 * NTHR * 4096) accv += *(const unsigned*)(a.ws + WS_S2 + off);
        for (size_t off = ((size_t)j * NTHR + F.wave * 64 + pg8::hw_lane()) * 4096; off < (size_t)72 * MiB; off += (size_t)32 * NTHR * 4096) accv += *(const unsigned*)(a.ws + WS_QG + (size_t)g * MH * DI * 2 + off);
        asm volatile("" :: "v"(accv));
    }
#endif
    int lane_ = pg8::hw_lane(), wave_ = F.wave; asm volatile("" : "+v"(lane_), "+s"(wave_));
    const bf16* QG = (const bf16*)(a.ws + WS_QG) + (size_t)g * MH * DI; const bf16* Kb = (const bf16*)(a.ws + WS_S2); const bf16* Vb = (const bf16*)(a.ws + WS_S3); const bf16* Zb = (const bf16*)(a.ws + WS_S4);
    const float lam_init = 0.8f - 0.6f * expf(-0.3f);
    float sa = 0.f, sb = 0.f;
    for (int i = 0; i < 64; ++i) { sa += a.in[20][i] * a.in[21][i]; sb += a.in[22][i] * a.in[23][i]; }
    const float lam = expf(sa) - expf(sb) + lam_init;
    constexpr int NLAT = HB * 16 * 16, NCTX = HB * 16 * 2;
    const int G = F.G, vcu = F.vcu; LAS unsigned char* lds = F.lds; const float* sg = a.in[24];
    auto units = [&](auto cc) {
        constexpr int COMP = decltype(cc)::value;
        for (int i = 0;; ++i) {
            const int id = i * G + vcu; if (id >= NLAT + NCTX) break;
            int bl, h, qb, nt; size_t row0;
            if (id < NLAT) { qb = id & 15; h = (id >> 4) & 15; bl = id >> 8; nt = RB / 64; row0 = (size_t)bl * RB + CT + qb * 128; }
            else { const int j = id - NLAT; qb = j & 1; h = (j >> 1) & 15; bl = j >> 5; nt = CT / 64; row0 = (size_t)bl * RB + qb * 128; }
            Src s; s.K[0] = Kb + (2 * h) * 64; s.K[1] = Kb + (2 * h + 1) * 64; s.V = Vb + h * 128; s.ldk = DI; s.ldv = DI;
            diff_unit<COMP>(lds, s, QG + row0 * DI + h * 128, Zb + row0 * DI + h * 128, (bf16*)QG + row0 * DI + h * 128, (size_t)bl * RB, nt, lam, lam_init, sg, wave_, lane_, dry);
        }
    };
    if (wave_ >> 2) units(std::integral_constant<int, 1>{}); else units(std::integral_constant<int, 0>{});
}
}
namespace mk {
typedef float f32x4v __attribute__((ext_vector_type(4)));
__device__ __forceinline__ void seq_bounds(int row, int& lo, int& hi) { const int rr = row % RB, b0 = row - rr; if (rr < CT) { lo = b0; hi = b0 + CT; } else { lo = b0 + CT; hi = b0 + RB; } }

#ifndef MK_GATES_Q
#define MK_GATES_Q 4
#endif
__device__ __forceinline__ void mlstm_gates_phase(Frame& F, const Args& a, int g) {
    int lane = pg8::hw_lane(), wave = F.wave; asm volatile("" : "+v"(lane), "+s"(wave));
    const bf16* XM = (const bf16*)(a.ws + WS_S2); const bf16* W2 = (const bf16*)(a.ws + WS_WG2);
    bf16* XC = g == 0 ? (bf16*)(a.ws + WS_QG) + (size_t)MH * DI : (bf16*)(a.ws + WS_H);
    const float* cw = a.in[9]; const float* cb = a.in[10]; const float* bg = a.in[15];
    LAS float* T = (LAS float*)F.lds;
    constexpr int G_W2S = 49152;
    const int khw = (int)blockIdx.x & 3;
    { const int tid = wave * 64 + lane;
      for (int i = tid; i < 5 * 2048 / 4; i += NTHR) *(LAS f32x4v*)(T + 4 * i) = *(const f32x4v*)(cw + 4 * i);
      for (int i = tid; i < 2048 / 4; i += NTHR) *(LAS f32x4v*)(T + 10240 + 4 * i) = *(const f32x4v*)(cb + 4 * i);
      for (int i = tid; i < 64 * 64; i += NTHR) { const int rw = i >> 6, c8 = (i & 63) * 8;
          *(LAS u32x4*)(F.lds + G_W2S + (rw * 520 + c8) * 2) = *(const u32x4*)(W2 + (size_t)(rw >> 1) * 4096 + (rw & 1) * 2048 + khw * 512 + c8); }
      __syncthreads(); }
    const int r = lane & 15, kq = lane >> 4;
    constexpr int GQ = MK_GATES_Q;
    for (int grp = ((int)blockIdx.x >> 2) + 64 * wave; grp < MH / 16; grp += 64 * NWAVES) {
        const int kh = khw;
        float* gates = (float*)(a.ws + (kh == 0 ? WS_GATES : kh == 1 ? WS_GATES2 : kh == 2 ? WS_GATES3 : WS_GATES4));
        const int row = grp * 16 + r; int lo, hi; seq_bounds(row, lo, hi);
        pg8::f32x4 acc0 = {0.f, 0.f, 0.f, 0.f}, acc1 = {0.f, 0.f, 0.f, 0.f};
        for (int sb = 0; sb < 16 / GQ; ++sb) {
            u32x4 xr[GQ][5];
#pragma unroll
            for (int q = 0; q < GQ; ++q) { const int c0 = kh * 512 + (sb * GQ + q) * 32 + 8 * kq;
#pragma unroll
                for (int j = 0; j < 5; ++j) { const int tt = row + j - 2; xr[q][j] = (tt >= lo && tt < hi) ? *(const u32x4*)(XM + (size_t)tt * DI + c0) : (u32x4){0u, 0u, 0u, 0u}; }
            }
#pragma unroll
            for (int q = 0; q < GQ; ++q) { const int c0 = kh * 512 + (sb * GQ + q) * 32 + 8 * kq;
                const int cl = c0 - kh * 512; LAS const unsigned char* wl = F.lds + G_W2S + cl * 2;
                const bf16x8 wf0 = *(LAS const bf16x8*)(wl + (2 * r) * 1040), wf1 = *(LAS const bf16x8*)(wl + (2 * (r + 16)) * 1040), wf2 = *(LAS const bf16x8*)(wl + (2 * r + 1) * 1040), wf3 = *(LAS const bf16x8*)(wl + (2 * (r + 16) + 1) * 1040);
                const f32x4v b0 = *(LAS const f32x4v*)(T + 10240 + c0), b1 = *(LAS const f32x4v*)(T + 10240 + c0 + 4);
                float av[8] = {b0.x, b0.y, b0.z, b0.w, b1.x, b1.y, b1.z, b1.w};
#pragma unroll
                for (int j = 0; j < 5; ++j) { const u32x4 x = xr[q][j];
                    const f32x4v w0 = *(LAS const f32x4v*)(T + j * DI + c0), w1 = *(LAS const f32x4v*)(T + j * DI + c0 + 4);
                    av[0] += bflo(x.x) * w0.x; av[1] += bfhi(x.x) * w0.y; av[2] += bflo(x.y) * w0.z; av[3] += bfhi(x.y) * w0.w;
                    av[4] += bflo(x.z) * w1.x; av[5] += bfhi(x.z) * w1.y; av[6] += bflo(x.w) * w1.z; av[7] += bfhi(x.w) * w1.w; }
                u32x4 xcw; xcw.x = att::cvtpk(silu(av[0]), silu(av[1])); xcw.y = att::cvtpk(silu(av[2]), silu(av[3])); xcw.z = att::cvtpk(silu(av[4]), silu(av[5])); xcw.w = att::cvtpk(silu(av[6]), silu(av[7]));
                *(u32x4*)(XC + (size_t)row * DI + c0) = xcw;
                const bf16x8 axc = __builtin_bit_cast(bf16x8, xcw), axm = __builtin_bit_cast(bf16x8, xr[q][2]);
                acc0 = __builtin_amdgcn_mfma_f32_16x16x32_bf16(axc, wf0, acc0, 0, 0, 0); acc1 = __builtin_amdgcn_mfma_f32_16x16x32_bf16(axc, wf1, acc1, 0, 0, 0);
                acc0 = __builtin_amdgcn_mfma_f32_16x16x32_bf16(axm, wf2, acc0, 0, 0, 0); acc1 = __builtin_amdgcn_mfma_f32_16x16x32_bf16(axm, wf3, acc1, 0, 0, 0); }
        }
        const float bg0 = kh == 0 ? bg[r] : 0.f, bg1 = kh == 0 ? bg[16 + r] : 0.f;
#pragma unroll
        for (int rg = 0; rg < 4; ++rg) { const size_t tk = (size_t)grp * 16 + 4 * kq + rg; gates[tk * 32 + r] = acc0[rg] + bg0; gates[tk * 32 + 16 + r] = acc1[rg] + bg1; }
    }
    __syncthreads();
}

#define ML_BAR() asm volatile("s_waitcnt lgkmcnt(0)\n\ts_barrier" ::: "memory")
#ifndef MK_SC_A
#define MK_SC_A 1
#endif
#ifndef MK_SC_B
#define MK_SC_B 1
#endif
constexpr int ML_QS = 0, ML_KS = 33792, ML_VS = 67584, ML_P = 84992, ML_HO = 94208, ML_F = 110592;
constexpr int ML_W1 = RING_BYTES + 512  , ML_WV = 115200  ;
constexpr int ML_KSTR = 528, ML_VSTR = 272, ML_PSTR = 144;
__device__ __forceinline__ int ml_row(int base, int dir, int s) { return base + (dir == 0 ? s : (s < CT ? CT - 1 - s : CT + (S - 1) - (s - CT))); }
__device__ __forceinline__ s16x4 ml_tr(LAS const unsigned char* p) { return __builtin_bit_cast(s16x4, __builtin_amdgcn_ds_read_tr16_b64_v4i16((LAS att::v4i16_t*)p)); }
__device__ __forceinline__ void mlstm_scan_phase(Frame& F, const Args& a, int g) {
    int tid0 = F.wave * 64 + pg8::hw_lane(); asm volatile("" : "+v"(tid0));
    const int wid = __builtin_amdgcn_readfirstlane(tid0 >> 6);
    const int u = F.vcu; if (u >= HB * 8 * 2 * 2) return;
    const int dvh = u & 1, dir = (u >> 1) & 1, h = (u >> 2) & 7, bl = u >> 5;
    const bf16* XM = (const bf16*)(a.ws + WS_S2); const float* gates = (const float*)(a.ws + WS_GATES); const float* gates2 = (const float*)(a.ws + WS_GATES2); const float* gates3 = (const float*)(a.ws + WS_GATES3); const float* gates4 = (const float*)(a.ws + WS_GATES4);
    const bf16* XC = g == 0 ? (const bf16*)(a.ws + WS_QG) + (size_t)MH * DI : (const bf16*)(a.ws + WS_H);
    bf16* Hd = dir == 0 ? (bf16*)(a.ws + WS_QG) + (size_t)g * MH * DI : (bf16*)(a.ws + WS_S4);
    const float* cw = a.in[9]; const float* cb = a.in[10]; const float* wq = a.in[11]; const float* wk = a.in[12]; const float* wv = a.in[13];
    LAS unsigned char* L = F.lds; LAS float* Ff = (LAS float*)(L + ML_F);
    pg8::f32x4 C[16];
#pragma unroll
    for (int i = 0; i < 16; ++i) C[i] = (pg8::f32x4){0.f, 0.f, 0.f, 0.f};
    int tid = tid0;
    if (tid < 256) { Ff[640 + tid] = 0.f; }
    {
        LAS float* W1 = (LAS float*)(L + ML_W1); LAS float* WV = (LAS float*)(L + ML_WV);
        for (int i = tid; i < 5 * 256; i += NTHR) W1[i] = cw[(i >> 8) * DI + h * 256 + (i & 255)];
        if (tid < 256) W1[1280 + tid] = cb[h * 256 + tid];
        for (int i = tid; i < 1024; i += NTHR) { W1[1536 + i] = wq[h * 1024 + i]; W1[2560 + i] = wk[h * 1024 + i]; WV[i] = wv[h * 1024 + i]; }
        __syncthreads();
    }
    LAS const float* W1 = (LAS const float*)(L + ML_W1); LAS const float* WV = (LAS const float*)(L + ML_WV);
    bf16x8 aq[2], ak[2], av_[2], aql[2], akl[2], avl[2];
    { const int o = tid0 & 15, g4 = (tid0 >> 4) & 3;
#pragma unroll
      for (int n = 0; n < 2; ++n) { const int bo = 4 * n + (o >> 2); u32x4 fq, fk, fv, lq, lk, lv; unsigned* pq = (unsigned*)&fq; unsigned* pk_ = (unsigned*)&fk; unsigned* pv_ = (unsigned*)&fv; unsigned* qq_ = (unsigned*)&lq; unsigned* qk_ = (unsigned*)&lk; unsigned* qv_ = (unsigned*)&lv;
#pragma unroll
          for (int jp = 0; jp < 4; ++jp) { float q2[2], k2[2], v2[2], q2l[2], k2l[2], v2l[2];
#pragma unroll
              for (int e = 0; e < 2; ++e) { const int j = 2 * jp + e, bi = 2 * g4 + (j >> 2); const bool nz = bi == bo; const int gb = wid * 8 + bo, idx = gb * 16 + (j & 3) * 4 + (o & 3);
                  q2[e] = nz ? W1[1536 + idx] : 0.f; k2[e] = nz ? W1[2560 + idx] * 0.0625f : 0.f; v2[e] = nz ? WV[idx] : 0.f;
                  q2l[e] = q2[e] - bf2f((unsigned short)f2bf(q2[e])); k2l[e] = k2[e] - bf2f((unsigned short)f2bf(k2[e])); v2l[e] = v2[e] - bf2f((unsigned short)f2bf(v2[e])); }
              pq[jp] = pk2(q2[0], q2[1]); pk_[jp] = pk2(k2[0], k2[1]); pv_[jp] = pk2(v2[0], v2[1]);
              qq_[jp] = pk2(q2l[0], q2l[1]); qk_[jp] = pk2(k2l[0], k2l[1]); qv_[jp] = pk2(v2l[0], v2l[1]); }
          aq[n] = __builtin_bit_cast(bf16x8, fq); ak[n] = __builtin_bit_cast(bf16x8, fk); av_[n] = __builtin_bit_cast(bf16x8, fv);
          aql[n] = __builtin_bit_cast(bf16x8, lq); akl[n] = __builtin_bit_cast(bf16x8, lk); avl[n] = __builtin_bit_cast(bf16x8, lv); } }
    const int base = bl * RB;
    u32x4 xw[8];
#define ML_LOADX(cc) do { const int rlo_ = dir ? ml_row(base, 1, (cc) * 64 + 63) : ml_row(base, 0, (cc) * 64); \
        const size_t o_ = (size_t)(rlo_ + (tid0 & 15)) * DI + h * 256 + wid * 32 + ((tid0 >> 4) & 3) * 8; \
        _Pragma("unroll") for (int i_ = 0; i_ < 4; ++i_) { xw[i_] = *(const u32x4*)(XM + o_ + (size_t)(16 * i_) * DI); xw[4 + i_] = *(const u32x4*)(XC + o_ + (size_t)(16 * i_) * DI); } } while (0)
    float gpre[8] = {0.f, 0.f, 0.f, 0.f, 0.f, 0.f, 0.f, 0.f};
#define ML_LOADG(cc) do { if (wid == 0) { const size_t gi_ = (size_t)ml_row(base, dir, (cc) * 64 + (tid0 & 63)) * 32 + (2 * dir) * 8 + h; \
        gpre[0] = gates[gi_]; gpre[1] = gates2[gi_]; gpre[2] = gates3[gi_]; gpre[3] = gates4[gi_]; gpre[4] = gates[gi_ + 8]; gpre[5] = gates2[gi_ + 8]; gpre[6] = gates3[gi_ + 8]; gpre[7] = gates4[gi_ + 8]; } } while (0)
    ML_LOADX(0); ML_LOADG(0);
    for (int c = 0; c < RB / 64; ++c) {
        const int par = c & 1;
        tid = tid0; asm volatile("" : "+v"(tid));
        const int lane = tid & 63, l15 = lane & 15, gq = lane >> 4;
#pragma unroll 1
        for (int repA_ = 0; repA_ < MK_SC_A; ++repA_) {
        {
            const bool hasv = (wid >> 2) == dvh;
            const pg8::f32x4 z4 = {0.f, 0.f, 0.f, 0.f};
#pragma unroll
            for (int tt = 0; tt < 4; ++tt) {
                const bf16x8 bxm = __builtin_bit_cast(bf16x8, xw[tt]), bxc = __builtin_bit_cast(bf16x8, xw[4 + tt]);
                const int mrow = 16 * tt + l15, t = dir ? 63 - mrow : mrow;
#pragma unroll
                for (int n = 0; n < 2; ++n) {
                    const pg8::f32x4 dq = __builtin_amdgcn_mfma_f32_16x16x32_bf16(aq[n], bxc, __builtin_amdgcn_mfma_f32_16x16x32_bf16(aql[n], bxc, z4, 0, 0, 0), 0, 0, 0), dk = __builtin_amdgcn_mfma_f32_16x16x32_bf16(ak[n], bxc, __builtin_amdgcn_mfma_f32_16x16x32_bf16(akl[n], bxc, z4, 0, 0, 0), 0, 0, 0);
                    const int cl = wid * 32 + 16 * n + 4 * gq;
                    u32x2 w2; w2.x = att::cvtpk(dq[0], dq[1]); w2.y = att::cvtpk(dq[2], dq[3]); *(LAS u32x2*)(L + ML_QS + t * ML_KSTR + cl * 2) = w2;
                    w2.x = att::cvtpk(dk[0], dk[1]); w2.y = att::cvtpk(dk[2], dk[3]); *(LAS u32x2*)(L + ML_KS + t * ML_KSTR + cl * 2) = w2;
                    if (hasv) { const pg8::f32x4 dv = __builtin_amdgcn_mfma_f32_16x16x32_bf16(av_[n], bxm, __builtin_amdgcn_mfma_f32_16x16x32_bf16(avl[n], bxm, z4, 0, 0, 0), 0, 0, 0);
                        w2.x = att::cvtpk(dv[0], dv[1]); w2.y = att::cvtpk(dv[2], dv[3]); *(LAS u32x2*)(L + ML_VS + t * ML_VSTR + (cl & 127) * 2) = w2; }
                }
            }
        }
#if defined(MK_SC_G2)
        for (int repg_ = 0; repg_ < 2; ++repg_)
#endif
        if (wid == 0) {
            const float gi = (gpre[0] + gpre[1]) + (gpre[2] + gpre[3]), gf = (gpre[4] + gpre[5]) + (gpre[6] + gpre[7]);
            const float lf = fminf(gf, 0.f) - log1pf(__expf(-fabsf(gf)));
            float b = lf;
#pragma unroll
            for (int o = 1; o < 64; o <<= 1) { const float y = __shfl_up(b, o); if (lane >= o) b += y; }
            const float bend = __shfl(b, 63);
            Ff[lane] = b * LOG2E; Ff[64 + lane] = (gi - b) * LOG2E; Ff[128 + lane] = __expf(b); Ff[192 + lane] = __expf(bend - b + gi);
            if (lane == 0) Ff[576] = __expf(bend);
        }
        }
        ML_BAR();
#if defined(MK_SC_L2)
        if (c + 1 < RB / 64) { ML_LOADX(c + 1); ML_LOADG(c + 1); asm volatile("" : "+v"(xw[0]), "+v"(xw[1]), "+v"(xw[2]), "+v"(xw[3]), "+v"(xw[4]), "+v"(xw[5]), "+v"(xw[6]), "+v"(xw[7])); }
#endif
        if (c + 1 < RB / 64) { ML_LOADX(c + 1); ML_LOADG(c + 1); }
        for (int repB_ = 0; repB_ < MK_SC_B; ++repB_) {
        {
            const int si = wid >> 1;
            pg8::f32x4 st[2] = {{0.f, 0.f, 0.f, 0.f}, {0.f, 0.f, 0.f, 0.f}};
            LAS const unsigned char* kp = L + ML_KS + (16 * si + l15) * ML_KSTR + gq * 16;
            LAS const unsigned char* qp0 = L + ML_QS + (16 * (2 * (wid & 1)) + l15) * ML_KSTR + gq * 16;
#pragma unroll
            for (int ks = 0; ks < 8; ++ks) {
                const bf16x8 ka = *(LAS const bf16x8*)(kp + ks * 64);
                const bf16x8 q0 = *(LAS const bf16x8*)(qp0 + ks * 64), q1 = *(LAS const bf16x8*)(qp0 + 16 * ML_KSTR + ks * 64);
                st[0] = __builtin_amdgcn_mfma_f32_16x16x32_bf16(ka, q0, st[0], 0, 0, 0);
                st[1] = __builtin_amdgcn_mfma_f32_16x16x32_bf16(ka, q1, st[1], 0, 0, 0);
            }
            const f32x4v al = *(LAS const f32x4v*)(Ff + 64 + 16 * si + 4 * gq);
            const float alv[4] = {al.x, al.y, al.z, al.w};
#pragma unroll
            for (int e = 0; e < 2; ++e) {
                const int ti = 2 * (wid & 1) + e, t = 16 * ti + l15; const float bt = Ff[t];
                float pv[4], rsum = 0.f;
#pragma unroll
                for (int r = 0; r < 4; ++r) { const int s = 16 * si + 4 * gq + r; const float wgt = (s <= t) ? att::ex2(bt + alv[r]) : 0.f; pv[r] = st[e][r] * wgt; rsum += pv[r]; }
                u32x2 w2; w2.x = att::cvtpk(pv[0], pv[1]); w2.y = att::cvtpk(pv[2], pv[3]);
                *(LAS u32x2*)(L + ML_P + t * ML_PSTR + (16 * si + 4 * gq) * 2) = w2;
                rsum += __shfl_xor(rsum, 16); rsum += __shfl_xor(rsum, 32);
                if (gq == 0) Ff[320 + si * 64 + t] = rsum;
            }
        }
        {
            const int t = tid >> 3, part = tid & 7; LAS const float* np_ = Ff + 640 + par * 256 + part * 32; LAS const unsigned char* qrow = L + ML_QS + t * ML_KSTR + part * 64;
            float acc = 0.f;
#pragma unroll
            for (int i = 0; i < 4; ++i) { const u32x4 qw = *(LAS const u32x4*)(qrow + i * 16); const f32x4v n0 = *(LAS const f32x4v*)(np_ + i * 8), n1 = *(LAS const f32x4v*)(np_ + i * 8 + 4);
                acc += bflo(qw.x) * n0.x + bfhi(qw.x) * n0.y + bflo(qw.y) * n0.z + bfhi(qw.y) * n0.w + bflo(qw.z) * n1.x + bfhi(qw.z) * n1.y + bflo(qw.w) * n1.z + bfhi(qw.w) * n1.w; }
            acc += __shfl_xor(acc, 1); acc += __shfl_xor(acc, 2); acc += __shfl_xor(acc, 4);
            if (part == 0) Ff[256 + t] = acc * Ff[128 + t];
        }
        if (tid < 256) {
            float nn = Ff[576] * Ff[640 + par * 256 + tid];
#pragma unroll
            for (int s = 0; s < 64; s += 4) { const f32x4v w4 = *(LAS const f32x4v*)(Ff + 192 + s); LAS const unsigned char* kc = L + ML_KS + s * ML_KSTR + tid * 2;
                nn += (w4.x * bf2f(*(LAS const unsigned short*)kc) + w4.y * bf2f(*(LAS const unsigned short*)(kc + ML_KSTR))) + (w4.z * bf2f(*(LAS const unsigned short*)(kc + 2 * ML_KSTR)) + w4.w * bf2f(*(LAS const unsigned short*)(kc + 3 * ML_KSTR))); }
            Ff[640 + (par ^ 1) * 256 + tid] = nn;
        }
        }
        ML_BAR();
        {
            pg8::f32x4 y[4];
#if defined(MK_SC_SYNC)
            ML_BAR(); __syncthreads(); __syncthreads();
#endif
#if defined(MK_SC_QC2)
            for (int repq_ = 0; repq_ < 2; ++repq_)
#endif
            {
#pragma unroll
            for (int tt = 0; tt < 4; ++tt) y[tt] = (pg8::f32x4){0.f, 0.f, 0.f, 0.f};
            {
                u32x2 qa[2][4], qb[2][4];
#define ML_QRD(ks_, b_) do { _Pragma("unroll") for (int tt = 0; tt < 4; ++tt) { LAS const unsigned char* qp = L + ML_QS + (16 * tt + l15) * ML_KSTR + (32 * (ks_) + 4 * gq) * 2; qa[b_][tt] = *(LAS const u32x2*)qp; qb[b_][tt] = *(LAS const u32x2*)(qp + 32); } } while (0)
                ML_QRD(0, 0);
#pragma unroll
                for (int ks = 0; ks < 8; ++ks) {
                    if (ks + 1 < 8) ML_QRD(ks + 1, (ks + 1) & 1);
                    u32x4 cw4; cw4.x = att::cvtpk(C[2 * ks][0], C[2 * ks][1]); cw4.y = att::cvtpk(C[2 * ks][2], C[2 * ks][3]); cw4.z = att::cvtpk(C[2 * ks + 1][0], C[2 * ks + 1][1]); cw4.w = att::cvtpk(C[2 * ks + 1][2], C[2 * ks + 1][3]);
                    const bf16x8 cf = __builtin_bit_cast(bf16x8, cw4);
                    __builtin_amdgcn_sched_barrier(0);
#pragma unroll
                    for (int tt = 0; tt < 4; ++tt) { const u32x4 qq = {qa[ks & 1][tt].x, qa[ks & 1][tt].y, qb[ks & 1][tt].x, qb[ks & 1][tt].y};
                        y[tt] = __builtin_amdgcn_mfma_f32_16x16x32_bf16(__builtin_bit_cast(bf16x8, qq), cf, y[tt], 0, 0, 0); }
                    __builtin_amdgcn_sched_barrier(0);
                }
#undef ML_QRD
            }
            }
#pragma unroll
            for (int tt = 0; tt < 4; ++tt) { const f32x4v e4 = *(LAS const f32x4v*)(Ff + 128 + 16 * tt + 4 * gq); y[tt][0] *= e4.x; y[tt][1] *= e4.y; y[tt][2] *= e4.z; y[tt][3] *= e4.w; }
            bf16x8 vf[2];
            { LAS const unsigned char* vb = L + ML_VS + (8 * gq + (l15 >> 2)) * ML_VSTR + (16 * wid + 4 * (lane & 3)) * 2;
#pragma unroll
              for (int k2 = 0; k2 < 2; ++k2) { const s16x4 lo = ml_tr(vb + k2 * 32 * ML_VSTR), hi4 = ml_tr(vb + k2 * 32 * ML_VSTR + 4 * ML_VSTR); vf[k2] = (bf16x8){lo[0], lo[1], lo[2], lo[3], hi4[0], hi4[1], hi4[2], hi4[3]}; } }
#pragma unroll
            for (int k2 = 0; k2 < 2; ++k2)
#pragma unroll
                for (int tt = 0; tt < 4; ++tt) { const bf16x8 pa = *(LAS const bf16x8*)(L + ML_P + (16 * tt + l15) * ML_PSTR + (32 * k2 + 8 * gq) * 2);
                    y[tt] = __builtin_amdgcn_mfma_f32_16x16x32_bf16(pa, vf[k2], y[tt], 0, 0, 0); }
#pragma unroll
            for (int tt = 0; tt < 4; ++tt)
#pragma unroll
                for (int r = 0; r < 4; ++r) { const int t = 16 * tt + 4 * gq + r;
                    *(LAS unsigned short*)(L + ML_HO + t * 256 + (16 * wid + l15) * 2) = (unsigned short)f2bf(y[tt][r]); }
            const float ebend = Ff[576];
#pragma unroll
            for (int i = 0; i < 16; ++i) C[i] = C[i] * ebend;
            bf16x8 vw[2];
#pragma unroll
            for (int k2 = 0; k2 < 2; ++k2) { const f32x4v w0 = *(LAS const f32x4v*)(Ff + 192 + 32 * k2 + 8 * gq), w1 = *(LAS const f32x4v*)(Ff + 192 + 32 * k2 + 8 * gq + 4);
                const u32x4 vv = __builtin_bit_cast(u32x4, vf[k2]); u32x4 o;
                o.x = att::cvtpk(bflo(vv.x) * w0.x, bfhi(vv.x) * w0.y); o.y = att::cvtpk(bflo(vv.y) * w0.z, bfhi(vv.y) * w0.w); o.z = att::cvtpk(bflo(vv.z) * w1.x, bfhi(vv.z) * w1.y); o.w = att::cvtpk(bflo(vv.w) * w1.z, bfhi(vv.w) * w1.w);
                vw[k2] = __builtin_bit_cast(bf16x8, o); }
            LAS const unsigned char* kb = L + ML_KS + (8 * gq + (l15 >> 2)) * ML_KSTR + (4 * (lane & 3)) * 2;
            {
                s16x4 klo[2][2], khi[2][2];
#define ML_KRD(dt_, b_) do { _Pragma("unroll") for (int k2 = 0; k2 < 2; ++k2) { klo[b_][k2] = ml_tr(kb + k2 * 32 * ML_KSTR + (dt_) * 32); khi[b_][k2] = ml_tr(kb + k2 * 32 * ML_KSTR + 4 * ML_KSTR + (dt_) * 32); } } while (0)
                ML_KRD(0, 0);
#pragma unroll
                for (int dt = 0; dt < 16; ++dt) {
                    if (dt + 1 < 16) ML_KRD(dt + 1, (dt + 1) & 1);
                    __builtin_amdgcn_sched_barrier(0);
#pragma unroll
                    for (int k2 = 0; k2 < 2; ++k2) { const s16x4 lo = klo[dt & 1][k2], hi4 = khi[dt & 1][k2];
                        const bf16x8 ka = {lo[0], lo[1], lo[2], lo[3], hi4[0], hi4[1], hi4[2], hi4[3]};
                        C[dt] = __builtin_amdgcn_mfma_f32_16x16x32_bf16(ka, vw[k2], C[dt], 0, 0, 0); }
                    __builtin_amdgcn_sched_barrier(0);
                }
#undef ML_KRD
            }
        }
        ML_BAR();
#if defined(MK_SC_W2)
        for (int repw_ = 0; repw_ < 2; ++repw_)
#endif
#pragma unroll
        for (int it = 0; it < 2; ++it) { const int idx = tid + it * NTHR, t = idx >> 4, pc = idx & 15; const int row = ml_row(base, dir, c * 64 + t);
            const float den = Ff[256 + t] + (Ff[320 + t] + Ff[384 + t]) + (Ff[448 + t] + Ff[512 + t]);
            const float rd = 1.f / fmaxf(fabsf(den), 1.f);
            const u32x4 yv = *(LAS const u32x4*)(L + ML_HO + t * 256 + pc * 16); u32x4 hv;
            hv.x = att::cvtpk(bflo(yv.x) * rd, bfhi(yv.x) * rd); hv.y = att::cvtpk(bflo(yv.y) * rd, bfhi(yv.y) * rd); hv.z = att::cvtpk(bflo(yv.z) * rd, bfhi(yv.z) * rd); hv.w = att::cvtpk(bflo(yv.w) * rd, bfhi(yv.w) * rd);
            *(u32x4*)(Hd + (size_t)row * DI + h * 256 + dvh * 128 + pc * 8) = hv; }
    }
}

__device__ __forceinline__ void mlstm_out_phase(Frame& F, const Args& a, int g, int dry) {
    int lane = pg8::hw_lane(), wave = F.wave; asm volatile("" : "+v"(lane), "+s"(wave));
    const bf16* XC = g == 0 ? (const bf16*)(a.ws + WS_QG) + (size_t)MH * DI : (const bf16*)(a.ws + WS_H); const bf16* Z = (const bf16*)(a.ws + WS_S3); const bf16* HB2 = (const bf16*)(a.ws + WS_S4); bf16* HF = (bf16*)(a.ws + WS_QG) + (size_t)g * MH * DI;
    const float* ng = a.in[16]; const float* skip = a.in[17];
    const int gw = F.vcu * NWAVES + wave, NGW = F.G * NWAVES;
    for (int it0 = gw; it0 < MH * 8; it0 += 2 * NGW) {
        u32x2 hf[2], hb[2], xcw[2], zw[2]; f32x4v gg[2], sk[2]; size_t o[2];
#pragma unroll
        for (int u = 0; u < 2; ++u) { int it = it0 + u * NGW; if (it >= MH * 8) it = it0; const int row = it >> 3, h = it & 7, ch = h * 256 + lane * 4; o[u] = (size_t)row * DI + ch;
            hf[u] = *(const u32x2*)(HF + o[u]); hb[u] = *(const u32x2*)(HB2 + o[u]); xcw[u] = *(const u32x2*)(XC + o[u]); zw[u] = *(const u32x2*)(Z + o[u]);
            gg[u] = *(const f32x4v*)(ng + ch); sk[u] = *(const f32x4v*)(skip + ch); }
#pragma unroll
        for (int u = 0; u < 2; ++u) {
            const float hs[4] = {bflo(hf[u].x) + bflo(hb[u].x), bfhi(hf[u].x) + bfhi(hb[u].x), bflo(hf[u].y) + bflo(hb[u].y), bfhi(hf[u].y) + bfhi(hb[u].y)};
            const float mu = wave_sum((hs[0] + hs[1]) + (hs[2] + hs[3])) * (1.f / 256.f);
            const float d[4] = {hs[0] - mu, hs[1] - mu, hs[2] - mu, hs[3] - mu};
            const float rstd = rsqrtf(wave_sum((d[0] * d[0] + d[1] * d[1]) + (d[2] * d[2] + d[3] * d[3])) * (1.f / 256.f) + EPS);
            const float xcv[4] = {bflo(xcw[u].x), bfhi(xcw[u].x), bflo(xcw[u].y), bfhi(xcw[u].y)}, z[4] = {bflo(zw[u].x), bfhi(zw[u].x), bflo(zw[u].y), bfhi(zw[u].y)};
            const float ggv[4] = {gg[u].x, gg[u].y, gg[u].z, gg[u].w}, skv[4] = {sk[u].x, sk[u].y, sk[u].z, sk[u].w};
            float ov[4];
#pragma unroll
            for (int i = 0; i < 4; ++i) ov[i] = (d[i] * rstd * ggv[i] + skv[i] * xcv[i]) * silu(z[i]);
            u32x2 w; w.x = att::cvtpk(ov[0], ov[1]); w.y = att::cvtpk(ov[2], ov[3]); if (!dry && (u == 0 || it0 + NGW < MH * 8)) *(u32x2*)(HF + o[u]) = w;
        }
    }
}
}
namespace mk {
enum { P_PRO = 0, P_PRO2 = 1, P_NORM0 = 2, P_L0 = 3  , P_OUT0 = 11, P_NORM1 = 12, P_L1 = 13  , P_OUT1 = 17, P_NORM2 = 18, P_L2 = 19  , P_OUT2 = 23, P_NORM3 = 24, P_L3 = 25  , P_OUT3 = 29, P_FINAL = 30, P_END = 31 };

__global__ void __launch_bounds__(NTHR, 2) mega(Args a) {
    extern __shared__ __attribute__((aligned(16))) unsigned char lds_raw[];
    Frame F;
    F.lds = (LAS unsigned char*)lds_raw;
    F.wave = __builtin_amdgcn_readfirstlane((int)threadIdx.x >> 6); F.lane = pg8::hw_lane(); F.tid = F.wave * 64 + F.lane;
    F.G = gridDim.x; { const int bx = blockIdx.x; F.vcu = (F.G % 8 == 0) ? (bx % 8) * (F.G / 8) + bx / 8 : bx; }
    volatile LAS unsigned* MISC = (volatile LAS unsigned*)(F.lds + MISC_OFF);
    for (int u = F.tid; u < (LDS_BYTES - RING_BYTES) / 4; u += NTHR) ((LAS unsigned*)(F.lds + RING_BYTES))[u] = 0u;
    __syncthreads();
    XcdBarrier bar = xcd_barrier_post((unsigned*)(a.ws + WS_CTL) + CW_BAR, MISC + 8, (unsigned)F.wave);
    const int lo = a.ph_lo, hi = a.ph_hi;
#ifndef MK_REP_GEMM
#define MK_REP_GEMM 1
#endif
#ifndef MK_REP_ATT
#define MK_REP_ATT 1
#endif
#ifndef MK_REP_MISC
#define MK_REP_MISC 1
#endif
#ifndef MK_GEMM_ALIGN
#define MK_GEMM_ALIGN true
#endif
#ifndef MK_GEMM_SP2
#define MK_GEMM_SP2 true
#endif
#ifndef MK_REP_WC
#define MK_REP_WC 1
#endif
#ifndef MK_REP_SYNC
#define MK_REP_SYNC 0
#endif
#ifndef MK_REP_DIFF
#define MK_REP_DIFF MK_REP_ATT
#endif
#ifndef MK_REP_NA
#define MK_REP_NA MK_REP_ATT
#endif
#ifndef MK_REP_SWA
#define MK_REP_SWA MK_REP_ATT
#endif
#ifndef MK_REP_SCAN
#define MK_REP_SCAN 1
#endif
#ifndef MK_REP_GATES
#define MK_REP_GATES MK_REP_SCAN
#endif
#ifndef MK_SITES
#define MK_SITES 0xFFFFFFFFu
#endif
#define ON(b) (((MK_SITES) >> (b)) & 1u)
#ifdef MK_PARTIAL
#define IN(k) (lo <= (k) && (k) < hi)
#else
#define IN(k) true
#endif
#ifndef MK_REP_BAR
#define MK_REP_BAR 1
#endif
#ifdef MK_TP
    long long tp_acc = 0, tp_prev = wall_clock64(), tp_t0 = 0;
#define TP_PRE(k) tp_t0 = wall_clock64();
#define TP_POST(k) { long long n_ = wall_clock64(); if ((MK_TP_MASK >> (k)) & 1u) tp_acc += n_ - (MK_TP == 1 ? tp_t0 : tp_prev); tp_prev = n_; }
#else
#define TP_PRE(k)
#define TP_POST(k)
#endif
#define SEAM(k) do { if (IN(k) && IN((k) + 1)) { TP_PRE(k) for (int rb_ = 0; rb_ < MK_REP_BAR; ++rb_) xcd_barrier(bar); TP_POST(k) } } while (0)
    const int gw = F.vcu * NWAVES + F.wave, NGW = F.G * NWAVES;
#define WSB ([&]() { unsigned char* p_ = a.ws; asm volatile("" : "+s"(p_)); return p_; }())
#define xs (a.out)
#define ctxs ((float*)(WSB + WS_CTXS))
#define xsb ((bf16*)a.out)
#define ctxb ((bf16*)(WSB + WS_CTXS))
#define x3b ((bf16*)(WSB + WS_S3))
#define mod ((const float*)(WSB + WS_MOD))
#define WinA ((bf16*)(WSB + WS_WIN))
#define WoutA ((bf16*)(WSB + WS_WOUT))
#define WinB ((bf16*)(WSB + WS_W2))
#define WoutB ((bf16*)(WSB + WS_W2 + 16 * MiB))
#define H ((bf16*)(WSB + WS_H))
#define QG ((bf16*)(WSB + WS_QG))
#define ssq ((float*)(WSB + WS_SSQ))
#define shw ((const float*)(WSB + WS_SHW))
#define S2 ((bf16*)(WSB + WS_S2))
#define S3 ((bf16*)(WSB + WS_S3))
#define S4 ((bf16*)(WSB + WS_S4))
#define rope ((const float*)(WSB + WS_ROPE))
    const float QSC = 0.125f * LOG2E;

    if (ON(0) && IN(P_PRO)) prologue_phase(F, a);
    SEAM(P_PRO);
    if (ON(0) && IN(P_PRO2)) { prologue2_phase(F, a); for (int rw_ = 0; rw_ < MK_REP_WC; ++rw_) wconv(F, a.in[8], 4096, a.in[18], WinA, WoutA, gw, NGW); }
    SEAM(P_PRO2);
    if (ON(1) && IN(P_NORM0)) { for (int rep = 0; rep < MK_REP_MISC; ++rep) norm_phase(F, a.in[0], a.in[2], a.in[4], mod, H); }
    SEAM(P_NORM0);
#if MK_HAVE_L0
    for (int g = 0; g < 2; ++g) {
        if (ON(2) && IN(P_L0 + 4 * g)) {
            pg8::Gemm gm{H + (size_t)g * MH * D, WinA, MH, 4096, D}; pg8::StaticOrder So; So.init(MH, 4096, F.G, (int)blockIdx.x);
            EpiProj<false> E{S2, S3, S3, S3, DI, DI, DI, DI, 8, 16, 16, 0u, 1.f, rope, nullptr, nullptr, 0};
            for (int rep = 0; rep < MK_REP_GEMM; ++rep) { if (MK_REP_SYNC && rep) xcd_barrier(bar); pg8::gemm_phase<EpiProj<false>, pg8::StaticOrder, MK_GEMM_ALIGN, MK_GEMM_SP2>(F.lds, gm, So, E, F.wave); }
        }
        SEAM(P_L0 + 4 * g);
        if (ON(17) && IN(P_L0 + 4 * g + 1)) for (int rep = 0; rep < MK_REP_GATES; ++rep) mlstm_gates_phase(F, a, g);
        SEAM(P_L0 + 4 * g + 1);
        if (ON(18) && IN(P_L0 + 4 * g + 2)) for (int rep = 0; rep < MK_REP_SCAN; ++rep) mlstm_scan_phase(F, a, g);
        SEAM(P_L0 + 4 * g + 2);
        if (ON(19) && IN(P_L0 + 4 * g + 3)) for (int rep = 0; rep < MK_REP_MISC; ++rep) mlstm_out_phase(F, a, g, rep + 1 < MK_REP_MISC);
        SEAM(P_L0 + 4 * g + 3);
    }
#endif
    constexpr int RHEAD = 128 * 256;
    if (ON(3) && IN(P_OUT0)) {
        pg8::Gemm gm{QG, WoutA, MT, D, DI}; pg8::StaticOrder So; So.init(RHEAD, D, F.G, (int)blockIdx.x);
        for (int rep = 0; rep < MK_REP_GEMM; ++rep) { if (MK_REP_SYNC && rep) xcd_barrier(bar); EpiResidT<float, bf16> E{a.in[0], a.in[2], xsb, ctxb, mod, 1, rep + 1 < MK_REP_GEMM, nullptr, nullptr, nullptr, nullptr};
        pg8::gemm_phase<EpiResidT<float, bf16>, pg8::StaticOrder, MK_GEMM_ALIGN, MK_GEMM_SP2>(F.lds, gm, So, E, F.wave); }
    }
    SEAM(P_OUT0);
    if (ON(3) && IN(P_OUT0)) {
        if (blockIdx.x < 64) { pg8::Gemm gm{QG, WoutA, MT, D, DI}; OutTailOrder So; So.init(F.G, (int)blockIdx.x); EpiResidT<float, bf16> E{a.in[0], a.in[2], xsb, ctxb, mod, 1, 0, nullptr, nullptr, nullptr, nullptr};
            pg8::gemm_phase<EpiResidT<float, bf16>, OutTailOrder, MK_GEMM_ALIGN, MK_GEMM_SP2>(F.lds, gm, So, E, F.wave); }
        else { wconv(F, a.in[19], 8192, a.in[25], WinB, WoutB, ((int)blockIdx.x - 64) * NWAVES + F.wave, (F.G - 64) * NWAVES);
            if (ON(4)) norm_phase(F, xsb, ctxb, a.in[4] + 1024, mod + 17 * 3072, H, 0, RHEAD, 64); }
    }
    SEAM(P_OUT0);
    for (int g = 0; g < 2; ++g) {
        if (ON(5) && IN(P_L1 + 2 * g)) {
            if (g == 0 && ON(4)) norm_phase(F, xsb, ctxb, a.in[4] + 1024, mod + 17 * 3072, H, RHEAD, MT);
            pg8::Gemm gm{H + (size_t)g * MH * D, WinB, MH, 8192, D}; pg8::StaticOrder So; So.init(MH, 8192, F.G, (int)blockIdx.x);
            EpiProj<true, false> E{QG + (size_t)g * MH * DI, S2, S3, S4, DI, DI, DI, DI, 8, 16, 24, 3u, QSC, rope, ssq, shw, g * MH};
#ifdef MK_STAGGER
            if (blockIdx.x >= 128) { const long long t0_ = wall_clock64(); while (wall_clock64() - t0_ < MK_STAGGER) __builtin_amdgcn_s_sleep(8); }
#endif
            for (int rep = 0; rep < MK_REP_GEMM; ++rep) { if (MK_REP_SYNC && rep) xcd_barrier(bar); pg8::gemm_phase<EpiProj<true, false>, pg8::StaticOrder, MK_GEMM_ALIGN, MK_GEMM_SP2>(F.lds, gm, So, E, F.wave); }
        }
        SEAM(P_L1 + 2 * g);
        if (ON(6) && IN(P_L1 + 2 * g + 1)) for (int rep = 0; rep < MK_REP_DIFF; ++rep) { if (MK_REP_SYNC && rep) xcd_barrier(bar); diff_phase(F, a, g, rep + 1 < MK_REP_DIFF); }
        SEAM(P_L1 + 2 * g + 1);
    }
    if (ON(7) && IN(P_OUT1)) {
        pg8::Gemm gm{QG, WoutB, MT, D, DI}; pg8::StaticOrder So; So.init(RHEAD, D, F.G, (int)blockIdx.x);
        for (int rep = 0; rep < MK_REP_GEMM; ++rep) { if (MK_REP_SYNC && rep) xcd_barrier(bar); EpiResidT<bf16, bf16> E{xsb, ctxb, xsb, ctxb, mod + 17 * 3072, 1, rep + 1 < MK_REP_GEMM, nullptr, nullptr, nullptr, nullptr};
        pg8::gemm_phase<EpiResidT<bf16, bf16>, pg8::StaticOrder, MK_GEMM_ALIGN, MK_GEMM_SP2>(F.lds, gm, So, E, F.wave); }
    }
    SEAM(P_OUT1);
    if (ON(7) && IN(P_OUT1)) {
        if (blockIdx.x < 64) { pg8::Gemm gm{QG, WoutB, MT, D, DI}; OutTailOrder So; So.init(F.G, (int)blockIdx.x); EpiResidT<bf16, bf16> E{xsb, ctxb, xsb, ctxb, mod + 17 * 3072, 1, 0, nullptr, nullptr, nullptr, nullptr};
            pg8::gemm_phase<EpiResidT<bf16, bf16>, OutTailOrder, MK_GEMM_ALIGN, MK_GEMM_SP2>(F.lds, gm, So, E, F.wave); }
        else { wconv(F, a.in[26], 8192, a.in[28], WinA, WoutA, ((int)blockIdx.x - 64) * NWAVES + F.wave, (F.G - 64) * NWAVES);
            if (ON(8)) norm_phase(F, xsb, ctxb, a.in[4] + 2048, mod + 2 * 17 * 3072, H, 0, RHEAD, 64); }
    }
    SEAM(P_OUT1);
    for (int g = 0; g < 2; ++g) {
        if (ON(9) && IN(P_L2 + 2 * g)) {
            if (g == 0 && ON(8)) norm_phase(F, xsb, ctxb, a.in[4] + 2048, mod + 2 * 17 * 3072, H, RHEAD, MT);
            pg8::Gemm gm{H + (size_t)g * MH * D, WinA, MH, 8192, D}; pg8::StaticOrder So; So.init(MH, 8192, F.G, (int)blockIdx.x);
            EpiProj<false, false> E{QG + (size_t)g * MH * DI, S2, S3, S4, DI, DI, DI, DI, 8, 16, 24, 0u, QSC, rope, ssq, shw + 17 * 8192, g * MH};
#ifdef MK_STAGGER
            if (blockIdx.x >= 128) { const long long t0_ = wall_clock64(); while (wall_clock64() - t0_ < MK_STAGGER) __builtin_amdgcn_s_sleep(8); }
#endif
            for (int rep = 0; rep < MK_REP_GEMM; ++rep) { if (MK_REP_SYNC && rep) xcd_barrier(bar); pg8::gemm_phase<EpiProj<false, false>, pg8::StaticOrder, MK_GEMM_ALIGN, MK_GEMM_SP2>(F.lds, gm, So, E, F.wave); }
        }
        SEAM(P_L2 + 2 * g);
        if (ON(10) && IN(P_L2 + 2 * g + 1)) for (int rep = 0; rep < MK_REP_NA; ++rep) { if (MK_REP_SYNC && rep) xcd_barrier(bar); na_phase(F, a, g, rep + 1 < MK_REP_NA); }
        SEAM(P_L2 + 2 * g + 1);
    }
    if (ON(11) && IN(P_OUT2)) {
        pg8::Gemm gm{QG, WoutA, MT, D, DI}; pg8::StaticOrder So; So.init(RHEAD, D, F.G, (int)blockIdx.x);
        for (int rep = 0; rep < MK_REP_GEMM; ++rep) { if (MK_REP_SYNC && rep) xcd_barrier(bar); EpiResidT<bf16, bf16> E{xsb, ctxb, x3b, ctxb, mod + 2 * 17 * 3072, 1, rep + 1 < MK_REP_GEMM, nullptr, nullptr, nullptr, nullptr};
        pg8::gemm_phase<EpiResidT<bf16, bf16>, pg8::StaticOrder, MK_GEMM_ALIGN, MK_GEMM_SP2>(F.lds, gm, So, E, F.wave); }
    }
    SEAM(P_OUT2);
    if (ON(11) && IN(P_OUT2)) {
        if (blockIdx.x < 64) { pg8::Gemm gm{QG, WoutA, MT, D, DI}; OutTailOrder So; So.init(F.G, (int)blockIdx.x); EpiResidT<bf16, bf16> E{xsb, ctxb, x3b, ctxb, mod + 2 * 17 * 3072, 1, 0, nullptr, nullptr, nullptr, nullptr};
            pg8::gemm_phase<EpiResidT<bf16, bf16>, OutTailOrder, MK_GEMM_ALIGN, MK_GEMM_SP2>(F.lds, gm, So, E, F.wave); }
        else { wconv(F, a.in[29], 4608, a.in[31], WinB, WoutB, ((int)blockIdx.x - 64) * NWAVES + F.wave, (F.G - 64) * NWAVES);
            if (ON(12)) norm_phase(F, x3b, ctxb, a.in[4] + 3072, mod + 3 * 17 * 3072, H, 0, RHEAD, 64); }
    }
    SEAM(P_OUT2);
    for (int g = 0; g < 2; ++g) {
        if (ON(13) && IN(P_L3 + 2 * g)) {
            if (g == 0 && ON(12)) norm_phase(F, x3b, ctxb, a.in[4] + 3072, mod + 3 * 17 * 3072, H, RHEAD, MT);
            pg8::Gemm gm{H + (size_t)g * MH * D, WinB, MH, 4608, D}; L3Order So; So.init(F.G, (int)blockIdx.x);
            EpiProj<true, false> E{QG + (size_t)g * MH * DI, S2, S2 + (size_t)MH * 256, S4, DI, 256, 256, DI, 8, 9, 10, 3u, QSC, rope, ssq, shw + 2 * 17 * 8192, g * MH};
            for (int rep = 0; rep < MK_REP_GEMM; ++rep) { if (MK_REP_SYNC && rep) xcd_barrier(bar); pg8::gemm_phase<EpiProj<true, false>, L3Order, MK_GEMM_ALIGN, MK_GEMM_SP2>(F.lds, gm, So, E, F.wave); }
        }
        SEAM(P_L3 + 2 * g);
        if (ON(14) && IN(P_L3 + 2 * g + 1)) for (int rep = 0; rep < MK_REP_SWA; ++rep) { if (MK_REP_SYNC && rep) xcd_barrier(bar); swa_phase(F, a, g, rep + 1 < MK_REP_SWA); }
        SEAM(P_L3 + 2 * g + 1);
    }
    if (ON(15) && IN(P_OUT3)) {
        pg8::Gemm gm{QG, WoutB, MT, D, DI}; LatOnlyOrder So; So.init(F.G, (int)blockIdx.x);
        for (int rep = 0; rep < MK_REP_GEMM; ++rep) { if (MK_REP_SYNC && rep) xcd_barrier(bar); EpiResidT<bf16, float> E{x3b, ctxb, xs, ctxs, mod + 3 * 17 * 3072, 0, rep + 1 < MK_REP_GEMM, nullptr, nullptr, nullptr, nullptr};
        pg8::gemm_phase<EpiResidT<bf16, float>, LatOnlyOrder, MK_GEMM_ALIGN, MK_GEMM_SP2>(F.lds, gm, So, E, F.wave); }
    }
    SEAM(P_OUT3);
    if (ON(16) && IN(P_FINAL)) final_norm_phase(F, xs, a.in[7]);
#ifdef MK_TP
    {
        if (MK_TP == 2) TP_POST(P_FINAL)
        unsigned long long* tpw = (unsigned long long*)(a.ws + WS_CTL + 32768);
        if (F.wave == 0 && pg8::hw_lane() == 0) __hip_atomic_fetch_add(tpw, (unsigned long long)tp_acc, __ATOMIC_RELAXED, __HIP_MEMORY_SCOPE_AGENT);
        xcd_barrier(bar);
        const unsigned long long sum = __hip_atomic_load(tpw, __ATOMIC_RELAXED, __HIP_MEMORY_SCOPE_AGENT);
        const long long wait = (long long)(sum / 256) * MK_TP_K, ts = wall_clock64();
        while (wall_clock64() - ts < wait) __builtin_amdgcn_s_sleep(32);
    }
#endif
#undef IN
#undef SEAM
#undef WSB
#undef xs
#undef ctxs
#undef xsb
#undef ctxb
#undef x3b
#undef mod
#undef WinA
#undef WoutA
#undef WinB
#undef WoutB
#undef H
#undef QG
#undef ssq
#undef shw
#undef S2
#undef S3
#undef S4
#undef rope
}

inline void launch_mega(void* const* d_in, void* d_out, void* d_ws, int lo, int hi, hipStream_t stream) {
    static int inited = 0;
    if (!inited) { (void)hipFuncSetAttribute((const void*)mega, hipFuncAttributeMaxDynamicSharedMemorySize, LDS_BYTES); inited = 1; }
    (void)hipMemsetAsync((char*)d_ws + WS_CTL, 0, CTL_BYTES, stream);
    Args a{};
    for (int i = 0; i < 32; ++i) a.in[i] = (const float*)d_in[i];
    a.out = (float*)d_out; a.ws = (unsigned char*)d_ws; a.ph_lo = lo; a.ph_hi = hi;
    hipLaunchKernelGGL(mega, dim3(256), dim3(NTHR), LDS_BYTES, stream, a);
}
}
extern "C" void kernel_launch(void* const* d_in, const int* in_sizes, int n_in, void* d_out, int out_size, void* d_ws, size_t ws_size, hipStream_t stream) {
    mk::launch_mega(d_in, d_out, d_ws, mk::P_PRO, mk::P_END, stream);
}
```

```cpp
#include <hip/hip_runtime.h>
#include <cstdint>
#include <cstdio>
#include <cmath>
#define MK_HAVE_L0 1
namespace pg8 {
#define PG8_LAS __attribute__((address_space(3)))
typedef unsigned short bf16_t;
typedef short bf16x8 __attribute__((ext_vector_type(8)));
typedef float f32x4 __attribute__((ext_vector_type(4)));
typedef unsigned u32x4 __attribute__((ext_vector_type(4)));
__device__ __forceinline__ int hw_lane() { int l; asm volatile("v_mbcnt_lo_u32_b32 %0, -1, 0\n\tv_mbcnt_hi_u32_b32 %0, -1, %0" : "=v"(l)); return l; }
constexpr int BM = 256, BK = 64, HALF = 128, HTB = HALF * BK * 2  , STAGE_BYTES = 8 * HTB, NXCD = 8, WGM = 8;

__host__ __device__ __forceinline__ int lds_byte(int r, int c) { const int st = (r >> 4) * 2 + (c >> 5), rr = r & 15, cc = c & 31, ob = rr * 64 + cc * 2; return st * 1024 + (ob ^ (((ob >> 9) & 1) << 5)); }
__host__ __device__ __forceinline__ void stage_rc(int b, int& R, int& C) { const int st = b / 1024, sb = b % 1024, swz = sb ^ (((sb >> 9) & 1) << 5); R = (st >> 1) * 16 + swz / 64; C = (st & 1) * 32 + (swz % 64) / 2; }
__host__ __device__ __forceinline__ int perm32(int rho) { const int n = rho >> 4, i = rho & 15; return 8 * (i >> 2) + 4 * n + (i & 3); }

struct Unit { int pm, pn; };
struct Gemm { const bf16_t* A; const bf16_t* Bt; int M, N, K; };

struct StaticOrder {
    int nM, nN, nwg, G, c;
    __host__ __device__ void init(int M, int N, int G_, int c_) { nM = M / BM; nN = N / BM; nwg = nM * nN; G = G_; c = c_; }
    __host__ __device__ bool next(int i, Unit& u) const {
        const long L = (long)i * G + c; if (L >= nwg) return false;
        int wgid = (int)L; { const int q = nwg / NXCD, r = nwg % NXCD, xcd = wgid % NXCD, off = wgid / NXCD; wgid = (xcd < r ? xcd * (q + 1) : r * (q + 1) + (xcd - r) * q) + off; }
        const int nig = WGM * nN, gid = wgid / nig, fm = gid * WGM, gsz = (nM - fm) < WGM ? (nM - fm) : WGM;
        u.pm = fm + ((wgid % nig) % gsz); u.pn = (wgid % nig) / gsz; return true;
    }
    __device__ __forceinline__ void a_ready(const Unit&) const {}
    __device__ __forceinline__ void done(const Unit&) const {}
};

__device__ __forceinline__ unsigned cvt_pk_bf16(float lo, float hi) { unsigned r; asm volatile("v_cvt_pk_bf16_f32 %0, %1, %2" : "=v"(r) : "v"(lo), "v"(hi)); return r; }
typedef float f32x2 __attribute__((ext_vector_type(2)));
template <class Epi, class Sched, bool ALIGN_EPI = false, bool SP2 = false>
__device__ __forceinline__ void gemm_phase(PG8_LAS unsigned char* lds, const Gemm g, const Sched& S, const Epi& E, int wave_id) {
    int tid_ = wave_id * 64 + hw_lane(); asm volatile("" : "+v"(tid_));
    const int tid = tid_, wid = __builtin_amdgcn_readfirstlane(tid >> 6), lane = tid & 63, wr = wid >> 2, wc = wid & 3, fr = lane & 15, fq = lane >> 4;
    const int K = g.K, nt = K / BK;
    unsigned voffA[2], voffB[2];
#pragma unroll
    for (int i = 0; i < 2; ++i) { int R, C; stage_rc(tid * 16 + i * 8192, R, C); const int Rb = Epi::PERM ? ((R & ~31) + perm32(R & 31)) : R;
        voffA[i] = (unsigned)(R * K + C) * 2u; voffB[i] = (unsigned)(Rb * K + C) * 2u; }
    const size_t kstep = (size_t)(BK * 2);
    const size_t hstep = (size_t)HALF * K * 2;
    const size_t tstep = 2 * hstep;
    const unsigned ldsw = (unsigned)wid * 1024u;
    const int aoff = lds_byte(wr * 64 + fr, fq * 8), boff = lds_byte(wc * 32 + fr, fq * 8);
#define PG8_SA(b, h) (((b) * 2 + (h)) * HTB)
#define PG8_SB(b, h) ((4 + (b) * 2 + (h)) * HTB)
#define PG8_STAGE(bufoff, gbase, voff) do { _Pragma("unroll") for (int _i = 0; _i < 2; ++_i) \
        __builtin_amdgcn_global_load_lds((const unsigned*)((const char*)(gbase) + (voff)[_i]), (PG8_LAS unsigned*)(lds + (bufoff) + ldsw + _i * 8192), 16, 0, 0); } while (0)
#define PG8_LDA(dst, b, h) do { _Pragma("unroll") for (int m = 0; m < 4; ++m) _Pragma("unroll") for (int k = 0; k < 2; ++k) dst[m][k] = *(const PG8_LAS bf16x8*)(lds + PG8_SA(b, h) + aoff + m * 2048 + k * 1024); } while (0)
#define PG8_LDB(dst, b, h) do { _Pragma("unroll") for (int n = 0; n < 2; ++n) _Pragma("unroll") for (int k = 0; k < 2; ++k) dst[n][k] = *(const PG8_LAS bf16x8*)(lds + PG8_SB(b, h) + boff + n * 2048 + k * 1024); } while (0)
#define PG8_MMA(ai, bj, At, Bt) do { __builtin_amdgcn_s_setprio(1); _Pragma("unroll") for (int m = 0; m < 4; ++m) _Pragma("unroll") for (int n = 0; n < 2; ++n) _Pragma("unroll") for (int k = 0; k < 2; ++k) \
        acc[ai][bj][m][n] = __builtin_amdgcn_mfma_f32_16x16x32_bf16(Bt[n][k], At[m][k], acc[ai][bj][m][n], 0, 0, 0); __builtin_amdgcn_s_setprio(0); } while (0)
#define PG8_WAIT_V(n) asm volatile("s_waitcnt vmcnt(" #n ")" ::: "memory")
#define PG8_WAIT_L(n) asm volatile("s_waitcnt lgkmcnt(" #n ")" ::: "memory")
#define PG8_BAR __builtin_amdgcn_s_barrier()
#define PG8_SCHED __builtin_amdgcn_sched_barrier(0)
    Unit cur, nxt; int ui = 0;
    if (!S.next(0, cur)) return;
    f32x4 acc[2][2][4][2];
#pragma unroll
    for (int a = 0; a < 2; ++a)
#pragma unroll
        for (int b = 0; b < 2; ++b)
#pragma unroll
            for (int m = 0; m < 4; ++m)
#pragma unroll
                for (int n = 0; n < 2; ++n) acc[a][b][m][n] = (f32x4){0.f, 0.f, 0.f, 0.f};
    bf16x8 At[4][2], B0[2][2], B1[2][2];
    const char* cA = (const char*)g.A + (size_t)cur.pm * tstep; const char* cB = (const char*)g.Bt + (size_t)cur.pn * tstep;
    S.a_ready(cur);
    if constexpr (SP2) {
        PG8_STAGE(PG8_SB(0, 0), cB, voffB); PG8_STAGE(PG8_SB(0, 1), cB + hstep, voffB); PG8_STAGE(PG8_SA(0, 0), cA, voffA); PG8_STAGE(PG8_SA(0, 1), cA + hstep, voffA);
        if (wr == 1) PG8_BAR;
        PG8_WAIT_V(2); PG8_BAR;
        PG8_STAGE(PG8_SB(1, 0), cB + kstep, voffB); PG8_STAGE(PG8_SA(1, 0), cA + kstep, voffA); PG8_STAGE(PG8_SB(1, 1), cB + hstep + kstep, voffB);
        PG8_WAIT_V(6); PG8_BAR;
    } else {
        PG8_STAGE(PG8_SB(0, 0), cB, voffB); PG8_STAGE(PG8_SA(0, 0), cA, voffA); PG8_STAGE(PG8_SB(0, 1), cB + hstep, voffB); PG8_STAGE(PG8_SA(0, 1), cA + hstep, voffA);
        if (wr == 1) PG8_BAR;
        PG8_WAIT_V(4); PG8_BAR;
        PG8_STAGE(PG8_SB(1, 0), cB + kstep, voffB); PG8_STAGE(PG8_SA(1, 0), cA + kstep, voffA); PG8_STAGE(PG8_SB(1, 1), cB + hstep + kstep, voffB);
        PG8_WAIT_V(6); PG8_BAR;
    }
    for (;;) {
        const bool has_next = S.next(ui + 1, nxt);
        const char* nA = has_next ? (const char*)g.A + (size_t)nxt.pm * tstep : cA; const char* nB = has_next ? (const char*)g.Bt + (size_t)nxt.pn * tstep : cB;
        for (int t = 0; t < nt; t += 2) {
            const bool last = (t == nt - 2);
            const char* a1 = cA + (size_t)(t + 1) * kstep;
            const char* a2 = last ? nA : cA + (size_t)(t + 2) * kstep; const char* b2 = last ? nB : cB + (size_t)(t + 2) * kstep;
            const char* a3 = a2 + kstep; const char* b3 = b2 + kstep;
            if (last && has_next) S.a_ready(nxt);
            if constexpr (SP2) {
            PG8_LDB(B0, 0, 0); PG8_LDB(B1, 0, 1); PG8_SCHED; PG8_LDA(At, 0, 0); PG8_STAGE(PG8_SA(1, 1), a1 + hstep, voffA);
            PG8_WAIT_V(8); PG8_WAIT_L(0); PG8_BAR; PG8_MMA(0, 0, At, B0); PG8_MMA(0, 1, At, B1); PG8_BAR; PG8_SCHED;
            PG8_LDA(At, 0, 1); PG8_STAGE(PG8_SB(0, 0), b2, voffB); PG8_STAGE(PG8_SB(0, 1), b2 + hstep, voffB); PG8_STAGE(PG8_SA(0, 0), a2, voffA);
            PG8_WAIT_V(8); PG8_WAIT_L(0); PG8_BAR; PG8_MMA(1, 0, At, B0); PG8_MMA(1, 1, At, B1); PG8_BAR; PG8_SCHED;
            PG8_LDB(B0, 1, 0); PG8_LDB(B1, 1, 1); PG8_SCHED; PG8_LDA(At, 1, 0); PG8_STAGE(PG8_SA(0, 1), a2 + hstep, voffA);
            PG8_WAIT_V(8); PG8_WAIT_L(0); PG8_BAR; PG8_MMA(0, 0, At, B0); PG8_MMA(0, 1, At, B1); PG8_BAR; PG8_SCHED;
            PG8_LDA(At, 1, 1); PG8_STAGE(PG8_SB(1, 0), b3, voffB); PG8_STAGE(PG8_SB(1, 1), b3 + hstep, voffB); PG8_STAGE(PG8_SA(1, 0), a3, voffA);
            PG8_WAIT_V(8); PG8_WAIT_L(0); PG8_BAR; PG8_MMA(1, 0, At, B0); PG8_MMA(1, 1, At, B1); PG8_BAR; PG8_SCHED;
            } else {
            PG8_LDB(B0, 0, 0); PG8_SCHED; PG8_LDA(At, 0, 0); PG8_STAGE(PG8_SA(1, 1), a1 + hstep, voffA);
            PG8_WAIT_L(8); PG8_BAR; PG8_WAIT_L(0); PG8_MMA(0, 0, At, B0); PG8_BAR; PG8_SCHED;
            PG8_LDB(B1, 0, 1); PG8_STAGE(PG8_SB(0, 0), b2, voffB);
            PG8_BAR; PG8_WAIT_L(0); PG8_MMA(0, 1, At, B1); PG8_BAR;
            PG8_LDA(At, 0, 1); PG8_STAGE(PG8_SA(0, 0), a2, voffA);
            PG8_BAR; PG8_WAIT_L(0); PG8_MMA(1, 0, At, B0); PG8_BAR; PG8_SCHED;
            PG8_STAGE(PG8_SB(0, 1), b2 + hstep, voffB);
            PG8_WAIT_V(6); PG8_BAR; PG8_MMA(1, 1, At, B1); PG8_BAR;
            PG8_LDB(B0, 1, 0); PG8_SCHED; PG8_LDA(At, 1, 0); PG8_STAGE(PG8_SA(0, 1), a2 + hstep, voffA);
            PG8_WAIT_L(8); PG8_BAR; PG8_WAIT_L(0); PG8_MMA(0, 0, At, B0); PG8_BAR; PG8_SCHED;
            PG8_LDB(B1, 1, 1); PG8_STAGE(PG8_SB(1, 0), b3, voffB);
            PG8_BAR; PG8_WAIT_L(0); PG8_MMA(0, 1, At, B1); PG8_BAR;
            PG8_LDA(At, 1, 1); PG8_STAGE(PG8_SA(1, 0), a3, voffA);
            PG8_BAR; PG8_WAIT_L(0); PG8_MMA(1, 0, At, B0); PG8_BAR; PG8_SCHED;
            PG8_STAGE(PG8_SB(1, 1), b3 + hstep, voffB);
            PG8_WAIT_V(6); PG8_BAR; PG8_MMA(1, 1, At, B1); PG8_BAR;
            }
        }
        if constexpr (ALIGN_EPI) { if (wr == 0) PG8_BAR; }
#if defined(MK_EXP_EPI2)
        if constexpr (!Epi::AFTER_DRAIN && Epi::PERM) { E.template run<(MK_EXP_EPI2 == 2)>(acc, cur, wr, wc, fr, fq); }
#endif
        if constexpr (!Epi::AFTER_DRAIN) { E(acc, cur, wr, wc, fr, fq); S.done(cur); }
        if (!has_next) break;
#pragma unroll
        for (int a = 0; a < 2; ++a)
#pragma unroll
            for (int b = 0; b < 2; ++b)
#pragma unroll
                for (int m = 0; m < 4; ++m)
#pragma unroll
                    for (int n = 0; n < 2; ++n) acc[a][b][m][n] = (f32x4){0.f, 0.f, 0.f, 0.f};
        cur = nxt; cA = nA; cB = nB; ++ui;
        if constexpr (ALIGN_EPI) { if (wr == 1) PG8_BAR; }
    }
    PG8_WAIT_V(0);
    if constexpr (!ALIGN_EPI) { if (wr == 0) PG8_BAR; }
    PG8_BAR;
    if constexpr (Epi::AFTER_DRAIN) { E.fused(acc, cur, wr, wc, fr, fq, lds, wid, lane); S.done(cur); }
#undef PG8_SA
#undef PG8_SB
#undef PG8_STAGE
#undef PG8_LDA
#undef PG8_LDB
#undef PG8_MMA
#undef PG8_WAIT_V
#undef PG8_WAIT_L
#undef PG8_BAR
#undef PG8_SCHED
}
}
#define GAS __attribute__((address_space(1)))
#define LAS __attribute__((address_space(3)))
typedef unsigned short bf16;
typedef unsigned v4u __attribute__((ext_vector_type(4)));
typedef float f32x4 __attribute__((ext_vector_type(4)));
typedef short bf16x8 __attribute__((ext_vector_type(8)));
typedef GAS unsigned gu32;
typedef GAS unsigned long long gu64;
#define RLX_AGENT __ATOMIC_RELAXED, __HIP_MEMORY_SCOPE_AGENT
#define LDS_WAIT() asm volatile("s_waitcnt lgkmcnt(0)" ::: "memory")
#define VM_WAIT() asm volatile("s_waitcnt vmcnt(0)" ::: "memory")
__device__ __forceinline__ unsigned long long rt() { return __builtin_amdgcn_s_memrealtime(); }
__device__ __forceinline__ unsigned f2bf(float f) { unsigned u = __builtin_bit_cast(unsigned, f); return (u + 0x7fffu + ((u >> 16) & 1u)) >> 16; }
__device__ __forceinline__ unsigned pk2(float lo, float hi) { return f2bf(lo) | (f2bf(hi) << 16); }
#define XB_TMO      128
#define XB_XCNT(j)  (256  + 64 * (j))
#define XB_XSUB(j)  (1280 + 64 * (j))
#define XB_XGEN(j)  (2304 + 64 * (j))
#define XB_TOP      3328
#define XB_TOPGEN   3392
#define XCD_BAR_WORDS 3456
#define XB_SPIN_CAP (1u << 18)

__device__ __forceinline__ unsigned xb_ld(unsigned* p)              { return __hip_atomic_load(p, __ATOMIC_RELAXED, __HIP_MEMORY_SCOPE_AGENT); }
__device__ __forceinline__ unsigned xb_add(unsigned* p, unsigned v) { return __hip_atomic_fetch_add(p, v, __ATOMIC_RELAXED, __HIP_MEMORY_SCOPE_AGENT); }
__device__ __forceinline__ unsigned xb_xcc_id() { return (unsigned)__builtin_amdgcn_s_getreg((3 << 11) | 20) & 0xFu; }
#define XB_SPIN(cond, bar) do { unsigned _sp = 0; while (cond) { __builtin_amdgcn_s_sleep(1); \
    if ((++_sp & 255u) == 0u) { if (xb_ld(&(bar)[XB_TMO])) break; if (_sp > XB_SPIN_CAP) { atomicAdd(&(bar)[XB_TMO], 1u); break; } } } } while (0)

struct XcdBarrier {
    unsigned* bar; unsigned x; unsigned w;
    volatile LAS unsigned* st;
};

__device__ __forceinline__ XcdBarrier xcd_barrier_post(unsigned* bar, volatile LAS unsigned* st, unsigned wave) {
    XcdBarrier b; b.bar = bar; b.x = xb_xcc_id(); b.st = st; b.w = wave;
    if (b.w == 0u && pg8::hw_lane() == 0) (void)xb_add(&bar[XB_XCNT(b.x)], 1u);
    return b;
}
__device__ __forceinline__ void xcd_barrier_complete(unsigned* bar, unsigned x, unsigned& nloc, unsigned& nx) {
    const unsigned G = gridDim.x * gridDim.y * gridDim.z;
    unsigned sum, cnt, mine, sp = 0u;
    for (;;) {
        sum = 0u; cnt = 0u; mine = 0u;
#pragma unroll
        for (unsigned j = 0; j < 16; ++j) { const unsigned c = xb_ld(&bar[XB_XCNT(j)]); sum += c; cnt += (c > 0u) ? 1u : 0u; mine = (j == x) ? c : mine; }
        if (sum == G) break;
        __builtin_amdgcn_s_sleep(1);
        if ((++sp & 255u) == 0u) { if (xb_ld(&bar[XB_TMO])) break; if (sp > XB_SPIN_CAP) { atomicAdd(&bar[XB_TMO], 1u); break; } }
    }
    nloc = mine > 0u ? mine : 1u; nx = cnt > 0u ? cnt : 1u;
}

__device__ __forceinline__ void xcd_barrier(const XcdBarrier& b) {
    asm volatile("s_waitcnt vmcnt(0)" ::: "memory");
    __syncthreads();
    if (b.w == 0u && pg8::hw_lane() == 0) {
        unsigned* bar = b.bar;
        __builtin_amdgcn_s_waitcnt(0);
        unsigned nloc = b.st[0], nx = b.st[1];
        if (nloc == 0u) { xcd_barrier_complete(bar, b.x, nloc, nx); b.st[0] = nloc; b.st[1] = nx; }
        const unsigned old = xb_add(&bar[XB_XSUB(b.x)], 1u);
        const unsigned gen = old / nloc;
        if (old + 1u == (gen + 1u) * nloc) {
            __builtin_amdgcn_fence(__ATOMIC_RELEASE, "agent");
            asm volatile("s_waitcnt vmcnt(0)" ::: "memory");
            const unsigned og = xb_add(&bar[XB_TOP], 1u);
            const unsigned tg = og / nx;
            if (og + 1u == (tg + 1u) * nx) xb_add(&bar[XB_TOPGEN], 1u);
            else XB_SPIN(xb_ld(&bar[XB_TOPGEN]) == tg, bar);
            __builtin_amdgcn_fence(__ATOMIC_ACQUIRE, "agent");
            xb_add(&bar[XB_XGEN(b.x)], 1u);
            asm volatile("s_waitcnt vmcnt(0)" ::: "memory");
        } else {
            XB_SPIN(xb_ld(&bar[XB_XGEN(b.x)]) == gen, bar);
            __builtin_amdgcn_fence(__ATOMIC_ACQUIRE, "agent");
            asm volatile("s_waitcnt vmcnt(0)" ::: "memory");
        }
    }
    __syncthreads();
}
namespace mk {
constexpr int NWAVES = 8, NTHR = 512;
constexpr int NB = 16, S = 2048, D = 1024, CT = 256, RB = S + CT  , MT = NB * RB, HB = 8  , MH = HB * RB, DI = 2048;
constexpr float EPS = 1e-6f, LOG2E = 1.4426950408889634f;
constexpr size_t MiB = 1u << 20;
constexpr size_t WS_CTXS = 0, WS_MOD = 16 * MiB, WS_CTL = 17 * MiB, CTL_BYTES = 64 * 1024;
constexpr size_t WS_ROPE = 18 * MiB, WS_WG2 = 18 * MiB + 64 * 1024, WS_GATES = 19 * MiB;
constexpr size_t WS_WIN = 22 * MiB, WS_WOUT = 38 * MiB, WS_H = 42 * MiB, WS_QG = 114 * MiB, WS_S2 = 258 * MiB, WS_S3 = 330 * MiB, WS_S4 = 402 * MiB, WS_END = 474 * MiB, WS_GATES2 = 474 * MiB  ,
    WS_SSQ = 477 * MiB  , WS_W2 = 480 * MiB  , WS_SHW = 500 * MiB  , WS_GATES3 = 503 * MiB, WS_GATES4 = 506 * MiB  ;
constexpr int CW_BAR = 1024;
constexpr int RING_BYTES = 131072, MISC_OFF = RING_BYTES + 320, LDS_BYTES = 147456;

typedef unsigned short bf16;
typedef float f32x4 __attribute__((ext_vector_type(4)));
typedef float f32x16 __attribute__((ext_vector_type(16)));
typedef short bf16x8 __attribute__((ext_vector_type(8)));
typedef short s16x4 __attribute__((ext_vector_type(4)));
typedef unsigned u32x4 __attribute__((ext_vector_type(4)));
typedef unsigned u32x2 __attribute__((ext_vector_type(2)));

__device__ __forceinline__ float silu(float x) { return x / (1.f + __expf(-x)); }
__device__ __forceinline__ float bf2f(unsigned short b) { return __uint_as_float((unsigned)b << 16); }
__device__ __forceinline__ float bflo(unsigned w) { return __uint_as_float(w << 16); }
__device__ __forceinline__ float bfhi(unsigned w) { return __uint_as_float(w & 0xffff0000u); }
__device__ __forceinline__ float wave_sum(float v) {
#pragma unroll
    for (int o = 1; o < 64; o <<= 1) v += __shfl_xor(v, o);
    return v;
}

struct Frame {
    LAS unsigned char* lds;
    int tid, lane, wave, vcu, G;
    void* const* dummy;
};
__device__ __forceinline__ Frame fresh(const Frame& F0) { Frame F = F0; const int l = pg8::hw_lane(); F.lane = l; F.tid = F0.wave * 64 + l; return F; }
struct Args { const float* in[32]; float* out; unsigned char* ws; int ph_lo, ph_hi; };

template <bool ROPE, bool AFFINE = false> struct EpiProj {
    static constexpr bool PERM = true, AFTER_DRAIN = false;
    bf16 *d0, *d1, *d2, *d3; int l0, l1, l2, l3; int t1, t2, t3; unsigned ropemask; float sc0; const float* rope;
    const float* ssq; const float* shw; int row_base;
    __device__ __forceinline__ void operator()(const pg8::f32x4 (&acc)[2][2][4][2], const pg8::Unit& u, int wr, int wc, int fr, int fq) const { run<false>(acc, u, wr, wc, fr, fq); }
    template <bool NOSTORE> __device__ __forceinline__ void run(const pg8::f32x4 (&acc)[2][2][4][2], const pg8::Unit& u, int wr, int wc, int fr, int fq) const {
        asm volatile("" : "+v"(fr), "+v"(fq));
        const int pn = u.pn;
        long long off = 0; int ld = l0, tb = 0, s = 0;
        if (pn >= t1) { off += (long long)(d1 - d0); ld += l1 - l0; tb = t1; s = 1; }
        if (pn >= t2) { off += (long long)(d2 - d1); ld += l2 - l1; tb = t2; s = 2; }
        if (pn >= t3) { off += (long long)(d3 - d2); ld += l3 - l2; tb = t3; s = 3; }
        bf16* base = d0 + off;
        const float sc = (pn >= t1) ? 1.f : sc0;
        const int rr0 = (u.pm * 256) % RB;
        const bool do_rope = ROPE && ((ropemask >> s) & 1u) && rr0 != 0;
        const int col0 = (pn - tb) * 256 + wc * 32 + 8 * fq;
        const int rloc = wr * 64 + fr;
        pg8::f32x4 sw[2][2];
        if (AFFINE) { const int gr0 = row_base + u.pm * 256; const float* sp = shw + (size_t)(rr0 == 0 ? 16 : gr0 / RB) * 8192 + pn * 256 + wc * 32 + 8 * fq;
#pragma unroll
            for (int bj = 0; bj < 2; ++bj) { sw[bj][0] = *(const pg8::f32x4*)(sp + bj * 128); sw[bj][1] = *(const pg8::f32x4*)(sp + bj * 128 + 4); } }
#pragma unroll
        for (int ai = 0; ai < 2; ++ai)
#pragma unroll
            for (int m = 0; m < 4; ++m) {
                const int rt = rloc + ai * 128 + m * 16;
                bf16* rowp = base + (size_t)(u.pm * 256 + rt) * ld + col0;
                float rstd = 1.f;
                if (AFFINE) { const pg8::f32x4* qp = (const pg8::f32x4*)(ssq + (size_t)(row_base + u.pm * 256 + rt) * 16); const pg8::f32x4 a0 = qp[0], a1 = qp[1], a2 = qp[2], a3 = qp[3];
                    const float tot = ((a0[0] + a0[1]) + (a0[2] + a0[3])) + ((a1[0] + a1[1]) + (a1[2] + a1[3])) + ((a2[0] + a2[1]) + (a2[2] + a2[3])) + ((a3[0] + a3[1]) + (a3[2] + a3[3]));
                    rstd = rsqrtf(tot * (1.f / D) + EPS); }
                f32x4 cs0 = {}, cs1 = {}, cs2 = {}, cs3 = {};
                if (ROPE && do_rope) { const int t = rr0 - CT + rt; const int pos = (wc & 1) ? (t & 63) : (t >> 6); const f32x4* tp = (const f32x4*)(rope + pos * 32 + 16 * (fq & 1));
                    cs0 = tp[0]; cs1 = tp[1]; cs2 = tp[2]; cs3 = tp[3]; }
#pragma unroll
                for (int bj = 0; bj < 2; ++bj) {
                    pg8::f32x4 v0 = acc[ai][bj][m][0], v1 = acc[ai][bj][m][1];
                    if (AFFINE) { v0 = v0 * rstd + sw[bj][0]; v1 = v1 * rstd + sw[bj][1]; }
                    if (ROPE && do_rope) {
                        const float sg = (fq & 2) ? 1.f : -1.f;
                        pg8::f32x4 p0, p1;
#pragma unroll
                        for (int i = 0; i < 4; ++i) { p0[i] = __shfl_xor(v0[i], 32); p1[i] = __shfl_xor(v1[i], 32); }
                        v0[0] = v0[0] * cs0[0] + sg * p0[0] * cs0[1]; v0[1] = v0[1] * cs0[2] + sg * p0[1] * cs0[3];
                        v0[2] = v0[2] * cs1[0] + sg * p0[2] * cs1[1]; v0[3] = v0[3] * cs1[2] + sg * p0[3] * cs1[3];
                        v1[0] = v1[0] * cs2[0] + sg * p1[0] * cs2[1]; v1[1] = v1[1] * cs2[2] + sg * p1[1] * cs2[3];
                        v1[2] = v1[2] * cs3[0] + sg * p1[2] * cs3[1]; v1[3] = v1[3] * cs3[2] + sg * p1[3] * cs3[3];
                    }
                    v0 = v0 * sc; v1 = v1 * sc;
                    pg8::u32x4 w; w.x = pg8::cvt_pk_bf16(v0[0], v0[1]); w.y = pg8::cvt_pk_bf16(v0[2], v0[3]); w.z = pg8::cvt_pk_bf16(v1[0], v1[1]); w.w = pg8::cvt_pk_bf16(v1[2], v1[3]);
                    if (NOSTORE) asm volatile("" :: "v"(w)); else { *(pg8::u32x4*)(rowp + bj * 128) = w;
#ifdef MK_EXP_ST2
                        asm volatile("" ::: "memory"); *(volatile pg8::u32x4*)(rowp + bj * 128) = w;
#endif
                    }
                }
            }
    }
};
__device__ __forceinline__ pg8::f32x4 ld4(const float* p) { return *(const pg8::f32x4*)p; }
__device__ __forceinline__ pg8::f32x4 ld4(const bf16* p) { const u32x2 w = *(const u32x2*)p; pg8::f32x4 v; v[0] = bflo(w.x); v[1] = bfhi(w.x); v[2] = bflo(w.y); v[3] = bfhi(w.y); return v; }
__device__ __forceinline__ void st4(float* p, const pg8::f32x4& v) { *(pg8::f32x4*)p = v; }
__device__ __forceinline__ void st4(bf16* p, const pg8::f32x4& v) { u32x2 w; w.x = pg8::cvt_pk_bf16(v[0], v[1]); w.y = pg8::cvt_pk_bf16(v[2], v[3]); *(u32x2*)p = w; }
template <class BT = float, class OT = float> struct EpiResidT {
    static constexpr bool PERM = false, AFTER_DRAIN = false;
    const BT* base_lat; const BT* base_ctx; OT* out_lat; OT* out_ctx; const float* mod_l; int need_ctx; int dry;
    bf16* Hn; const float* gnext; const float* modn; float* ssq;
    __device__ __forceinline__ void operator()(const pg8::f32x4 (&acc)[2][2][4][2], const pg8::Unit& u, int wr, int wc, int fr, int fq) const {
        asm volatile("" : "+v"(fr), "+v"(fq));
        const int r0 = u.pm * 256, b = r0 / RB, rr0 = r0 % RB; const bool ctx = rr0 == 0;
        if ((ctx && !need_ctx) || dry) return;
        const size_t ro = ctx ? (size_t)b * CT * D : ((size_t)b * S + (rr0 - CT)) * D;
        const BT* bp = (ctx ? base_ctx : base_lat) + ro; OT* op = (ctx ? out_ctx : out_lat) + ro;
        const float* gt = mod_l + (size_t)(ctx ? 16 : b) * 3072 + 2048;
        const int col0 = u.pn * 256 + wc * 32 + 4 * fq;
        pg8::f32x4 g[2][2];
#pragma unroll
        for (int bj = 0; bj < 2; ++bj)
#pragma unroll
            for (int n = 0; n < 2; ++n) g[bj][n] = *(const pg8::f32x4*)(gt + col0 + bj * 128 + n * 16);
        pg8::f32x4 gm[2][2];
        if (Hn) { const float* sn = modn + (size_t)(ctx ? 16 : b) * 3072 + 1024;
#pragma unroll
            for (int bj = 0; bj < 2; ++bj)
#pragma unroll
                for (int n = 0; n < 2; ++n) gm[bj][n] = *(const pg8::f32x4*)(gnext + col0 + bj * 128 + n * 16) * (*(const pg8::f32x4*)(sn + col0 + bj * 128 + n * 16) + 1.0f); }
#pragma unroll
        for (int ai = 0; ai < 2; ++ai)
#pragma unroll
            for (int m = 0; m < 4; ++m) { const size_t off = (size_t)(ai * 128 + wr * 64 + m * 16 + fr) * D + col0; float sq = 0.f;
#pragma unroll
                for (int bj = 0; bj < 2; ++bj)
#pragma unroll
                    for (int n = 0; n < 2; ++n) { const pg8::f32x4 bs = ld4(bp + off + bj * 128 + n * 16); const pg8::f32x4 xn = bs + g[bj][n] * acc[ai][bj][m][n]; st4(op + off + bj * 128 + n * 16, xn);
                        if (Hn) { sq += (xn[0] * xn[0] + xn[1] * xn[1]) + (xn[2] * xn[2] + xn[3] * xn[3]); const pg8::f32x4 hv = xn * gm[bj][n];
                            u32x2 w; w.x = pg8::cvt_pk_bf16(hv[0], hv[1]); w.y = pg8::cvt_pk_bf16(hv[2], hv[3]); *(u32x2*)(Hn + (size_t)(r0 + ai * 128 + wr * 64 + m * 16 + fr) * D + col0 + bj * 128 + n * 16) = w; } }
                if (Hn) { sq += __shfl_xor(sq, 16); sq += __shfl_xor(sq, 32); if (fq == 0) ssq[(size_t)(r0 + ai * 128 + wr * 64 + m * 16 + fr) * 16 + u.pn * 4 + wc] = sq; } }
    }
};
using EpiResid = EpiResidT<float, float>;

struct LatOnlyOrder {
    pg8::StaticOrder lat;
    __device__ void init(int G_, int c_) { lat.init(128 * 256, D, G_, c_); }
    __device__ bool next(int i, pg8::Unit& u) const { const bool ok = lat.next(i, u); u.pm = (u.pm >> 3) * 9 + 1 + (u.pm & 7); return ok; }
    __device__ __forceinline__ void a_ready(const pg8::Unit&) const {}
    __device__ __forceinline__ void done(const pg8::Unit&) const {}
};
struct OutTailOrder {
    int c;
    __device__ void init(int, int c_) { c = c_; }
    __device__ bool next(int i, pg8::Unit& u) const { if (i > 0 || c >= 64) return false; const int x = c & 7, j = c >> 3; u.pm = 128 + 2 * x + (j >> 2); u.pn = j & 3; return true; }
    __device__ __forceinline__ void a_ready(const pg8::Unit&) const {}
    __device__ __forceinline__ void done(const pg8::Unit&) const {}
};
struct L3Order {
    pg8::StaticOrder lat; int G, c;
    __device__ void init(int G_, int c_) { lat.init(64 * 256, 18 * 256, G_, c_); G = G_; c = c_; }
    __device__ bool next(int i, pg8::Unit& u) const {
        const long L = (long)i * G + c;
        if (L < 1152) { const bool ok = lat.next(i, u); u.pm = (u.pm >> 3) * 9 + 1 + (u.pm & 7); return ok; }
        if (L >= 1168) return false;
        const int j = (int)L - 1152; u.pm = (j >> 1) * 9; u.pn = 8 + (j & 1); return true;
    }
    __device__ __forceinline__ void a_ready(const pg8::Unit&) const {}
    __device__ __forceinline__ void done(const pg8::Unit&) const {}
};

__device__ __forceinline__ void transpose_item(const float* W, int K, int N, bf16* WT, LAS float* scr, int item, int lane) {
    const int nblk = N / 32, kb = item / nblk, nb = item % nblk, k0 = 64 * kb, n0 = 32 * nb;
#pragma unroll 8
    for (int i = 0; i < 32; ++i) { const int kk = 2 * i + (lane >> 5); scr[kk * 33 + (lane & 31)] = W[(size_t)(k0 + kk) * N + n0 + (lane & 31)]; }
    LDS_WAIT(); asm volatile("" ::: "memory");
    const int c = lane & 7;
#pragma unroll
    for (int j = 0; j < 4; ++j) { const int n = (lane >> 3) + 8 * j; const LAS float* s = scr + (8 * c) * 33 + n;
        v4u o; o.x = pk2(s[0 * 33], s[1 * 33]); o.y = pk2(s[2 * 33], s[3 * 33]); o.z = pk2(s[4 * 33], s[5 * 33]); o.w = pk2(s[6 * 33], s[7 * 33]);
        *(GAS v4u*)(WT + (size_t)(n0 + n) * K + k0 + 8 * c) = o; }
    LDS_WAIT(); asm volatile("" ::: "memory");
}
__device__ __forceinline__ void wconv(Frame& F0, const float* Win, int Nin, const float* Wout, bf16* WinT, bf16* WoutT, int gw, int NGW) {
    Frame F = fresh(F0);
    LAS float* scr = (LAS float*)(F.lds + F.wave * 16384);
    const int I1 = (D / 64) * (Nin / 32), I2 = (DI / 64) * (D / 32);
    for (int it = gw; it < I1 + I2; it += NGW) { if (it < I1) transpose_item(Win, D, Nin, WinT, scr, it, F.lane); else transpose_item(Wout, DI, D, WoutT, scr, it - I1, F.lane); }
}
template <class XT>
__device__ __forceinline__ void norm_phase(Frame& F0, const XT* xlat, const XT* xctx, const float* g, const float* mod_l, bf16* H, int row_lo = 0, int row_hi = MT, int wg0 = 0) {
    Frame F = fresh(F0);
    const int gw = (wg0 ? (int)blockIdx.x - wg0 : F.vcu) * NWAVES + F.wave, NGW = (F.G - wg0) * NWAVES;
    f32x4 gg[4];
#pragma unroll
    for (int j = 0; j < 4; ++j) gg[j] = *(const f32x4*)(g + F.lane * 4 + 256 * j);
    for (int row0 = row_lo + gw; row0 < row_hi; row0 += 2 * NGW) {
        f32x4 v[2][4]; const float* mrow[2]; float ss[2] = {0.f, 0.f}; int rowi[2];
#pragma unroll
        for (int u = 0; u < 2; ++u) { int row = row0 + u * NGW; if (row >= row_hi) row = row0; rowi[u] = row;
            const int b = row / RB, rr = row % RB;
            const XT* src = rr < CT ? xctx + ((size_t)b * CT + rr) * D : xlat + ((size_t)b * S + (rr - CT)) * D;
            mrow[u] = mod_l + (size_t)(rr < CT ? 16 : b) * 3072;
#pragma unroll
            for (int j = 0; j < 4; ++j) v[u][j] = ld4(src + F.lane * 4 + 256 * j); }
#pragma unroll
        for (int u = 0; u < 2; ++u) {
#pragma unroll
            for (int j = 0; j < 4; ++j) ss[u] += (v[u][j].x * v[u][j].x + v[u][j].y * v[u][j].y) + (v[u][j].z * v[u][j].z + v[u][j].w * v[u][j].w);
            const float rstd = rsqrtf(wave_sum(ss[u]) * (1.f / D) + EPS);
#pragma unroll
            for (int j = 0; j < 4; ++j) { const int c = F.lane * 4 + 256 * j; const f32x4 sc = *(const f32x4*)(mrow[u] + 1024 + c), sh = *(const f32x4*)(mrow[u] + c);
                const f32x4 o = v[u][j] * rstd * gg[j] * (sc + 1.0f) + sh;
                u32x2 w; w.x = pk2(o.x, o.y); w.y = pk2(o.z, o.w); *(u32x2*)(H + (size_t)rowi[u] * D + c) = w; }
        }
    }
}
__device__ __forceinline__ void final_norm_phase(Frame& F0, float* xs, const float* g) {
    Frame F = fresh(F0);
    const int gw = F.vcu * NWAVES + F.wave, NGW = F.G * NWAVES;
    f32x4 gg[4];
#pragma unroll
    for (int j = 0; j < 4; ++j) gg[j] = *(const f32x4*)(g + F.lane * 4 + 256 * j);
    for (int row0 = gw; row0 < NB * S; row0 += 2 * NGW) {
        f32x4 v[2][4]; float* p[2];
#pragma unroll
        for (int u = 0; u < 2; ++u) { int row = row0 + u * NGW; if (row >= NB * S) row = row0; p[u] = xs + (size_t)row * D;
#pragma unroll
            for (int j = 0; j < 4; ++j) v[u][j] = *(const f32x4*)(p[u] + F.lane * 4 + 256 * j); }
#pragma unroll
        for (int u = 0; u < 2; ++u) { float ss = 0.f;
#pragma unroll
            for (int j = 0; j < 4; ++j) ss += (v[u][j].x * v[u][j].x + v[u][j].y * v[u][j].y) + (v[u][j].z * v[u][j].z + v[u][j].w * v[u][j].w);
            const float rstd = rsqrtf(wave_sum(ss) * (1.f / D) + EPS);
#pragma unroll
            for (int j = 0; j < 4; ++j) { const int c = F.lane * 4 + 256 * j; *(f32x4*)(p[u] + c) = v[u][j] * rstd * gg[j]; } }
    }
}
__device__ __forceinline__ void shw_phase(Frame& F0, const Args& a) {
    Frame F = fresh(F0);
    const float* mod = (const float*)(a.ws + WS_MOD); float* shw = (float*)(a.ws + WS_SHW);
    LAS float* sh = (LAS float*)F.lds;
    LAS float* red = (LAS float*)(F.lds + 69632);
    int cur_l = -1;
    for (int it = blockIdx.x; it < 128 + 128 + 72; it += F.G) {
        const int l = it < 128 ? 0 : (it < 256 ? 1 : 2), cg = it - (l == 0 ? 0 : (l == 1 ? 128 : 256));
        const int N = l == 2 ? 4608 : 8192; const float* W = a.in[l == 0 ? 19 : (l == 1 ? 26 : 29)];
        __syncthreads();
        if (l != cur_l) { for (int i = F.tid; i < 17 * 1024; i += NTHR) sh[i] = mod[((size_t)(l + 1) * 17 + (i >> 10)) * 3072 + (i & 1023)]; cur_l = l; __syncthreads(); }
        float acc[17];
#pragma unroll
        for (int r = 0; r < 17; ++r) acc[r] = 0.f;
        const float* wp = W + (size_t)(F.wave * 128) * N + cg * 64 + F.lane;
#pragma unroll 8
        for (int kk = 0; kk < 128; ++kk) { const float w = wp[(size_t)kk * N];
#pragma unroll
            for (int r = 0; r < 17; ++r) acc[r] += sh[r * 1024 + F.wave * 128 + kk] * w; }
#pragma unroll
        for (int r = 0; r < 17; ++r) red[(F.wave * 17 + r) * 64 + F.lane] = acc[r];
        __syncthreads();
        for (int i = F.tid; i < 17 * 64; i += NTHR) { float sacc = 0.f;
#pragma unroll
            for (int w8 = 0; w8 < 8; ++w8) sacc += red[(w8 * 17 + (i >> 6)) * 64 + (i & 63)];
            shw[((size_t)l * 17 + (i >> 6)) * 8192 + cg * 64 + (i & 63)] = sacc; }
    }
    __syncthreads();
}
__device__ __forceinline__ void prologue_phase(Frame& F0, const Args& a) {
    Frame F = fresh(F0);
    const float* c = a.in[1]; const float* cctx = a.in[3]; const float* w_ada = a.in[5];
    float* part = (float*)(a.ws + WS_QG);
    {
        LAS float* st = (LAS float*)F.lds;
        const int wg = blockIdx.x, l = wg >> 6, sl = wg & 63, k0 = sl * 16;
        if (F.tid < 17 * 16) { const int r = F.tid >> 4, k = F.tid & 15; st[F.tid] = silu(r < 16 ? c[r * 1024 + k0 + k] : cctx[k0 + k]); }
        __syncthreads();
        float acc[17][6];
#pragma unroll
        for (int r = 0; r < 17; ++r)
#pragma unroll
            for (int i = 0; i < 6; ++i) acc[r][i] = 0.f;
        const float* wp = w_ada + ((size_t)l * 1024 + k0) * 3072 + F.tid;
#pragma unroll 2
        for (int kk = 0; kk < 16; ++kk) { float w[6];
#pragma unroll
            for (int i = 0; i < 6; ++i) w[i] = wp[(size_t)kk * 3072 + 512 * i];
#pragma unroll
            for (int r = 0; r < 17; ++r) { const float sv = st[r * 16 + kk];
#pragma unroll
                for (int i = 0; i < 6; ++i) acc[r][i] += sv * w[i]; } }
        float* pp = part + (size_t)wg * 17 * 3072 + F.tid;
#pragma unroll
        for (int r = 0; r < 17; ++r)
#pragma unroll
            for (int i = 0; i < 6; ++i) pp[r * 3072 + 512 * i] = acc[r][i];
    }
#ifdef MK_TOUCH
    {
        const int xg = blockIdx.x >> 3; unsigned accv = 0u;
        for (size_t off = ((size_t)xg * NTHR + F.tid) * 4096; off < WS_END; off += (size_t)32 * NTHR * 4096) accv += *(const unsigned*)(a.ws + off);
        for (size_t off = ((size_t)xg * NTHR + F.tid) * 4096; off < (size_t)NB * S * D * 4; off += (size_t)32 * NTHR * 4096) accv += *(const unsigned*)((const unsigned char*)a.out + off) + *(const unsigned*)((const unsigned char*)a.in[0] + off);
        asm volatile("" :: "v"(accv));
    }
#endif
    if (blockIdx.x == 0) {
        float* rope = (float*)(a.ws + WS_ROPE);
        for (int i = F.tid; i < 64 * 16; i += NTHR) { const int pos = i >> 4, j = i & 15; const float inv = powf(10000.f, -(float)j / 16.f), ang = (float)pos * inv; rope[2 * i] = cosf(ang); rope[2 * i + 1] = sinf(ang); }
    } else if (blockIdx.x < 33) {
        bf16* W2 = (bf16*)(a.ws + WS_WG2); const float* wq = a.in[11]; const float* wk = a.in[12]; const float* wv = a.in[13]; const float* wg = a.in[14];
        for (int i = (blockIdx.x - 1) * NTHR + F.tid; i < 32 * 4096; i += 32 * NTHR) { const int n = i >> 12, k = i & 4095; float s = 0.f;
            if (k < 2048) { const int gq = k >> 2, ii = k & 3;
#pragma unroll
                for (int j = 0; j < 4; ++j) s += wq[(gq * 4 + ii) * 4 + j] * wg[(size_t)(gq * 4 + j) * 32 + n] + wk[(gq * 4 + ii) * 4 + j] * wg[(size_t)(2048 + gq * 4 + j) * 32 + n]; }
            else { const int kk = k - 2048, gq = kk >> 2, ii = kk & 3;
#pragma unroll
                for (int j = 0; j < 4; ++j) s += wv[(gq * 4 + ii) * 4 + j] * wg[(size_t)(4096 + gq * 4 + j) * 32 + n]; }
            W2[i] = (bf16)f2bf(s); }
    }
}
__device__ __forceinline__ void prologue2_phase(Frame& F0, const Args& a) {
    Frame F = fresh(F0);
    const float* part = (const float*)(a.ws + WS_QG); const float* b_ada = a.in[6]; float* mod = (float*)(a.ws + WS_MOD);
    for (int o = blockIdx.x * NTHR + F.tid; o < 4 * 17 * 3072; o += F.G * NTHR) {
        const int l = o / (17 * 3072), rn = o % (17 * 3072), n = rn % 3072;
        const float* pp = part + (size_t)l * 64 * 17 * 3072 + rn; float s0 = 0.f, s1 = 0.f, s2 = 0.f, s3 = 0.f;
#pragma unroll
        for (int sl = 0; sl < 64; sl += 16) { float v[16];
#pragma unroll
            for (int j = 0; j < 16; ++j) v[j] = pp[(size_t)(sl + j) * 17 * 3072];
#pragma unroll
            for (int j = 0; j < 16; j += 4) { s0 += v[j]; s1 += v[j + 1]; s2 += v[j + 2]; s3 += v[j + 3]; } }
        mod[o] = ((s0 + s1) + (s2 + s3)) + b_ada[l * 3072 + n];
    }
}
}
namespace att {
using mk::bf16; using mk::bf16x8; using mk::s16x4; using mk::f32x16; using mk::u32x4; using mk::u32x2;
typedef short v4i16_t __attribute__((ext_vector_type(4)));
typedef float f32x2_t __attribute__((ext_vector_type(2))); typedef __bf16 bf16x2_t __attribute__((ext_vector_type(2)));
__device__ __forceinline__ int crow(int r, int hi) { return (r & 3) + 8 * (r >> 2) + 4 * hi; }
__device__ __forceinline__ unsigned cvtpk(float lo, float hi) { f32x2_t v = {lo, hi}; bf16x2_t b = __builtin_convertvector(v, bf16x2_t); return __builtin_bit_cast(unsigned, b); }
__device__ __forceinline__ s16x4 vtr(LAS const unsigned char* p) { return __builtin_bit_cast(s16x4, __builtin_amdgcn_ds_read_tr16_b64_v4i16((LAS v4i16_t*)p)); }
__device__ __forceinline__ float ex2(float x) { return __builtin_amdgcn_exp2f(x); }
__device__ __forceinline__ float max3f(float a, float b, float c) { float r; asm("v_max3_f32 %0, %1, %2, %3" : "=v"(r) : "v"(a), "v"(b), "v"(c)); return r; }
#define ATT_SB() __builtin_amdgcn_sched_barrier(0)

struct Src { const bf16* K[2]; const bf16* V; int ldk, ldv; };

template <int DV, int NCOMP> struct Stage { u32x4 kr[NCOMP]; u32x4 vr[DV / 64]; };
template <int DV, int NCOMP>
__device__ __forceinline__ void stage_load(Stage<DV, NCOMP>& st, const Src& s, size_t row, int wid, int lane) {
#pragma unroll
    for (int c = 0; c < NCOMP; ++c) st.kr[c] = *(const u32x4*)(s.K[c] + (row + lane) * s.ldk + wid * 8);
#pragma unroll
    for (int i = 0; i < DV / 64; ++i) { const int p = wid + 8 * i, d0 = p >> 2, kg = p & 3; st.vr[i] = *(const u32x4*)(s.V + (row + 16 * kg + (lane >> 2)) * s.ldv + d0 * 32 + (lane & 3) * 8); }
}
template <int DV, int NCOMP>
__device__ __forceinline__ void stage_store(const Stage<DV, NCOMP>& st, LAS unsigned char* buf, int wid, int lane) {
#pragma unroll
    for (int c = 0; c < NCOMP; ++c) *(LAS u32x4*)(buf + c * 8192 + wid * 1024 + lane * 16) = st.kr[c];
#pragma unroll
    for (int i = 0; i < DV / 64; ++i) *(LAS u32x4*)(buf + NCOMP * 8192 + (wid + 8 * i) * 1024 + lane * 16) = st.vr[i];
}
__device__ __forceinline__ void glds16(const void* gsrc, unsigned lds_dst) { unsigned keep;
    asm volatile("s_mov_b32 %0, m0\n\ts_mov_b32 m0, %2\n\ts_nop 0\n\tglobal_load_lds_dwordx4 %1, off\n\ts_mov_b32 m0, %0" : "=&s"(keep) : "v"(gsrc), "s"(lds_dst) : "memory"); }
__device__ __forceinline__ unsigned long long uni64(const void* p) { const unsigned long long a = (unsigned long long)p;
    return ((unsigned long long)(unsigned)__builtin_amdgcn_readfirstlane((unsigned)(a >> 32)) << 32) | (unsigned)__builtin_amdgcn_readfirstlane((unsigned)a); }
__device__ __forceinline__ void glds16s(const void* sbase_, unsigned voff, unsigned lds_dst) { unsigned keep; const unsigned long long sbase = uni64(sbase_);
    asm volatile("s_mov_b32 %0, m0\n\ts_mov_b32 m0, %3\n\ts_nop 0\n\tglobal_load_lds_dwordx4 %1, %2\n\ts_mov_b32 m0, %0" : "=&s"(keep) : "v"(voff), "s"(sbase), "s"(lds_dst) : "memory"); }
template <int DV, int NCOMP>
__device__ __forceinline__ void dma_issue(const Src& s, size_t row, LAS unsigned char* buf, int wid, int lane) {
    const unsigned b0 = (unsigned)(size_t)buf;
    const unsigned ko = (unsigned)(lane * s.ldk + wid * 8) * 2u, vo = (unsigned)((16 * (wid & 3) + (lane >> 2)) * s.ldv + (lane & 3) * 8) * 2u;
#pragma unroll
    for (int c = 0; c < NCOMP; ++c) glds16s(s.K[c] + row * s.ldk, ko, (unsigned)__builtin_amdgcn_readfirstlane(b0 + c * 8192 + wid * 1024));
#pragma unroll
    for (int i = 0; i < DV / 64; ++i) { const int p = wid + 8 * i, d0 = p >> 2;
        glds16s(s.V + row * s.ldv + d0 * 32, vo, (unsigned)__builtin_amdgcn_readfirstlane(b0 + NCOMP * 8192 + p * 1024)); }
}
#define ATT_WAIT_BAR(N) asm volatile("s_waitcnt vmcnt(" #N ") lgkmcnt(0)\n\ts_barrier" ::: "memory")
template <int NL> __device__ __forceinline__ void wait_bar_keep() { if constexpr (NL == 2) ATT_WAIT_BAR(2); else if constexpr (NL == 4) ATT_WAIT_BAR(4); else static_assert(NL == 2 || NL == 4, "pieces per wave"); }
__device__ __forceinline__ void qk_tile(LAS const unsigned char* kimg, const bf16x8 (&qf)[4], int r32, int hi, f32x16& p0, f32x16& p1, const f32x16& z, const f32x16& z1  ) {
    LAS const unsigned char* kb = kimg + hi * 1024 + r32 * 16;
#define ATT_KRD(i) (*(LAS const bf16x8*)(kb + ((i) >> 1) * 2048 + ((i) & 1) * 512))
    bf16x8 f0 = ATT_KRD(0), f1 = ATT_KRD(1), f2;
    f2 = ATT_KRD(2); ATT_SB(); p0 = __builtin_amdgcn_mfma_f32_32x32x16_bf16(f0, qf[0], z, 0, 0, 0);
    f0 = ATT_KRD(3); ATT_SB(); p1 = __builtin_amdgcn_mfma_f32_32x32x16_bf16(f1, qf[0], z1, 0, 0, 0);
    f1 = ATT_KRD(4); ATT_SB(); p0 = __builtin_amdgcn_mfma_f32_32x32x16_bf16(f2, qf[1], p0, 0, 0, 0);
    f2 = ATT_KRD(5); ATT_SB(); p1 = __builtin_amdgcn_mfma_f32_32x32x16_bf16(f0, qf[1], p1, 0, 0, 0);
    f0 = ATT_KRD(6); ATT_SB(); p0 = __builtin_amdgcn_mfma_f32_32x32x16_bf16(f1, qf[2], p0, 0, 0, 0);
    f1 = ATT_KRD(7); ATT_SB(); p1 = __builtin_amdgcn_mfma_f32_32x32x16_bf16(f2, qf[2], p1, 0, 0, 0);
    ATT_SB(); p0 = __builtin_amdgcn_mfma_f32_32x32x16_bf16(f0, qf[3], p0, 0, 0, 0);
    ATT_SB(); p1 = __builtin_amdgcn_mfma_f32_32x32x16_bf16(f1, qf[3], p1, 0, 0, 0);
#undef ATT_KRD
}
template <int DV>
__device__ __forceinline__ void softmax_tile(f32x16& p0, f32x16& p1, f32x16 (&o)[DV / 32], float& m, float& l, u32x4 (&pw)[4]) {
    float mxa = max3f(p0[0], p0[1], p1[0]), mxb = max3f(p0[2], p0[3], p1[1]); mxa = max3f(mxa, p1[2], p1[3]);
#pragma unroll
    for (int r = 4; r < 16; r += 4) { mxa = max3f(mxa, p0[r], p0[r + 1]); mxb = max3f(mxb, p0[r + 2], p0[r + 3]); mxa = max3f(mxa, p1[r], p1[r + 1]); mxb = max3f(mxb, p1[r + 2], p1[r + 3]); }
    const float mx0 = max3f(mxa, mxb, mxb);
    const float mn = max3f(m, mx0, __shfl_xor(mx0, 32)), alpha = ex2(m - mn);
    float ls = 0.f;
#pragma unroll
    for (int r = 0; r < 16; ++r) { p0[r] = ex2(p0[r] - mn); p1[r] = ex2(p1[r] - mn); ls += p0[r] + p1[r]; }
    l = l * alpha + ls;
    if (__any(mn != m)) {
#pragma unroll
        for (int d0 = 0; d0 < DV / 32; ++d0)
#pragma unroll
            for (int r = 0; r < 16; ++r) o[d0][r] *= alpha;
    }
    m = mn;
#pragma unroll
    for (int ks = 0; ks < 4; ++ks) { const int b = 8 * (ks & 1);
        if (ks < 2) { pw[ks].x = cvtpk(p0[b], p0[b + 1]); pw[ks].y = cvtpk(p0[b + 2], p0[b + 3]); pw[ks].z = cvtpk(p0[b + 4], p0[b + 5]); pw[ks].w = cvtpk(p0[b + 6], p0[b + 7]); }
        else { pw[ks].x = cvtpk(p1[b], p1[b + 1]); pw[ks].y = cvtpk(p1[b + 2], p1[b + 3]); pw[ks].z = cvtpk(p1[b + 4], p1[b + 5]); pw[ks].w = cvtpk(p1[b + 6], p1[b + 7]); } }
}
template <int DV>
__device__ __forceinline__ void pv_tile(LAS const unsigned char* vimg, int lane, int hi, const u32x4 (&pw)[4], f32x16 (&o)[DV / 32]) {
    LAS const unsigned char* vb = vimg + ((lane >> 4) & 1) * 32 + (lane & 3) * 8 + (4 * hi + ((lane & 15) >> 2)) * 64;
    constexpr int ND = DV / 32, NF = 4 * ND;
    constexpr int PD = 4, NB_ = PD + 1;
    s16x4 lo[NB_], hi4[NB_];
#define ATT_VRD(i, b) do { lo[b] = vtr(vb + ((i) % ND) * 4096 + ((i) / ND) * 1024); hi4[b] = vtr(vb + ((i) % ND) * 4096 + ((i) / ND) * 1024 + 512); } while (0)
#pragma unroll
    for (int i = 0; i < PD; ++i) ATT_VRD(i, i);
#pragma unroll
    for (int i = 0; i < NF; ++i) {
        if (i + PD < NF) ATT_VRD(i + PD, (i + PD) % NB_);
        ATT_SB();
        const int b = i % NB_;
        const bf16x8 vf = {lo[b][0], lo[b][1], lo[b][2], lo[b][3], hi4[b][0], hi4[b][1], hi4[b][2], hi4[b][3]};
        o[i % ND] = __builtin_amdgcn_mfma_f32_32x32x16_bf16(vf, __builtin_bit_cast(bf16x8, pw[i / ND]), o[i % ND], 0, 0, 0);
    }
#undef ATT_VRD
}

struct SmState { float mxa, mxb, mn, alpha, ls, delta; bool resc; };
template <int NM>
__device__ __forceinline__ void negm_shift(f32x16 (&negm)[NM], float delta) {
#pragma unroll
    for (int i = 0; i < NM; ++i)
#pragma unroll
        for (int r = 0; r < 16; ++r) negm[i][r] -= delta;
}
__device__ __forceinline__ float xmax32(float v) { auto rr = __builtin_amdgcn_permlane32_swap(__float_as_uint(v), __float_as_uint(v), false, false); return max3f(__uint_as_float(rr[0]), __uint_as_float(rr[1]), v); }
template <int SK> __device__ __forceinline__ constexpr bool sm_live0(int r) { return SK != 2 || r >= 12; }
template <int SK> __device__ __forceinline__ constexpr bool sm_live1(int r) { return SK != 1 || r < 4; }
template <int SK = 0>
__device__ __forceinline__ void sm_slice(int k, f32x16& p0, f32x16& p1, float& m, float& l, SmState& s, u32x4 (&pwn)[4]) {
    if (k <= 3) { const int r = 4 * k;
        if (SK == 0 && k == 0) { s.mxa = max3f(p0[0], p0[1], p1[0]); s.mxb = max3f(p0[2], p0[3], p1[1]); s.mxa = max3f(s.mxa, p1[2], p1[3]); }
        else { if (k == 0) { s.mxa = -INFINITY; s.mxb = -INFINITY; }
            if (sm_live0<SK>(r)) { s.mxa = max3f(s.mxa, p0[r], p0[r + 1]); s.mxb = max3f(s.mxb, p0[r + 2], p0[r + 3]); }
            if (sm_live1<SK>(r)) { s.mxa = max3f(s.mxa, p1[r], p1[r + 1]); s.mxb = max3f(s.mxb, p1[r + 2], p1[r + 3]); } }
        asm volatile("" : "+v"(s.mxa), "+v"(s.mxb)); }
    else if (k == 4) { const float mx0 = xmax32(max3f(s.mxa, s.mxb, s.mxb)); const bool first = m == -INFINITY;
        const float delta = (first || mx0 > 8.f) ? mx0 : 0.f; s.delta = delta; s.mn = first ? mx0 : m + delta; s.alpha = ex2(-delta); s.resc = __any(delta != 0.f); l *= s.alpha; s.ls = 0.f;
        if (s.resc) {
#pragma unroll
            for (int r = 0; r < 16; ++r) { p0[r] -= delta; p1[r] -= delta; }
        }
        asm volatile("" : "+v"(s.mn), "+v"(s.alpha), "+v"(l)); }
    else if (k <= 12) { const int j = 2 * (k - 5);
        if (sm_live0<SK>(j)) { p0[j] = ex2(p0[j]); p0[j + 1] = ex2(p0[j + 1]); s.ls += p0[j] + p0[j + 1]; }
        if (sm_live1<SK>(j)) { p1[j] = ex2(p1[j]); p1[j + 1] = ex2(p1[j + 1]); s.ls += p1[j] + p1[j + 1]; }
        asm volatile("" : "+v"(p0), "+v"(p1), "+v"(s.ls)); }
    else if (k == 13) {
        if (SK == 2) { pwn[0] = u32x4{0u, 0u, 0u, 0u}; pwn[1].x = 0u; pwn[1].y = 0u; }
        else { pwn[0].x = cvtpk(p0[0], p0[1]); pwn[0].y = cvtpk(p0[2], p0[3]); pwn[0].z = cvtpk(p0[4], p0[5]); pwn[0].w = cvtpk(p0[6], p0[7]); pwn[1].x = cvtpk(p0[8], p0[9]); pwn[1].y = cvtpk(p0[10], p0[11]); }
        pwn[1].z = cvtpk(p0[12], p0[13]); pwn[1].w = cvtpk(p0[14], p0[15]); asm volatile("" : "+v"(pwn[0]), "+v"(pwn[1])); }
    else if (k == 14) { pwn[2].x = cvtpk(p1[0], p1[1]); pwn[2].y = cvtpk(p1[2], p1[3]);
        if (SK == 1) { pwn[2].z = 0u; pwn[2].w = 0u; pwn[3] = u32x4{0u, 0u, 0u, 0u}; }
        else { pwn[2].z = cvtpk(p1[4], p1[5]); pwn[2].w = cvtpk(p1[6], p1[7]); pwn[3].x = cvtpk(p1[8], p1[9]); pwn[3].y = cvtpk(p1[10], p1[11]); pwn[3].z = cvtpk(p1[12], p1[13]); pwn[3].w = cvtpk(p1[14], p1[15]); }
        asm volatile("" : "+v"(pwn[2]), "+v"(pwn[3])); }
    else { l += s.ls; asm volatile("" : "+v"(l)); }
}
template <int DV, int NM, int SK = 0>
__device__ __forceinline__ void sm_alone(f32x16& p0, f32x16& p1, f32x16 (&o)[DV / 32], float& m, float& l, u32x4 (&pwn)[4], f32x16 (&negm)[NM]) {
    SmState s;
#pragma unroll
    for (int k = 0; k < 16; ++k) sm_slice<SK>(k, p0, p1, m, l, s, pwn);
    if (s.resc) {
#pragma unroll
        for (int d0 = 0; d0 < DV / 32; ++d0)
#pragma unroll
            for (int r = 0; r < 16; ++r) o[d0][r] *= s.alpha;
        negm_shift<NM>(negm, s.delta);
    }
    m = s.mn;
}
template <int DV, int NM, int SK = 0>
__device__ __forceinline__ void pv_sm_tile(LAS const unsigned char* vimg, int lane, int hi, const u32x4 (&pw)[4], f32x16 (&o)[DV / 32], f32x16& p0, f32x16& p1, float& m, float& l, u32x4 (&pwn)[4], f32x16 (&negm)[NM]) {
    LAS const unsigned char* vb = vimg + ((lane >> 4) & 1) * 32 + (lane & 3) * 8 + (4 * hi + ((lane & 15) >> 2)) * 64;
    constexpr int ND = DV / 32, NF = 4 * ND, PD = 3, NB_ = PD + 1, SPM = 16 / NF;
    s16x4 lo[NB_], hi4[NB_];
    SmState s;
#define ATT_VRD(i, b) do { lo[b] = vtr(vb + ((i) % ND) * 4096 + ((i) / ND) * 1024); hi4[b] = vtr(vb + ((i) % ND) * 4096 + ((i) / ND) * 1024 + 512); } while (0)
#pragma unroll
    for (int i = 0; i < PD; ++i) ATT_VRD(i, i);
#pragma unroll
    for (int i = 0; i < NF; ++i) {
        if (i + PD < NF) ATT_VRD(i + PD, (i + PD) % NB_);
        ATT_SB();
        const int b = i % NB_;
        const bf16x8 vf = {lo[b][0], lo[b][1], lo[b][2], lo[b][3], hi4[b][0], hi4[b][1], hi4[b][2], hi4[b][3]};
        o[i % ND] = __builtin_amdgcn_mfma_f32_32x32x16_bf16(vf, __builtin_bit_cast(bf16x8, pw[i / ND]), o[i % ND], 0, 0, 0);
#pragma unroll
        for (int k = i * SPM; k < (i + 1) * SPM; ++k) sm_slice<SK>(k, p0, p1, m, l, s, pwn);
        ATT_SB();
    }
#undef ATT_VRD
    if (s.resc) {
#pragma unroll
        for (int d0 = 0; d0 < ND; ++d0)
#pragma unroll
            for (int r = 0; r < 16; ++r) o[d0][r] *= s.alpha;
        negm_shift<NM>(negm, s.delta);
    }
    m = s.mn;
}

__device__ __forceinline__ void wait_bar_tiles2(int c) {
    if (c >= 5) ATT_WAIT_BAR(10); else if (c == 4) ATT_WAIT_BAR(8); else if (c == 3) ATT_WAIT_BAR(6); else if (c == 2) ATT_WAIT_BAR(4); else if (c == 1) ATT_WAIT_BAR(2); else ATT_WAIT_BAR(0);
}
template <int DV, class Pol, int NS = 4>
__device__ __forceinline__ void run_unit1(LAS unsigned char* lds, const Pol& P, const Src& src, const bf16* Q, int ldq, int wid, int lane) {
    const int r32 = lane & 31, hi = lane >> 5;
    constexpr int STG = 8192 + DV * 128, NL = 1 + DV / 64, LA = NS - 2;
    static_assert(NL == 2 && LA <= 6, "wait_bar_tiles2 counts two-piece tiles");
    const int nt = P.ntiles();
#pragma unroll
    for (int t = 0; t < LA; ++t) if (t < nt) dma_issue<DV, 1>(src, P.tile_row(t), lds + t * STG, wid, lane);
    bf16x8 qf[4];
    { const bf16* qp = Q + (size_t)(wid * 32 + r32) * ldq + hi * 8;
#pragma unroll
      for (int d0 = 0; d0 < 4; ++d0) qf[d0] = *(const bf16x8*)(qp + d0 * 16); }
    f32x16 o[DV / 32];
#pragma unroll
    for (int d0 = 0; d0 < DV / 32; ++d0) o[d0] = f32x16{};
    float m = -INFINITY, l = 0.f; f32x16 negm[1] = {f32x16{}};
    u32x4 pw[4], pwn[4]; bool pend = false;
    asm volatile("" : "+v"(qf[0]), "+v"(qf[1]), "+v"(qf[2]), "+v"(qf[3]));
    ATT_WAIT_BAR(0);
    int ic = 0;
    for (int ti = 0; ti < nt; ++ti) {
        LAS unsigned char* cur = lds + ic * STG; LAS unsigned char* prv = lds + ((ic + NS - 1) & (NS - 1)) * STG;
        if (ti + LA < nt) dma_issue<DV, 1>(src, P.tile_row(ti + LA), lds + ((ic + LA) & (NS - 1)) * STG, wid, lane);
        if (P.needs(ti, wid)) {
            f32x16 p0, p1;
            qk_tile(cur, qf, r32, hi, p0, p1, negm[0], negm[0]);
            P.mask(ti, wid, r32, hi, p0, p1);
            if (pend) pv_sm_tile<DV, 1>(prv + 8192, lane, hi, pw, o, p0, p1, m, l, pwn, negm); else sm_alone<DV, 1>(p0, p1, o, m, l, pwn, negm);
#pragma unroll
            for (int k = 0; k < 4; ++k) pw[k] = pwn[k];
            pend = true;
        } else if (pend) { pv_tile<DV>(prv + 8192, lane, hi, pw, o); pend = false; }
        wait_bar_tiles2(min(ti + LA, nt - 1) - (ti + 1));
        ic = (ic + 1) & (NS - 1);
    }
    if (pend) pv_tile<DV>(lds + ((ic + NS - 1) & (NS - 1)) * STG + 8192, lane, hi, pw, o);
    P.finish(o, m, l, wid, r32, hi);
    ATT_WAIT_BAR(0);
}
constexpr int ZQ_Z = 65536, ZQ_Q = 98304;
__device__ __forceinline__ void glds4s(const void* sbase_, unsigned voff, unsigned lds_dst) { unsigned keep; const unsigned long long sbase = uni64(sbase_);
    asm volatile("s_mov_b32 %0, m0\n\ts_mov_b32 m0, %3\n\ts_nop 0\n\tglobal_load_lds_dword %1, %2\n\ts_mov_b32 m0, %0" : "=&s"(keep) : "v"(voff), "s"(sbase), "s"(lds_dst) : "memory"); }
__device__ __forceinline__ void dma_rows64(const bf16* base, int ld, LAS unsigned char* dst, int lane) {
    const unsigned vo = (unsigned)((lane & 31) * ld + (lane >> 5) * 8) * 2u;
    const unsigned b0 = (unsigned)(size_t)dst;
#pragma unroll
    for (int j = 0; j < 4; ++j) glds16s(base + j * 16, vo, (unsigned)__builtin_amdgcn_readfirstlane(b0 + j * 1024));
}
template <class Pol, int SKL  , class Ctx, class Gen>
__device__ __forceinline__ void run_stream1(LAS unsigned char* lds, const Ctx& C, const Gen& gen, int wid_, int lane_) {
    constexpr int DV = 64, STG = 16384, EX = Pol::EXTRA;
    static_assert(EX == 4 || EX == 5, "first-step wait counts");
    int lane = lane_, wid = wid_;
#define ZL_ (lds + ZQ_Z + wid * 4096)
#define QL_ (lds + ZQ_Q + wid * 4096)
    Pol P;
    if (!gen(0, P)) return;
    dma_rows64(P.qrow(C, wid), mk::DI, QL_, lane);
    dma_issue<DV, 1>(P.src(C), P.tile_row(0), lds, wid, lane);
    dma_issue<DV, 1>(P.src(C), P.tile_row(1), lds + STG, wid, lane);
    ATT_WAIT_BAR(0);
    int ic = 0;
    for (int i = 0;; ++i) {
        Pol Pn; const bool hn = gen(i + 1, Pn);
        asm volatile("" : "+v"(lane), "+s"(wid));
        bf16x8 qf[4];
#pragma unroll
        for (int d0 = 0; d0 < 4; ++d0) qf[d0] = *(LAS const bf16x8*)(QL_ + d0 * 1024 + lane * 16);
        asm volatile("" : "+v"(qf[0]), "+v"(qf[1]), "+v"(qf[2]), "+v"(qf[3]));
        const int nt = P.ntiles();
        f32x16 o[2] = {f32x16{}, f32x16{}};
        float m = -INFINITY, l = 0.f; f32x16 negm[Pol::NM];
#pragma unroll
        for (int i_ = 0; i_ < Pol::NM; ++i_) negm[i_] = f32x16{};
        u32x4 pw[4], pwn[4]; bool pend = false;
        auto steps = [&](auto skc, int t0, int t1) {
          constexpr int SK_ = decltype(skc)::value;
          for (int ti = t0; ti < t1; ++ti) {
            LAS unsigned char* cur = lds + ic * STG; LAS unsigned char* prv = lds + ((ic + 3) & 3) * STG; LAS unsigned char* nxt = lds + ((ic + 2) & 3) * STG;
            asm volatile("" : "+v"(lane), "+s"(wid)); const int r32 = lane & 31, hi = lane >> 5;
            if (ti == 0) { P.stage_extra(C, ZL_, wid, lane); if (hn) dma_rows64(Pn.qrow(C, wid), mk::DI, QL_, lane); }
            bool issued = true;
            if (ti + 2 < nt) dma_issue<DV, 1>(P.src(C), P.tile_row(ti + 2), nxt, wid, lane);
            else if (hn) dma_issue<DV, 1>(Pn.src(C), Pn.tile_row(ti + 2 - nt), nxt, wid, lane);
            else issued = false;
            P.prep(ti, wid, r32, hi, negm);
            if (P.needs(ti, wid)) {
                f32x16 p0, p1;
                qk_tile(cur, qf, r32, hi, p0, p1, negm[0], negm[Pol::NM - 1]);
                P.template mask<SK_>(C, ti, wid, r32, hi, p0, p1);
                if (pend) pv_sm_tile<DV, Pol::NM, SK_>(prv + 8192, lane, hi, pw, o, p0, p1, m, l, pwn, negm); else sm_alone<DV, Pol::NM, SK_>(p0, p1, o, m, l, pwn, negm);
#pragma unroll
                for (int k = 0; k < 4; ++k) pw[k] = pwn[k];
                pend = true;
            } else if (pend) { pv_tile<DV>(prv + 8192, lane, hi, pw, o); pend = false; }
            if (ti == 0) { if constexpr (EX == 4) { if (hn) ATT_WAIT_BAR(10); else ATT_WAIT_BAR(6); } else { if (hn) ATT_WAIT_BAR(11); else ATT_WAIT_BAR(7); } }
            else if (issued) ATT_WAIT_BAR(2); else ATT_WAIT_BAR(0);
            ic = (ic + 1) & 3;
          }
        };
        if constexpr (SKL == 0) steps(std::integral_constant<int, 0>{}, 0, nt);
        else { steps(std::integral_constant<int, 0>{}, 0, 4);
            steps(std::integral_constant<int, SKL>{}, 4, nt); }
        asm volatile("" : "+v"(lane), "+s"(wid)); const int r32 = lane & 31, hi = lane >> 5;
        if (pend) pv_tile<DV>(lds + ((ic + 3) & 3) * STG + 8192, lane, hi, pw, o);
        P.finish(C, o, m, l, wid, r32, hi, ZL_);
        if (!hn) break;
        P = Pn;
    }
    ATT_WAIT_BAR(0);
#undef ZL_
#undef QL_
}
}
namespace mk {
using att::Src; using att::crow; using att::ex2;

template <int DV>
__device__ __forceinline__ void store_gated(const f32x16 (&o)[DV / 32], float inv, const bf16* zrow, bf16* grow, int hi) {
#pragma unroll
    for (int d0 = 0; d0 < DV / 32; ++d0)
#pragma unroll
        for (int i = 0; i < 4; ++i) { const int d = 32 * d0 + 8 * i + 4 * hi;
            const u32x2 zw = *(const u32x2*)(zrow + d);
            const float v0 = o[d0][4 * i] * inv * silu(bflo(zw.x)), v1 = o[d0][4 * i + 1] * inv * silu(bfhi(zw.x)), v2 = o[d0][4 * i + 2] * inv * silu(bflo(zw.y)), v3 = o[d0][4 * i + 3] * inv * silu(bfhi(zw.y));
            u32x2 w; w.x = att::cvtpk(v0, v1); w.y = att::cvtpk(v2, v3); *(u32x2*)(grow + d) = w; }
}

__device__ __forceinline__ void store_gated_l(const f32x16 (&o)[2], float inv, LAS const unsigned char* zl, bf16* grow, int r32, int hi) {
#pragma unroll
    for (int d0 = 0; d0 < 2; ++d0)
#pragma unroll
        for (int i = 0; i < 4; ++i) { const int d = 32 * d0 + 8 * i + 4 * hi;
            const u32x2 zw = *(LAS const u32x2*)(zl + (2 * d0 + (i >> 1)) * 1024 + (r32 + 32 * (i & 1)) * 16 + 8 * hi);
            const float v0 = o[d0][4 * i] * inv * silu(bflo(zw.x)), v1 = o[d0][4 * i + 1] * inv * silu(bfhi(zw.x)), v2 = o[d0][4 * i + 2] * inv * silu(bflo(zw.y)), v3 = o[d0][4 * i + 3] * inv * silu(bfhi(zw.y));
            u32x2 w; w.x = att::cvtpk(v0, v1); w.y = att::cvtpk(v2, v3); *(u32x2*)(grow + d) = w; }
}

struct AttCtx { const bf16* QG; const bf16* Kb; const bf16* Vb; const bf16* Zb; const float* aux; LAS const float* tab; int dry; };
struct SwaPol {
    static constexpr int EXTRA = 4, NM = 1;
    int bl, hq, qb, tl0, ntl; float sinkl2;
    __device__ __forceinline__ size_t off() const { return ((size_t)bl * RB + CT + qb * 256) * DI + hq * 64; }
    __device__ __forceinline__ Src src(const AttCtx& C) const { Src s; s.K[0] = C.Kb + (hq >> 3) * 64; s.K[1] = nullptr; s.V = C.Vb + (hq >> 3) * 64; s.ldk = 256; s.ldv = 256; return s; }
    __device__ __forceinline__ void prep(int, int, int, int, f32x16 (&)[1]) const {}
    __device__ __forceinline__ int ntiles() const { return 4 + ntl; }
    __device__ __forceinline__ const bf16* qrow(const AttCtx& C, int wid) const { return C.QG + off() + (size_t)(wid * 32) * DI; }
    __device__ __forceinline__ void stage_extra(const AttCtx& C, LAS unsigned char* zl, int wid, int lane) const { att::dma_rows64(C.Zb + off() + (size_t)(wid * 32) * DI, DI, zl, lane); }
    __device__ __forceinline__ size_t tile_row(int ti) const { return (size_t)bl * RB + (ti < 4 ? 64 * ti : CT + 64 * (tl0 + ti - 4)); }
    __device__ __forceinline__ bool needs(int ti, int wid) const { if (ti < 4) return true; const int kt0 = 64 * (tl0 + ti - 4), qw0 = qb * 256 + 32 * wid; return kt0 <= qw0 + 31 + 128 && kt0 + 63 >= qw0 - 128; }
    __device__ __forceinline__ int skip(int, int) const { return 0; }
    template <int SK> __device__ __forceinline__ void mask(const AttCtx&, int ti, int wid, int r32, int hi, f32x16& p0, f32x16& p1) const {
        if (ti < 4) return;
        const int kt0 = 64 * (tl0 + ti - 4), qw0 = qb * 256 + 32 * wid;
        if (kt0 >= qw0 + 31 - 128 && kt0 + 63 <= qw0 + 128) return;
        const int qt = qw0 + r32;
#pragma unroll
        for (int r = 0; r < 16; ++r) { const int kt = kt0 + crow(r, hi); int d0 = kt - qt; d0 = d0 < 0 ? -d0 : d0; int d1 = kt + 32 - qt; d1 = d1 < 0 ? -d1 : d1;
            if (d0 > 128) p0[r] = -INFINITY; if (d1 > 128) p1[r] = -INFINITY; }
    }
    __device__ __forceinline__ void finish(const AttCtx& C, f32x16 (&o)[2], float m, float l, int wid, int r32, int hi, LAS const unsigned char* zl) const {
        const float mn = fmaxf(m, sinkl2), alpha = ex2(m - mn);
        const float lt = (l + __shfl_xor(l, 32)) * alpha + ex2(sinkl2 - mn);
        const float inv = alpha / lt;
        if (!C.dry) store_gated_l(o, inv, zl, (bf16*)C.QG + off() + (size_t)(wid * 32 + r32) * DI, r32, hi);
    }
};
__device__ __forceinline__ void swa_phase(Frame& F, const Args& a, int g, int dry) {
    int lane_ = pg8::hw_lane(), wave_ = F.wave; asm volatile("" : "+v"(lane_), "+s"(wave_));
    AttCtx C; C.QG = (const bf16*)(a.ws + WS_QG) + (size_t)g * MH * DI; C.Kb = (const bf16*)(a.ws + WS_S2); C.Vb = C.Kb + (size_t)MH * 256; C.Zb = (const bf16*)(a.ws + WS_S4); C.aux = a.in[30]; C.tab = nullptr; C.dry = dry;
    const int G = F.G, vcu = F.vcu;
    auto gen = [&](int i, SwaPol& P) -> bool {
        const int id = i * G + vcu; if (id >= HB * 32 * 8) return false;
        P.qb = (id + i) & 7; P.hq = (id >> 3) & 31; P.bl = id >> 8;
        P.tl0 = max(0, 4 * P.qb - 2); P.ntl = min(31, 4 * P.qb + 5) - P.tl0 + 1; P.sinkl2 = C.aux[P.hq] * LOG2E;
        return true; };
    att::run_stream1<SwaPol, 0>(F.lds, C, gen, wave_, lane_);
}

constexpr int NA_TAB_OFF = RING_BYTES + 512;
struct NaPol {
    static constexpr int EXTRA = 5, NM = 2;
    int bl, hq, qb, krow0, ntl, isctx;
    __device__ __forceinline__ size_t off() const { return ((size_t)bl * RB + (isctx ? 0 : CT + qb * 256)) * DI + hq * 64; }
    __device__ __forceinline__ Src src(const AttCtx& C) const { Src s; s.K[0] = C.Kb + hq * 64; s.K[1] = nullptr; s.V = C.Vb + hq * 64; s.ldk = DI; s.ldv = DI; return s; }
    __device__ __forceinline__ void prep(int ti, int wid, int r32, int hi, f32x16 (&negm)[2]) const {
        if (ti != 4) return;
        const int gc = 32 * (wid & 1) + r32, cs = min(max(gc - 8, 0), 48);
#pragma unroll
        for (int r = 0; r < 16; ++r) { const int kc = crow(r, hi);
            if (!(kc >= cs && kc < cs + 16)) negm[0][r] = -INFINITY;
            if (!(kc + 32 >= cs && kc + 32 < cs + 16)) negm[1][r] = -INFINITY; }
    }
    __device__ __forceinline__ int ntiles() const { return 4 + ntl; }
    __device__ __forceinline__ const bf16* qrow(const AttCtx& C, int wid) const { return C.QG + off() + (size_t)(wid * 32) * DI; }
    __device__ __forceinline__ void stage_extra(const AttCtx& C, LAS unsigned char* zl, int wid, int lane) const {
        att::dma_rows64(C.Zb + off() + (size_t)(wid * 32) * DI, DI, zl, lane);
        att::glds4s(C.aux + hq * 465, (unsigned)min(wid * 64 + lane, 464) * 4u, (unsigned)__builtin_amdgcn_readfirstlane((unsigned)(size_t)C.tab + wid * 256));
    }
    __device__ __forceinline__ size_t tile_row(int ti) const { return (size_t)bl * RB + (ti < 4 ? 64 * ti : CT + 64 * (krow0 + ti - 4)); }
    __device__ __forceinline__ bool needs(int ti, int wid) const { if (ti < 4) return true; const int gr = 4 * qb + (wid >> 1), rs = min(max(gr - 4, 0), 24), kr = krow0 + ti - 4; return kr >= rs && kr < rs + 8; }
    __device__ __forceinline__ int skip(int ti, int wid) const { return ti < 4 ? 0 : 1 + (wid & 1); }
    template <int SK> __device__ __forceinline__ void mask(const AttCtx& C, int ti, int wid, int r32, int hi, f32x16& p0, f32x16& p1) const {
        if (ti < 4) return;
        const int gr = 4 * qb + (wid >> 1), gc = 32 * (wid & 1) + r32, kr = krow0 + ti - 4;
        LAS const float* trow = C.tab + (kr - gr + 7) * 31 + 15 - gc;
#pragma unroll
        for (int r = 0; r < 16; ++r) { const int kc = crow(r, hi);
            if (att::sm_live0<SK>(r)) p0[r] = fmaf(trow[kc], LOG2E, p0[r]);
            if (att::sm_live1<SK>(r)) p1[r] = fmaf(trow[kc + 32], LOG2E, p1[r]);
            if ((r & 3) == 3) __builtin_amdgcn_sched_barrier(0); }
    }
    __device__ __forceinline__ void finish(const AttCtx& C, f32x16 (&o)[2], float m, float l, int wid, int r32, int hi, LAS const unsigned char* zl) const {
        const float inv = 1.f / (l + __shfl_xor(l, 32));
        if (!C.dry) store_gated_l(o, inv, zl, (bf16*)C.QG + off() + (size_t)(wid * 32 + r32) * DI, r32, hi);
    }
};
__device__ __forceinline__ void na_phase(Frame& F, const Args& a, int g, int dry) {
    int lane_ = pg8::hw_lane(), wave_ = F.wave; asm volatile("" : "+v"(lane_), "+s"(wave_));
    AttCtx C; C.QG = (const bf16*)(a.ws + WS_QG) + (size_t)g * MH * DI; C.Kb = (const bf16*)(a.ws + WS_S2); C.Vb = (const bf16*)(a.ws + WS_S3); C.Zb = (const bf16*)(a.ws + WS_S4); C.aux = a.in[27]; C.tab = (LAS const float*)(F.lds + NA_TAB_OFF); C.dry = dry;
    constexpr int NLAT = HB * 32 * 8, NCTX = HB * 32;
    const int G = F.G, vcu = F.vcu;
    auto gen = [&](int i, NaPol& P) -> bool {
        const int id = i * G + vcu; if (id >= NLAT + NCTX) return false;
        if (id < NLAT) { P.isctx = 0; P.qb = (id + i) & 7; P.hq = (id >> 3) & 31; P.bl = id >> 8; P.krow0 = min(max(4 * P.qb - 4, 0), 24); P.ntl = min(max(4 * P.qb + 3 - 4, 0), 24) + 7 - P.krow0 + 1; }
        else { const int j = id - NLAT; P.isctx = 1; P.qb = 0; P.hq = j & 31; P.bl = j >> 5; P.krow0 = 0; P.ntl = 0; }
        return true; };
    if (wave_ & 1) att::run_stream1<NaPol, 2>(F.lds, C, gen, wave_, lane_); else att::run_stream1<NaPol, 1>(F.lds, C, gen, wave_, lane_);
}

template <int COMP>
__device__ __forceinline__ void diff_unit(LAS unsigned char* lds, const Src& src, const bf16* Q  , const bf16* zb, bf16* gb, size_t trow0, int nt, float lam, float lam_init, const float* sg, int wid, int lane, int dry) {
    const int r32 = lane & 31, hi = lane >> 5, wq = wid & 3; constexpr int comp = COMP;
    constexpr int STG = 32768;
    att::dma_issue<128, 2>(src, trow0, lds, wid, lane);
    if (nt > 1) att::dma_issue<128, 2>(src, trow0 + 64, lds + STG, wid, lane);
    bf16x8 qf[4];
    { const bf16* qp = Q + (size_t)(wq * 32 + r32) * DI + comp * 64 + hi * 8;
#pragma unroll
      for (int d0 = 0; d0 < 4; ++d0) qf[d0] = *(const bf16x8*)(qp + d0 * 16); }
    f32x16 o[4];
#pragma unroll
    for (int d0 = 0; d0 < 4; ++d0) o[d0] = f32x16{};
    float m = -INFINITY, l = 0.f; f32x16 negm[1] = {f32x16{}};
    u32x4 pw[4], pwn[4];
    asm volatile("" : "+v"(qf[0]), "+v"(qf[1]), "+v"(qf[2]), "+v"(qf[3]));
    ATT_WAIT_BAR(0);
    if constexpr (COMP == 0) {
        int ic = 0;
        for (int ti = 0; ti < nt; ++ti) {
            LAS unsigned char* cur = lds + ic * STG; LAS unsigned char* prv = lds + ((ic + 3) & 3) * STG;
            if (ti >= 1 && ti + 1 < nt) att::dma_issue<128, 2>(src, trow0 + 64 * (ti + 1), lds + ((ic + 1) & 3) * STG, wid, lane);
            { f32x16 p0, p1; att::qk_tile(cur, qf, r32, hi, p0, p1, negm[0], negm[0]);
              if (ti > 0) att::pv_sm_tile<128, 1>(prv + 16384, lane, hi, pw, o, p0, p1, m, l, pwn, negm); else att::sm_alone<128, 1>(p0, p1, o, m, l, pwn, negm); }
#pragma unroll
            for (int k = 0; k < 4; ++k) pw[k] = pwn[k];
            ATT_WAIT_BAR(0);
            ic = (ic + 1) & 3;
        }
        att::pv_tile<128>(lds + ((ic + 3) & 3) * STG + 16384, lane, hi, pw, o);
    } else {
        f32x16 p0, p1;
        att::qk_tile(lds + 8192, qf, r32, hi, p0, p1, negm[0], negm[0]);
        ATT_WAIT_BAR(0);
        int ic = 1;
        for (int ti = 1; ti < nt; ++ti) {
            LAS unsigned char* cur = lds + ic * STG; LAS unsigned char* pv2 = lds + ((ic + 2) & 3) * STG;
            if (ti + 1 < nt) att::dma_issue<128, 2>(src, trow0 + 64 * (ti + 1), lds + ((ic + 1) & 3) * STG, wid, lane);
            if (ti >= 2) att::pv_sm_tile<128, 1>(pv2 + 16384, lane, hi, pw, o, p0, p1, m, l, pwn, negm); else att::sm_alone<128, 1>(p0, p1, o, m, l, pwn, negm);
#pragma unroll
            for (int k = 0; k < 4; ++k) pw[k] = pwn[k];
            att::qk_tile(cur + 8192, qf, r32, hi, p0, p1, negm[0], negm[0]);
            ATT_WAIT_BAR(0);
            ic = (ic + 1) & 3;
        }
        if (nt >= 2) att::pv_sm_tile<128, 1>(lds + ((ic + 2) & 3) * STG + 16384, lane, hi, pw, o, p0, p1, m, l, pwn, negm); else att::sm_alone<128, 1>(p0, p1, o, m, l, pwn, negm);
#pragma unroll
        for (int k = 0; k < 4; ++k) pw[k] = pwn[k];
        att::pv_tile<128>(lds + ((ic + 3) & 3) * STG + 16384, lane, hi, pw, o);
    }
    ATT_WAIT_BAR(0);
    const float inv = 1.f / (l + __shfl_xor(l, 32));
    LAS float* xb = (LAS float*)lds;
    if (comp == 1) {
#pragma unroll
        for (int d0 = 0; d0 < 4; ++d0)
#pragma unroll
            for (int r = 0; r < 16; ++r) xb[((wq * 64 + d0 * 16 + r) * 64) + lane] = o[d0][r] * inv;
    }
    __syncthreads();
    if (comp == 0 && !dry) {
        float ss = 0.f;
#pragma unroll
        for (int d0 = 0; d0 < 4; ++d0)
#pragma unroll
            for (int r = 0; r < 16; ++r) { const float v = o[d0][r] * inv - lam * xb[((wq * 64 + d0 * 16 + r) * 64) + lane]; o[d0][r] = v; ss += v * v; }
        ss += __shfl_xor(ss, 32);
        const float rs = rsqrtf(ss * (1.f / 128.f) + EPS) * (1.f - lam_init);
        const size_t ro = (size_t)(wq * 32 + r32) * DI;
#pragma unroll
        for (int d0 = 0; d0 < 4; ++d0)
#pragma unroll
            for (int i = 0; i < 4; ++i) { const int d = 32 * d0 + 8 * i + 4 * hi; const f32x4 gg = *(const f32x4*)(sg + d); const u32x2 zw = *(const u32x2*)(zb + ro + d);
                const float v0 = o[d0][4 * i] * rs * gg.x * silu(bflo(zw.x)), v1 = o[d0][4 * i + 1] * rs * gg.y * silu(bfhi(zw.x)), v2 = o[d0][4 * i + 2] * rs * gg.z * silu(bflo(zw.y)), v3 = o[d0][4 * i + 3] * rs * gg.w * silu(bfhi(zw.y));
                u32x2 w; w.x = att::cvtpk(v0, v1); w.y = att::cvtpk(v2, v3); *(u32x2*)(gb + ro + d) = w; }
    }
    asm volatile("s_waitcnt lgkmcnt(0)\n\ts_barrier" ::: "memory");
}
__device__ __forceinline__ void diff_phase(Frame& F, const Args& a, int g, int dry) {
#ifdef MK_TOUCH2
    {
        const int j = F.vcu & 31; unsigned accv = 0u;
        for (size_t off = ((size_t)j * NTHR + F.wave * 64 + pg8::hw_lane()) * 4096; off < (size_t)216 * MiB; off += (size_t)32 * NTHR * 4096) accv += *(const unsigned*)(a.ws + WS_S2 + off);
        for (size_t off = ((size_t)j * NTHR + F.wave * 64 + pg8::hw_lane()) * 4096; off < (size_t)72 * MiB; off += (size_t)32 * NTHR * 4096) accv += *(const unsigned*)(a.ws + WS_QG + (size_t)g * MH * DI * 2 + off);
        asm volatile("" :: "v"(accv));
    }
#endif
    int lane_ = pg8::hw_lane(), wave_ = F.wave; asm volatile("" : "+v"(lane_), "+s"(wave_));
    const bf16* QG = (const bf16*)(a.ws + WS_QG) + (size_t)g * MH * DI; const bf16* Kb = (const bf16*)(a.ws + WS_S2); const bf16* Vb = (const bf16*)(a.ws + WS_S3); const bf16* Zb = (const bf16*)(a.ws + WS_S4);
    const float lam_init = 0.8f - 0.6f * expf(-0.3f);
    float sa = 0.f, sb = 0.f;
    for (int i = 0; i < 64; ++i) { sa += a.in[20][i] * a.in[21][i]; sb += a.in[22][i] * a.in[23][i]; }
    const float lam = expf(sa) - expf(sb) + lam_init;
    constexpr int NLAT = HB * 16 * 16, NCTX = HB * 16 * 2;
    const int G = F.G, vcu = F.vcu; LAS unsigned char* lds = F.lds; const float* sg = a.in[24];
    auto units = [&](auto cc) {
        constexpr int COMP = decltype(cc)::value;
        for (int i = 0;; ++i) {
            const int id = i * G + vcu; if (id >= NLAT + NCTX) break;
            int bl, h, qb, nt; size_t row0;
            if (id < NLAT) { qb = id & 15; h = (id >> 4) & 15; bl = id >> 8; nt = RB / 64; row0 = (size_t)bl * RB + CT + qb * 128; }
            else { const int j = id - NLAT; qb = j & 1; h = (j >> 1) & 15; bl = j >> 5; nt = CT / 64; row0 = (size_t)bl * RB + qb * 128; }
            Src s; s.K[0] = Kb + (2 * h) * 64; s.K[1] = Kb + (2 * h + 1) * 64; s.V = Vb + h * 128; s.ldk = DI; s.ldv = DI;
            diff_unit<COMP>(lds, s, QG + row0 * DI + h * 128, Zb + row0 * DI + h * 128, (bf16*)QG + row0 * DI + h * 128, (size_t)bl * RB, nt, lam, lam_init, sg, wave_, lane_, dry);
        }
    };
    if (wave_ >> 2) units(std::integral_constant<int, 1>{}); else units(std::integral_constant<int, 0>{});
}
}
namespace mk {
typedef float f32x4v __attribute__((ext_vector_type(4)));
__device__ __forceinline__ void seq_bounds(int row, int& lo, int& hi) { const int rr = row % RB, b0 = row - rr; if (rr < CT) { lo = b0; hi = b0 + CT; } else { lo = b0 + CT; hi = b0 + RB; } }

#ifndef MK_GATES_Q
#define MK_GATES_Q 4
#endif
__device__ __forceinline__ void mlstm_gates_phase(Frame& F, const Args& a, int g) {
    int lane = pg8::hw_lane(), wave = F.wave; asm volatile("" : "+v"(lane), "+s"(wave));
    const bf16* XM = (const bf16*)(a.ws + WS_S2); const bf16* W2 = (const bf16*)(a.ws + WS_WG2);
    bf16* XC = g == 0 ? (bf16*)(a.ws + WS_QG) + (size_t)MH * DI : (bf16*)(a.ws + WS_H);
    const float* cw = a.in[9]; const float* cb = a.in[10]; const float* bg = a.in[15];
    LAS float* T = (LAS float*)F.lds;
    constexpr int G_W2S = 12288, G_XS = G_W2S + 64 * 1040;
    const int khw = (int)blockIdx.x & 3;
    { const int tid = wave * 64 + lane;
      for (int i = tid; i < 5 * 128; i += NTHR) { const int j = i >> 7, c4 = (i & 127) * 4; *(LAS f32x4v*)(T + j * 512 + c4) = *(const f32x4v*)(cw + j * 2048 + khw * 512 + c4); }
      for (int i = tid; i < 128; i += NTHR) *(LAS f32x4v*)(T + 2560 + 4 * i) = *(const f32x4v*)(cb + khw * 512 + 4 * i);
      for (int i = tid; i < 64 * 64; i += NTHR) { const int rw = i >> 6, c8 = (i & 63) * 8;
          *(LAS u32x4*)(F.lds + G_W2S + (rw * 520 + c8) * 2) = *(const u32x4*)(W2 + (size_t)(rw >> 1) * 4096 + (rw & 1) * 2048 + khw * 512 + c8); }
      __syncthreads(); }
    const int r = lane & 15, kq = lane >> 4;
    LAS unsigned char* xs = F.lds + G_XS + wave * 5440;
    const int kh = khw;
    float* gates = (float*)(a.ws + (kh == 0 ? WS_GATES : kh == 1 ? WS_GATES2 : kh == 2 ? WS_GATES3 : WS_GATES4));
    for (int grp = ((int)blockIdx.x >> 2) + 64 * wave; grp < MH / 16; grp += 64 * NWAVES) {
        const int row0 = grp * 16, row = row0 + r; int lo, hi; seq_bounds(row0, lo, hi);
        pg8::f32x4 acc0 = {0.f, 0.f, 0.f, 0.f}, acc1 = {0.f, 0.f, 0.f, 0.f};
        u32x4 xg[5];
#define ML_GLOAD(sb_) do { _Pragma("unroll") for (int j = 0; j < 5; ++j) { const int sr = row0 - 2 + 4 * j + (lane >> 4); \
            xg[j] = (sr >= lo && sr < hi) ? *(const u32x4*)(XM + (size_t)sr * DI + kh * 512 + (sb_) * 128 + (lane & 15) * 8) : (u32x4){0u, 0u, 0u, 0u}; } } while (0)
        ML_GLOAD(0);
        for (int sb = 0; sb < 4; ++sb) {
#pragma unroll
            for (int j = 0; j < 5; ++j) *(LAS u32x4*)(xs + (4 * j + (lane >> 4)) * 272 + (lane & 15) * 16) = xg[j];
            if (sb + 1 < 4) ML_GLOAD(sb + 1);
#pragma unroll
            for (int q = 0; q < 4; ++q) { const int cl = sb * 128 + q * 32 + 8 * kq, c0 = kh * 512 + cl;
                LAS const unsigned char* wl = F.lds + G_W2S + cl * 2; LAS const unsigned char* xl = xs + r * 272 + (q * 32 + 8 * kq) * 2;
                const bf16x8 wf0 = *(LAS const bf16x8*)(wl + (2 * r) * 1040), wf1 = *(LAS const bf16x8*)(wl + (2 * (r + 16)) * 1040), wf2 = *(LAS const bf16x8*)(wl + (2 * r + 1) * 1040), wf3 = *(LAS const bf16x8*)(wl + (2 * (r + 16) + 1) * 1040);
                const f32x4v b0 = *(LAS const f32x4v*)(T + 2560 + cl), b1 = *(LAS const f32x4v*)(T + 2560 + cl + 4);
                float av[8] = {b0.x, b0.y, b0.z, b0.w, b1.x, b1.y, b1.z, b1.w};
                u32x4 xmid;
#pragma unroll
                for (int j = 0; j < 5; ++j) { const u32x4 x = *(LAS const u32x4*)(xl + j * 272); if (j == 2) xmid = x;
                    const f32x4v w0 = *(LAS const f32x4v*)(T + j * 512 + cl), w1 = *(LAS const f32x4v*)(T + j * 512 + cl + 4);
                    av[0] += bflo(x.x) * w0.x; av[1] += bfhi(x.x) * w0.y; av[2] += bflo(x.y) * w0.z; av[3] += bfhi(x.y) * w0.w;
                    av[4] += bflo(x.z) * w1.x; av[5] += bfhi(x.z) * w1.y; av[6] += bflo(x.w) * w1.z; av[7] += bfhi(x.w) * w1.w; }
                u32x4 xcw; xcw.x = att::cvtpk(silu(av[0]), silu(av[1])); xcw.y = att::cvtpk(silu(av[2]), silu(av[3])); xcw.z = att::cvtpk(silu(av[4]), silu(av[5])); xcw.w = att::cvtpk(silu(av[6]), silu(av[7]));
                *(u32x4*)(XC + (size_t)row * DI + c0) = xcw;
                const bf16x8 axc = __builtin_bit_cast(bf16x8, xcw), axm = __builtin_bit_cast(bf16x8, xmid);
                acc0 = __builtin_amdgcn_mfma_f32_16x16x32_bf16(axc, wf0, acc0, 0, 0, 0); acc1 = __builtin_amdgcn_mfma_f32_16x16x32_bf16(axc, wf1, acc1, 0, 0, 0);
                acc0 = __builtin_amdgcn_mfma_f32_16x16x32_bf16(axm, wf2, acc0, 0, 0, 0); acc1 = __builtin_amdgcn_mfma_f32_16x16x32_bf16(axm, wf3, acc1, 0, 0, 0); }
            asm volatile("s_waitcnt lgkmcnt(0)" ::: "memory");
        }
#undef ML_GLOAD
        const float bg0 = kh == 0 ? bg[r] : 0.f, bg1 = kh == 0 ? bg[16 + r] : 0.f;
#pragma unroll
        for (int rg = 0; rg < 4; ++rg) { const size_t tk = (size_t)grp * 16 + 4 * kq + rg; gates[tk * 32 + r] = acc0[rg] + bg0; gates[tk * 32 + 16 + r] = acc1[rg] + bg1; }
    }
    __syncthreads();
}

#define ML_BAR() asm volatile("s_waitcnt lgkmcnt(0)\n\ts_barrier" ::: "memory")
#ifndef MK_SC_A
#define MK_SC_A 1
#endif
#ifndef MK_SC_B
#define MK_SC_B 1
#endif
constexpr int ML_QS = 0, ML_KS = 33792, ML_VS = 67584, ML_P = 84992, ML_HO = 94208, ML_F = 110592;
constexpr int ML_W1 = RING_BYTES + 512  , ML_WV = 115200  ;
constexpr int ML_KSTR = 528, ML_VSTR = 272, ML_PSTR = 144;
__device__ __forceinline__ int ml_row(int base, int dir, int s) { return base + (dir == 0 ? s : (s < CT ? CT - 1 - s : CT + (S - 1) - (s - CT))); }
__device__ __forceinline__ s16x4 ml_tr(LAS const unsigned char* p) { return __builtin_bit_cast(s16x4, __builtin_amdgcn_ds_read_tr16_b64_v4i16((LAS att::v4i16_t*)p)); }
__device__ __forceinline__ void mlstm_scan_phase(Frame& F, const Args& a, int g) {
    int tid0 = F.wave * 64 + pg8::hw_lane(); asm volatile("" : "+v"(tid0));
    const int wid = __builtin_amdgcn_readfirstlane(tid0 >> 6);
    const int u = F.vcu; if (u >= HB * 8 * 2 * 2) return;
    const int dvh = u & 1, dir = (u >> 1) & 1, h = (u >> 2) & 7, bl = u >> 5;
    const bf16* XM = (const bf16*)(a.ws + WS_S2); const float* gates = (const float*)(a.ws + WS_GATES); const float* gates2 = (const float*)(a.ws + WS_GATES2); const float* gates3 = (const float*)(a.ws + WS_GATES3); const float* gates4 = (const float*)(a.ws + WS_GATES4);
    const bf16* XC = g == 0 ? (const bf16*)(a.ws + WS_QG) + (size_t)MH * DI : (const bf16*)(a.ws + WS_H);
    bf16* Hd = dir == 0 ? (bf16*)(a.ws + WS_QG) + (size_t)g * MH * DI : (bf16*)(a.ws + WS_S4);
    const float* cw = a.in[9]; const float* cb = a.in[10]; const float* wq = a.in[11]; const float* wk = a.in[12]; const float* wv = a.in[13];
    LAS unsigned char* L = F.lds; LAS float* Ff = (LAS float*)(L + ML_F);
    pg8::f32x4 C[16];
#pragma unroll
    for (int i = 0; i < 16; ++i) C[i] = (pg8::f32x4){0.f, 0.f, 0.f, 0.f};
    int tid = tid0;
    if (tid < 256) { Ff[640 + tid] = 0.f; }
    {
        LAS float* W1 = (LAS float*)(L + ML_W1); LAS float* WV = (LAS float*)(L + ML_WV);
        for (int i = tid; i < 5 * 256; i += NTHR) W1[i] = cw[(i >> 8) * DI + h * 256 + (i & 255)];
        if (tid < 256) W1[1280 + tid] = cb[h * 256 + tid];
        for (int i = tid; i < 1024; i += NTHR) { W1[1536 + i] = wq[h * 1024 + i]; W1[2560 + i] = wk[h * 1024 + i]; WV[i] = wv[h * 1024 + i]; }
        __syncthreads();
    }
    LAS const float* W1 = (LAS const float*)(L + ML_W1); LAS const float* WV = (LAS const float*)(L + ML_WV);
    bf16x8 aq[2], ak[2], av_[2], aql[2], akl[2], avl[2];
    { const int o = tid0 & 15, g4 = (tid0 >> 4) & 3;
#pragma unroll
      for (int n = 0; n < 2; ++n) { const int bo = 4 * n + (o >> 2); u32x4 fq, fk, fv, lq, lk, lv; unsigned* pq = (unsigned*)&fq; unsigned* pk_ = (unsigned*)&fk; unsigned* pv_ = (unsigned*)&fv; unsigned* qq_ = (unsigned*)&lq; unsigned* qk_ = (unsigned*)&lk; unsigned* qv_ = (unsigned*)&lv;
#pragma unroll
          for (int jp = 0; jp < 4; ++jp) { float q2[2], k2[2], v2[2], q2l[2], k2l[2], v2l[2];
#pragma unroll
              for (int e = 0; e < 2; ++e) { const int j = 2 * jp + e, bi = 2 * g4 + (j >> 2); const bool nz = bi == bo; const int gb = wid * 8 + bo, idx = gb * 16 + (j & 3) * 4 + (o & 3);
                  q2[e] = nz ? W1[1536 + idx] : 0.f; k2[e] = nz ? W1[2560 + idx] * 0.0625f : 0.f; v2[e] = nz ? WV[idx] : 0.f;
                  q2l[e] = q2[e] - bf2f((unsigned short)f2bf(q2[e])); k2l[e] = k2[e] - bf2f((unsigned short)f2bf(k2[e])); v2l[e] = v2[e] - bf2f((unsigned short)f2bf(v2[e])); }
              pq[jp] = pk2(q2[0], q2[1]); pk_[jp] = pk2(k2[0], k2[1]); pv_[jp] = pk2(v2[0], v2[1]);
              qq_[jp] = pk2(q2l[0], q2l[1]); qk_[jp] = pk2(k2l[0], k2l[1]); qv_[jp] = pk2(v2l[0], v2l[1]); }
          aq[n] = __builtin_bit_cast(bf16x8, fq); ak[n] = __builtin_bit_cast(bf16x8, fk); av_[n] = __builtin_bit_cast(bf16x8, fv);
          aql[n] = __builtin_bit_cast(bf16x8, lq); akl[n] = __builtin_bit_cast(bf16x8, lk); avl[n] = __builtin_bit_cast(bf16x8, lv); } }
    const int base = bl * RB;
    u32x4 xw[8];
#define ML_LOADX(cc) do { const int rlo_ = dir ? ml_row(base, 1, (cc) * 64 + 63) : ml_row(base, 0, (cc) * 64); \
        const size_t o_ = (size_t)(rlo_ + (tid0 & 15)) * DI + h * 256 + wid * 32 + ((tid0 >> 4) & 3) * 8; \
        _Pragma("unroll") for (int i_ = 0; i_ < 4; ++i_) { xw[i_] = *(const u32x4*)(XM + o_ + (size_t)(16 * i_) * DI); xw[4 + i_] = *(const u32x4*)(XC + o_ + (size_t)(16 * i_) * DI); } } while (0)
    float gpre[8] = {0.f, 0.f, 0.f, 0.f, 0.f, 0.f, 0.f, 0.f};
#define ML_LOADG(cc) do { if (wid == 0) { const size_t gi_ = (size_t)ml_row(base, dir, (cc) * 64 + (tid0 & 63)) * 32 + (2 * dir) * 8 + h; \
        gpre[0] = gates[gi_]; gpre[1] = gates2[gi_]; gpre[2] = gates3[gi_]; gpre[3] = gates4[gi_]; gpre[4] = gates[gi_ + 8]; gpre[5] = gates2[gi_ + 8]; gpre[6] = gates3[gi_ + 8]; gpre[7] = gates4[gi_ + 8]; } } while (0)
    ML_LOADX(0); ML_LOADG(0);
    for (int c = 0; c < RB / 64; ++c) {
        const int par = c & 1;
        tid = tid0; asm volatile("" : "+v"(tid));
        const int lane = tid & 63, l15 = lane & 15, gq = lane >> 4;
#pragma unroll 1
        for (int repA_ = 0; repA_ < MK_SC_A; ++repA_) {
        {
            const bool hasv = (wid >> 2) == dvh;
            const pg8::f32x4 z4 = {0.f, 0.f, 0.f, 0.f};
#pragma unroll
            for (int tt = 0; tt < 4; ++tt) {
                const bf16x8 bxm = __builtin_bit_cast(bf16x8, xw[tt]), bxc = __builtin_bit_cast(bf16x8, xw[4 + tt]);
                const int mrow = 16 * tt + l15, t = dir ? 63 - mrow : mrow;
#pragma unroll
                for (int n = 0; n < 2; ++n) {
                    const pg8::f32x4 dq = __builtin_amdgcn_mfma_f32_16x16x32_bf16(aq[n], bxc, __builtin_amdgcn_mfma_f32_16x16x32_bf16(aql[n], bxc, z4, 0, 0, 0), 0, 0, 0), dk = __builtin_amdgcn_mfma_f32_16x16x32_bf16(ak[n], bxc, __builtin_amdgcn_mfma_f32_16x16x32_bf16(akl[n], bxc, z4, 0, 0, 0), 0, 0, 0);
                    const int cl = wid * 32 + 16 * n + 4 * gq;
                    u32x2 w2; w2.x = att::cvtpk(dq[0], dq[1]); w2.y = att::cvtpk(dq[2], dq[3]); *(LAS u32x2*)(L + ML_QS + t * ML_KSTR + cl * 2) = w2;
                    w2.x = att::cvtpk(dk[0], dk[1]); w2.y = att::cvtpk(dk[2], dk[3]); *(LAS u32x2*)(L + ML_KS + t * ML_KSTR + cl * 2) = w2;
                    if (hasv) { const pg8::f32x4 dv = __builtin_amdgcn_mfma_f32_16x16x32_bf16(av_[n], bxm, __builtin_amdgcn_mfma_f32_16x16x32_bf16(avl[n], bxm, z4, 0, 0, 0), 0, 0, 0);
                        w2.x = att::cvtpk(dv[0], dv[1]); w2.y = att::cvtpk(dv[2], dv[3]); *(LAS u32x2*)(L + ML_VS + t * ML_VSTR + (cl & 127) * 2) = w2; }
                }
            }
        }
#if defined(MK_SC_G2)
        for (int repg_ = 0; repg_ < 2; ++repg_)
#endif
        if (wid == 0) {
            const float gi = (gpre[0] + gpre[1]) + (gpre[2] + gpre[3]), gf = (gpre[4] + gpre[5]) + (gpre[6] + gpre[7]);
            const float lf = fminf(gf, 0.f) - log1pf(__expf(-fabsf(gf)));
            float b = lf;
#pragma unroll
            for (int o = 1; o < 64; o <<= 1) { const float y = __shfl_up(b, o); if (lane >= o) b += y; }
            const float bend = __shfl(b, 63);
            Ff[lane] = b * LOG2E; Ff[64 + lane] = (gi - b) * LOG2E; Ff[128 + lane] = __expf(b); Ff[192 + lane] = __expf(bend - b + gi);
            if (lane == 0) Ff[576] = __expf(bend);
        }
        }
        ML_BAR();
#if defined(MK_SC_L2)
        if (c + 1 < RB / 64) { ML_LOADX(c + 1); ML_LOADG(c + 1); asm volatile("" : "+v"(xw[0]), "+v"(xw[1]), "+v"(xw[2]), "+v"(xw[3]), "+v"(xw[4]), "+v"(xw[5]), "+v"(xw[6]), "+v"(xw[7])); }
#endif
        if (c + 1 < RB / 64) { ML_LOADX(c + 1); ML_LOADG(c + 1); }
        for (int repB_ = 0; repB_ < MK_SC_B; ++repB_) {
        {
            const int si = wid >> 1;
            pg8::f32x4 st[2] = {{0.f, 0.f, 0.f, 0.f}, {0.f, 0.f, 0.f, 0.f}};
            LAS const unsigned char* kp = L + ML_KS + (16 * si + l15) * ML_KSTR + gq * 16;
            LAS const unsigned char* qp0 = L + ML_QS + (16 * (2 * (wid & 1)) + l15) * ML_KSTR + gq * 16;
#pragma unroll
            for (int ks = 0; ks < 8; ++ks) {
                const bf16x8 ka = *(LAS const bf16x8*)(kp + ks * 64);
                const bf16x8 q0 = *(LAS const bf16x8*)(qp0 + ks * 64), q1 = *(LAS const bf16x8*)(qp0 + 16 * ML_KSTR + ks * 64);
                st[0] = __builtin_amdgcn_mfma_f32_16x16x32_bf16(ka, q0, st[0], 0, 0, 0);
                st[1] = __builtin_amdgcn_mfma_f32_16x16x32_bf16(ka, q1, st[1], 0, 0, 0);
            }
            const f32x4v al = *(LAS const f32x4v*)(Ff + 64 + 16 * si + 4 * gq);
            const float alv[4] = {al.x, al.y, al.z, al.w};
#pragma unroll
            for (int e = 0; e < 2; ++e) {
                const int ti = 2 * (wid & 1) + e, t = 16 * ti + l15; const float bt = Ff[t];
                float pv[4], rsum = 0.f;
#pragma unroll
                for (int r = 0; r < 4; ++r) { const int s = 16 * si + 4 * gq + r; const float wgt = (s <= t) ? att::ex2(bt + alv[r]) : 0.f; pv[r] = st[e][r] * wgt; rsum += pv[r]; }
                u32x2 w2; w2.x = att::cvtpk(pv[0], pv[1]); w2.y = att::cvtpk(pv[2], pv[3]);
                *(LAS u32x2*)(L + ML_P + t * ML_PSTR + (16 * si + 4 * gq) * 2) = w2;
                rsum += __shfl_xor(rsum, 16); rsum += __shfl_xor(rsum, 32);
                if (gq == 0) Ff[320 + si * 64 + t] = rsum;
            }
        }
        {
            const int t = tid >> 3, part = tid & 7; LAS const float* np_ = Ff + 640 + par * 256 + part * 32; LAS const unsigned char* qrow = L + ML_QS + t * ML_KSTR + part * 64;
            float acc = 0.f;
#pragma unroll
            for (int i = 0; i < 4; ++i) { const u32x4 qw = *(LAS const u32x4*)(qrow + i * 16); const f32x4v n0 = *(LAS const f32x4v*)(np_ + i * 8), n1 = *(LAS const f32x4v*)(np_ + i * 8 + 4);
                acc += bflo(qw.x) * n0.x + bfhi(qw.x) * n0.y + bflo(qw.y) * n0.z + bfhi(qw.y) * n0.w + bflo(qw.z) * n1.x + bfhi(qw.z) * n1.y + bflo(qw.w) * n1.z + bfhi(qw.w) * n1.w; }
            acc += __shfl_xor(acc, 1); acc += __shfl_xor(acc, 2); acc += __shfl_xor(acc, 4);
            if (part == 0) Ff[256 + t] = acc * Ff[128 + t];
        }
        if (tid < 256) {
            float nn = Ff[576] * Ff[640 + par * 256 + tid];
#pragma unroll
            for (int s = 0; s < 64; s += 4) { const f32x4v w4 = *(LAS const f32x4v*)(Ff + 192 + s); LAS const unsigned char* kc = L + ML_KS + s * ML_KSTR + tid * 2;
                nn += (w4.x * bf2f(*(LAS const unsigned short*)kc) + w4.y * bf2f(*(LAS const unsigned short*)(kc + ML_KSTR))) + (w4.z * bf2f(*(LAS const unsigned short*)(kc + 2 * ML_KSTR)) + w4.w * bf2f(*(LAS const unsigned short*)(kc + 3 * ML_KSTR))); }
            Ff[640 + (par ^ 1) * 256 + tid] = nn;
        }
        }
        ML_BAR();
        {
            pg8::f32x4 y[4];
#if defined(MK_SC_SYNC)
            ML_BAR(); __syncthreads(); __syncthreads();
#endif
#if defined(MK_SC_QC2)
            for (int repq_ = 0; repq_ < 2; ++repq_)
#endif
            {
#pragma unroll
            for (int tt = 0; tt < 4; ++tt) y[tt] = (pg8::f32x4){0.f, 0.f, 0.f, 0.f};
            {
                u32x2 qa[2][4], qb[2][4];
#define ML_QRD(ks_, b_) do { _Pragma("unroll") for (int tt = 0; tt < 4; ++tt) { LAS const unsigned char* qp = L + ML_QS + (16 * tt + l15) * ML_KSTR + (32 * (ks_) + 4 * gq) * 2; qa[b_][tt] = *(LAS const u32x2*)qp; qb[b_][tt] = *(LAS const u32x2*)(qp + 32); } } while (0)
                ML_QRD(0, 0);
#pragma unroll
                for (int ks = 0; ks < 8; ++ks) {
                    if (ks + 1 < 8) ML_QRD(ks + 1, (ks + 1) & 1);
                    u32x4 cw4; cw4.x = att::cvtpk(C[2 * ks][0], C[2 * ks][1]); cw4.y = att::cvtpk(C[2 * ks][2], C[2 * ks][3]); cw4.z = att::cvtpk(C[2 * ks + 1][0], C[2 * ks + 1][1]); cw4.w = att::cvtpk(C[2 * ks + 1][2], C[2 * ks + 1][3]);
                    const bf16x8 cf = __builtin_bit_cast(bf16x8, cw4);
                    __builtin_amdgcn_sched_barrier(0);
#pragma unroll
                    for (int tt = 0; tt < 4; ++tt) { const u32x4 qq = {qa[ks & 1][tt].x, qa[ks & 1][tt].y, qb[ks & 1][tt].x, qb[ks & 1][tt].y};
                        y[tt] = __builtin_amdgcn_mfma_f32_16x16x32_bf16(__builtin_bit_cast(bf16x8, qq), cf, y[tt], 0, 0, 0); }
                    __builtin_amdgcn_sched_barrier(0);
                }
#undef ML_QRD
            }
            }
#pragma unroll
            for (int tt = 0; tt < 4; ++tt) { const f32x4v e4 = *(LAS const f32x4v*)(Ff + 128 + 16 * tt + 4 * gq); y[tt][0] *= e4.x; y[tt][1] *= e4.y; y[tt][2] *= e4.z; y[tt][3] *= e4.w; }
            bf16x8 vf[2];
            { LAS const unsigned char* vb = L + ML_VS + (8 * gq + (l15 >> 2)) * ML_VSTR + (16 * wid + 4 * (lane & 3)) * 2;
#pragma unroll
              for (int k2 = 0; k2 < 2; ++k2) { const s16x4 lo = ml_tr(vb + k2 * 32 * ML_VSTR), hi4 = ml_tr(vb + k2 * 32 * ML_VSTR + 4 * ML_VSTR); vf[k2] = (bf16x8){lo[0], lo[1], lo[2], lo[3], hi4[0], hi4[1], hi4[2], hi4[3]}; } }
#pragma unroll
            for (int k2 = 0; k2 < 2; ++k2)
#pragma unroll
                for (int tt = 0; tt < 4; ++tt) { const bf16x8 pa = *(LAS const bf16x8*)(L + ML_P + (16 * tt + l15) * ML_PSTR + (32 * k2 + 8 * gq) * 2);
                    y[tt] = __builtin_amdgcn_mfma_f32_16x16x32_bf16(pa, vf[k2], y[tt], 0, 0, 0); }
#pragma unroll
            for (int tt = 0; tt < 4; ++tt)
#pragma unroll
                for (int r = 0; r < 4; ++r) { const int t = 16 * tt + 4 * gq + r;
                    *(LAS unsigned short*)(L + ML_HO + t * 256 + (16 * wid + l15) * 2) = (unsigned short)f2bf(y[tt][r]); }
            const float ebend = Ff[576];
#pragma unroll
            for (int i = 0; i < 16; ++i) C[i] = C[i] * ebend;
            bf16x8 vw[2];
#pragma unroll
            for (int k2 = 0; k2 < 2; ++k2) { const f32x4v w0 = *(LAS const f32x4v*)(Ff + 192 + 32 * k2 + 8 * gq), w1 = *(LAS const f32x4v*)(Ff + 192 + 32 * k2 + 8 * gq + 4);
                const u32x4 vv = __builtin_bit_cast(u32x4, vf[k2]); u32x4 o;
                o.x = att::cvtpk(bflo(vv.x) * w0.x, bfhi(vv.x) * w0.y); o.y = att::cvtpk(bflo(vv.y) * w0.z, bfhi(vv.y) * w0.w); o.z = att::cvtpk(bflo(vv.z) * w1.x, bfhi(vv.z) * w1.y); o.w = att::cvtpk(bflo(vv.w) * w1.z, bfhi(vv.w) * w1.w);
                vw[k2] = __builtin_bit_cast(bf16x8, o); }
            LAS const unsigned char* kb = L + ML_KS + (8 * gq + (l15 >> 2)) * ML_KSTR + (4 * (lane & 3)) * 2;
            {
                s16x4 klo[2][2], khi[2][2];
#define ML_KRD(dt_, b_) do { _Pragma("unroll") for (int k2 = 0; k2 < 2; ++k2) { klo[b_][k2] = ml_tr(kb + k2 * 32 * ML_KSTR + (dt_) * 32); khi[b_][k2] = ml_tr(kb + k2 * 32 * ML_KSTR + 4 * ML_KSTR + (dt_) * 32); } } while (0)
                ML_KRD(0, 0);
#pragma unroll
                for (int dt = 0; dt < 16; ++dt) {
                    if (dt + 1 < 16) ML_KRD(dt + 1, (dt + 1) & 1);
                    __builtin_amdgcn_sched_barrier(0);
#pragma unroll
                    for (int k2 = 0; k2 < 2; ++k2) { const s16x4 lo = klo[dt & 1][k2], hi4 = khi[dt & 1][k2];
                        const bf16x8 ka = {lo[0], lo[1], lo[2], lo[3], hi4[0], hi4[1], hi4[2], hi4[3]};
                        C[dt] = __builtin_amdgcn_mfma_f32_16x16x32_bf16(ka, vw[k2], C[dt], 0, 0, 0); }
                    __builtin_amdgcn_sched_barrier(0);
                }
#undef ML_KRD
            }
        }
        ML_BAR();
#if defined(MK_SC_W2)
        for (int repw_ = 0; repw_ < 2; ++repw_)
#endif
#pragma unroll
        for (int it = 0; it < 2; ++it) { const int idx = tid + it * NTHR, t = idx >> 4, pc = idx & 15; const int row = ml_row(base, dir, c * 64 + t);
            const float den = Ff[256 + t] + (Ff[320 + t] + Ff[384 + t]) + (Ff[448 + t] + Ff[512 + t]);
            const float rd = 1.f / fmaxf(fabsf(den), 1.f);
            const u32x4 yv = *(LAS const u32x4*)(L + ML_HO + t * 256 + pc * 16); u32x4 hv;
            hv.x = att::cvtpk(bflo(yv.x) * rd, bfhi(yv.x) * rd); hv.y = att::cvtpk(bflo(yv.y) * rd, bfhi(yv.y) * rd); hv.z = att::cvtpk(bflo(yv.z) * rd, bfhi(yv.z) * rd); hv.w = att::cvtpk(bflo(yv.w) * rd, bfhi(yv.w) * rd);
            *(u32x4*)(Hd + (size_t)row * DI + h * 256 + dvh * 128 + pc * 8) = hv; }
    }
}

__device__ __forceinline__ void mlstm_out_phase(Frame& F, const Args& a, int g, int dry) {
    int lane = pg8::hw_lane(), wave = F.wave; asm volatile("" : "+v"(lane), "+s"(wave));
    const bf16* XC = g == 0 ? (const bf16*)(a.ws + WS_QG) + (size_t)MH * DI : (const bf16*)(a.ws + WS_H); const bf16* Z = (const bf16*)(a.ws + WS_S3); const bf16* HB2 = (const bf16*)(a.ws + WS_S4); bf16* HF = (bf16*)(a.ws + WS_QG) + (size_t)g * MH * DI;
    const float* ng = a.in[16]; const float* skip = a.in[17];
    const int gw = F.vcu * NWAVES + wave, NGW = F.G * NWAVES;
    for (int it0 = gw; it0 < MH * 8; it0 += 2 * NGW) {
        u32x2 hf[2], hb[2], xcw[2], zw[2]; f32x4v gg[2], sk[2]; size_t o[2];
#pragma unroll
        for (int u = 0; u < 2; ++u) { int it = it0 + u * NGW; if (it >= MH * 8) it = it0; const int row = it >> 3, h = it & 7, ch = h * 256 + lane * 4; o[u] = (size_t)row * DI + ch;
            hf[u] = *(const u32x2*)(HF + o[u]); hb[u] = *(const u32x2*)(HB2 + o[u]); xcw[u] = *(const u32x2*)(XC + o[u]); zw[u] = *(const u32x2*)(Z + o[u]);
            gg[u] = *(const f32x4v*)(ng + ch); sk[u] = *(const f32x4v*)(skip + ch); }
#pragma unroll
        for (int u = 0; u < 2; ++u) {
            const float hs[4] = {bflo(hf[u].x) + bflo(hb[u].x), bfhi(hf[u].x) + bfhi(hb[u].x), bflo(hf[u].y) + bflo(hb[u].y), bfhi(hf[u].y) + bfhi(hb[u].y)};
            const float mu = wave_sum((hs[0] + hs[1]) + (hs[2] + hs[3])) * (1.f / 256.f);
            const float d[4] = {hs[0] - mu, hs[1] - mu, hs[2] - mu, hs[3] - mu};
            const float rstd = rsqrtf(wave_sum((d[0] * d[0] + d[1] * d[1]) + (d[2] * d[2] + d[3] * d[3])) * (1.f / 256.f) + EPS);
            const float xcv[4] = {bflo(xcw[u].x), bfhi(xcw[u].x), bflo(xcw[u].y), bfhi(xcw[u].y)}, z[4] = {bflo(zw[u].x), bfhi(zw[u].x), bflo(zw[u].y), bfhi(zw[u].y)};
            const float ggv[4] = {gg[u].x, gg[u].y, gg[u].z, gg[u].w}, skv[4] = {sk[u].x, sk[u].y, sk[u].z, sk[u].w};
            float ov[4];
#pragma unroll
            for (int i = 0; i < 4; ++i) ov[i] = (d[i] * rstd * ggv[i] + skv[i] * xcv[i]) * silu(z[i]);
            u32x2 w; w.x = att::cvtpk(ov[0], ov[1]); w.y = att::cvtpk(ov[2], ov[3]); if (!dry && (u == 0 || it0 + NGW < MH * 8)) *(u32x2*)(HF + o[u]) = w;
        }
    }
}
}
namespace mk {
enum { P_PRO = 0, P_PRO2 = 1, P_NORM0 = 2, P_L0 = 3  , P_OUT0 = 11, P_NORM1 = 12, P_L1 = 13  , P_OUT1 = 17, P_NORM2 = 18, P_L2 = 19  , P_OUT2 = 23, P_NORM3 = 24, P_L3 = 25  , P_OUT3 = 29, P_FINAL = 30, P_END = 31 };

__global__ void __launch_bounds__(NTHR, 2) mega(Args a) {
    extern __shared__ __attribute__((aligned(16))) unsigned char lds_raw[];
    Frame F;
    F.lds = (LAS unsigned char*)lds_raw;
    F.wave = __builtin_amdgcn_readfirstlane((int)threadIdx.x >> 6); F.lane = pg8::hw_lane(); F.tid = F.wave * 64 + F.lane;
    F.G = gridDim.x; { const int bx = blockIdx.x; F.vcu = (F.G % 8 == 0) ? (bx % 8) * (F.G / 8) + bx / 8 : bx; }
    volatile LAS unsigned* MISC = (volatile LAS unsigned*)(F.lds + MISC_OFF);
    for (int u = F.tid; u < (LDS_BYTES - RING_BYTES) / 4; u += NTHR) ((LAS unsigned*)(F.lds + RING_BYTES))[u] = 0u;
    __syncthreads();
    XcdBarrier bar = xcd_barrier_post((unsigned*)(a.ws + WS_CTL) + CW_BAR, MISC + 8, (unsigned)F.wave);
    const int lo = a.ph_lo, hi = a.ph_hi;
#ifndef MK_REP_GEMM
#define MK_REP_GEMM 1
#endif
#ifndef MK_REP_ATT
#define MK_REP_ATT 1
#endif
#ifndef MK_REP_MISC
#define MK_REP_MISC 1
#endif
#ifndef MK_GEMM_ALIGN
#define MK_GEMM_ALIGN true
#endif
#ifndef MK_GEMM_SP2
#define MK_GEMM_SP2 true
#endif
#ifndef MK_REP_WC
#define MK_REP_WC 1
#endif
#ifndef MK_REP_SYNC
#define MK_REP_SYNC 0
#endif
#ifndef MK_REP_DIFF
#define MK_REP_DIFF MK_REP_ATT
#endif
#ifndef MK_REP_NA
#define MK_REP_NA MK_REP_ATT
#endif
#ifndef MK_REP_SWA
#define MK_REP_SWA MK_REP_ATT
#endif
#ifndef MK_REP_SCAN
#define MK_REP_SCAN 1
#endif
#ifndef MK_REP_GATES
#define MK_REP_GATES MK_REP_SCAN
#endif
#ifndef MK_SITES
#define MK_SITES 0xFFFFFFFFu
#endif
#define ON(b) (((MK_SITES) >> (b)) & 1u)
#ifdef MK_PARTIAL
#define IN(k) (lo <= (k) && (k) < hi)
#else
#define IN(k) true
#endif
#ifndef MK_REP_BAR
#define MK_REP_BAR 1
#endif
#ifdef MK_TP
    long long tp_acc = 0, tp_prev = wall_clock64(), tp_t0 = 0;
#define TP_PRE(k) tp_t0 = wall_clock64();
#define TP_POST(k) { long long n_ = wall_clock64(); if ((MK_TP_MASK >> (k)) & 1u) tp_acc += n_ - (MK_TP == 1 ? tp_t0 : tp_prev); tp_prev = n_; }
#else
#define TP_PRE(k)
#define TP_POST(k)
#endif
#define SEAM(k) do { if (IN(k) && IN((k) + 1)) { TP_PRE(k) for (int rb_ = 0; rb_ < MK_REP_BAR; ++rb_) xcd_barrier(bar); TP_POST(k) } } while (0)
    const int gw = F.vcu * NWAVES + F.wave, NGW = F.G * NWAVES;
#define WSB ([&]() { unsigned char* p_ = a.ws; asm volatile("" : "+s"(p_)); return p_; }())
#define xs (a.out)
#define ctxs ((float*)(WSB + WS_CTXS))
#define xsb ((bf16*)a.out)
#define ctxb ((bf16*)(WSB + WS_CTXS))
#define x3b ((bf16*)(WSB + WS_S3))
#define mod ((const float*)(WSB + WS_MOD))
#define WinA ((bf16*)(WSB + WS_WIN))
#define WoutA ((bf16*)(WSB + WS_WOUT))
#define WinB ((bf16*)(WSB + WS_W2))
#define WoutB ((bf16*)(WSB + WS_W2 + 16 * MiB))
#define H ((bf16*)(WSB + WS_H))
#define QG ((bf16*)(WSB + WS_QG))
#define ssq ((float*)(WSB + WS_SSQ))
#define shw ((const float*)(WSB + WS_SHW))
#define S2 ((bf16*)(WSB + WS_S2))
#define S3 ((bf16*)(WSB + WS_S3))
#define S4 ((bf16*)(WSB + WS_S4))
#define rope ((const float*)(WSB + WS_ROPE))
    const float QSC = 0.125f * LOG2E;

    if (ON(0) && IN(P_PRO)) prologue_phase(F, a);
    SEAM(P_PRO);
    if (ON(0) && IN(P_PRO2)) { prologue2_phase(F, a); for (int rw_ = 0; rw_ < MK_REP_WC; ++rw_) wconv(F, a.in[8], 4096, a.in[18], WinA, WoutA, gw, NGW); }
    SEAM(P_PRO2);
    if (ON(1) && IN(P_NORM0)) { for (int rep = 0; rep < MK_REP_MISC; ++rep) norm_phase(F, a.in[0], a.in[2], a.in[4], mod, H); }
    SEAM(P_NORM0);
#if MK_HAVE_L0
    for (int g = 0; g < 2; ++g) {
        if (ON(2) && IN(P_L0 + 4 * g)) {
            pg8::Gemm gm{H + (size_t)g * MH * D, WinA, MH, 4096, D}; pg8::StaticOrder So; So.init(MH, 4096, F.G, (int)blockIdx.x);
            EpiProj<false> E{S2, S3, S3, S3, DI, DI, DI, DI, 8, 16, 16, 0u, 1.f, rope, nullptr, nullptr, 0};
            for (int rep = 0; rep < MK_REP_GEMM; ++rep) { if (MK_REP_SYNC && rep) xcd_barrier(bar); pg8::gemm_phase<EpiProj<false>, pg8::StaticOrder, MK_GEMM_ALIGN, MK_GEMM_SP2>(F.lds, gm, So, E, F.wave); }
        }
        SEAM(P_L0 + 4 * g);
        if (ON(17) && IN(P_L0 + 4 * g + 1)) for (int rep = 0; rep < MK_REP_GATES; ++rep) mlstm_gates_phase(F, a, g);
        SEAM(P_L0 + 4 * g + 1);
        if (ON(18) && IN(P_L0 + 4 * g + 2)) for (int rep = 0; rep < MK_REP_SCAN; ++rep) mlstm_scan_phase(F, a, g);
        SEAM(P_L0 + 4 * g + 2);
        if (ON(19) && IN(P_L0 + 4 * g + 3)) for (int rep = 0; rep < MK_REP_MISC; ++rep) mlstm_out_phase(F, a, g, rep + 1 < MK_REP_MISC);
        SEAM(P_L0 + 4 * g + 3);
    }
#endif
    constexpr int RHEAD = 128 * 256;
    if (ON(3) && IN(P_OUT0)) {
        pg8::Gemm gm{QG, WoutA, MT, D, DI}; pg8::StaticOrder So; So.init(RHEAD, D, F.G, (int)blockIdx.x);
        for (int rep = 0; rep < MK_REP_GEMM; ++rep) { if (MK_REP_SYNC && rep) xcd_barrier(bar); EpiResidT<float, bf16> E{a.in[0], a.in[2], xsb, ctxb, mod, 1, rep + 1 < MK_REP_GEMM, nullptr, nullptr, nullptr, nullptr};
        pg8::gemm_phase<EpiResidT<float, bf16>, pg8::StaticOrder, MK_GEMM_ALIGN, MK_GEMM_SP2>(F.lds, gm, So, E, F.wave); }
    }
    SEAM(P_OUT0);
    if (ON(3) && IN(P_OUT0)) {
        if (blockIdx.x < 64) { pg8::Gemm gm{QG, WoutA, MT, D, DI}; OutTailOrder So; So.init(F.G, (int)blockIdx.x); EpiResidT<float, bf16> E{a.in[0], a.in[2], xsb, ctxb, mod, 1, 0, nullptr, nullptr, nullptr, nullptr};
            pg8::gemm_phase<EpiResidT<float, bf16>, OutTailOrder, MK_GEMM_ALIGN, MK_GEMM_SP2>(F.lds, gm, So, E, F.wave); }
        else { wconv(F, a.in[19], 8192, a.in[25], WinB, WoutB, ((int)blockIdx.x - 64) * NWAVES + F.wave, (F.G - 64) * NWAVES);
            if (ON(4)) norm_phase(F, xsb, ctxb, a.in[4] + 1024, mod + 17 * 3072, H, 0, RHEAD, 64); }
    }
    SEAM(P_OUT0);
    for (int g = 0; g < 2; ++g) {
        if (ON(5) && IN(P_L1 + 2 * g)) {
            if (g == 0 && ON(4)) norm_phase(F, xsb, ctxb, a.in[4] + 1024, mod + 17 * 3072, H, RHEAD, MT);
            pg8::Gemm gm{H + (size_t)g * MH * D, WinB, MH, 8192, D}; pg8::StaticOrder So; So.init(MH, 8192, F.G, (int)blockIdx.x);
            EpiProj<true, false> E{QG + (size_t)g * MH * DI, S2, S3, S4, DI, DI, DI, DI, 8, 16, 24, 3u, QSC, rope, ssq, shw, g * MH};
#ifdef MK_STAGGER
            if (blockIdx.x >= 128) { const long long t0_ = wall_clock64(); while (wall_clock64() - t0_ < MK_STAGGER) __builtin_amdgcn_s_sleep(8); }
#endif
            for (int rep = 0; rep < MK_REP_GEMM; ++rep) { if (MK_REP_SYNC && rep) xcd_barrier(bar); pg8::gemm_phase<EpiProj<true, false>, pg8::StaticOrder, MK_GEMM_ALIGN, MK_GEMM_SP2>(F.lds, gm, So, E, F.wave); }
        }
        SEAM(P_L1 + 2 * g);
        if (ON(6) && IN(P_L1 + 2 * g + 1)) for (int rep = 0; rep < MK_REP_DIFF; ++rep) { if (MK_REP_SYNC && rep) xcd_barrier(bar); diff_phase(F, a, g, rep + 1 < MK_REP_DIFF); }
        SEAM(P_L1 + 2 * g + 1);
    }
    if (ON(7) && IN(P_OUT1)) {
        pg8::Gemm gm{QG, WoutB, MT, D, DI}; pg8::StaticOrder So; So.init(RHEAD, D, F.G, (int)blockIdx.x);
        for (int rep = 0; rep < MK_REP_GEMM; ++rep) { if (MK_REP_SYNC && rep) xcd_barrier(bar); EpiResidT<bf16, bf16> E{xsb, ctxb, xsb, ctxb, mod + 17 * 3072, 1, rep + 1 < MK_REP_GEMM, nullptr, nullptr, nullptr, nullptr};
        pg8::gemm_phase<EpiResidT<bf16, bf16>, pg8::StaticOrder, MK_GEMM_ALIGN, MK_GEMM_SP2>(F.lds, gm, So, E, F.wave); }
    }
    SEAM(P_OUT1);
    if (ON(7) && IN(P_OUT1)) {
        if (blockIdx.x < 64) { pg8::Gemm gm{QG, WoutB, MT, D, DI}; OutTailOrder So; So.init(F.G, (int)blockIdx.x); EpiResidT<bf16, bf16> E{xsb, ctxb, xsb, ctxb, mod + 17 * 3072, 1, 0, nullptr, nullptr, nullptr, nullptr};
            pg8::gemm_phase<EpiResidT<bf16, bf16>, OutTailOrder, MK_GEMM_ALIGN, MK_GEMM_SP2>(F.lds, gm, So, E, F.wave); }
        else { wconv(F, a.in[26], 8192, a.in[28], WinA, WoutA, ((int)blockIdx.x - 64) * NWAVES + F.wave, (F.G - 64) * NWAVES);
            if (ON(8)) norm_phase(F, xsb, ctxb, a.in[4] + 2048, mod + 2 * 17 * 3072, H, 0, RHEAD, 64); }
    }
    SEAM(P_OUT1);
    for (int g = 0; g < 2; ++g) {
        if (ON(9) && IN(P_L2 + 2 * g)) {
            if (g == 0 && ON(8)) norm_phase(F, xsb, ctxb, a.in[4] + 2048, mod + 2 * 17 * 3072, H, RHEAD, MT);
            pg8::Gemm gm{H + (size_t)g * MH * D, WinA, MH, 8192, D}; pg8::StaticOrder So; So.init(MH, 8192, F.G, (int)blockIdx.x);
            EpiProj<false, false> E{QG + (size_t)g * MH * DI, S2, S3, S4, DI, DI, DI, DI, 8, 16, 24, 0u, QSC, rope, ssq, shw + 17 * 8192, g * MH};
#ifdef MK_STAGGER
            if (blockIdx.x >= 128) { const long long t0_ = wall_clock64(); while (wall_clock64() - t0_ < MK_STAGGER) __builtin_amdgcn_s_sleep(8); }
#endif
            for (int rep = 0; rep < MK_REP_GEMM; ++rep) { if (MK_REP_SYNC && rep) xcd_barrier(bar); pg8::gemm_phase<EpiProj<false, false>, pg8::StaticOrder, MK_GEMM_ALIGN, MK_GEMM_SP2>(F.lds, gm, So, E, F.wave); }
        }
        SEAM(P_L2 + 2 * g);
        if (ON(10) && IN(P_L2 + 2 * g + 1)) for (int rep = 0; rep < MK_REP_NA; ++rep) { if (MK_REP_SYNC && rep) xcd_barrier(bar); na_phase(F, a, g, rep + 1 < MK_REP_NA); }
        SEAM(P_L2 + 2 * g + 1);
    }
    if (ON(11) && IN(P_OUT2)) {
        pg8::Gemm gm{QG, WoutA, MT, D, DI}; pg8::StaticOrder So; So.init(RHEAD, D, F.G, (int)blockIdx.x);
        for (int rep = 0; rep < MK_REP_GEMM; ++rep) { if (MK_REP_SYNC && rep) xcd_barrier(bar); EpiResidT<bf16, bf16> E{xsb, ctxb, x3b, ctxb, mod + 2 * 17 * 3072, 1, rep + 1 < MK_REP_GEMM, nullptr, nullptr, nullptr, nullptr};
        pg8::gemm_phase<EpiResidT<bf16, bf16>, pg8::StaticOrder, MK_GEMM_ALIGN, MK_GEMM_SP2>(F.lds, gm, So, E, F.wave); }
    }
    SEAM(P_OUT2);
    if (ON(11) && IN(P_OUT2)) {
        if (blockIdx.x < 64) { pg8::Gemm gm{QG, WoutA, MT, D, DI}; OutTailOrder So; So.init(F.G, (int)blockIdx.x); EpiResidT<bf16, bf16> E{xsb, ctxb, x3b, ctxb, mod + 2 * 17 * 3072, 1, 0, nullptr, nullptr, nullptr, nullptr};
            pg8::gemm_phase<EpiResidT<bf16, bf16>, OutTailOrder, MK_GEMM_ALIGN, MK_GEMM_SP2>(F.lds, gm, So, E, F.wave); }
        else { wconv(F, a.in[29], 4608, a.in[31], WinB, WoutB, ((int)blockIdx.x - 64) * NWAVES + F.wave, (F.G - 64) * NWAVES);
            if (ON(12)) norm_phase(F, x3b, ctxb, a.in[4] + 3072, mod + 3 * 17 * 3072, H, 0, RHEAD, 64); }
    }
    SEAM(P_OUT2);
    for (int g = 0; g < 2; ++g) {
        if (ON(13) && IN(P_L3 + 2 * g)) {
            if (g == 0 && ON(12)) norm_phase(F, x3b, ctxb, a.in[4] + 3072, mod + 3 * 17 * 3072, H, RHEAD, MT);
            pg8::Gemm gm{H + (size_t)g * MH * D, WinB, MH, 4608, D}; L3Order So; So.init(F.G, (int)blockIdx.x);
            EpiProj<true, false> E{QG + (size_t)g * MH * DI, S2, S2 + (size_t)MH * 256, S4, DI, 256, 256, DI, 8, 9, 10, 3u, QSC, rope, ssq, shw + 2 * 17 * 8192, g * MH};
            for (int rep = 0; rep < MK_REP_GEMM; ++rep) { if (MK_REP_SYNC && rep) xcd_barrier(bar); pg8::gemm_phase<EpiProj<true, false>, L3Order, MK_GEMM_ALIGN, MK_GEMM_SP2>(F.lds, gm, So, E, F.wave); }
        }
        SEAM(P_L3 + 2 * g);
        if (ON(14) && IN(P_L3 + 2 * g + 1)) for (int rep = 0; rep < MK_REP_SWA; ++rep) { if (MK_REP_SYNC && rep) xcd_barrier(bar); swa_phase(F, a, g, rep + 1 < MK_REP_SWA); }
        SEAM(P_L3 + 2 * g + 1);
    }
    if (ON(15) && IN(P_OUT3)) {
        pg8::Gemm gm{QG, WoutB, MT, D, DI}; LatOnlyOrder So; So.init(F.G, (int)blockIdx.x);
        for (int rep = 0; rep < MK_REP_GEMM; ++rep) { if (MK_REP_SYNC && rep) xcd_barrier(bar); EpiResidT<bf16, float> E{x3b, ctxb, xs, ctxs, mod + 3 * 17 * 3072, 0, rep + 1 < MK_REP_GEMM, nullptr, nullptr, nullptr, nullptr};
        pg8::gemm_phase<EpiResidT<bf16, float>, LatOnlyOrder, MK_GEMM_ALIGN, MK_GEMM_SP2>(F.lds, gm, So, E, F.wave); }
    }
    SEAM(P_OUT3);
    if (ON(16) && IN(P_FINAL)) final_norm_phase(F, xs, a.in[7]);
#ifdef MK_TP
    {
        if (MK_TP == 2) TP_POST(P_FINAL)
        unsigned long long* tpw = (unsigned long long*)(a.ws + WS_CTL + 32768);
        if (F.wave == 0 && pg8::hw_lane() == 0) __hip_atomic_fetch_add(tpw, (unsigned long long)tp_acc, __ATOMIC_RELAXED, __HIP_MEMORY_SCOPE_AGENT);
        xcd_barrier(bar);
        const unsigned long long sum = __hip_atomic_load(tpw, __ATOMIC_RELAXED, __HIP_MEMORY_SCOPE_AGENT);
        const long long wait = (long long)(sum / 256) * MK_TP_K, ts = wall_clock64();
        while (wall_clock64() - ts < wait) __builtin_amdgcn_s_sleep(32);
    }
#endif
#undef IN
#undef SEAM
#undef WSB
#undef xs
#undef ctxs
#undef xsb
#undef ctxb
#undef x3b
#undef mod
#undef WinA
#undef WoutA
#undef WinB
#undef WoutB
#undef H
#undef QG
#undef ssq
#undef shw
#undef S2
#undef S3
#undef S4
#undef rope
}

inline void launch_mega(void* const* d_in, void* d_out, void* d_ws, int lo, int hi, hipStream_t stream) {
    static int inited = 0;
    if (!inited) { (void)hipFuncSetAttribute((const void*)mega, hipFuncAttributeMaxDynamicSharedMemorySize, LDS_BYTES); inited = 1; }
    (void)hipMemsetAsync((char*)d_ws + WS_CTL, 0, CTL_BYTES, stream);
    Args a{};
    for (int i = 0; i < 32; ++i) a.in[i] = (const float*)d_in[i];
    a.out = (float*)d_out; a.ws = (unsigned char*)d_ws; a.ph_lo = lo; a.ph_hi = hi;
    hipLaunchKernelGGL(mega, dim3(256), dim3(NTHR), LDS_BYTES, stream, a);
}
}
extern "C" void kernel_launch(void* const* d_in, const int* in_sizes, int n_in, void* d_out, int out_size, void* d_ws, size_t ws_size, hipStream_t stream) {
    mk::launch_mega(d_in, d_out, d_ws, mk::P_PRO, mk::P_END, stream);
}
```

```cpp
#include <hip/hip_runtime.h>
#include <cstdint>
#include <cstdio>
#include <cmath>
#define MK_HAVE_L0 1
namespace pg8 {
#define PG8_LAS __attribute__((address_space(3)))
typedef unsigned short bf16_t;
typedef short bf16x8 __attribute__((ext_vector_type(8)));
typedef float f32x4 __attribute__((ext_vector_type(4)));
typedef unsigned u32x4 __attribute__((ext_vector_type(4)));
__device__ __forceinline__ int hw_lane() { int l; asm volatile("v_mbcnt_lo_u32_b32 %0, -1, 0\n\tv_mbcnt_hi_u32_b32 %0, -1, %0" : "=v"(l)); return l; }
constexpr int BM = 256, BK = 64, HALF = 128, HTB = HALF * BK * 2  , STAGE_BYTES = 8 * HTB, NXCD = 8, WGM = 8;

__host__ __device__ __forceinline__ int lds_byte(int r, int c) { const int st = (r >> 4) * 2 + (c >> 5), rr = r & 15, cc = c & 31, ob = rr * 64 + cc * 2; return st * 1024 + (ob ^ (((ob >> 9) & 1) << 5)); }
__host__ __device__ __forceinline__ void stage_rc(int b, int& R, int& C) { const int st = b / 1024, sb = b % 1024, swz = sb ^ (((sb >> 9) & 1) << 5); R = (st >> 1) * 16 + swz / 64; C = (st & 1) * 32 + (swz % 64) / 2; }
__host__ __device__ __forceinline__ int perm32(int rho) { const int n = rho >> 4, i = rho & 15; return 8 * (i >> 2) + 4 * n + (i & 3); }

struct Unit { int pm, pn; };
struct Gemm { const bf16_t* A; const bf16_t* Bt; int M, N, K; };

struct StaticOrder {
    int nM, nN, nwg, G, c;
    __host__ __device__ void init(int M, int N, int G_, int c_) { nM = M / BM; nN = N / BM; nwg = nM * nN; G = G_; c = c_; }
    __host__ __device__ bool next(int i, Unit& u) const {
        const long L = (long)i * G + c; if (L >= nwg) return false;
        int wgid = (int)L; { const int q = nwg / NXCD, r = nwg % NXCD, xcd = wgid % NXCD, off = wgid / NXCD; wgid = (xcd < r ? xcd * (q + 1) : r * (q + 1) + (xcd - r) * q) + off; }
        const int nig = WGM * nN, gid = wgid / nig, fm = gid * WGM, gsz = (nM - fm) < WGM ? (nM - fm) : WGM;
        u.pm = fm + ((wgid % nig) % gsz); u.pn = (wgid % nig) / gsz; return true;
    }
    __device__ __forceinline__ void a_ready(const Unit&) const {}
    __device__ __forceinline__ void done(const Unit&) const {}
};

__device__ __forceinline__ unsigned cvt_pk_bf16(float lo, float hi) { unsigned r; asm volatile("v_cvt_pk_bf16_f32 %0, %1, %2" : "=v"(r) : "v"(lo), "v"(hi)); return r; }
typedef float f32x2 __attribute__((ext_vector_type(2)));
template <class Epi, class Sched, bool ALIGN_EPI = false, bool SP2 = false>
__device__ __forceinline__ void gemm_phase(PG8_LAS unsigned char* lds, const Gemm g, const Sched& S, const Epi& E, int wave_id) {
    int tid_ = wave_id * 64 + hw_lane(); asm volatile("" : "+v"(tid_));
    const int tid = tid_, wid = __builtin_amdgcn_readfirstlane(tid >> 6), lane = tid & 63, wr = wid >> 2, wc = wid & 3, fr = lane & 15, fq = lane >> 4;
    const int K = g.K, nt = K / BK;
    unsigned voffA[2], voffB[2];
#pragma unroll
    for (int i = 0; i < 2; ++i) { int R, C; stage_rc(tid * 16 + i * 8192, R, C); const int Rb = Epi::PERM ? ((R & ~31) + perm32(R & 31)) : R;
        voffA[i] = (unsigned)(R * K + C) * 2u; voffB[i] = (unsigned)(Rb * K + C) * 2u; }
    const size_t kstep = (size_t)(BK * 2);
    const size_t hstep = (size_t)HALF * K * 2;
    const size_t tstep = 2 * hstep;
    const unsigned ldsw = (unsigned)wid * 1024u;
    const int aoff = lds_byte(wr * 64 + fr, fq * 8), boff = lds_byte(wc * 32 + fr, fq * 8);
#define PG8_SA(b, h) (((b) * 2 + (h)) * HTB)
#define PG8_SB(b, h) ((4 + (b) * 2 + (h)) * HTB)
#define PG8_STAGE(bufoff, gbase, voff) do { _Pragma("unroll") for (int _i = 0; _i < 2; ++_i) \
        __builtin_amdgcn_global_load_lds((const unsigned*)((const char*)(gbase) + (voff)[_i]), (PG8_LAS unsigned*)(lds + (bufoff) + ldsw + _i * 8192), 16, 0, 0); } while (0)
#define PG8_LDA(dst, b, h) do { _Pragma("unroll") for (int m = 0; m < 4; ++m) _Pragma("unroll") for (int k = 0; k < 2; ++k) dst[m][k] = *(const PG8_LAS bf16x8*)(lds + PG8_SA(b, h) + aoff + m * 2048 + k * 1024); } while (0)
#define PG8_LDB(dst, b, h) do { _Pragma("unroll") for (int n = 0; n < 2; ++n) _Pragma("unroll") for (int k = 0; k < 2; ++k) dst[n][k] = *(const PG8_LAS bf16x8*)(lds + PG8_SB(b, h) + boff + n * 2048 + k * 1024); } while (0)
#define PG8_MMA(ai, bj, At, Bt) do { __builtin_amdgcn_s_setprio(1); _Pragma("unroll") for (int m = 0; m < 4; ++m) _Pragma("unroll") for (int n = 0; n < 2; ++n) _Pragma("unroll") for (int k = 0; k < 2; ++k) \
        acc[ai][bj][m][n] = __builtin_amdgcn_mfma_f32_16x16x32_bf16(Bt[n][k], At[m][k], acc[ai][bj][m][n], 0, 0, 0); __builtin_amdgcn_s_setprio(0); } while (0)
#define PG8_WAIT_V(n) asm volatile("s_waitcnt vmcnt(" #n ")" ::: "memory")
#define PG8_WAIT_L(n) asm volatile("s_waitcnt lgkmcnt(" #n ")" ::: "memory")
#define PG8_BAR __builtin_amdgcn_s_barrier()
#define PG8_SCHED __builtin_amdgcn_sched_barrier(0)
    Unit cur, nxt; int ui = 0;
    if (!S.next(0, cur)) return;
    f32x4 acc[2][2][4][2];
#pragma unroll
    for (int a = 0; a < 2; ++a)
#pragma unroll
        for (int b = 0; b < 2; ++b)
#pragma unroll
            for (int m = 0; m < 4; ++m)
#pragma unroll
                for (int n = 0; n < 2; ++n) acc[a][b][m][n] = (f32x4){0.f, 0.f, 0.f, 0.f};
    bf16x8 At[4][2], B0[2][2], B1[2][2];
    const char* cA = (const char*)g.A + (size_t)cur.pm * tstep; const char* cB = (const char*)g.Bt + (size_t)cur.pn * tstep;
    S.a_ready(cur);
    if constexpr (SP2) {
        PG8_STAGE(PG8_SB(0, 0), cB, voffB); PG8_STAGE(PG8_SB(0, 1), cB + hstep, voffB); PG8_STAGE(PG8_SA(0, 0), cA, voffA); PG8_STAGE(PG8_SA(0, 1), cA + hstep, voffA);
        if (wr == 1) PG8_BAR;
        PG8_WAIT_V(2); PG8_BAR;
        PG8_STAGE(PG8_SB(1, 0), cB + kstep, voffB); PG8_STAGE(PG8_SA(1, 0), cA + kstep, voffA); PG8_STAGE(PG8_SB(1, 1), cB + hstep + kstep, voffB);
        PG8_WAIT_V(6); PG8_BAR;
    } else {
        PG8_STAGE(PG8_SB(0, 0), cB, voffB); PG8_STAGE(PG8_SA(0, 0), cA, voffA); PG8_STAGE(PG8_SB(0, 1), cB + hstep, voffB); PG8_STAGE(PG8_SA(0, 1), cA + hstep, voffA);
        if (wr == 1) PG8_BAR;
        PG8_WAIT_V(4); PG8_BAR;
        PG8_STAGE(PG8_SB(1, 0), cB + kstep, voffB); PG8_STAGE(PG8_SA(1, 0), cA + kstep, voffA); PG8_STAGE(PG8_SB(1, 1), cB + hstep + kstep, voffB);
        PG8_WAIT_V(6); PG8_BAR;
    }
    for (;;) {
        const bool has_next = S.next(ui + 1, nxt);
        const char* nA = has_next ? (const char*)g.A + (size_t)nxt.pm * tstep : cA; const char* nB = has_next ? (const char*)g.Bt + (size_t)nxt.pn * tstep : cB;
        for (int t = 0; t < nt; t += 2) {
            const bool last = (t == nt - 2);
            const char* a1 = cA + (size_t)(t + 1) * kstep;
            const char* a2 = last ? nA : cA + (size_t)(t + 2) * kstep; const char* b2 = last ? nB : cB + (size_t)(t + 2) * kstep;
            const char* a3 = a2 + kstep; const char* b3 = b2 + kstep;
            if (last && has_next) S.a_ready(nxt);
            if constexpr (SP2) {
            PG8_LDB(B0, 0, 0); PG8_LDB(B1, 0, 1); PG8_SCHED; PG8_LDA(At, 0, 0); PG8_STAGE(PG8_SA(1, 1), a1 + hstep, voffA);
            PG8_WAIT_V(8); PG8_WAIT_L(0); PG8_BAR; PG8_MMA(0, 0, At, B0); PG8_MMA(0, 1, At, B1); PG8_BAR; PG8_SCHED;
            PG8_LDA(At, 0, 1); PG8_STAGE(PG8_SB(0, 0), b2, voffB); PG8_STAGE(PG8_SB(0, 1), b2 + hstep, voffB); PG8_STAGE(PG8_SA(0, 0), a2, voffA);
            PG8_WAIT_V(8); PG8_WAIT_L(0); PG8_BAR; PG8_MMA(1, 0, At, B0); PG8_MMA(1, 1, At, B1); PG8_BAR; PG8_SCHED;
            PG8_LDB(B0, 1, 0); PG8_LDB(B1, 1, 1); PG8_SCHED; PG8_LDA(At, 1, 0); PG8_STAGE(PG8_SA(0, 1), a2 + hstep, voffA);
            PG8_WAIT_V(8); PG8_WAIT_L(0); PG8_BAR; PG8_MMA(0, 0, At, B0); PG8_MMA(0, 1, At, B1); PG8_BAR; PG8_SCHED;
            PG8_LDA(At, 1, 1); PG8_STAGE(PG8_SB(1, 0), b3, voffB); PG8_STAGE(PG8_SB(1, 1), b3 + hstep, voffB); PG8_STAGE(PG8_SA(1, 0), a3, voffA);
            PG8_WAIT_V(8); PG8_WAIT_L(0); PG8_BAR; PG8_MMA(1, 0, At, B0); PG8_MMA(1, 1, At, B1); PG8_BAR; PG8_SCHED;
            } else {
            PG8_LDB(B0, 0, 0); PG8_SCHED; PG8_LDA(At, 0, 0); PG8_STAGE(PG8_SA(1, 1), a1 + hstep, voffA);
            PG8_WAIT_L(8); PG8_BAR; PG8_WAIT_L(0); PG8_MMA(0, 0, At, B0); PG8_BAR; PG8_SCHED;
            PG8_LDB(B1, 0, 1); PG8_STAGE(PG8_SB(0, 0), b2, voffB);
            PG8_BAR; PG8_WAIT_L(0); PG8_MMA(0, 1, At, B1); PG8_BAR;
            PG8_LDA(At, 0, 1); PG8_STAGE(PG8_SA(0, 0), a2, voffA);
            PG8_BAR; PG8_WAIT_L(0); PG8_MMA(1, 0, At, B0); PG8_BAR; PG8_SCHED;
            PG8_STAGE(PG8_SB(0, 1), b2 + hstep, voffB);
            PG8_WAIT_V(6); PG8_BAR; PG8_MMA(1, 1, At, B1); PG8_BAR;
            PG8_LDB(B0, 1, 0); PG8_SCHED; PG8_LDA(At, 1, 0); PG8_STAGE(PG8_SA(0, 1), a2 + hstep, voffA);
            PG8_WAIT_L(8); PG8_BAR; PG8_WAIT_L(0); PG8_MMA(0, 0, At, B0); PG8_BAR; PG8_SCHED;
            PG8_LDB(B1, 1, 1); PG8_STAGE(PG8_SB(1, 0), b3, voffB);
            PG8_BAR; PG8_WAIT_L(0); PG8_MMA(0, 1, At, B1); PG8_BAR;
            PG8_LDA(At, 1, 1); PG8_STAGE(PG8_SA(1, 0), a3, voffA);
            PG8_BAR; PG8_WAIT_L(0); PG8_MMA(1, 0, At, B0); PG8_BAR; PG8_SCHED;
            PG8_STAGE(PG8_SB(1, 1), b3 + hstep, voffB);
            PG8_WAIT_V(6); PG8_BAR; PG8_MMA(1, 1, At, B1); PG8_BAR;
            }
        }
        if constexpr (ALIGN_EPI) { if (wr == 0) PG8_BAR; }
#if defined(MK_EXP_EPI2)
        if constexpr (!Epi::AFTER_DRAIN && Epi::PERM) { E.template run<(MK_EXP_EPI2 == 2)>(acc, cur, wr, wc, fr, fq); }
#endif
        if constexpr (!Epi::AFTER_DRAIN) { E(acc, cur, wr, wc, fr, fq); S.done(cur); }
        if (!has_next) break;
#pragma unroll
        for (int a = 0; a < 2; ++a)
#pragma unroll
            for (int b = 0; b < 2; ++b)
#pragma unroll
                for (int m = 0; m < 4; ++m)
#pragma unroll
                    for (int n = 0; n < 2; ++n) acc[a][b][m][n] = (f32x4){0.f, 0.f, 0.f, 0.f};
        cur = nxt; cA = nA; cB = nB; ++ui;
        if constexpr (ALIGN_EPI) { if (wr == 1) PG8_BAR; }
    }
    PG8_WAIT_V(0);
    if constexpr (!ALIGN_EPI) { if (wr == 0) PG8_BAR; }
    PG8_BAR;
    if constexpr (Epi::AFTER_DRAIN) { E.fused(acc, cur, wr, wc, fr, fq, lds, wid, lane); S.done(cur); }
#undef PG8_SA
#undef PG8_SB
#undef PG8_STAGE
#undef PG8_LDA
#undef PG8_LDB
#undef PG8_MMA
#undef PG8_WAIT_V
#undef PG8_WAIT_L
#undef PG8_BAR
#undef PG8_SCHED
}
}
#define GAS __attribute__((address_space(1)))
#define LAS __attribute__((address_space(3)))
typedef unsigned short bf16;
typedef unsigned v4u __attribute__((ext_vector_type(4)));
typedef float f32x4 __attribute__((ext_vector_type(4)));
typedef short bf16x8 __attribute__((ext_vector_type(8)));
typedef GAS unsigned gu32;
typedef GAS unsigned long long gu64;
#define RLX_AGENT __ATOMIC_RELAXED, __HIP_MEMORY_SCOPE_AGENT
#define LDS_WAIT() asm volatile("s_waitcnt lgkmcnt(0)" ::: "memory")
#define VM_WAIT() asm volatile("s_waitcnt vmcnt(0)" ::: "memory")
__device__ __forceinline__ unsigned long long rt() { return __builtin_amdgcn_s_memrealtime(); }
__device__ __forceinline__ unsigned f2bf(float f) { unsigned u = __builtin_bit_cast(unsigned, f); return (u + 0x7fffu + ((u >> 16) & 1u)) >> 16; }
__device__ __forceinline__ unsigned pk2(float lo, float hi) { return f2bf(lo) | (f2bf(hi) << 16); }
#define XB_TMO      128
#define XB_XCNT(j)  (256  + 64 * (j))
#define XB_XSUB(j)  (1280 + 64 * (j))
#define XB_XGEN(j)  (2304 + 64 * (j))
#define XB_TOP      3328
#define XB_TOPGEN   3392
#define XCD_BAR_WORDS 3456
#define XB_SPIN_CAP (1u << 18)

__device__ __forceinline__ unsigned xb_ld(unsigned* p)              { return __hip_atomic_load(p, __ATOMIC_RELAXED, __HIP_MEMORY_SCOPE_AGENT); }
__device__ __forceinline__ unsigned xb_add(unsigned* p, unsigned v) { return __hip_atomic_fetch_add(p, v, __ATOMIC_RELAXED, __HIP_MEMORY_SCOPE_AGENT); }
__device__ __forceinline__ unsigned xb_xcc_id() { return (unsigned)__builtin_amdgcn_s_getreg((3 << 11) | 20) & 0xFu; }
#define XB_SPIN(cond, bar) do { unsigned _sp = 0; while (cond) { __builtin_amdgcn_s_sleep(1); \
    if ((++_sp & 255u) == 0u) { if (xb_ld(&(bar)[XB_TMO])) break; if (_sp > XB_SPIN_CAP) { atomicAdd(&(bar)[XB_TMO], 1u); break; } } } } while (0)

struct XcdBarrier {
    unsigned* bar; unsigned x; unsigned w;
    volatile LAS unsigned* st;
};

__device__ __forceinline__ XcdBarrier xcd_barrier_post(unsigned* bar, volatile LAS unsigned* st, unsigned wave) {
    XcdBarrier b; b.bar = bar; b.x = xb_xcc_id(); b.st = st; b.w = wave;
    if (b.w == 0u && pg8::hw_lane() == 0) (void)xb_add(&bar[XB_XCNT(b.x)], 1u);
    return b;
}
__device__ __forceinline__ void xcd_barrier_complete(unsigned* bar, unsigned x, unsigned& nloc, unsigned& nx) {
    const unsigned G = gridDim.x * gridDim.y * gridDim.z;
    unsigned sum, cnt, mine, sp = 0u;
    for (;;) {
        sum = 0u; cnt = 0u; mine = 0u;
#pragma unroll
        for (unsigned j = 0; j < 16; ++j) { const unsigned c = xb_ld(&bar[XB_XCNT(j)]); sum += c; cnt += (c > 0u) ? 1u : 0u; mine = (j == x) ? c : mine; }
        if (sum == G) break;
        __builtin_amdgcn_s_sleep(1);
        if ((++sp & 255u) == 0u) { if (xb_ld(&bar[XB_TMO])) break; if (sp > XB_SPIN_CAP) { atomicAdd(&bar[XB_TMO], 1u); break; } }
    }
    nloc = mine > 0u ? mine : 1u; nx = cnt > 0u ? cnt : 1u;
}

__device__ __forceinline__ void xcd_barrier(const XcdBarrier& b) {
    asm volatile("s_waitcnt vmcnt(0)" ::: "memory");
    __syncthreads();
    if (b.w == 0u && pg8::hw_lane() == 0) {
        unsigned* bar = b.bar;
        __builtin_amdgcn_s_waitcnt(0);
        unsigned nloc = b.st[0], nx = b.st[1];
        if (nloc == 0u) { xcd_barrier_complete(bar, b.x, nloc, nx); b.st[0] = nloc; b.st[1] = nx; }
        const unsigned old = xb_add(&bar[XB_XSUB(b.x)], 1u);
        const unsigned gen = old / nloc;
        if (old + 1u == (gen + 1u) * nloc) {
            __builtin_amdgcn_fence(__ATOMIC_RELEASE, "agent");
            asm volatile("s_waitcnt vmcnt(0)" ::: "memory");
            const unsigned og = xb_add(&bar[XB_TOP], 1u);
            const unsigned tg = og / nx;
            if (og + 1u == (tg + 1u) * nx) xb_add(&bar[XB_TOPGEN], 1u);
            else XB_SPIN(xb_ld(&bar[XB_TOPGEN]) == tg, bar);
            __builtin_amdgcn_fence(__ATOMIC_ACQUIRE, "agent");
            xb_add(&bar[XB_XGEN(b.x)], 1u);
            asm volatile("s_waitcnt vmcnt(0)" ::: "memory");
        } else {
            XB_SPIN(xb_ld(&bar[XB_XGEN(b.x)]) == gen, bar);
            __builtin_amdgcn_fence(__ATOMIC_ACQUIRE, "agent");
            asm volatile("s_waitcnt vmcnt(0)" ::: "memory");
        }
    }
    __syncthreads();
}
namespace mk {
constexpr int NWAVES = 8, NTHR = 512;
constexpr int NB = 16, S = 2048, D = 1024, CT = 256, RB = S + CT  , MT = NB * RB, HB = 8  , MH = HB * RB, DI = 2048;
constexpr float EPS = 1e-6f, LOG2E = 1.4426950408889634f;
constexpr size_t MiB = 1u << 20;
constexpr size_t WS_CTXS = 0, WS_MOD = 16 * MiB, WS_CTL = 17 * MiB, CTL_BYTES = 64 * 1024;
constexpr size_t WS_ROPE = 18 * MiB, WS_WG2 = 18 * MiB + 64 * 1024, WS_GATES = 19 * MiB;
constexpr size_t WS_WIN = 22 * MiB, WS_WOUT = 38 * MiB, WS_H = 42 * MiB, WS_QG = 114 * MiB, WS_S2 = 258 * MiB, WS_S3 = 330 * MiB, WS_S4 = 402 * MiB, WS_END = 474 * MiB, WS_GATES2 = 474 * MiB  ,
    WS_SSQ = 477 * MiB  , WS_W2 = 480 * MiB  , WS_SHW = 500 * MiB  , WS_GATES3 = 503 * MiB, WS_GATES4 = 506 * MiB  ;
constexpr int CW_BAR = 1024;
constexpr int RING_BYTES = 131072, MISC_OFF = RING_BYTES + 320, LDS_BYTES = 147456;

typedef unsigned short bf16;
typedef float f32x4 __attribute__((ext_vector_type(4)));
typedef float f32x16 __attribute__((ext_vector_type(16)));
typedef short bf16x8 __attribute__((ext_vector_type(8)));
typedef short s16x4 __attribute__((ext_vector_type(4)));
typedef unsigned u32x4 __attribute__((ext_vector_type(4)));
typedef unsigned u32x2 __attribute__((ext_vector_type(2)));

__device__ __forceinline__ float silu(float x) { return x / (1.f + __expf(-x)); }
__device__ __forceinline__ float bf2f(unsigned short b) { return __uint_as_float((unsigned)b << 16); }
__device__ __forceinline__ float bflo(unsigned w) { return __uint_as_float(w << 16); }
__device__ __forceinline__ float bfhi(unsigned w) { return __uint_as_float(w & 0xffff0000u); }
__device__ __forceinline__ float wave_sum(float v) {
#pragma unroll
    for (int o = 1; o < 64; o <<= 1) v += __shfl_xor(v, o);
    return v;
}

struct Frame {
    LAS unsigned char* lds;
    int tid, lane, wave, vcu, G;
    void* const* dummy;
};
__device__ __forceinline__ Frame fresh(const Frame& F0) { Frame F = F0; const int l = pg8::hw_lane(); F.lane = l; F.tid = F0.wave * 64 + l; return F; }
struct Args { const float* in[32]; float* out; unsigned char* ws; int ph_lo, ph_hi; };

template <bool ROPE, bool AFFINE = false> struct EpiProj {
    static constexpr bool PERM = true, AFTER_DRAIN = false;
    bf16 *d0, *d1, *d2, *d3; int l0, l1, l2, l3; int t1, t2, t3; unsigned ropemask; float sc0; const float* rope;
    const float* ssq; const float* shw; int row_base;
    __device__ __forceinline__ void operator()(const pg8::f32x4 (&acc)[2][2][4][2], const pg8::Unit& u, int wr, int wc, int fr, int fq) const { run<false>(acc, u, wr, wc, fr, fq); }
    template <bool NOSTORE> __device__ __forceinline__ void run(const pg8::f32x4 (&acc)[2][2][4][2], const pg8::Unit& u, int wr, int wc, int fr, int fq) const {
        asm volatile("" : "+v"(fr), "+v"(fq));
        const int pn = u.pn;
        long long off = 0; int ld = l0, tb = 0, s = 0;
        if (pn >= t1) { off += (long long)(d1 - d0); ld += l1 - l0; tb = t1; s = 1; }
        if (pn >= t2) { off += (long long)(d2 - d1); ld += l2 - l1; tb = t2; s = 2; }
        if (pn >= t3) { off += (long long)(d3 - d2); ld += l3 - l2; tb = t3; s = 3; }
        bf16* base = d0 + off;
        const float sc = (pn >= t1) ? 1.f : sc0;
        const int rr0 = (u.pm * 256) % RB;
        const bool do_rope = ROPE && ((ropemask >> s) & 1u) && rr0 != 0;
        const int col0 = (pn - tb) * 256 + wc * 32 + 8 * fq;
        const int rloc = wr * 64 + fr;
        pg8::f32x4 sw[2][2];
        if (AFFINE) { const int gr0 = row_base + u.pm * 256; const float* sp = shw + (size_t)(rr0 == 0 ? 16 : gr0 / RB) * 8192 + pn * 256 + wc * 32 + 8 * fq;
#pragma unroll
            for (int bj = 0; bj < 2; ++bj) { sw[bj][0] = *(const pg8::f32x4*)(sp + bj * 128); sw[bj][1] = *(const pg8::f32x4*)(sp + bj * 128 + 4); } }
#pragma unroll
        for (int ai = 0; ai < 2; ++ai)
#pragma unroll
            for (int m = 0; m < 4; ++m) {
                const int rt = rloc + ai * 128 + m * 16;
                bf16* rowp = base + (size_t)(u.pm * 256 + rt) * ld + col0;
                float rstd = 1.f;
                if (AFFINE) { const pg8::f32x4* qp = (const pg8::f32x4*)(ssq + (size_t)(row_base + u.pm * 256 + rt) * 16); const pg8::f32x4 a0 = qp[0], a1 = qp[1], a2 = qp[2], a3 = qp[3];
                    const float tot = ((a0[0] + a0[1]) + (a0[2] + a0[3])) + ((a1[0] + a1[1]) + (a1[2] + a1[3])) + ((a2[0] + a2[1]) + (a2[2] + a2[3])) + ((a3[0] + a3[1]) + (a3[2] + a3[3]));
                    rstd = rsqrtf(tot * (1.f / D) + EPS); }
                f32x4 cs0 = {}, cs1 = {}, cs2 = {}, cs3 = {};
                if (ROPE && do_rope) { const int t = rr0 - CT + rt; const int pos = (wc & 1) ? (t & 63) : (t >> 6); const f32x4* tp = (const f32x4*)(rope + pos * 32 + 16 * (fq & 1));
                    cs0 = tp[0]; cs1 = tp[1]; cs2 = tp[2]; cs3 = tp[3]; }
#pragma unroll
                for (int bj = 0; bj < 2; ++bj) {
                    pg8::f32x4 v0 = acc[ai][bj][m][0], v1 = acc[ai][bj][m][1];
                    if (AFFINE) { v0 = v0 * rstd + sw[bj][0]; v1 = v1 * rstd + sw[bj][1]; }
                    if (ROPE && do_rope) {
                        const float sg = (fq & 2) ? 1.f : -1.f;
                        pg8::f32x4 p0, p1;
#pragma unroll
                        for (int i = 0; i < 4; ++i) { p0[i] = __shfl_xor(v0[i], 32); p1[i] = __shfl_xor(v1[i], 32); }
                        v0[0] = v0[0] * cs0[0] + sg * p0[0] * cs0[1]; v0[1] = v0[1] * cs0[2] + sg * p0[1] * cs0[3];
                        v0[2] = v0[2] * cs1[0] + sg * p0[2] * cs1[1]; v0[3] = v0[3] * cs1[2] + sg * p0[3] * cs1[3];
                        v1[0] = v1[0] * cs2[0] + sg * p1[0] * cs2[1]; v1[1] = v1[1] * cs2[2] + sg * p1[1] * cs2[3];
                        v1[2] = v1[2] * cs3[0] + sg * p1[2] * cs3[1]; v1[3] = v1[3] * cs3[2] + sg * p1[3] * cs3[3];
                    }
                    v0 = v0 * sc; v1 = v1 * sc;
                    pg8::u32x4 w; w.x = pg8::cvt_pk_bf16(v0[0], v0[1]); w.y = pg8::cvt_pk_bf16(v0[2], v0[3]); w.z = pg8::cvt_pk_bf16(v1[0], v1[1]); w.w = pg8::cvt_pk_bf16(v1[2], v1[3]);
                    if (NOSTORE) asm volatile("" :: "v"(w)); else { *(pg8::u32x4*)(rowp + bj * 128) = w;
#ifdef MK_EXP_ST2
                        asm volatile("" ::: "memory"); *(volatile pg8::u32x4*)(rowp + bj * 128) = w;
#endif
                    }
                }
            }
    }
};
__device__ __forceinline__ pg8::f32x4 ld4(const float* p) { return *(const pg8::f32x4*)p; }
__device__ __forceinline__ pg8::f32x4 ld4(const bf16* p) { const u32x2 w = *(const u32x2*)p; pg8::f32x4 v; v[0] = bflo(w.x); v[1] = bfhi(w.x); v[2] = bflo(w.y); v[3] = bfhi(w.y); return v; }
__device__ __forceinline__ void st4(float* p, const pg8::f32x4& v) { *(pg8::f32x4*)p = v; }
__device__ __forceinline__ void st4(bf16* p, const pg8::f32x4& v) { u32x2 w; w.x = pg8::cvt_pk_bf16(v[0], v[1]); w.y = pg8::cvt_pk_bf16(v[2], v[3]); *(u32x2*)p = w; }
template <class BT = float, class OT = float> struct EpiResidT {
    static constexpr bool PERM = false, AFTER_DRAIN = false;
    const BT* base_lat; const BT* base_ctx; OT* out_lat; OT* out_ctx; const float* mod_l; int need_ctx; int dry;
    bf16* Hn; const float* gnext; const float* modn; float* ssq;
    __device__ __forceinline__ void operator()(const pg8::f32x4 (&acc)[2][2][4][2], const pg8::Unit& u, int wr, int wc, int fr, int fq) const {
        asm volatile("" : "+v"(fr), "+v"(fq));
        const int r0 = u.pm * 256, b = r0 / RB, rr0 = r0 % RB; const bool ctx = rr0 == 0;
        if ((ctx && !need_ctx) || dry) return;
        const size_t ro = ctx ? (size_t)b * CT * D : ((size_t)b * S + (rr0 - CT)) * D;
        const BT* bp = (ctx ? base_ctx : base_lat) + ro; OT* op = (ctx ? out_ctx : out_lat) + ro;
        const float* gt = mod_l + (size_t)(ctx ? 16 : b) * 3072 + 2048;
        const int col0 = u.pn * 256 + wc * 32 + 4 * fq;
        pg8::f32x4 g[2][2];
#pragma unroll
        for (int bj = 0; bj < 2; ++bj)
#pragma unroll
            for (int n = 0; n < 2; ++n) g[bj][n] = *(const pg8::f32x4*)(gt + col0 + bj * 128 + n * 16);
        pg8::f32x4 gm[2][2];
        if (Hn) { const float* sn = modn + (size_t)(ctx ? 16 : b) * 3072 + 1024;
#pragma unroll
            for (int bj = 0; bj < 2; ++bj)
#pragma unroll
                for (int n = 0; n < 2; ++n) gm[bj][n] = *(const pg8::f32x4*)(gnext + col0 + bj * 128 + n * 16) * (*(const pg8::f32x4*)(sn + col0 + bj * 128 + n * 16) + 1.0f); }
#pragma unroll
        for (int ai = 0; ai < 2; ++ai)
#pragma unroll
            for (int m = 0; m < 4; ++m) { const size_t off = (size_t)(ai * 128 + wr * 64 + m * 16 + fr) * D + col0; float sq = 0.f;
#pragma unroll
                for (int bj = 0; bj < 2; ++bj)
#pragma unroll
                    for (int n = 0; n < 2; ++n) { const pg8::f32x4 bs = ld4(bp + off + bj * 128 + n * 16); const pg8::f32x4 xn = bs + g[bj][n] * acc[ai][bj][m][n]; st4(op + off + bj * 128 + n * 16, xn);
                        if (Hn) { sq += (xn[0] * xn[0] + xn[1] * xn[1]) + (xn[2] * xn[2] + xn[3] * xn[3]); const pg8::f32x4 hv = xn * gm[bj][n];
                            u32x2 w; w.x = pg8::cvt_pk_bf16(hv[0], hv[1]); w.y = pg8::cvt_pk_bf16(hv[2], hv[3]); *(u32x2*)(Hn + (size_t)(r0 + ai * 128 + wr * 64 + m * 16 + fr) * D + col0 + bj * 128 + n * 16) = w; } }
                if (Hn) { sq += __shfl_xor(sq, 16); sq += __shfl_xor(sq, 32); if (fq == 0) ssq[(size_t)(r0 + ai * 128 + wr * 64 + m * 16 + fr) * 16 + u.pn * 4 + wc] = sq; } }
    }
};
using EpiResid = EpiResidT<float, float>;

struct LatOnlyOrder {
    pg8::StaticOrder lat;
    __device__ void init(int G_, int c_) { lat.init(128 * 256, D, G_, c_); }
    __device__ bool next(int i, pg8::Unit& u) const { const bool ok = lat.next(i, u); u.pm = (u.pm >> 3) * 9 + 1 + (u.pm & 7); return ok; }
    __device__ __forceinline__ void a_ready(const pg8::Unit&) const {}
    __device__ __forceinline__ void done(const pg8::Unit&) const {}
};
struct OutTailOrder {
    int c;
    __device__ void init(int, int c_) { c = c_; }
    __device__ bool next(int i, pg8::Unit& u) const { if (i > 0 || c >= 64) return false; const int x = c & 7, j = c >> 3; u.pm = 128 + 2 * x + (j >> 2); u.pn = j & 3; return true; }
    __device__ __forceinline__ void a_ready(const pg8::Unit&) const {}
    __device__ __forceinline__ void done(const pg8::Unit&) const {}
};
struct L3Order {
    pg8::StaticOrder lat; int G, c;
    __device__ void init(int G_, int c_) { lat.init(64 * 256, 18 * 256, G_, c_); G = G_; c = c_; }
    __device__ bool next(int i, pg8::Unit& u) const {
        const long L = (long)i * G + c;
        if (L < 1152) { const bool ok = lat.next(i, u); u.pm = (u.pm >> 3) * 9 + 1 + (u.pm & 7); return ok; }
        if (L >= 1168) return false;
        const int j = (int)L - 1152; u.pm = (j >> 1) * 9; u.pn = 8 + (j & 1); return true;
    }
    __device__ __forceinline__ void a_ready(const pg8::Unit&) const {}
    __device__ __forceinline__ void done(const pg8::Unit&) const {}
};

__device__ __forceinline__ void transpose_item(const float* W, int K, int N, bf16* WT, LAS float* scr, int item, int lane) {
    const int nblk = N / 32, kb = item / nblk, nb = item % nblk, k0 = 64 * kb, n0 = 32 * nb;
#pragma unroll 8
    for (int i = 0; i < 32; ++i) { const int kk = 2 * i + (lane >> 5); scr[kk * 33 + (lane & 31)] = W[(size_t)(k0 + kk) * N + n0 + (lane & 31)]; }
    LDS_WAIT(); asm volatile("" ::: "memory");
    const int c = lane & 7;
#pragma unroll
    for (int j = 0; j < 4; ++j) { const int n = (lane >> 3) + 8 * j; const LAS float* s = scr + (8 * c) * 33 + n;
        v4u o; o.x = pk2(s[0 * 33], s[1 * 33]); o.y = pk2(s[2 * 33], s[3 * 33]); o.z = pk2(s[4 * 33], s[5 * 33]); o.w = pk2(s[6 * 33], s[7 * 33]);
        *(GAS v4u*)(WT + (size_t)(n0 + n) * K + k0 + 8 * c) = o; }
    LDS_WAIT(); asm volatile("" ::: "memory");
}
__device__ __forceinline__ void wconv(Frame& F0, const float* Win, int Nin, const float* Wout, bf16* WinT, bf16* WoutT, int gw, int NGW) {
    Frame F = fresh(F0);
    LAS float* scr = (LAS float*)(F.lds + F.wave * 16384);
    const int I1 = (D / 64) * (Nin / 32), I2 = (DI / 64) * (D / 32);
    for (int it = gw; it < I1 + I2; it += NGW) { if (it < I1) transpose_item(Win, D, Nin, WinT, scr, it, F.lane); else transpose_item(Wout, DI, D, WoutT, scr, it - I1, F.lane); }
}
template <class XT>
__device__ __forceinline__ void norm_phase(Frame& F0, const XT* xlat, const XT* xctx, const float* g, const float* mod_l, bf16* H, int row_lo = 0, int row_hi = MT, int wg0 = 0) {
    Frame F = fresh(F0);
    const int gw = (wg0 ? (int)blockIdx.x - wg0 : F.vcu) * NWAVES + F.wave, NGW = (F.G - wg0) * NWAVES;
    f32x4 gg[4];
#pragma unroll
    for (int j = 0; j < 4; ++j) gg[j] = *(const f32x4*)(g + F.lane * 4 + 256 * j);
    for (int row0 = row_lo + gw; row0 < row_hi; row0 += 2 * NGW) {
        f32x4 v[2][4]; const float* mrow[2]; float ss[2] = {0.f, 0.f}; int rowi[2];
#pragma unroll
        for (int u = 0; u < 2; ++u) { int row = row0 + u * NGW; if (row >= row_hi) row = row0; rowi[u] = row;
            const int b = row / RB, rr = row % RB;
            const XT* src = rr < CT ? xctx + ((size_t)b * CT + rr) * D : xlat + ((size_t)b * S + (rr - CT)) * D;
            mrow[u] = mod_l + (size_t)(rr < CT ? 16 : b) * 3072;
#pragma unroll
            for (int j = 0; j < 4; ++j) v[u][j] = ld4(src + F.lane * 4 + 256 * j); }
#pragma unroll
        for (int u = 0; u < 2; ++u) {
#pragma unroll
            for (int j = 0; j < 4; ++j) ss[u] += (v[u][j].x * v[u][j].x + v[u][j].y * v[u][j].y) + (v[u][j].z * v[u][j].z + v[u][j].w * v[u][j].w);
            const float rstd = rsqrtf(wave_sum(ss[u]) * (1.f / D) + EPS);
#pragma unroll
            for (int j = 0; j < 4; ++j) { const int c = F.lane * 4 + 256 * j; const f32x4 sc = *(const f32x4*)(mrow[u] + 1024 + c), sh = *(const f32x4*)(mrow[u] + c);
                const f32x4 o = v[u][j] * rstd * gg[j] * (sc + 1.0f) + sh;
                u32x2 w; w.x = pk2(o.x, o.y); w.y = pk2(o.z, o.w); *(u32x2*)(H + (size_t)rowi[u] * D + c) = w; }
        }
    }
}
__device__ __forceinline__ void final_norm_phase(Frame& F0, float* xs, const float* g) {
    Frame F = fresh(F0);
    const int gw = F.vcu * NWAVES + F.wave, NGW = F.G * NWAVES;
    f32x4 gg[4];
#pragma unroll
    for (int j = 0; j < 4; ++j) gg[j] = *(const f32x4*)(g + F.lane * 4 + 256 * j);
    for (int row0 = gw; row0 < NB * S; row0 += 2 * NGW) {
        f32x4 v[2][4]; float* p[2];
#pragma unroll
        for (int u = 0; u < 2; ++u) { int row = row0 + u * NGW; if (row >= NB * S) row = row0; p[u] = xs + (size_t)row * D;
#pragma unroll
            for (int j = 0; j < 4; ++j) v[u][j] = *(const f32x4*)(p[u] + F.lane * 4 + 256 * j); }
#pragma unroll
        for (int u = 0; u < 2; ++u) { float ss = 0.f;
#pragma unroll
            for (int j = 0; j < 4; ++j) ss += (v[u][j].x * v[u][j].x + v[u][j].y * v[u][j].y) + (v[u][j].z * v[u][j].z + v[u][j].w * v[u][j].w);
            const float rstd = rsqrtf(wave_sum(ss) * (1.f / D) + EPS);
#pragma unroll
            for (int j = 0; j < 4; ++j) { const int c = F.lane * 4 + 256 * j; *(f32x4*)(p[u] + c) = v[u][j] * rstd * gg[j]; } }
    }
}
__device__ __forceinline__ void shw_phase(Frame& F0, const Args& a) {
    Frame F = fresh(F0);
    const float* mod = (const float*)(a.ws + WS_MOD); float* shw = (float*)(a.ws + WS_SHW);
    LAS float* sh = (LAS float*)F.lds;
    LAS float* red = (LAS float*)(F.lds + 69632);
    int cur_l = -1;
    for (int it = blockIdx.x; it < 128 + 128 + 72; it += F.G) {
        const int l = it < 128 ? 0 : (it < 256 ? 1 : 2), cg = it - (l == 0 ? 0 : (l == 1 ? 128 : 256));
        const int N = l == 2 ? 4608 : 8192; const float* W = a.in[l == 0 ? 19 : (l == 1 ? 26 : 29)];
        __syncthreads();
        if (l != cur_l) { for (int i = F.tid; i < 17 * 1024; i += NTHR) sh[i] = mod[((size_t)(l + 1) * 17 + (i >> 10)) * 3072 + (i & 1023)]; cur_l = l; __syncthreads(); }
        float acc[17];
#pragma unroll
        for (int r = 0; r < 17; ++r) acc[r] = 0.f;
        const float* wp = W + (size_t)(F.wave * 128) * N + cg * 64 + F.lane;
#pragma unroll 8
        for (int kk = 0; kk < 128; ++kk) { const float w = wp[(size_t)kk * N];
#pragma unroll
            for (int r = 0; r < 17; ++r) acc[r] += sh[r * 1024 + F.wave * 128 + kk] * w; }
#pragma unroll
        for (int r = 0; r < 17; ++r) red[(F.wave * 17 + r) * 64 + F.lane] = acc[r];
        __syncthreads();
        for (int i = F.tid; i < 17 * 64; i += NTHR) { float sacc = 0.f;
#pragma unroll
            for (int w8 = 0; w8 < 8; ++w8) sacc += red[(w8 * 17 + (i >> 6)) * 64 + (i & 63)];
            shw[((size_t)l * 17 + (i >> 6)) * 8192 + cg * 64 + (i & 63)] = sacc; }
    }
    __syncthreads();
}
__device__ __forceinline__ void prologue_phase(Frame& F0, const Args& a) {
    Frame F = fresh(F0);
    const float* c = a.in[1]; const float* cctx = a.in[3]; const float* w_ada = a.in[5];
    float* part = (float*)(a.ws + WS_QG);
    {
        LAS float* st = (LAS float*)F.lds;
        const int wg = blockIdx.x, l = wg >> 6, sl = wg & 63, k0 = sl * 16;
        if (F.tid < 17 * 16) { const int r = F.tid >> 4, k = F.tid & 15; st[F.tid] = silu(r < 16 ? c[r * 1024 + k0 + k] : cctx[k0 + k]); }
        __syncthreads();
        float acc[17][6];
#pragma unroll
        for (int r = 0; r < 17; ++r)
#pragma unroll
            for (int i = 0; i < 6; ++i) acc[r][i] = 0.f;
        const float* wp = w_ada + ((size_t)l * 1024 + k0) * 3072 + F.tid;
#pragma unroll 2
        for (int kk = 0; kk < 16; ++kk) { float w[6];
#pragma unroll
            for (int i = 0; i < 6; ++i) w[i] = wp[(size_t)kk * 3072 + 512 * i];
#pragma unroll
            for (int r = 0; r < 17; ++r) { const float sv = st[r * 16 + kk];
#pragma unroll
                for (int i = 0; i < 6; ++i) acc[r][i] += sv * w[i]; } }
        float* pp = part + (size_t)wg * 17 * 3072 + F.tid;
#pragma unroll
        for (int r = 0; r < 17; ++r)
#pragma unroll
            for (int i = 0; i < 6; ++i) pp[r * 3072 + 512 * i] = acc[r][i];
    }
#ifdef MK_TOUCH
    {
        const int xg = blockIdx.x >> 3; unsigned accv = 0u;
        for (size_t off = ((size_t)xg * NTHR + F.tid) * 4096; off < WS_END; off += (size_t)32 * NTHR * 4096) accv += *(const unsigned*)(a.ws + off);
        for (size_t off = ((size_t)xg * NTHR + F.tid) * 4096; off < (size_t)NB * S * D * 4; off += (size_t)32 * NTHR * 4096) accv += *(const unsigned*)((const unsigned char*)a.out + off) + *(const unsigned*)((const unsigned char*)a.in[0] + off);
        asm volatile("" :: "v"(accv));
    }
#endif
    if (blockIdx.x == 0) {
        float* rope = (float*)(a.ws + WS_ROPE);
        for (int i = F.tid; i < 64 * 16; i += NTHR) { const int pos = i >> 4, j = i & 15; const float inv = powf(10000.f, -(float)j / 16.f), ang = (float)pos * inv; rope[2 * i] = cosf(ang); rope[2 * i + 1] = sinf(ang); }
    } else if (blockIdx.x < 33) {
        bf16* W2 = (bf16*)(a.ws + WS_WG2); const float* wq = a.in[11]; const float* wk = a.in[12]; const float* wv = a.in[13]; const float* wg = a.in[14];
        for (int i = (blockIdx.x - 1) * NTHR + F.tid; i < 32 * 4096; i += 32 * NTHR) { const int n = i >> 12, k = i & 4095; float s = 0.f;
            if (k < 2048) { const int gq = k >> 2, ii = k & 3;
#pragma unroll
                for (int j = 0; j < 4; ++j) s += wq[(gq * 4 + ii) * 4 + j] * wg[(size_t)(gq * 4 + j) * 32 + n] + wk[(gq * 4 + ii) * 4 + j] * wg[(size_t)(2048 + gq * 4 + j) * 32 + n]; }
            else { const int kk = k - 2048, gq = kk >> 2, ii = kk & 3;
#pragma unroll
                for (int j = 0; j < 4; ++j) s += wv[(gq * 4 + ii) * 4 + j] * wg[(size_t)(4096 + gq * 4 + j) * 32 + n]; }
            W2[i] = (bf16)f2bf(s); }
    }
}
__device__ __forceinline__ void prologue2_phase(Frame& F0, const Args& a) {
    Frame F = fresh(F0);
    const float* part = (const float*)(a.ws + WS_QG); const float* b_ada = a.in[6]; float* mod = (float*)(a.ws + WS_MOD);
    for (int o = blockIdx.x * NTHR + F.tid; o < 4 * 17 * 3072; o += F.G * NTHR) {
        const int l = o / (17 * 3072), rn = o % (17 * 3072), n = rn % 3072;
        const float* pp = part + (size_t)l * 64 * 17 * 3072 + rn; float s0 = 0.f, s1 = 0.f, s2 = 0.f, s3 = 0.f;
#pragma unroll
        for (int sl = 0; sl < 64; sl += 16) { float v[16];
#pragma unroll
            for (int j = 0; j < 16; ++j) v[j] = pp[(size_t)(sl + j) * 17 * 3072];
#pragma unroll
            for (int j = 0; j < 16; j += 4) { s0 += v[j]; s1 += v[j + 1]; s2 += v[j + 2]; s3 += v[j + 3]; } }
        mod[o] = ((s0 + s1) + (s2 + s3)) + b_ada[l * 3072 + n];
    }
}
}
namespace att {
using mk::bf16; using mk::bf16x8; using mk::s16x4; using mk::f32x16; using mk::u32x4; using mk::u32x2;
typedef short v4i16_t __attribute__((ext_vector_type(4)));
typedef float f32x2_t __attribute__((ext_vector_type(2))); typedef __bf16 bf16x2_t __attribute__((ext_vector_type(2)));
__device__ __forceinline__ int crow(int r, int hi) { return (r & 3) + 8 * (r >> 2) + 4 * hi; }
__device__ __forceinline__ unsigned cvtpk(float lo, float hi) { f32x2_t v = {lo, hi}; bf16x2_t b = __builtin_convertvector(v, bf16x2_t); return __builtin_bit_cast(unsigned, b); }
__device__ __forceinline__ s16x4 vtr(LAS const unsigned char* p) { return __builtin_bit_cast(s16x4, __builtin_amdgcn_ds_read_tr16_b64_v4i16((LAS v4i16_t*)p)); }
__device__ __forceinline__ float ex2(float x) { return __builtin_amdgcn_exp2f(x); }
__device__ __forceinline__ float max3f(float a, float b, float c) { float r; asm("v_max3_f32 %0, %1, %2, %3" : "=v"(r) : "v"(a), "v"(b), "v"(c)); return r; }
#define ATT_SB() __builtin_amdgcn_sched_barrier(0)

struct Src { const bf16* K[2]; const bf16* V; int ldk, ldv; };

template <int DV, int NCOMP> struct Stage { u32x4 kr[NCOMP]; u32x4 vr[DV / 64]; };
template <int DV, int NCOMP>
__device__ __forceinline__ void stage_load(Stage<DV, NCOMP>& st, const Src& s, size_t row, int wid, int lane) {
#pragma unroll
    for (int c = 0; c < NCOMP; ++c) st.kr[c] = *(const u32x4*)(s.K[c] + (row + lane) * s.ldk + wid * 8);
#pragma unroll
    for (int i = 0; i < DV / 64; ++i) { const int p = wid + 8 * i, d0 = p >> 2, kg = p & 3; st.vr[i] = *(const u32x4*)(s.V + (row + 16 * kg + (lane >> 2)) * s.ldv + d0 * 32 + (lane & 3) * 8); }
}
template <int DV, int NCOMP>
__device__ __forceinline__ void stage_store(const Stage<DV, NCOMP>& st, LAS unsigned char* buf, int wid, int lane) {
#pragma unroll
    for (int c = 0; c < NCOMP; ++c) *(LAS u32x4*)(buf + c * 8192 + wid * 1024 + lane * 16) = st.kr[c];
#pragma unroll
    for (int i = 0; i < DV / 64; ++i) *(LAS u32x4*)(buf + NCOMP * 8192 + (wid + 8 * i) * 1024 + lane * 16) = st.vr[i];
}
__device__ __forceinline__ void glds16(const void* gsrc, unsigned lds_dst) { unsigned keep;
    asm volatile("s_mov_b32 %0, m0\n\ts_mov_b32 m0, %2\n\ts_nop 0\n\tglobal_load_lds_dwordx4 %1, off\n\ts_mov_b32 m0, %0" : "=&s"(keep) : "v"(gsrc), "s"(lds_dst) : "memory"); }
__device__ __forceinline__ unsigned long long uni64(const void* p) { const unsigned long long a = (unsigned long long)p;
    return ((unsigned long long)(unsigned)__builtin_amdgcn_readfirstlane((unsigned)(a >> 32)) << 32) | (unsigned)__builtin_amdgcn_readfirstlane((unsigned)a); }
__device__ __forceinline__ void glds16s(const void* sbase_, unsigned voff, unsigned lds_dst) { unsigned keep; const unsigned long long sbase = uni64(sbase_);
    asm volatile("s_mov_b32 %0, m0\n\ts_mov_b32 m0, %3\n\ts_nop 0\n\tglobal_load_lds_dwordx4 %1, %2\n\ts_mov_b32 m0, %0" : "=&s"(keep) : "v"(voff), "s"(sbase), "s"(lds_dst) : "memory"); }
template <int DV, int NCOMP>
__device__ __forceinline__ void dma_issue(const Src& s, size_t row, LAS unsigned char* buf, int wid, int lane) {
    const unsigned b0 = (unsigned)(size_t)buf;
    const int kl = lane >> 3;
    const unsigned ko = (unsigned)(kl * s.ldk + (((lane & 7) ^ ((4 * (wid & 1) + (kl >> 1)) & 7)) * 8)) * 2u, vo = (unsigned)((16 * (wid & 3) + (lane >> 2)) * s.ldv + (lane & 3) * 8) * 2u;
#pragma unroll
    for (int c = 0; c < NCOMP; ++c) glds16s(s.K[c] + (row + 8 * wid) * s.ldk, ko, (unsigned)__builtin_amdgcn_readfirstlane(b0 + c * 8192 + wid * 1024));
#pragma unroll
    for (int i = 0; i < DV / 64; ++i) { const int p = wid + 8 * i, d0 = p >> 2;
        glds16s(s.V + row * s.ldv + d0 * 32, vo, (unsigned)__builtin_amdgcn_readfirstlane(b0 + NCOMP * 8192 + p * 1024)); }
}
#define ATT_WAIT_BAR(N) asm volatile("s_waitcnt vmcnt(" #N ") lgkmcnt(0)\n\ts_barrier" ::: "memory")
template <int NL> __device__ __forceinline__ void wait_bar_keep() { if constexpr (NL == 2) ATT_WAIT_BAR(2); else if constexpr (NL == 4) ATT_WAIT_BAR(4); else static_assert(NL == 2 || NL == 4, "pieces per wave"); }
__device__ __forceinline__ void qk_tile(LAS const unsigned char* kimg, const bf16x8 (&qf)[4], int r32, int hi, f32x16& p0, f32x16& p1, const f32x16& z, const f32x16& z1  ) {
    const int sw = (r32 >> 1) & 7, u16 = (sw & 6) * 16;
    LAS const unsigned char* kb = kimg + r32 * 128 + ((hi ^ sw) & 1) * 16;
    LAS const unsigned char* ka[4] = {kb + (0 ^ u16), kb + (32 ^ u16), kb + (64 ^ u16), kb + (96 ^ u16)};
#define ATT_KRD(i) (*(LAS const bf16x8*)(ka[(i) >> 1] + ((i) & 1) * 4096))
    bf16x8 f0 = ATT_KRD(0), f1 = ATT_KRD(1), f2;
    f2 = ATT_KRD(2); ATT_SB(); p0 = __builtin_amdgcn_mfma_f32_32x32x16_bf16(f0, qf[0], z, 0, 0, 0);
    f0 = ATT_KRD(3); ATT_SB(); p1 = __builtin_amdgcn_mfma_f32_32x32x16_bf16(f1, qf[0], z1, 0, 0, 0);
    f1 = ATT_KRD(4); ATT_SB(); p0 = __builtin_amdgcn_mfma_f32_32x32x16_bf16(f2, qf[1], p0, 0, 0, 0);
    f2 = ATT_KRD(5); ATT_SB(); p1 = __builtin_amdgcn_mfma_f32_32x32x16_bf16(f0, qf[1], p1, 0, 0, 0);
    f0 = ATT_KRD(6); ATT_SB(); p0 = __builtin_amdgcn_mfma_f32_32x32x16_bf16(f1, qf[2], p0, 0, 0, 0);
    f1 = ATT_KRD(7); ATT_SB(); p1 = __builtin_amdgcn_mfma_f32_32x32x16_bf16(f2, qf[2], p1, 0, 0, 0);
    ATT_SB(); p0 = __builtin_amdgcn_mfma_f32_32x32x16_bf16(f0, qf[3], p0, 0, 0, 0);
    ATT_SB(); p1 = __builtin_amdgcn_mfma_f32_32x32x16_bf16(f1, qf[3], p1, 0, 0, 0);
#undef ATT_KRD
}
template <int DV>
__device__ __forceinline__ void softmax_tile(f32x16& p0, f32x16& p1, f32x16 (&o)[DV / 32], float& m, float& l, u32x4 (&pw)[4]) {
    float mxa = max3f(p0[0], p0[1], p1[0]), mxb = max3f(p0[2], p0[3], p1[1]); mxa = max3f(mxa, p1[2], p1[3]);
#pragma unroll
    for (int r = 4; r < 16; r += 4) { mxa = max3f(mxa, p0[r], p0[r + 1]); mxb = max3f(mxb, p0[r + 2], p0[r + 3]); mxa = max3f(mxa, p1[r], p1[r + 1]); mxb = max3f(mxb, p1[r + 2], p1[r + 3]); }
    const float mx0 = max3f(mxa, mxb, mxb);
    const float mn = max3f(m, mx0, __shfl_xor(mx0, 32)), alpha = ex2(m - mn);
    float ls = 0.f;
#pragma unroll
    for (int r = 0; r < 16; ++r) { p0[r] = ex2(p0[r] - mn); p1[r] = ex2(p1[r] - mn); ls += p0[r] + p1[r]; }
    l = l * alpha + ls;
    if (__any(mn != m)) {
#pragma unroll
        for (int d0 = 0; d0 < DV / 32; ++d0)
#pragma unroll
            for (int r = 0; r < 16; ++r) o[d0][r] *= alpha;
    }
    m = mn;
#pragma unroll
    for (int ks = 0; ks < 4; ++ks) { const int b = 8 * (ks & 1);
        if (ks < 2) { pw[ks].x = cvtpk(p0[b], p0[b + 1]); pw[ks].y = cvtpk(p0[b + 2], p0[b + 3]); pw[ks].z = cvtpk(p0[b + 4], p0[b + 5]); pw[ks].w = cvtpk(p0[b + 6], p0[b + 7]); }
        else { pw[ks].x = cvtpk(p1[b], p1[b + 1]); pw[ks].y = cvtpk(p1[b + 2], p1[b + 3]); pw[ks].z = cvtpk(p1[b + 4], p1[b + 5]); pw[ks].w = cvtpk(p1[b + 6], p1[b + 7]); } }
}
template <int DV>
__device__ __forceinline__ void pv_tile(LAS const unsigned char* vimg, int lane, int hi, const u32x4 (&pw)[4], f32x16 (&o)[DV / 32]) {
    LAS const unsigned char* vb = vimg + ((lane >> 4) & 1) * 32 + (lane & 3) * 8 + (4 * hi + ((lane & 15) >> 2)) * 64;
    constexpr int ND = DV / 32, NF = 4 * ND;
    constexpr int PD = 4, NB_ = PD + 1;
    s16x4 lo[NB_], hi4[NB_];
#define ATT_VRD(i, b) do { lo[b] = vtr(vb + ((i) % ND) * 4096 + ((i) / ND) * 1024); hi4[b] = vtr(vb + ((i) % ND) * 4096 + ((i) / ND) * 1024 + 512); } while (0)
#pragma unroll
    for (int i = 0; i < PD; ++i) ATT_VRD(i, i);
#pragma unroll
    for (int i = 0; i < NF; ++i) {
        if (i + PD < NF) ATT_VRD(i + PD, (i + PD) % NB_);
        ATT_SB();
        const int b = i % NB_;
        const bf16x8 vf = {lo[b][0], lo[b][1], lo[b][2], lo[b][3], hi4[b][0], hi4[b][1], hi4[b][2], hi4[b][3]};
        o[i % ND] = __builtin_amdgcn_mfma_f32_32x32x16_bf16(vf, __builtin_bit_cast(bf16x8, pw[i / ND]), o[i % ND], 0, 0, 0);
    }
#undef ATT_VRD
}

struct SmState { float mxa, mxb, mn, alpha, ls, delta; bool resc; };
template <int NM>
__device__ __forceinline__ void negm_shift(f32x16 (&negm)[NM], float delta) {
#pragma unroll
    for (int i = 0; i < NM; ++i)
#pragma unroll
        for (int r = 0; r < 16; ++r) negm[i][r] -= delta;
}
__device__ __forceinline__ float xmax32(float v) { auto rr = __builtin_amdgcn_permlane32_swap(__float_as_uint(v), __float_as_uint(v), false, false); return max3f(__uint_as_float(rr[0]), __uint_as_float(rr[1]), v); }
template <int SK> __device__ __forceinline__ constexpr bool sm_live0(int r) { return SK != 2 || r >= 12; }
template <int SK> __device__ __forceinline__ constexpr bool sm_live1(int r) { return SK != 1 || r < 4; }
template <int SK = 0>
__device__ __forceinline__ void sm_slice(int k, f32x16& p0, f32x16& p1, float& m, float& l, SmState& s, u32x4 (&pwn)[4]) {
    if (k <= 3) { const int r = 4 * k;
        if (SK == 0 && k == 0) { s.mxa = max3f(p0[0], p0[1], p1[0]); s.mxb = max3f(p0[2], p0[3], p1[1]); s.mxa = max3f(s.mxa, p1[2], p1[3]); }
        else { if (k == 0) { s.mxa = -INFINITY; s.mxb = -INFINITY; }
            if (sm_live0<SK>(r)) { s.mxa = max3f(s.mxa, p0[r], p0[r + 1]); s.mxb = max3f(s.mxb, p0[r + 2], p0[r + 3]); }
            if (sm_live1<SK>(r)) { s.mxa = max3f(s.mxa, p1[r], p1[r + 1]); s.mxb = max3f(s.mxb, p1[r + 2], p1[r + 3]); } }
        asm volatile("" : "+v"(s.mxa), "+v"(s.mxb)); }
    else if (k == 4) { const float mx0 = xmax32(max3f(s.mxa, s.mxb, s.mxb)); const bool first = m == -INFINITY;
        const float delta = (first || mx0 > 8.f) ? mx0 : 0.f; s.delta = delta; s.mn = first ? mx0 : m + delta; s.alpha = ex2(-delta); s.resc = __any(delta != 0.f); l *= s.alpha; s.ls = 0.f;
        if (s.resc) {
#pragma unroll
            for (int r = 0; r < 16; ++r) { p0[r] -= delta; p1[r] -= delta; }
        }
        asm volatile("" : "+v"(s.mn), "+v"(s.alpha), "+v"(l)); }
    else if (k <= 12) { const int j = 2 * (k - 5);
        if (sm_live0<SK>(j)) { p0[j] = ex2(p0[j]); p0[j + 1] = ex2(p0[j + 1]); s.ls += p0[j] + p0[j + 1]; }
        if (sm_live1<SK>(j)) { p1[j] = ex2(p1[j]); p1[j + 1] = ex2(p1[j + 1]); s.ls += p1[j] + p1[j + 1]; }
        asm volatile("" : "+v"(p0), "+v"(p1), "+v"(s.ls)); }
    else if (k == 13) {
        if (SK == 2) { pwn[0] = u32x4{0u, 0u, 0u, 0u}; pwn[1].x = 0u; pwn[1].y = 0u; }
        else { pwn[0].x = cvtpk(p0[0], p0[1]); pwn[0].y = cvtpk(p0[2], p0[3]); pwn[0].z = cvtpk(p0[4], p0[5]); pwn[0].w = cvtpk(p0[6], p0[7]); pwn[1].x = cvtpk(p0[8], p0[9]); pwn[1].y = cvtpk(p0[10], p0[11]); }
        pwn[1].z = cvtpk(p0[12], p0[13]); pwn[1].w = cvtpk(p0[14], p0[15]); asm volatile("" : "+v"(pwn[0]), "+v"(pwn[1])); }
    else if (k == 14) { pwn[2].x = cvtpk(p1[0], p1[1]); pwn[2].y = cvtpk(p1[2], p1[3]);
        if (SK == 1) { pwn[2].z = 0u; pwn[2].w = 0u; pwn[3] = u32x4{0u, 0u, 0u, 0u}; }
        else { pwn[2].z = cvtpk(p1[4], p1[5]); pwn[2].w = cvtpk(p1[6], p1[7]); pwn[3].x = cvtpk(p1[8], p1[9]); pwn[3].y = cvtpk(p1[10], p1[11]); pwn[3].z = cvtpk(p1[12], p1[13]); pwn[3].w = cvtpk(p1[14], p1[15]); }
        asm volatile("" : "+v"(pwn[2]), "+v"(pwn[3])); }
    else { l += s.ls; asm volatile("" : "+v"(l)); }
}
template <int DV, int NM, int SK = 0>
__device__ __forceinline__ void sm_alone(f32x16& p0, f32x16& p1, f32x16 (&o)[DV / 32], float& m, float& l, u32x4 (&pwn)[4], f32x16 (&negm)[NM]) {
    SmState s;
#pragma unroll
    for (int k = 0; k < 16; ++k) sm_slice<SK>(k, p0, p1, m, l, s, pwn);
    if (s.resc) {
#pragma unroll
        for (int d0 = 0; d0 < DV / 32; ++d0)
#pragma unroll
            for (int r = 0; r < 16; ++r) o[d0][r] *= s.alpha;
        negm_shift<NM>(negm, s.delta);
    }
    m = s.mn;
}
template <int DV, int NM, int SK = 0>
__device__ __forceinline__ void pv_sm_tile(LAS const unsigned char* vimg, int lane, int hi, const u32x4 (&pw)[4], f32x16 (&o)[DV / 32], f32x16& p0, f32x16& p1, float& m, float& l, u32x4 (&pwn)[4], f32x16 (&negm)[NM]) {
    LAS const unsigned char* vb = vimg + ((lane >> 4) & 1) * 32 + (lane & 3) * 8 + (4 * hi + ((lane & 15) >> 2)) * 64;
    constexpr int ND = DV / 32, NF = 4 * ND, PD = 3, NB_ = PD + 1, SPM = 16 / NF;
    s16x4 lo[NB_], hi4[NB_];
    SmState s;
#define ATT_VRD(i, b) do { lo[b] = vtr(vb + ((i) % ND) * 4096 + ((i) / ND) * 1024); hi4[b] = vtr(vb + ((i) % ND) * 4096 + ((i) / ND) * 1024 + 512); } while (0)
#pragma unroll
    for (int i = 0; i < PD; ++i) ATT_VRD(i, i);
#pragma unroll
    for (int i = 0; i < NF; ++i) {
        if (i + PD < NF) ATT_VRD(i + PD, (i + PD) % NB_);
        ATT_SB();
        const int b = i % NB_;
        const bf16x8 vf = {lo[b][0], lo[b][1], lo[b][2], lo[b][3], hi4[b][0], hi4[b][1], hi4[b][2], hi4[b][3]};
        o[i % ND] = __builtin_amdgcn_mfma_f32_32x32x16_bf16(vf, __builtin_bit_cast(bf16x8, pw[i / ND]), o[i % ND], 0, 0, 0);
#pragma unroll
        for (int k = i * SPM; k < (i + 1) * SPM; ++k) sm_slice<SK>(k, p0, p1, m, l, s, pwn);
        ATT_SB();
    }
#undef ATT_VRD
    if (s.resc) {
#pragma unroll
        for (int d0 = 0; d0 < ND; ++d0)
#pragma unroll
            for (int r = 0; r < 16; ++r) o[d0][r] *= s.alpha;
        negm_shift<NM>(negm, s.delta);
    }
    m = s.mn;
}

__device__ __forceinline__ void wait_bar_tiles2(int c) {
    if (c >= 5) ATT_WAIT_BAR(10); else if (c == 4) ATT_WAIT_BAR(8); else if (c == 3) ATT_WAIT_BAR(6); else if (c == 2) ATT_WAIT_BAR(4); else if (c == 1) ATT_WAIT_BAR(2); else ATT_WAIT_BAR(0);
}
template <int DV, class Pol, int NS = 4>
__device__ __forceinline__ void run_unit1(LAS unsigned char* lds, const Pol& P, const Src& src, const bf16* Q, int ldq, int wid, int lane) {
    const int r32 = lane & 31, hi = lane >> 5;
    constexpr int STG = 8192 + DV * 128, NL = 1 + DV / 64, LA = NS - 2;
    static_assert(NL == 2 && LA <= 6, "wait_bar_tiles2 counts two-piece tiles");
    const int nt = P.ntiles();
#pragma unroll
    for (int t = 0; t < LA; ++t) if (t < nt) dma_issue<DV, 1>(src, P.tile_row(t), lds + t * STG, wid, lane);
    bf16x8 qf[4];
    { const bf16* qp = Q + (size_t)(wid * 32 + r32) * ldq + hi * 8;
#pragma unroll
      for (int d0 = 0; d0 < 4; ++d0) qf[d0] = *(const bf16x8*)(qp + d0 * 16); }
    f32x16 o[DV / 32];
#pragma unroll
    for (int d0 = 0; d0 < DV / 32; ++d0) o[d0] = f32x16{};
    float m = -INFINITY, l = 0.f; f32x16 negm[1] = {f32x16{}};
    u32x4 pw[4], pwn[4]; bool pend = false;
    asm volatile("" : "+v"(qf[0]), "+v"(qf[1]), "+v"(qf[2]), "+v"(qf[3]));
    ATT_WAIT_BAR(0);
    int ic = 0;
    for (int ti = 0; ti < nt; ++ti) {
        LAS unsigned char* cur = lds + ic * STG; LAS unsigned char* prv = lds + ((ic + NS - 1) & (NS - 1)) * STG;
        if (ti + LA < nt) dma_issue<DV, 1>(src, P.tile_row(ti + LA), lds + ((ic + LA) & (NS - 1)) * STG, wid, lane);
        if (P.needs(ti, wid)) {
            f32x16 p0, p1;
            qk_tile(cur, qf, r32, hi, p0, p1, negm[0], negm[0]);
            P.mask(ti, wid, r32, hi, p0, p1);
            if (pend) pv_sm_tile<DV, 1>(prv + 8192, lane, hi, pw, o, p0, p1, m, l, pwn, negm); else sm_alone<DV, 1>(p0, p1, o, m, l, pwn, negm);
#pragma unroll
            for (int k = 0; k < 4; ++k) pw[k] = pwn[k];
            pend = true;
        } else if (pend) { pv_tile<DV>(prv + 8192, lane, hi, pw, o); pend = false; }
        wait_bar_tiles2(min(ti + LA, nt - 1) - (ti + 1));
        ic = (ic + 1) & (NS - 1);
    }
    if (pend) pv_tile<DV>(lds + ((ic + NS - 1) & (NS - 1)) * STG + 8192, lane, hi, pw, o);
    P.finish(o, m, l, wid, r32, hi);
    ATT_WAIT_BAR(0);
}
constexpr int ZQ_Z = 65536, ZQ_Q = 98304;
__device__ __forceinline__ void glds4s(const void* sbase_, unsigned voff, unsigned lds_dst) { unsigned keep; const unsigned long long sbase = uni64(sbase_);
    asm volatile("s_mov_b32 %0, m0\n\ts_mov_b32 m0, %3\n\ts_nop 0\n\tglobal_load_lds_dword %1, %2\n\ts_mov_b32 m0, %0" : "=&s"(keep) : "v"(voff), "s"(sbase), "s"(lds_dst) : "memory"); }
__device__ __forceinline__ void dma_rows64(const bf16* base, int ld, LAS unsigned char* dst, int lane) {
    const unsigned vo = (unsigned)((lane & 31) * ld + (lane >> 5) * 8) * 2u;
    const unsigned b0 = (unsigned)(size_t)dst;
#pragma unroll
    for (int j = 0; j < 4; ++j) glds16s(base + j * 16, vo, (unsigned)__builtin_amdgcn_readfirstlane(b0 + j * 1024));
}
template <class Pol, int SKL  , class Ctx, class Gen>
__device__ __forceinline__ void run_stream1(LAS unsigned char* lds, const Ctx& C, const Gen& gen, int wid_, int lane_) {
    constexpr int DV = 64, STG = 16384, EX = Pol::EXTRA;
    static_assert(EX == 4 || EX == 5, "first-step wait counts");
    int lane = lane_, wid = wid_;
#define ZL_ (lds + ZQ_Z + wid * 4096)
#define QL_ (lds + ZQ_Q + wid * 4096)
    Pol P;
    if (!gen(0, P)) return;
    dma_rows64(P.qrow(C, wid), mk::DI, QL_, lane);
    dma_issue<DV, 1>(P.src(C), P.tile_row(0), lds, wid, lane);
    dma_issue<DV, 1>(P.src(C), P.tile_row(1), lds + STG, wid, lane);
    ATT_WAIT_BAR(0);
    int ic = 0;
    for (int i = 0;; ++i) {
        Pol Pn; const bool hn = gen(i + 1, Pn);
        asm volatile("" : "+v"(lane), "+s"(wid));
        bf16x8 qf[4];
#pragma unroll
        for (int d0 = 0; d0 < 4; ++d0) qf[d0] = *(LAS const bf16x8*)(QL_ + d0 * 1024 + lane * 16);
        asm volatile("" : "+v"(qf[0]), "+v"(qf[1]), "+v"(qf[2]), "+v"(qf[3]));
        const int nt = P.ntiles();
        f32x16 o[2] = {f32x16{}, f32x16{}};
        float m = -INFINITY, l = 0.f; f32x16 negm[Pol::NM];
#pragma unroll
        for (int i_ = 0; i_ < Pol::NM; ++i_) negm[i_] = f32x16{};
        u32x4 pw[4], pwn[4]; bool pend = false;
        auto steps = [&](auto skc, int t0, int t1) {
          constexpr int SK_ = decltype(skc)::value;
          for (int ti = t0; ti < t1; ++ti) {
            LAS unsigned char* cur = lds + ic * STG; LAS unsigned char* prv = lds + ((ic + 3) & 3) * STG; LAS unsigned char* nxt = lds + ((ic + 2) & 3) * STG;
            asm volatile("" : "+v"(lane), "+s"(wid)); const int r32 = lane & 31, hi = lane >> 5;
            if (ti == 0) { P.stage_extra(C, ZL_, wid, lane); if (hn) dma_rows64(Pn.qrow(C, wid), mk::DI, QL_, lane); }
            bool issued = true;
            if (ti + 2 < nt) dma_issue<DV, 1>(P.src(C), P.tile_row(ti + 2), nxt, wid, lane);
            else if (hn) dma_issue<DV, 1>(Pn.src(C), Pn.tile_row(ti + 2 - nt), nxt, wid, lane);
            else issued = false;
            P.prep(ti, wid, r32, hi, negm);
            if (P.needs(ti, wid)) {
                f32x16 p0, p1;
                qk_tile(cur, qf, r32, hi, p0, p1, negm[0], negm[Pol::NM - 1]);
                P.template mask<SK_>(C, ti, wid, r32, hi, p0, p1);
                if (pend) pv_sm_tile<DV, Pol::NM, SK_>(prv + 8192, lane, hi, pw, o, p0, p1, m, l, pwn, negm); else sm_alone<DV, Pol::NM, SK_>(p0, p1, o, m, l, pwn, negm);
#pragma unroll
                for (int k = 0; k < 4; ++k) pw[k] = pwn[k];
                pend = true;
            } else if (pend) { pv_tile<DV>(prv + 8192, lane, hi, pw, o); pend = false; }
            if (ti == 0) { if constexpr (EX == 4) { if (hn) ATT_WAIT_BAR(10); else ATT_WAIT_BAR(6); } else { if (hn) ATT_WAIT_BAR(11); else ATT_WAIT_BAR(7); } }
            else if (issued) ATT_WAIT_BAR(2); else ATT_WAIT_BAR(0);
            ic = (ic + 1) & 3;
          }
        };
        if constexpr (SKL == 0) steps(std::integral_constant<int, 0>{}, 0, nt);
        else { steps(std::integral_constant<int, 0>{}, 0, 4);
            steps(std::integral_constant<int, SKL>{}, 4, nt); }
        asm volatile("" : "+v"(lane), "+s"(wid)); const int r32 = lane & 31, hi = lane >> 5;
        if (pend) pv_tile<DV>(lds + ((ic + 3) & 3) * STG + 8192, lane, hi, pw, o);
        P.finish(C, o, m, l, wid, r32, hi, ZL_);
        if (!hn) break;
        P = Pn;
    }
    ATT_WAIT_BAR(0);
#undef ZL_
#undef QL_
}
}
namespace mk {
using att::Src; using att::crow; using att::ex2;

template <int DV>
__device__ __forceinline__ void store_gated(const f32x16 (&o)[DV / 32], float inv, const bf16* zrow, bf16* grow, int hi) {
#pragma unroll
    for (int d0 = 0; d0 < DV / 32; ++d0)
#pragma unroll
        for (int i = 0; i < 4; ++i) { const int d = 32 * d0 + 8 * i + 4 * hi;
            const u32x2 zw = *(const u32x2*)(zrow + d);
            const float v0 = o[d0][4 * i] * inv * silu(bflo(zw.x)), v1 = o[d0][4 * i + 1] * inv * silu(bfhi(zw.x)), v2 = o[d0][4 * i + 2] * inv * silu(bflo(zw.y)), v3 = o[d0][4 * i + 3] * inv * silu(bfhi(zw.y));
            u32x2 w; w.x = att::cvtpk(v0, v1); w.y = att::cvtpk(v2, v3); *(u32x2*)(grow + d) = w; }
}

__device__ __forceinline__ void store_gated_l(const f32x16 (&o)[2], float inv, LAS const unsigned char* zl, bf16* grow, int r32, int hi) {
#pragma unroll
    for (int d0 = 0; d0 < 2; ++d0)
#pragma unroll
        for (int i = 0; i < 4; ++i) { const int d = 32 * d0 + 8 * i + 4 * hi;
            const u32x2 zw = *(LAS const u32x2*)(zl + (2 * d0 + (i >> 1)) * 1024 + (r32 + 32 * (i & 1)) * 16 + 8 * hi);
            const float v0 = o[d0][4 * i] * inv * silu(bflo(zw.x)), v1 = o[d0][4 * i + 1] * inv * silu(bfhi(zw.x)), v2 = o[d0][4 * i + 2] * inv * silu(bflo(zw.y)), v3 = o[d0][4 * i + 3] * inv * silu(bfhi(zw.y));
            u32x2 w; w.x = att::cvtpk(v0, v1); w.y = att::cvtpk(v2, v3); *(u32x2*)(grow + d) = w; }
}

struct AttCtx { const bf16* QG; const bf16* Kb; const bf16* Vb; const bf16* Zb; const float* aux; LAS const float* tab; int dry; };
struct SwaPol {
    static constexpr int EXTRA = 4, NM = 1;
    int bl, hq, qb, tl0, ntl; float sinkl2;
    __device__ __forceinline__ size_t off() const { return ((size_t)bl * RB + CT + qb * 256) * DI + hq * 64; }
    __device__ __forceinline__ Src src(const AttCtx& C) const { Src s; s.K[0] = C.Kb + (hq >> 3) * 64; s.K[1] = nullptr; s.V = C.Vb + (hq >> 3) * 64; s.ldk = 256; s.ldv = 256; return s; }
    __device__ __forceinline__ void prep(int, int, int, int, f32x16 (&)[1]) const {}
    __device__ __forceinline__ int ntiles() const { return 4 + ntl; }
    __device__ __forceinline__ const bf16* qrow(const AttCtx& C, int wid) const { return C.QG + off() + (size_t)(wid * 32) * DI; }
    __device__ __forceinline__ void stage_extra(const AttCtx& C, LAS unsigned char* zl, int wid, int lane) const { att::dma_rows64(C.Zb + off() + (size_t)(wid * 32) * DI, DI, zl, lane); }
    __device__ __forceinline__ size_t tile_row(int ti) const { return (size_t)bl * RB + (ti < 4 ? 64 * ti : CT + 64 * (tl0 + ti - 4)); }
    __device__ __forceinline__ bool needs(int ti, int wid) const { if (ti < 4) return true; const int kt0 = 64 * (tl0 + ti - 4), qw0 = qb * 256 + 32 * wid; return kt0 <= qw0 + 31 + 128 && kt0 + 63 >= qw0 - 128; }
    __device__ __forceinline__ int skip(int, int) const { return 0; }
    template <int SK> __device__ __forceinline__ void mask(const AttCtx&, int ti, int wid, int r32, int hi, f32x16& p0, f32x16& p1) const {
        if (ti < 4) return;
        const int kt0 = 64 * (tl0 + ti - 4), qw0 = qb * 256 + 32 * wid;
        if (kt0 >= qw0 + 31 - 128 && kt0 + 63 <= qw0 + 128) return;
        const int qt = qw0 + r32;
#pragma unroll
        for (int r = 0; r < 16; ++r) { const int kt = kt0 + crow(r, hi); int d0 = kt - qt; d0 = d0 < 0 ? -d0 : d0; int d1 = kt + 32 - qt; d1 = d1 < 0 ? -d1 : d1;
            if (d0 > 128) p0[r] = -INFINITY; if (d1 > 128) p1[r] = -INFINITY; }
    }
    __device__ __forceinline__ void finish(const AttCtx& C, f32x16 (&o)[2], float m, float l, int wid, int r32, int hi, LAS const unsigned char* zl) const {
        const float mn = fmaxf(m, sinkl2), alpha = ex2(m - mn);
        const float lt = (l + __shfl_xor(l, 32)) * alpha + ex2(sinkl2 - mn);
        const float inv = alpha / lt;
        if (!C.dry) store_gated_l(o, inv, zl, (bf16*)C.QG + off() + (size_t)(wid * 32 + r32) * DI, r32, hi);
    }
};
__device__ __forceinline__ void swa_phase(Frame& F, const Args& a, int g, int dry) {
    int lane_ = pg8::hw_lane(), wave_ = F.wave; asm volatile("" : "+v"(lane_), "+s"(wave_));
    AttCtx C; C.QG = (const bf16*)(a.ws + WS_QG) + (size_t)g * MH * DI; C.Kb = (const bf16*)(a.ws + WS_S2); C.Vb = C.Kb + (size_t)MH * 256; C.Zb = (const bf16*)(a.ws + WS_S4); C.aux = a.in[30]; C.tab = nullptr; C.dry = dry;
    const int G = F.G, vcu = F.vcu;
    auto gen = [&](int i, SwaPol& P) -> bool {
        const int id = i * G + vcu; if (id >= HB * 32 * 8) return false;
        P.qb = (id + i) & 7; P.hq = (id >> 3) & 31; P.bl = id >> 8;
        P.tl0 = max(0, 4 * P.qb - 2); P.ntl = min(31, 4 * P.qb + 5) - P.tl0 + 1; P.sinkl2 = C.aux[P.hq] * LOG2E;
        return true; };
    att::run_stream1<SwaPol, 0>(F.lds, C, gen, wave_, lane_);
}

constexpr int NA_TAB_OFF = RING_BYTES + 512;
struct NaPol {
    static constexpr int EXTRA = 5, NM = 2;
    int bl, hq, qb, krow0, ntl, isctx;
    __device__ __forceinline__ size_t off() const { return ((size_t)bl * RB + (isctx ? 0 : CT + qb * 256)) * DI + hq * 64; }
    __device__ __forceinline__ Src src(const AttCtx& C) const { Src s; s.K[0] = C.Kb + hq * 64; s.K[1] = nullptr; s.V = C.Vb + hq * 64; s.ldk = DI; s.ldv = DI; return s; }
    __device__ __forceinline__ void prep(int ti, int wid, int r32, int hi, f32x16 (&negm)[2]) const {
        if (ti != 4) return;
        const int gc = 32 * (wid & 1) + r32, cs = min(max(gc - 8, 0), 48);
#pragma unroll
        for (int r = 0; r < 16; ++r) { const int kc = crow(r, hi);
            if (!(kc >= cs && kc < cs + 16)) negm[0][r] = -INFINITY;
            if (!(kc + 32 >= cs && kc + 32 < cs + 16)) negm[1][r] = -INFINITY; }
    }
    __device__ __forceinline__ int ntiles() const { return 4 + ntl; }
    __device__ __forceinline__ const bf16* qrow(const AttCtx& C, int wid) const { return C.QG + off() + (size_t)(wid * 32) * DI; }
    __device__ __forceinline__ void stage_extra(const AttCtx& C, LAS unsigned char* zl, int wid, int lane) const {
        att::dma_rows64(C.Zb + off() + (size_t)(wid * 32) * DI, DI, zl, lane);
        att::glds4s(C.aux + hq * 465, (unsigned)min(wid * 64 + lane, 464) * 4u, (unsigned)__builtin_amdgcn_readfirstlane((unsigned)(size_t)C.tab + wid * 256));
    }
    __device__ __forceinline__ size_t tile_row(int ti) const { return (size_t)bl * RB + (ti < 4 ? 64 * ti : CT + 64 * (krow0 + ti - 4)); }
    __device__ __forceinline__ bool needs(int ti, int wid) const { if (ti < 4) return true; const int gr = 4 * qb + (wid >> 1), rs = min(max(gr - 4, 0), 24), kr = krow0 + ti - 4; return kr >= rs && kr < rs + 8; }
    __device__ __forceinline__ int skip(int ti, int wid) const { return ti < 4 ? 0 : 1 + (wid & 1); }
    template <int SK> __device__ __forceinline__ void mask(const AttCtx& C, int ti, int wid, int r32, int hi, f32x16& p0, f32x16& p1) const {
        if (ti < 4) return;
        const int gr = 4 * qb + (wid >> 1), gc = 32 * (wid & 1) + r32, kr = krow0 + ti - 4;
        LAS const float* trow = C.tab + (kr - gr + 7) * 31 + 15 - gc;
#pragma unroll
        for (int r = 0; r < 16; ++r) { const int kc = crow(r, hi);
            if (att::sm_live0<SK>(r)) p0[r] = fmaf(trow[kc], LOG2E, p0[r]);
            if (att::sm_live1<SK>(r)) p1[r] = fmaf(trow[kc + 32], LOG2E, p1[r]);
            if ((r & 3) == 3) __builtin_amdgcn_sched_barrier(0); }
    }
    __device__ __forceinline__ void finish(const AttCtx& C, f32x16 (&o)[2], float m, float l, int wid, int r32, int hi, LAS const unsigned char* zl) const {
        const float inv = 1.f / (l + __shfl_xor(l, 32));
        if (!C.dry) store_gated_l(o, inv, zl, (bf16*)C.QG + off() + (size_t)(wid * 32 + r32) * DI, r32, hi);
    }
};
__device__ __forceinline__ void na_phase(Frame& F, const Args& a, int g, int dry) {
    int lane_ = pg8::hw_lane(), wave_ = F.wave; asm volatile("" : "+v"(lane_), "+s"(wave_));
    AttCtx C; C.QG = (const bf16*)(a.ws + WS_QG) + (size_t)g * MH * DI; C.Kb = (const bf16*)(a.ws + WS_S2); C.Vb = (const bf16*)(a.ws + WS_S3); C.Zb = (const bf16*)(a.ws + WS_S4); C.aux = a.in[27]; C.tab = (LAS const float*)(F.lds + NA_TAB_OFF); C.dry = dry;
    constexpr int NLAT = HB * 32 * 8, NCTX = HB * 32;
    const int G = F.G, vcu = F.vcu;
    auto gen = [&](int i, NaPol& P) -> bool {
        const int id = i * G + vcu; if (id >= NLAT + NCTX) return false;
        if (id < NLAT) { P.isctx = 0; P.qb = (id + i) & 7; P.hq = (id >> 3) & 31; P.bl = id >> 8; P.krow0 = min(max(4 * P.qb - 4, 0), 24); P.ntl = min(max(4 * P.qb + 3 - 4, 0), 24) + 7 - P.krow0 + 1; }
        else { const int j = id - NLAT; P.isctx = 1; P.qb = 0; P.hq = j & 31; P.bl = j >> 5; P.krow0 = 0; P.ntl = 0; }
        return true; };
    if (wave_ & 1) att::run_stream1<NaPol, 2>(F.lds, C, gen, wave_, lane_); else att::run_stream1<NaPol, 1>(F.lds, C, gen, wave_, lane_);
}

template <int COMP>
__device__ __forceinline__ void diff_unit(LAS unsigned char* lds, const Src& src, const bf16* Q  , const bf16* zb, bf16* gb, size_t trow0, int nt, float lam, float lam_init, const float* sg, int wid, int lane, int dry) {
    const int r32 = lane & 31, hi = lane >> 5, wq = wid & 3; constexpr int comp = COMP;
    constexpr int STG = 32768;
    att::dma_issue<128, 2>(src, trow0, lds, wid, lane);
    if (nt > 1) att::dma_issue<128, 2>(src, trow0 + 64, lds + STG, wid, lane);
    bf16x8 qf[4];
    { const bf16* qp = Q + (size_t)(wq * 32 + r32) * DI + comp * 64 + hi * 8;
#pragma unroll
      for (int d0 = 0; d0 < 4; ++d0) qf[d0] = *(const bf16x8*)(qp + d0 * 16); }
    f32x16 o[4];
#pragma unroll
    for (int d0 = 0; d0 < 4; ++d0) o[d0] = f32x16{};
    float m = -INFINITY, l = 0.f; f32x16 negm[1] = {f32x16{}};
    u32x4 pw[4], pwn[4];
    asm volatile("" : "+v"(qf[0]), "+v"(qf[1]), "+v"(qf[2]), "+v"(qf[3]));
    ATT_WAIT_BAR(0);
    if constexpr (COMP == 0) {
        int ic = 0;
        for (int ti = 0; ti < nt; ++ti) {
            LAS unsigned char* cur = lds + ic * STG; LAS unsigned char* prv = lds + ((ic + 3) & 3) * STG;
            if (ti >= 1 && ti + 1 < nt) att::dma_issue<128, 2>(src, trow0 + 64 * (ti + 1), lds + ((ic + 1) & 3) * STG, wid, lane);
            { f32x16 p0, p1; att::qk_tile(cur, qf, r32, hi, p0, p1, negm[0], negm[0]);
              if (ti > 0) att::pv_sm_tile<128, 1>(prv + 16384, lane, hi, pw, o, p0, p1, m, l, pwn, negm); else att::sm_alone<128, 1>(p0, p1, o, m, l, pwn, negm); }
#pragma unroll
            for (int k = 0; k < 4; ++k) pw[k] = pwn[k];
            ATT_WAIT_BAR(0);
            ic = (ic + 1) & 3;
        }
        att::pv_tile<128>(lds + ((ic + 3) & 3) * STG + 16384, lane, hi, pw, o);
    } else {
        f32x16 p0, p1;
        att::qk_tile(lds + 8192, qf, r32, hi, p0, p1, negm[0], negm[0]);
        ATT_WAIT_BAR(0);
        int ic = 1;
        for (int ti = 1; ti < nt; ++ti) {
            LAS unsigned char* cur = lds + ic * STG; LAS unsigned char* pv2 = lds + ((ic + 2) & 3) * STG;
            if (ti + 1 < nt) att::dma_issue<128, 2>(src, trow0 + 64 * (ti + 1), lds + ((ic + 1) & 3) * STG, wid, lane);
            if (ti >= 2) att::pv_sm_tile<128, 1>(pv2 + 16384, lane, hi, pw, o, p0, p1, m, l, pwn, negm); else att::sm_alone<128, 1>(p0, p1, o, m, l, pwn, negm);
#pragma unroll
            for (int k = 0; k < 4; ++k) pw[k] = pwn[k];
            att::qk_tile(cur + 8192, qf, r32, hi, p0, p1, negm[0], negm[0]);
            ATT_WAIT_BAR(0);
            ic = (ic + 1) & 3;
        }
        if (nt >= 2) att::pv_sm_tile<128, 1>(lds + ((ic + 2) & 3) * STG + 16384, lane, hi, pw, o, p0, p1, m, l, pwn, negm); else att::sm_alone<128, 1>(p0, p1, o, m, l, pwn, negm);
#pragma unroll
        for (int k = 0; k < 4; ++k) pw[k] = pwn[k];
        att::pv_tile<128>(lds + ((ic + 3) & 3) * STG + 16384, lane, hi, pw, o);
    }
    ATT_WAIT_BAR(0);
    const float inv = 1.f / (l + __shfl_xor(l, 32));
    LAS float* xb = (LAS float*)lds;
    if (comp == 1) {
#pragma unroll
        for (int d0 = 0; d0 < 4; ++d0)
#pragma unroll
            for (int r = 0; r < 16; ++r) xb[((wq * 64 + d0 * 16 + r) * 64) + lane] = o[d0][r] * inv;
    }
    __syncthreads();
    if (comp == 0 && !dry) {
        float ss = 0.f;
#pragma unroll
        for (int d0 = 0; d0 < 4; ++d0)
#pragma unroll
            for (int r = 0; r < 16; ++r) { const float v = o[d0][r] * inv - lam * xb[((wq * 64 + d0 * 16 + r) * 64) + lane]; o[d0][r] = v; ss += v * v; }
        ss += __shfl_xor(ss, 32);
        const float rs = rsqrtf(ss * (1.f / 128.f) + EPS) * (1.f - lam_init);
        const size_t ro = (size_t)(wq * 32 + r32) * DI;
#pragma unroll
        for (int d0 = 0; d0 < 4; ++d0)
#pragma unroll
            for (int i = 0; i < 4; ++i) { const int d = 32 * d0 + 8 * i + 4 * hi; const f32x4 gg = *(const f32x4*)(sg + d); const u32x2 zw = *(const u32x2*)(zb + ro + d);
                const float v0 = o[d0][4 * i] * rs * gg.x * silu(bflo(zw.x)), v1 = o[d0][4 * i + 1] * rs * gg.y * silu(bfhi(zw.x)), v2 = o[d0][4 * i + 2] * rs * gg.z * silu(bflo(zw.y)), v3 = o[d0][4 * i + 3] * rs * gg.w * silu(bfhi(zw.y));
                u32x2 w; w.x = att::cvtpk(v0, v1); w.y = att::cvtpk(v2, v3); *(u32x2*)(gb + ro + d) = w; }
    }
    asm volatile("s_waitcnt lgkmcnt(0)\n\ts_barrier" ::: "memory");
}
__device__ __forceinline__ void diff_phase(Frame& F, const Args& a, int g, int dry) {
#ifdef MK_TOUCH2
    {
        const int j = F.vcu & 31; unsigned accv = 0u;
        for (size_t off = ((size_t)j * NTHR + F.wave * 64 + pg8::hw_lane()) * 4096; off < (size_t)216 * MiB; off += (size_t)32 * NTHR * 4096) accv += *(const unsigned*)(a.ws + WS_S2 + off);
        for (size_t off = ((size_t)j * NTHR + F.wave * 64 + pg8::hw_lane()) * 4096; off < (size_t)72 * MiB; off += (size_t)32 * NTHR * 4096) accv += *(const unsigned*)(a.ws + WS_QG + (size_t)g * MH * DI * 2 + off);
        asm volatile("" :: "v"(accv));
    }
#endif
    int lane_ = pg8::hw_lane(), wave_ = F.wave; asm volatile("" : "+v"(lane_), "+s"(wave_));
    const bf16* QG = (const bf16*)(a.ws + WS_QG) + (size_t)g * MH * DI; const bf16* Kb = (const bf16*)(a.ws + WS_S2); const bf16* Vb = (const bf16*)(a.ws + WS_S3); const bf16* Zb = (const bf16*)(a.ws + WS_S4);
    const float lam_init = 0.8f - 0.6f * expf(-0.3f);
    float sa = 0.f, sb = 0.f;
    for (int i = 0; i < 64; ++i) { sa += a.in[20][i] * a.in[21][i]; sb += a.in[22][i] * a.in[23][i]; }
    const float lam = expf(sa) - expf(sb) + lam_init;
    constexpr int NLAT = HB * 16 * 16, NCTX = HB * 16 * 2;
    const int G = F.G, vcu = F.vcu; LAS unsigned char* lds = F.lds; const float* sg = a.in[24];
    auto units = [&](auto cc) {
        constexpr int COMP = decltype(cc)::value;
        for (int i = 0;; ++i) {
            const int id = i * G + vcu; if (id >= NLAT + NCTX) break;
            int bl, h, qb, nt; size_t row0;
            if (id < NLAT) { qb = id & 15; h = (id >> 4) & 15; bl = id >> 8; nt = RB / 64; row0 = (size_t)bl * RB + CT + qb * 128; }
            else { const int j = id - NLAT; qb = j & 1; h = (j >> 1) & 15; bl = j >> 5; nt = CT / 64; row0 = (size_t)bl * RB + qb * 128; }
            Src s; s.K[0] = Kb + (2 * h) * 64; s.K[1] = Kb + (2 * h + 1) * 64; s.V = Vb + h * 128; s.ldk = DI; s.ldv = DI;
            diff_unit<COMP>(lds, s, QG + row0 * DI + h * 128, Zb + row0 * DI + h * 128, (bf16*)QG + row0 * DI + h * 128, (size_t)bl * RB, nt, lam, lam_init, sg, wave_, lane_, dry);
        }
    };
    if (wave_ >> 2) units(std::integral_constant<int, 1>{}); else units(std::integral_constant<int, 0>{});
}
}
namespace mk {
typedef float f32x4v __attribute__((ext_vector_type(4)));
__device__ __forceinline__ void seq_bounds(int row, int& lo, int& hi) { const int rr = row % RB, b0 = row - rr; if (rr < CT) { lo = b0; hi = b0 + CT; } else { lo = b0 + CT; hi = b0 + RB; } }

#ifndef MK_GATES_Q
#define MK_GATES_Q 4
#endif
__device__ __forceinline__ void mlstm_gates_phase(Frame& F, const Args& a, int g) {
    int lane = pg8::hw_lane(), wave = F.wave; asm volatile("" : "+v"(lane), "+s"(wave));
    const bf16* XM = (const bf16*)(a.ws + WS_S2); const bf16* W2 = (const bf16*)(a.ws + WS_WG2);
    bf16* XC = g == 0 ? (bf16*)(a.ws + WS_QG) + (size_t)MH * DI : (bf16*)(a.ws + WS_H);
    const float* cw = a.in[9]; const float* cb = a.in[10]; const float* bg = a.in[15];
    LAS float* T = (LAS float*)F.lds;
    constexpr int G_W2S = 12288, G_XS = G_W2S + 64 * 1040;
    const int khw = (int)blockIdx.x & 3;
    { const int tid = wave * 64 + lane;
      for (int i = tid; i < 5 * 128; i += NTHR) { const int j = i >> 7, c4 = (i & 127) * 4; *(LAS f32x4v*)(T + j * 512 + c4) = *(const f32x4v*)(cw + j * 2048 + khw * 512 + c4); }
      for (int i = tid; i < 128; i += NTHR) *(LAS f32x4v*)(T + 2560 + 4 * i) = *(const f32x4v*)(cb + khw * 512 + 4 * i);
      for (int i = tid; i < 64 * 64; i += NTHR) { const int rw = i >> 6, c8 = (i & 63) * 8;
          *(LAS u32x4*)(F.lds + G_W2S + (rw * 520 + c8) * 2) = *(const u32x4*)(W2 + (size_t)(rw >> 1) * 4096 + (rw & 1) * 2048 + khw * 512 + c8); }
      __syncthreads(); }
    const int r = lane & 15, kq = lane >> 4;
    LAS unsigned char* xs = F.lds + G_XS + wave * 5440;
    const int kh = khw;
    float* gates = (float*)(a.ws + (kh == 0 ? WS_GATES : kh == 1 ? WS_GATES2 : kh == 2 ? WS_GATES3 : WS_GATES4));
    for (int grp = ((int)blockIdx.x >> 2) + 64 * wave; grp < MH / 16; grp += 64 * NWAVES) {
        const int row0 = grp * 16, row = row0 + r; int lo, hi; seq_bounds(row0, lo, hi);
        pg8::f32x4 acc0 = {0.f, 0.f, 0.f, 0.f}, acc1 = {0.f, 0.f, 0.f, 0.f};
        u32x4 xg[5];
#define ML_GLOAD(sb_) do { _Pragma("unroll") for (int j = 0; j < 5; ++j) { const int sr = row0 - 2 + 4 * j + (lane >> 4); \
            xg[j] = (sr >= lo && sr < hi) ? *(const u32x4*)(XM + (size_t)sr * DI + kh * 512 + (sb_) * 128 + (lane & 15) * 8) : (u32x4){0u, 0u, 0u, 0u}; } } while (0)
        ML_GLOAD(0);
        for (int sb = 0; sb < 4; ++sb) {
#pragma unroll
            for (int j = 0; j < 5; ++j) *(LAS u32x4*)(xs + (4 * j + (lane >> 4)) * 272 + (lane & 15) * 16) = xg[j];
            if (sb + 1 < 4) ML_GLOAD(sb + 1);
#pragma unroll
            for (int q = 0; q < 4; ++q) { const int cl = sb * 128 + q * 32 + 8 * kq, c0 = kh * 512 + cl;
                LAS const unsigned char* wl = F.lds + G_W2S + cl * 2; LAS const unsigned char* xl = xs + r * 272 + (q * 32 + 8 * kq) * 2;
                const bf16x8 wf0 = *(LAS const bf16x8*)(wl + (2 * r) * 1040), wf1 = *(LAS const bf16x8*)(wl + (2 * (r + 16)) * 1040), wf2 = *(LAS const bf16x8*)(wl + (2 * r + 1) * 1040), wf3 = *(LAS const bf16x8*)(wl + (2 * (r + 16) + 1) * 1040);
                const f32x4v b0 = *(LAS const f32x4v*)(T + 2560 + cl), b1 = *(LAS const f32x4v*)(T + 2560 + cl + 4);
                float av[8] = {b0.x, b0.y, b0.z, b0.w, b1.x, b1.y, b1.z, b1.w};
                u32x4 xmid;
#pragma unroll
                for (int j = 0; j < 5; ++j) { const u32x4 x = *(LAS const u32x4*)(xl + j * 272); if (j == 2) xmid = x;
                    const f32x4v w0 = *(LAS const f32x4v*)(T + j * 512 + cl), w1 = *(LAS const f32x4v*)(T + j * 512 + cl + 4);
                    av[0] += bflo(x.x) * w0.x; av[1] += bfhi(x.x) * w0.y; av[2] += bflo(x.y) * w0.z; av[3] += bfhi(x.y) * w0.w;
                    av[4] += bflo(x.z) * w1.x; av[5] += bfhi(x.z) * w1.y; av[6] += bflo(x.w) * w1.z; av[7] += bfhi(x.w) * w1.w; }
                u32x4 xcw; xcw.x = att::cvtpk(silu(av[0]), silu(av[1])); xcw.y = att::cvtpk(silu(av[2]), silu(av[3])); xcw.z = att::cvtpk(silu(av[4]), silu(av[5])); xcw.w = att::cvtpk(silu(av[6]), silu(av[7]));
                *(u32x4*)(XC + (size_t)row * DI + c0) = xcw;
                const bf16x8 axc = __builtin_bit_cast(bf16x8, xcw), axm = __builtin_bit_cast(bf16x8, xmid);
                acc0 = __builtin_amdgcn_mfma_f32_16x16x32_bf16(axc, wf0, acc0, 0, 0, 0); acc1 = __builtin_amdgcn_mfma_f32_16x16x32_bf16(axc, wf1, acc1, 0, 0, 0);
                acc0 = __builtin_amdgcn_mfma_f32_16x16x32_bf16(axm, wf2, acc0, 0, 0, 0); acc1 = __builtin_amdgcn_mfma_f32_16x16x32_bf16(axm, wf3, acc1, 0, 0, 0); }
            asm volatile("s_waitcnt lgkmcnt(0)" ::: "memory");
        }
#undef ML_GLOAD
        const float bg0 = kh == 0 ? bg[r] : 0.f, bg1 = kh == 0 ? bg[16 + r] : 0.f;
#pragma unroll
        for (int rg = 0; rg < 4; ++rg) { const size_t tk = (size_t)grp * 16 + 4 * kq + rg; gates[tk * 32 + r] = acc0[rg] + bg0; gates[tk * 32 + 16 + r] = acc1[rg] + bg1; }
    }
    __syncthreads();
}

#define ML_BAR() asm volatile("s_waitcnt lgkmcnt(0)\n\ts_barrier" ::: "memory")
#ifndef MK_SC_A
#define MK_SC_A 1
#endif
#ifndef MK_SC_B
#define MK_SC_B 1
#endif
constexpr int ML_QS = 0, ML_KS = 33792, ML_VS = 67584, ML_P = 84992, ML_HO = 94208, ML_F = 110592;
constexpr int ML_W1 = RING_BYTES + 512  , ML_WV = 115200  ;
constexpr int ML_KSTR = 528, ML_VSTR = 272, ML_PSTR = 144;
__device__ __forceinline__ int ml_row(int base, int dir, int s) { return base + (dir == 0 ? s : (s < CT ? CT - 1 - s : CT + (S - 1) - (s - CT))); }
__device__ __forceinline__ s16x4 ml_tr(LAS const unsigned char* p) { return __builtin_bit_cast(s16x4, __builtin_amdgcn_ds_read_tr16_b64_v4i16((LAS att::v4i16_t*)p)); }
__device__ __forceinline__ void mlstm_scan_phase(Frame& F, const Args& a, int g) {
    int tid0 = F.wave * 64 + pg8::hw_lane(); asm volatile("" : "+v"(tid0));
    const int wid = __builtin_amdgcn_readfirstlane(tid0 >> 6);
    const int u = F.vcu; if (u >= HB * 8 * 2 * 2) return;
    const int dvh = u & 1, dir = (u >> 1) & 1, h = (u >> 2) & 7, bl = u >> 5;
    const bf16* XM = (const bf16*)(a.ws + WS_S2); const float* gates = (const float*)(a.ws + WS_GATES); const float* gates2 = (const float*)(a.ws + WS_GATES2); const float* gates3 = (const float*)(a.ws + WS_GATES3); const float* gates4 = (const float*)(a.ws + WS_GATES4);
    const bf16* XC = g == 0 ? (const bf16*)(a.ws + WS_QG) + (size_t)MH * DI : (const bf16*)(a.ws + WS_H);
    bf16* Hd = dir == 0 ? (bf16*)(a.ws + WS_QG) + (size_t)g * MH * DI : (bf16*)(a.ws + WS_S4);
    const float* cw = a.in[9]; const float* cb = a.in[10]; const float* wq = a.in[11]; const float* wk = a.in[12]; const float* wv = a.in[13];
    LAS unsigned char* L = F.lds; LAS float* Ff = (LAS float*)(L + ML_F);
    pg8::f32x4 C[16];
#pragma unroll
    for (int i = 0; i < 16; ++i) C[i] = (pg8::f32x4){0.f, 0.f, 0.f, 0.f};
    int tid = tid0;
    if (tid < 256) { Ff[640 + tid] = 0.f; }
    {
        LAS float* W1 = (LAS float*)(L + ML_W1); LAS float* WV = (LAS float*)(L + ML_WV);
        for (int i = tid; i < 5 * 256; i += NTHR) W1[i] = cw[(i >> 8) * DI + h * 256 + (i & 255)];
        if (tid < 256) W1[1280 + tid] = cb[h * 256 + tid];
        for (int i = tid; i < 1024; i += NTHR) { W1[1536 + i] = wq[h * 1024 + i]; W1[2560 + i] = wk[h * 1024 + i]; WV[i] = wv[h * 1024 + i]; }
        __syncthreads();
    }
    LAS const float* W1 = (LAS const float*)(L + ML_W1); LAS const float* WV = (LAS const float*)(L + ML_WV);
    bf16x8 aq[2], ak[2], av_[2], aql[2], akl[2], avl[2];
    { const int o = tid0 & 15, g4 = (tid0 >> 4) & 3;
#pragma unroll
      for (int n = 0; n < 2; ++n) { const int bo = 4 * n + (o >> 2); u32x4 fq, fk, fv, lq, lk, lv; unsigned* pq = (unsigned*)&fq; unsigned* pk_ = (unsigned*)&fk; unsigned* pv_ = (unsigned*)&fv; unsigned* qq_ = (unsigned*)&lq; unsigned* qk_ = (unsigned*)&lk; unsigned* qv_ = (unsigned*)&lv;
#pragma unroll
          for (int jp = 0; jp < 4; ++jp) { float q2[2], k2[2], v2[2], q2l[2], k2l[2], v2l[2];
#pragma unroll
              for (int e = 0; e < 2; ++e) { const int j = 2 * jp + e, bi = 2 * g4 + (j >> 2); const bool nz = bi == bo; const int gb = wid * 8 + bo, idx = gb * 16 + (j & 3) * 4 + (o & 3);
                  q2[e] = nz ? W1[1536 + idx] : 0.f; k2[e] = nz ? W1[2560 + idx] * 0.0625f : 0.f; v2[e] = nz ? WV[idx] : 0.f;
                  q2l[e] = q2[e] - bf2f((unsigned short)f2bf(q2[e])); k2l[e] = k2[e] - bf2f((unsigned short)f2bf(k2[e])); v2l[e] = v2[e] - bf2f((unsigned short)f2bf(v2[e])); }
              pq[jp] = pk2(q2[0], q2[1]); pk_[jp] = pk2(k2[0], k2[1]); pv_[jp] = pk2(v2[0], v2[1]);
              qq_[jp] = pk2(q2l[0], q2l[1]); qk_[jp] = pk2(k2l[0], k2l[1]); qv_[jp] = pk2(v2l[0], v2l[1]); }
          aq[n] = __builtin_bit_cast(bf16x8, fq); ak[n] = __builtin_bit_cast(bf16x8, fk); av_[n] = __builtin_bit_cast(bf16x8, fv);
          aql[n] = __builtin_bit_cast(bf16x8, lq); akl[n] = __builtin_bit_cast(bf16x8, lk); avl[n] = __builtin_bit_cast(bf16x8, lv); } }
    const int base = bl * RB;
    u32x4 xw[8];
#define ML_LOADX(cc) do { const int rlo_ = dir ? ml_row(base, 1, (cc) * 64 + 63) : ml_row(base, 0, (cc) * 64); \
        const size_t o_ = (size_t)(rlo_ + (tid0 & 15)) * DI + h * 256 + wid * 32 + ((tid0 >> 4) & 3) * 8; \
        _Pragma("unroll") for (int i_ = 0; i_ < 4; ++i_) { xw[i_] = *(const u32x4*)(XM + o_ + (size_t)(16 * i_) * DI); xw[4 + i_] = *(const u32x4*)(XC + o_ + (size_t)(16 * i_) * DI); } } while (0)
    float gpre[8] = {0.f, 0.f, 0.f, 0.f, 0.f, 0.f, 0.f, 0.f};
#define ML_LOADG(cc) do { if (wid == 0) { const size_t gi_ = (size_t)ml_row(base, dir, (cc) * 64 + (tid0 & 63)) * 32 + (2 * dir) * 8 + h; \
        gpre[0] = gates[gi_]; gpre[1] = gates2[gi_]; gpre[2] = gates3[gi_]; gpre[3] = gates4[gi_]; gpre[4] = gates[gi_ + 8]; gpre[5] = gates2[gi_ + 8]; gpre[6] = gates3[gi_ + 8]; gpre[7] = gates4[gi_ + 8]; } } while (0)
    ML_LOADX(0); ML_LOADG(0);
    for (int c = 0; c < RB / 64; ++c) {
        const int par = c & 1;
        tid = tid0; asm volatile("" : "+v"(tid));
        const int lane = tid & 63, l15 = lane & 15, gq = lane >> 4;
#pragma unroll 1
        for (int repA_ = 0; repA_ < MK_SC_A; ++repA_) {
        {
            const bool hasv = (wid >> 2) == dvh;
            const pg8::f32x4 z4 = {0.f, 0.f, 0.f, 0.f};
#pragma unroll
            for (int tt = 0; tt < 4; ++tt) {
                const bf16x8 bxm = __builtin_bit_cast(bf16x8, xw[tt]), bxc = __builtin_bit_cast(bf16x8, xw[4 + tt]);
                const int mrow = 16 * tt + l15, t = dir ? 63 - mrow : mrow;
#pragma unroll
                for (int n = 0; n < 2; ++n) {
                    const pg8::f32x4 dq = __builtin_amdgcn_mfma_f32_16x16x32_bf16(aq[n], bxc, __builtin_amdgcn_mfma_f32_16x16x32_bf16(aql[n], bxc, z4, 0, 0, 0), 0, 0, 0), dk = __builtin_amdgcn_mfma_f32_16x16x32_bf16(ak[n], bxc, __builtin_amdgcn_mfma_f32_16x16x32_bf16(akl[n], bxc, z4, 0, 0, 0), 0, 0, 0);
                    const int cl = wid * 32 + 16 * n + 4 * gq;
                    u32x2 w2; w2.x = att::cvtpk(dq[0], dq[1]); w2.y = att::cvtpk(dq[2], dq[3]); *(LAS u32x2*)(L + ML_QS + t * ML_KSTR + cl * 2) = w2;
                    w2.x = att::cvtpk(dk[0], dk[1]); w2.y = att::cvtpk(dk[2], dk[3]); *(LAS u32x2*)(L + ML_KS + t * ML_KSTR + cl * 2) = w2;
                    if (hasv) { const pg8::f32x4 dv = __builtin_amdgcn_mfma_f32_16x16x32_bf16(av_[n], bxm, __builtin_amdgcn_mfma_f32_16x16x32_bf16(avl[n], bxm, z4, 0, 0, 0), 0, 0, 0);
                        w2.x = att::cvtpk(dv[0], dv[1]); w2.y = att::cvtpk(dv[2], dv[3]); *(LAS u32x2*)(L + ML_VS + t * ML_VSTR + (cl & 127) * 2) = w2; }
                }
            }
        }
#if defined(MK_SC_G2)
        for (int repg_ = 0; repg_ < 2; ++repg_)
#endif
        if (wid == 0) {
            const float gi = (gpre[0] + gpre[1]) + (gpre[2] + gpre[3]), gf = (gpre[4] + gpre[5]) + (gpre[6] + gpre[7]);
            const float lf = fminf(gf, 0.f) - log1pf(__expf(-fabsf(gf)));
            float b = lf;
#pragma unroll
            for (int o = 1; o < 64; o <<= 1) { const float y = __shfl_up(b, o); if (lane >= o) b += y; }
            const float bend = __shfl(b, 63);
            Ff[lane] = b * LOG2E; Ff[64 + lane] = (gi - b) * LOG2E; Ff[128 + lane] = __expf(b); Ff[192 + lane] = __expf(bend - b + gi);
            if (lane == 0) Ff[576] = __expf(bend);
        }
        }
        ML_BAR();
#if defined(MK_SC_L2)
        if (c + 1 < RB / 64) { ML_LOADX(c + 1); ML_LOADG(c + 1); asm volatile("" : "+v"(xw[0]), "+v"(xw[1]), "+v"(xw[2]), "+v"(xw[3]), "+v"(xw[4]), "+v"(xw[5]), "+v"(xw[6]), "+v"(xw[7])); }
#endif
        if (c + 1 < RB / 64) { ML_LOADX(c + 1); ML_LOADG(c + 1); }
        for (int repB_ = 0; repB_ < MK_SC_B; ++repB_) {
        {
            const int si = wid >> 1;
            pg8::f32x4 st[2] = {{0.f, 0.f, 0.f, 0.f}, {0.f, 0.f, 0.f, 0.f}};
            LAS const unsigned char* kp = L + ML_KS + (16 * si + l15) * ML_KSTR + gq * 16;
            LAS const unsigned char* qp0 = L + ML_QS + (16 * (2 * (wid & 1)) + l15) * ML_KSTR + gq * 16;
#pragma unroll
            for (int ks = 0; ks < 8; ++ks) {
                const bf16x8 ka = *(LAS const bf16x8*)(kp + ks * 64);
                const bf16x8 q0 = *(LAS const bf16x8*)(qp0 + ks * 64), q1 = *(LAS const bf16x8*)(qp0 + 16 * ML_KSTR + ks * 64);
                st[0] = __builtin_amdgcn_mfma_f32_16x16x32_bf16(ka, q0, st[0], 0, 0, 0);
                st[1] = __builtin_amdgcn_mfma_f32_16x16x32_bf16(ka, q1, st[1], 0, 0, 0);
            }
            const f32x4v al = *(LAS const f32x4v*)(Ff + 64 + 16 * si + 4 * gq);
            const float alv[4] = {al.x, al.y, al.z, al.w};
#pragma unroll
            for (int e = 0; e < 2; ++e) {
                const int ti = 2 * (wid & 1) + e, t = 16 * ti + l15; const float bt = Ff[t];
                float pv[4], rsum = 0.f;
#pragma unroll
                for (int r = 0; r < 4; ++r) { const int s = 16 * si + 4 * gq + r; const float wgt = (s <= t) ? att::ex2(bt + alv[r]) : 0.f; pv[r] = st[e][r] * wgt; rsum += pv[r]; }
                u32x2 w2; w2.x = att::cvtpk(pv[0], pv[1]); w2.y = att::cvtpk(pv[2], pv[3]);
                *(LAS u32x2*)(L + ML_P + t * ML_PSTR + (16 * si + 4 * gq) * 2) = w2;
                rsum += __shfl_xor(rsum, 16); rsum += __shfl_xor(rsum, 32);
                if (gq == 0) Ff[320 + si * 64 + t] = rsum;
            }
        }
        {
            const int t = tid >> 3, part = tid & 7; LAS const float* np_ = Ff + 640 + par * 256 + part * 32; LAS const unsigned char* qrow = L + ML_QS + t * ML_KSTR + part * 64;
            float acc = 0.f;
#pragma unroll
            for (int i = 0; i < 4; ++i) { const u32x4 qw = *(LAS const u32x4*)(qrow + i * 16); const f32x4v n0 = *(LAS const f32x4v*)(np_ + i * 8), n1 = *(LAS const f32x4v*)(np_ + i * 8 + 4);
                acc += bflo(qw.x) * n0.x + bfhi(qw.x) * n0.y + bflo(qw.y) * n0.z + bfhi(qw.y) * n0.w + bflo(qw.z) * n1.x + bfhi(qw.z) * n1.y + bflo(qw.w) * n1.z + bfhi(qw.w) * n1.w; }
            acc += __shfl_xor(acc, 1); acc += __shfl_xor(acc, 2); acc += __shfl_xor(acc, 4);
            if (part == 0) Ff[256 + t] = acc * Ff[128 + t];
        }
        if (tid < 256) {
            float nn = Ff[576] * Ff[640 + par * 256 + tid];
#pragma unroll
            for (int s = 0; s < 64; s += 4) { const f32x4v w4 = *(LAS const f32x4v*)(Ff + 192 + s); LAS const unsigned char* kc = L + ML_KS + s * ML_KSTR + tid * 2;
                nn += (w4.x * bf2f(*(LAS const unsigned short*)kc) + w4.y * bf2f(*(LAS const unsigned short*)(kc + ML_KSTR))) + (w4.z * bf2f(*(LAS const unsigned short*)(kc + 2 * ML_KSTR)) + w4.w * bf2f(*(LAS const unsigned short*)(kc + 3 * ML_KSTR))); }
            Ff[640 + (par ^ 1) * 256 + tid] = nn;
        }
        }
        ML_BAR();
        {
            pg8::f32x4 y[4];
#if defined(MK_SC_SYNC)
            ML_BAR(); __syncthreads(); __syncthreads();
#endif
#if defined(MK_SC_QC2)
            for (int repq_ = 0; repq_ < 2; ++repq_)
#endif
            {
#pragma unroll
            for (int tt = 0; tt < 4; ++tt) y[tt] = (pg8::f32x4){0.f, 0.f, 0.f, 0.f};
            {
                u32x2 qa[2][4], qb[2][4];
#define ML_QRD(ks_, b_) do { _Pragma("unroll") for (int tt = 0; tt < 4; ++tt) { LAS const unsigned char* qp = L + ML_QS + (16 * tt + l15) * ML_KSTR + (32 * (ks_) + 4 * gq) * 2; qa[b_][tt] = *(LAS const u32x2*)qp; qb[b_][tt] = *(LAS const u32x2*)(qp + 32); } } while (0)
                ML_QRD(0, 0);
#pragma unroll
                for (int ks = 0; ks < 8; ++ks) {
                    if (ks + 1 < 8) ML_QRD(ks + 1, (ks + 1) & 1);
                    u32x4 cw4; cw4.x = att::cvtpk(C[2 * ks][0], C[2 * ks][1]); cw4.y = att::cvtpk(C[2 * ks][2], C[2 * ks][3]); cw4.z = att::cvtpk(C[2 * ks + 1][0], C[2 * ks + 1][1]); cw4.w = att::cvtpk(C[2 * ks + 1][2], C[2 * ks + 1][3]);
                    const bf16x8 cf = __builtin_bit_cast(bf16x8, cw4);
                    __builtin_amdgcn_sched_barrier(0);
#pragma unroll
                    for (int tt = 0; tt < 4; ++tt) { const u32x4 qq = {qa[ks & 1][tt].x, qa[ks & 1][tt].y, qb[ks & 1][tt].x, qb[ks & 1][tt].y};
                        y[tt] = __builtin_amdgcn_mfma_f32_16x16x32_bf16(__builtin_bit_cast(bf16x8, qq), cf, y[tt], 0, 0, 0); }
                    __builtin_amdgcn_sched_barrier(0);
                }
#undef ML_QRD
            }
            }
#pragma unroll
            for (int tt = 0; tt < 4; ++tt) { const f32x4v e4 = *(LAS const f32x4v*)(Ff + 128 + 16 * tt + 4 * gq); y[tt][0] *= e4.x; y[tt][1] *= e4.y; y[tt][2] *= e4.z; y[tt][3] *= e4.w; }
            bf16x8 vf[2];
            { LAS const unsigned char* vb = L + ML_VS + (8 * gq + (l15 >> 2)) * ML_VSTR + (16 * wid + 4 * (lane & 3)) * 2;
#pragma unroll
              for (int k2 = 0; k2 < 2; ++k2) { const s16x4 lo = ml_tr(vb + k2 * 32 * ML_VSTR), hi4 = ml_tr(vb + k2 * 32 * ML_VSTR + 4 * ML_VSTR); vf[k2] = (bf16x8){lo[0], lo[1], lo[2], lo[3], hi4[0], hi4[1], hi4[2], hi4[3]}; } }
#pragma unroll
            for (int k2 = 0; k2 < 2; ++k2)
#pragma unroll
                for (int tt = 0; tt < 4; ++tt) { const bf16x8 pa = *(LAS const bf16x8*)(L + ML_P + (16 * tt + l15) * ML_PSTR + (32 * k2 + 8 * gq) * 2);
                    y[tt] = __builtin_amdgcn_mfma_f32_16x16x32_bf16(pa, vf[k2], y[tt], 0, 0, 0); }
#pragma unroll
            for (int tt = 0; tt < 4; ++tt)
#pragma unroll
                for (int r = 0; r < 4; ++r) { const int t = 16 * tt + 4 * gq + r;
                    *(LAS unsigned short*)(L + ML_HO + t * 256 + (16 * wid + l15) * 2) = (unsigned short)f2bf(y[tt][r]); }
            const float ebend = Ff[576];
#pragma unroll
            for (int i = 0; i < 16; ++i) C[i] = C[i] * ebend;
            bf16x8 vw[2];
#pragma unroll
            for (int k2 = 0; k2 < 2; ++k2) { const f32x4v w0 = *(LAS const f32x4v*)(Ff + 192 + 32 * k2 + 8 * gq), w1 = *(LAS const f32x4v*)(Ff + 192 + 32 * k2 + 8 * gq + 4);
                const u32x4 vv = __builtin_bit_cast(u32x4, vf[k2]); u32x4 o;
                o.x = att::cvtpk(bflo(vv.x) * w0.x, bfhi(vv.x) * w0.y); o.y = att::cvtpk(bflo(vv.y) * w0.z, bfhi(vv.y) * w0.w); o.z = att::cvtpk(bflo(vv.z) * w1.x, bfhi(vv.z) * w1.y); o.w = att::cvtpk(bflo(vv.w) * w1.z, bfhi(vv.w) * w1.w);
                vw[k2] = __builtin_bit_cast(bf16x8, o); }
            LAS const unsigned char* kb = L + ML_KS + (8 * gq + (l15 >> 2)) * ML_KSTR + (4 * (lane & 3)) * 2;
            {
                s16x4 klo[2][2], khi[2][2];
#define ML_KRD(dt_, b_) do { _Pragma("unroll") for (int k2 = 0; k2 < 2; ++k2) { klo[b_][k2] = ml_tr(kb + k2 * 32 * ML_KSTR + (dt_) * 32); khi[b_][k2] = ml_tr(kb + k2 * 32 * ML_KSTR + 4 * ML_KSTR + (dt_) * 32); } } while (0)
                ML_KRD(0, 0);
#pragma unroll
                for (int dt = 0; dt < 16; ++dt) {
                    if (dt + 1 < 16) ML_KRD(dt + 1, (dt + 1) & 1);
                    __builtin_amdgcn_sched_barrier(0);
#pragma unroll
                    for (int k2 = 0; k2 < 2; ++k2) { const s16x4 lo = klo[dt & 1][k2], hi4 = khi[dt & 1][k2];
                        const bf16x8 ka = {lo[0], lo[1], lo[2], lo[3], hi4[0], hi4[1], hi4[2], hi4[3]};
                        C[dt] = __builtin_amdgcn_mfma_f32_16x16x32_bf16(ka, vw[k2], C[dt], 0, 0, 0); }
                    __builtin_amdgcn_sched_barrier(0);
                }
#undef ML_KRD
            }
        }
        ML_BAR();
#if defined(MK_SC_W2)
        for (int repw_ = 0; repw_ < 2; ++repw_)
#endif
#pragma unroll
        for (int it = 0; it < 2; ++it) { const int idx = tid + it * NTHR, t = idx >> 4, pc = idx & 15; const int row = ml_row(base, dir, c * 64 + t);
            const float den = Ff[256 + t] + (Ff[320 + t] + Ff[384 + t]) + (Ff[448 + t] + Ff[512 + t]);
            const float rd = 1.f / fmaxf(fabsf(den), 1.f);
            const u32x4 yv = *(LAS const u32x4*)(L + ML_HO + t * 256 + pc * 16); u32x4 hv;
            hv.x = att::cvtpk(bflo(yv.x) * rd, bfhi(yv.x) * rd); hv.y = att::cvtpk(bflo(yv.y) * rd, bfhi(yv.y) * rd); hv.z = att::cvtpk(bflo(yv.z) * rd, bfhi(yv.z) * rd); hv.w = att::cvtpk(bflo(yv.w) * rd, bfhi(yv.w) * rd);
            *(u32x4*)(Hd + (size_t)row * DI + h * 256 + dvh * 128 + pc * 8) = hv; }
    }
}

__device__ __forceinline__ void mlstm_out_phase(Frame& F, const Args& a, int g, int dry) {
    int lane = pg8::hw_lane(), wave = F.wave; asm volatile("" : "+v"(lane), "+s"(wave));
    const bf16* XC = g == 0 ? (const bf16*)(a.ws + WS_QG) + (size_t)MH * DI : (const bf16*)(a.ws + WS_H); const bf16* Z = (const bf16*)(a.ws + WS_S3); const bf16* HB2 = (const bf16*)(a.ws + WS_S4); bf16* HF = (bf16*)(a.ws + WS_QG) + (size_t)g * MH * DI;
    const float* ng = a.in[16]; const float* skip = a.in[17];
    const int gw = F.vcu * NWAVES + wave, NGW = F.G * NWAVES;
    for (int it0 = gw; it0 < MH * 8; it0 += 2 * NGW) {
        u32x2 hf[2], hb[2], xcw[2], zw[2]; f32x4v gg[2], sk[2]; size_t o[2];
#pragma unroll
        for (int u = 0; u < 2; ++u) { int it = it0 + u * NGW; if (it >= MH * 8) it = it0; const int row = it >> 3, h = it & 7, ch = h * 256 + lane * 4; o[u] = (size_t)row * DI + ch;
            hf[u] = *(const u32x2*)(HF + o[u]); hb[u] = *(const u32x2*)(HB2 + o[u]); xcw[u] = *(const u32x2*)(XC + o[u]); zw[u] = *(const u32x2*)(Z + o[u]);
            gg[u] = *(const f32x4v*)(ng + ch); sk[u] = *(const f32x4v*)(skip + ch); }
#pragma unroll
        for (int u = 0; u < 2; ++u) {
            const float hs[4] = {bflo(hf[u].x) + bflo(hb[u].x), bfhi(hf[u].x) + bfhi(hb[u].x), bflo(hf[u].y) + bflo(hb[u].y), bfhi(hf[u].y) + bfhi(hb[u].y)};
            const float mu = wave_sum((hs[0] + hs[1]) + (hs[2] + hs[3])) * (1.f / 256.f);
            const float d[4] = {hs[0] - mu, hs[1] - mu, hs[2] - mu, hs[3] - mu};
            const float rstd = rsqrtf(wave_sum((d[0] * d[0] + d[1] * d[1]) + (d[2] * d[2] + d[3] * d[3])) * (1.f / 256.f) + EPS);
            const float xcv[4] = {bflo(xcw[u].x), bfhi(xcw[u].x), bflo(xcw[u].y), bfhi(xcw[u].y)}, z[4] = {bflo(zw[u].x), bfhi(zw[u].x), bflo(zw[u].y), bfhi(zw[u].y)};
            const float ggv[4] = {gg[u].x, gg[u].y, gg[u].z, gg[u].w}, skv[4] = {sk[u].x, sk[u].y, sk[u].z, sk[u].w};
            float ov[4];
#pragma unroll
            for (int i = 0; i < 4; ++i) ov[i] = (d[i] * rstd * ggv[i] + skv[i] * xcv[i]) * silu(z[i]);
            u32x2 w; w.x = att::cvtpk(ov[0], ov[1]); w.y = att::cvtpk(ov[2], ov[3]); if (!dry && (u == 0 || it0 + NGW < MH * 8)) *(u32x2*)(HF + o[u]) = w;
        }
    }
}
}
namespace mk {
enum { P_PRO = 0, P_PRO2 = 1, P_NORM0 = 2, P_L0 = 3  , P_OUT0 = 11, P_NORM1 = 12, P_L1 = 13  , P_OUT1 = 17, P_NORM2 = 18, P_L2 = 19  , P_OUT2 = 23, P_NORM3 = 24, P_L3 = 25  , P_OUT3 = 29, P_FINAL = 30, P_END = 31 };

__global__ void __launch_bounds__(NTHR, 2) mega(Args a) {
    extern __shared__ __attribute__((aligned(16))) unsigned char lds_raw[];
    Frame F;
    F.lds = (LAS unsigned char*)lds_raw;
    F.wave = __builtin_amdgcn_readfirstlane((int)threadIdx.x >> 6); F.lane = pg8::hw_lane(); F.tid = F.wave * 64 + F.lane;
    F.G = gridDim.x; { const int bx = blockIdx.x; F.vcu = (F.G % 8 == 0) ? (bx % 8) * (F.G / 8) + bx / 8 : bx; }
    volatile LAS unsigned* MISC = (volatile LAS unsigned*)(F.lds + MISC_OFF);
    for (int u = F.tid; u < (LDS_BYTES - RING_BYTES) / 4; u += NTHR) ((LAS unsigned*)(F.lds + RING_BYTES))[u] = 0u;
    __syncthreads();
    XcdBarrier bar = xcd_barrier_post((unsigned*)(a.ws + WS_CTL) + CW_BAR, MISC + 8, (unsigned)F.wave);
    const int lo = a.ph_lo, hi = a.ph_hi;
#ifndef MK_REP_GEMM
#define MK_REP_GEMM 1
#endif
#ifndef MK_REP_ATT
#define MK_REP_ATT 1
#endif
#ifndef MK_REP_MISC
#define MK_REP_MISC 1
#endif
#ifndef MK_GEMM_ALIGN
#define MK_GEMM_ALIGN true
#endif
#ifndef MK_GEMM_SP2
#define MK_GEMM_SP2 true
#endif
#ifndef MK_REP_WC
#define MK_REP_WC 1
#endif
#ifndef MK_REP_SYNC
#define MK_REP_SYNC 0
#endif
#ifndef MK_REP_DIFF
#define MK_REP_DIFF MK_REP_ATT
#endif
#ifndef MK_REP_NA
#define MK_REP_NA MK_REP_ATT
#endif
#ifndef MK_REP_SWA
#define MK_REP_SWA MK_REP_ATT
#endif
#ifndef MK_REP_SCAN
#define MK_REP_SCAN 1
#endif
#ifndef MK_REP_GATES
#define MK_REP_GATES MK_REP_SCAN
#endif
#ifndef MK_SITES
#define MK_SITES 0xFFFFFFFFu
#endif
#define ON(b) (((MK_SITES) >> (b)) & 1u)
#ifdef MK_PARTIAL
#define IN(k) (lo <= (k) && (k) < hi)
#else
#define IN(k) true
#endif
#ifndef MK_REP_BAR
#define MK_REP_BAR 1
#endif
#ifdef MK_TP
    long long tp_acc = 0, tp_prev = wall_clock64(), tp_t0 = 0;
#define TP_PRE(k) tp_t0 = wall_clock64();
#define TP_POST(k) { long long n_ = wall_clock64(); if ((MK_TP_MASK >> (k)) & 1u) tp_acc += n_ - (MK_TP == 1 ? tp_t0 : tp_prev); tp_prev = n_; }
#else
#define TP_PRE(k)
#define TP_POST(k)
#endif
#define SEAM(k) do { if (IN(k) && IN((k) + 1)) { TP_PRE(k) for (int rb_ = 0; rb_ < MK_REP_BAR; ++rb_) xcd_barrier(bar); TP_POST(k) } } while (0)
    const int gw = F.vcu * NWAVES + F.wave, NGW = F.G * NWAVES;
#define WSB ([&]() { unsigned char* p_ = a.ws; asm volatile("" : "+s"(p_)); return p_; }())
#define xs (a.out)
#define ctxs ((float*)(WSB + WS_CTXS))
#define xsb ((bf16*)a.out)
#define ctxb ((bf16*)(WSB + WS_CTXS))
#define x3b ((bf16*)(WSB + WS_S3))
#define mod ((const float*)(WSB + WS_MOD))
#define WinA ((bf16*)(WSB + WS_WIN))
#define WoutA ((bf16*)(WSB + WS_WOUT))
#define WinB ((bf16*)(WSB + WS_W2))
#define WoutB ((bf16*)(WSB + WS_W2 + 16 * MiB))
#define H ((bf16*)(WSB + WS_H))
#define QG ((bf16*)(WSB + WS_QG))
#define ssq ((float*)(WSB + WS_SSQ))
#define shw ((const float*)(WSB + WS_SHW))
#define S2 ((bf16*)(WSB + WS_S2))
#define S3 ((bf16*)(WSB + WS_S3))
#define S4 ((bf16*)(WSB + WS_S4))
#define rope ((const float*)(WSB + WS_ROPE))
    const float QSC = 0.125f * LOG2E;

    if (ON(0) && IN(P_PRO)) prologue_phase(F, a);
    SEAM(P_PRO);
    if (ON(0) && IN(P_PRO2)) { prologue2_phase(F, a); for (int rw_ = 0; rw_ < MK_REP_WC; ++rw_) wconv(F, a.in[8], 4096, a.in[18], WinA, WoutA, gw, NGW); }
    SEAM(P_PRO2);
    if (ON(1) && IN(P_NORM0)) { for (int rep = 0; rep < MK_REP_MISC; ++rep) norm_phase(F, a.in[0], a.in[2], a.in[4], mod, H); }
    SEAM(P_NORM0);
#if MK_HAVE_L0
    for (int g = 0; g < 2; ++g) {
        if (ON(2) && IN(P_L0 + 4 * g)) {
            pg8::Gemm gm{H + (size_t)g * MH * D, WinA, MH, 4096, D}; pg8::StaticOrder So; So.init(MH, 4096, F.G, (int)blockIdx.x);
            EpiProj<false> E{S2, S3, S3, S3, DI, DI, DI, DI, 8, 16, 16, 0u, 1.f, rope, nullptr, nullptr, 0};
            for (int rep = 0; rep < MK_REP_GEMM; ++rep) { if (MK_REP_SYNC && rep) xcd_barrier(bar); pg8::gemm_phase<EpiProj<false>, pg8::StaticOrder, MK_GEMM_ALIGN, MK_GEMM_SP2>(F.lds, gm, So, E, F.wave); }
        }
        SEAM(P_L0 + 4 * g);
        if (ON(17) && IN(P_L0 + 4 * g + 1)) for (int rep = 0; rep < MK_REP_GATES; ++rep) mlstm_gates_phase(F, a, g);
        SEAM(P_L0 + 4 * g + 1);
        if (ON(18) && IN(P_L0 + 4 * g + 2)) for (int rep = 0; rep < MK_REP_SCAN; ++rep) mlstm_scan_phase(F, a, g);
        SEAM(P_L0 + 4 * g + 2);
        if (ON(19) && IN(P_L0 + 4 * g + 3)) for (int rep = 0; rep < MK_REP_MISC; ++rep) mlstm_out_phase(F, a, g, rep + 1 < MK_REP_MISC);
        SEAM(P_L0 + 4 * g + 3);
    }
#endif
    constexpr int RHEAD = 128 * 256;
    if (ON(3) && IN(P_OUT0)) {
        pg8::Gemm gm{QG, WoutA, MT, D, DI}; pg8::StaticOrder So; So.init(RHEAD, D, F.G, (int)blockIdx.x);
        for (int rep = 0; rep < MK_REP_GEMM; ++rep) { if (MK_REP_SYNC && rep) xcd_barrier(bar); EpiResidT<float, bf16> E{a.in[0], a.in[2], xsb, ctxb, mod, 1, rep + 1 < MK_REP_GEMM, nullptr, nullptr, nullptr, nullptr};
        pg8::gemm_phase<EpiResidT<float, bf16>, pg8::StaticOrder, MK_GEMM_ALIGN, MK_GEMM_SP2>(F.lds, gm, So, E, F.wave); }
    }
    SEAM(P_OUT0);
    if (ON(3) && IN(P_OUT0)) {
        if (blockIdx.x < 64) { pg8::Gemm gm{QG, WoutA, MT, D, DI}; OutTailOrder So; So.init(F.G, (int)blockIdx.x); EpiResidT<float, bf16> E{a.in[0], a.in[2], xsb, ctxb, mod, 1, 0, nullptr, nullptr, nullptr, nullptr};
            pg8::gemm_phase<EpiResidT<float, bf16>, OutTailOrder, MK_GEMM_ALIGN, MK_GEMM_SP2>(F.lds, gm, So, E, F.wave); }
        else { wconv(F, a.in[19], 8192, a.in[25], WinB, WoutB, ((int)blockIdx.x - 64) * NWAVES + F.wave, (F.G - 64) * NWAVES);
            if (ON(4)) norm_phase(F, xsb, ctxb, a.in[4] + 1024, mod + 17 * 3072, H, 0, RHEAD, 64); }
    }
    SEAM(P_OUT0);
    for (int g = 0; g < 2; ++g) {
        if (ON(5) && IN(P_L1 + 2 * g)) {
            if (g == 0 && ON(4)) norm_phase(F, xsb, ctxb, a.in[4] + 1024, mod + 17 * 3072, H, RHEAD, MT);
            pg8::Gemm gm{H + (size_t)g * MH * D, WinB, MH, 8192, D}; pg8::StaticOrder So; So.init(MH, 8192, F.G, (int)blockIdx.x);
            EpiProj<true, false> E{QG + (size_t)g * MH * DI, S2, S3, S4, DI, DI, DI, DI, 8, 16, 24, 3u, QSC, rope, ssq, shw, g * MH};
#ifdef MK_STAGGER
            if (blockIdx.x >= 128) { const long long t0_ = wall_clock64(); while (wall_clock64() - t0_ < MK_STAGGER) __builtin_amdgcn_s_sleep(8); }
#endif
            for (int rep = 0; rep < MK_REP_GEMM; ++rep) { if (MK_REP_SYNC && rep) xcd_barrier(bar); pg8::gemm_phase<EpiProj<true, false>, pg8::StaticOrder, MK_GEMM_ALIGN, MK_GEMM_SP2>(F.lds, gm, So, E, F.wave); }
        }
        SEAM(P_L1 + 2 * g);
        if (ON(6) && IN(P_L1 + 2 * g + 1)) for (int rep = 0; rep < MK_REP_DIFF; ++rep) { if (MK_REP_SYNC && rep) xcd_barrier(bar); diff_phase(F, a, g, rep + 1 < MK_REP_DIFF); }
        SEAM(P_L1 + 2 * g + 1);
    }
    if (ON(7) && IN(P_OUT1)) {
        pg8::Gemm gm{QG, WoutB, MT, D, DI}; pg8::StaticOrder So; So.init(RHEAD, D, F.G, (int)blockIdx.x);
        for (int rep = 0; rep < MK_REP_GEMM; ++rep) { if (MK_REP_SYNC && rep) xcd_barrier(bar); EpiResidT<bf16, bf16> E{xsb, ctxb, xsb, ctxb, mod + 17 * 3072, 1, rep + 1 < MK_REP_GEMM, nullptr, nullptr, nullptr, nullptr};
        pg8::gemm_phase<EpiResidT<bf16, bf16>, pg8::StaticOrder, MK_GEMM_ALIGN, MK_GEMM_SP2>(F.lds, gm, So, E, F.wave); }
    }
    SEAM(P_OUT1);
    if (ON(7) && IN(P_OUT1)) {
        if (blockIdx.x < 64) { pg8::Gemm gm{QG, WoutB, MT, D, DI}; OutTailOrder So; So.init(F.G, (int)blockIdx.x); EpiResidT<bf16, bf16> E{xsb, ctxb, xsb, ctxb, mod + 17 * 3072, 1, 0, nullptr, nullptr, nullptr, nullptr};
            pg8::gemm_phase<EpiResidT<bf16, bf16>, OutTailOrder, MK_GEMM_ALIGN, MK_GEMM_SP2>(F.lds, gm, So, E, F.wave); }
        else { wconv(F, a.in[26], 8192, a.in[28], WinA, WoutA, ((int)blockIdx.x - 64) * NWAVES + F.wave, (F.G - 64) * NWAVES);
            if (ON(8)) norm_phase(F, xsb, ctxb, a.in[4] + 2048, mod + 2 * 17 * 3072, H, 0, RHEAD, 64); }
    }
    SEAM(P_OUT1);
    for (int g = 0; g < 2; ++g) {
        if (ON(9) && IN(P_L2 + 2 * g)) {
            if (g == 0 && ON(8)) norm_phase(F, xsb, ctxb, a.in[4] + 2048, mod + 2 * 17 * 3072, H, RHEAD, MT);
            pg8::Gemm gm{H + (size_t)g * MH * D, WinA, MH, 8192, D}; pg8::StaticOrder So; So.init(MH, 8192, F.G, (int)blockIdx.x);
            EpiProj<false, false> E{QG + (size_t)g * MH * DI, S2, S3, S4, DI, DI, DI, DI, 8, 16, 24, 0u, QSC, rope, ssq, shw + 17 * 8192, g * MH};
#ifdef MK_STAGGER
            if (blockIdx.x >= 128) { const long long t0_ = wall_clock64(); while (wall_clock64() - t0_ < MK_STAGGER) __builtin_amdgcn_s_sleep(8); }
#endif
            for (int rep = 0; rep < MK_REP_GEMM; ++rep) { if (MK_REP_SYNC && rep) xcd_barrier(bar); pg8::gemm_phase<EpiProj<false, false>, pg8::StaticOrder, MK_GEMM_ALIGN, MK_GEMM_SP2>(F.lds, gm, So, E, F.wave); }
        }
        SEAM(P_L2 + 2 * g);
        if (ON(10) && IN(P_L2 + 2 * g + 1)) for (int rep = 0; rep < MK_REP_NA; ++rep) { if (MK_REP_SYNC && rep) xcd_barrier(bar); na_phase(F, a, g, rep + 1 < MK_REP_NA); }
        SEAM(P_L2 + 2 * g + 1);
    }
    if (ON(11) && IN(P_OUT2)) {
        pg8::Gemm gm{QG, WoutA, MT, D, DI}; pg8::StaticOrder So; So.init(RHEAD, D, F.G, (int)blockIdx.x);
        for (int rep = 0; rep < MK_REP_GEMM; ++rep) { if (MK_REP_SYNC && rep) xcd_barrier(bar); EpiResidT<bf16, bf16> E{xsb, ctxb, x3b, ctxb, mod + 2 * 17 * 3072, 1, rep + 1 < MK_REP_GEMM, nullptr, nullptr, nullptr, nullptr};
        pg8::gemm_phase<EpiResidT<bf16, bf16>, pg8::StaticOrder, MK_GEMM_ALIGN, MK_GEMM_SP2>(F.lds, gm, So, E, F.wave); }
    }
    SEAM(P_OUT2);
    if (ON(11) && IN(P_OUT2)) {
        if (blockIdx.x < 64) { pg8::Gemm gm{QG, WoutA, MT, D, DI}; OutTailOrder So; So.init(F.G, (int)blockIdx.x); EpiResidT<bf16, bf16> E{xsb, ctxb, x3b, ctxb, mod + 2 * 17 * 3072, 1, 0, nullptr, nullptr, nullptr, nullptr};
            pg8::gemm_phase<EpiResidT<bf16, bf16>, OutTailOrder, MK_GEMM_ALIGN, MK_GEMM_SP2>(F.lds, gm, So, E, F.wave); }
        else { wconv(F, a.in[29], 4608, a.in[31], WinB, WoutB, ((int)blockIdx.x - 64) * NWAVES + F.wave, (F.G - 64) * NWAVES);
            if (ON(12)) norm_phase(F, x3b, ctxb, a.in[4] + 3072, mod + 3 * 17 * 3072, H, 0, RHEAD, 64); }
    }
    SEAM(P_OUT2);
    for (int g = 0; g < 2; ++g) {
        if (ON(13) && IN(P_L3 + 2 * g)) {
            if (g == 0 && ON(12)) norm_phase(F, x3b, ctxb, a.in[4] + 3072, mod + 3 * 17 * 3072, H, RHEAD, MT);
            pg8::Gemm gm{H + (size_t)g * MH * D, WinB, MH, 4608, D}; L3Order So; So.init(F.G, (int)blockIdx.x);
            EpiProj<true, false> E{QG + (size_t)g * MH * DI, S2, S2 + (size_t)MH * 256, S4, DI, 256, 256, DI, 8, 9, 10, 3u, QSC, rope, ssq, shw + 2 * 17 * 8192, g * MH};
            for (int rep = 0; rep < MK_REP_GEMM; ++rep) { if (MK_REP_SYNC && rep) xcd_barrier(bar); pg8::gemm_phase<EpiProj<true, false>, L3Order, MK_GEMM_ALIGN, MK_GEMM_SP2>(F.lds, gm, So, E, F.wave); }
        }
        SEAM(P_L3 + 2 * g);
        if (ON(14) && IN(P_L3 + 2 * g + 1)) for (int rep = 0; rep < MK_REP_SWA; ++rep) { if (MK_REP_SYNC && rep) xcd_barrier(bar); swa_phase(F, a, g, rep + 1 < MK_REP_SWA); }
        SEAM(P_L3 + 2 * g + 1);
    }
    if (ON(15) && IN(P_OUT3)) {
        pg8::Gemm gm{QG, WoutB, MT, D, DI}; LatOnlyOrder So; So.init(F.G, (int)blockIdx.x);
        for (int rep = 0; rep < MK_REP_GEMM; ++rep) { if (MK_REP_SYNC && rep) xcd_barrier(bar); EpiResidT<bf16, float> E{x3b, ctxb, xs, ctxs, mod + 3 * 17 * 3072, 0, rep + 1 < MK_REP_GEMM, nullptr, nullptr, nullptr, nullptr};
        pg8::gemm_phase<EpiResidT<bf16, float>, LatOnlyOrder, MK_GEMM_ALIGN, MK_GEMM_SP2>(F.lds, gm, So, E, F.wave); }
    }
    SEAM(P_OUT3);
    if (ON(16) && IN(P_FINAL)) final_norm_phase(F, xs, a.in[7]);
#ifdef MK_TP
    {
        if (MK_TP == 2) TP_POST(P_FINAL)
        unsigned long long* tpw = (unsigned long long*)(a.ws + WS_CTL + 32768);
        if (F.wave == 0 && pg8::hw_lane() == 0) __hip_atomic_fetch_add(tpw, (unsigned long long)tp_acc, __ATOMIC_RELAXED, __HIP_MEMORY_SCOPE_AGENT);
        xcd_barrier(bar);
        const unsigned long long sum = __hip_atomic_load(tpw, __ATOMIC_RELAXED, __HIP_MEMORY_SCOPE_AGENT);
        const long long wait = (long long)(sum / 256) * MK_TP_K, ts = wall_clock64();
        while (wall_clock64() - ts < wait) __builtin_amdgcn_s_sleep(32);
    }
#endif
#undef IN
#undef SEAM
#undef WSB
#undef xs
#undef ctxs
#undef xsb
#undef ctxb
#undef x3b
#undef mod
#undef WinA
#undef WoutA
#undef WinB
#undef WoutB
#undef H
#undef QG
#undef ssq
#undef shw
#undef S2
#undef S3
#undef S4
#undef rope
}

inline void launch_mega(void* const* d_in, void* d_out, void* d_ws, int lo, int hi, hipStream_t stream) {
    static int inited = 0;
    if (!inited) { (void)hipFuncSetAttribute((const void*)mega, hipFuncAttributeMaxDynamicSharedMemorySize, LDS_BYTES); inited = 1; }
    (void)hipMemsetAsync((char*)d_ws + WS_CTL, 0, CTL_BYTES, stream);
    Args a{};
    for (int i = 0; i < 32; ++i) a.in[i] = (const float*)d_in[i];
    a.out = (float*)d_out; a.ws = (unsigned char*)d_ws; a.ph_lo = lo; a.ph_hi = hi;
    hipLaunchKernelGGL(mega, dim3(256), dim3(NTHR), LDS_BYTES, stream, a);
}
}
extern "C" void kernel_launch(void* const* d_in, const int* in_sizes, int n_in, void* d_out, int out_size, void* d_ws, size_t ws_size, hipStream_t stream) {
    mk::launch_mega(d_in, d_out, d_ws, mk::P_PRO, mk::P_END, stream);
}
```

```cpp
#include <hip/hip_runtime.h>
#include <cstdint>
#include <cstdio>
#include <cmath>
#define MK_HAVE_L0 1
namespace pg8 {
#define PG8_LAS __attribute__((address_space(3)))
typedef unsigned short bf16_t;
typedef short bf16x8 __attribute__((ext_vector_type(8)));
typedef float f32x4 __attribute__((ext_vector_type(4)));
typedef unsigned u32x4 __attribute__((ext_vector_type(4)));
__device__ __forceinline__ int hw_lane() { int l; asm volatile("v_mbcnt_lo_u32_b32 %0, -1, 0\n\tv_mbcnt_hi_u32_b32 %0, -1, %0" : "=v"(l)); return l; }
constexpr int BM = 256, BK = 64, HALF = 128, HTB = HALF * BK * 2  , STAGE_BYTES = 8 * HTB, NXCD = 8, WGM = 8;

__host__ __device__ __forceinline__ int lds_byte(int r, int c) { const int st = (r >> 4) * 2 + (c >> 5), rr = r & 15, cc = c & 31, ob = rr * 64 + cc * 2; return st * 1024 + (ob ^ (((ob >> 9) & 1) << 5)); }
__host__ __device__ __forceinline__ void stage_rc(int b, int& R, int& C) { const int st = b / 1024, sb = b % 1024, swz = sb ^ (((sb >> 9) & 1) << 5); R = (st >> 1) * 16 + swz / 64; C = (st & 1) * 32 + (swz % 64) / 2; }
__host__ __device__ __forceinline__ int perm32(int rho) { const int n = rho >> 4, i = rho & 15; return 8 * (i >> 2) + 4 * n + (i & 3); }

struct Unit { int pm, pn; };
struct Gemm { const bf16_t* A; const bf16_t* Bt; int M, N, K; };

struct StaticOrder {
    int nM, nN, nwg, G, c;
    __host__ __device__ void init(int M, int N, int G_, int c_) { nM = M / BM; nN = N / BM; nwg = nM * nN; G = G_; c = c_; }
    __host__ __device__ bool next(int i, Unit& u) const {
        const long L = (long)i * G + c; if (L >= nwg) return false;
        int wgid = (int)L; { const int q = nwg / NXCD, r = nwg % NXCD, xcd = wgid % NXCD, off = wgid / NXCD; wgid = (xcd < r ? xcd * (q + 1) : r * (q + 1) + (xcd - r) * q) + off; }
        const int nig = WGM * nN, gid = wgid / nig, fm = gid * WGM, gsz = (nM - fm) < WGM ? (nM - fm) : WGM;
        u.pm = fm + ((wgid % nig) % gsz); u.pn = (wgid % nig) / gsz; return true;
    }
    __device__ __forceinline__ void a_ready(const Unit&) const {}
    __device__ __forceinline__ void done(const Unit&) const {}
};

__device__ __forceinline__ unsigned cvt_pk_bf16(float lo, float hi) { unsigned r; asm volatile("v_cvt_pk_bf16_f32 %0, %1, %2" : "=v"(r) : "v"(lo), "v"(hi)); return r; }
typedef float f32x2 __attribute__((ext_vector_type(2)));
template <class Epi, class Sched, bool ALIGN_EPI = false, bool SP2 = false>
__device__ __forceinline__ void gemm_phase(PG8_LAS unsigned char* lds, const Gemm g, const Sched& S, const Epi& E, int wave_id) {
    int tid_ = wave_id * 64 + hw_lane(); asm volatile("" : "+v"(tid_));
    const int tid = tid_, wid = __builtin_amdgcn_readfirstlane(tid >> 6), lane = tid & 63, wr = wid >> 2, wc = wid & 3, fr = lane & 15, fq = lane >> 4;
    const int K = g.K, nt = K / BK;
    unsigned voffA[2], voffB[2];
#pragma unroll
    for (int i = 0; i < 2; ++i) { int R, C; stage_rc(tid * 16 + i * 8192, R, C); const int Rb = Epi::PERM ? ((R & ~31) + perm32(R & 31)) : R;
        voffA[i] = (unsigned)(R * K + C) * 2u; voffB[i] = (unsigned)(Rb * K + C) * 2u; }
    const size_t kstep = (size_t)(BK * 2);
    const size_t hstep = (size_t)HALF * K * 2;
    const size_t tstep = 2 * hstep;
    const unsigned ldsw = (unsigned)wid * 1024u;
    const int aoff = lds_byte(wr * 64 + fr, fq * 8), boff = lds_byte(wc * 32 + fr, fq * 8);
#define PG8_SA(b, h) (((b) * 2 + (h)) * HTB)
#define PG8_SB(b, h) ((4 + (b) * 2 + (h)) * HTB)
#define PG8_STAGE(bufoff, gbase, voff) do { _Pragma("unroll") for (int _i = 0; _i < 2; ++_i) \
        __builtin_amdgcn_global_load_lds((const unsigned*)((const char*)(gbase) + (voff)[_i]), (PG8_LAS unsigned*)(lds + (bufoff) + ldsw + _i * 8192), 16, 0, 0); } while (0)
#define PG8_LDA(dst, b, h) do { _Pragma("unroll") for (int m = 0; m < 4; ++m) _Pragma("unroll") for (int k = 0; k < 2; ++k) dst[m][k] = *(const PG8_LAS bf16x8*)(lds + PG8_SA(b, h) + aoff + m * 2048 + k * 1024); } while (0)
#define PG8_LDB(dst, b, h) do { _Pragma("unroll") for (int n = 0; n < 2; ++n) _Pragma("unroll") for (int k = 0; k < 2; ++k) dst[n][k] = *(const PG8_LAS bf16x8*)(lds + PG8_SB(b, h) + boff + n * 2048 + k * 1024); } while (0)
#define PG8_MMA(ai, bj, At, Bt) do { __builtin_amdgcn_s_setprio(1); _Pragma("unroll") for (int m = 0; m < 4; ++m) _Pragma("unroll") for (int n = 0; n < 2; ++n) _Pragma("unroll") for (int k = 0; k < 2; ++k) \
        acc[ai][bj][m][n] = __builtin_amdgcn_mfma_f32_16x16x32_bf16(Bt[n][k], At[m][k], acc[ai][bj][m][n], 0, 0, 0); __builtin_amdgcn_s_setprio(0); } while (0)
#define PG8_WAIT_V(n) asm volatile("s_waitcnt vmcnt(" #n ")" ::: "memory")
#define PG8_WAIT_L(n) asm volatile("s_waitcnt lgkmcnt(" #n ")" ::: "memory")
#define PG8_BAR __builtin_amdgcn_s_barrier()
#define PG8_SCHED __builtin_amdgcn_sched_barrier(0)
    Unit cur, nxt; int ui = 0;
    if (!S.next(0, cur)) return;
    f32x4 acc[2][2][4][2];
#pragma unroll
    for (int a = 0; a < 2; ++a)
#pragma unroll
        for (int b = 0; b < 2; ++b)
#pragma unroll
            for (int m = 0; m < 4; ++m)
#pragma unroll
                for (int n = 0; n < 2; ++n) acc[a][b][m][n] = (f32x4){0.f, 0.f, 0.f, 0.f};
    bf16x8 At[4][2], B0[2][2], B1[2][2];
    const char* cA = (const char*)g.A + (size_t)cur.pm * tstep; const char* cB = (const char*)g.Bt + (size_t)cur.pn * tstep;
    S.a_ready(cur);
    if constexpr (SP2) {
        PG8_STAGE(PG8_SB(0, 0), cB, voffB); PG8_STAGE(PG8_SB(0, 1), cB + hstep, voffB); PG8_STAGE(PG8_SA(0, 0), cA, voffA); PG8_STAGE(PG8_SA(0, 1), cA + hstep, voffA);
        if (wr == 1) PG8_BAR;
        PG8_WAIT_V(2); PG8_BAR;
        PG8_STAGE(PG8_SB(1, 0), cB + kstep, voffB); PG8_STAGE(PG8_SA(1, 0), cA + kstep, voffA); PG8_STAGE(PG8_SB(1, 1), cB + hstep + kstep, voffB);
        PG8_WAIT_V(6); PG8_BAR;
    } else {
        PG8_STAGE(PG8_SB(0, 0), cB, voffB); PG8_STAGE(PG8_SA(0, 0), cA, voffA); PG8_STAGE(PG8_SB(0, 1), cB + hstep, voffB); PG8_STAGE(PG8_SA(0, 1), cA + hstep, voffA);
        if (wr == 1) PG8_BAR;
        PG8_WAIT_V(4); PG8_BAR;
        PG8_STAGE(PG8_SB(1, 0), cB + kstep, voffB); PG8_STAGE(PG8_SA(1, 0), cA + kstep, voffA); PG8_STAGE(PG8_SB(1, 1), cB + hstep + kstep, voffB);
        PG8_WAIT_V(6); PG8_BAR;
    }
    for (;;) {
        const bool has_next = S.next(ui + 1, nxt);
        const char* nA = has_next ? (const char*)g.A + (size_t)nxt.pm * tstep : cA; const char* nB = has_next ? (const char*)g.Bt + (size_t)nxt.pn * tstep : cB;
        for (int t = 0; t < nt; t += 2) {
            const bool last = (t == nt - 2);
            const char* a1 = cA + (size_t)(t + 1) * kstep;
            const char* a2 = last ? nA : cA + (size_t)(t + 2) * kstep; const char* b2 = last ? nB : cB + (size_t)(t + 2) * kstep;
            const char* a3 = a2 + kstep; const char* b3 = b2 + kstep;
            if (last && has_next) S.a_ready(nxt);
            if constexpr (SP2) {
            PG8_LDB(B0, 0, 0); PG8_LDB(B1, 0, 1); PG8_SCHED; PG8_LDA(At, 0, 0); PG8_STAGE(PG8_SA(1, 1), a1 + hstep, voffA);
            PG8_WAIT_V(8); PG8_WAIT_L(0); PG8_BAR; PG8_MMA(0, 0, At, B0); PG8_MMA(0, 1, At, B1); PG8_BAR; PG8_SCHED;
            PG8_LDA(At, 0, 1); PG8_STAGE(PG8_SB(0, 0), b2, voffB); PG8_STAGE(PG8_SB(0, 1), b2 + hstep, voffB); PG8_STAGE(PG8_SA(0, 0), a2, voffA);
            PG8_WAIT_V(8); PG8_WAIT_L(0); PG8_BAR; PG8_MMA(1, 0, At, B0); PG8_MMA(1, 1, At, B1); PG8_BAR; PG8_SCHED;
            PG8_LDB(B0, 1, 0); PG8_LDB(B1, 1, 1); PG8_SCHED; PG8_LDA(At, 1, 0); PG8_STAGE(PG8_SA(0, 1), a2 + hstep, voffA);
            PG8_WAIT_V(8); PG8_WAIT_L(0); PG8_BAR; PG8_MMA(0, 0, At, B0); PG8_MMA(0, 1, At, B1); PG8_BAR; PG8_SCHED;
            PG8_LDA(At, 1, 1); PG8_STAGE(PG8_SB(1, 0), b3, voffB); PG8_STAGE(PG8_SB(1, 1), b3 + hstep, voffB); PG8_STAGE(PG8_SA(1, 0), a3, voffA);
            PG8_WAIT_V(8); PG8_WAIT_L(0); PG8_BAR; PG8_MMA(1, 0, At, B0); PG8_MMA(1, 1, At, B1); PG8_BAR; PG8_SCHED;
            } else {
            PG8_LDB(B0, 0, 0); PG8_SCHED; PG8_LDA(At, 0, 0); PG8_STAGE(PG8_SA(1, 1), a1 + hstep, voffA);
            PG8_WAIT_L(8); PG8_BAR; PG8_WAIT_L(0); PG8_MMA(0, 0, At, B0); PG8_BAR; PG8_SCHED;
            PG8_LDB(B1, 0, 1); PG8_STAGE(PG8_SB(0, 0), b2, voffB);
            PG8_BAR; PG8_WAIT_L(0); PG8_MMA(0, 1, At, B1); PG8_BAR;
            PG8_LDA(At, 0, 1); PG8_STAGE(PG8_SA(0, 0), a2, voffA);
            PG8_BAR; PG8_WAIT_L(0); PG8_MMA(1, 0, At, B0); PG8_BAR; PG8_SCHED;
            PG8_STAGE(PG8_SB(0, 1), b2 + hstep, voffB);
            PG8_WAIT_V(6); PG8_BAR; PG8_MMA(1, 1, At, B1); PG8_BAR;
            PG8_LDB(B0, 1, 0); PG8_SCHED; PG8_LDA(At, 1, 0); PG8_STAGE(PG8_SA(0, 1), a2 + hstep, voffA);
            PG8_WAIT_L(8); PG8_BAR; PG8_WAIT_L(0); PG8_MMA(0, 0, At, B0); PG8_BAR; PG8_SCHED;
            PG8_LDB(B1, 1, 1); PG8_STAGE(PG8_SB(1, 0), b3, voffB);
            PG8_BAR; PG8_WAIT_L(0); PG8_MMA(0, 1, At, B1); PG8_BAR;
            PG8_LDA(At, 1, 1); PG8_STAGE(PG8_SA(1, 0), a3, voffA);
            PG8_BAR; PG8_WAIT_L(0); PG8_MMA(1, 0, At, B0); PG8_BAR; PG8_SCHED;
            PG8_STAGE(PG8_SB(1, 1), b3 + hstep, voffB);
            PG8_WAIT_V(6); PG8_BAR; PG8_MMA(1, 1, At, B1); PG8_BAR;
            }
        }
        if constexpr (ALIGN_EPI) { if (wr == 0) PG8_BAR; }
#if defined(MK_EXP_EPI2)
        if constexpr (!Epi::AFTER_DRAIN && Epi::PERM) { E.template run<(MK_EXP_EPI2 == 2)>(acc, cur, wr, wc, fr, fq); }
#endif
        if constexpr (!Epi::AFTER_DRAIN) { E(acc, cur, wr, wc, fr, fq); S.done(cur); }
        if (!has_next) break;
#pragma unroll
        for (int a = 0; a < 2; ++a)
#pragma unroll
            for (int b = 0; b < 2; ++b)
#pragma unroll
                for (int m = 0; m < 4; ++m)
#pragma unroll
                    for (int n = 0; n < 2; ++n) acc[a][b][m][n] = (f32x4){0.f, 0.f, 0.f, 0.f};
        cur = nxt; cA = nA; cB = nB; ++ui;
        if constexpr (ALIGN_EPI) { if (wr == 1) PG8_BAR; }
    }
    PG8_WAIT_V(0);
    if constexpr (!ALIGN_EPI) { if (wr == 0) PG8_BAR; }
    PG8_BAR;
    if constexpr (Epi::AFTER_DRAIN) { E.fused(acc, cur, wr, wc, fr, fq, lds, wid, lane); S.done(cur); }
#undef PG8_SA
#undef PG8_SB
#undef PG8_STAGE
#undef PG8_LDA
#undef PG8_LDB
#undef PG8_MMA
#undef PG8_WAIT_V
#undef PG8_WAIT_L
#undef PG8_BAR
#undef PG8_SCHED
}
}
#define GAS __attribute__((address_space(1)))
#define LAS __attribute__((address_space(3)))
typedef unsigned short bf16;
typedef unsigned v4u __attribute__((ext_vector_type(4)));
typedef float f32x4 __attribute__((ext_vector_type(4)));
typedef short bf16x8 __attribute__((ext_vector_type(8)));
typedef GAS unsigned gu32;
typedef GAS unsigned long long gu64;
#define RLX_AGENT __ATOMIC_RELAXED, __HIP_MEMORY_SCOPE_AGENT
#define LDS_WAIT() asm volatile("s_waitcnt lgkmcnt(0)" ::: "memory")
#define VM_WAIT() asm volatile("s_waitcnt vmcnt(0)" ::: "memory")
__device__ __forceinline__ unsigned long long rt() { return __builtin_amdgcn_s_memrealtime(); }
__device__ __forceinline__ unsigned f2bf(float f) { unsigned u = __builtin_bit_cast(unsigned, f); return (u + 0x7fffu + ((u >> 16) & 1u)) >> 16; }
__device__ __forceinline__ unsigned pk2(float lo, float hi) { return f2bf(lo) | (f2bf(hi) << 16); }
#define XB_TMO      128
#define XB_XCNT(j)  (256  + 64 * (j))
#define XB_XSUB(j)  (1280 + 64 * (j))
#define XB_XGEN(j)  (2304 + 64 * (j))
#define XB_TOP      3328
#define XB_TOPGEN   3392
#define XCD_BAR_WORDS 3456
#define XB_SPIN_CAP (1u << 18)

__device__ __forceinline__ unsigned xb_ld(unsigned* p)              { return __hip_atomic_load(p, __ATOMIC_RELAXED, __HIP_MEMORY_SCOPE_AGENT); }
__device__ __forceinline__ unsigned xb_add(unsigned* p, unsigned v) { return __hip_atomic_fetch_add(p, v, __ATOMIC_RELAXED, __HIP_MEMORY_SCOPE_AGENT); }
__device__ __forceinline__ unsigned xb_xcc_id() { return (unsigned)__builtin_amdgcn_s_getreg((3 << 11) | 20) & 0xFu; }
#define XB_SPIN(cond, bar) do { unsigned _sp = 0; while (cond) { __builtin_amdgcn_s_sleep(1); \
    if ((++_sp & 255u) == 0u) { if (xb_ld(&(bar)[XB_TMO])) break; if (_sp > XB_SPIN_CAP) { atomicAdd(&(bar)[XB_TMO], 1u); break; } } } } while (0)

struct XcdBarrier {
    unsigned* bar; unsigned x; unsigned w;
    volatile LAS unsigned* st;
};

__device__ __forceinline__ XcdBarrier xcd_barrier_post(unsigned* bar, volatile LAS unsigned* st, unsigned wave) {
    XcdBarrier b; b.bar = bar; b.x = xb_xcc_id(); b.st = st; b.w = wave;
    if (b.w == 0u && pg8::hw_lane() == 0) (void)xb_add(&bar[XB_XCNT(b.x)], 1u);
    return b;
}
__device__ __forceinline__ void xcd_barrier_complete(unsigned* bar, unsigned x, unsigned& nloc, unsigned& nx) {
    const unsigned G = gridDim.x * gridDim.y * gridDim.z;
    unsigned sum, cnt, mine, sp = 0u;
    for (;;) {
        sum = 0u; cnt = 0u; mine = 0u;
#pragma unroll
        for (unsigned j = 0; j < 16; ++j) { const unsigned c = xb_ld(&bar[XB_XCNT(j)]); sum += c; cnt += (c > 0u) ? 1u : 0u; mine = (j == x) ? c : mine; }
        if (sum == G) break;
        __builtin_amdgcn_s_sleep(1);
        if ((++sp & 255u) == 0u) { if (xb_ld(&bar[XB_TMO])) break; if (sp > XB_SPIN_CAP) { atomicAdd(&bar[XB_TMO], 1u); break; } }
    }
    nloc = mine > 0u ? mine : 1u; nx = cnt > 0u ? cnt : 1u;
}

__device__ __forceinline__ void xcd_barrier(const XcdBarrier& b) {
    asm volatile("s_waitcnt vmcnt(0)" ::: "memory");
    __syncthreads();
    if (b.w == 0u && pg8::hw_lane() == 0) {
        unsigned* bar = b.bar;
        __builtin_amdgcn_s_waitcnt(0);
        unsigned nloc = b.st[0], nx = b.st[1];
        if (nloc == 0u) { xcd_barrier_complete(bar, b.x, nloc, nx); b.st[0] = nloc; b.st[1] = nx; }
        const unsigned old = xb_add(&bar[XB_XSUB(b.x)], 1u);
        const unsigned gen = old / nloc;
        if (old + 1u == (gen + 1u) * nloc) {
            __builtin_amdgcn_fence(__ATOMIC_RELEASE, "agent");
            asm volatile("s_waitcnt vmcnt(0)" ::: "memory");
            const unsigned og = xb_add(&bar[XB_TOP], 1u);
            const unsigned tg = og / nx;
            if (og + 1u == (tg + 1u) * nx) xb_add(&bar[XB_TOPGEN], 1u);
            else XB_SPIN(xb_ld(&bar[XB_TOPGEN]) == tg, bar);
            __builtin_amdgcn_fence(__ATOMIC_ACQUIRE, "agent");
            xb_add(&bar[XB_XGEN(b.x)], 1u);
            asm volatile("s_waitcnt vmcnt(0)" ::: "memory");
        } else {
            XB_SPIN(xb_ld(&bar[XB_XGEN(b.x)]) == gen, bar);
            __builtin_amdgcn_fence(__ATOMIC_ACQUIRE, "agent");
            asm volatile("s_waitcnt vmcnt(0)" ::: "memory");
        }
    }
    __syncthreads();
}
namespace mk {
constexpr int NWAVES = 8, NTHR = 512;
constexpr int NB = 16, S = 2048, D = 1024, CT = 256, RB = S + CT  , MT = NB * RB, HB = 8  , MH = HB * RB, DI = 2048;
constexpr float EPS = 1e-6f, LOG2E = 1.4426950408889634f;
constexpr size_t MiB = 1u << 20;
constexpr size_t WS_CTXS = 0, WS_MOD = 16 * MiB, WS_CTL = 17 * MiB, CTL_BYTES = 64 * 1024;
constexpr size_t WS_ROPE = 18 * MiB, WS_WG2 = 18 * MiB + 64 * 1024, WS_GATES = 19 * MiB;
constexpr size_t WS_WIN = 22 * MiB, WS_WOUT = 38 * MiB, WS_H = 42 * MiB, WS_QG = 114 * MiB, WS_S2 = 258 * MiB, WS_S3 = 330 * MiB, WS_S4 = 402 * MiB, WS_END = 474 * MiB, WS_GATES2 = 474 * MiB  ,
    WS_SSQ = 477 * MiB  , WS_W2 = 480 * MiB  , WS_SHW = 500 * MiB  , WS_GATES3 = 503 * MiB, WS_GATES4 = 506 * MiB  ;
constexpr int CW_BAR = 1024;
constexpr int RING_BYTES = 131072, MISC_OFF = RING_BYTES + 320, LDS_BYTES = 147456;

typedef unsigned short bf16;
typedef float f32x4 __attribute__((ext_vector_type(4)));
typedef float f32x16 __attribute__((ext_vector_type(16)));
typedef short bf16x8 __attribute__((ext_vector_type(8)));
typedef short s16x4 __attribute__((ext_vector_type(4)));
typedef unsigned u32x4 __attribute__((ext_vector_type(4)));
typedef unsigned u32x2 __attribute__((ext_vector_type(2)));

__device__ __forceinline__ float silu(float x) { return x / (1.f + __expf(-x)); }
__device__ __forceinline__ float bf2f(unsigned short b) { return __uint_as_float((unsigned)b << 16); }
__device__ __forceinline__ float bflo(unsigned w) { return __uint_as_float(w << 16); }
__device__ __forceinline__ float bfhi(unsigned w) { return __uint_as_float(w & 0xffff0000u); }
__device__ __forceinline__ float wave_sum(float v) {
#pragma unroll
    for (int o = 1; o < 64; o <<= 1) v += __shfl_xor(v, o);
    return v;
}

struct Frame {
    LAS unsigned char* lds;
    int tid, lane, wave, vcu, G;
    void* const* dummy;
};
__device__ __forceinline__ Frame fresh(const Frame& F0) { Frame F = F0; const int l = pg8::hw_lane(); F.lane = l; F.tid = F0.wave * 64 + l; return F; }
struct Args { const float* in[32]; float* out; unsigned char* ws; int ph_lo, ph_hi; };

template <bool ROPE, bool AFFINE = false> struct EpiProj {
    static constexpr bool PERM = true, AFTER_DRAIN = false;
    bf16 *d0, *d1, *d2, *d3; int l0, l1, l2, l3; int t1, t2, t3; unsigned ropemask; float sc0; const float* rope;
    const float* ssq; const float* shw; int row_base;
    __device__ __forceinline__ void operator()(const pg8::f32x4 (&acc)[2][2][4][2], const pg8::Unit& u, int wr, int wc, int fr, int fq) const { run<false>(acc, u, wr, wc, fr, fq); }
    template <bool NOSTORE> __device__ __forceinline__ void run(const pg8::f32x4 (&acc)[2][2][4][2], const pg8::Unit& u, int wr, int wc, int fr, int fq) const {
        asm volatile("" : "+v"(fr), "+v"(fq));
        const int pn = u.pn;
        long long off = 0; int ld = l0, tb = 0, s = 0;
        if (pn >= t1) { off += (long long)(d1 - d0); ld += l1 - l0; tb = t1; s = 1; }
        if (pn >= t2) { off += (long long)(d2 - d1); ld += l2 - l1; tb = t2; s = 2; }
        if (pn >= t3) { off += (long long)(d3 - d2); ld += l3 - l2; tb = t3; s = 3; }
        bf16* base = d0 + off;
        const float sc = (pn >= t1) ? 1.f : sc0;
        const int rr0 = (u.pm * 256) % RB;
        const bool do_rope = ROPE && ((ropemask >> s) & 1u) && rr0 != 0;
        const int col0 = (pn - tb) * 256 + wc * 32 + 8 * fq;
        const int rloc = wr * 64 + fr;
        pg8::f32x4 sw[2][2];
        if (AFFINE) { const int gr0 = row_base + u.pm * 256; const float* sp = shw + (size_t)(rr0 == 0 ? 16 : gr0 / RB) * 8192 + pn * 256 + wc * 32 + 8 * fq;
#pragma unroll
            for (int bj = 0; bj < 2; ++bj) { sw[bj][0] = *(const pg8::f32x4*)(sp + bj * 128); sw[bj][1] = *(const pg8::f32x4*)(sp + bj * 128 + 4); } }
#pragma unroll
        for (int ai = 0; ai < 2; ++ai)
#pragma unroll
            for (int m = 0; m < 4; ++m) {
                const int rt = rloc + ai * 128 + m * 16;
                bf16* rowp = base + (size_t)(u.pm * 256 + rt) * ld + col0;
                float rstd = 1.f;
                if (AFFINE) { const pg8::f32x4* qp = (const pg8::f32x4*)(ssq + (size_t)(row_base + u.pm * 256 + rt) * 16); const pg8::f32x4 a0 = qp[0], a1 = qp[1], a2 = qp[2], a3 = qp[3];
                    const float tot = ((a0[0] + a0[1]) + (a0[2] + a0[3])) + ((a1[0] + a1[1]) + (a1[2] + a1[3])) + ((a2[0] + a2[1]) + (a2[2] + a2[3])) + ((a3[0] + a3[1]) + (a3[2] + a3[3]));
                    rstd = rsqrtf(tot * (1.f / D) + EPS); }
                f32x4 cs0 = {}, cs1 = {}, cs2 = {}, cs3 = {};
                if (ROPE && do_rope) { const int t = rr0 - CT + rt; const int pos = (wc & 1) ? (t & 63) : (t >> 6); const f32x4* tp = (const f32x4*)(rope + pos * 32 + 16 * (fq & 1));
                    cs0 = tp[0]; cs1 = tp[1]; cs2 = tp[2]; cs3 = tp[3]; }
#pragma unroll
                for (int bj = 0; bj < 2; ++bj) {
                    pg8::f32x4 v0 = acc[ai][bj][m][0], v1 = acc[ai][bj][m][1];
                    if (AFFINE) { v0 = v0 * rstd + sw[bj][0]; v1 = v1 * rstd + sw[bj][1]; }
                    if (ROPE && do_rope) {
                        const float sg = (fq & 2) ? 1.f : -1.f;
                        pg8::f32x4 p0, p1;
#pragma unroll
                        for (int i = 0; i < 4; ++i) { p0[i] = __shfl_xor(v0[i], 32); p1[i] = __shfl_xor(v1[i], 32); }
                        v0[0] = v0[0] * cs0[0] + sg * p0[0] * cs0[1]; v0[1] = v0[1] * cs0[2] + sg * p0[1] * cs0[3];
                        v0[2] = v0[2] * cs1[0] + sg * p0[2] * cs1[1]; v0[3] = v0[3] * cs1[2] + sg * p0[3] * cs1[3];
                        v1[0] = v1[0] * cs2[0] + sg * p1[0] * cs2[1]; v1[1] = v1[1] * cs2[2] + sg * p1[1] * cs2[3];
                        v1[2] = v1[2] * cs3[0] + sg * p1[2] * cs3[1]; v1[3] = v1[3] * cs3[2] + sg * p1[3] * cs3[3];
                    }
                    v0 = v0 * sc; v1 = v1 * sc;
                    pg8::u32x4 w; w.x = pg8::cvt_pk_bf16(v0[0], v0[1]); w.y = pg8::cvt_pk_bf16(v0[2], v0[3]); w.z = pg8::cvt_pk_bf16(v1[0], v1[1]); w.w = pg8::cvt_pk_bf16(v1[2], v1[3]);
                    if (NOSTORE) asm volatile("" :: "v"(w)); else { *(pg8::u32x4*)(rowp + bj * 128) = w;
#ifdef MK_EXP_ST2
                        asm volatile("" ::: "memory"); *(volatile pg8::u32x4*)(rowp + bj * 128) = w;
#endif
                    }
                }
            }
    }
};
__device__ __forceinline__ pg8::f32x4 ld4(const float* p) { return *(const pg8::f32x4*)p; }
__device__ __forceinline__ pg8::f32x4 ld4(const bf16* p) { const u32x2 w = *(const u32x2*)p; pg8::f32x4 v; v[0] = bflo(w.x); v[1] = bfhi(w.x); v[2] = bflo(w.y); v[3] = bfhi(w.y); return v; }
__device__ __forceinline__ void st4(float* p, const pg8::f32x4& v) { *(pg8::f32x4*)p = v; }
__device__ __forceinline__ void st4(bf16* p, const pg8::f32x4& v) { u32x2 w; w.x = pg8::cvt_pk_bf16(v[0], v[1]); w.y = pg8::cvt_pk_bf16(v[2], v[3]); *(u32x2*)p = w; }
template <class BT = float, class OT = float> struct EpiResidT {
    static constexpr bool PERM = false, AFTER_DRAIN = false;
    const BT* base_lat; const BT* base_ctx; OT* out_lat; OT* out_ctx; const float* mod_l; int need_ctx; int dry;
    bf16* Hn; const float* gnext; const float* modn; float* ssq;
    __device__ __forceinline__ void operator()(const pg8::f32x4 (&acc)[2][2][4][2], const pg8::Unit& u, int wr, int wc, int fr, int fq) const {
        asm volatile("" : "+v"(fr), "+v"(fq));
        const int r0 = u.pm * 256, b = r0 / RB, rr0 = r0 % RB; const bool ctx = rr0 == 0;
        if ((ctx && !need_ctx) || dry) return;
        const size_t ro = ctx ? (size_t)b * CT * D : ((size_t)b * S + (rr0 - CT)) * D;
        const BT* bp = (ctx ? base_ctx : base_lat) + ro; OT* op = (ctx ? out_ctx : out_lat) + ro;
        const float* gt = mod_l + (size_t)(ctx ? 16 : b) * 3072 + 2048;
        const int col0 = u.pn * 256 + wc * 32 + 4 * fq;
        pg8::f32x4 g[2][2];
#pragma unroll
        for (int bj = 0; bj < 2; ++bj)
#pragma unroll
            for (int n = 0; n < 2; ++n) g[bj][n] = *(const pg8::f32x4*)(gt + col0 + bj * 128 + n * 16);
        pg8::f32x4 gm[2][2];
        if (Hn) { const float* sn = modn + (size_t)(ctx ? 16 : b) * 3072 + 1024;
#pragma unroll
            for (int bj = 0; bj < 2; ++bj)
#pragma unroll
                for (int n = 0; n < 2; ++n) gm[bj][n] = *(const pg8::f32x4*)(gnext + col0 + bj * 128 + n * 16) * (*(const pg8::f32x4*)(sn + col0 + bj * 128 + n * 16) + 1.0f); }
#pragma unroll
        for (int ai = 0; ai < 2; ++ai)
#pragma unroll
            for (int m = 0; m < 4; ++m) { const size_t off = (size_t)(ai * 128 + wr * 64 + m * 16 + fr) * D + col0; float sq = 0.f;
#pragma unroll
                for (int bj = 0; bj < 2; ++bj)
#pragma unroll
                    for (int n = 0; n < 2; ++n) { const pg8::f32x4 bs = ld4(bp + off + bj * 128 + n * 16); const pg8::f32x4 xn = bs + g[bj][n] * acc[ai][bj][m][n]; st4(op + off + bj * 128 + n * 16, xn);
                        if (Hn) { sq += (xn[0] * xn[0] + xn[1] * xn[1]) + (xn[2] * xn[2] + xn[3] * xn[3]); const pg8::f32x4 hv = xn * gm[bj][n];
                            u32x2 w; w.x = pg8::cvt_pk_bf16(hv[0], hv[1]); w.y = pg8::cvt_pk_bf16(hv[2], hv[3]); *(u32x2*)(Hn + (size_t)(r0 + ai * 128 + wr * 64 + m * 16 + fr) * D + col0 + bj * 128 + n * 16) = w; } }
                if (Hn) { sq += __shfl_xor(sq, 16); sq += __shfl_xor(sq, 32); if (fq == 0) ssq[(size_t)(r0 + ai * 128 + wr * 64 + m * 16 + fr) * 16 + u.pn * 4 + wc] = sq; } }
    }
};
using EpiResid = EpiResidT<float, float>;

struct LatOnlyOrder {
    pg8::StaticOrder lat;
    __device__ void init(int G_, int c_) { lat.init(128 * 256, D, G_, c_); }
    __device__ bool next(int i, pg8::Unit& u) const { const bool ok = lat.next(i, u); u.pm = (u.pm >> 3) * 9 + 1 + (u.pm & 7); return ok; }
    __device__ __forceinline__ void a_ready(const pg8::Unit&) const {}
    __device__ __forceinline__ void done(const pg8::Unit&) const {}
};
struct OutTailOrder {
    int c;
    __device__ void init(int, int c_) { c = c_; }
    __device__ bool next(int i, pg8::Unit& u) const { if (i > 0 || c >= 64) return false; const int x = c & 7, j = c >> 3; u.pm = 128 + 2 * x + (j >> 2); u.pn = j & 3; return true; }
    __device__ __forceinline__ void a_ready(const pg8::Unit&) const {}
    __device__ __forceinline__ void done(const pg8::Unit&) const {}
};
struct L3Order {
    pg8::StaticOrder lat; int G, c;
    __device__ void init(int G_, int c_) { lat.init(64 * 256, 18 * 256, G_, c_); G = G_; c = c_; }
    __device__ bool next(int i, pg8::Unit& u) const {
        const long L = (long)i * G + c;
        if (L < 1152) { const bool ok = lat.next(i, u); u.pm = (u.pm >> 3) * 9 + 1 + (u.pm & 7); return ok; }
        if (L >= 1168) return false;
        const int j = (int)L - 1152; u.pm = (j >> 1) * 9; u.pn = 8 + (j & 1); return true;
    }
    __device__ __forceinline__ void a_ready(const pg8::Unit&) const {}
    __device__ __forceinline__ void done(const pg8::Unit&) const {}
};

__device__ __forceinline__ void transpose_item(const float* W, int K, int N, bf16* WT, LAS float* scr, int item, int lane) {
    const int nblk = N / 32, kb = item / nblk, nb = item % nblk, k0 = 64 * kb, n0 = 32 * nb;
#pragma unroll 8
    for (int i = 0; i < 32; ++i) { const int kk = 2 * i + (lane >> 5); scr[kk * 33 + (lane & 31)] = W[(size_t)(k0 + kk) * N + n0 + (lane & 31)]; }
    LDS_WAIT(); asm volatile("" ::: "memory");
    const int c = lane & 7;
#pragma unroll
    for (int j = 0; j < 4; ++j) { const int n = (lane >> 3) + 8 * j; const LAS float* s = scr + (8 * c) * 33 + n;
        v4u o; o.x = pk2(s[0 * 33], s[1 * 33]); o.y = pk2(s[2 * 33], s[3 * 33]); o.z = pk2(s[4 * 33], s[5 * 33]); o.w = pk2(s[6 * 33], s[7 * 33]);
        *(GAS v4u*)(WT + (size_t)(n0 + n) * K + k0 + 8 * c) = o; }
    LDS_WAIT(); asm volatile("" ::: "memory");
}
__device__ __forceinline__ void wconv(Frame& F0, const float* Win, int Nin, const float* Wout, bf16* WinT, bf16* WoutT, int gw, int NGW) {
    Frame F = fresh(F0);
    LAS float* scr = (LAS float*)(F.lds + F.wave * 16384);
    const int I1 = (D / 64) * (Nin / 32), I2 = (DI / 64) * (D / 32);
    for (int it = gw; it < I1 + I2; it += NGW) { if (it < I1) transpose_item(Win, D, Nin, WinT, scr, it, F.lane); else transpose_item(Wout, DI, D, WoutT, scr, it - I1, F.lane); }
}
template <class XT>
__device__ __forceinline__ void norm_phase(Frame& F0, const XT* xlat, const XT* xctx, const float* g, const float* mod_l, bf16* H, int row_lo = 0, int row_hi = MT, int wg0 = 0) {
    Frame F = fresh(F0);
    const int gw = (wg0 ? (int)blockIdx.x - wg0 : F.vcu) * NWAVES + F.wave, NGW = (F.G - wg0) * NWAVES;
    f32x4 gg[4];
#pragma unroll
    for (int j = 0; j < 4; ++j) gg[j] = *(const f32x4*)(g + F.lane * 4 + 256 * j);
    for (int row0 = row_lo + gw; row0 < row_hi; row0 += 2 * NGW) {
        f32x4 v[2][4]; const float* mrow[2]; float ss[2] = {0.f, 0.f}; int rowi[2];
#pragma unroll
        for (int u = 0; u < 2; ++u) { int row = row0 + u * NGW; if (row >= row_hi) row = row0; rowi[u] = row;
            const int b = row / RB, rr = row % RB;
            const XT* src = rr < CT ? xctx + ((size_t)b * CT + rr) * D : xlat + ((size_t)b * S + (rr - CT)) * D;
            mrow[u] = mod_l + (size_t)(rr < CT ? 16 : b) * 3072;
#pragma unroll
            for (int j = 0; j < 4; ++j) v[u][j] = ld4(src + F.lane * 4 + 256 * j); }
#pragma unroll
        for (int u = 0; u < 2; ++u) {
#pragma unroll
            for (int j = 0; j < 4; ++j) ss[u] += (v[u][j].x * v[u][j].x + v[u][j].y * v[u][j].y) + (v[u][j].z * v[u][j].z + v[u][j].w * v[u][j].w);
            const float rstd = rsqrtf(wave_sum(ss[u]) * (1.f / D) + EPS);
#pragma unroll
            for (int j = 0; j < 4; ++j) { const int c = F.lane * 4 + 256 * j; const f32x4 sc = *(const f32x4*)(mrow[u] + 1024 + c), sh = *(const f32x4*)(mrow[u] + c);
                const f32x4 o = v[u][j] * rstd * gg[j] * (sc + 1.0f) + sh;
                u32x2 w; w.x = pk2(o.x, o.y); w.y = pk2(o.z, o.w); *(u32x2*)(H + (size_t)rowi[u] * D + c) = w; }
        }
    }
}
__device__ __forceinline__ void final_norm_phase(Frame& F0, float* xs, const float* g) {
    Frame F = fresh(F0);
    const int gw = F.vcu * NWAVES + F.wave, NGW = F.G * NWAVES;
    f32x4 gg[4];
#pragma unroll
    for (int j = 0; j < 4; ++j) gg[j] = *(const f32x4*)(g + F.lane * 4 + 256 * j);
    for (int row0 = gw; row0 < NB * S; row0 += 2 * NGW) {
        f32x4 v[2][4]; float* p[2];
#pragma unroll
        for (int u = 0; u < 2; ++u) { int row = row0 + u * NGW; if (row >= NB * S) row = row0; p[u] = xs + (size_t)row * D;
#pragma unroll
            for (int j = 0; j < 4; ++j) v[u][j] = *(const f32x4*)(p[u] + F.lane * 4 + 256 * j); }
#pragma unroll
        for (int u = 0; u < 2; ++u) { float ss = 0.f;
#pragma unroll
            for (int j = 0; j < 4; ++j) ss += (v[u][j].x * v[u][j].x + v[u][j].y * v[u][j].y) + (v[u][j].z * v[u][j].z + v[u][j].w * v[u][j].w);
            const float rstd = rsqrtf(wave_sum(ss) * (1.f / D) + EPS);
#pragma unroll
            for (int j = 0; j < 4; ++j) { const int c = F.lane * 4 + 256 * j; *(f32x4*)(p[u] + c) = v[u][j] * rstd * gg[j]; } }
    }
}
__device__ __forceinline__ void shw_phase(Frame& F0, const Args& a) {
    Frame F = fresh(F0);
    const float* mod = (const float*)(a.ws + WS_MOD); float* shw = (float*)(a.ws + WS_SHW);
    LAS float* sh = (LAS float*)F.lds;
    LAS float* red = (LAS float*)(F.lds + 69632);
    int cur_l = -1;
    for (int it = blockIdx.x; it < 128 + 128 + 72; it += F.G) {
        const int l = it < 128 ? 0 : (it < 256 ? 1 : 2), cg = it - (l == 0 ? 0 : (l == 1 ? 128 : 256));
        const int N = l == 2 ? 4608 : 8192; const float* W = a.in[l == 0 ? 19 : (l == 1 ? 26 : 29)];
        __syncthreads();
        if (l != cur_l) { for (int i = F.tid; i < 17 * 1024; i += NTHR) sh[i] = mod[((size_t)(l + 1) * 17 + (i >> 10)) * 3072 + (i & 1023)]; cur_l = l; __syncthreads(); }
        float acc[17];
#pragma unroll
        for (int r = 0; r < 17; ++r) acc[r] = 0.f;
        const float* wp = W + (size_t)(F.wave * 128) * N + cg * 64 + F.lane;
#pragma unroll 8
        for (int kk = 0; kk < 128; ++kk) { const float w = wp[(size_t)kk * N];
#pragma unroll
            for (int r = 0; r < 17; ++r) acc[r] += sh[r * 1024 + F.wave * 128 + kk] * w; }
#pragma unroll
        for (int r = 0; r < 17; ++r) red[(F.wave * 17 + r) * 64 + F.lane] = acc[r];
        __syncthreads();
        for (int i = F.tid; i < 17 * 64; i += NTHR) { float sacc = 0.f;
#pragma unroll
            for (int w8 = 0; w8 < 8; ++w8) sacc += red[(w8 * 17 + (i >> 6)) * 64 + (i & 63)];
            shw[((size_t)l * 17 + (i >> 6)) * 8192 + cg * 64 + (i & 63)] = sacc; }
    }
    __syncthreads();
}
__device__ __forceinline__ void prologue_phase(Frame& F0, const Args& a) {
    Frame F = fresh(F0);
    const float* c = a.in[1]; const float* cctx = a.in[3]; const float* w_ada = a.in[5];
    float* part = (float*)(a.ws + WS_QG);
    {
        LAS float* st = (LAS float*)F.lds;
        const int wg = blockIdx.x, l = wg >> 6, sl = wg & 63, k0 = sl * 16;
        if (F.tid < 17 * 16) { const int r = F.tid >> 4, k = F.tid & 15; st[F.tid] = silu(r < 16 ? c[r * 1024 + k0 + k] : cctx[k0 + k]); }
        __syncthreads();
        float acc[17][6];
#pragma unroll
        for (int r = 0; r < 17; ++r)
#pragma unroll
            for (int i = 0; i < 6; ++i) acc[r][i] = 0.f;
        const float* wp = w_ada + ((size_t)l * 1024 + k0) * 3072 + F.tid;
#pragma unroll 2
        for (int kk = 0; kk < 16; ++kk) { float w[6];
#pragma unroll
            for (int i = 0; i < 6; ++i) w[i] = wp[(size_t)kk * 3072 + 512 * i];
#pragma unroll
            for (int r = 0; r < 17; ++r) { const float sv = st[r * 16 + kk];
#pragma unroll
                for (int i = 0; i < 6; ++i) acc[r][i] += sv * w[i]; } }
        float* pp = part + (size_t)wg * 17 * 3072 + F.tid;
#pragma unroll
        for (int r = 0; r < 17; ++r)
#pragma unroll
            for (int i = 0; i < 6; ++i) pp[r * 3072 + 512 * i] = acc[r][i];
    }
#ifdef MK_TOUCH
    {
        const int xg = blockIdx.x >> 3; unsigned accv = 0u;
        for (size_t off = ((size_t)xg * NTHR + F.tid) * 4096; off < WS_END; off += (size_t)32 * NTHR * 4096) accv += *(const unsigned*)(a.ws + off);
        for (size_t off = ((size_t)xg * NTHR + F.tid) * 4096; off < (size_t)NB * S * D * 4; off += (size_t)32 * NTHR * 4096) accv += *(const unsigned*)((const unsigned char*)a.out + off) + *(const unsigned*)((const unsigned char*)a.in[0] + off);
        asm volatile("" :: "v"(accv));
    }
#endif
    if (blockIdx.x == 0) {
        float* rope = (float*)(a.ws + WS_ROPE);
        for (int i = F.tid; i < 64 * 16; i += NTHR) { const int pos = i >> 4, j = i & 15; const float inv = powf(10000.f, -(float)j / 16.f), ang = (float)pos * inv; rope[2 * i] = cosf(ang); rope[2 * i + 1] = sinf(ang); }
    } else if (blockIdx.x < 33) {
        bf16* W2 = (bf16*)(a.ws + WS_WG2); const float* wq = a.in[11]; const float* wk = a.in[12]; const float* wv = a.in[13]; const float* wg = a.in[14];
        for (int i = (blockIdx.x - 1) * NTHR + F.tid; i < 32 * 4096; i += 32 * NTHR) { const int n = i >> 12, k = i & 4095; float s = 0.f;
            if (k < 2048) { const int gq = k >> 2, ii = k & 3;
#pragma unroll
                for (int j = 0; j < 4; ++j) s += wq[(gq * 4 + ii) * 4 + j] * wg[(size_t)(gq * 4 + j) * 32 + n] + wk[(gq * 4 + ii) * 4 + j] * wg[(size_t)(2048 + gq * 4 + j) * 32 + n]; }
            else { const int kk = k - 2048, gq = kk >> 2, ii = kk & 3;
#pragma unroll
                for (int j = 0; j < 4; ++j) s += wv[(gq * 4 + ii) * 4 + j] * wg[(size_t)(4096 + gq * 4 + j) * 32 + n]; }
            W2[i] = (bf16)f2bf(s); }
    }
}
__device__ __forceinline__ void prologue2_phase(Frame& F0, const Args& a) {
    Frame F = fresh(F0);
    const float* part = (const float*)(a.ws + WS_QG); const float* b_ada = a.in[6]; float* mod = (float*)(a.ws + WS_MOD);
    for (int o = blockIdx.x * NTHR + F.tid; o < 4 * 17 * 3072; o += F.G * NTHR) {
        const int l = o / (17 * 3072), rn = o % (17 * 3072), n = rn % 3072;
        const float* pp = part + (size_t)l * 64 * 17 * 3072 + rn; float s0 = 0.f, s1 = 0.f, s2 = 0.f, s3 = 0.f;
#pragma unroll
        for (int sl = 0; sl < 64; sl += 16) { float v[16];
#pragma unroll
            for (int j = 0; j < 16; ++j) v[j] = pp[(size_t)(sl + j) * 17 * 3072];
#pragma unroll
            for (int j = 0; j < 16; j += 4) { s0 += v[j]; s1 += v[j + 1]; s2 += v[j + 2]; s3 += v[j + 3]; } }
        mod[o] = ((s0 + s1) + (s2 + s3)) + b_ada[l * 3072 + n];
    }
}
}
namespace att {
using mk::bf16; using mk::bf16x8; using mk::s16x4; using mk::f32x16; using mk::u32x4; using mk::u32x2;
typedef short v4i16_t __attribute__((ext_vector_type(4)));
typedef float f32x2_t __attribute__((ext_vector_type(2))); typedef __bf16 bf16x2_t __attribute__((ext_vector_type(2)));
__device__ __forceinline__ int crow(int r, int hi) { return (r & 3) + 8 * (r >> 2) + 4 * hi; }
__device__ __forceinline__ unsigned cvtpk(float lo, float hi) { f32x2_t v = {lo, hi}; bf16x2_t b = __builtin_convertvector(v, bf16x2_t); return __builtin_bit_cast(unsigned, b); }
__device__ __forceinline__ s16x4 vtr(LAS const unsigned char* p) { return __builtin_bit_cast(s16x4, __builtin_amdgcn_ds_read_tr16_b64_v4i16((LAS v4i16_t*)p)); }
__device__ __forceinline__ float ex2(float x) { return __builtin_amdgcn_exp2f(x); }
__device__ __forceinline__ float max3f(float a, float b, float c) { float r; asm("v_max3_f32 %0, %1, %2, %3" : "=v"(r) : "v"(a), "v"(b), "v"(c)); return r; }
#define ATT_SB() __builtin_amdgcn_sched_barrier(0)

struct Src { const bf16* K[2]; const bf16* V; int ldk, ldv; };

template <int DV, int NCOMP> struct Stage { u32x4 kr[NCOMP]; u32x4 vr[DV / 64]; };
template <int DV, int NCOMP>
__device__ __forceinline__ void stage_load(Stage<DV, NCOMP>& st, const Src& s, size_t row, int wid, int lane) {
#pragma unroll
    for (int c = 0; c < NCOMP; ++c) st.kr[c] = *(const u32x4*)(s.K[c] + (row + lane) * s.ldk + wid * 8);
#pragma unroll
    for (int i = 0; i < DV / 64; ++i) { const int p = wid + 8 * i, d0 = p >> 2, kg = p & 3; st.vr[i] = *(const u32x4*)(s.V + (row + 16 * kg + (lane >> 2)) * s.ldv + d0 * 32 + (lane & 3) * 8); }
}
template <int DV, int NCOMP>
__device__ __forceinline__ void stage_store(const Stage<DV, NCOMP>& st, LAS unsigned char* buf, int wid, int lane) {
#pragma unroll
    for (int c = 0; c < NCOMP; ++c) *(LAS u32x4*)(buf + c * 8192 + wid * 1024 + lane * 16) = st.kr[c];
#pragma unroll
    for (int i = 0; i < DV / 64; ++i) *(LAS u32x4*)(buf + NCOMP * 8192 + (wid + 8 * i) * 1024 + lane * 16) = st.vr[i];
}
__device__ __forceinline__ void glds16(const void* gsrc, unsigned lds_dst) { unsigned keep;
    asm volatile("s_mov_b32 %0, m0\n\ts_mov_b32 m0, %2\n\ts_nop 0\n\tglobal_load_lds_dwordx4 %1, off\n\ts_mov_b32 m0, %0" : "=&s"(keep) : "v"(gsrc), "s"(lds_dst) : "memory"); }
__device__ __forceinline__ unsigned long long uni64(const void* p) { const unsigned long long a = (unsigned long long)p;
    return ((unsigned long long)(unsigned)__builtin_amdgcn_readfirstlane((unsigned)(a >> 32)) << 32) | (unsigned)__builtin_amdgcn_readfirstlane((unsigned)a); }
__device__ __forceinline__ void glds16s(const void* sbase_, unsigned voff, unsigned lds_dst) { unsigned keep; const unsigned long long sbase = uni64(sbase_);
    asm volatile("s_mov_b32 %0, m0\n\ts_mov_b32 m0, %3\n\ts_nop 0\n\tglobal_load_lds_dwordx4 %1, %2\n\ts_mov_b32 m0, %0" : "=&s"(keep) : "v"(voff), "s"(sbase), "s"(lds_dst) : "memory"); }
template <int DV, int NCOMP>
__device__ __forceinline__ void dma_issue(const Src& s, size_t row, LAS unsigned char* buf, int wid, int lane) {
    const unsigned b0 = (unsigned)(size_t)buf;
    const int kl = lane >> 3;
    const unsigned ko = (unsigned)(kl * s.ldk + (((lane & 7) ^ ((4 * (wid & 1) + (kl >> 1)) & 7)) * 8)) * 2u, vo = (unsigned)((16 * (wid & 3) + (lane >> 2)) * s.ldv + (lane & 3) * 8) * 2u;
#pragma unroll
    for (int c = 0; c < NCOMP; ++c) glds16s(s.K[c] + (row + 8 * wid) * s.ldk, ko, (unsigned)__builtin_amdgcn_readfirstlane(b0 + c * 8192 + wid * 1024));
#pragma unroll
    for (int i = 0; i < DV / 64; ++i) { const int p = wid + 8 * i, d0 = p >> 2;
        glds16s(s.V + row * s.ldv + d0 * 32, vo, (unsigned)__builtin_amdgcn_readfirstlane(b0 + NCOMP * 8192 + p * 1024)); }
}
#define ATT_WAIT_BAR(N) asm volatile("s_waitcnt vmcnt(" #N ") lgkmcnt(0)\n\ts_barrier" ::: "memory")
template <int NL> __device__ __forceinline__ void wait_bar_keep() { if constexpr (NL == 2) ATT_WAIT_BAR(2); else if constexpr (NL == 4) ATT_WAIT_BAR(4); else static_assert(NL == 2 || NL == 4, "pieces per wave"); }
__device__ __forceinline__ void qk_tile(LAS const unsigned char* kimg, const bf16x8 (&qf)[4], int r32, int hi, f32x16& p0, f32x16& p1, const f32x16& z, const f32x16& z1  ) {
    const int sw = (r32 >> 1) & 7, u16 = (sw & 6) * 16;
    LAS const unsigned char* kb = kimg + r32 * 128 + ((hi ^ sw) & 1) * 16;
    LAS const unsigned char* ka[4] = {kb + (0 ^ u16), kb + (32 ^ u16), kb + (64 ^ u16), kb + (96 ^ u16)};
#define ATT_KRD(i) (*(LAS const bf16x8*)(ka[(i) >> 1] + ((i) & 1) * 4096))
    bf16x8 f0 = ATT_KRD(0), f1 = ATT_KRD(1), f2;
    f2 = ATT_KRD(2); ATT_SB(); p0 = __builtin_amdgcn_mfma_f32_32x32x16_bf16(f0, qf[0], z, 0, 0, 0);
    f0 = ATT_KRD(3); ATT_SB(); p1 = __builtin_amdgcn_mfma_f32_32x32x16_bf16(f1, qf[0], z1, 0, 0, 0);
    f1 = ATT_KRD(4); ATT_SB(); p0 = __builtin_amdgcn_mfma_f32_32x32x16_bf16(f2, qf[1], p0, 0, 0, 0);
    f2 = ATT_KRD(5); ATT_SB(); p1 = __builtin_amdgcn_mfma_f32_32x32x16_bf16(f0, qf[1], p1, 0, 0, 0);
    f0 = ATT_KRD(6); ATT_SB(); p0 = __builtin_amdgcn_mfma_f32_32x32x16_bf16(f1, qf[2], p0, 0, 0, 0);
    f1 = ATT_KRD(7); ATT_SB(); p1 = __builtin_amdgcn_mfma_f32_32x32x16_bf16(f2, qf[2], p1, 0, 0, 0);
    ATT_SB(); p0 = __builtin_amdgcn_mfma_f32_32x32x16_bf16(f0, qf[3], p0, 0, 0, 0);
    ATT_SB(); p1 = __builtin_amdgcn_mfma_f32_32x32x16_bf16(f1, qf[3], p1, 0, 0, 0);
#undef ATT_KRD
}
template <int DV>
__device__ __forceinline__ void softmax_tile(f32x16& p0, f32x16& p1, f32x16 (&o)[DV / 32], float& m, float& l, u32x4 (&pw)[4]) {
    float mxa = max3f(p0[0], p0[1], p1[0]), mxb = max3f(p0[2], p0[3], p1[1]); mxa = max3f(mxa, p1[2], p1[3]);
#pragma unroll
    for (int r = 4; r < 16; r += 4) { mxa = max3f(mxa, p0[r], p0[r + 1]); mxb = max3f(mxb, p0[r + 2], p0[r + 3]); mxa = max3f(mxa, p1[r], p1[r + 1]); mxb = max3f(mxb, p1[r + 2], p1[r + 3]); }
    const float mx0 = max3f(mxa, mxb, mxb);
    const float mn = max3f(m, mx0, __shfl_xor(mx0, 32)), alpha = ex2(m - mn);
    float ls = 0.f;
#pragma unroll
    for (int r = 0; r < 16; ++r) { p0[r] = ex2(p0[r] - mn); p1[r] = ex2(p1[r] - mn); ls += p0[r] + p1[r]; }
    l = l * alpha + ls;
    if (__any(mn != m)) {
#pragma unroll
        for (int d0 = 0; d0 < DV / 32; ++d0)
#pragma unroll
            for (int r = 0; r < 16; ++r) o[d0][r] *= alpha;
    }
    m = mn;
#pragma unroll
    for (int ks = 0; ks < 4; ++ks) { const int b = 8 * (ks & 1);
        if (ks < 2) { pw[ks].x = cvtpk(p0[b], p0[b + 1]); pw[ks].y = cvtpk(p0[b + 2], p0[b + 3]); pw[ks].z = cvtpk(p0[b + 4], p0[b + 5]); pw[ks].w = cvtpk(p0[b + 6], p0[b + 7]); }
        else { pw[ks].x = cvtpk(p1[b], p1[b + 1]); pw[ks].y = cvtpk(p1[b + 2], p1[b + 3]); pw[ks].z = cvtpk(p1[b + 4], p1[b + 5]); pw[ks].w = cvtpk(p1[b + 6], p1[b + 7]); } }
}
template <int DV>
__device__ __forceinline__ void pv_tile(LAS const unsigned char* vimg, int lane, int hi, const u32x4 (&pw)[4], f32x16 (&o)[DV / 32]) {
    LAS const unsigned char* vb = vimg + ((lane >> 4) & 1) * 32 + (lane & 3) * 8 + (4 * hi + ((lane & 15) >> 2)) * 64;
    constexpr int ND = DV / 32, NF = 4 * ND;
    constexpr int PD = 4, NB_ = PD + 1;
    s16x4 lo[NB_], hi4[NB_];
#define ATT_VRD(i, b) do { lo[b] = vtr(vb + ((i) % ND) * 4096 + ((i) / ND) * 1024); hi4[b] = vtr(vb + ((i) % ND) * 4096 + ((i) / ND) * 1024 + 512); } while (0)
#pragma unroll
    for (int i = 0; i < PD; ++i) ATT_VRD(i, i);
#pragma unroll
    for (int i = 0; i < NF; ++i) {
        if (i + PD < NF) ATT_VRD(i + PD, (i + PD) % NB_);
        ATT_SB();
        const int b = i % NB_;
        const bf16x8 vf = {lo[b][0], lo[b][1], lo[b][2], lo[b][3], hi4[b][0], hi4[b][1], hi4[b][2], hi4[b][3]};
        o[i % ND] = __builtin_amdgcn_mfma_f32_32x32x16_bf16(vf, __builtin_bit_cast(bf16x8, pw[i / ND]), o[i % ND], 0, 0, 0);
    }
#undef ATT_VRD
}

struct SmState { float mxa, mxb, mn, alpha, ls, delta; bool resc; };
template <int NM>
__device__ __forceinline__ void negm_shift(f32x16 (&negm)[NM], float delta) {
#pragma unroll
    for (int i = 0; i < NM; ++i)
#pragma unroll
        for (int r = 0; r < 16; ++r) negm[i][r] -= delta;
}
__device__ __forceinline__ float xmax32(float v) { auto rr = __builtin_amdgcn_permlane32_swap(__float_as_uint(v), __float_as_uint(v), false, false); return max3f(__uint_as_float(rr[0]), __uint_as_float(rr[1]), v); }
template <int SK> __device__ __forceinline__ constexpr bool sm_live0(int r) { return SK != 2 || r >= 12; }
template <int SK> __device__ __forceinline__ constexpr bool sm_live1(int r) { return SK != 1 || r < 4; }
template <int SK = 0>
__device__ __forceinline__ void sm_slice(int k, f32x16& p0, f32x16& p1, float& m, float& l, SmState& s, u32x4 (&pwn)[4]) {
    if (k <= 3) { const int r = 4 * k;
        if (SK == 0 && k == 0) { s.mxa = max3f(p0[0], p0[1], p1[0]); s.mxb = max3f(p0[2], p0[3], p1[1]); s.mxa = max3f(s.mxa, p1[2], p1[3]); }
        else { if (k == 0) { s.mxa = -INFINITY; s.mxb = -INFINITY; }
            if (sm_live0<SK>(r)) { s.mxa = max3f(s.mxa, p0[r], p0[r + 1]); s.mxb = max3f(s.mxb, p0[r + 2], p0[r + 3]); }
            if (sm_live1<SK>(r)) { s.mxa = max3f(s.mxa, p1[r], p1[r + 1]); s.mxb = max3f(s.mxb, p1[r + 2], p1[r + 3]); } }
        asm volatile("" : "+v"(s.mxa), "+v"(s.mxb)); }
    else if (k == 4) { const float mx0 = xmax32(max3f(s.mxa, s.mxb, s.mxb)); const bool first = m == -INFINITY;
        const float delta = (first || mx0 > 8.f) ? mx0 : 0.f; s.delta = delta; s.mn = first ? mx0 : m + delta; s.alpha = ex2(-delta); s.resc = __any(delta != 0.f); l *= s.alpha; s.ls = 0.f;
        if (s.resc) {
#pragma unroll
            for (int r = 0; r < 16; ++r) { p0[r] -= delta; p1[r] -= delta; }
        }
        asm volatile("" : "+v"(s.mn), "+v"(s.alpha), "+v"(l)); }
    else if (k <= 12) { const int j = 2 * (k - 5);
        if (sm_live0<SK>(j)) { p0[j] = ex2(p0[j]); p0[j + 1] = ex2(p0[j + 1]); s.ls += p0[j] + p0[j + 1]; }
        if (sm_live1<SK>(j)) { p1[j] = ex2(p1[j]); p1[j + 1] = ex2(p1[j + 1]); s.ls += p1[j] + p1[j + 1]; }
        asm volatile("" : "+v"(p0), "+v"(p1), "+v"(s.ls)); }
    else if (k == 13) {
        if (SK == 2) { pwn[0] = u32x4{0u, 0u, 0u, 0u}; pwn[1].x = 0u; pwn[1].y = 0u; }
        else { pwn[0].x = cvtpk(p0[0], p0[1]); pwn[0].y = cvtpk(p0[2], p0[3]); pwn[0].z = cvtpk(p0[4], p0[5]); pwn[0].w = cvtpk(p0[6], p0[7]); pwn[1].x = cvtpk(p0[8], p0[9]); pwn[1].y = cvtpk(p0[10], p0[11]); }
        pwn[1].z = cvtpk(p0[12], p0[13]); pwn[1].w = cvtpk(p0[14], p0[15]); asm volatile("" : "+v"(pwn[0]), "+v"(pwn[1])); }
    else if (k == 14) { pwn[2].x = cvtpk(p1[0], p1[1]); pwn[2].y = cvtpk(p1[2], p1[3]);
        if (SK == 1) { pwn[2].z = 0u; pwn[2].w = 0u; pwn[3] = u32x4{0u, 0u, 0u, 0u}; }
        else { pwn[2].z = cvtpk(p1[4], p1[5]); pwn[2].w = cvtpk(p1[6], p1[7]); pwn[3].x = cvtpk(p1[8], p1[9]); pwn[3].y = cvtpk(p1[10], p1[11]); pwn[3].z = cvtpk(p1[12], p1[13]); pwn[3].w = cvtpk(p1[14], p1[15]); }
        asm volatile("" : "+v"(pwn[2]), "+v"(pwn[3])); }
    else { l += s.ls; asm volatile("" : "+v"(l)); }
}
template <int DV, int NM, int SK = 0>
__device__ __forceinline__ void sm_alone(f32x16& p0, f32x16& p1, f32x16 (&o)[DV / 32], float& m, float& l, u32x4 (&pwn)[4], f32x16 (&negm)[NM]) {
    SmState s;
#pragma unroll
    for (int k = 0; k < 16; ++k) sm_slice<SK>(k, p0, p1, m, l, s, pwn);
    if (s.resc) {
#pragma unroll
        for (int d0 = 0; d0 < DV / 32; ++d0)
#pragma unroll
            for (int r = 0; r < 16; ++r) o[d0][r] *= s.alpha;
        negm_shift<NM>(negm, s.delta);
    }
    m = s.mn;
}
template <int DV, int NM, int SK = 0>
__device__ __forceinline__ void pv_sm_tile(LAS const unsigned char* vimg, int lane, int hi, const u32x4 (&pw)[4], f32x16 (&o)[DV / 32], f32x16& p0, f32x16& p1, float& m, float& l, u32x4 (&pwn)[4], f32x16 (&negm)[NM]) {
    LAS const unsigned char* vb = vimg + ((lane >> 4) & 1) * 32 + (lane & 3) * 8 + (4 * hi + ((lane & 15) >> 2)) * 64;
    constexpr int ND = DV / 32, NF = 4 * ND, PD = 3, NB_ = PD + 1, SPM = 16 / NF;
    s16x4 lo[NB_], hi4[NB_];
    SmState s;
#define ATT_VRD(i, b) do { lo[b] = vtr(vb + ((i) % ND) * 4096 + ((i) / ND) * 1024); hi4[b] = vtr(vb + ((i) % ND) * 4096 + ((i) / ND) * 1024 + 512); } while (0)
#pragma unroll
    for (int i = 0; i < PD; ++i) ATT_VRD(i, i);
#pragma unroll
    for (int i = 0; i < NF; ++i) {
        if (i + PD < NF) ATT_VRD(i + PD, (i + PD) % NB_);
        ATT_SB();
        const int b = i % NB_;
        const bf16x8 vf = {lo[b][0], lo[b][1], lo[b][2], lo[b][3], hi4[b][0], hi4[b][1], hi4[b][2], hi4[b][3]};
        o[i % ND] = __builtin_amdgcn_mfma_f32_32x32x16_bf16(vf, __builtin_bit_cast(bf16x8, pw[i / ND]), o[i % ND], 0, 0, 0);
#pragma unroll
        for (int k = i * SPM; k < (i + 1) * SPM; ++k) sm_slice<SK>(k, p0, p1, m, l, s, pwn);
        ATT_SB();
    }
#undef ATT_VRD
    if (s.resc) {
#pragma unroll
        for (int d0 = 0; d0 < ND; ++d0)
#pragma unroll
            for (int r = 0; r < 16; ++r) o[d0][r] *= s.alpha;
        negm_shift<NM>(negm, s.delta);
    }
    m = s.mn;
}

__device__ __forceinline__ void wait_bar_tiles2(int c) {
    if (c >= 5) ATT_WAIT_BAR(10); else if (c == 4) ATT_WAIT_BAR(8); else if (c == 3) ATT_WAIT_BAR(6); else if (c == 2) ATT_WAIT_BAR(4); else if (c == 1) ATT_WAIT_BAR(2); else ATT_WAIT_BAR(0);
}
template <int DV, class Pol, int NS = 4>
__device__ __forceinline__ void run_unit1(LAS unsigned char* lds, const Pol& P, const Src& src, const bf16* Q, int ldq, int wid, int lane) {
    const int r32 = lane & 31, hi = lane >> 5;
    constexpr int STG = 8192 + DV * 128, NL = 1 + DV / 64, LA = NS - 2;
    static_assert(NL == 2 && LA <= 6, "wait_bar_tiles2 counts two-piece tiles");
    const int nt = P.ntiles();
#pragma unroll
    for (int t = 0; t < LA; ++t) if (t < nt) dma_issue<DV, 1>(src, P.tile_row(t), lds + t * STG, wid, lane);
    bf16x8 qf[4];
    { const bf16* qp = Q + (size_t)(wid * 32 + r32) * ldq + hi * 8;
#pragma unroll
      for (int d0 = 0; d0 < 4; ++d0) qf[d0] = *(const bf16x8*)(qp + d0 * 16); }
    f32x16 o[DV / 32];
#pragma unroll
    for (int d0 = 0; d0 < DV / 32; ++d0) o[d0] = f32x16{};
    float m = -INFINITY, l = 0.f; f32x16 negm[1] = {f32x16{}};
    u32x4 pw[4], pwn[4]; bool pend = false;
    asm volatile("" : "+v"(qf[0]), "+v"(qf[1]), "+v"(qf[2]), "+v"(qf[3]));
    ATT_WAIT_BAR(0);
    int ic = 0;
    for (int ti = 0; ti < nt; ++ti) {
        LAS unsigned char* cur = lds + ic * STG; LAS unsigned char* prv = lds + ((ic + NS - 1) & (NS - 1)) * STG;
        if (ti + LA < nt) dma_issue<DV, 1>(src, P.tile_row(ti + LA), lds + ((ic + LA) & (NS - 1)) * STG, wid, lane);
        if (P.needs(ti, wid)) {
            f32x16 p0, p1;
            qk_tile(cur, qf, r32, hi, p0, p1, negm[0], negm[0]);
            P.mask(ti, wid, r32, hi, p0, p1);
            if (pend) pv_sm_tile<DV, 1>(prv + 8192, lane, hi, pw, o, p0, p1, m, l, pwn, negm); else sm_alone<DV, 1>(p0, p1, o, m, l, pwn, negm);
#pragma unroll
            for (int k = 0; k < 4; ++k) pw[k] = pwn[k];
            pend = true;
        } else if (pend) { pv_tile<DV>(prv + 8192, lane, hi, pw, o); pend = false; }
        wait_bar_tiles2(min(ti + LA, nt - 1) - (ti + 1));
        ic = (ic + 1) & (NS - 1);
    }
    if (pend) pv_tile<DV>(lds + ((ic + NS - 1) & (NS - 1)) * STG + 8192, lane, hi, pw, o);
    P.finish(o, m, l, wid, r32, hi);
    ATT_WAIT_BAR(0);
}
constexpr int ZQ_Z = 65536, ZQ_Q = 98304;
__device__ __forceinline__ void glds4s(const void* sbase_, unsigned voff, unsigned lds_dst) { unsigned keep; const unsigned long long sbase = uni64(sbase_);
    asm volatile("s_mov_b32 %0, m0\n\ts_mov_b32 m0, %3\n\ts_nop 0\n\tglobal_load_lds_dword %1, %2\n\ts_mov_b32 m0, %0" : "=&s"(keep) : "v"(voff), "s"(sbase), "s"(lds_dst) : "memory"); }
__device__ __forceinline__ void dma_rows64(const bf16* base, int ld, LAS unsigned char* dst, int lane) {
    const unsigned vo = (unsigned)((lane & 31) * ld + (lane >> 5) * 8) * 2u;
    const unsigned b0 = (unsigned)(size_t)dst;
#pragma unroll
    for (int j = 0; j < 4; ++j) glds16s(base + j * 16, vo, (unsigned)__builtin_amdgcn_readfirstlane(b0 + j * 1024));
}
template <class Pol, int SKL  , class Ctx, class Gen>
__device__ __forceinline__ void run_stream1(LAS unsigned char* lds, const Ctx& C, const Gen& gen, int wid_, int lane_) {
    constexpr int DV = 64, STG = 16384, EX = Pol::EXTRA;
    static_assert(EX == 4 || EX == 5, "first-step wait counts");
    int lane = lane_, wid = wid_;
#define ZL_ (lds + ZQ_Z + wid * 4096)
#define QL_ (lds + ZQ_Q + wid * 4096)
    Pol P;
    if (!gen(0, P)) return;
    dma_rows64(P.qrow(C, wid), mk::DI, QL_, lane);
    dma_issue<DV, 1>(P.src(C), P.tile_row(0), lds, wid, lane);
    dma_issue<DV, 1>(P.src(C), P.tile_row(1), lds + STG, wid, lane);
    ATT_WAIT_BAR(0);
    int ic = 0;
    for (int i = 0;; ++i) {
        Pol Pn; const bool hn = gen(i + 1, Pn);
        asm volatile("" : "+v"(lane), "+s"(wid));
        bf16x8 qf[4];
#pragma unroll
        for (int d0 = 0; d0 < 4; ++d0) qf[d0] = *(LAS const bf16x8*)(QL_ + d0 * 1024 + lane * 16);
        asm volatile("" : "+v"(qf[0]), "+v"(qf[1]), "+v"(qf[2]), "+v"(qf[3]));
        const int nt = P.ntiles();
        f32x16 o[2] = {f32x16{}, f32x16{}};
        float m = -INFINITY, l = 0.f; f32x16 negm[Pol::NM];
#pragma unroll
        for (int i_ = 0; i_ < Pol::NM; ++i_) negm[i_] = f32x16{};
        u32x4 pw[4], pwn[4]; bool pend = false;
        auto steps = [&](auto skc, int t0, int t1) {
          constexpr int SK_ = decltype(skc)::value;
          for (int ti = t0; ti < t1; ++ti) {
            LAS unsigned char* cur = lds + ic * STG; LAS unsigned char* prv = lds + ((ic + 3) & 3) * STG; LAS unsigned char* nxt = lds + ((ic + 2) & 3) * STG;
            asm volatile("" : "+v"(lane), "+s"(wid)); const int r32 = lane & 31, hi = lane >> 5;
            if (ti == 0) { P.stage_extra(C, ZL_, wid, lane); if (hn) dma_rows64(Pn.qrow(C, wid), mk::DI, QL_, lane); }
            bool issued = true;
            if (ti + 2 < nt) dma_issue<DV, 1>(P.src(C), P.tile_row(ti + 2), nxt, wid, lane);
            else if (hn) dma_issue<DV, 1>(Pn.src(C), Pn.tile_row(ti + 2 - nt), nxt, wid, lane);
            else issued = false;
            P.prep(ti, wid, r32, hi, negm);
            if (P.needs(ti, wid)) {
                f32x16 p0, p1;
                qk_tile(cur, qf, r32, hi, p0, p1, negm[0], negm[Pol::NM - 1]);
                P.template mask<SK_>(C, ti, wid, r32, hi, p0, p1);
                if (pend) pv_sm_tile<DV, Pol::NM, SK_>(prv + 8192, lane, hi, pw, o, p0, p1, m, l, pwn, negm); else sm_alone<DV, Pol::NM, SK_>(p0, p1, o, m, l, pwn, negm);
#pragma unroll
                for (int k = 0; k < 4; ++k) pw[k] = pwn[k];
                pend = true;
            } else if (pend) { pv_tile<DV>(prv + 8192, lane, hi, pw, o); pend = false; }
            if (ti == 0) { if constexpr (EX == 4) { if (hn) ATT_WAIT_BAR(10); else ATT_WAIT_BAR(6); } else { if (hn) ATT_WAIT_BAR(11); else ATT_WAIT_BAR(7); } }
            else if (issued) ATT_WAIT_BAR(2); else ATT_WAIT_BAR(0);
            ic = (ic + 1) & 3;
          }
        };
        if constexpr (SKL == 0) steps(std::integral_constant<int, 0>{}, 0, nt);
        else { steps(std::integral_constant<int, 0>{}, 0, 4);
            steps(std::integral_constant<int, SKL>{}, 4, nt); }
        asm volatile("" : "+v"(lane), "+s"(wid)); const int r32 = lane & 31, hi = lane >> 5;
        if (pend) pv_tile<DV>(lds + ((ic + 3) & 3) * STG + 8192, lane, hi, pw, o);
        P.finish(C, o, m, l, wid, r32, hi, ZL_);
        if (!hn) break;
        P = Pn;
    }
    ATT_WAIT_BAR(0);
#undef ZL_
#undef QL_
}
}
namespace mk {
using att::Src; using att::crow; using att::ex2;

template <int DV>
__device__ __forceinline__ void store_gated(const f32x16 (&o)[DV / 32], float inv, const bf16* zrow, bf16* grow, int hi) {
#pragma unroll
    for (int d0 = 0; d0 < DV / 32; ++d0)
#pragma unroll
        for (int i = 0; i < 4; ++i) { const int d = 32 * d0 + 8 * i + 4 * hi;
            const u32x2 zw = *(const u32x2*)(zrow + d);
            const float v0 = o[d0][4 * i] * inv * silu(bflo(zw.x)), v1 = o[d0][4 * i + 1] * inv * silu(bfhi(zw.x)), v2 = o[d0][4 * i + 2] * inv * silu(bflo(zw.y)), v3 = o[d0][4 * i + 3] * inv * silu(bfhi(zw.y));
            u32x2 w; w.x = att::cvtpk(v0, v1); w.y = att::cvtpk(v2, v3); *(u32x2*)(grow + d) = w; }
}

__device__ __forceinline__ void store_gated_l(const f32x16 (&o)[2], float inv, LAS const unsigned char* zl, bf16* grow, int r32, int hi) {
#pragma unroll
    for (int d0 = 0; d0 < 2; ++d0)
#pragma unroll
        for (int i = 0; i < 4; ++i) { const int d = 32 * d0 + 8 * i + 4 * hi;
            const u32x2 zw = *(LAS const u32x2*)(zl + (2 * d0 + (i >> 1)) * 1024 + (r32 + 32 * (i & 1)) * 16 + 8 * hi);
            const float v0 = o[d0][4 * i] * inv * silu(bflo(zw.x)), v1 = o[d0][4 * i + 1] * inv * silu(bfhi(zw.x)), v2 = o[d0][4 * i + 2] * inv * silu(bflo(zw.y)), v3 = o[d0][4 * i + 3] * inv * silu(bfhi(zw.y));
            u32x2 w; w.x = att::cvtpk(v0, v1); w.y = att::cvtpk(v2, v3); *(u32x2*)(grow + d) = w; }
}

struct AttCtx { const bf16* QG; const bf16* Kb; const bf16* Vb; const bf16* Zb; const float* aux; LAS const float* tab; int dry; };
struct SwaPol {
    static constexpr int EXTRA = 4, NM = 1;
    int bl, hq, qb, tl0, ntl; float sinkl2;
    __device__ __forceinline__ size_t off() const { return ((size_t)bl * RB + CT + qb * 256) * DI + hq * 64; }
    __device__ __forceinline__ Src src(const AttCtx& C) const { Src s; s.K[0] = C.Kb + (hq >> 3) * 64; s.K[1] = nullptr; s.V = C.Vb + (hq >> 3) * 64; s.ldk = 256; s.ldv = 256; return s; }
    __device__ __forceinline__ void prep(int, int, int, int, f32x16 (&)[1]) const {}
    __device__ __forceinline__ int ntiles() const { return 4 + ntl; }
    __device__ __forceinline__ const bf16* qrow(const AttCtx& C, int wid) const { return C.QG + off() + (size_t)(wid * 32) * DI; }
    __device__ __forceinline__ void stage_extra(const AttCtx& C, LAS unsigned char* zl, int wid, int lane) const { att::dma_rows64(C.Zb + off() + (size_t)(wid * 32) * DI, DI, zl, lane); }
    __device__ __forceinline__ size_t tile_row(int ti) const { return (size_t)bl * RB + (ti < 4 ? 64 * ti : CT + 64 * (tl0 + ti - 4)); }
    __device__ __forceinline__ bool needs(int ti, int wid) const { if (ti < 4) return true; const int kt0 = 64 * (tl0 + ti - 4), qw0 = qb * 256 + 32 * wid; return kt0 <= qw0 + 31 + 128 && kt0 + 63 >= qw0 - 128; }
    __device__ __forceinline__ int skip(int, int) const { return 0; }
    template <int SK> __device__ __forceinline__ void mask(const AttCtx&, int ti, int wid, int r32, int hi, f32x16& p0, f32x16& p1) const {
        if (ti < 4) return;
        const int kt0 = 64 * (tl0 + ti - 4), qw0 = qb * 256 + 32 * wid;
        if (kt0 >= qw0 + 31 - 128 && kt0 + 63 <= qw0 + 128) return;
        const int qt = qw0 + r32;
#pragma unroll
        for (int r = 0; r < 16; ++r) { const int kt = kt0 + crow(r, hi); int d0 = kt - qt; d0 = d0 < 0 ? -d0 : d0; int d1 = kt + 32 - qt; d1 = d1 < 0 ? -d1 : d1;
            if (d0 > 128) p0[r] = -INFINITY; if (d1 > 128) p1[r] = -INFINITY; }
    }
    __device__ __forceinline__ void finish(const AttCtx& C, f32x16 (&o)[2], float m, float l, int wid, int r32, int hi, LAS const unsigned char* zl) const {
        const float mn = fmaxf(m, sinkl2), alpha = ex2(m - mn);
        const float lt = (l + __shfl_xor(l, 32)) * alpha + ex2(sinkl2 - mn);
        const float inv = alpha / lt;
        if (!C.dry) store_gated_l(o, inv, zl, (bf16*)C.QG + off() + (size_t)(wid * 32 + r32) * DI, r32, hi);
    }
};
__device__ __forceinline__ void swa_phase(Frame& F, const Args& a, int g, int dry) {
    int lane_ = pg8::hw_lane(), wave_ = F.wave; asm volatile("" : "+v"(lane_), "+s"(wave_));
    AttCtx C; C.QG = (const bf16*)(a.ws + WS_QG) + (size_t)g * MH * DI; C.Kb = (const bf16*)(a.ws + WS_S2); C.Vb = C.Kb + (size_t)MH * 256; C.Zb = (const bf16*)(a.ws + WS_S4); C.aux = a.in[30]; C.tab = nullptr; C.dry = dry;
    const int G = F.G, vcu = F.vcu;
    auto gen = [&](int i, SwaPol& P) -> bool {
        const int id = i * G + vcu; if (id >= HB * 32 * 8) return false;
        P.qb = (id + i) & 7; P.hq = (id >> 3) & 31; P.bl = id >> 8;
        P.tl0 = max(0, 4 * P.qb - 2); P.ntl = min(31, 4 * P.qb + 5) - P.tl0 + 1; P.sinkl2 = C.aux[P.hq] * LOG2E;
        return true; };
    att::run_stream1<SwaPol, 0>(F.lds, C, gen, wave_, lane_);
}

constexpr int NA_TAB_OFF = RING_BYTES + 512;
struct NaPol {
    static constexpr int EXTRA = 5, NM = 2;
    int bl, hq, qb, krow0, ntl, isctx;
    __device__ __forceinline__ size_t off() const { return ((size_t)bl * RB + (isctx ? 0 : CT + qb * 256)) * DI + hq * 64; }
    __device__ __forceinline__ Src src(const AttCtx& C) const { Src s; s.K[0] = C.Kb + hq * 64; s.K[1] = nullptr; s.V = C.Vb + hq * 64; s.ldk = DI; s.ldv = DI; return s; }
    __device__ __forceinline__ void prep(int ti, int wid, int r32, int hi, f32x16 (&negm)[2]) const {
        if (ti != 4) return;
        const int gc = 32 * (wid & 1) + r32, cs = min(max(gc - 8, 0), 48);
#pragma unroll
        for (int r = 0; r < 16; ++r) { const int kc = crow(r, hi);
            if (!(kc >= cs && kc < cs + 16)) negm[0][r] = -INFINITY;
            if (!(kc + 32 >= cs && kc + 32 < cs + 16)) negm[1][r] = -INFINITY; }
    }
    __device__ __forceinline__ int ntiles() const { return 4 + ntl; }
    __device__ __forceinline__ const bf16* qrow(const AttCtx& C, int wid) const { return C.QG + off() + (size_t)(wid * 32) * DI; }
    __device__ __forceinline__ void stage_extra(const AttCtx& C, LAS unsigned char* zl, int wid, int lane) const {
        att::dma_rows64(C.Zb + off() + (size_t)(wid * 32) * DI, DI, zl, lane);
        att::glds4s(C.aux + hq * 465, (unsigned)min(wid * 64 + lane, 464) * 4u, (unsigned)__builtin_amdgcn_readfirstlane((unsigned)(size_t)C.tab + wid * 256));
    }
    __device__ __forceinline__ size_t tile_row(int ti) const { return (size_t)bl * RB + (ti < 4 ? 64 * ti : CT + 64 * (krow0 + ti - 4)); }
    __device__ __forceinline__ bool needs(int ti, int wid) const { if (ti < 4) return true; const int gr = 4 * qb + (wid >> 1), rs = min(max(gr - 4, 0), 24), kr = krow0 + ti - 4; return kr >= rs && kr < rs + 8; }
    __device__ __forceinline__ int skip(int ti, int wid) const { return ti < 4 ? 0 : 1 + (wid & 1); }
    template <int SK> __device__ __forceinline__ void mask(const AttCtx& C, int ti, int wid, int r32, int hi, f32x16& p0, f32x16& p1) const {
        if (ti < 4) return;
        const int gr = 4 * qb + (wid >> 1), gc = 32 * (wid & 1) + r32, kr = krow0 + ti - 4;
        LAS const float* trow = C.tab + (kr - gr + 7) * 31 + 15 - gc;
#pragma unroll
        for (int r = 0; r < 16; ++r) { const int kc = crow(r, hi);
            if (att::sm_live0<SK>(r)) p0[r] = fmaf(trow[kc], LOG2E, p0[r]);
            if (att::sm_live1<SK>(r)) p1[r] = fmaf(trow[kc + 32], LOG2E, p1[r]);
            if ((r & 3) == 3) __builtin_amdgcn_sched_barrier(0); }
    }
    __device__ __forceinline__ void finish(const AttCtx& C, f32x16 (&o)[2], float m, float l, int wid, int r32, int hi, LAS const unsigned char* zl) const {
        const float inv = 1.f / (l + __shfl_xor(l, 32));
        if (!C.dry) store_gated_l(o, inv, zl, (bf16*)C.QG + off() + (size_t)(wid * 32 + r32) * DI, r32, hi);
    }
};
__device__ __forceinline__ void na_phase(Frame& F, const Args& a, int g, int dry) {
    int lane_ = pg8::hw_lane(), wave_ = F.wave; asm volatile("" : "+v"(lane_), "+s"(wave_));
    AttCtx C; C.QG = (const bf16*)(a.ws + WS_QG) + (size_t)g * MH * DI; C.Kb = (const bf16*)(a.ws + WS_S2); C.Vb = (const bf16*)(a.ws + WS_S3); C.Zb = (const bf16*)(a.ws + WS_S4); C.aux = a.in[27]; C.tab = (LAS const float*)(F.lds + NA_TAB_OFF); C.dry = dry;
    constexpr int NLAT = HB * 32 * 8, NCTX = HB * 32;
    const int G = F.G, vcu = F.vcu;
    auto gen = [&](int i, NaPol& P) -> bool {
        const int id = i * G + vcu; if (id >= NLAT + NCTX) return false;
        if (id < NLAT) { P.isctx = 0; P.qb = (id + i) & 7; P.hq = (id >> 3) & 31; P.bl = id >> 8; P.krow0 = min(max(4 * P.qb - 4, 0), 24); P.ntl = min(max(4 * P.qb + 3 - 4, 0), 24) + 7 - P.krow0 + 1; }
        else { const int j = id - NLAT; P.isctx = 1; P.qb = 0; P.hq = j & 31; P.bl = j >> 5; P.krow0 = 0; P.ntl = 0; }
        return true; };
    if (wave_ & 1) att::run_stream1<NaPol, 2>(F.lds, C, gen, wave_, lane_); else att::run_stream1<NaPol, 1>(F.lds, C, gen, wave_, lane_);
}

template <int COMP>
__device__ __forceinline__ void diff_unit(LAS unsigned char* lds, const Src& src, const bf16* Q  , const bf16* zb, bf16* gb, size_t trow0, int nt, float lam, float lam_init, const float* sg, int wid, int lane, int dry) {
    const int r32 = lane & 31, hi = lane >> 5, wq = wid & 3; constexpr int comp = COMP;
    constexpr int STG = 32768;
    att::dma_issue<128, 2>(src, trow0, lds, wid, lane);
    if (nt > 1) att::dma_issue<128, 2>(src, trow0 + 64, lds + STG, wid, lane);
    bf16x8 qf[4];
    { const bf16* qp = Q + (size_t)(wq * 32 + r32) * DI + comp * 64 + hi * 8;
#pragma unroll
      for (int d0 = 0; d0 < 4; ++d0) qf[d0] = *(const bf16x8*)(qp + d0 * 16); }
    f32x16 o[4];
#pragma unroll
    for (int d0 = 0; d0 < 4; ++d0) o[d0] = f32x16{};
    float m = -INFINITY, l = 0.f; f32x16 negm[1] = {f32x16{}};
    u32x4 pw[4], pwn[4];
    asm volatile("" : "+v"(qf[0]), "+v"(qf[1]), "+v"(qf[2]), "+v"(qf[3]));
    ATT_WAIT_BAR(0);
    if constexpr (COMP == 0) {
        int ic = 0;
        for (int ti = 0; ti < nt; ++ti) {
            LAS unsigned char* cur = lds + ic * STG; LAS unsigned char* prv = lds + ((ic + 3) & 3) * STG;
            if (ti >= 1 && ti + 1 < nt) att::dma_issue<128, 2>(src, trow0 + 64 * (ti + 1), lds + ((ic + 1) & 3) * STG, wid, lane);
            { f32x16 p0, p1; att::qk_tile(cur, qf, r32, hi, p0, p1, negm[0], negm[0]);
              if (ti > 0) att::pv_sm_tile<128, 1>(prv + 16384, lane, hi, pw, o, p0, p1, m, l, pwn, negm); else att::sm_alone<128, 1>(p0, p1, o, m, l, pwn, negm); }
#pragma unroll
            for (int k = 0; k < 4; ++k) pw[k] = pwn[k];
            ATT_WAIT_BAR(0);
            ic = (ic + 1) & 3;
        }
        att::pv_tile<128>(lds + ((ic + 3) & 3) * STG + 16384, lane, hi, pw, o);
    } else {
        f32x16 p0, p1;
        att::qk_tile(lds + 8192, qf, r32, hi, p0, p1, negm[0], negm[0]);
        ATT_WAIT_BAR(0);
        int ic = 1;
        for (int ti = 1; ti < nt; ++ti) {
            LAS unsigned char* cur = lds + ic * STG; LAS unsigned char* pv2 = lds + ((ic + 2) & 3) * STG;
            if (ti + 1 < nt) att::dma_issue<128, 2>(src, trow0 + 64 * (ti + 1), lds + ((ic + 1) & 3) * STG, wid, lane);
            if (ti >= 2) att::pv_sm_tile<128, 1>(pv2 + 16384, lane, hi, pw, o, p0, p1, m, l, pwn, negm); else att::sm_alone<128, 1>(p0, p1, o, m, l, pwn, negm);
#pragma unroll
            for (int k = 0; k < 4; ++k) pw[k] = pwn[k];
            att::qk_tile(cur + 8192, qf, r32, hi, p0, p1, negm[0], negm[0]);
            ATT_WAIT_BAR(0);
            ic = (ic + 1) & 3;
        }
        if (nt >= 2) att::pv_sm_tile<128, 1>(lds + ((ic + 2) & 3) * STG + 16384, lane, hi, pw, o, p0, p1, m, l, pwn, negm); else att::sm_alone<128, 1>(p0, p1, o, m, l, pwn, negm);
#pragma unroll
        for (int k = 0; k < 4; ++k) pw[k] = pwn[k];
        att::pv_tile<128>(lds + ((ic + 3) & 3) * STG + 16384, lane, hi, pw, o);
    }
    ATT_WAIT_BAR(0);
    const float inv = 1.f / (l + __shfl_xor(l, 32));
    LAS float* xb = (LAS float*)lds;
    if (comp == 1) {
#pragma unroll
        for (int d0 = 0; d0 < 4; ++d0)
#pragma unroll
            for (int r = 0; r < 16; ++r) xb[((wq * 64 + d0 * 16 + r) * 64) + lane] = o[d0][r] * inv;
    }
    __syncthreads();
    if (comp == 0 && !dry) {
        float ss = 0.f;
#pragma unroll
        for (int d0 = 0; d0 < 4; ++d0)
#pragma unroll
            for (int r = 0; r < 16; ++r) { const float v = o[d0][r] * inv - lam * xb[((wq * 64 + d0 * 16 + r) * 64) + lane]; o[d0][r] = v; ss += v * v; }
        ss += __shfl_xor(ss, 32);
        const float rs = rsqrtf(ss * (1.f / 128.f) + EPS) * (1.f - lam_init);
        const size_t ro = (size_t)(wq * 32 + r32) * DI;
#pragma unroll
        for (int d0 = 0; d0 < 4; ++d0)
#pragma unroll
            for (int i = 0; i < 4; ++i) { const int d = 32 * d0 + 8 * i + 4 * hi; const f32x4 gg = *(const f32x4*)(sg + d); const u32x2 zw = *(const u32x2*)(zb + ro + d);
                const float v0 = o[d0][4 * i] * rs * gg.x * silu(bflo(zw.x)), v1 = o[d0][4 * i + 1] * rs * gg.y * silu(bfhi(zw.x)), v2 = o[d0][4 * i + 2] * rs * gg.z * silu(bflo(zw.y)), v3 = o[d0][4 * i + 3] * rs * gg.w * silu(bfhi(zw.y));
                u32x2 w; w.x = att::cvtpk(v0, v1); w.y = att::cvtpk(v2, v3); *(u32x2*)(gb + ro + d) = w; }
    }
    asm volatile("s_waitcnt lgkmcnt(0)\n\ts_barrier" ::: "memory");
}
__device__ __forceinline__ void diff_phase(Frame& F, const Args& a, int g, int dry) {
#ifdef MK_TOUCH2
    {
        const int j = F.vcu & 31; unsigned accv = 0u;
        for (size_t off = ((size_t)j * NTHR + F.wave * 64 + pg8::hw_lane()) * 4096; off < (size_t)216 * MiB; off += (size_t)32 * NTHR * 4096) accv += *(const unsigned*)(a.ws + WS_S2 + off);
        for (size_t off = ((size_t)j * NTHR + F.wave * 64 + pg8::hw_lane()) * 4096; off < (size_t)72 * MiB; off += (size_t)32 * NTHR * 4096) accv += *(const unsigned*)(a.ws + WS_QG + (size_t)g * MH * DI * 2 + off);
        asm volatile("" :: "v"(accv));
    }
#endif
    int lane_ = pg8::hw_lane(), wave_ = F.wave; asm volatile("" : "+v"(lane_), "+s"(wave_));
    const bf16* QG = (const bf16*)(a.ws + WS_QG) + (size_t)g * MH * DI; const bf16* Kb = (const bf16*)(a.ws + WS_S2); const bf16* Vb = (const bf16*)(a.ws + WS_S3); const bf16* Zb = (const bf16*)(a.ws + WS_S4);
    const float lam_init = 0.8f - 0.6f * expf(-0.3f);
    float sa = 0.f, sb = 0.f;
    for (int i = 0; i < 64; ++i) { sa += a.in[20][i] * a.in[21][i]; sb += a.in[22][i] * a.in[23][i]; }
    const float lam = expf(sa) - expf(sb) + lam_init;
    constexpr int NLAT = HB * 16 * 16, NCTX = HB * 16 * 2;
    const int G = F.G, vcu = F.vcu; LAS unsigned char* lds = F.lds; const float* sg = a.in[24];
    auto units = [&](auto cc) {
        constexpr int COMP = decltype(cc)::value;
        for (int i = 0;; ++i) {
            const int id = i * G + vcu; if (id >= NLAT + NCTX) break;
            int bl, h, qb, nt; size_t row0;
            if (id < NLAT) { qb = id & 15; h = (id >> 4) & 15; bl = id >> 8; nt = RB / 64; row0 = (size_t)bl * RB + CT + qb * 128; }
            else { const int j = id - NLAT; qb = j & 1; h = (j >> 1) & 15; bl = j >> 5; nt = CT / 64; row0 = (size_t)bl * RB + qb * 128; }
            Src s; s.K[0] = Kb + (2 * h) * 64; s.K[1] = Kb + (2 * h + 1) * 64; s.V = Vb + h * 128; s.ldk = DI; s.ldv = DI;
            diff_unit<COMP>(lds, s, QG + row0 * DI + h * 128, Zb + row0 * DI + h * 128, (bf16*)QG + row0 * DI + h * 128, (size_t)bl * RB, nt, lam, lam_init, sg, wave_, lane_, dry);
        }
    };
    if (wave_ >> 2) units(std::integral_constant<int, 1>{}); else units(std::integral_constant<int, 0>{});
}
}
namespace mk {
typedef float f32x4v __attribute__((ext_vector_type(4)));
__device__ __forceinline__ void seq_bounds(int row, int& lo, int& hi) { const int rr = row % RB, b0 = row - rr; if (rr < CT) { lo = b0; hi = b0 + CT; } else { lo = b0 + CT; hi = b0 + RB; } }

#ifndef MK_GATES_Q
#define MK_GATES_Q 4
#endif
__device__ __forceinline__ void mlstm_gates_phase(Frame& F, const Args& a, int g) {
    int lane = pg8::hw_lane(), wave = F.wave; asm volatile("" : "+v"(lane), "+s"(wave));
    const bf16* XM = (const bf16*)(a.ws + WS_S2); const bf16* W2 = (const bf16*)(a.ws + WS_WG2);
    bf16* XC = g == 0 ? (bf16*)(a.ws + WS_QG) + (size_t)MH * DI : (bf16*)(a.ws + WS_H);
    const float* cw = a.in[9]; const float* cb = a.in[10]; const float* bg = a.in[15];
    LAS float* T = (LAS float*)F.lds;
    constexpr int G_W2S = 12288, G_XS = G_W2S + 64 * 1040;
    const int khw = (int)blockIdx.x & 3;
    { const int tid = wave * 64 + lane;
      for (int i = tid; i < 5 * 128; i += NTHR) { const int j = i >> 7, c4 = (i & 127) * 4; *(LAS f32x4v*)(T + j * 512 + c4) = *(const f32x4v*)(cw + j * 2048 + khw * 512 + c4); }
      for (int i = tid; i < 128; i += NTHR) *(LAS f32x4v*)(T + 2560 + 4 * i) = *(const f32x4v*)(cb + khw * 512 + 4 * i);
      for (int i = tid; i < 64 * 64; i += NTHR) { const int rw = i >> 6, c8 = (i & 63) * 8;
          *(LAS u32x4*)(F.lds + G_W2S + (rw * 520 + c8) * 2) = *(const u32x4*)(W2 + (size_t)(rw >> 1) * 4096 + (rw & 1) * 2048 + khw * 512 + c8); }
      __syncthreads(); }
    const int r = lane & 15, kq = lane >> 4;
    LAS unsigned char* xs = F.lds + G_XS + wave * 5440;
    const int kh = khw;
    float* gates = (float*)(a.ws + (kh == 0 ? WS_GATES : kh == 1 ? WS_GATES2 : kh == 2 ? WS_GATES3 : WS_GATES4));
    for (int grp = ((int)blockIdx.x >> 2) + 64 * wave; grp < MH / 16; grp += 64 * NWAVES) {
        const int row0 = grp * 16, row = row0 + r; int lo, hi; seq_bounds(row0, lo, hi);
        pg8::f32x4 acc0 = {0.f, 0.f, 0.f, 0.f}, acc1 = {0.f, 0.f, 0.f, 0.f};
        u32x4 xg[5];
#define ML_GLOAD(sb_) do { _Pragma("unroll") for (int j = 0; j < 5; ++j) { const int sr = row0 - 2 + 4 * j + (lane >> 4); \
            xg[j] = (sr >= lo && sr < hi) ? *(const u32x4*)(XM + (size_t)sr * DI + kh * 512 + (sb_) * 128 + (lane & 15) * 8) : (u32x4){0u, 0u, 0u, 0u}; } } while (0)
        ML_GLOAD(0);
        for (int sb = 0; sb < 4; ++sb) {
#pragma unroll
            for (int j = 0; j < 5; ++j) *(LAS u32x4*)(xs + (4 * j + (lane >> 4)) * 272 + (lane & 15) * 16) = xg[j];
            if (sb + 1 < 4) ML_GLOAD(sb + 1);
#pragma unroll
            for (int q = 0; q < 4; ++q) { const int cl = sb * 128 + q * 32 + 8 * kq, c0 = kh * 512 + cl;
                LAS const unsigned char* wl = F.lds + G_W2S + cl * 2; LAS const unsigned char* xl = xs + r * 272 + (q * 32 + 8 * kq) * 2;
                const bf16x8 wf0 = *(LAS const bf16x8*)(wl + (2 * r) * 1040), wf1 = *(LAS const bf16x8*)(wl + (2 * (r + 16)) * 1040), wf2 = *(LAS const bf16x8*)(wl + (2 * r + 1) * 1040), wf3 = *(LAS const bf16x8*)(wl + (2 * (r + 16) + 1) * 1040);
                const f32x4v b0 = *(LAS const f32x4v*)(T + 2560 + cl), b1 = *(LAS const f32x4v*)(T + 2560 + cl + 4);
                float av[8] = {b0.x, b0.y, b0.z, b0.w, b1.x, b1.y, b1.z, b1.w};
                u32x4 xmid;
#pragma unroll
                for (int j = 0; j < 5; ++j) { const u32x4 x = *(LAS const u32x4*)(xl + j * 272); if (j == 2) xmid = x;
                    const f32x4v w0 = *(LAS const f32x4v*)(T + j * 512 + cl), w1 = *(LAS const f32x4v*)(T + j * 512 + cl + 4);
                    av[0] += bflo(x.x) * w0.x; av[1] += bfhi(x.x) * w0.y; av[2] += bflo(x.y) * w0.z; av[3] += bfhi(x.y) * w0.w;
                    av[4] += bflo(x.z) * w1.x; av[5] += bfhi(x.z) * w1.y; av[6] += bflo(x.w) * w1.z; av[7] += bfhi(x.w) * w1.w; }
                u32x4 xcw; xcw.x = att::cvtpk(silu(av[0]), silu(av[1])); xcw.y = att::cvtpk(silu(av[2]), silu(av[3])); xcw.z = att::cvtpk(silu(av[4]), silu(av[5])); xcw.w = att::cvtpk(silu(av[6]), silu(av[7]));
                *(u32x4*)(XC + (size_t)row * DI + c0) = xcw;
                const bf16x8 axc = __builtin_bit_cast(bf16x8, xcw), axm = __builtin_bit_cast(bf16x8, xmid);
                acc0 = __builtin_amdgcn_mfma_f32_16x16x32_bf16(axc, wf0, acc0, 0, 0, 0); acc1 = __builtin_amdgcn_mfma_f32_16x16x32_bf16(axc, wf1, acc1, 0, 0, 0);
                acc0 = __builtin_amdgcn_mfma_f32_16x16x32_bf16(axm, wf2, acc0, 0, 0, 0); acc1 = __builtin_amdgcn_mfma_f32_16x16x32_bf16(axm, wf3, acc1, 0, 0, 0); }
            asm volatile("s_waitcnt lgkmcnt(0)" ::: "memory");
        }
#undef ML_GLOAD
        const float bg0 = kh == 0 ? bg[r] : 0.f, bg1 = kh == 0 ? bg[16 + r] : 0.f;
#pragma unroll
        for (int rg = 0; rg < 4; ++rg) { const size_t tk = (size_t)grp * 16 + 4 * kq + rg; gates[tk * 32 + r] = acc0[rg] + bg0; gates[tk * 32 + 16 + r] = acc1[rg] + bg1; }
    }
    __syncthreads();
}

#define ML_BAR() asm volatile("s_waitcnt lgkmcnt(0)\n\ts_barrier" ::: "memory")
#ifndef MK_SC_A
#define MK_SC_A 1
#endif
#ifndef MK_SC_B
#define MK_SC_B 1
#endif
constexpr int ML_QS = 0, ML_KS = 33792, ML_VS = 67584, ML_P = 84992, ML_HO = 94208, ML_F = 110592;
constexpr int ML_W1 = RING_BYTES + 512  , ML_WV = 115200  ;
constexpr int ML_KSTR = 528, ML_VSTR = 272, ML_PSTR = 144;
__device__ __forceinline__ int ml_row(int base, int dir, int s) { return base + (dir == 0 ? s : (s < CT ? CT - 1 - s : CT + (S - 1) - (s - CT))); }
__device__ __forceinline__ s16x4 ml_tr(LAS const unsigned char* p) { return __builtin_bit_cast(s16x4, __builtin_amdgcn_ds_read_tr16_b64_v4i16((LAS att::v4i16_t*)p)); }
__device__ __forceinline__ void mlstm_scan_phase(Frame& F, const Args& a, int g) {
    int tid0 = F.wave * 64 + pg8::hw_lane(); asm volatile("" : "+v"(tid0));
    const int wid = __builtin_amdgcn_readfirstlane(tid0 >> 6);
    const int u = F.vcu; if (u >= HB * 8 * 2 * 2) return;
    const int dvh = u & 1, dir = (u >> 1) & 1, h = (u >> 2) & 7, bl = u >> 5;
    const bf16* XM = (const bf16*)(a.ws + WS_S2); const float* gates = (const float*)(a.ws + WS_GATES); const float* gates2 = (const float*)(a.ws + WS_GATES2); const float* gates3 = (const float*)(a.ws + WS_GATES3); const float* gates4 = (const float*)(a.ws + WS_GATES4);
    const bf16* XC = g == 0 ? (const bf16*)(a.ws + WS_QG) + (size_t)MH * DI : (const bf16*)(a.ws + WS_H);
    bf16* Hd = dir == 0 ? (bf16*)(a.ws + WS_QG) + (size_t)g * MH * DI : (bf16*)(a.ws + WS_S4);
    const float* cw = a.in[9]; const float* cb = a.in[10]; const float* wq = a.in[11]; const float* wk = a.in[12]; const float* wv = a.in[13];
    LAS unsigned char* L = F.lds; LAS float* Ff = (LAS float*)(L + ML_F);
    pg8::f32x4 C[16];
#pragma unroll
    for (int i = 0; i < 16; ++i) C[i] = (pg8::f32x4){0.f, 0.f, 0.f, 0.f};
    int tid = tid0;
    if (tid < 256) { Ff[640 + tid] = 0.f; }
    {
        LAS float* W1 = (LAS float*)(L + ML_W1); LAS float* WV = (LAS float*)(L + ML_WV);
        for (int i = tid; i < 5 * 256; i += NTHR) W1[i] = cw[(i >> 8) * DI + h * 256 + (i & 255)];
        if (tid < 256) W1[1280 + tid] = cb[h * 256 + tid];
        for (int i = tid; i < 1024; i += NTHR) { W1[1536 + i] = wq[h * 1024 + i]; W1[2560 + i] = wk[h * 1024 + i]; WV[i] = wv[h * 1024 + i]; }
        __syncthreads();
    }
    LAS const float* W1 = (LAS const float*)(L + ML_W1); LAS const float* WV = (LAS const float*)(L + ML_WV);
    bf16x8 aq[2], ak[2], av_[2], aql[2], akl[2], avl[2];
    { const int o = tid0 & 15, g4 = (tid0 >> 4) & 3;
#pragma unroll
      for (int n = 0; n < 2; ++n) { const int bo = 4 * n + (o >> 2); u32x4 fq, fk, fv, lq, lk, lv; unsigned* pq = (unsigned*)&fq; unsigned* pk_ = (unsigned*)&fk; unsigned* pv_ = (unsigned*)&fv; unsigned* qq_ = (unsigned*)&lq; unsigned* qk_ = (unsigned*)&lk; unsigned* qv_ = (unsigned*)&lv;
#pragma unroll
          for (int jp = 0; jp < 4; ++jp) { float q2[2], k2[2], v2[2], q2l[2], k2l[2], v2l[2];
#pragma unroll
              for (int e = 0; e < 2; ++e) { const int j = 2 * jp + e, bi = 2 * g4 + (j >> 2); const bool nz = bi == bo; const int gb = wid * 8 + bo, idx = gb * 16 + (j & 3) * 4 + (o & 3);
                  q2[e] = nz ? W1[1536 + idx] : 0.f; k2[e] = nz ? W1[2560 + idx] * 0.0625f : 0.f; v2[e] = nz ? WV[idx] : 0.f;
                  q2l[e] = q2[e] - bf2f((unsigned short)f2bf(q2[e])); k2l[e] = k2[e] - bf2f((unsigned short)f2bf(k2[e])); v2l[e] = v2[e] - bf2f((unsigned short)f2bf(v2[e])); }
              pq[jp] = pk2(q2[0], q2[1]); pk_[jp] = pk2(k2[0], k2[1]); pv_[jp] = pk2(v2[0], v2[1]);
              qq_[jp] = pk2(q2l[0], q2l[1]); qk_[jp] = pk2(k2l[0], k2l[1]); qv_[jp] = pk2(v2l[0], v2l[1]); }
          aq[n] = __builtin_bit_cast(bf16x8, fq); ak[n] = __builtin_bit_cast(bf16x8, fk); av_[n] = __builtin_bit_cast(bf16x8, fv);
          aql[n] = __builtin_bit_cast(bf16x8, lq); akl[n] = __builtin_bit_cast(bf16x8, lk); avl[n] = __builtin_bit_cast(bf16x8, lv); } }
    const int base = bl * RB;
    u32x4 xw[8];
#define ML_LOADX(cc) do { const int rlo_ = dir ? ml_row(base, 1, (cc) * 64 + 63) : ml_row(base, 0, (cc) * 64); \
        const size_t o_ = (size_t)(rlo_ + (tid0 & 15)) * DI + h * 256 + wid * 32 + ((tid0 >> 4) & 3) * 8; \
        _Pragma("unroll") for (int i_ = 0; i_ < 4; ++i_) { xw[i_] = *(const u32x4*)(XM + o_ + (size_t)(16 * i_) * DI); xw[4 + i_] = *(const u32x4*)(XC + o_ + (size_t)(16 * i_) * DI); } } while (0)
    const int gwave = dvh == 0 ? 4 : 0;
    float gpre[8] = {0.f, 0.f, 0.f, 0.f, 0.f, 0.f, 0.f, 0.f};
#define ML_LOADG(cc) do { if (wid == gwave) { const size_t gi_ = (size_t)ml_row(base, dir, (cc) * 64 + (tid0 & 63)) * 32 + (2 * dir) * 8 + h; \
        gpre[0] = gates[gi_]; gpre[1] = gates2[gi_]; gpre[2] = gates3[gi_]; gpre[3] = gates4[gi_]; gpre[4] = gates[gi_ + 8]; gpre[5] = gates2[gi_ + 8]; gpre[6] = gates3[gi_ + 8]; gpre[7] = gates4[gi_ + 8]; } } while (0)
    ML_LOADX(0); ML_LOADG(0);
    for (int c = 0; c < RB / 64; ++c) {
        const int par = c & 1;
        tid = tid0; asm volatile("" : "+v"(tid));
        const int lane = tid & 63, l15 = lane & 15, gq = lane >> 4;
#pragma unroll 1
        for (int repA_ = 0; repA_ < MK_SC_A; ++repA_) {
        {
            const bool hasv = (wid >> 2) == dvh;
            const pg8::f32x4 z4 = {0.f, 0.f, 0.f, 0.f};
#pragma unroll
            for (int tt = 0; tt < 4; ++tt) {
                const bf16x8 bxm = __builtin_bit_cast(bf16x8, xw[tt]), bxc = __builtin_bit_cast(bf16x8, xw[4 + tt]);
                const int mrow = 16 * tt + l15, t = dir ? 63 - mrow : mrow;
#pragma unroll
                for (int n = 0; n < 2; ++n) {
                    const pg8::f32x4 dq = __builtin_amdgcn_mfma_f32_16x16x32_bf16(aq[n], bxc, __builtin_amdgcn_mfma_f32_16x16x32_bf16(aql[n], bxc, z4, 0, 0, 0), 0, 0, 0), dk = __builtin_amdgcn_mfma_f32_16x16x32_bf16(ak[n], bxc, __builtin_amdgcn_mfma_f32_16x16x32_bf16(akl[n], bxc, z4, 0, 0, 0), 0, 0, 0);
                    const int cl = wid * 32 + 16 * n + 4 * gq;
                    u32x2 w2; w2.x = att::cvtpk(dq[0], dq[1]); w2.y = att::cvtpk(dq[2], dq[3]); *(LAS u32x2*)(L + ML_QS + t * ML_KSTR + cl * 2) = w2;
                    w2.x = att::cvtpk(dk[0], dk[1]); w2.y = att::cvtpk(dk[2], dk[3]); *(LAS u32x2*)(L + ML_KS + t * ML_KSTR + cl * 2) = w2;
                    if (hasv) { const pg8::f32x4 dv = __builtin_amdgcn_mfma_f32_16x16x32_bf16(av_[n], bxm, __builtin_amdgcn_mfma_f32_16x16x32_bf16(avl[n], bxm, z4, 0, 0, 0), 0, 0, 0);
                        w2.x = att::cvtpk(dv[0], dv[1]); w2.y = att::cvtpk(dv[2], dv[3]); *(LAS u32x2*)(L + ML_VS + t * ML_VSTR + (cl & 127) * 2) = w2; }
                }
            }
        }
#if defined(MK_SC_G2)
        for (int repg_ = 0; repg_ < 2; ++repg_)
#endif
        if (wid == gwave) {
            const float gi = (gpre[0] + gpre[1]) + (gpre[2] + gpre[3]), gf = (gpre[4] + gpre[5]) + (gpre[6] + gpre[7]);
            const float lf = fminf(gf, 0.f) - log1pf(__expf(-fabsf(gf)));
            float b = lf;
#pragma unroll
            for (int o = 1; o < 64; o <<= 1) { const float y = __shfl_up(b, o); if (lane >= o) b += y; }
            const float bend = __shfl(b, 63);
            Ff[lane] = b * LOG2E; Ff[64 + lane] = (gi - b) * LOG2E; Ff[128 + lane] = __expf(b); Ff[192 + lane] = __expf(bend - b + gi);
            if (lane == 0) Ff[576] = __expf(bend);
        }
        }
        ML_BAR();
#if defined(MK_SC_L2)
        if (c + 1 < RB / 64) { ML_LOADX(c + 1); ML_LOADG(c + 1); asm volatile("" : "+v"(xw[0]), "+v"(xw[1]), "+v"(xw[2]), "+v"(xw[3]), "+v"(xw[4]), "+v"(xw[5]), "+v"(xw[6]), "+v"(xw[7])); }
#endif
        if (c + 1 < RB / 64) { ML_LOADX(c + 1); ML_LOADG(c + 1); }
        for (int repB_ = 0; repB_ < MK_SC_B; ++repB_) {
        {
            const int si = wid >> 1;
            pg8::f32x4 st[2] = {{0.f, 0.f, 0.f, 0.f}, {0.f, 0.f, 0.f, 0.f}};
            LAS const unsigned char* kp = L + ML_KS + (16 * si + l15) * ML_KSTR + gq * 16;
            LAS const unsigned char* qp0 = L + ML_QS + (16 * (2 * (wid & 1)) + l15) * ML_KSTR + gq * 16;
#pragma unroll
            for (int ks = 0; ks < 8; ++ks) {
                const bf16x8 ka = *(LAS const bf16x8*)(kp + ks * 64);
                const bf16x8 q0 = *(LAS const bf16x8*)(qp0 + ks * 64), q1 = *(LAS const bf16x8*)(qp0 + 16 * ML_KSTR + ks * 64);
                st[0] = __builtin_amdgcn_mfma_f32_16x16x32_bf16(ka, q0, st[0], 0, 0, 0);
                st[1] = __builtin_amdgcn_mfma_f32_16x16x32_bf16(ka, q1, st[1], 0, 0, 0);
            }
            const f32x4v al = *(LAS const f32x4v*)(Ff + 64 + 16 * si + 4 * gq);
            const float alv[4] = {al.x, al.y, al.z, al.w};
#pragma unroll
            for (int e = 0; e < 2; ++e) {
                const int ti = 2 * (wid & 1) + e, t = 16 * ti + l15; const float bt = Ff[t];
                float pv[4], rsum = 0.f;
#pragma unroll
                for (int r = 0; r < 4; ++r) { const int s = 16 * si + 4 * gq + r; const float wgt = (s <= t) ? att::ex2(bt + alv[r]) : 0.f; pv[r] = st[e][r] * wgt; rsum += pv[r]; }
                u32x2 w2; w2.x = att::cvtpk(pv[0], pv[1]); w2.y = att::cvtpk(pv[2], pv[3]);
                *(LAS u32x2*)(L + ML_P + t * ML_PSTR + (16 * si + 4 * gq) * 2) = w2;
                rsum += __shfl_xor(rsum, 16); rsum += __shfl_xor(rsum, 32);
                if (gq == 0) Ff[320 + si * 64 + t] = rsum;
            }
        }
        {
            const int t = tid >> 3, part = tid & 7; LAS const float* np_ = Ff + 640 + par * 256 + part * 32; LAS const unsigned char* qrow = L + ML_QS + t * ML_KSTR + part * 64;
            float acc = 0.f;
#pragma unroll
            for (int i = 0; i < 4; ++i) { const u32x4 qw = *(LAS const u32x4*)(qrow + i * 16); const f32x4v n0 = *(LAS const f32x4v*)(np_ + i * 8), n1 = *(LAS const f32x4v*)(np_ + i * 8 + 4);
                acc += bflo(qw.x) * n0.x + bfhi(qw.x) * n0.y + bflo(qw.y) * n0.z + bfhi(qw.y) * n0.w + bflo(qw.z) * n1.x + bfhi(qw.z) * n1.y + bflo(qw.w) * n1.z + bfhi(qw.w) * n1.w; }
            acc += __shfl_xor(acc, 1); acc += __shfl_xor(acc, 2); acc += __shfl_xor(acc, 4);
            if (part == 0) Ff[256 + t] = acc * Ff[128 + t];
        }
        if (tid < 256) {
            float nn = Ff[576] * Ff[640 + par * 256 + tid];
#pragma unroll
            for (int s = 0; s < 64; s += 4) { const f32x4v w4 = *(LAS const f32x4v*)(Ff + 192 + s); LAS const unsigned char* kc = L + ML_KS + s * ML_KSTR + tid * 2;
                nn += (w4.x * bf2f(*(LAS const unsigned short*)kc) + w4.y * bf2f(*(LAS const unsigned short*)(kc + ML_KSTR))) + (w4.z * bf2f(*(LAS const unsigned short*)(kc + 2 * ML_KSTR)) + w4.w * bf2f(*(LAS const unsigned short*)(kc + 3 * ML_KSTR))); }
            Ff[640 + (par ^ 1) * 256 + tid] = nn;
        }
        }
        ML_BAR();
        {
            pg8::f32x4 y[4];
#if defined(MK_SC_SYNC)
            ML_BAR(); __syncthreads(); __syncthreads();
#endif
#if defined(MK_SC_QC2)
            for (int repq_ = 0; repq_ < 2; ++repq_)
#endif
            {
#pragma unroll
            for (int tt = 0; tt < 4; ++tt) y[tt] = (pg8::f32x4){0.f, 0.f, 0.f, 0.f};
            {
                u32x2 qa[2][4], qb[2][4];
#define ML_QRD(ks_, b_) do { _Pragma("unroll") for (int tt = 0; tt < 4; ++tt) { LAS const unsigned char* qp = L + ML_QS + (16 * tt + l15) * ML_KSTR + (32 * (ks_) + 4 * gq) * 2; qa[b_][tt] = *(LAS const u32x2*)qp; qb[b_][tt] = *(LAS const u32x2*)(qp + 32); } } while (0)
                ML_QRD(0, 0);
#pragma unroll
                for (int ks = 0; ks < 8; ++ks) {
                    if (ks + 1 < 8) ML_QRD(ks + 1, (ks + 1) & 1);
                    u32x4 cw4; cw4.x = att::cvtpk(C[2 * ks][0], C[2 * ks][1]); cw4.y = att::cvtpk(C[2 * ks][2], C[2 * ks][3]); cw4.z = att::cvtpk(C[2 * ks + 1][0], C[2 * ks + 1][1]); cw4.w = att::cvtpk(C[2 * ks + 1][2], C[2 * ks + 1][3]);
                    const bf16x8 cf = __builtin_bit_cast(bf16x8, cw4);
                    __builtin_amdgcn_sched_barrier(0);
#pragma unroll
                    for (int tt = 0; tt < 4; ++tt) { const u32x4 qq = {qa[ks & 1][tt].x, qa[ks & 1][tt].y, qb[ks & 1][tt].x, qb[ks & 1][tt].y};
                        y[tt] = __builtin_amdgcn_mfma_f32_16x16x32_bf16(__builtin_bit_cast(bf16x8, qq), cf, y[tt], 0, 0, 0); }
                    __builtin_amdgcn_sched_barrier(0);
                }
#undef ML_QRD
            }
            }
#pragma unroll
            for (int tt = 0; tt < 4; ++tt) { const f32x4v e4 = *(LAS const f32x4v*)(Ff + 128 + 16 * tt + 4 * gq); y[tt][0] *= e4.x; y[tt][1] *= e4.y; y[tt][2] *= e4.z; y[tt][3] *= e4.w; }
            bf16x8 vf[2];
            { LAS const unsigned char* vb = L + ML_VS + (8 * gq + (l15 >> 2)) * ML_VSTR + (16 * wid + 4 * (lane & 3)) * 2;
#pragma unroll
              for (int k2 = 0; k2 < 2; ++k2) { const s16x4 lo = ml_tr(vb + k2 * 32 * ML_VSTR), hi4 = ml_tr(vb + k2 * 32 * ML_VSTR + 4 * ML_VSTR); vf[k2] = (bf16x8){lo[0], lo[1], lo[2], lo[3], hi4[0], hi4[1], hi4[2], hi4[3]}; } }
#pragma unroll
            for (int k2 = 0; k2 < 2; ++k2)
#pragma unroll
                for (int tt = 0; tt < 4; ++tt) { const bf16x8 pa = *(LAS const bf16x8*)(L + ML_P + (16 * tt + l15) * ML_PSTR + (32 * k2 + 8 * gq) * 2);
                    y[tt] = __builtin_amdgcn_mfma_f32_16x16x32_bf16(pa, vf[k2], y[tt], 0, 0, 0); }
#pragma unroll
            for (int tt = 0; tt < 4; ++tt)
#pragma unroll
                for (int r = 0; r < 4; ++r) { const int t = 16 * tt + 4 * gq + r;
                    *(LAS unsigned short*)(L + ML_HO + t * 256 + (16 * wid + l15) * 2) = (unsigned short)f2bf(y[tt][r]); }
            const float ebend = Ff[576];
#pragma unroll
            for (int i = 0; i < 16; ++i) C[i] = C[i] * ebend;
            bf16x8 vw[2];
#pragma unroll
            for (int k2 = 0; k2 < 2; ++k2) { const f32x4v w0 = *(LAS const f32x4v*)(Ff + 192 + 32 * k2 + 8 * gq), w1 = *(LAS const f32x4v*)(Ff + 192 + 32 * k2 + 8 * gq + 4);
                const u32x4 vv = __builtin_bit_cast(u32x4, vf[k2]); u32x4 o;
                o.x = att::cvtpk(bflo(vv.x) * w0.x, bfhi(vv.x) * w0.y); o.y = att::cvtpk(bflo(vv.y) * w0.z, bfhi(vv.y) * w0.w); o.z = att::cvtpk(bflo(vv.z) * w1.x, bfhi(vv.z) * w1.y); o.w = att::cvtpk(bflo(vv.w) * w1.z, bfhi(vv.w) * w1.w);
                vw[k2] = __builtin_bit_cast(bf16x8, o); }
            LAS const unsigned char* kb = L + ML_KS + (8 * gq + (l15 >> 2)) * ML_KSTR + (4 * (lane & 3)) * 2;
            {
                s16x4 klo[2][2], khi[2][2];
#define ML_KRD(dt_, b_) do { _Pragma("unroll") for (int k2 = 0; k2 < 2; ++k2) { klo[b_][k2] = ml_tr(kb + k2 * 32 * ML_KSTR + (dt_) * 32); khi[b_][k2] = ml_tr(kb + k2 * 32 * ML_KSTR + 4 * ML_KSTR + (dt_) * 32); } } while (0)
                ML_KRD(0, 0);
#pragma unroll
                for (int dt = 0; dt < 16; ++dt) {
                    if (dt + 1 < 16) ML_KRD(dt + 1, (dt + 1) & 1);
                    __builtin_amdgcn_sched_barrier(0);
#pragma unroll
                    for (int k2 = 0; k2 < 2; ++k2) { const s16x4 lo = klo[dt & 1][k2], hi4 = khi[dt & 1][k2];
                        const bf16x8 ka = {lo[0], lo[1], lo[2], lo[3], hi4[0], hi4[1], hi4[2], hi4[3]};
                        C[dt] = __builtin_amdgcn_mfma_f32_16x16x32_bf16(ka, vw[k2], C[dt], 0, 0, 0); }
                    __builtin_amdgcn_sched_barrier(0);
                }
#undef ML_KRD
            }
        }
        ML_BAR();
#if defined(MK_SC_W2)
        for (int repw_ = 0; repw_ < 2; ++repw_)
#endif
#pragma unroll
        for (int it = 0; it < 2; ++it) { const int idx = tid + it * NTHR, t = idx >> 4, pc = idx & 15; const int row = ml_row(base, dir, c * 64 + t);
            const float den = Ff[256 + t] + (Ff[320 + t] + Ff[384 + t]) + (Ff[448 + t] + Ff[512 + t]);
            const float rd = 1.f / fmaxf(fabsf(den), 1.f);
            const u32x4 yv = *(LAS const u32x4*)(L + ML_HO + t * 256 + pc * 16); u32x4 hv;
            hv.x = att::cvtpk(bflo(yv.x) * rd, bfhi(yv.x) * rd); hv.y = att::cvtpk(bflo(yv.y) * rd, bfhi(yv.y) * rd); hv.z = att::cvtpk(bflo(yv.z) * rd, bfhi(yv.z) * rd); hv.w = att::cvtpk(bflo(yv.w) * rd, bfhi(yv.w) * rd);
            *(u32x4*)(Hd + (size_t)row * DI + h * 256 + dvh * 128 + pc * 8) = hv; }
    }
}

__device__ __forceinline__ void mlstm_out_phase(Frame& F, const Args& a, int g, int dry) {
    int lane = pg8::hw_lane(), wave = F.wave; asm volatile("" : "+v"(lane), "+s"(wave));
    const bf16* XC = g == 0 ? (const bf16*)(a.ws + WS_QG) + (size_t)MH * DI : (const bf16*)(a.ws + WS_H); const bf16* Z = (const bf16*)(a.ws + WS_S3); const bf16* HB2 = (const bf16*)(a.ws + WS_S4); bf16* HF = (bf16*)(a.ws + WS_QG) + (size_t)g * MH * DI;
    const float* ng = a.in[16]; const float* skip = a.in[17];
    const int gw = F.vcu * NWAVES + wave, NGW = F.G * NWAVES;
    for (int it0 = gw; it0 < MH * 8; it0 += 2 * NGW) {
        u32x2 hf[2], hb[2], xcw[2], zw[2]; f32x4v gg[2], sk[2]; size_t o[2];
#pragma unroll
        for (int u = 0; u < 2; ++u) { int it = it0 + u * NGW; if (it >= MH * 8) it = it0; const int row = it >> 3, h = it & 7, ch = h * 256 + lane * 4; o[u] = (size_t)row * DI + ch;
            hf[u] = *(const u32x2*)(HF + o[u]); hb[u] = *(const u32x2*)(HB2 + o[u]); xcw[u] = *(const u32x2*)(XC + o[u]); zw[u] = *(const u32x2*)(Z + o[u]);
            gg[u] = *(const f32x4v*)(ng + ch); sk[u] = *(const f32x4v*)(skip + ch); }
#pragma unroll
        for (int u = 0; u < 2; ++u) {
            const float hs[4] = {bflo(hf[u].x) + bflo(hb[u].x), bfhi(hf[u].x) + bfhi(hb[u].x), bflo(hf[u].y) + bflo(hb[u].y), bfhi(hf[u].y) + bfhi(hb[u].y)};
            const float mu = wave_sum((hs[0] + hs[1]) + (hs[2] + hs[3])) * (1.f / 256.f);
            const float d[4] = {hs[0] - mu, hs[1] - mu, hs[2] - mu, hs[3] - mu};
            const float rstd = rsqrtf(wave_sum((d[0] * d[0] + d[1] * d[1]) + (d[2] * d[2] + d[3] * d[3])) * (1.f / 256.f) + EPS);
            const float xcv[4] = {bflo(xcw[u].x), bfhi(xcw[u].x), bflo(xcw[u].y), bfhi(xcw[u].y)}, z[4] = {bflo(zw[u].x), bfhi(zw[u].x), bflo(zw[u].y), bfhi(zw[u].y)};
            const float ggv[4] = {gg[u].x, gg[u].y, gg[u].z, gg[u].w}, skv[4] = {sk[u].x, sk[u].y, sk[u].z, sk[u].w};
            float ov[4];
#pragma unroll
            for (int i = 0; i < 4; ++i) ov[i] = (d[i] * rstd * ggv[i] + skv[i] * xcv[i]) * silu(z[i]);
            u32x2 w; w.x = att::cvtpk(ov[0], ov[1]); w.y = att::cvtpk(ov[2], ov[3]); if (!dry && (u == 0 || it0 + NGW < MH * 8)) *(u32x2*)(HF + o[u]) = w;
        }
    }
}
}
namespace mk {
enum { P_PRO = 0, P_PRO2 = 1, P_NORM0 = 2, P_L0 = 3  , P_OUT0 = 11, P_NORM1 = 12, P_L1 = 13  , P_OUT1 = 17, P_NORM2 = 18, P_L2 = 19  , P_OUT2 = 23, P_NORM3 = 24, P_L3 = 25  , P_OUT3 = 29, P_FINAL = 30, P_END = 31 };

__global__ void __launch_bounds__(NTHR, 2) mega(Args a) {
    extern __shared__ __attribute__((aligned(16))) unsigned char lds_raw[];
    Frame F;
    F.lds = (LAS unsigned char*)lds_raw;
    F.wave = __builtin_amdgcn_readfirstlane((int)threadIdx.x >> 6); F.lane = pg8::hw_lane(); F.tid = F.wave * 64 + F.lane;
    F.G = gridDim.x; { const int bx = blockIdx.x; F.vcu = (F.G % 8 == 0) ? (bx % 8) * (F.G / 8) + bx / 8 : bx; }
    volatile LAS unsigned* MISC = (volatile LAS unsigned*)(F.lds + MISC_OFF);
    for (int u = F.tid; u < (LDS_BYTES - RING_BYTES) / 4; u += NTHR) ((LAS unsigned*)(F.lds + RING_BYTES))[u] = 0u;
    __syncthreads();
    XcdBarrier bar = xcd_barrier_post((unsigned*)(a.ws + WS_CTL) + CW_BAR, MISC + 8, (unsigned)F.wave);
    const int lo = a.ph_lo, hi = a.ph_hi;
#ifndef MK_REP_GEMM
#define MK_REP_GEMM 1
#endif
#ifndef MK_REP_ATT
#define MK_REP_ATT 1
#endif
#ifndef MK_REP_MISC
#define MK_REP_MISC 1
#endif
#ifndef MK_GEMM_ALIGN
#define MK_GEMM_ALIGN true
#endif
#ifndef MK_GEMM_SP2
#define MK_GEMM_SP2 true
#endif
#ifndef MK_REP_WC
#define MK_REP_WC 1
#endif
#ifndef MK_REP_SYNC
#define MK_REP_SYNC 0
#endif
#ifndef MK_REP_DIFF
#define MK_REP_DIFF MK_REP_ATT
#endif
#ifndef MK_REP_NA
#define MK_REP_NA MK_REP_ATT
#endif
#ifndef MK_REP_SWA
#define MK_REP_SWA MK_REP_ATT
#endif
#ifndef MK_REP_SCAN
#define MK_REP_SCAN 1
#endif
#ifndef MK_REP_GATES
#define MK_REP_GATES MK_REP_SCAN
#endif
#ifndef MK_SITES
#define MK_SITES 0xFFFFFFFFu
#endif
#define ON(b) (((MK_SITES) >> (b)) & 1u)
#ifdef MK_PARTIAL
#define IN(k) (lo <= (k) && (k) < hi)
#else
#define IN(k) true
#endif
#ifndef MK_REP_BAR
#define MK_REP_BAR 1
#endif
#ifdef MK_TP
    long long tp_acc = 0, tp_prev = wall_clock64(), tp_t0 = 0;
#define TP_PRE(k) tp_t0 = wall_clock64();
#define TP_POST(k) { long long n_ = wall_clock64(); if ((MK_TP_MASK >> (k)) & 1u) tp_acc += n_ - (MK_TP == 1 ? tp_t0 : tp_prev); tp_prev = n_; }
#else
#define TP_PRE(k)
#define TP_POST(k)
#endif
#define SEAM(k) do { if (IN(k) && IN((k) + 1)) { TP_PRE(k) for (int rb_ = 0; rb_ < MK_REP_BAR; ++rb_) xcd_barrier(bar); TP_POST(k) } } while (0)
    const int gw = F.vcu * NWAVES + F.wave, NGW = F.G * NWAVES;
#define WSB ([&]() { unsigned char* p_ = a.ws; asm volatile("" : "+s"(p_)); return p_; }())
#define xs (a.out)
#define ctxs ((float*)(WSB + WS_CTXS))
#define xsb ((bf16*)a.out)
#define ctxb ((bf16*)(WSB + WS_CTXS))
#define x3b ((bf16*)(WSB + WS_S3))
#define mod ((const float*)(WSB + WS_MOD))
#define WinA ((bf16*)(WSB + WS_WIN))
#define WoutA ((bf16*)(WSB + WS_WOUT))
#define WinB ((bf16*)(WSB + WS_W2))
#define WoutB ((bf16*)(WSB + WS_W2 + 16 * MiB))
#define H ((bf16*)(WSB + WS_H))
#define QG ((bf16*)(WSB + WS_QG))
#define ssq ((float*)(WSB + WS_SSQ))
#define shw ((const float*)(WSB + WS_SHW))
#define S2 ((bf16*)(WSB + WS_S2))
#define S3 ((bf16*)(WSB + WS_S3))
#define S4 ((bf16*)(WSB + WS_S4))
#define rope ((const float*)(WSB + WS_ROPE))
    const float QSC = 0.125f * LOG2E;

    if (ON(0) && IN(P_PRO)) prologue_phase(F, a);
    SEAM(P_PRO);
    if (ON(0) && IN(P_PRO2)) { prologue2_phase(F, a); for (int rw_ = 0; rw_ < MK_REP_WC; ++rw_) wconv(F, a.in[8], 4096, a.in[18], WinA, WoutA, gw, NGW); }
    SEAM(P_PRO2);
    if (ON(1) && IN(P_NORM0)) { for (int rep = 0; rep < MK_REP_MISC; ++rep) norm_phase(F, a.in[0], a.in[2], a.in[4], mod, H); }
    SEAM(P_NORM0);
#if MK_HAVE_L0
    for (int g = 0; g < 2; ++g) {
        if (ON(2) && IN(P_L0 + 4 * g)) {
            pg8::Gemm gm{H + (size_t)g * MH * D, WinA, MH, 4096, D}; pg8::StaticOrder So; So.init(MH, 4096, F.G, (int)blockIdx.x);
            EpiProj<false> E{S2, S3, S3, S3, DI, DI, DI, DI, 8, 16, 16, 0u, 1.f, rope, nullptr, nullptr, 0};
            for (int rep = 0; rep < MK_REP_GEMM; ++rep) { if (MK_REP_SYNC && rep) xcd_barrier(bar); pg8::gemm_phase<EpiProj<false>, pg8::StaticOrder, MK_GEMM_ALIGN, MK_GEMM_SP2>(F.lds, gm, So, E, F.wave); }
        }
        SEAM(P_L0 + 4 * g);
        if (ON(17) && IN(P_L0 + 4 * g + 1)) for (int rep = 0; rep < MK_REP_GATES; ++rep) mlstm_gates_phase(F, a, g);
        SEAM(P_L0 + 4 * g + 1);
        if (ON(18) && IN(P_L0 + 4 * g + 2)) for (int rep = 0; rep < MK_REP_SCAN; ++rep) mlstm_scan_phase(F, a, g);
        SEAM(P_L0 + 4 * g + 2);
        if (ON(19) && IN(P_L0 + 4 * g + 3)) for (int rep = 0; rep < MK_REP_MISC; ++rep) mlstm_out_phase(F, a, g, rep + 1 < MK_REP_MISC);
        SEAM(P_L0 + 4 * g + 3);
    }
#endif
    constexpr int RHEAD = 128 * 256;
    if (ON(3) && IN(P_OUT0)) {
        pg8::Gemm gm{QG, WoutA, MT, D, DI}; pg8::StaticOrder So; So.init(RHEAD, D, F.G, (int)blockIdx.x);
        for (int rep = 0; rep < MK_REP_GEMM; ++rep) { if (MK_REP_SYNC && rep) xcd_barrier(bar); EpiResidT<float, bf16> E{a.in[0], a.in[2], xsb, ctxb, mod, 1, rep + 1 < MK_REP_GEMM, nullptr, nullptr, nullptr, nullptr};
        pg8::gemm_phase<EpiResidT<float, bf16>, pg8::StaticOrder, MK_GEMM_ALIGN, MK_GEMM_SP2>(F.lds, gm, So, E, F.wave); }
    }
    SEAM(P_OUT0);
    if (ON(3) && IN(P_OUT0)) {
        if (blockIdx.x < 64) { pg8::Gemm gm{QG, WoutA, MT, D, DI}; OutTailOrder So; So.init(F.G, (int)blockIdx.x); EpiResidT<float, bf16> E{a.in[0], a.in[2], xsb, ctxb, mod, 1, 0, nullptr, nullptr, nullptr, nullptr};
            pg8::gemm_phase<EpiResidT<float, bf16>, OutTailOrder, MK_GEMM_ALIGN, MK_GEMM_SP2>(F.lds, gm, So, E, F.wave); }
        else { wconv(F, a.in[19], 8192, a.in[25], WinB, WoutB, ((int)blockIdx.x - 64) * NWAVES + F.wave, (F.G - 64) * NWAVES);
            if (ON(4)) norm_phase(F, xsb, ctxb, a.in[4] + 1024, mod + 17 * 3072, H, 0, RHEAD, 64); }
    }
    SEAM(P_OUT0);
    for (int g = 0; g < 2; ++g) {
        if (ON(5) && IN(P_L1 + 2 * g)) {
            if (g == 0 && ON(4)) norm_phase(F, xsb, ctxb, a.in[4] + 1024, mod + 17 * 3072, H, RHEAD, MT);
            pg8::Gemm gm{H + (size_t)g * MH * D, WinB, MH, 8192, D}; pg8::StaticOrder So; So.init(MH, 8192, F.G, (int)blockIdx.x);
            EpiProj<true, false> E{QG + (size_t)g * MH * DI, S2, S3, S4, DI, DI, DI, DI, 8, 16, 24, 3u, QSC, rope, ssq, shw, g * MH};
#ifdef MK_STAGGER
            if (blockIdx.x >= 128) { const long long t0_ = wall_clock64(); while (wall_clock64() - t0_ < MK_STAGGER) __builtin_amdgcn_s_sleep(8); }
#endif
            for (int rep = 0; rep < MK_REP_GEMM; ++rep) { if (MK_REP_SYNC && rep) xcd_barrier(bar); pg8::gemm_phase<EpiProj<true, false>, pg8::StaticOrder, MK_GEMM_ALIGN, MK_GEMM_SP2>(F.lds, gm, So, E, F.wave); }
        }
        SEAM(P_L1 + 2 * g);
        if (ON(6) && IN(P_L1 + 2 * g + 1)) for (int rep = 0; rep < MK_REP_DIFF; ++rep) { if (MK_REP_SYNC && rep) xcd_barrier(bar); diff_phase(F, a, g, rep + 1 < MK_REP_DIFF); }
        SEAM(P_L1 + 2 * g + 1);
    }
    if (ON(7) && IN(P_OUT1)) {
        pg8::Gemm gm{QG, WoutB, MT, D, DI}; pg8::StaticOrder So; So.init(RHEAD, D, F.G, (int)blockIdx.x);
        for (int rep = 0; rep < MK_REP_GEMM; ++rep) { if (MK_REP_SYNC && rep) xcd_barrier(bar); EpiResidT<bf16, bf16> E{xsb, ctxb, xsb, ctxb, mod + 17 * 3072, 1, rep + 1 < MK_REP_GEMM, nullptr, nullptr, nullptr, nullptr};
        pg8::gemm_phase<EpiResidT<bf16, bf16>, pg8::StaticOrder, MK_GEMM_ALIGN, MK_GEMM_SP2>(F.lds, gm, So, E, F.wave); }
    }
    SEAM(P_OUT1);
    if (ON(7) && IN(P_OUT1)) {
        if (blockIdx.x < 64) { pg8::Gemm gm{QG, WoutB, MT, D, DI}; OutTailOrder So; So.init(F.G, (int)blockIdx.x); EpiResidT<bf16, bf16> E{xsb, ctxb, xsb, ctxb, mod + 17 * 3072, 1, 0, nullptr, nullptr, nullptr, nullptr};
            pg8::gemm_phase<EpiResidT<bf16, bf16>, OutTailOrder, MK_GEMM_ALIGN, MK_GEMM_SP2>(F.lds, gm, So, E, F.wave); }
        else { wconv(F, a.in[26], 8192, a.in[28], WinA, WoutA, ((int)blockIdx.x - 64) * NWAVES + F.wave, (F.G - 64) * NWAVES);
            if (ON(8)) norm_phase(F, xsb, ctxb, a.in[4] + 2048, mod + 2 * 17 * 3072, H, 0, RHEAD, 64); }
    }
    SEAM(P_OUT1);
    for (int g = 0; g < 2; ++g) {
        if (ON(9) && IN(P_L2 + 2 * g)) {
            if (g == 0 && ON(8)) norm_phase(F, xsb, ctxb, a.in[4] + 2048, mod + 2 * 17 * 3072, H, RHEAD, MT);
            pg8::Gemm gm{H + (size_t)g * MH * D, WinA, MH, 8192, D}; pg8::StaticOrder So; So.init(MH, 8192, F.G, (int)blockIdx.x);
            EpiProj<false, false> E{QG + (size_t)g * MH * DI, S2, S3, S4, DI, DI, DI, DI, 8, 16, 24, 0u, QSC, rope, ssq, shw + 17 * 8192, g * MH};
#ifdef MK_STAGGER
            if (blockIdx.x >= 128) { const long long t0_ = wall_clock64(); while (wall_clock64() - t0_ < MK_STAGGER) __builtin_amdgcn_s_sleep(8); }
#endif
            for (int rep = 0; rep < MK_REP_GEMM; ++rep) { if (MK_REP_SYNC && rep) xcd_barrier(bar); pg8::gemm_phase<EpiProj<false, false>, pg8::StaticOrder, MK_GEMM_ALIGN, MK_GEMM_SP2>(F.lds, gm, So, E, F.wave); }
        }
        SEAM(P_L2 + 2 * g);
        if (ON(10) && IN(P_L2 + 2 * g + 1)) for (int rep = 0; rep < MK_REP_NA; ++rep) { if (MK_REP_SYNC && rep) xcd_barrier(bar); na_phase(F, a, g, rep + 1 < MK_REP_NA); }
        SEAM(P_L2 + 2 * g + 1);
    }
    if (ON(11) && IN(P_OUT2)) {
        pg8::Gemm gm{QG, WoutA, MT, D, DI}; pg8::StaticOrder So; So.init(RHEAD, D, F.G, (int)blockIdx.x);
        for (int rep = 0; rep < MK_REP_GEMM; ++rep) { if (MK_REP_SYNC && rep) xcd_barrier(bar); EpiResidT<bf16, bf16> E{xsb, ctxb, x3b, ctxb, mod + 2 * 17 * 3072, 1, rep + 1 < MK_REP_GEMM, nullptr, nullptr, nullptr, nullptr};
        pg8::gemm_phase<EpiResidT<bf16, bf16>, pg8::StaticOrder, MK_GEMM_ALIGN, MK_GEMM_SP2>(F.lds, gm, So, E, F.wave); }
    }
    SEAM(P_OUT2);
    if (ON(11) && IN(P_OUT2)) {
        if (blockIdx.x < 64) { pg8::Gemm gm{QG, WoutA, MT, D, DI}; OutTailOrder So; So.init(F.G, (int)blockIdx.x); EpiResidT<bf16, bf16> E{xsb, ctxb, x3b, ctxb, mod + 2 * 17 * 3072, 1, 0, nullptr, nullptr, nullptr, nullptr};
            pg8::gemm_phase<EpiResidT<bf16, bf16>, OutTailOrder, MK_GEMM_ALIGN, MK_GEMM_SP2>(F.lds, gm, So, E, F.wave); }
        else { wconv(F, a.in[29], 4608, a.in[31], WinB, WoutB, ((int)blockIdx.x - 64) * NWAVES + F.wave, (F.G - 64) * NWAVES);
            if (ON(12)) norm_phase(F, x3b, ctxb, a.in[4] + 3072, mod + 3 * 17 * 3072, H, 0, RHEAD, 64); }
    }
    SEAM(P_OUT2);
    for (int g = 0; g < 2; ++g) {
        if (ON(13) && IN(P_L3 + 2 * g)) {
            if (g == 0 && ON(12)) norm_phase(F, x3b, ctxb, a.in[4] + 3072, mod + 3 * 17 * 3072, H, RHEAD, MT);
            pg8::Gemm gm{H + (size_t)g * MH * D, WinB, MH, 4608, D}; L3Order So; So.init(F.G, (int)blockIdx.x);
            EpiProj<true, false> E{QG + (size_t)g * MH * DI, S2, S2 + (size_t)MH * 256, S4, DI, 256, 256, DI, 8, 9, 10, 3u, QSC, rope, ssq, shw + 2 * 17 * 8192, g * MH};
            for (int rep = 0; rep < MK_REP_GEMM; ++rep) { if (MK_REP_SYNC && rep) xcd_barrier(bar); pg8::gemm_phase<EpiProj<true, false>, L3Order, MK_GEMM_ALIGN, MK_GEMM_SP2>(F.lds, gm, So, E, F.wave); }
        }
        SEAM(P_L3 + 2 * g);
        if (ON(14) && IN(P_L3 + 2 * g + 1)) for (int rep = 0; rep < MK_REP_SWA; ++rep) { if (MK_REP_SYNC && rep) xcd_barrier(bar); swa_phase(F, a, g, rep + 1 < MK_REP_SWA); }
        SEAM(P_L3 + 2 * g + 1);
    }
    if (ON(15) && IN(P_OUT3)) {
        pg8::Gemm gm{QG, WoutB, MT, D, DI}; LatOnlyOrder So; So.init(F.G, (int)blockIdx.x);
        for (int rep = 0; rep < MK_REP_GEMM; ++rep) { if (MK_REP_SYNC && rep) xcd_barrier(bar); EpiResidT<bf16, float> E{x3b, ctxb, xs, ctxs, mod + 3 * 17 * 3072, 0, rep + 1 < MK_REP_GEMM, nullptr, nullptr, nullptr, nullptr};
        pg8::gemm_phase<EpiResidT<bf16, float>, LatOnlyOrder, MK_GEMM_ALIGN, MK_GEMM_SP2>(F.lds, gm, So, E, F.wave); }
    }
    SEAM(P_OUT3);
    if (ON(16) && IN(P_FINAL)) final_norm_phase(F, xs, a.in[7]);
#ifdef MK_TP
    {
        if (MK_TP == 2) TP_POST(P_FINAL)
        unsigned long long* tpw = (unsigned long long*)(a.ws + WS_CTL + 32768);
        if (F.wave == 0 && pg8::hw_lane() == 0) __hip_atomic_fetch_add(tpw, (unsigned long long)tp_acc, __ATOMIC_RELAXED, __HIP_MEMORY_SCOPE_AGENT);
        xcd_barrier(bar);
        const unsigned long long sum = __hip_atomic_load(tpw, __ATOMIC_RELAXED, __HIP_MEMORY_SCOPE_AGENT);
        const long long wait = (long long)(sum / 256) * MK_TP_K, ts = wall_clock64();
        while (wall_clock64() - ts < wait) __builtin_amdgcn_s_sleep(32);
    }
#endif
#undef IN
#undef SEAM
#undef WSB
#undef xs
#undef ctxs
#undef xsb
#undef ctxb
#undef x3b
#undef mod
#undef WinA
#undef WoutA
#undef WinB
#undef WoutB
#undef H
#undef QG
#undef ssq
#undef shw
#undef S2
#undef S3
#undef S4
#undef rope
}

inline void launch_mega(void* const* d_in, void* d_out, void* d_ws, int lo, int hi, hipStream_t stream) {
    static int inited = 0;
    if (!inited) { (void)hipFuncSetAttribute((const void*)mega, hipFuncAttributeMaxDynamicSharedMemorySize, LDS_BYTES); inited = 1; }
    (void)hipMemsetAsync((char*)d_ws + WS_CTL, 0, CTL_BYTES, stream);
    Args a{};
    for (int i = 0; i < 32; ++i) a.in[i] = (const float*)d_in[i];
    a.out = (float*)d_out; a.ws = (unsigned char*)d_ws; a.ph_lo = lo; a.ph_hi = hi;
    hipLaunchKernelGGL(mega, dim3(256), dim3(NTHR), LDS_BYTES, stream, a);
}
}
extern "C" void kernel_launch(void* const* d_in, const int* in_sizes, int n_in, void* d_out, int out_size, void* d_ws, size_t ws_size, hipStream_t stream) {
    mk::launch_mega(d_in, d_out, d_ws, mk::P_PRO, mk::P_END, stream);
}
```

```cpp
#include <hip/hip_runtime.h>
#include <cstdint>
#include <cstdio>
#include <cmath>
#define MK_HAVE_L0 1
namespace pg8 {
#define PG8_LAS __attribute__((address_space(3)))
typedef unsigned short bf16_t;
typedef short bf16x8 __attribute__((ext_vector_type(8)));
typedef float f32x4 __attribute__((ext_vector_type(4)));
typedef unsigned u32x4 __attribute__((ext_vector_type(4)));
__device__ __forceinline__ int hw_lane() { int l; asm volatile("v_mbcnt_lo_u32_b32 %0, -1, 0\n\tv_mbcnt_hi_u32_b32 %0, -1, %0" : "=v"(l)); return l; }
constexpr int BM = 256, BK = 64, HALF = 128, HTB = HALF * BK * 2  , STAGE_BYTES = 8 * HTB, NXCD = 8, WGM = 8;

__host__ __device__ __forceinline__ int lds_byte(int r, int c) { const int st = (r >> 4) * 2 + (c >> 5), rr = r & 15, cc = c & 31, ob = rr * 64 + cc * 2; return st * 1024 + (ob ^ (((ob >> 9) & 1) << 5)); }
__host__ __device__ __forceinline__ void stage_rc(int b, int& R, int& C) { const int st = b / 1024, sb = b % 1024, swz = sb ^ (((sb >> 9) & 1) << 5); R = (st >> 1) * 16 + swz / 64; C = (st & 1) * 32 + (swz % 64) / 2; }
__host__ __device__ __forceinline__ int perm32(int rho) { const int n = rho >> 4, i = rho & 15; return 8 * (i >> 2) + 4 * n + (i & 3); }

struct Unit { int pm, pn; };
struct Gemm { const bf16_t* A; const bf16_t* Bt; int M, N, K; };

struct StaticOrder {
    int nM, nN, nwg, G, c;
    __host__ __device__ void init(int M, int N, int G_, int c_) { nM = M / BM; nN = N / BM; nwg = nM * nN; G = G_; c = c_; }
    __host__ __device__ bool next(int i, Unit& u) const {
        const long L = (long)i * G + c; if (L >= nwg) return false;
        int wgid = (int)L; { const int q = nwg / NXCD, r = nwg % NXCD, xcd = wgid % NXCD, off = wgid / NXCD; wgid = (xcd < r ? xcd * (q + 1) : r * (q + 1) + (xcd - r) * q) + off; }
        const int nig = WGM * nN, gid = wgid / nig, fm = gid * WGM, gsz = (nM - fm) < WGM ? (nM - fm) : WGM;
        u.pm = fm + ((wgid % nig) % gsz); u.pn = (wgid % nig) / gsz; return true;
    }
    __device__ __forceinline__ void a_ready(const Unit&) const {}
    __device__ __forceinline__ void done(const Unit&) const {}
};

__device__ __forceinline__ unsigned cvt_pk_bf16(float lo, float hi) { unsigned r; asm volatile("v_cvt_pk_bf16_f32 %0, %1, %2" : "=v"(r) : "v"(lo), "v"(hi)); return r; }
typedef float f32x2 __attribute__((ext_vector_type(2)));
template <class Epi, class Sched, bool ALIGN_EPI = false, bool SP2 = false>
__device__ __forceinline__ void gemm_phase(PG8_LAS unsigned char* lds, const Gemm g, const Sched& S, const Epi& E, int wave_id) {
    int tid_ = wave_id * 64 + hw_lane(); asm volatile("" : "+v"(tid_));
    const int tid = tid_, wid = __builtin_amdgcn_readfirstlane(tid >> 6), lane = tid & 63, wr = wid >> 2, wc = wid & 3, fr = lane & 15, fq = lane >> 4;
    const int K = g.K, nt = K / BK;
    unsigned voffA[2], voffB[2];
#pragma unroll
    for (int i = 0; i < 2; ++i) { int R, C; stage_rc(tid * 16 + i * 8192, R, C); const int Rb = Epi::PERM ? ((R & ~31) + perm32(R & 31)) : R;
        voffA[i] = (unsigned)(R * K + C) * 2u; voffB[i] = (unsigned)(Rb * K + C) * 2u; }
    const size_t kstep = (size_t)(BK * 2);
    const size_t hstep = (size_t)HALF * K * 2;
    const size_t tstep = 2 * hstep;
    const unsigned ldsw = (unsigned)wid * 1024u;
    const int aoff = lds_byte(wr * 64 + fr, fq * 8), boff = lds_byte(wc * 32 + fr, fq * 8);
#define PG8_SA(b, h) (((b) * 2 + (h)) * HTB)
#define PG8_SB(b, h) ((4 + (b) * 2 + (h)) * HTB)
#define PG8_STAGE(bufoff, gbase, voff) do { _Pragma("unroll") for (int _i = 0; _i < 2; ++_i) \
        __builtin_amdgcn_global_load_lds((const unsigned*)((const char*)(gbase) + (voff)[_i]), (PG8_LAS unsigned*)(lds + (bufoff) + ldsw + _i * 8192), 16, 0, 0); } while (0)
#define PG8_LDA(dst, b, h) do { _Pragma("unroll") for (int m = 0; m < 4; ++m) _Pragma("unroll") for (int k = 0; k < 2; ++k) dst[m][k] = *(const PG8_LAS bf16x8*)(lds + PG8_SA(b, h) + aoff + m * 2048 + k * 1024); } while (0)
#define PG8_LDB(dst, b, h) do { _Pragma("unroll") for (int n = 0; n < 2; ++n) _Pragma("unroll") for (int k = 0; k < 2; ++k) dst[n][k] = *(const PG8_LAS bf16x8*)(lds + PG8_SB(b, h) + boff + n * 2048 + k * 1024); } while (0)
#define PG8_MMA(ai, bj, At, Bt) do { __builtin_amdgcn_s_setprio(1); _Pragma("unroll") for (int m = 0; m < 4; ++m) _Pragma("unroll") for (int n = 0; n < 2; ++n) _Pragma("unroll") for (int k = 0; k < 2; ++k) \
        acc[ai][bj][m][n] = __builtin_amdgcn_mfma_f32_16x16x32_bf16(Bt[n][k], At[m][k], acc[ai][bj][m][n], 0, 0, 0); __builtin_amdgcn_s_setprio(0); } while (0)
#define PG8_WAIT_V(n) asm volatile("s_waitcnt vmcnt(" #n ")" ::: "memory")
#define PG8_WAIT_L(n) asm volatile("s_waitcnt lgkmcnt(" #n ")" ::: "memory")
#define PG8_BAR __builtin_amdgcn_s_barrier()
#define PG8_SCHED __builtin_amdgcn_sched_barrier(0)
    Unit cur, nxt; int ui = 0;
    if (!S.next(0, cur)) return;
    f32x4 acc[2][2][4][2];
#pragma unroll
    for (int a = 0; a < 2; ++a)
#pragma unroll
        for (int b = 0; b < 2; ++b)
#pragma unroll
            for (int m = 0; m < 4; ++m)
#pragma unroll
                for (int n = 0; n < 2; ++n) acc[a][b][m][n] = (f32x4){0.f, 0.f, 0.f, 0.f};
    bf16x8 At[4][2], B0[2][2], B1[2][2];
    const char* cA = (const char*)g.A + (size_t)cur.pm * tstep; const char* cB = (const char*)g.Bt + (size_t)cur.pn * tstep;
    S.a_ready(cur);
    if constexpr (SP2) {
        PG8_STAGE(PG8_SB(0, 0), cB, voffB); PG8_STAGE(PG8_SB(0, 1), cB + hstep, voffB); PG8_STAGE(PG8_SA(0, 0), cA, voffA); PG8_STAGE(PG8_SA(0, 1), cA + hstep, voffA);
        if (wr == 1) PG8_BAR;
        PG8_WAIT_V(2); PG8_BAR;
        PG8_STAGE(PG8_SB(1, 0), cB + kstep, voffB); PG8_STAGE(PG8_SA(1, 0), cA + kstep, voffA); PG8_STAGE(PG8_SB(1, 1), cB + hstep + kstep, voffB);
        PG8_WAIT_V(6); PG8_BAR;
    } else {
        PG8_STAGE(PG8_SB(0, 0), cB, voffB); PG8_STAGE(PG8_SA(0, 0), cA, voffA); PG8_STAGE(PG8_SB(0, 1), cB + hstep, voffB); PG8_STAGE(PG8_SA(0, 1), cA + hstep, voffA);
        if (wr == 1) PG8_BAR;
        PG8_WAIT_V(4); PG8_BAR;
        PG8_STAGE(PG8_SB(1, 0), cB + kstep, voffB); PG8_STAGE(PG8_SA(1, 0), cA + kstep, voffA); PG8_STAGE(PG8_SB(1, 1), cB + hstep + kstep, voffB);
        PG8_WAIT_V(6); PG8_BAR;
    }
    for (;;) {
        const bool has_next = S.next(ui + 1, nxt);
        const char* nA = has_next ? (const char*)g.A + (size_t)nxt.pm * tstep : cA; const char* nB = has_next ? (const char*)g.Bt + (size_t)nxt.pn * tstep : cB;
        for (int t = 0; t < nt; t += 2) {
            const bool last = (t == nt - 2);
            const char* a1 = cA + (size_t)(t + 1) * kstep;
            const char* a2 = last ? nA : cA + (size_t)(t + 2) * kstep; const char* b2 = last ? nB : cB + (size_t)(t + 2) * kstep;
            const char* a3 = a2 + kstep; const char* b3 = b2 + kstep;
            if (last && has_next) S.a_ready(nxt);
            if constexpr (SP2) {
            PG8_LDB(B0, 0, 0); PG8_LDB(B1, 0, 1); PG8_SCHED; PG8_LDA(At, 0, 0); PG8_STAGE(PG8_SA(1, 1), a1 + hstep, voffA);
            PG8_WAIT_V(8); PG8_WAIT_L(0); PG8_BAR; PG8_MMA(0, 0, At, B0); PG8_MMA(0, 1, At, B1); PG8_BAR; PG8_SCHED;
            PG8_LDA(At, 0, 1); PG8_STAGE(PG8_SB(0, 0), b2, voffB); PG8_STAGE(PG8_SB(0, 1), b2 + hstep, voffB); PG8_STAGE(PG8_SA(0, 0), a2, voffA);
            PG8_WAIT_V(8); PG8_WAIT_L(0); PG8_BAR; PG8_MMA(1, 0, At, B0); PG8_MMA(1, 1, At, B1); PG8_BAR; PG8_SCHED;
            PG8_LDB(B0, 1, 0); PG8_LDB(B1, 1, 1); PG8_SCHED; PG8_LDA(At, 1, 0); PG8_STAGE(PG8_SA(0, 1), a2 + hstep, voffA);
            PG8_WAIT_V(8); PG8_WAIT_L(0); PG8_BAR; PG8_MMA(0, 0, At, B0); PG8_MMA(0, 1, At, B1); PG8_BAR; PG8_SCHED;
            PG8_LDA(At, 1, 1); PG8_STAGE(PG8_SB(1, 0), b3, voffB); PG8_STAGE(PG8_SB(1, 1), b3 + hstep, voffB); PG8_STAGE(PG8_SA(1, 0), a3, voffA);
            PG8_WAIT_V(8); PG8_WAIT_L(0); PG8_BAR; PG8_MMA(1, 0, At, B0); PG8_MMA(1, 1, At, B1); PG8_BAR; PG8_SCHED;
            } else {
            PG8_LDB(B0, 0, 0); PG8_SCHED; PG8_LDA(At, 0, 0); PG8_STAGE(PG8_SA(1, 1), a1 + hstep, voffA);
            PG8_WAIT_L(8); PG8_BAR; PG8_WAIT_L(0); PG8_MMA(0, 0, At, B0); PG8_BAR; PG8_SCHED;
            PG8_LDB(B1, 0, 1); PG8_STAGE(PG8_SB(0, 0), b2, voffB);
            PG8_BAR; PG8_WAIT_L(0); PG8_MMA(0, 1, At, B1); PG8_BAR;
            PG8_LDA(At, 0, 1); PG8_STAGE(PG8_SA(0, 0), a2, voffA);
            PG8_BAR; PG8_WAIT_L(0); PG8_MMA(1, 0, At, B0); PG8_BAR; PG8_SCHED;
            PG8_STAGE(PG8_SB(0, 1), b2 + hstep, voffB);
            PG8_WAIT_V(6); PG8_BAR; PG8_MMA(1, 1, At, B1); PG8_BAR;
            PG8_LDB(B0, 1, 0); PG8_SCHED; PG8_LDA(At, 1, 0); PG8_STAGE(PG8_SA(0, 1), a2 + hstep, voffA);
            PG8_WAIT_L(8); PG8_BAR; PG8_WAIT_L(0); PG8_MMA(0, 0, At, B0); PG8_BAR; PG8_SCHED;
            PG8_LDB(B1, 1, 1); PG8_STAGE(PG8_SB(1, 0), b3, voffB);
            PG8_BAR; PG8_WAIT_L(0); PG8_MMA(0, 1, At, B1); PG8_BAR;
            PG8_LDA(At, 1, 1); PG8_STAGE(PG8_SA(1, 0), a3, voffA);
            PG8_BAR; PG8_WAIT_L(0); PG8_MMA(1, 0, At, B0); PG8_BAR; PG8_SCHED;
            PG8_STAGE(PG8_SB(1, 1), b3 + hstep, voffB);
            PG8_WAIT_V(6); PG8_BAR; PG8_MMA(1, 1, At, B1); PG8_BAR;
            }
        }
        if constexpr (ALIGN_EPI) { if (wr == 0) PG8_BAR; }
#if defined(MK_EXP_EPI2)
        if constexpr (!Epi::AFTER_DRAIN && Epi::PERM) { E.template run<(MK_EXP_EPI2 == 2)>(acc, cur, wr, wc, fr, fq); }
#endif
        if constexpr (!Epi::AFTER_DRAIN) { E(acc, cur, wr, wc, fr, fq); S.done(cur); }
        if (!has_next) break;
#pragma unroll
        for (int a = 0; a < 2; ++a)
#pragma unroll
            for (int b = 0; b < 2; ++b)
#pragma unroll
                for (int m = 0; m < 4; ++m)
#pragma unroll
                    for (int n = 0; n < 2; ++n) acc[a][b][m][n] = (f32x4){0.f, 0.f, 0.f, 0.f};
        cur = nxt; cA = nA; cB = nB; ++ui;
        if constexpr (ALIGN_EPI) { if (wr == 1) PG8_BAR; }
    }
    PG8_WAIT_V(0);
    if constexpr (!ALIGN_EPI) { if (wr == 0) PG8_BAR; }
    PG8_BAR;
    if constexpr (Epi::AFTER_DRAIN) { E.fused(acc, cur, wr, wc, fr, fq, lds, wid, lane); S.done(cur); }
#undef PG8_SA
#undef PG8_SB
#undef PG8_STAGE
#undef PG8_LDA
#undef PG8_LDB
#undef PG8_MMA
#undef PG8_WAIT_V
#undef PG8_WAIT_L
#undef PG8_BAR
#undef PG8_SCHED
}
}
#define GAS __attribute__((address_space(1)))
#define LAS __attribute__((address_space(3)))
typedef unsigned short bf16;
typedef unsigned v4u __attribute__((ext_vector_type(4)));
typedef float f32x4 __attribute__((ext_vector_type(4)));
typedef short bf16x8 __attribute__((ext_vector_type(8)));
typedef GAS unsigned gu32;
typedef GAS unsigned long long gu64;
#define RLX_AGENT __ATOMIC_RELAXED, __HIP_MEMORY_SCOPE_AGENT
#define LDS_WAIT() asm volatile("s_waitcnt lgkmcnt(0)" ::: "memory")
#define VM_WAIT() asm volatile("s_waitcnt vmcnt(0)" ::: "memory")
__device__ __forceinline__ unsigned long long rt() { return __builtin_amdgcn_s_memrealtime(); }
__device__ __forceinline__ unsigned f2bf(float f) { unsigned u = __builtin_bit_cast(unsigned, f); return (u + 0x7fffu + ((u >> 16) & 1u)) >> 16; }
__device__ __forceinline__ unsigned pk2(float lo, float hi) { return f2bf(lo) | (f2bf(hi) << 16); }
#define XB_TMO      128
#define XB_XCNT(j)  (256  + 64 * (j))
#define XB_XSUB(j)  (1280 + 64 * (j))
#define XB_XGEN(j)  (2304 + 64 * (j))
#define XB_TOP      3328
#define XB_TOPGEN   3392
#define XCD_BAR_WORDS 3456
#define XB_SPIN_CAP (1u << 18)

__device__ __forceinline__ unsigned xb_ld(unsigned* p)              { return __hip_atomic_load(p, __ATOMIC_RELAXED, __HIP_MEMORY_SCOPE_AGENT); }
__device__ __forceinline__ unsigned xb_add(unsigned* p, unsigned v) { return __hip_atomic_fetch_add(p, v, __ATOMIC_RELAXED, __HIP_MEMORY_SCOPE_AGENT); }
__device__ __forceinline__ unsigned xb_xcc_id() { return (unsigned)__builtin_amdgcn_s_getreg((3 << 11) | 20) & 0xFu; }
#define XB_SPIN(cond, bar) do { unsigned _sp = 0; while (cond) { __builtin_amdgcn_s_sleep(1); \
    if ((++_sp & 255u) == 0u) { if (xb_ld(&(bar)[XB_TMO])) break; if (_sp > XB_SPIN_CAP) { atomicAdd(&(bar)[XB_TMO], 1u); break; } } } } while (0)

struct XcdBarrier {
    unsigned* bar; unsigned x; unsigned w;
    volatile LAS unsigned* st;
};

__device__ __forceinline__ XcdBarrier xcd_barrier_post(unsigned* bar, volatile LAS unsigned* st, unsigned wave) {
    XcdBarrier b; b.bar = bar; b.x = xb_xcc_id(); b.st = st; b.w = wave;
    if (b.w == 0u && pg8::hw_lane() == 0) (void)xb_add(&bar[XB_XCNT(b.x)], 1u);
    return b;
}
__device__ __forceinline__ void xcd_barrier_complete(unsigned* bar, unsigned x, unsigned& nloc, unsigned& nx) {
    const unsigned G = gridDim.x * gridDim.y * gridDim.z;
    unsigned sum, cnt, mine, sp = 0u;
    for (;;) {
        sum = 0u; cnt = 0u; mine = 0u;
#pragma unroll
        for (unsigned j = 0; j < 16; ++j) { const unsigned c = xb_ld(&bar[XB_XCNT(j)]); sum += c; cnt += (c > 0u) ? 1u : 0u; mine = (j == x) ? c : mine; }
        if (sum == G) break;
        __builtin_amdgcn_s_sleep(1);
        if ((++sp & 255u) == 0u) { if (xb_ld(&bar[XB_TMO])) break; if (sp > XB_SPIN_CAP) { atomicAdd(&bar[XB_TMO], 1u); break; } }
    }
    nloc = mine > 0u ? mine : 1u; nx = cnt > 0u ? cnt : 1u;
}

__device__ __forceinline__ void xcd_barrier(const XcdBarrier& b) {
    asm volatile("s_waitcnt vmcnt(0)" ::: "memory");
    __syncthreads();
    if (b.w == 0u && pg8::hw_lane() == 0) {
        unsigned* bar = b.bar;
        __builtin_amdgcn_s_waitcnt(0);
        unsigned nloc = b.st[0], nx = b.st[1];
        if (nloc == 0u) { xcd_barrier_complete(bar, b.x, nloc, nx); b.st[0] = nloc; b.st[1] = nx; }
        const unsigned old = xb_add(&bar[XB_XSUB(b.x)], 1u);
        const unsigned gen = old / nloc;
        if (old + 1u == (gen + 1u) * nloc) {
            __builtin_amdgcn_fence(__ATOMIC_RELEASE, "agent");
            asm volatile("s_waitcnt vmcnt(0)" ::: "memory");
            const unsigned og = xb_add(&bar[XB_TOP], 1u);
            const unsigned tg = og / nx;
            if (og + 1u == (tg + 1u) * nx) xb_add(&bar[XB_TOPGEN], 1u);
            else XB_SPIN(xb_ld(&bar[XB_TOPGEN]) == tg, bar);
            __builtin_amdgcn_fence(__ATOMIC_ACQUIRE, "agent");
            xb_add(&bar[XB_XGEN(b.x)], 1u);
            asm volatile("s_waitcnt vmcnt(0)" ::: "memory");
        } else {
            XB_SPIN(xb_ld(&bar[XB_XGEN(b.x)]) == gen, bar);
            __builtin_amdgcn_fence(__ATOMIC_ACQUIRE, "agent");
            asm volatile("s_waitcnt vmcnt(0)" ::: "memory");
        }
    }
    __syncthreads();
}
namespace mk {
constexpr int NWAVES = 8, NTHR = 512;
constexpr int NB = 16, S = 2048, D = 1024, CT = 256, RB = S + CT  , MT = NB * RB, HB = 8  , MH = HB * RB, DI = 2048;
constexpr float EPS = 1e-6f, LOG2E = 1.4426950408889634f;
constexpr size_t MiB = 1u << 20;
constexpr size_t WS_CTXS = 0, WS_MOD = 16 * MiB, WS_CTL = 17 * MiB, CTL_BYTES = 64 * 1024;
constexpr size_t WS_ROPE = 18 * MiB, WS_WG2 = 18 * MiB + 64 * 1024, WS_GATES = 19 * MiB;
constexpr size_t WS_WIN = 22 * MiB, WS_WOUT = 38 * MiB, WS_H = 42 * MiB, WS_QG = 114 * MiB, WS_S2 = 258 * MiB, WS_S3 = 330 * MiB, WS_S4 = 402 * MiB, WS_END = 474 * MiB, WS_GATES2 = 474 * MiB  ,
    WS_SSQ = 477 * MiB  , WS_W2 = 480 * MiB  , WS_SHW = 500 * MiB  , WS_GATES3 = 503 * MiB, WS_GATES4 = 506 * MiB  ;
constexpr int CW_BAR = 1024;
constexpr int RING_BYTES = 131072, MISC_OFF = RING_BYTES + 320, LDS_BYTES = 147456;

typedef unsigned short bf16;
typedef float f32x4 __attribute__((ext_vector_type(4)));
typedef float f32x16 __attribute__((ext_vector_type(16)));
typedef short bf16x8 __attribute__((ext_vector_type(8)));
typedef short s16x4 __attribute__((ext_vector_type(4)));
typedef unsigned u32x4 __attribute__((ext_vector_type(4)));
typedef unsigned u32x2 __attribute__((ext_vector_type(2)));

__device__ __forceinline__ float silu(float x) { return x / (1.f + __expf(-x)); }
__device__ __forceinline__ float bf2f(unsigned short b) { return __uint_as_float((unsigned)b << 16); }
__device__ __forceinline__ float bflo(unsigned w) { return __uint_as_float(w << 16); }
__device__ __forceinline__ float bfhi(unsigned w) { return __uint_as_float(w & 0xffff0000u); }
__device__ __forceinline__ float wave_sum(float v) {
#pragma unroll
    for (int o = 1; o < 64; o <<= 1) v += __shfl_xor(v, o);
    return v;
}

struct Frame {
    LAS unsigned char* lds;
    int tid, lane, wave, vcu, G;
    void* const* dummy;
};
__device__ __forceinline__ Frame fresh(const Frame& F0) { Frame F = F0; const int l = pg8::hw_lane(); F.lane = l; F.tid = F0.wave * 64 + l; return F; }
struct Args { const float* in[32]; float* out; unsigned char* ws; int ph_lo, ph_hi; };

template <bool ROPE, bool AFFINE = false> struct EpiProj {
    static constexpr bool PERM = true, AFTER_DRAIN = false;
    bf16 *d0, *d1, *d2, *d3; int l0, l1, l2, l3; int t1, t2, t3; unsigned ropemask; float sc0; const float* rope;
    const float* ssq; const float* shw; int row_base;
    __device__ __forceinline__ void operator()(const pg8::f32x4 (&acc)[2][2][4][2], const pg8::Unit& u, int wr, int wc, int fr, int fq) const { run<false>(acc, u, wr, wc, fr, fq); }
    template <bool NOSTORE> __device__ __forceinline__ void run(const pg8::f32x4 (&acc)[2][2][4][2], const pg8::Unit& u, int wr, int wc, int fr, int fq) const {
        asm volatile("" : "+v"(fr), "+v"(fq));
        const int pn = u.pn;
        long long off = 0; int ld = l0, tb = 0, s = 0;
        if (pn >= t1) { off += (long long)(d1 - d0); ld += l1 - l0; tb = t1; s = 1; }
        if (pn >= t2) { off += (long long)(d2 - d1); ld += l2 - l1; tb = t2; s = 2; }
        if (pn >= t3) { off += (long long)(d3 - d2); ld += l3 - l2; tb = t3; s = 3; }
        bf16* base = d0 + off;
        const float sc = (pn >= t1) ? 1.f : sc0;
        const int rr0 = (u.pm * 256) % RB;
        const bool do_rope = ROPE && ((ropemask >> s) & 1u) && rr0 != 0;
        const int col0 = (pn - tb) * 256 + wc * 32 + 8 * fq;
        const int rloc = wr * 64 + fr;
        pg8::f32x4 sw[2][2];
        if (AFFINE) { const int gr0 = row_base + u.pm * 256; const float* sp = shw + (size_t)(rr0 == 0 ? 16 : gr0 / RB) * 8192 + pn * 256 + wc * 32 + 8 * fq;
#pragma unroll
            for (int bj = 0; bj < 2; ++bj) { sw[bj][0] = *(const pg8::f32x4*)(sp + bj * 128); sw[bj][1] = *(const pg8::f32x4*)(sp + bj * 128 + 4); } }
#pragma unroll
        for (int ai = 0; ai < 2; ++ai)
#pragma unroll
            for (int m = 0; m < 4; ++m) {
                const int rt = rloc + ai * 128 + m * 16;
                bf16* rowp = base + (size_t)(u.pm * 256 + rt) * ld + col0;
                float rstd = 1.f;
                if (AFFINE) { const pg8::f32x4* qp = (const pg8::f32x4*)(ssq + (size_t)(row_base + u.pm * 256 + rt) * 16); const pg8::f32x4 a0 = qp[0], a1 = qp[1], a2 = qp[2], a3 = qp[3];
                    const float tot = ((a0[0] + a0[1]) + (a0[2] + a0[3])) + ((a1[0] + a1[1]) + (a1[2] + a1[3])) + ((a2[0] + a2[1]) + (a2[2] + a2[3])) + ((a3[0] + a3[1]) + (a3[2] + a3[3]));
                    rstd = rsqrtf(tot * (1.f / D) + EPS); }
                f32x4 cs0 = {}, cs1 = {}, cs2 = {}, cs3 = {};
                if (ROPE && do_rope) { const int t = rr0 - CT + rt; const int pos = (wc & 1) ? (t & 63) : (t >> 6); const f32x4* tp = (const f32x4*)(rope + pos * 32 + 16 * (fq & 1));
                    cs0 = tp[0]; cs1 = tp[1]; cs2 = tp[2]; cs3 = tp[3]; }
#pragma unroll
                for (int bj = 0; bj < 2; ++bj) {
                    pg8::f32x4 v0 = acc[ai][bj][m][0], v1 = acc[ai][bj][m][1];
                    if (AFFINE) { v0 = v0 * rstd + sw[bj][0]; v1 = v1 * rstd + sw[bj][1]; }
                    if (ROPE && do_rope) {
                        const float sg = (fq & 2) ? 1.f : -1.f;
                        pg8::f32x4 p0, p1;
#pragma unroll
                        for (int i = 0; i < 4; ++i) { p0[i] = __shfl_xor(v0[i], 32); p1[i] = __shfl_xor(v1[i], 32); }
                        v0[0] = v0[0] * cs0[0] + sg * p0[0] * cs0[1]; v0[1] = v0[1] * cs0[2] + sg * p0[1] * cs0[3];
                        v0[2] = v0[2] * cs1[0] + sg * p0[2] * cs1[1]; v0[3] = v0[3] * cs1[2] + sg * p0[3] * cs1[3];
                        v1[0] = v1[0] * cs2[0] + sg * p1[0] * cs2[1]; v1[1] = v1[1] * cs2[2] + sg * p1[1] * cs2[3];
                        v1[2] = v1[2] * cs3[0] + sg * p1[2] * cs3[1]; v1[3] = v1[3] * cs3[2] + sg * p1[3] * cs3[3];
                    }
                    v0 = v0 * sc; v1 = v1 * sc;
                    pg8::u32x4 w; w.x = pg8::cvt_pk_bf16(v0[0], v0[1]); w.y = pg8::cvt_pk_bf16(v0[2], v0[3]); w.z = pg8::cvt_pk_bf16(v1[0], v1[1]); w.w = pg8::cvt_pk_bf16(v1[2], v1[3]);
                    if (NOSTORE) asm volatile("" :: "v"(w)); else { *(pg8::u32x4*)(rowp + bj * 128) = w;
#ifdef MK_EXP_ST2
                        asm volatile("" ::: "memory"); *(volatile pg8::u32x4*)(rowp + bj * 128) = w;
#endif
                    }
                }
            }
    }
};
__device__ __forceinline__ pg8::f32x4 ld4(const float* p) { return *(const pg8::f32x4*)p; }
__device__ __forceinline__ pg8::f32x4 ld4(const bf16* p) { const u32x2 w = *(const u32x2*)p; pg8::f32x4 v; v[0] = bflo(w.x); v[1] = bfhi(w.x); v[2] = bflo(w.y); v[3] = bfhi(w.y); return v; }
__device__ __forceinline__ void st4(float* p, const pg8::f32x4& v) { *(pg8::f32x4*)p = v; }
__device__ __forceinline__ void st4(bf16* p, const pg8::f32x4& v) { u32x2 w; w.x = pg8::cvt_pk_bf16(v[0], v[1]); w.y = pg8::cvt_pk_bf16(v[2], v[3]); *(u32x2*)p = w; }
template <class BT = float, class OT = float> struct EpiResidT {
    static constexpr bool PERM = false, AFTER_DRAIN = false;
    const BT* base_lat; const BT* base_ctx; OT* out_lat; OT* out_ctx; const float* mod_l; int need_ctx; int dry;
    bf16* Hn; const float* gnext; const float* modn; float* ssq;
    __device__ __forceinline__ void operator()(const pg8::f32x4 (&acc)[2][2][4][2], const pg8::Unit& u, int wr, int wc, int fr, int fq) const {
        asm volatile("" : "+v"(fr), "+v"(fq));
        const int r0 = u.pm * 256, b = r0 / RB, rr0 = r0 % RB; const bool ctx = rr0 == 0;
        if ((ctx && !need_ctx) || dry) return;
        const size_t ro = ctx ? (size_t)b * CT * D : ((size_t)b * S + (rr0 - CT)) * D;
        const BT* bp = (ctx ? base_ctx : base_lat) + ro; OT* op = (ctx ? out_ctx : out_lat) + ro;
        const float* gt = mod_l + (size_t)(ctx ? 16 : b) * 3072 + 2048;
        const int col0 = u.pn * 256 + wc * 32 + 4 * fq;
        pg8::f32x4 g[2][2];
#pragma unroll
        for (int bj = 0; bj < 2; ++bj)
#pragma unroll
            for (int n = 0; n < 2; ++n) g[bj][n] = *(const pg8::f32x4*)(gt + col0 + bj * 128 + n * 16);
        pg8::f32x4 gm[2][2];
        if (Hn) { const float* sn = modn + (size_t)(ctx ? 16 : b) * 3072 + 1024;
#pragma unroll
            for (int bj = 0; bj < 2; ++bj)
#pragma unroll
                for (int n = 0; n < 2; ++n) gm[bj][n] = *(const pg8::f32x4*)(gnext + col0 + bj * 128 + n * 16) * (*(const pg8::f32x4*)(sn + col0 + bj * 128 + n * 16) + 1.0f); }
#pragma unroll
        for (int ai = 0; ai < 2; ++ai)
#pragma unroll
            for (int m = 0; m < 4; ++m) { const size_t off = (size_t)(ai * 128 + wr * 64 + m * 16 + fr) * D + col0; float sq = 0.f;
#pragma unroll
                for (int bj = 0; bj < 2; ++bj)
#pragma unroll
                    for (int n = 0; n < 2; ++n) { const pg8::f32x4 bs = ld4(bp + off + bj * 128 + n * 16); const pg8::f32x4 xn = bs + g[bj][n] * acc[ai][bj][m][n]; st4(op + off + bj * 128 + n * 16, xn);
                        if (Hn) { sq += (xn[0] * xn[0] + xn[1] * xn[1]) + (xn[2] * xn[2] + xn[3] * xn[3]); const pg8::f32x4 hv = xn * gm[bj][n];
                            u32x2 w; w.x = pg8::cvt_pk_bf16(hv[0], hv[1]); w.y = pg8::cvt_pk_bf16(hv[2], hv[3]); *(u32x2*)(Hn + (size_t)(r0 + ai * 128 + wr * 64 + m * 16 + fr) * D + col0 + bj * 128 + n * 16) = w; } }
                if (Hn) { sq += __shfl_xor(sq, 16); sq += __shfl_xor(sq, 32); if (fq == 0) ssq[(size_t)(r0 + ai * 128 + wr * 64 + m * 16 + fr) * 16 + u.pn * 4 + wc] = sq; } }
    }
};
using EpiResid = EpiResidT<float, float>;

struct LatOnlyOrder {
    pg8::StaticOrder lat;
    __device__ void init(int G_, int c_) { lat.init(128 * 256, D, G_, c_); }
    __device__ bool next(int i, pg8::Unit& u) const { const bool ok = lat.next(i, u); u.pm = (u.pm >> 3) * 9 + 1 + (u.pm & 7); return ok; }
    __device__ __forceinline__ void a_ready(const pg8::Unit&) const {}
    __device__ __forceinline__ void done(const pg8::Unit&) const {}
};
struct OutTailOrder {
    int c;
    __device__ void init(int, int c_) { c = c_; }
    __device__ bool next(int i, pg8::Unit& u) const { if (i > 0 || c >= 64) return false; const int x = c & 7, j = c >> 3; u.pm = 128 + 2 * x + (j >> 2); u.pn = j & 3; return true; }
    __device__ __forceinline__ void a_ready(const pg8::Unit&) const {}
    __device__ __forceinline__ void done(const pg8::Unit&) const {}
};
struct L3Order {
    pg8::StaticOrder lat; int G, c;
    __device__ void init(int G_, int c_) { lat.init(64 * 256, 18 * 256, G_, c_); G = G_; c = c_; }
    __device__ bool next(int i, pg8::Unit& u) const {
        const long L = (long)i * G + c;
        if (L < 1152) { const bool ok = lat.next(i, u); u.pm = (u.pm >> 3) * 9 + 1 + (u.pm & 7); return ok; }
        if (L >= 1168) return false;
        const int j = (int)L - 1152; u.pm = (j >> 1) * 9; u.pn = 8 + (j & 1); return true;
    }
    __device__ __forceinline__ void a_ready(const pg8::Unit&) const {}
    __device__ __forceinline__ void done(const pg8::Unit&) const {}
};

__device__ __forceinline__ void transpose_item(const float* W, int K, int N, bf16* WT, LAS float* scr, int item, int lane) {
    const int nblk = N / 32, kb = item / nblk, nb = item % nblk, k0 = 64 * kb, n0 = 32 * nb;
#pragma unroll 8
    for (int i = 0; i < 32; ++i) { const int kk = 2 * i + (lane >> 5); scr[kk * 33 + (lane & 31)] = W[(size_t)(k0 + kk) * N + n0 + (lane & 31)]; }
    LDS_WAIT(); asm volatile("" ::: "memory");
    const int c = lane & 7;
#pragma unroll
    for (int j = 0; j < 4; ++j) { const int n = (lane >> 3) + 8 * j; const LAS float* s = scr + (8 * c) * 33 + n;
        v4u o; o.x = pk2(s[0 * 33], s[1 * 33]); o.y = pk2(s[2 * 33], s[3 * 33]); o.z = pk2(s[4 * 33], s[5 * 33]); o.w = pk2(s[6 * 33], s[7 * 33]);
        *(GAS v4u*)(WT + (size_t)(n0 + n) * K + k0 + 8 * c) = o; }
    LDS_WAIT(); asm volatile("" ::: "memory");
}
__device__ __forceinline__ void wconv(Frame& F0, const float* Win, int Nin, const float* Wout, bf16* WinT, bf16* WoutT, int gw, int NGW) {
    Frame F = fresh(F0);
    LAS float* scr = (LAS float*)(F.lds + F.wave * 16384);
    const int I1 = (D / 64) * (Nin / 32), I2 = (DI / 64) * (D / 32);
    for (int it = gw; it < I1 + I2; it += NGW) { if (it < I1) transpose_item(Win, D, Nin, WinT, scr, it, F.lane); else transpose_item(Wout, DI, D, WoutT, scr, it - I1, F.lane); }
}
template <class XT>
__device__ __forceinline__ void norm_phase(Frame& F0, const XT* xlat, const XT* xctx, const float* g, const float* mod_l, bf16* H, int row_lo = 0, int row_hi = MT, int wg0 = 0) {
    Frame F = fresh(F0);
    const int gw = (wg0 ? (int)blockIdx.x - wg0 : F.vcu) * NWAVES + F.wave, NGW = (F.G - wg0) * NWAVES;
    f32x4 gg[4];
#pragma unroll
    for (int j = 0; j < 4; ++j) gg[j] = *(const f32x4*)(g + F.lane * 4 + 256 * j);
    for (int row0 = row_lo + gw; row0 < row_hi; row0 += 2 * NGW) {
        f32x4 v[2][4]; const float* mrow[2]; float ss[2] = {0.f, 0.f}; int rowi[2];
#pragma unroll
        for (int u = 0; u < 2; ++u) { int row = row0 + u * NGW; if (row >= row_hi) row = row0; rowi[u] = row;
            const int b = row / RB, rr = row % RB;
            const XT* src = rr < CT ? xctx + ((size_t)b * CT + rr) * D : xlat + ((size_t)b * S + (rr - CT)) * D;
            mrow[u] = mod_l + (size_t)(rr < CT ? 16 : b) * 3072;
#pragma unroll
            for (int j = 0; j < 4; ++j) v[u][j] = ld4(src + F.lane * 4 + 256 * j); }
#pragma unroll
        for (int u = 0; u < 2; ++u) {
#pragma unroll
            for (int j = 0; j < 4; ++j) ss[u] += (v[u][j].x * v[u][j].x + v[u][j].y * v[u][j].y) + (v[u][j].z * v[u][j].z + v[u][j].w * v[u][j].w);
            const float rstd = rsqrtf(wave_sum(ss[u]) * (1.f / D) + EPS);
#pragma unroll
            for (int j = 0; j < 4; ++j) { const int c = F.lane * 4 + 256 * j; const f32x4 sc = *(const f32x4*)(mrow[u] + 1024 + c), sh = *(const f32x4*)(mrow[u] + c);
                const f32x4 o = v[u][j] * rstd * gg[j] * (sc + 1.0f) + sh;
                u32x2 w; w.x = pk2(o.x, o.y); w.y = pk2(o.z, o.w); *(u32x2*)(H + (size_t)rowi[u] * D + c) = w; }
        }
    }
}
__device__ __forceinline__ void final_norm_phase(Frame& F0, float* xs, const float* g) {
    Frame F = fresh(F0);
    const int gw = F.vcu * NWAVES + F.wave, NGW = F.G * NWAVES;
    f32x4 gg[4];
#pragma unroll
    for (int j = 0; j < 4; ++j) gg[j] = *(const f32x4*)(g + F.lane * 4 + 256 * j);
    for (int row0 = gw; row0 < NB * S; row0 += 2 * NGW) {
        f32x4 v[2][4]; float* p[2];
#pragma unroll
        for (int u = 0; u < 2; ++u) { int row = row0 + u * NGW; if (row >= NB * S) row = row0; p[u] = xs + (size_t)row * D;
#pragma unroll
            for (int j = 0; j < 4; ++j) v[u][j] = *(const f32x4*)(p[u] + F.lane * 4 + 256 * j); }
#pragma unroll
        for (int u = 0; u < 2; ++u) { float ss = 0.f;
#pragma unroll
            for (int j = 0; j < 4; ++j) ss += (v[u][j].x * v[u][j].x + v[u][j].y * v[u][j].y) + (v[u][j].z * v[u][j].z + v[u][j].w * v[u][j].w);
            const float rstd = rsqrtf(wave_sum(ss) * (1.f / D) + EPS);
#pragma unroll
            for (int j = 0; j < 4; ++j) { const int c = F.lane * 4 + 256 * j; *(f32x4*)(p[u] + c) = v[u][j] * rstd * gg[j]; } }
    }
}
__device__ __forceinline__ void shw_phase(Frame& F0, const Args& a) {
    Frame F = fresh(F0);
    const float* mod = (const float*)(a.ws + WS_MOD); float* shw = (float*)(a.ws + WS_SHW);
    LAS float* sh = (LAS float*)F.lds;
    LAS float* red = (LAS float*)(F.lds + 69632);
    int cur_l = -1;
    for (int it = blockIdx.x; it < 128 + 128 + 72; it += F.G) {
        const int l = it < 128 ? 0 : (it < 256 ? 1 : 2), cg = it - (l == 0 ? 0 : (l == 1 ? 128 : 256));
        const int N = l == 2 ? 4608 : 8192; const float* W = a.in[l == 0 ? 19 : (l == 1 ? 26 : 29)];
        __syncthreads();
        if (l != cur_l) { for (int i = F.tid; i < 17 * 1024; i += NTHR) sh[i] = mod[((size_t)(l + 1) * 17 + (i >> 10)) * 3072 + (i & 1023)]; cur_l = l; __syncthreads(); }
        float acc[17];
#pragma unroll
        for (int r = 0; r < 17; ++r) acc[r] = 0.f;
        const float* wp = W + (size_t)(F.wave * 128) * N + cg * 64 + F.lane;
#pragma unroll 8
        for (int kk = 0; kk < 128; ++kk) { const float w = wp[(size_t)kk * N];
#pragma unroll
            for (int r = 0; r < 17; ++r) acc[r] += sh[r * 1024 + F.wave * 128 + kk] * w; }
#pragma unroll
        for (int r = 0; r < 17; ++r) red[(F.wave * 17 + r) * 64 + F.lane] = acc[r];
        __syncthreads();
        for (int i = F.tid; i < 17 * 64; i += NTHR) { float sacc = 0.f;
#pragma unroll
            for (int w8 = 0; w8 < 8; ++w8) sacc += red[(w8 * 17 + (i >> 6)) * 64 + (i & 63)];
            shw[((size_t)l * 17 + (i >> 6)) * 8192 + cg * 64 + (i & 63)] = sacc; }
    }
    __syncthreads();
}
__device__ __forceinline__ void prologue_phase(Frame& F0, const Args& a) {
    Frame F = fresh(F0);
    const float* c = a.in[1]; const float* cctx = a.in[3]; const float* w_ada = a.in[5];
    float* part = (float*)(a.ws + WS_QG);
    {
        LAS float* st = (LAS float*)F.lds;
        const int wg = blockIdx.x, l = wg >> 6, sl = wg & 63, k0 = sl * 16;
        if (F.tid < 17 * 16) { const int r = F.tid >> 4, k = F.tid & 15; st[F.tid] = silu(r < 16 ? c[r * 1024 + k0 + k] : cctx[k0 + k]); }
        __syncthreads();
        float acc[17][6];
#pragma unroll
        for (int r = 0; r < 17; ++r)
#pragma unroll
            for (int i = 0; i < 6; ++i) acc[r][i] = 0.f;
        const float* wp = w_ada + ((size_t)l * 1024 + k0) * 3072 + F.tid;
#pragma unroll 2
        for (int kk = 0; kk < 16; ++kk) { float w[6];
#pragma unroll
            for (int i = 0; i < 6; ++i) w[i] = wp[(size_t)kk * 3072 + 512 * i];
#pragma unroll
            for (int r = 0; r < 17; ++r) { const float sv = st[r * 16 + kk];
#pragma unroll
                for (int i = 0; i < 6; ++i) acc[r][i] += sv * w[i]; } }
        float* pp = part + (size_t)wg * 17 * 3072 + F.tid;
#pragma unroll
        for (int r = 0; r < 17; ++r)
#pragma unroll
            for (int i = 0; i < 6; ++i) pp[r * 3072 + 512 * i] = acc[r][i];
    }
#ifdef MK_TOUCH
    {
        const int xg = blockIdx.x >> 3; unsigned accv = 0u;
        for (size_t off = ((size_t)xg * NTHR + F.tid) * 4096; off < WS_END; off += (size_t)32 * NTHR * 4096) accv += *(const unsigned*)(a.ws + off);
        for (size_t off = ((size_t)xg * NTHR + F.tid) * 4096; off < (size_t)NB * S * D * 4; off += (size_t)32 * NTHR * 4096) accv += *(const unsigned*)((const unsigned char*)a.out + off) + *(const unsigned*)((const unsigned char*)a.in[0] + off);
        asm volatile("" :: "v"(accv));
    }
#endif
    if (blockIdx.x == 0) {
        float* rope = (float*)(a.ws + WS_ROPE);
        for (int i = F.tid; i < 64 * 16; i += NTHR) { const int pos = i >> 4, j = i & 15; const float inv = powf(10000.f, -(float)j / 16.f), ang = (float)pos * inv; rope[2 * i] = cosf(ang); rope[2 * i + 1] = sinf(ang); }
    } else if (blockIdx.x < 33) {
        bf16* W2 = (bf16*)(a.ws + WS_WG2); const float* wq = a.in[11]; const float* wk = a.in[12]; const float* wv = a.in[13]; const float* wg = a.in[14];
        for (int i = (blockIdx.x - 1) * NTHR + F.tid; i < 32 * 4096; i += 32 * NTHR) { const int n = i >> 12, k = i & 4095; float s = 0.f;
            if (k < 2048) { const int gq = k >> 2, ii = k & 3;
#pragma unroll
                for (int j = 0; j < 4; ++j) s += wq[(gq * 4 + ii) * 4 + j] * wg[(size_t)(gq * 4 + j) * 32 + n] + wk[(gq * 4 + ii) * 4 + j] * wg[(size_t)(2048 + gq * 4 + j) * 32 + n]; }
            else { const int kk = k - 2048, gq = kk >> 2, ii = kk & 3;
#pragma unroll
                for (int j = 0; j < 4; ++j) s += wv[(gq * 4 + ii) * 4 + j] * wg[(size_t)(4096 + gq * 4 + j) * 32 + n]; }
            W2[i] = (bf16)f2bf(s); }
    }
}
__device__ __forceinline__ void prologue2_phase(Frame& F0, const Args& a) {
    Frame F = fresh(F0);
    const float* part = (const float*)(a.ws + WS_QG); const float* b_ada = a.in[6]; float* mod = (float*)(a.ws + WS_MOD);
    for (int o = blockIdx.x * NTHR + F.tid; o < 4 * 17 * 3072; o += F.G * NTHR) {
        const int l = o / (17 * 3072), rn = o % (17 * 3072), n = rn % 3072;
        const float* pp = part + (size_t)l * 64 * 17 * 3072 + rn; float s0 = 0.f, s1 = 0.f, s2 = 0.f, s3 = 0.f;
#pragma unroll
        for (int sl = 0; sl < 64; sl += 16) { float v[16];
#pragma unroll
            for (int j = 0; j < 16; ++j) v[j] = pp[(size_t)(sl + j) * 17 * 3072];
#pragma unroll
            for (int j = 0; j < 16; j += 4) { s0 += v[j]; s1 += v[j + 1]; s2 += v[j + 2]; s3 += v[j + 3]; } }
        mod[o] = ((s0 + s1) + (s2 + s3)) + b_ada[l * 3072 + n];
    }
}
}
namespace att {
using mk::bf16; using mk::bf16x8; using mk::s16x4; using mk::f32x16; using mk::u32x4; using mk::u32x2;
typedef short v4i16_t __attribute__((ext_vector_type(4)));
typedef float f32x2_t __attribute__((ext_vector_type(2))); typedef __bf16 bf16x2_t __attribute__((ext_vector_type(2)));
__device__ __forceinline__ int crow(int r, int hi) { return (r & 3) + 8 * (r >> 2) + 4 * hi; }
__device__ __forceinline__ unsigned cvtpk(float lo, float hi) { f32x2_t v = {lo, hi}; bf16x2_t b = __builtin_convertvector(v, bf16x2_t); return __builtin_bit_cast(unsigned, b); }
__device__ __forceinline__ s16x4 vtr(LAS const unsigned char* p) { return __builtin_bit_cast(s16x4, __builtin_amdgcn_ds_read_tr16_b64_v4i16((LAS v4i16_t*)p)); }
__device__ __forceinline__ float ex2(float x) { return __builtin_amdgcn_exp2f(x); }
__device__ __forceinline__ float max3f(float a, float b, float c) { float r; asm("v_max3_f32 %0, %1, %2, %3" : "=v"(r) : "v"(a), "v"(b), "v"(c)); return r; }
#define ATT_SB() __builtin_amdgcn_sched_barrier(0)

struct Src { const bf16* K[2]; const bf16* V; int ldk, ldv; };

template <int DV, int NCOMP> struct Stage { u32x4 kr[NCOMP]; u32x4 vr[DV / 64]; };
template <int DV, int NCOMP>
__device__ __forceinline__ void stage_load(Stage<DV, NCOMP>& st, const Src& s, size_t row, int wid, int lane) {
#pragma unroll
    for (int c = 0; c < NCOMP; ++c) st.kr[c] = *(const u32x4*)(s.K[c] + (row + lane) * s.ldk + wid * 8);
#pragma unroll
    for (int i = 0; i < DV / 64; ++i) { const int p = wid + 8 * i, d0 = p >> 2, kg = p & 3; st.vr[i] = *(const u32x4*)(s.V + (row + 16 * kg + (lane >> 2)) * s.ldv + d0 * 32 + (lane & 3) * 8); }
}
template <int DV, int NCOMP>
__device__ __forceinline__ void stage_store(const Stage<DV, NCOMP>& st, LAS unsigned char* buf, int wid, int lane) {
#pragma unroll
    for (int c = 0; c < NCOMP; ++c) *(LAS u32x4*)(buf + c * 8192 + wid * 1024 + lane * 16) = st.kr[c];
#pragma unroll
    for (int i = 0; i < DV / 64; ++i) *(LAS u32x4*)(buf + NCOMP * 8192 + (wid + 8 * i) * 1024 + lane * 16) = st.vr[i];
}
__device__ __forceinline__ void glds16(const void* gsrc, unsigned lds_dst) { unsigned keep;
    asm volatile("s_mov_b32 %0, m0\n\ts_mov_b32 m0, %2\n\ts_nop 0\n\tglobal_load_lds_dwordx4 %1, off\n\ts_mov_b32 m0, %0" : "=&s"(keep) : "v"(gsrc), "s"(lds_dst) : "memory"); }
__device__ __forceinline__ unsigned long long uni64(const void* p) { const unsigned long long a = (unsigned long long)p;
    return ((unsigned long long)(unsigned)__builtin_amdgcn_readfirstlane((unsigned)(a >> 32)) << 32) | (unsigned)__builtin_amdgcn_readfirstlane((unsigned)a); }
__device__ __forceinline__ void glds16s(const void* sbase_, unsigned voff, unsigned lds_dst) { unsigned keep; const unsigned long long sbase = uni64(sbase_);
    asm volatile("s_mov_b32 %0, m0\n\ts_mov_b32 m0, %3\n\ts_nop 0\n\tglobal_load_lds_dwordx4 %1, %2\n\ts_mov_b32 m0, %0" : "=&s"(keep) : "v"(voff), "s"(sbase), "s"(lds_dst) : "memory"); }
template <int DV, int NCOMP>
__device__ __forceinline__ void dma_issue(const Src& s, size_t row, LAS unsigned char* buf, int wid, int lane) {
    const unsigned b0 = (unsigned)(size_t)buf;
    const int kl = lane >> 3;
    const unsigned ko = (unsigned)(kl * s.ldk + (((lane & 7) ^ ((4 * (wid & 1) + (kl >> 1)) & 7)) * 8)) * 2u, vo = (unsigned)((16 * (wid & 3) + (lane >> 2)) * s.ldv + (lane & 3) * 8) * 2u;
#pragma unroll
    for (int c = 0; c < NCOMP; ++c) glds16s(s.K[c] + (row + 8 * wid) * s.ldk, ko, (unsigned)__builtin_amdgcn_readfirstlane(b0 + c * 8192 + wid * 1024));
#pragma unroll
    for (int i = 0; i < DV / 64; ++i) { const int p = wid + 8 * i, d0 = p >> 2;
        glds16s(s.V + row * s.ldv + d0 * 32, vo, (unsigned)__builtin_amdgcn_readfirstlane(b0 + NCOMP * 8192 + p * 1024)); }
}
#define ATT_WAIT_BAR(N) asm volatile("s_waitcnt vmcnt(" #N ") lgkmcnt(0)\n\ts_barrier" ::: "memory")
template <int NL> __device__ __forceinline__ void wait_bar_keep() { if constexpr (NL == 2) ATT_WAIT_BAR(2); else if constexpr (NL == 4) ATT_WAIT_BAR(4); else static_assert(NL == 2 || NL == 4, "pieces per wave"); }
__device__ __forceinline__ void qk_tile(LAS const unsigned char* kimg, const bf16x8 (&qf)[4], int r32, int hi, f32x16& p0, f32x16& p1, const f32x16& z, const f32x16& z1  ) {
    const int sw = (r32 >> 1) & 7, u16 = (sw & 6) * 16;
    LAS const unsigned char* kb = kimg + r32 * 128 + ((hi ^ sw) & 1) * 16;
    LAS const unsigned char* ka[4] = {kb + (0 ^ u16), kb + (32 ^ u16), kb + (64 ^ u16), kb + (96 ^ u16)};
#define ATT_KRD(i) (*(LAS const bf16x8*)(ka[(i) >> 1] + ((i) & 1) * 4096))
    bf16x8 f0 = ATT_KRD(0), f1 = ATT_KRD(1), f2;
    f2 = ATT_KRD(2); ATT_SB(); p0 = __builtin_amdgcn_mfma_f32_32x32x16_bf16(f0, qf[0], z, 0, 0, 0);
    f0 = ATT_KRD(3); ATT_SB(); p1 = __builtin_amdgcn_mfma_f32_32x32x16_bf16(f1, qf[0], z1, 0, 0, 0);
    f1 = ATT_KRD(4); ATT_SB(); p0 = __builtin_amdgcn_mfma_f32_32x32x16_bf16(f2, qf[1], p0, 0, 0, 0);
    f2 = ATT_KRD(5); ATT_SB(); p1 = __builtin_amdgcn_mfma_f32_32x32x16_bf16(f0, qf[1], p1, 0, 0, 0);
    f0 = ATT_KRD(6); ATT_SB(); p0 = __builtin_amdgcn_mfma_f32_32x32x16_bf16(f1, qf[2], p0, 0, 0, 0);
    f1 = ATT_KRD(7); ATT_SB(); p1 = __builtin_amdgcn_mfma_f32_32x32x16_bf16(f2, qf[2], p1, 0, 0, 0);
    ATT_SB(); p0 = __builtin_amdgcn_mfma_f32_32x32x16_bf16(f0, qf[3], p0, 0, 0, 0);
    ATT_SB(); p1 = __builtin_amdgcn_mfma_f32_32x32x16_bf16(f1, qf[3], p1, 0, 0, 0);
#undef ATT_KRD
}
template <int DV>
__device__ __forceinline__ void softmax_tile(f32x16& p0, f32x16& p1, f32x16 (&o)[DV / 32], float& m, float& l, u32x4 (&pw)[4]) {
    float mxa = max3f(p0[0], p0[1], p1[0]), mxb = max3f(p0[2], p0[3], p1[1]); mxa = max3f(mxa, p1[2], p1[3]);
#pragma unroll
    for (int r = 4; r < 16; r += 4) { mxa = max3f(mxa, p0[r], p0[r + 1]); mxb = max3f(mxb, p0[r + 2], p0[r + 3]); mxa = max3f(mxa, p1[r], p1[r + 1]); mxb = max3f(mxb, p1[r + 2], p1[r + 3]); }
    const float mx0 = max3f(mxa, mxb, mxb);
    const float mn = max3f(m, mx0, __shfl_xor(mx0, 32)), alpha = ex2(m - mn);
    float ls = 0.f;
#pragma unroll
    for (int r = 0; r < 16; ++r) { p0[r] = ex2(p0[r] - mn); p1[r] = ex2(p1[r] - mn); ls += p0[r] + p1[r]; }
    l = l * alpha + ls;
    if (__any(mn != m)) {
#pragma unroll
        for (int d0 = 0; d0 < DV / 32; ++d0)
#pragma unroll
            for (int r = 0; r < 16; ++r) o[d0][r] *= alpha;
    }
    m = mn;
#pragma unroll
    for (int ks = 0; ks < 4; ++ks) { const int b = 8 * (ks & 1);
        if (ks < 2) { pw[ks].x = cvtpk(p0[b], p0[b + 1]); pw[ks].y = cvtpk(p0[b + 2], p0[b + 3]); pw[ks].z = cvtpk(p0[b + 4], p0[b + 5]); pw[ks].w = cvtpk(p0[b + 6], p0[b + 7]); }
        else { pw[ks].x = cvtpk(p1[b], p1[b + 1]); pw[ks].y = cvtpk(p1[b + 2], p1[b + 3]); pw[ks].z = cvtpk(p1[b + 4], p1[b + 5]); pw[ks].w = cvtpk(p1[b + 6], p1[b + 7]); } }
}
template <int DV>
__device__ __forceinline__ void pv_tile(LAS const unsigned char* vimg, int lane, int hi, const u32x4 (&pw)[4], f32x16 (&o)[DV / 32]) {
    LAS const unsigned char* vb = vimg + ((lane >> 4) & 1) * 32 + (lane & 3) * 8 + (4 * hi + ((lane & 15) >> 2)) * 64;
    constexpr int ND = DV / 32, NF = 4 * ND;
    constexpr int PD = 4, NB_ = PD + 1;
    s16x4 lo[NB_], hi4[NB_];
#define ATT_VRD(i, b) do { lo[b] = vtr(vb + ((i) % ND) * 4096 + ((i) / ND) * 1024); hi4[b] = vtr(vb + ((i) % ND) * 4096 + ((i) / ND) * 1024 + 512); } while (0)
#pragma unroll
    for (int i = 0; i < PD; ++i) ATT_VRD(i, i);
#pragma unroll
    for (int i = 0; i < NF; ++i) {
        if (i + PD < NF) ATT_VRD(i + PD, (i + PD) % NB_);
        ATT_SB();
        const int b = i % NB_;
        const bf16x8 vf = {lo[b][0], lo[b][1], lo[b][2], lo[b][3], hi4[b][0], hi4[b][1], hi4[b][2], hi4[b][3]};
        o[i % ND] = __builtin_amdgcn_mfma_f32_32x32x16_bf16(vf, __builtin_bit_cast(bf16x8, pw[i / ND]), o[i % ND], 0, 0, 0);
    }
#undef ATT_VRD
}

struct SmState { float mxa, mxb, mn, alpha, ls, delta; bool resc; };
template <int NM>
__device__ __forceinline__ void negm_shift(f32x16 (&negm)[NM], float delta) {
#pragma unroll
    for (int i = 0; i < NM; ++i)
#pragma unroll
        for (int r = 0; r < 16; ++r) negm[i][r] -= delta;
}
__device__ __forceinline__ float xmax32(float v) { auto rr = __builtin_amdgcn_permlane32_swap(__float_as_uint(v), __float_as_uint(v), false, false); return max3f(__uint_as_float(rr[0]), __uint_as_float(rr[1]), v); }
template <int SK> __device__ __forceinline__ constexpr bool sm_live0(int r) { return SK != 2 || r >= 12; }
template <int SK> __device__ __forceinline__ constexpr bool sm_live1(int r) { return SK != 1 || r < 4; }
template <int SK = 0>
__device__ __forceinline__ void sm_slice(int k, f32x16& p0, f32x16& p1, float& m, float& l, SmState& s, u32x4 (&pwn)[4]) {
    if (k <= 3) { const int r = 4 * k;
        if (SK == 0 && k == 0) { s.mxa = max3f(p0[0], p0[1], p1[0]); s.mxb = max3f(p0[2], p0[3], p1[1]); s.mxa = max3f(s.mxa, p1[2], p1[3]); }
        else { if (k == 0) { s.mxa = -INFINITY; s.mxb = -INFINITY; }
            if (sm_live0<SK>(r)) { s.mxa = max3f(s.mxa, p0[r], p0[r + 1]); s.mxb = max3f(s.mxb, p0[r + 2], p0[r + 3]); }
            if (sm_live1<SK>(r)) { s.mxa = max3f(s.mxa, p1[r], p1[r + 1]); s.mxb = max3f(s.mxb, p1[r + 2], p1[r + 3]); } }
        asm volatile("" : "+v"(s.mxa), "+v"(s.mxb)); }
    else if (k == 4) { const float mx0 = xmax32(max3f(s.mxa, s.mxb, s.mxb)); const bool first = m == -INFINITY;
        const float delta = (first || mx0 > 8.f) ? mx0 : 0.f; s.delta = delta; s.mn = first ? mx0 : m + delta; s.alpha = ex2(-delta); s.resc = __any(delta != 0.f); l *= s.alpha; s.ls = 0.f;
        if (s.resc) {
#pragma unroll
            for (int r = 0; r < 16; ++r) { p0[r] -= delta; p1[r] -= delta; }
        }
        asm volatile("" : "+v"(s.mn), "+v"(s.alpha), "+v"(l)); }
    else if (k <= 12) { const int j = 2 * (k - 5);
        if (sm_live0<SK>(j)) { p0[j] = ex2(p0[j]); p0[j + 1] = ex2(p0[j + 1]); s.ls += p0[j] + p0[j + 1]; }
        if (sm_live1<SK>(j)) { p1[j] = ex2(p1[j]); p1[j + 1] = ex2(p1[j + 1]); s.ls += p1[j] + p1[j + 1]; }
        asm volatile("" : "+v"(p0), "+v"(p1), "+v"(s.ls)); }
    else if (k == 13) {
        if (SK == 2) { pwn[0] = u32x4{0u, 0u, 0u, 0u}; pwn[1].x = 0u; pwn[1].y = 0u; }
        else { pwn[0].x = cvtpk(p0[0], p0[1]); pwn[0].y = cvtpk(p0[2], p0[3]); pwn[0].z = cvtpk(p0[4], p0[5]); pwn[0].w = cvtpk(p0[6], p0[7]); pwn[1].x = cvtpk(p0[8], p0[9]); pwn[1].y = cvtpk(p0[10], p0[11]); }
        pwn[1].z = cvtpk(p0[12], p0[13]); pwn[1].w = cvtpk(p0[14], p0[15]); asm volatile("" : "+v"(pwn[0]), "+v"(pwn[1])); }
    else if (k == 14) { pwn[2].x = cvtpk(p1[0], p1[1]); pwn[2].y = cvtpk(p1[2], p1[3]);
        if (SK == 1) { pwn[2].z = 0u; pwn[2].w = 0u; pwn[3] = u32x4{0u, 0u, 0u, 0u}; }
        else { pwn[2].z = cvtpk(p1[4], p1[5]); pwn[2].w = cvtpk(p1[6], p1[7]); pwn[3].x = cvtpk(p1[8], p1[9]); pwn[3].y = cvtpk(p1[10], p1[11]); pwn[3].z = cvtpk(p1[12], p1[13]); pwn[3].w = cvtpk(p1[14], p1[15]); }
        asm volatile("" : "+v"(pwn[2]), "+v"(pwn[3])); }
    else { l += s.ls; asm volatile("" : "+v"(l)); }
}
template <int DV, int NM, int SK = 0>
__device__ __forceinline__ void sm_alone(f32x16& p0, f32x16& p1, f32x16 (&o)[DV / 32], float& m, float& l, u32x4 (&pwn)[4], f32x16 (&negm)[NM]) {
    SmState s;
#pragma unroll
    for (int k = 0; k < 16; ++k) sm_slice<SK>(k, p0, p1, m, l, s, pwn);
    if (s.resc) {
#pragma unroll
        for (int d0 = 0; d0 < DV / 32; ++d0)
#pragma unroll
            for (int r = 0; r < 16; ++r) o[d0][r] *= s.alpha;
        negm_shift<NM>(negm, s.delta);
    }
    m = s.mn;
}
template <int DV, int NM, int SK = 0>
__device__ __forceinline__ void pv_sm_tile(LAS const unsigned char* vimg, int lane, int hi, const u32x4 (&pw)[4], f32x16 (&o)[DV / 32], f32x16& p0, f32x16& p1, float& m, float& l, u32x4 (&pwn)[4], f32x16 (&negm)[NM]) {
    LAS const unsigned char* vb = vimg + ((lane >> 4) & 1) * 32 + (lane & 3) * 8 + (4 * hi + ((lane & 15) >> 2)) * 64;
    constexpr int ND = DV / 32, NF = 4 * ND, PD = 3, NB_ = PD + 1, SPM = 16 / NF;
    s16x4 lo[NB_], hi4[NB_];
    SmState s;
#define ATT_VRD(i, b) do { lo[b] = vtr(vb + ((i) % ND) * 4096 + ((i) / ND) * 1024); hi4[b] = vtr(vb + ((i) % ND) * 4096 + ((i) / ND) * 1024 + 512); } while (0)
#pragma unroll
    for (int i = 0; i < PD; ++i) ATT_VRD(i, i);
#pragma unroll
    for (int i = 0; i < NF; ++i) {
        if (i + PD < NF) ATT_VRD(i + PD, (i + PD) % NB_);
        ATT_SB();
        const int b = i % NB_;
        const bf16x8 vf = {lo[b][0], lo[b][1], lo[b][2], lo[b][3], hi4[b][0], hi4[b][1], hi4[b][2], hi4[b][3]};
        o[i % ND] = __builtin_amdgcn_mfma_f32_32x32x16_bf16(vf, __builtin_bit_cast(bf16x8, pw[i / ND]), o[i % ND], 0, 0, 0);
#pragma unroll
        for (int k = i * SPM; k < (i + 1) * SPM; ++k) sm_slice<SK>(k, p0, p1, m, l, s, pwn);
        ATT_SB();
    }
#undef ATT_VRD
    if (s.resc) {
#pragma unroll
        for (int d0 = 0; d0 < ND; ++d0)
#pragma unroll
            for (int r = 0; r < 16; ++r) o[d0][r] *= s.alpha;
        negm_shift<NM>(negm, s.delta);
    }
    m = s.mn;
}

__device__ __forceinline__ void wait_bar_tiles2(int c) {
    if (c >= 5) ATT_WAIT_BAR(10); else if (c == 4) ATT_WAIT_BAR(8); else if (c == 3) ATT_WAIT_BAR(6); else if (c == 2) ATT_WAIT_BAR(4); else if (c == 1) ATT_WAIT_BAR(2); else ATT_WAIT_BAR(0);
}
template <int DV, class Pol, int NS = 4>
__device__ __forceinline__ void run_unit1(LAS unsigned char* lds, const Pol& P, const Src& src, const bf16* Q, int ldq, int wid, int lane) {
    const int r32 = lane & 31, hi = lane >> 5;
    constexpr int STG = 8192 + DV * 128, NL = 1 + DV / 64, LA = NS - 2;
    static_assert(NL == 2 && LA <= 6, "wait_bar_tiles2 counts two-piece tiles");
    const int nt = P.ntiles();
#pragma unroll
    for (int t = 0; t < LA; ++t) if (t < nt) dma_issue<DV, 1>(src, P.tile_row(t), lds + t * STG, wid, lane);
    bf16x8 qf[4];
    { const bf16* qp = Q + (size_t)(wid * 32 + r32) * ldq + hi * 8;
#pragma unroll
      for (int d0 = 0; d0 < 4; ++d0) qf[d0] = *(const bf16x8*)(qp + d0 * 16); }
    f32x16 o[DV / 32];
#pragma unroll
    for (int d0 = 0; d0 < DV / 32; ++d0) o[d0] = f32x16{};
    float m = -INFINITY, l = 0.f; f32x16 negm[1] = {f32x16{}};
    u32x4 pw[4], pwn[4]; bool pend = false;
    asm volatile("" : "+v"(qf[0]), "+v"(qf[1]), "+v"(qf[2]), "+v"(qf[3]));
    ATT_WAIT_BAR(0);
    int ic = 0;
    for (int ti = 0; ti < nt; ++ti) {
        LAS unsigned char* cur = lds + ic * STG; LAS unsigned char* prv = lds + ((ic + NS - 1) & (NS - 1)) * STG;
        if (ti + LA < nt) dma_issue<DV, 1>(src, P.tile_row(ti + LA), lds + ((ic + LA) & (NS - 1)) * STG, wid, lane);
        if (P.needs(ti, wid)) {
            f32x16 p0, p1;
            qk_tile(cur, qf, r32, hi, p0, p1, negm[0], negm[0]);
            P.mask(ti, wid, r32, hi, p0, p1);
            if (pend) pv_sm_tile<DV, 1>(prv + 8192, lane, hi, pw, o, p0, p1, m, l, pwn, negm); else sm_alone<DV, 1>(p0, p1, o, m, l, pwn, negm);
#pragma unroll
            for (int k = 0; k < 4; ++k) pw[k] = pwn[k];
            pend = true;
        } else if (pend) { pv_tile<DV>(prv + 8192, lane, hi, pw, o); pend = false; }
        wait_bar_tiles2(min(ti + LA, nt - 1) - (ti + 1));
        ic = (ic + 1) & (NS - 1);
    }
    if (pend) pv_tile<DV>(lds + ((ic + NS - 1) & (NS - 1)) * STG + 8192, lane, hi, pw, o);
    P.finish(o, m, l, wid, r32, hi);
    ATT_WAIT_BAR(0);
}
constexpr int ZQ_Z = 65536, ZQ_Q = 98304;
__device__ __forceinline__ void glds4s(const void* sbase_, unsigned voff, unsigned lds_dst) { unsigned keep; const unsigned long long sbase = uni64(sbase_);
    asm volatile("s_mov_b32 %0, m0\n\ts_mov_b32 m0, %3\n\ts_nop 0\n\tglobal_load_lds_dword %1, %2\n\ts_mov_b32 m0, %0" : "=&s"(keep) : "v"(voff), "s"(sbase), "s"(lds_dst) : "memory"); }
__device__ __forceinline__ void dma_rows64(const bf16* base, int ld, LAS unsigned char* dst, int lane) {
    const unsigned vo = (unsigned)((lane & 31) * ld + (lane >> 5) * 8) * 2u;
    const unsigned b0 = (unsigned)(size_t)dst;
#pragma unroll
    for (int j = 0; j < 4; ++j) glds16s(base + j * 16, vo, (unsigned)__builtin_amdgcn_readfirstlane(b0 + j * 1024));
}
template <class Pol, int SKL  , class Ctx, class Gen>
__device__ __forceinline__ void run_stream1(LAS unsigned char* lds, const Ctx& C, const Gen& gen, int wid_, int lane_) {
    constexpr int DV = 64, STG = 16384, EX = Pol::EXTRA;
    static_assert(EX == 4 || EX == 5, "first-step wait counts");
    int lane = lane_, wid = wid_;
#define ZL_ (lds + ZQ_Z + wid * 4096)
#define QL_ (lds + ZQ_Q + wid * 4096)
    Pol P;
    if (!gen(0, P)) return;
    dma_rows64(P.qrow(C, wid), mk::DI, QL_, lane);
    dma_issue<DV, 1>(P.src(C), P.tile_row(0), lds, wid, lane);
    dma_issue<DV, 1>(P.src(C), P.tile_row(1), lds + STG, wid, lane);
    ATT_WAIT_BAR(0);
    int ic = 0;
    for (int i = 0;; ++i) {
        Pol Pn; const bool hn = gen(i + 1, Pn);
        asm volatile("" : "+v"(lane), "+s"(wid));
        bf16x8 qf[4];
#pragma unroll
        for (int d0 = 0; d0 < 4; ++d0) qf[d0] = *(LAS const bf16x8*)(QL_ + d0 * 1024 + lane * 16);
        asm volatile("" : "+v"(qf[0]), "+v"(qf[1]), "+v"(qf[2]), "+v"(qf[3]));
        const int nt = P.ntiles();
        f32x16 o[2] = {f32x16{}, f32x16{}};
        float m = -INFINITY, l = 0.f; f32x16 negm[Pol::NM];
#pragma unroll
        for (int i_ = 0; i_ < Pol::NM; ++i_) negm[i_] = f32x16{};
        u32x4 pw[4], pwn[4]; bool pend = false;
        auto steps = [&](auto skc, int t0, int t1) {
          constexpr int SK_ = decltype(skc)::value;
          for (int ti = t0; ti < t1; ++ti) {
            LAS unsigned char* cur = lds + ic * STG; LAS unsigned char* prv = lds + ((ic + 3) & 3) * STG; LAS unsigned char* nxt = lds + ((ic + 2) & 3) * STG;
            asm volatile("" : "+v"(lane), "+s"(wid)); const int r32 = lane & 31, hi = lane >> 5;
            if (ti == 0) { P.stage_extra(C, ZL_, wid, lane); if (hn) dma_rows64(Pn.qrow(C, wid), mk::DI, QL_, lane); }
            bool issued = true;
            if (ti + 2 < nt) dma_issue<DV, 1>(P.src(C), P.tile_row(ti + 2), nxt, wid, lane);
            else if (hn) dma_issue<DV, 1>(Pn.src(C), Pn.tile_row(ti + 2 - nt), nxt, wid, lane);
            else issued = false;
            P.prep(ti, wid, r32, hi, negm);
            if (P.needs(ti, wid)) {
                f32x16 p0, p1;
                qk_tile(cur, qf, r32, hi, p0, p1, negm[0], negm[Pol::NM - 1]);
                P.template mask<SK_>(C, ti, wid, r32, hi, p0, p1);
                if (pend) pv_sm_tile<DV, Pol::NM, SK_>(prv + 8192, lane, hi, pw, o, p0, p1, m, l, pwn, negm); else sm_alone<DV, Pol::NM, SK_>(p0, p1, o, m, l, pwn, negm);
#pragma unroll
                for (int k = 0; k < 4; ++k) pw[k] = pwn[k];
                pend = true;
            } else if (pend) { pv_tile<DV>(prv + 8192, lane, hi, pw, o); pend = false; }
            if (ti == 0) { if constexpr (EX == 4) { if (hn) ATT_WAIT_BAR(10); else ATT_WAIT_BAR(6); } else { if (hn) ATT_WAIT_BAR(11); else ATT_WAIT_BAR(7); } }
            else if (issued) ATT_WAIT_BAR(2); else ATT_WAIT_BAR(0);
            ic = (ic + 1) & 3;
          }
        };
        if constexpr (SKL == 0) steps(std::integral_constant<int, 0>{}, 0, nt);
        else { steps(std::integral_constant<int, 0>{}, 0, 4);
            steps(std::integral_constant<int, SKL>{}, 4, nt); }
        asm volatile("" : "+v"(lane), "+s"(wid)); const int r32 = lane & 31, hi = lane >> 5;
        if (pend) pv_tile<DV>(lds + ((ic + 3) & 3) * STG + 8192, lane, hi, pw, o);
        P.finish(C, o, m, l, wid, r32, hi, ZL_);
        if (!hn) break;
        P = Pn;
    }
    ATT_WAIT_BAR(0);
#undef ZL_
#undef QL_
}
}
namespace mk {
using att::Src; using att::crow; using att::ex2;

template <int DV>
__device__ __forceinline__ void store_gated(const f32x16 (&o)[DV / 32], float inv, const bf16* zrow, bf16* grow, int hi) {
#pragma unroll
    for (int d0 = 0; d0 < DV / 32; ++d0)
#pragma unroll
        for (int i = 0; i < 4; ++i) { const int d = 32 * d0 + 8 * i + 4 * hi;
            const u32x2 zw = *(const u32x2*)(zrow + d);
            const float v0 = o[d0][4 * i] * inv * silu(bflo(zw.x)), v1 = o[d0][4 * i + 1] * inv * silu(bfhi(zw.x)), v2 = o[d0][4 * i + 2] * inv * silu(bflo(zw.y)), v3 = o[d0][4 * i + 3] * inv * silu(bfhi(zw.y));
            u32x2 w; w.x = att::cvtpk(v0, v1); w.y = att::cvtpk(v2, v3); *(u32x2*)(grow + d) = w; }
}

__device__ __forceinline__ void store_gated_l(const f32x16 (&o)[2], float inv, LAS const unsigned char* zl, bf16* grow, int r32, int hi) {
#pragma unroll
    for (int d0 = 0; d0 < 2; ++d0)
#pragma unroll
        for (int i = 0; i < 4; ++i) { const int d = 32 * d0 + 8 * i + 4 * hi;
            const u32x2 zw = *(LAS const u32x2*)(zl + (2 * d0 + (i >> 1)) * 1024 + (r32 + 32 * (i & 1)) * 16 + 8 * hi);
            const float v0 = o[d0][4 * i] * inv * silu(bflo(zw.x)), v1 = o[d0][4 * i + 1] * inv * silu(bfhi(zw.x)), v2 = o[d0][4 * i + 2] * inv * silu(bflo(zw.y)), v3 = o[d0][4 * i + 3] * inv * silu(bfhi(zw.y));
            u32x2 w; w.x = att::cvtpk(v0, v1); w.y = att::cvtpk(v2, v3); *(u32x2*)(grow + d) = w; }
}

struct AttCtx { const bf16* QG; const bf16* Kb; const bf16* Vb; const bf16* Zb; const float* aux; LAS const float* tab; int dry; };
struct SwaPol {
    static constexpr int EXTRA = 4, NM = 1;
    int bl, hq, qb, tl0, ntl; float sinkl2;
    __device__ __forceinline__ size_t off() const { return ((size_t)bl * RB + CT + qb * 256) * DI + hq * 64; }
    __device__ __forceinline__ Src src(const AttCtx& C) const { Src s; s.K[0] = C.Kb + (hq >> 3) * 64; s.K[1] = nullptr; s.V = C.Vb + (hq >> 3) * 64; s.ldk = 256; s.ldv = 256; return s; }
    __device__ __forceinline__ void prep(int, int, int, int, f32x16 (&)[1]) const {}
    __device__ __forceinline__ int ntiles() const { return 4 + ntl; }
    __device__ __forceinline__ const bf16* qrow(const AttCtx& C, int wid) const { return C.QG + off() + (size_t)(wid * 32) * DI; }
    __device__ __forceinline__ void stage_extra(const AttCtx& C, LAS unsigned char* zl, int wid, int lane) const { att::dma_rows64(C.Zb + off() + (size_t)(wid * 32) * DI, DI, zl, lane); }
    __device__ __forceinline__ size_t tile_row(int ti) const { return (size_t)bl * RB + (ti < 4 ? 64 * ti : CT + 64 * (tl0 + ti - 4)); }
    __device__ __forceinline__ bool needs(int ti, int wid) const { if (ti < 4) return true; const int kt0 = 64 * (tl0 + ti - 4), qw0 = qb * 256 + 32 * wid; return kt0 <= qw0 + 31 + 128 && kt0 + 63 >= qw0 - 128; }
    __device__ __forceinline__ int skip(int, int) const { return 0; }
    template <int SK> __device__ __forceinline__ void mask(const AttCtx&, int ti, int wid, int r32, int hi, f32x16& p0, f32x16& p1) const {
        if (ti < 4) return;
        const int kt0 = 64 * (tl0 + ti - 4), qw0 = qb * 256 + 32 * wid;
        if (kt0 >= qw0 + 31 - 128 && kt0 + 63 <= qw0 + 128) return;
        const int qt = qw0 + r32;
#pragma unroll
        for (int r = 0; r < 16; ++r) { const int kt = kt0 + crow(r, hi); int d0 = kt - qt; d0 = d0 < 0 ? -d0 : d0; int d1 = kt + 32 - qt; d1 = d1 < 0 ? -d1 : d1;
            if (d0 > 128) p0[r] = -INFINITY; if (d1 > 128) p1[r] = -INFINITY; }
    }
    __device__ __forceinline__ void finish(const AttCtx& C, f32x16 (&o)[2], float m, float l, int wid, int r32, int hi, LAS const unsigned char* zl) const {
        const float mn = fmaxf(m, sinkl2), alpha = ex2(m - mn);
        const float lt = (l + __shfl_xor(l, 32)) * alpha + ex2(sinkl2 - mn);
        const float inv = alpha / lt;
        if (!C.dry) store_gated_l(o, inv, zl, (bf16*)C.QG + off() + (size_t)(wid * 32 + r32) * DI, r32, hi);
    }
};
__device__ __forceinline__ void swa_phase(Frame& F, const Args& a, int g, int dry) {
    int lane_ = pg8::hw_lane(), wave_ = F.wave; asm volatile("" : "+v"(lane_), "+s"(wave_));
    AttCtx C; C.QG = (const bf16*)(a.ws + WS_QG) + (size_t)g * MH * DI; C.Kb = (const bf16*)(a.ws + WS_S2); C.Vb = C.Kb + (size_t)MH * 256; C.Zb = (const bf16*)(a.ws + WS_S4); C.aux = a.in[30]; C.tab = nullptr; C.dry = dry;
    const int G = F.G, vcu = F.vcu;
    auto gen = [&](int i, SwaPol& P) -> bool {
        const int id = i * G + vcu; if (id >= HB * 32 * 8) return false;
        P.qb = (id + i) & 7; P.hq = (id >> 3) & 31; P.bl = id >> 8;
        P.tl0 = max(0, 4 * P.qb - 2); P.ntl = min(31, 4 * P.qb + 5) - P.tl0 + 1; P.sinkl2 = C.aux[P.hq] * LOG2E;
        return true; };
    att::run_stream1<SwaPol, 0>(F.lds, C, gen, wave_, lane_);
}

constexpr int NA_TAB_OFF = RING_BYTES + 512;
struct NaPol {
    static constexpr int EXTRA = 5, NM = 2;
    int bl, hq, qb, krow0, ntl, isctx;
    __device__ __forceinline__ size_t off() const { return ((size_t)bl * RB + (isctx ? 0 : CT + qb * 256)) * DI + hq * 64; }
    __device__ __forceinline__ Src src(const AttCtx& C) const { Src s; s.K[0] = C.Kb + hq * 64; s.K[1] = nullptr; s.V = C.Vb + hq * 64; s.ldk = DI; s.ldv = DI; return s; }
    __device__ __forceinline__ void prep(int ti, int wid, int r32, int hi, f32x16 (&negm)[2]) const {
        if (ti != 4) return;
        const int gc = 32 * (wid & 1) + r32, cs = min(max(gc - 8, 0), 48);
#pragma unroll
        for (int r = 0; r < 16; ++r) { const int kc = crow(r, hi);
            if (!(kc >= cs && kc < cs + 16)) negm[0][r] = -INFINITY;
            if (!(kc + 32 >= cs && kc + 32 < cs + 16)) negm[1][r] = -INFINITY; }
    }
    __device__ __forceinline__ int ntiles() const { return 4 + ntl; }
    __device__ __forceinline__ const bf16* qrow(const AttCtx& C, int wid) const { return C.QG + off() + (size_t)(wid * 32) * DI; }
    __device__ __forceinline__ void stage_extra(const AttCtx& C, LAS unsigned char* zl, int wid, int lane) const {
        att::dma_rows64(C.Zb + off() + (size_t)(wid * 32) * DI, DI, zl, lane);
        att::glds4s(C.aux + hq * 465, (unsigned)min(wid * 64 + lane, 464) * 4u, (unsigned)__builtin_amdgcn_readfirstlane((unsigned)(size_t)C.tab + wid * 256));
    }
    __device__ __forceinline__ size_t tile_row(int ti) const { return (size_t)bl * RB + (ti < 4 ? 64 * ti : CT + 64 * (krow0 + ti - 4)); }
    __device__ __forceinline__ bool needs(int ti, int wid) const { if (ti < 4) return true; const int gr = 4 * qb + (wid >> 1), rs = min(max(gr - 4, 0), 24), kr = krow0 + ti - 4; return kr >= rs && kr < rs + 8; }
    __device__ __forceinline__ int skip(int ti, int wid) const { return ti < 4 ? 0 : 1 + (wid & 1); }
    template <int SK> __device__ __forceinline__ void mask(const AttCtx& C, int ti, int wid, int r32, int hi, f32x16& p0, f32x16& p1) const {
        if (ti < 4) return;
        const int gr = 4 * qb + (wid >> 1), gc = 32 * (wid & 1) + r32, kr = krow0 + ti - 4;
        LAS const float* trow = C.tab + (kr - gr + 7) * 31 + 15 - gc;
#pragma unroll
        for (int r = 0; r < 16; ++r) { const int kc = crow(r, hi);
            if (att::sm_live0<SK>(r)) p0[r] = fmaf(trow[kc], LOG2E, p0[r]);
            if (att::sm_live1<SK>(r)) p1[r] = fmaf(trow[kc + 32], LOG2E, p1[r]);
            if ((r & 3) == 3) __builtin_amdgcn_sched_barrier(0); }
    }
    __device__ __forceinline__ void finish(const AttCtx& C, f32x16 (&o)[2], float m, float l, int wid, int r32, int hi, LAS const unsigned char* zl) const {
        const float inv = 1.f / (l + __shfl_xor(l, 32));
        if (!C.dry) store_gated_l(o, inv, zl, (bf16*)C.QG + off() + (size_t)(wid * 32 + r32) * DI, r32, hi);
    }
};
__device__ __forceinline__ void na_phase(Frame& F, const Args& a, int g, int dry) {
    int lane_ = pg8::hw_lane(), wave_ = F.wave; asm volatile("" : "+v"(lane_), "+s"(wave_));
    AttCtx C; C.QG = (const bf16*)(a.ws + WS_QG) + (size_t)g * MH * DI; C.Kb = (const bf16*)(a.ws + WS_S2); C.Vb = (const bf16*)(a.ws + WS_S3); C.Zb = (const bf16*)(a.ws + WS_S4); C.aux = a.in[27]; C.tab = (LAS const float*)(F.lds + NA_TAB_OFF); C.dry = dry;
    constexpr int NLAT = HB * 32 * 8, NCTX = HB * 32;
    const int G = F.G, vcu = F.vcu;
    auto gen = [&](int i, NaPol& P) -> bool {
        const int id = i * G + vcu; if (id >= NLAT + NCTX) return false;
        if (id < NLAT) { P.isctx = 0; P.qb = (id + i) & 7; P.hq = (id >> 3) & 31; P.bl = id >> 8; P.krow0 = min(max(4 * P.qb - 4, 0), 24); P.ntl = min(max(4 * P.qb + 3 - 4, 0), 24) + 7 - P.krow0 + 1; }
        else { const int j = id - NLAT; P.isctx = 1; P.qb = 0; P.hq = j & 31; P.bl = j >> 5; P.krow0 = 0; P.ntl = 0; }
        return true; };
    if (wave_ & 1) att::run_stream1<NaPol, 2>(F.lds, C, gen, wave_, lane_); else att::run_stream1<NaPol, 1>(F.lds, C, gen, wave_, lane_);
}

template <int COMP>
__device__ __forceinline__ void diff_unit(LAS unsigned char* lds, const Src& src, const bf16* Q  , const bf16* zb, bf16* gb, size_t trow0, int nt, float lam, float lam_init, const float* sg, int wid, int lane, int dry) {
    const int r32 = lane & 31, hi = lane >> 5, wq = wid & 3; constexpr int comp = COMP;
    constexpr int STG = 32768;
    att::dma_issue<128, 2>(src, trow0, lds, wid, lane);
    if (nt > 1) att::dma_issue<128, 2>(src, trow0 + 64, lds + STG, wid, lane);
    bf16x8 qf[4];
    { const bf16* qp = Q + (size_t)(wq * 32 + r32) * DI + comp * 64 + hi * 8;
#pragma unroll
      for (int d0 = 0; d0 < 4; ++d0) qf[d0] = *(const bf16x8*)(qp + d0 * 16); }
    f32x16 o[4];
#pragma unroll
    for (int d0 = 0; d0 < 4; ++d0) o[d0] = f32x16{};
    float m = -INFINITY, l = 0.f; f32x16 negm[1] = {f32x16{}};
    u32x4 pw[4], pwn[4];
    asm volatile("" : "+v"(qf[0]), "+v"(qf[1]), "+v"(qf[2]), "+v"(qf[3]));
    ATT_WAIT_BAR(0);
    if constexpr (COMP == 0) {
        int ic = 0;
        for (int ti = 0; ti < nt; ++ti) {
            LAS unsigned char* cur = lds + ic * STG; LAS unsigned char* prv = lds + ((ic + 3) & 3) * STG;
            if (ti >= 1 && ti + 1 < nt) att::dma_issue<128, 2>(src, trow0 + 64 * (ti + 1), lds + ((ic + 1) & 3) * STG, wid, lane);
            { f32x16 p0, p1; att::qk_tile(cur, qf, r32, hi, p0, p1, negm[0], negm[0]);
              if (ti > 0) att::pv_sm_tile<128, 1>(prv + 16384, lane, hi, pw, o, p0, p1, m, l, pwn, negm); else att::sm_alone<128, 1>(p0, p1, o, m, l, pwn, negm); }
#pragma unroll
            for (int k = 0; k < 4; ++k) pw[k] = pwn[k];
            ATT_WAIT_BAR(0);
            ic = (ic + 1) & 3;
        }
        att::pv_tile<128>(lds + ((ic + 3) & 3) * STG + 16384, lane, hi, pw, o);
    } else {
        f32x16 p0, p1;
        att::qk_tile(lds + 8192, qf, r32, hi, p0, p1, negm[0], negm[0]);
        ATT_WAIT_BAR(0);
        int ic = 1;
        for (int ti = 1; ti < nt; ++ti) {
            LAS unsigned char* cur = lds + ic * STG; LAS unsigned char* pv2 = lds + ((ic + 2) & 3) * STG;
            if (ti + 1 < nt) att::dma_issue<128, 2>(src, trow0 + 64 * (ti + 1), lds + ((ic + 1) & 3) * STG, wid, lane);
            if (ti >= 2) att::pv_sm_tile<128, 1>(pv2 + 16384, lane, hi, pw, o, p0, p1, m, l, pwn, negm); else att::sm_alone<128, 1>(p0, p1, o, m, l, pwn, negm);
#pragma unroll
            for (int k = 0; k < 4; ++k) pw[k] = pwn[k];
            att::qk_tile(cur + 8192, qf, r32, hi, p0, p1, negm[0], negm[0]);
            ATT_WAIT_BAR(0);
            ic = (ic + 1) & 3;
        }
        if (nt >= 2) att::pv_sm_tile<128, 1>(lds + ((ic + 2) & 3) * STG + 16384, lane, hi, pw, o, p0, p1, m, l, pwn, negm); else att::sm_alone<128, 1>(p0, p1, o, m, l, pwn, negm);
#pragma unroll
        for (int k = 0; k < 4; ++k) pw[k] = pwn[k];
        att::pv_tile<128>(lds + ((ic + 3) & 3) * STG + 16384, lane, hi, pw, o);
    }
    ATT_WAIT_BAR(0);
    const float inv = 1.f / (l + __shfl_xor(l, 32));
    LAS float* xb = (LAS float*)lds;
    if (comp == 1) {
#pragma unroll
        for (int d0 = 0; d0 < 4; ++d0)
#pragma unroll
            for (int r = 0; r < 16; ++r) xb[((wq * 64 + d0 * 16 + r) * 64) + lane] = o[d0][r] * inv;
    }
    __syncthreads();
    if (comp == 0 && !dry) {
        float ss = 0.f;
#pragma unroll
        for (int d0 = 0; d0 < 4; ++d0)
#pragma unroll
            for (int r = 0; r < 16; ++r) { const float v = o[d0][r] * inv - lam * xb[((wq * 64 + d0 * 16 + r) * 64) + lane]; o[d0][r] = v; ss += v * v; }
        ss += __shfl_xor(ss, 32);
        const float rs = rsqrtf(ss * (1.f / 128.f) + EPS) * (1.f - lam_init);
        const size_t ro = (size_t)(wq * 32 + r32) * DI;
#pragma unroll
        for (int d0 = 0; d0 < 4; ++d0)
#pragma unroll
            for (int i = 0; i < 4; ++i) { const int d = 32 * d0 + 8 * i + 4 * hi; const f32x4 gg = *(const f32x4*)(sg + d); const u32x2 zw = *(const u32x2*)(zb + ro + d);
                const float v0 = o[d0][4 * i] * rs * gg.x * silu(bflo(zw.x)), v1 = o[d0][4 * i + 1] * rs * gg.y * silu(bfhi(zw.x)), v2 = o[d0][4 * i + 2] * rs * gg.z * silu(bflo(zw.y)), v3 = o[d0][4 * i + 3] * rs * gg.w * silu(bfhi(zw.y));
                u32x2 w; w.x = att::cvtpk(v0, v1); w.y = att::cvtpk(v2, v3); *(u32x2*)(gb + ro + d) = w; }
    }
    asm volatile("s_waitcnt lgkmcnt(0)\n\ts_barrier" ::: "memory");
}
__device__ __forceinline__ void diff_phase(Frame& F, const Args& a, int g, int dry) {
#ifdef MK_TOUCH2
    {
        const int j = F.vcu & 31; unsigned accv = 0u;
        for (size_t off = ((size_t)j * NTHR + F.wave * 64 + pg8::hw_lane()) * 4096; off < (size_t)216 * MiB; off += (size_t)32 * NTHR * 4096) accv += *(const unsigned*)(a.ws + WS_S2 + off);
        for (size_t off = ((size_t)j * NTHR + F.wave * 64 + pg8::hw_lane()) * 4096; off < (size_t)72 * MiB; off += (size_t)32 * NTHR * 4096) accv += *(const unsigned*)(a.ws + WS_QG + (size_t)g * MH * DI * 2 + off);
        asm volatile("" :: "v"(accv));
    }
#endif
    int lane_ = pg8::hw_lane(), wave_ = F.wave; asm volatile("" : "+v"(lane_), "+s"(wave_));
    const bf16* QG = (const bf16*)(a.ws + WS_QG) + (size_t)g * MH * DI; const bf16* Kb = (const bf16*)(a.ws + WS_S2); const bf16* Vb = (const bf16*)(a.ws + WS_S3); const bf16* Zb = (const bf16*)(a.ws + WS_S4);
    const float lam_init = 0.8f - 0.6f * expf(-0.3f);
    float sa = 0.f, sb = 0.f;
    for (int i = 0; i < 64; ++i) { sa += a.in[20][i] * a.in[21][i]; sb += a.in[22][i] * a.in[23][i]; }
    const float lam = expf(sa) - expf(sb) + lam_init;
    constexpr int NLAT = HB * 16 * 16, NCTX = HB * 16 * 2;
    const int G = F.G, vcu = F.vcu; LAS unsigned char* lds = F.lds; const float* sg = a.in[24];
    auto units = [&](auto cc) {
        constexpr int COMP = decltype(cc)::value;
        for (int i = 0;; ++i) {
            const int id = i * G + vcu; if (id >= NLAT + NCTX) break;
            int bl, h, qb, nt; size_t row0;
            if (id < NLAT) { qb = id & 15; h = (id >> 4) & 15; bl = id >> 8; nt = RB / 64; row0 = (size_t)bl * RB + CT + qb * 128; }
            else { const int j = id - NLAT; qb = j & 1; h = (j >> 1) & 15; bl = j >> 5; nt = CT / 64; row0 = (size_t)bl * RB + qb * 128; }
            Src s; s.K[0] = Kb + (2 * h) * 64; s.K[1] = Kb + (2 * h + 1) * 64; s.V = Vb + h * 128; s.ldk = DI; s.ldv = DI;
            diff_unit<COMP>(lds, s, QG + row0 * DI + h * 128, Zb + row0 * DI + h * 128, (bf16*)QG + row0 * DI + h * 128, (size_t)bl * RB, nt, lam, lam_init, sg, wave_, lane_, dry);
        }
    };
    if (wave_ >> 2) units(std::integral_constant<int, 1>{}); else units(std::integral_constant<int, 0>{});
}
}
namespace mk {
typedef float f32x4v __attribute__((ext_vector_type(4)));
__device__ __forceinline__ void seq_bounds(int row, int& lo, int& hi) { const int rr = row % RB, b0 = row - rr; if (rr < CT) { lo = b0; hi = b0 + CT; } else { lo = b0 + CT; hi = b0 + RB; } }

#ifndef MK_GATES_Q
#define MK_GATES_Q 4
#endif
__device__ __forceinline__ void mlstm_gates_phase(Frame& F, const Args& a, int g) {
    int lane = pg8::hw_lane(), wave = F.wave; asm volatile("" : "+v"(lane), "+s"(wave));
    const bf16* XM = (const bf16*)(a.ws + WS_S2); const bf16* W2 = (const bf16*)(a.ws + WS_WG2);
    bf16* XC = g == 0 ? (bf16*)(a.ws + WS_QG) + (size_t)MH * DI : (bf16*)(a.ws + WS_H);
    const float* cw = a.in[9]; const float* cb = a.in[10]; const float* bg = a.in[15];
    LAS float* T = (LAS float*)F.lds;
    constexpr int G_W2S = 12288, G_XS = G_W2S + 64 * 1040;
    const int khw = (int)blockIdx.x & 3;
    { const int tid = wave * 64 + lane;
      for (int i = tid; i < 5 * 128; i += NTHR) { const int j = i >> 7, c4 = (i & 127) * 4; *(LAS f32x4v*)(T + j * 512 + c4) = *(const f32x4v*)(cw + j * 2048 + khw * 512 + c4); }
      for (int i = tid; i < 128; i += NTHR) *(LAS f32x4v*)(T + 2560 + 4 * i) = *(const f32x4v*)(cb + khw * 512 + 4 * i);
      for (int i = tid; i < 64 * 64; i += NTHR) { const int rw = i >> 6, c8 = (i & 63) * 8;
          *(LAS u32x4*)(F.lds + G_W2S + (rw * 520 + c8) * 2) = *(const u32x4*)(W2 + (size_t)(rw >> 1) * 4096 + (rw & 1) * 2048 + khw * 512 + c8); }
      __syncthreads(); }
    const int r = lane & 15, kq = lane >> 4;
    LAS unsigned char* xs = F.lds + G_XS + wave * 5440;
    const int kh = khw;
    float* gates = (float*)(a.ws + (kh == 0 ? WS_GATES : kh == 1 ? WS_GATES2 : kh == 2 ? WS_GATES3 : WS_GATES4));
    for (int grp = ((int)blockIdx.x >> 2) + 64 * wave; grp < MH / 16; grp += 64 * NWAVES) {
        const int row0 = grp * 16, row = row0 + r; int lo, hi; seq_bounds(row0, lo, hi);
        pg8::f32x4 acc0 = {0.f, 0.f, 0.f, 0.f}, acc1 = {0.f, 0.f, 0.f, 0.f};
        u32x4 xg[5];
#define ML_GLOAD(sb_) do { _Pragma("unroll") for (int j = 0; j < 5; ++j) { const int sr = row0 - 2 + 4 * j + (lane >> 4); \
            xg[j] = (sr >= lo && sr < hi) ? *(const u32x4*)(XM + (size_t)sr * DI + kh * 512 + (sb_) * 128 + (lane & 15) * 8) : (u32x4){0u, 0u, 0u, 0u}; } } while (0)
        ML_GLOAD(0);
        for (int sb = 0; sb < 4; ++sb) {
#pragma unroll
            for (int j = 0; j < 5; ++j) *(LAS u32x4*)(xs + (4 * j + (lane >> 4)) * 272 + (lane & 15) * 16) = xg[j];
            if (sb + 1 < 4) ML_GLOAD(sb + 1);
#pragma unroll
            for (int q = 0; q < 4; ++q) { const int cl = sb * 128 + q * 32 + 8 * kq, c0 = kh * 512 + cl;
                LAS const unsigned char* wl = F.lds + G_W2S + cl * 2; LAS const unsigned char* xl = xs + r * 272 + (q * 32 + 8 * kq) * 2;
                const bf16x8 wf0 = *(LAS const bf16x8*)(wl + (2 * r) * 1040), wf1 = *(LAS const bf16x8*)(wl + (2 * (r + 16)) * 1040), wf2 = *(LAS const bf16x8*)(wl + (2 * r + 1) * 1040), wf3 = *(LAS const bf16x8*)(wl + (2 * (r + 16) + 1) * 1040);
                const f32x4v b0 = *(LAS const f32x4v*)(T + 2560 + cl), b1 = *(LAS const f32x4v*)(T + 2560 + cl + 4);
                float av[8] = {b0.x, b0.y, b0.z, b0.w, b1.x, b1.y, b1.z, b1.w};
                u32x4 xmid;
#pragma unroll
                for (int j = 0; j < 5; ++j) { const u32x4 x = *(LAS const u32x4*)(xl + j * 272); if (j == 2) xmid = x;
                    const f32x4v w0 = *(LAS const f32x4v*)(T + j * 512 + cl), w1 = *(LAS const f32x4v*)(T + j * 512 + cl + 4);
                    av[0] += bflo(x.x) * w0.x; av[1] += bfhi(x.x) * w0.y; av[2] += bflo(x.y) * w0.z; av[3] += bfhi(x.y) * w0.w;
                    av[4] += bflo(x.z) * w1.x; av[5] += bfhi(x.z) * w1.y; av[6] += bflo(x.w) * w1.z; av[7] += bfhi(x.w) * w1.w; }
                u32x4 xcw; xcw.x = att::cvtpk(silu(av[0]), silu(av[1])); xcw.y = att::cvtpk(silu(av[2]), silu(av[3])); xcw.z = att::cvtpk(silu(av[4]), silu(av[5])); xcw.w = att::cvtpk(silu(av[6]), silu(av[7]));
                *(u32x4*)(XC + (size_t)row * DI + c0) = xcw;
                const bf16x8 axc = __builtin_bit_cast(bf16x8, xcw), axm = __builtin_bit_cast(bf16x8, xmid);
                acc0 = __builtin_amdgcn_mfma_f32_16x16x32_bf16(axc, wf0, acc0, 0, 0, 0); acc1 = __builtin_amdgcn_mfma_f32_16x16x32_bf16(axc, wf1, acc1, 0, 0, 0);
                acc0 = __builtin_amdgcn_mfma_f32_16x16x32_bf16(axm, wf2, acc0, 0, 0, 0); acc1 = __builtin_amdgcn_mfma_f32_16x16x32_bf16(axm, wf3, acc1, 0, 0, 0); }
            asm volatile("s_waitcnt lgkmcnt(0)" ::: "memory");
        }
#undef ML_GLOAD
        const float bg0 = kh == 0 ? bg[r] : 0.f, bg1 = kh == 0 ? bg[16 + r] : 0.f;
#pragma unroll
        for (int rg = 0; rg < 4; ++rg) { const size_t tk = (size_t)grp * 16 + 4 * kq + rg; gates[tk * 32 + r] = acc0[rg] + bg0; gates[tk * 32 + 16 + r] = acc1[rg] + bg1; }
    }
    __syncthreads();
}

#define ML_BAR() asm volatile("s_waitcnt lgkmcnt(0)\n\ts_barrier" ::: "memory")
#ifndef MK_SC_A
#define MK_SC_A 1
#endif
#ifndef MK_SC_B
#define MK_SC_B 1
#endif
constexpr int ML_QS = 0, ML_KS = 33792, ML_VS = 67584, ML_P = 84992, ML_HO = 94208, ML_F = 110592;
constexpr int ML_W1 = RING_BYTES + 512  , ML_WV = 115200  ;
constexpr int ML_KSTR = 528, ML_VSTR = 272, ML_PSTR = 144;
__device__ __forceinline__ int ml_row(int base, int dir, int s) { return base + (dir == 0 ? s : (s < CT ? CT - 1 - s : CT + (S - 1) - (s - CT))); }
__device__ __forceinline__ s16x4 ml_tr(LAS const unsigned char* p) { return __builtin_bit_cast(s16x4, __builtin_amdgcn_ds_read_tr16_b64_v4i16((LAS att::v4i16_t*)p)); }
__device__ __forceinline__ void mlstm_scan_phase(Frame& F, const Args& a, int g) {
    int tid0 = F.wave * 64 + pg8::hw_lane(); asm volatile("" : "+v"(tid0));
    const int wid = __builtin_amdgcn_readfirstlane(tid0 >> 6);
    const int u = F.vcu; if (u >= HB * 8 * 2 * 2) return;
    const int dvh = u & 1, dir = (u >> 1) & 1, h = (u >> 2) & 7, bl = u >> 5;
    const bf16* XM = (const bf16*)(a.ws + WS_S2); const float* gates = (const float*)(a.ws + WS_GATES); const float* gates2 = (const float*)(a.ws + WS_GATES2); const float* gates3 = (const float*)(a.ws + WS_GATES3); const float* gates4 = (const float*)(a.ws + WS_GATES4);
    const bf16* XC = g == 0 ? (const bf16*)(a.ws + WS_QG) + (size_t)MH * DI : (const bf16*)(a.ws + WS_H);
    bf16* Hd = dir == 0 ? (bf16*)(a.ws + WS_QG) + (size_t)g * MH * DI : (bf16*)(a.ws + WS_S4);
    const float* cw = a.in[9]; const float* cb = a.in[10]; const float* wq = a.in[11]; const float* wk = a.in[12]; const float* wv = a.in[13];
    LAS unsigned char* L = F.lds; LAS float* Ff = (LAS float*)(L + ML_F);
    pg8::f32x4 C[16];
#pragma unroll
    for (int i = 0; i < 16; ++i) C[i] = (pg8::f32x4){0.f, 0.f, 0.f, 0.f};
    int tid = tid0;
    if (tid < 256) { Ff[640 + tid] = 0.f; }
    {
        LAS float* W1 = (LAS float*)(L + ML_W1); LAS float* WV = (LAS float*)(L + ML_WV);
        for (int i = tid; i < 5 * 256; i += NTHR) W1[i] = cw[(i >> 8) * DI + h * 256 + (i & 255)];
        if (tid < 256) W1[1280 + tid] = cb[h * 256 + tid];
        for (int i = tid; i < 1024; i += NTHR) { W1[1536 + i] = wq[h * 1024 + i]; W1[2560 + i] = wk[h * 1024 + i]; WV[i] = wv[h * 1024 + i]; }
        __syncthreads();
    }
    LAS const float* W1 = (LAS const float*)(L + ML_W1); LAS const float* WV = (LAS const float*)(L + ML_WV);
    bf16x8 aq[2], ak[2], av_[2], aql[2], akl[2], avl[2];
    { const int o = tid0 & 15, g4 = (tid0 >> 4) & 3;
#pragma unroll
      for (int n = 0; n < 2; ++n) { const int bo = 4 * n + (o >> 2); u32x4 fq, fk, fv, lq, lk, lv; unsigned* pq = (unsigned*)&fq; unsigned* pk_ = (unsigned*)&fk; unsigned* pv_ = (unsigned*)&fv; unsigned* qq_ = (unsigned*)&lq; unsigned* qk_ = (unsigned*)&lk; unsigned* qv_ = (unsigned*)&lv;
#pragma unroll
          for (int jp = 0; jp < 4; ++jp) { float q2[2], k2[2], v2[2], q2l[2], k2l[2], v2l[2];
#pragma unroll
              for (int e = 0; e < 2; ++e) { const int j = 2 * jp + e, bi = 2 * g4 + (j >> 2); const bool nz = bi == bo; const int gb = wid * 8 + bo, idx = gb * 16 + (j & 3) * 4 + (o & 3);
                  q2[e] = nz ? W1[1536 + idx] : 0.f; k2[e] = nz ? W1[2560 + idx] * 0.0625f : 0.f; v2[e] = nz ? WV[idx] : 0.f;
                  q2l[e] = q2[e] - bf2f((unsigned short)f2bf(q2[e])); k2l[e] = k2[e] - bf2f((unsigned short)f2bf(k2[e])); v2l[e] = v2[e] - bf2f((unsigned short)f2bf(v2[e])); }
              pq[jp] = pk2(q2[0], q2[1]); pk_[jp] = pk2(k2[0], k2[1]); pv_[jp] = pk2(v2[0], v2[1]);
              qq_[jp] = pk2(q2l[0], q2l[1]); qk_[jp] = pk2(k2l[0], k2l[1]); qv_[jp] = pk2(v2l[0], v2l[1]); }
          aq[n] = __builtin_bit_cast(bf16x8, fq); ak[n] = __builtin_bit_cast(bf16x8, fk); av_[n] = __builtin_bit_cast(bf16x8, fv);
          aql[n] = __builtin_bit_cast(bf16x8, lq); akl[n] = __builtin_bit_cast(bf16x8, lk); avl[n] = __builtin_bit_cast(bf16x8, lv); } }
    const int base = bl * RB;
    u32x4 xw[8];
#define ML_LOADX(cc) do { const int rlo_ = dir ? ml_row(base, 1, (cc) * 64 + 63) : ml_row(base, 0, (cc) * 64); \
        const size_t o_ = (size_t)(rlo_ + (tid0 & 15)) * DI + h * 256 + wid * 32 + ((tid0 >> 4) & 3) * 8; \
        _Pragma("unroll") for (int i_ = 0; i_ < 4; ++i_) { xw[i_] = *(const u32x4*)(XM + o_ + (size_t)(16 * i_) * DI); xw[4 + i_] = *(const u32x4*)(XC + o_ + (size_t)(16 * i_) * DI); } } while (0)
    const int gwave = dvh == 0 ? 4 : 0;
    float gpre[8] = {0.f, 0.f, 0.f, 0.f, 0.f, 0.f, 0.f, 0.f};
#define ML_LOADG(cc) do { if (wid == gwave) { const size_t gi_ = (size_t)ml_row(base, dir, (cc) * 64 + (tid0 & 63)) * 32 + (2 * dir) * 8 + h; \
        gpre[0] = gates[gi_]; gpre[1] = gates2[gi_]; gpre[2] = gates3[gi_]; gpre[3] = gates4[gi_]; gpre[4] = gates[gi_ + 8]; gpre[5] = gates2[gi_ + 8]; gpre[6] = gates3[gi_ + 8]; gpre[7] = gates4[gi_ + 8]; } } while (0)
    ML_LOADX(0); ML_LOADG(0);
    for (int c = 0; c < RB / 64; ++c) {
        const int par = c & 1;
        tid = tid0; asm volatile("" : "+v"(tid));
        const int lane = tid & 63, l15 = lane & 15, gq = lane >> 4;
#pragma unroll 1
        for (int repA_ = 0; repA_ < MK_SC_A; ++repA_) {
        {
            const bool hasv = (wid >> 2) == dvh;
            const pg8::f32x4 z4 = {0.f, 0.f, 0.f, 0.f};
#pragma unroll
            for (int tt = 0; tt < 4; ++tt) {
                const bf16x8 bxm = __builtin_bit_cast(bf16x8, xw[tt]), bxc = __builtin_bit_cast(bf16x8, xw[4 + tt]);
                const int mrow = 16 * tt + l15, t = dir ? 63 - mrow : mrow;
#pragma unroll
                for (int n = 0; n < 2; ++n) {
                    const pg8::f32x4 dq = __builtin_amdgcn_mfma_f32_16x16x32_bf16(aq[n], bxc, __builtin_amdgcn_mfma_f32_16x16x32_bf16(aql[n], bxc, z4, 0, 0, 0), 0, 0, 0), dk = __builtin_amdgcn_mfma_f32_16x16x32_bf16(ak[n], bxc, __builtin_amdgcn_mfma_f32_16x16x32_bf16(akl[n], bxc, z4, 0, 0, 0), 0, 0, 0);
                    const int cl = wid * 32 + 16 * n + 4 * gq;
                    u32x2 w2; w2.x = att::cvtpk(dq[0], dq[1]); w2.y = att::cvtpk(dq[2], dq[3]); *(LAS u32x2*)(L + ML_QS + t * ML_KSTR + cl * 2) = w2;
                    w2.x = att::cvtpk(dk[0], dk[1]); w2.y = att::cvtpk(dk[2], dk[3]); *(LAS u32x2*)(L + ML_KS + t * ML_KSTR + cl * 2) = w2;
                    if (hasv) { const pg8::f32x4 dv = __builtin_amdgcn_mfma_f32_16x16x32_bf16(av_[n], bxm, __builtin_amdgcn_mfma_f32_16x16x32_bf16(avl[n], bxm, z4, 0, 0, 0), 0, 0, 0);
                        w2.x = att::cvtpk(dv[0], dv[1]); w2.y = att::cvtpk(dv[2], dv[3]); *(LAS u32x2*)(L + ML_VS + t * ML_VSTR + (cl & 127) * 2) = w2; }
                }
            }
        }
#if defined(MK_SC_G2)
        for (int repg_ = 0; repg_ < 2; ++repg_)
#endif
        if (wid == gwave) {
            const float gi = (gpre[0] + gpre[1]) + (gpre[2] + gpre[3]), gf = (gpre[4] + gpre[5]) + (gpre[6] + gpre[7]);
            const float lf = fminf(gf, 0.f) - log1pf(__expf(-fabsf(gf)));
            float b = lf;
#define ML_DPP(x, ctrl, rmask) __uint_as_float((unsigned)__builtin_amdgcn_update_dpp(0, (int)__float_as_uint(x), ctrl, rmask, 0xf, true))
            b += ML_DPP(b, 0x111, 0xf); b += ML_DPP(b, 0x112, 0xf); b += ML_DPP(b, 0x114, 0xf); b += ML_DPP(b, 0x118, 0xf);
            b += ML_DPP(b, 0x142, 0xa);
            b += ML_DPP(b, 0x143, 0xc);
#undef ML_DPP
            const float bend = __shfl(b, 63);
            Ff[lane] = b * LOG2E; Ff[64 + lane] = (gi - b) * LOG2E; Ff[128 + lane] = __expf(b); Ff[192 + lane] = __expf(bend - b + gi);
            if (lane == 0) Ff[576] = __expf(bend);
        }
        }
        ML_BAR();
#if defined(MK_SC_L2)
        if (c + 1 < RB / 64) { ML_LOADX(c + 1); ML_LOADG(c + 1); asm volatile("" : "+v"(xw[0]), "+v"(xw[1]), "+v"(xw[2]), "+v"(xw[3]), "+v"(xw[4]), "+v"(xw[5]), "+v"(xw[6]), "+v"(xw[7])); }
#endif
        if (c + 1 < RB / 64) { ML_LOADX(c + 1); ML_LOADG(c + 1); }
        for (int repB_ = 0; repB_ < MK_SC_B; ++repB_) {
        {
            const int si = wid >> 1;
            pg8::f32x4 st[2] = {{0.f, 0.f, 0.f, 0.f}, {0.f, 0.f, 0.f, 0.f}};
            LAS const unsigned char* kp = L + ML_KS + (16 * si + l15) * ML_KSTR + gq * 16;
            LAS const unsigned char* qp0 = L + ML_QS + (16 * (2 * (wid & 1)) + l15) * ML_KSTR + gq * 16;
#pragma unroll
            for (int ks = 0; ks < 8; ++ks) {
                const bf16x8 ka = *(LAS const bf16x8*)(kp + ks * 64);
                const bf16x8 q0 = *(LAS const bf16x8*)(qp0 + ks * 64), q1 = *(LAS const bf16x8*)(qp0 + 16 * ML_KSTR + ks * 64);
                st[0] = __builtin_amdgcn_mfma_f32_16x16x32_bf16(ka, q0, st[0], 0, 0, 0);
                st[1] = __builtin_amdgcn_mfma_f32_16x16x32_bf16(ka, q1, st[1], 0, 0, 0);
            }
            const f32x4v al = *(LAS const f32x4v*)(Ff + 64 + 16 * si + 4 * gq);
            const float alv[4] = {al.x, al.y, al.z, al.w};
#pragma unroll
            for (int e = 0; e < 2; ++e) {
                const int ti = 2 * (wid & 1) + e, t = 16 * ti + l15; const float bt = Ff[t];
                float pv[4], rsum = 0.f;
#pragma unroll
                for (int r = 0; r < 4; ++r) { const int s = 16 * si + 4 * gq + r; const float wgt = (s <= t) ? att::ex2(bt + alv[r]) : 0.f; pv[r] = st[e][r] * wgt; rsum += pv[r]; }
                u32x2 w2; w2.x = att::cvtpk(pv[0], pv[1]); w2.y = att::cvtpk(pv[2], pv[3]);
                *(LAS u32x2*)(L + ML_P + t * ML_PSTR + (16 * si + 4 * gq) * 2) = w2;
                rsum += __shfl_xor(rsum, 16); rsum += __shfl_xor(rsum, 32);
                if (gq == 0) Ff[320 + si * 64 + t] = rsum;
            }
        }
        {
            const int t = tid >> 3, part = tid & 7; LAS const float* np_ = Ff + 640 + par * 256 + part * 32; LAS const unsigned char* qrow = L + ML_QS + t * ML_KSTR + part * 64;
            float acc = 0.f;
#pragma unroll
            for (int i = 0; i < 4; ++i) { const u32x4 qw = *(LAS const u32x4*)(qrow + i * 16); const f32x4v n0 = *(LAS const f32x4v*)(np_ + i * 8), n1 = *(LAS const f32x4v*)(np_ + i * 8 + 4);
                acc += bflo(qw.x) * n0.x + bfhi(qw.x) * n0.y + bflo(qw.y) * n0.z + bfhi(qw.y) * n0.w + bflo(qw.z) * n1.x + bfhi(qw.z) * n1.y + bflo(qw.w) * n1.z + bfhi(qw.w) * n1.w; }
            acc += __shfl_xor(acc, 1); acc += __shfl_xor(acc, 2); acc += __shfl_xor(acc, 4);
            if (part == 0) Ff[256 + t] = acc * Ff[128 + t];
        }
        if (tid < 256) {
            float nn = Ff[576] * Ff[640 + par * 256 + tid];
#pragma unroll
            for (int s = 0; s < 64; s += 4) { const f32x4v w4 = *(LAS const f32x4v*)(Ff + 192 + s); LAS const unsigned char* kc = L + ML_KS + s * ML_KSTR + tid * 2;
                nn += (w4.x * bf2f(*(LAS const unsigned short*)kc) + w4.y * bf2f(*(LAS const unsigned short*)(kc + ML_KSTR))) + (w4.z * bf2f(*(LAS const unsigned short*)(kc + 2 * ML_KSTR)) + w4.w * bf2f(*(LAS const unsigned short*)(kc + 3 * ML_KSTR))); }
            Ff[640 + (par ^ 1) * 256 + tid] = nn;
        }
        }
        ML_BAR();
        {
            pg8::f32x4 y[4];
#if defined(MK_SC_SYNC)
            ML_BAR(); __syncthreads(); __syncthreads();
#endif
#if defined(MK_SC_QC2)
            for (int repq_ = 0; repq_ < 2; ++repq_)
#endif
            {
#pragma unroll
            for (int tt = 0; tt < 4; ++tt) y[tt] = (pg8::f32x4){0.f, 0.f, 0.f, 0.f};
            {
                u32x2 qa[2][4], qb[2][4];
#define ML_QRD(ks_, b_) do { _Pragma("unroll") for (int tt = 0; tt < 4; ++tt) { LAS const unsigned char* qp = L + ML_QS + (16 * tt + l15) * ML_KSTR + (32 * (ks_) + 4 * gq) * 2; qa[b_][tt] = *(LAS const u32x2*)qp; qb[b_][tt] = *(LAS const u32x2*)(qp + 32); } } while (0)
                ML_QRD(0, 0);
#pragma unroll
                for (int ks = 0; ks < 8; ++ks) {
                    if (ks + 1 < 8) ML_QRD(ks + 1, (ks + 1) & 1);
                    u32x4 cw4; cw4.x = att::cvtpk(C[2 * ks][0], C[2 * ks][1]); cw4.y = att::cvtpk(C[2 * ks][2], C[2 * ks][3]); cw4.z = att::cvtpk(C[2 * ks + 1][0], C[2 * ks + 1][1]); cw4.w = att::cvtpk(C[2 * ks + 1][2], C[2 * ks + 1][3]);
                    const bf16x8 cf = __builtin_bit_cast(bf16x8, cw4);
                    __builtin_amdgcn_sched_barrier(0);
#pragma unroll
                    for (int tt = 0; tt < 4; ++tt) { const u32x4 qq = {qa[ks & 1][tt].x, qa[ks & 1][tt].y, qb[ks & 1][tt].x, qb[ks & 1][tt].y};
                        y[tt] = __builtin_amdgcn_mfma_f32_16x16x32_bf16(__builtin_bit_cast(bf16x8, qq), cf, y[tt], 0, 0, 0); }
                    __builtin_amdgcn_sched_barrier(0);
                }
#undef ML_QRD
            }
            }
#pragma unroll
            for (int tt = 0; tt < 4; ++tt) { const f32x4v e4 = *(LAS const f32x4v*)(Ff + 128 + 16 * tt + 4 * gq); y[tt][0] *= e4.x; y[tt][1] *= e4.y; y[tt][2] *= e4.z; y[tt][3] *= e4.w; }
            bf16x8 vf[2];
            { LAS const unsigned char* vb = L + ML_VS + (8 * gq + (l15 >> 2)) * ML_VSTR + (16 * wid + 4 * (lane & 3)) * 2;
#pragma unroll
              for (int k2 = 0; k2 < 2; ++k2) { const s16x4 lo = ml_tr(vb + k2 * 32 * ML_VSTR), hi4 = ml_tr(vb + k2 * 32 * ML_VSTR + 4 * ML_VSTR); vf[k2] = (bf16x8){lo[0], lo[1], lo[2], lo[3], hi4[0], hi4[1], hi4[2], hi4[3]}; } }
#pragma unroll
            for (int k2 = 0; k2 < 2; ++k2)
#pragma unroll
                for (int tt = 0; tt < 4; ++tt) { const bf16x8 pa = *(LAS const bf16x8*)(L + ML_P + (16 * tt + l15) * ML_PSTR + (32 * k2 + 8 * gq) * 2);
                    y[tt] = __builtin_amdgcn_mfma_f32_16x16x32_bf16(pa, vf[k2], y[tt], 0, 0, 0); }
#pragma unroll
            for (int tt = 0; tt < 4; ++tt)
#pragma unroll
                for (int r = 0; r < 4; ++r) { const int t = 16 * tt + 4 * gq + r;
                    *(LAS unsigned short*)(L + ML_HO + t * 256 + (16 * wid + l15) * 2) = (unsigned short)f2bf(y[tt][r]); }
            const float ebend = Ff[576];
#pragma unroll
            for (int i = 0; i < 16; ++i) C[i] = C[i] * ebend;
            bf16x8 vw[2];
#pragma unroll
            for (int k2 = 0; k2 < 2; ++k2) { const f32x4v w0 = *(LAS const f32x4v*)(Ff + 192 + 32 * k2 + 8 * gq), w1 = *(LAS const f32x4v*)(Ff + 192 + 32 * k2 + 8 * gq + 4);
                const u32x4 vv = __builtin_bit_cast(u32x4, vf[k2]); u32x4 o;
                o.x = att::cvtpk(bflo(vv.x) * w0.x, bfhi(vv.x) * w0.y); o.y = att::cvtpk(bflo(vv.y) * w0.z, bfhi(vv.y) * w0.w); o.z = att::cvtpk(bflo(vv.z) * w1.x, bfhi(vv.z) * w1.y); o.w = att::cvtpk(bflo(vv.w) * w1.z, bfhi(vv.w) * w1.w);
                vw[k2] = __builtin_bit_cast(bf16x8, o); }
            LAS const unsigned char* kb = L + ML_KS + (8 * gq + (l15 >> 2)) * ML_KSTR + (4 * (lane & 3)) * 2;
            {
                s16x4 klo[2][2], khi[2][2];
#define ML_KRD(dt_, b_) do { _Pragma("unroll") for (int k2 = 0; k2 < 2; ++k2) { klo[b_][k2] = ml_tr(kb + k2 * 32 * ML_KSTR + (dt_) * 32); khi[b_][k2] = ml_tr(kb + k2 * 32 * ML_KSTR + 4 * ML_KSTR + (dt_) * 32); } } while (0)
                ML_KRD(0, 0);
#pragma unroll
                for (int dt = 0; dt < 16; ++dt) {
                    if (dt + 1 < 16) ML_KRD(dt + 1, (dt + 1) & 1);
                    __builtin_amdgcn_sched_barrier(0);
#pragma unroll
                    for (int k2 = 0; k2 < 2; ++k2) { const s16x4 lo = klo[dt & 1][k2], hi4 = khi[dt & 1][k2];
                        const bf16x8 ka = {lo[0], lo[1], lo[2], lo[3], hi4[0], hi4[1], hi4[2], hi4[3]};
                        C[dt] = __builtin_amdgcn_mfma_f32_16x16x32_bf16(ka, vw[k2], C[dt], 0, 0, 0); }
                    __builtin_amdgcn_sched_barrier(0);
                }
#undef ML_KRD
            }
        }
        ML_BAR();
#if defined(MK_SC_W2)
        for (int repw_ = 0; repw_ < 2; ++repw_)
#endif
#pragma unroll
        for (int it = 0; it < 2; ++it) { const int idx = tid + it * NTHR, t = idx >> 4, pc = idx & 15; const int row = ml_row(base, dir, c * 64 + t);
            const float den = Ff[256 + t] + (Ff[320 + t] + Ff[384 + t]) + (Ff[448 + t] + Ff[512 + t]);
            const float rd = 1.f / fmaxf(fabsf(den), 1.f);
            const u32x4 yv = *(LAS const u32x4*)(L + ML_HO + t * 256 + pc * 16); u32x4 hv;
            hv.x = att::cvtpk(bflo(yv.x) * rd, bfhi(yv.x) * rd); hv.y = att::cvtpk(bflo(yv.y) * rd, bfhi(yv.y) * rd); hv.z = att::cvtpk(bflo(yv.z) * rd, bfhi(yv.z) * rd); hv.w = att::cvtpk(bflo(yv.w) * rd, bfhi(yv.w) * rd);
            *(u32x4*)(Hd + (size_t)row * DI + h * 256 + dvh * 128 + pc * 8) = hv; }
    }
}

__device__ __forceinline__ void mlstm_out_phase(Frame& F, const Args& a, int g, int dry) {
    int lane = pg8::hw_lane(), wave = F.wave; asm volatile("" : "+v"(lane), "+s"(wave));
    const bf16* XC = g == 0 ? (const bf16*)(a.ws + WS_QG) + (size_t)MH * DI : (const bf16*)(a.ws + WS_H); const bf16* Z = (const bf16*)(a.ws + WS_S3); const bf16* HB2 = (const bf16*)(a.ws + WS_S4); bf16* HF = (bf16*)(a.ws + WS_QG) + (size_t)g * MH * DI;
    const float* ng = a.in[16]; const float* skip = a.in[17];
    const int gw = F.vcu * NWAVES + wave, NGW = F.G * NWAVES;
    for (int it0 = gw; it0 < MH * 8; it0 += 2 * NGW) {
        u32x2 hf[2], hb[2], xcw[2], zw[2]; f32x4v gg[2], sk[2]; size_t o[2];
#pragma unroll
        for (int u = 0; u < 2; ++u) { int it = it0 + u * NGW; if (it >= MH * 8) it = it0; const int row = it >> 3, h = it & 7, ch = h * 256 + lane * 4; o[u] = (size_t)row * DI + ch;
            hf[u] = *(const u32x2*)(HF + o[u]); hb[u] = *(const u32x2*)(HB2 + o[u]); xcw[u] = *(const u32x2*)(XC + o[u]); zw[u] = *(const u32x2*)(Z + o[u]);
            gg[u] = *(const f32x4v*)(ng + ch); sk[u] = *(const f32x4v*)(skip + ch); }
#pragma unroll
        for (int u = 0; u < 2; ++u) {
            const float hs[4] = {bflo(hf[u].x) + bflo(hb[u].x), bfhi(hf[u].x) + bfhi(hb[u].x), bflo(hf[u].y) + bflo(hb[u].y), bfhi(hf[u].y) + bfhi(hb[u].y)};
            const float mu = wave_sum((hs[0] + hs[1]) + (hs[2] + hs[3])) * (1.f / 256.f);
            const float d[4] = {hs[0] - mu, hs[1] - mu, hs[2] - mu, hs[3] - mu};
            const float rstd = rsqrtf(wave_sum((d[0] * d[0] + d[1] * d[1]) + (d[2] * d[2] + d[3] * d[3])) * (1.f / 256.f) + EPS);
            const float xcv[4] = {bflo(xcw[u].x), bfhi(xcw[u].x), bflo(xcw[u].y), bfhi(xcw[u].y)}, z[4] = {bflo(zw[u].x), bfhi(zw[u].x), bflo(zw[u].y), bfhi(zw[u].y)};
            const float ggv[4] = {gg[u].x, gg[u].y, gg[u].z, gg[u].w}, skv[4] = {sk[u].x, sk[u].y, sk[u].z, sk[u].w};
            float ov[4];
#pragma unroll
            for (int i = 0; i < 4; ++i) ov[i] = (d[i] * rstd * ggv[i] + skv[i] * xcv[i]) * silu(z[i]);
            u32x2 w; w.x = att::cvtpk(ov[0], ov[1]); w.y = att::cvtpk(ov[2], ov[3]); if (!dry && (u == 0 || it0 + NGW < MH * 8)) *(u32x2*)(HF + o[u]) = w;
        }
    }
}
}
namespace mk {
enum { P_PRO = 0, P_PRO2 = 1, P_NORM0 = 2, P_L0 = 3  , P_OUT0 = 11, P_NORM1 = 12, P_L1 = 13  , P_OUT1 = 17, P_NORM2 = 18, P_L2 = 19  , P_OUT2 = 23, P_NORM3 = 24, P_L3 = 25  , P_OUT3 = 29, P_FINAL = 30, P_END = 31 };

__global__ void __launch_bounds__(NTHR, 2) mega(Args a) {
    extern __shared__ __attribute__((aligned(16))) unsigned char lds_raw[];
    Frame F;
    F.lds = (LAS unsigned char*)lds_raw;
    F.wave = __builtin_amdgcn_readfirstlane((int)threadIdx.x >> 6); F.lane = pg8::hw_lane(); F.tid = F.wave * 64 + F.lane;
    F.G = gridDim.x; { const int bx = blockIdx.x; F.vcu = (F.G % 8 == 0) ? (bx % 8) * (F.G / 8) + bx / 8 : bx; }
    volatile LAS unsigned* MISC = (volatile LAS unsigned*)(F.lds + MISC_OFF);
    for (int u = F.tid; u < (LDS_BYTES - RING_BYTES) / 4; u += NTHR) ((LAS unsigned*)(F.lds + RING_BYTES))[u] = 0u;
    __syncthreads();
    XcdBarrier bar = xcd_barrier_post((unsigned*)(a.ws + WS_CTL) + CW_BAR, MISC + 8, (unsigned)F.wave);
    const int lo = a.ph_lo, hi = a.ph_hi;
#ifndef MK_REP_GEMM
#define MK_REP_GEMM 1
#endif
#ifndef MK_REP_ATT
#define MK_REP_ATT 1
#endif
#ifndef MK_REP_MISC
#define MK_REP_MISC 1
#endif
#ifndef MK_GEMM_ALIGN
#define MK_GEMM_ALIGN true
#endif
#ifndef MK_GEMM_SP2
#define MK_GEMM_SP2 true
#endif
#ifndef MK_REP_WC
#define MK_REP_WC 1
#endif
#ifndef MK_REP_SYNC
#define MK_REP_SYNC 0
#endif
#ifndef MK_REP_DIFF
#define MK_REP_DIFF MK_REP_ATT
#endif
#ifndef MK_REP_NA
#define MK_REP_NA MK_REP_ATT
#endif
#ifndef MK_REP_SWA
#define MK_REP_SWA MK_REP_ATT
#endif
#ifndef MK_REP_SCAN
#define MK_REP_SCAN 1
#endif
#ifndef MK_REP_GATES
#define MK_REP_GATES MK_REP_SCAN
#endif
#ifndef MK_SITES
#define MK_SITES 0xFFFFFFFFu
#endif
#define ON(b) (((MK_SITES) >> (b)) & 1u)
#ifdef MK_PARTIAL
#define IN(k) (lo <= (k) && (k) < hi)
#else
#define IN(k) true
#endif
#ifndef MK_REP_BAR
#define MK_REP_BAR 1
#endif
#ifdef MK_TP
    long long tp_acc = 0, tp_prev = wall_clock64(), tp_t0 = 0;
#define TP_PRE(k) tp_t0 = wall_clock64();
#define TP_POST(k) { long long n_ = wall_clock64(); if ((MK_TP_MASK >> (k)) & 1u) tp_acc += n_ - (MK_TP == 1 ? tp_t0 : tp_prev); tp_prev = n_; }
#else
#define TP_PRE(k)
#define TP_POST(k)
#endif
#define SEAM(k) do { if (IN(k) && IN((k) + 1)) { TP_PRE(k) for (int rb_ = 0; rb_ < MK_REP_BAR; ++rb_) xcd_barrier(bar); TP_POST(k) } } while (0)
    const int gw = F.vcu * NWAVES + F.wave, NGW = F.G * NWAVES;
#define WSB ([&]() { unsigned char* p_ = a.ws; asm volatile("" : "+s"(p_)); return p_; }())
#define xs (a.out)
#define ctxs ((float*)(WSB + WS_CTXS))
#define xsb ((bf16*)a.out)
#define ctxb ((bf16*)(WSB + WS_CTXS))
#define x3b ((bf16*)(WSB + WS_S3))
#define mod ((const float*)(WSB + WS_MOD))
#define WinA ((bf16*)(WSB + WS_WIN))
#define WoutA ((bf16*)(WSB + WS_WOUT))
#define WinB ((bf16*)(WSB + WS_W2))
#define WoutB ((bf16*)(WSB + WS_W2 + 16 * MiB))
#define H ((bf16*)(WSB + WS_H))
#define QG ((bf16*)(WSB + WS_QG))
#define ssq ((float*)(WSB + WS_SSQ))
#define shw ((const float*)(WSB + WS_SHW))
#define S2 ((bf16*)(WSB + WS_S2))
#define S3 ((bf16*)(WSB + WS_S3))
#define S4 ((bf16*)(WSB + WS_S4))
#define rope ((const float*)(WSB + WS_ROPE))
    const float QSC = 0.125f * LOG2E;

    if (ON(0) && IN(P_PRO)) prologue_phase(F, a);
    SEAM(P_PRO);
    if (ON(0) && IN(P_PRO2)) { prologue2_phase(F, a); for (int rw_ = 0; rw_ < MK_REP_WC; ++rw_) wconv(F, a.in[8], 4096, a.in[18], WinA, WoutA, gw, NGW); }
    SEAM(P_PRO2);
    if (ON(1) && IN(P_NORM0)) { for (int rep = 0; rep < MK_REP_MISC; ++rep) norm_phase(F, a.in[0], a.in[2], a.in[4], mod, H); }
    SEAM(P_NORM0);
#if MK_HAVE_L0
    for (int g = 0; g < 2; ++g) {
        if (ON(2) && IN(P_L0 + 4 * g)) {
            pg8::Gemm gm{H + (size_t)g * MH * D, WinA, MH, 4096, D}; pg8::StaticOrder So; So.init(MH, 4096, F.G, (int)blockIdx.x);
            EpiProj<false> E{S2, S3, S3, S3, DI, DI, DI, DI, 8, 16, 16, 0u, 1.f, rope, nullptr, nullptr, 0};
            for (int rep = 0; rep < MK_REP_GEMM; ++rep) { if (MK_REP_SYNC && rep) xcd_barrier(bar); pg8::gemm_phase<EpiProj<false>, pg8::StaticOrder, MK_GEMM_ALIGN, MK_GEMM_SP2>(F.lds, gm, So, E, F.wave); }
        }
        SEAM(P_L0 + 4 * g);
        if (ON(17) && IN(P_L0 + 4 * g + 1)) for (int rep = 0; rep < MK_REP_GATES; ++rep) mlstm_gates_phase(F, a, g);
        SEAM(P_L0 + 4 * g + 1);
        if (ON(18) && IN(P_L0 + 4 * g + 2)) for (int rep = 0; rep < MK_REP_SCAN; ++rep) mlstm_scan_phase(F, a, g);
        SEAM(P_L0 + 4 * g + 2);
        if (ON(19) && IN(P_L0 + 4 * g + 3)) for (int rep = 0; rep < MK_REP_MISC; ++rep) mlstm_out_phase(F, a, g, rep + 1 < MK_REP_MISC);
        SEAM(P_L0 + 4 * g + 3);
    }
#endif
    constexpr int RHEAD = 128 * 256;
    if (ON(3) && IN(P_OUT0)) {
        pg8::Gemm gm{QG, WoutA, MT, D, DI}; pg8::StaticOrder So; So.init(RHEAD, D, F.G, (int)blockIdx.x);
        for (int rep = 0; rep < MK_REP_GEMM; ++rep) { if (MK_REP_SYNC && rep) xcd_barrier(bar); EpiResidT<float, bf16> E{a.in[0], a.in[2], xsb, ctxb, mod, 1, rep + 1 < MK_REP_GEMM, nullptr, nullptr, nullptr, nullptr};
        pg8::gemm_phase<EpiResidT<float, bf16>, pg8::StaticOrder, MK_GEMM_ALIGN, MK_GEMM_SP2>(F.lds, gm, So, E, F.wave); }
    }
    SEAM(P_OUT0);
    if (ON(3) && IN(P_OUT0)) {
        if (blockIdx.x < 64) { pg8::Gemm gm{QG, WoutA, MT, D, DI}; OutTailOrder So; So.init(F.G, (int)blockIdx.x); EpiResidT<float, bf16> E{a.in[0], a.in[2], xsb, ctxb, mod, 1, 0, nullptr, nullptr, nullptr, nullptr};
            pg8::gemm_phase<EpiResidT<float, bf16>, OutTailOrder, MK_GEMM_ALIGN, MK_GEMM_SP2>(F.lds, gm, So, E, F.wave); }
        else { wconv(F, a.in[19], 8192, a.in[25], WinB, WoutB, ((int)blockIdx.x - 64) * NWAVES + F.wave, (F.G - 64) * NWAVES);
            if (ON(4)) norm_phase(F, xsb, ctxb, a.in[4] + 1024, mod + 17 * 3072, H, 0, RHEAD, 64); }
    }
    SEAM(P_OUT0);
    for (int g = 0; g < 2; ++g) {
        if (ON(5) && IN(P_L1 + 2 * g)) {
            if (g == 0 && ON(4)) norm_phase(F, xsb, ctxb, a.in[4] + 1024, mod + 17 * 3072, H, RHEAD, MT);
            pg8::Gemm gm{H + (size_t)g * MH * D, WinB, MH, 8192, D}; pg8::StaticOrder So; So.init(MH, 8192, F.G, (int)blockIdx.x);
            EpiProj<true, false> E{QG + (size_t)g * MH * DI, S2, S3, S4, DI, DI, DI, DI, 8, 16, 24, 3u, QSC, rope, ssq, shw, g * MH};
#ifdef MK_STAGGER
            if (blockIdx.x >= 128) { const long long t0_ = wall_clock64(); while (wall_clock64() - t0_ < MK_STAGGER) __builtin_amdgcn_s_sleep(8); }
#endif
            for (int rep = 0; rep < MK_REP_GEMM; ++rep) { if (MK_REP_SYNC && rep) xcd_barrier(bar); pg8::gemm_phase<EpiProj<true, false>, pg8::StaticOrder, MK_GEMM_ALIGN, MK_GEMM_SP2>(F.lds, gm, So, E, F.wave); }
        }
        SEAM(P_L1 + 2 * g);
        if (ON(6) && IN(P_L1 + 2 * g + 1)) for (int rep = 0; rep < MK_REP_DIFF; ++rep) { if (MK_REP_SYNC && rep) xcd_barrier(bar); diff_phase(F, a, g, rep + 1 < MK_REP_DIFF); }
        SEAM(P_L1 + 2 * g + 1);
    }
    if (ON(7) && IN(P_OUT1)) {
        pg8::Gemm gm{QG, WoutB, MT, D, DI}; pg8::StaticOrder So; So.init(RHEAD, D, F.G, (int)blockIdx.x);
        for (int rep = 0; rep < MK_REP_GEMM; ++rep) { if (MK_REP_SYNC && rep) xcd_barrier(bar); EpiResidT<bf16, bf16> E{xsb, ctxb, xsb, ctxb, mod + 17 * 3072, 1, rep + 1 < MK_REP_GEMM, nullptr, nullptr, nullptr, nullptr};
        pg8::gemm_phase<EpiResidT<bf16, bf16>, pg8::StaticOrder, MK_GEMM_ALIGN, MK_GEMM_SP2>(F.lds, gm, So, E, F.wave); }
    }
    SEAM(P_OUT1);
    if (ON(7) && IN(P_OUT1)) {
        if (blockIdx.x < 64) { pg8::Gemm gm{QG, WoutB, MT, D, DI}; OutTailOrder So; So.init(F.G, (int)blockIdx.x); EpiResidT<bf16, bf16> E{xsb, ctxb, xsb, ctxb, mod + 17 * 3072, 1, 0, nullptr, nullptr, nullptr, nullptr};
            pg8::gemm_phase<EpiResidT<bf16, bf16>, OutTailOrder, MK_GEMM_ALIGN, MK_GEMM_SP2>(F.lds, gm, So, E, F.wave); }
        else { wconv(F, a.in[26], 8192, a.in[28], WinA, WoutA, ((int)blockIdx.x - 64) * NWAVES + F.wave, (F.G - 64) * NWAVES);
            if (ON(8)) norm_phase(F, xsb, ctxb, a.in[4] + 2048, mod + 2 * 17 * 3072, H, 0, RHEAD, 64); }
    }
    SEAM(P_OUT1);
    for (int g = 0; g < 2; ++g) {
        if (ON(9) && IN(P_L2 + 2 * g)) {
            if (g == 0 && ON(8)) norm_phase(F, xsb, ctxb, a.in[4] + 2048, mod + 2 * 17 * 3072, H, RHEAD, MT);
            pg8::Gemm gm{H + (size_t)g * MH * D, WinA, MH, 8192, D}; pg8::StaticOrder So; So.init(MH, 8192, F.G, (int)blockIdx.x);
            EpiProj<false, false> E{QG + (size_t)g * MH * DI, S2, S3, S4, DI, DI, DI, DI, 8, 16, 24, 0u, QSC, rope, ssq, shw + 17 * 8192, g * MH};
#ifdef MK_STAGGER
            if (blockIdx.x >= 128) { const long long t0_ = wall_clock64(); while (wall_clock64() - t0_ < MK_STAGGER) __builtin_amdgcn_s_sleep(8); }
#endif
            for (int rep = 0; rep < MK_REP_GEMM; ++rep) { if (MK_REP_SYNC && rep) xcd_barrier(bar); pg8::gemm_phase<EpiProj<false, false>, pg8::StaticOrder, MK_GEMM_ALIGN, MK_GEMM_SP2>(F.lds, gm, So, E, F.wave); }
        }
        SEAM(P_L2 + 2 * g);
        if (ON(10) && IN(P_L2 + 2 * g + 1)) for (int rep = 0; rep < MK_REP_NA; ++rep) { if (MK_REP_SYNC && rep) xcd_barrier(bar); na_phase(F, a, g, rep + 1 < MK_REP_NA); }
        SEAM(P_L2 + 2 * g + 1);
    }
    if (ON(11) && IN(P_OUT2)) {
        pg8::Gemm gm{QG, WoutA, MT, D, DI}; pg8::StaticOrder So; So.init(RHEAD, D, F.G, (int)blockIdx.x);
        for (int rep = 0; rep < MK_REP_GEMM; ++rep) { if (MK_REP_SYNC && rep) xcd_barrier(bar); EpiResidT<bf16, bf16> E{xsb, ctxb, x3b, ctxb, mod + 2 * 17 * 3072, 1, rep + 1 < MK_REP_GEMM, nullptr, nullptr, nullptr, nullptr};
        pg8::gemm_phase<EpiResidT<bf16, bf16>, pg8::StaticOrder, MK_GEMM_ALIGN, MK_GEMM_SP2>(F.lds, gm, So, E, F.wave); }
    }
    SEAM(P_OUT2);
    if (ON(11) && IN(P_OUT2)) {
        if (blockIdx.x < 64) { pg8::Gemm gm{QG, WoutA, MT, D, DI}; OutTailOrder So; So.init(F.G, (int)blockIdx.x); EpiResidT<bf16, bf16> E{xsb, ctxb, x3b, ctxb, mod + 2 * 17 * 3072, 1, 0, nullptr, nullptr, nullptr, nullptr};
            pg8::gemm_phase<EpiResidT<bf16, bf16>, OutTailOrder, MK_GEMM_ALIGN, MK_GEMM_SP2>(F.lds, gm, So, E, F.wave); }
        else { wconv(F, a.in[29], 4608, a.in[31], WinB, WoutB, ((int)blockIdx.x - 64) * NWAVES + F.wave, (F.G - 64) * NWAVES);
            if (ON(12)) norm_phase(F, x3b, ctxb, a.in[4] + 3072, mod + 3 * 17 * 3072, H, 0, RHEAD, 64); }
    }
    SEAM(P_OUT2);
    for (int g = 0; g < 2; ++g) {
        if (ON(13) && IN(P_L3 + 2 * g)) {
            if (g == 0 && ON(12)) norm_phase(F, x3b, ctxb, a.in[4] + 3072, mod + 3 * 17 * 3072, H, RHEAD, MT);
            pg8::Gemm gm{H + (size_t)g * MH * D, WinB, MH, 4608, D}; L3Order So; So.init(F.G, (int)blockIdx.x);
            EpiProj<true, false> E{QG + (size_t)g * MH * DI, S2, S2 + (size_t)MH * 256, S4, DI, 256, 256, DI, 8, 9, 10, 3u, QSC, rope, ssq, shw + 2 * 17 * 8192, g * MH};
            for (int rep = 0; rep < MK_REP_GEMM; ++rep) { if (MK_REP_SYNC && rep) xcd_barrier(bar); pg8::gemm_phase<EpiProj<true, false>, L3Order, MK_GEMM_ALIGN, MK_GEMM_SP2>(F.lds, gm, So, E, F.wave); }
        }
        SEAM(P_L3 + 2 * g);
        if (ON(14) && IN(P_L3 + 2 * g + 1)) for (int rep = 0; rep < MK_REP_SWA; ++rep) { if (MK_REP_SYNC && rep) xcd_barrier(bar); swa_phase(F, a, g, rep + 1 < MK_REP_SWA); }
        SEAM(P_L3 + 2 * g + 1);
    }
    if (ON(15) && IN(P_OUT3)) {
        pg8::Gemm gm{QG, WoutB, MT, D, DI}; LatOnlyOrder So; So.init(F.G, (int)blockIdx.x);
        for (int rep = 0; rep < MK_REP_GEMM; ++rep) { if (MK_REP_SYNC && rep) xcd_barrier(bar); EpiResidT<bf16, float> E{x3b, ctxb, xs, ctxs, mod + 3 * 17 * 3072, 0, rep + 1 < MK_REP_GEMM, nullptr, nullptr, nullptr, nullptr};
        pg8::gemm_phase<EpiResidT<bf16, float>, LatOnlyOrder, MK_GEMM_ALIGN, MK_GEMM_SP2>(F.lds, gm, So, E, F.wave); }
    }
    SEAM(P_OUT3);
    if (ON(16) && IN(P_FINAL)) final_norm_phase(F, xs, a.in[7]);
#ifdef MK_TP
    {
        if (MK_TP == 2) TP_POST(P_FINAL)
        unsigned long long* tpw = (unsigned long long*)(a.ws + WS_CTL + 32768);
        if (F.wave == 0 && pg8::hw_lane() == 0) __hip_atomic_fetch_add(tpw, (unsigned long long)tp_acc, __ATOMIC_RELAXED, __HIP_MEMORY_SCOPE_AGENT);
        xcd_barrier(bar);
        const unsigned long long sum = __hip_atomic_load(tpw, __ATOMIC_RELAXED, __HIP_MEMORY_SCOPE_AGENT);
        const long long wait = (long long)(sum / 256) * MK_TP_K, ts = wall_clock64();
        while (wall_clock64() - ts < wait) __builtin_amdgcn_s_sleep(32);
    }
#endif
#undef IN
#undef SEAM
#undef WSB
#undef xs
#undef ctxs
#undef xsb
#undef ctxb
#undef x3b
#undef mod
#undef WinA
#undef WoutA
#undef WinB
#undef WoutB
#undef H
#undef QG
#undef ssq
#undef shw
#undef S2
#undef S3
#undef S4
#undef rope
}

inline void launch_mega(void* const* d_in, void* d_out, void* d_ws, int lo, int hi, hipStream_t stream) {
    static int inited = 0;
    if (!inited) { (void)hipFuncSetAttribute((const void*)mega, hipFuncAttributeMaxDynamicSharedMemorySize, LDS_BYTES); inited = 1; }
    (void)hipMemsetAsync((char*)d_ws + WS_CTL, 0, CTL_BYTES, stream);
    Args a{};
    for (int i = 0; i < 32; ++i) a.in[i] = (const float*)d_in[i];
    a.out = (float*)d_out; a.ws = (unsigned char*)d_ws; a.ph_lo = lo; a.ph_hi = hi;
    hipLaunchKernelGGL(mega, dim3(256), dim3(NTHR), LDS_BYTES, stream, a);
}
}
extern "C" void kernel_launch(void* const* d_in, const int* in_sizes, int n_in, void* d_out, int out_size, void* d_ws, size_t ws_size, hipStream_t stream) {
    mk::launch_mega(d_in, d_out, d_ws, mk::P_PRO, mk::P_END, stream);
}
```

```cpp
#include <hip/hip_runtime.h>
#include <cstdint>
#include <cstdio>
#include <cmath>
#define MK_HAVE_L0 1
namespace pg8 {
#define PG8_LAS __attribute__((address_space(3)))
typedef unsigned short bf16_t;
typedef short bf16x8 __attribute__((ext_vector_type(8)));
typedef float f32x4 __attribute__((ext_vector_type(4)));
typedef unsigned u32x4 __attribute__((ext_vector_type(4)));
__device__ __forceinline__ int hw_lane() { int l; asm volatile("v_mbcnt_lo_u32_b32 %0, -1, 0\n\tv_mbcnt_hi_u32_b32 %0, -1, %0" : "=v"(l)); return l; }
constexpr int BM = 256, BK = 64, HALF = 128, HTB = HALF * BK * 2  , STAGE_BYTES = 8 * HTB, NXCD = 8, WGM = 8;

__host__ __device__ __forceinline__ int lds_byte(int r, int c) { const int st = (r >> 4) * 2 + (c >> 5), rr = r & 15, cc = c & 31, ob = rr * 64 + cc * 2; return st * 1024 + (ob ^ (((ob >> 9) & 1) << 5)); }
__host__ __device__ __forceinline__ void stage_rc(int b, int& R, int& C) { const int st = b / 1024, sb = b % 1024, swz = sb ^ (((sb >> 9) & 1) << 5); R = (st >> 1) * 16 + swz / 64; C = (st & 1) * 32 + (swz % 64) / 2; }
__host__ __device__ __forceinline__ int perm32(int rho) { const int n = rho >> 4, i = rho & 15; return 8 * (i >> 2) + 4 * n + (i & 3); }

struct Unit { int pm, pn; };
struct Gemm { const bf16_t* A; const bf16_t* Bt; int M, N, K; };

struct StaticOrder {
    int nM, nN, nwg, G, c;
    __host__ __device__ void init(int M, int N, int G_, int c_) { nM = M / BM; nN = N / BM; nwg = nM * nN; G = G_; c = c_; }
    __host__ __device__ bool next(int i, Unit& u) const {
        const long L = (long)i * G + c; if (L >= nwg) return false;
        int wgid = (int)L; { const int q = nwg / NXCD, r = nwg % NXCD, xcd = wgid % NXCD, off = wgid / NXCD; wgid = (xcd < r ? xcd * (q + 1) : r * (q + 1) + (xcd - r) * q) + off; }
        const int nig = WGM * nN, gid = wgid / nig, fm = gid * WGM, gsz = (nM - fm) < WGM ? (nM - fm) : WGM;
        u.pm = fm + ((wgid % nig) % gsz); u.pn = (wgid % nig) / gsz; return true;
    }
    __device__ __forceinline__ void a_ready(const Unit&) const {}
    __device__ __forceinline__ void done(const Unit&) const {}
};

__device__ __forceinline__ unsigned cvt_pk_bf16(float lo, float hi) { unsigned r; asm volatile("v_cvt_pk_bf16_f32 %0, %1, %2" : "=v"(r) : "v"(lo), "v"(hi)); return r; }
typedef float f32x2 __attribute__((ext_vector_type(2)));
template <class Epi, class Sched, bool ALIGN_EPI = false, bool SP2 = false>
__device__ __forceinline__ void gemm_phase(PG8_LAS unsigned char* lds, const Gemm g, const Sched& S, const Epi& E, int wave_id) {
    int tid_ = wave_id * 64 + hw_lane(); asm volatile("" : "+v"(tid_));
    const int tid = tid_, wid = __builtin_amdgcn_readfirstlane(tid >> 6), lane = tid & 63, wr = wid >> 2, wc = wid & 3, fr = lane & 15, fq = lane >> 4;
    const int K = g.K, nt = K / BK;
    unsigned voffA[2], voffB[2];
#pragma unroll
    for (int i = 0; i < 2; ++i) { int R, C; stage_rc(tid * 16 + i * 8192, R, C); const int Rb = Epi::PERM ? ((R & ~31) + perm32(R & 31)) : R;
        voffA[i] = (unsigned)(R * K + C) * 2u; voffB[i] = (unsigned)(Rb * K + C) * 2u; }
    const size_t kstep = (size_t)(BK * 2);
    const size_t hstep = (size_t)HALF * K * 2;
    const size_t tstep = 2 * hstep;
    const unsigned ldsw = (unsigned)wid * 1024u;
    const int aoff = lds_byte(wr * 64 + fr, fq * 8), boff = lds_byte(wc * 32 + fr, fq * 8);
#define PG8_SA(b, h) (((b) * 2 + (h)) * HTB)
#define PG8_SB(b, h) ((4 + (b) * 2 + (h)) * HTB)
#define PG8_STAGE(bufoff, gbase, voff) do { _Pragma("unroll") for (int _i = 0; _i < 2; ++_i) \
        __builtin_amdgcn_global_load_lds((const unsigned*)((const char*)(gbase) + (voff)[_i]), (PG8_LAS unsigned*)(lds + (bufoff) + ldsw + _i * 8192), 16, 0, 0); } while (0)
#define PG8_LDA(dst, b, h) do { _Pragma("unroll") for (int m = 0; m < 4; ++m) _Pragma("unroll") for (int k = 0; k < 2; ++k) dst[m][k] = *(const PG8_LAS bf16x8*)(lds + PG8_SA(b, h) + aoff + m * 2048 + k * 1024); } while (0)
#define PG8_LDB(dst, b, h) do { _Pragma("unroll") for (int n = 0; n < 2; ++n) _Pragma("unroll") for (int k = 0; k < 2; ++k) dst[n][k] = *(const PG8_LAS bf16x8*)(lds + PG8_SB(b, h) + boff + n * 2048 + k * 1024); } while (0)
#define PG8_MMA(ai, bj, At, Bt) do { __builtin_amdgcn_s_setprio(1); _Pragma("unroll") for (int m = 0; m < 4; ++m) _Pragma("unroll") for (int n = 0; n < 2; ++n) _Pragma("unroll") for (int k = 0; k < 2; ++k) \
        acc[ai][bj][m][n] = __builtin_amdgcn_mfma_f32_16x16x32_bf16(Bt[n][k], At[m][k], acc[ai][bj][m][n], 0, 0, 0); __builtin_amdgcn_s_setprio(0); } while (0)
#define PG8_WAIT_V(n) asm volatile("s_waitcnt vmcnt(" #n ")" ::: "memory")
#define PG8_WAIT_L(n) asm volatile("s_waitcnt lgkmcnt(" #n ")" ::: "memory")
#define PG8_BAR __builtin_amdgcn_s_barrier()
#define PG8_SCHED __builtin_amdgcn_sched_barrier(0)
    Unit cur, nxt; int ui = 0;
    if (!S.next(0, cur)) return;
    f32x4 acc[2][2][4][2];
#pragma unroll
    for (int a = 0; a < 2; ++a)
#pragma unroll
        for (int b = 0; b < 2; ++b)
#pragma unroll
            for (int m = 0; m < 4; ++m)
#pragma unroll
                for (int n = 0; n < 2; ++n) acc[a][b][m][n] = (f32x4){0.f, 0.f, 0.f, 0.f};
    bf16x8 At[4][2], B0[2][2], B1[2][2];
    const char* cA = (const char*)g.A + (size_t)cur.pm * tstep; const char* cB = (const char*)g.Bt + (size_t)cur.pn * tstep;
    S.a_ready(cur);
    if constexpr (SP2) {
        PG8_STAGE(PG8_SB(0, 0), cB, voffB); PG8_STAGE(PG8_SB(0, 1), cB + hstep, voffB); PG8_STAGE(PG8_SA(0, 0), cA, voffA); PG8_STAGE(PG8_SA(0, 1), cA + hstep, voffA);
        if (wr == 1) PG8_BAR;
        PG8_WAIT_V(2); PG8_BAR;
        PG8_STAGE(PG8_SB(1, 0), cB + kstep, voffB); PG8_STAGE(PG8_SA(1, 0), cA + kstep, voffA); PG8_STAGE(PG8_SB(1, 1), cB + hstep + kstep, voffB);
        PG8_WAIT_V(6); PG8_BAR;
    } else {
        PG8_STAGE(PG8_SB(0, 0), cB, voffB); PG8_STAGE(PG8_SA(0, 0), cA, voffA); PG8_STAGE(PG8_SB(0, 1), cB + hstep, voffB); PG8_STAGE(PG8_SA(0, 1), cA + hstep, voffA);
        if (wr == 1) PG8_BAR;
        PG8_WAIT_V(4); PG8_BAR;
        PG8_STAGE(PG8_SB(1, 0), cB + kstep, voffB); PG8_STAGE(PG8_SA(1, 0), cA + kstep, voffA); PG8_STAGE(PG8_SB(1, 1), cB + hstep + kstep, voffB);
        PG8_WAIT_V(6); PG8_BAR;
    }
    for (;;) {
        const bool has_next = S.next(ui + 1, nxt);
        const char* nA = has_next ? (const char*)g.A + (size_t)nxt.pm * tstep : cA; const char* nB = has_next ? (const char*)g.Bt + (size_t)nxt.pn * tstep : cB;
        for (int t = 0; t < nt; t += 2) {
            const bool last = (t == nt - 2);
            const char* a1 = cA + (size_t)(t + 1) * kstep;
            const char* a2 = last ? nA : cA + (size_t)(t + 2) * kstep; const char* b2 = last ? nB : cB + (size_t)(t + 2) * kstep;
            const char* a3 = a2 + kstep; const char* b3 = b2 + kstep;
            if (last && has_next) S.a_ready(nxt);
            if constexpr (SP2) {
            PG8_LDB(B0, 0, 0); PG8_LDB(B1, 0, 1); PG8_SCHED; PG8_LDA(At, 0, 0); PG8_STAGE(PG8_SA(1, 1), a1 + hstep, voffA);
            PG8_WAIT_V(8); PG8_WAIT_L(0); PG8_BAR; PG8_MMA(0, 0, At, B0); PG8_MMA(0, 1, At, B1); PG8_BAR; PG8_SCHED;
            PG8_LDA(At, 0, 1); PG8_STAGE(PG8_SB(0, 0), b2, voffB); PG8_STAGE(PG8_SB(0, 1), b2 + hstep, voffB); PG8_STAGE(PG8_SA(0, 0), a2, voffA);
            PG8_WAIT_V(8); PG8_WAIT_L(0); PG8_BAR; PG8_MMA(1, 0, At, B0); PG8_MMA(1, 1, At, B1); PG8_BAR; PG8_SCHED;
            PG8_LDB(B0, 1, 0); PG8_LDB(B1, 1, 1); PG8_SCHED; PG8_LDA(At, 1, 0); PG8_STAGE(PG8_SA(0, 1), a2 + hstep, voffA);
            PG8_WAIT_V(8); PG8_WAIT_L(0); PG8_BAR; PG8_MMA(0, 0, At, B0); PG8_MMA(0, 1, At, B1); PG8_BAR; PG8_SCHED;
            PG8_LDA(At, 1, 1); PG8_STAGE(PG8_SB(1, 0), b3, voffB); PG8_STAGE(PG8_SB(1, 1), b3 + hstep, voffB); PG8_STAGE(PG8_SA(1, 0), a3, voffA);
            PG8_WAIT_V(8); PG8_WAIT_L(0); PG8_BAR; PG8_MMA(1, 0, At, B0); PG8_MMA(1, 1, At, B1); PG8_BAR; PG8_SCHED;
            } else {
            PG8_LDB(B0, 0, 0); PG8_SCHED; PG8_LDA(At, 0, 0); PG8_STAGE(PG8_SA(1, 1), a1 + hstep, voffA);
            PG8_WAIT_L(8); PG8_BAR; PG8_WAIT_L(0); PG8_MMA(0, 0, At, B0); PG8_BAR; PG8_SCHED;
            PG8_LDB(B1, 0, 1); PG8_STAGE(PG8_SB(0, 0), b2, voffB);
            PG8_BAR; PG8_WAIT_L(0); PG8_MMA(0, 1, At, B1); PG8_BAR;
            PG8_LDA(At, 0, 1); PG8_STAGE(PG8_SA(0, 0), a2, voffA);
            PG8_BAR; PG8_WAIT_L(0); PG8_MMA(1, 0, At, B0); PG8_BAR; PG8_SCHED;
            PG8_STAGE(PG8_SB(0, 1), b2 + hstep, voffB);
            PG8_WAIT_V(6); PG8_BAR; PG8_MMA(1, 1, At, B1); PG8_BAR;
            PG8_LDB(B0, 1, 0); PG8_SCHED; PG8_LDA(At, 1, 0); PG8_STAGE(PG8_SA(0, 1), a2 + hstep, voffA);
            PG8_WAIT_L(8); PG8_BAR; PG8_WAIT_L(0); PG8_MMA(0, 0, At, B0); PG8_BAR; PG8_SCHED;
            PG8_LDB(B1, 1, 1); PG8_STAGE(PG8_SB(1, 0), b3, voffB);
            PG8_BAR; PG8_WAIT_L(0); PG8_MMA(0, 1, At, B1); PG8_BAR;
            PG8_LDA(At, 1, 1); PG8_STAGE(PG8_SA(1, 0), a3, voffA);
            PG8_BAR; PG8_WAIT_L(0); PG8_MMA(1, 0, At, B0); PG8_BAR; PG8_SCHED;
            PG8_STAGE(PG8_SB(1, 1), b3 + hstep, voffB);
            PG8_WAIT_V(6); PG8_BAR; PG8_MMA(1, 1, At, B1); PG8_BAR;
            }
        }
        if constexpr (ALIGN_EPI) { if (wr == 0) PG8_BAR; }
#if defined(MK_EXP_EPI2)
        if constexpr (!Epi::AFTER_DRAIN && Epi::PERM) { E.template run<(MK_EXP_EPI2 == 2)>(acc, cur, wr, wc, fr, fq); }
#endif
        if constexpr (!Epi::AFTER_DRAIN) { E(acc, cur, wr, wc, fr, fq); S.done(cur); }
        if (!has_next) break;
#pragma unroll
        for (int a = 0; a < 2; ++a)
#pragma unroll
            for (int b = 0; b < 2; ++b)
#pragma unroll
                for (int m = 0; m < 4; ++m)
#pragma unroll
                    for (int n = 0; n < 2; ++n) acc[a][b][m][n] = (f32x4){0.f, 0.f, 0.f, 0.f};
        cur = nxt; cA = nA; cB = nB; ++ui;
        if constexpr (ALIGN_EPI) { if (wr == 1) PG8_BAR; }
    }
    PG8_WAIT_V(0);
    if constexpr (!ALIGN_EPI) { if (wr == 0) PG8_BAR; }
    PG8_BAR;
    if constexpr (Epi::AFTER_DRAIN) { E.fused(acc, cur, wr, wc, fr, fq, lds, wid, lane); S.done(cur); }
#undef PG8_SA
#undef PG8_SB
#undef PG8_STAGE
#undef PG8_LDA
#undef PG8_LDB
#undef PG8_MMA
#undef PG8_WAIT_V
#undef PG8_WAIT_L
#undef PG8_BAR
#undef PG8_SCHED
}
}
#define GAS __attribute__((address_space(1)))
#define LAS __attribute__((address_space(3)))
typedef unsigned short bf16;
typedef unsigned v4u __attribute__((ext_vector_type(4)));
typedef float f32x4 __attribute__((ext_vector_type(4)));
typedef short bf16x8 __attribute__((ext_vector_type(8)));
typedef GAS unsigned gu32;
typedef GAS unsigned long long gu64;
#define RLX_AGENT __ATOMIC_RELAXED, __HIP_MEMORY_SCOPE_AGENT
#define LDS_WAIT() asm volatile("s_waitcnt lgkmcnt(0)" ::: "memory")
#define VM_WAIT() asm volatile("s_waitcnt vmcnt(0)" ::: "memory")
__device__ __forceinline__ unsigned long long rt() { return __builtin_amdgcn_s_memrealtime(); }
__device__ __forceinline__ unsigned f2bf(float f) { unsigned u = __builtin_bit_cast(unsigned, f); return (u + 0x7fffu + ((u >> 16) & 1u)) >> 16; }
__device__ __forceinline__ unsigned pk2(float lo, float hi) { return f2bf(lo) | (f2bf(hi) << 16); }
#define XB_TMO      128
#define XB_XCNT(j)  (256  + 64 * (j))
#define XB_XSUB(j)  (1280 + 64 * (j))
#define XB_XGEN(j)  (2304 + 64 * (j))
#define XB_TOP      3328
#define XB_TOPGEN   3392
#define XCD_BAR_WORDS 3456
#define XB_SPIN_CAP (1u << 18)

__device__ __forceinline__ unsigned xb_ld(unsigned* p)              { return __hip_atomic_load(p, __ATOMIC_RELAXED, __HIP_MEMORY_SCOPE_AGENT); }
__device__ __forceinline__ unsigned xb_add(unsigned* p, unsigned v) { return __hip_atomic_fetch_add(p, v, __ATOMIC_RELAXED, __HIP_MEMORY_SCOPE_AGENT); }
__device__ __forceinline__ unsigned xb_xcc_id() { return (unsigned)__builtin_amdgcn_s_getreg((3 << 11) | 20) & 0xFu; }
#define XB_SPIN(cond, bar) do { unsigned _sp = 0; while (cond) { __builtin_amdgcn_s_sleep(1); \
    if ((++_sp & 255u) == 0u) { if (xb_ld(&(bar)[XB_TMO])) break; if (_sp > XB_SPIN_CAP) { atomicAdd(&(bar)[XB_TMO], 1u); break; } } } } while (0)

struct XcdBarrier {
    unsigned* bar; unsigned x; unsigned w;
    volatile LAS unsigned* st;
};

__device__ __forceinline__ XcdBarrier xcd_barrier_post(unsigned* bar, volatile LAS unsigned* st, unsigned wave) {
    XcdBarrier b; b.bar = bar; b.x = xb_xcc_id(); b.st = st; b.w = wave;
    if (b.w == 0u && pg8::hw_lane() == 0) (void)xb_add(&bar[XB_XCNT(b.x)], 1u);
    return b;
}
__device__ __forceinline__ void xcd_barrier_complete(unsigned* bar, unsigned x, unsigned& nloc, unsigned& nx) {
    const unsigned G = gridDim.x * gridDim.y * gridDim.z;
    unsigned sum, cnt, mine, sp = 0u;
    for (;;) {
        sum = 0u; cnt = 0u; mine = 0u;
#pragma unroll
        for (unsigned j = 0; j < 16; ++j) { const unsigned c = xb_ld(&bar[XB_XCNT(j)]); sum += c; cnt += (c > 0u) ? 1u : 0u; mine = (j == x) ? c : mine; }
        if (sum == G) break;
        __builtin_amdgcn_s_sleep(1);
        if ((++sp & 255u) == 0u) { if (xb_ld(&bar[XB_TMO])) break; if (sp > XB_SPIN_CAP) { atomicAdd(&bar[XB_TMO], 1u); break; } }
    }
    nloc = mine > 0u ? mine : 1u; nx = cnt > 0u ? cnt : 1u;
}

__device__ __forceinline__ void xcd_barrier(const XcdBarrier& b) {
    asm volatile("s_waitcnt vmcnt(0)" ::: "memory");
    __syncthreads();
    if (b.w == 0u && pg8::hw_lane() == 0) {
        unsigned* bar = b.bar;
        __builtin_amdgcn_s_waitcnt(0);
        unsigned nloc = b.st[0], nx = b.st[1];
        if (nloc == 0u) { xcd_barrier_complete(bar, b.x, nloc, nx); b.st[0] = nloc; b.st[1] = nx; }
        const unsigned old = xb_add(&bar[XB_XSUB(b.x)], 1u);
        const unsigned gen = old / nloc;
        if (old + 1u == (gen + 1u) * nloc) {
            __builtin_amdgcn_fence(__ATOMIC_RELEASE, "agent");
            asm volatile("s_waitcnt vmcnt(0)" ::: "memory");
            const unsigned og = xb_add(&bar[XB_TOP], 1u);
            const unsigned tg = og / nx;
            if (og + 1u == (tg + 1u) * nx) xb_add(&bar[XB_TOPGEN], 1u);
            else XB_SPIN(xb_ld(&bar[XB_TOPGEN]) == tg, bar);
            __builtin_amdgcn_fence(__ATOMIC_ACQUIRE, "agent");
            xb_add(&bar[XB_XGEN(b.x)], 1u);
            asm volatile("s_waitcnt vmcnt(0)" ::: "memory");
        } else {
            XB_SPIN(xb_ld(&bar[XB_XGEN(b.x)]) == gen, bar);
            __builtin_amdgcn_fence(__ATOMIC_ACQUIRE, "agent");
            asm volatile("s_waitcnt vmcnt(0)" ::: "memory");
        }
    }
    __syncthreads();
}
namespace mk {
constexpr int NWAVES = 8, NTHR = 512;
constexpr int NB = 16, S = 2048, D = 1024, CT = 256, RB = S + CT  , MT = NB * RB, HB = 8  , MH = HB * RB, DI = 2048;
constexpr float EPS = 1e-6f, LOG2E = 1.4426950408889634f;
constexpr size_t MiB = 1u << 20;
constexpr size_t WS_CTXS = 0, WS_MOD = 16 * MiB, WS_CTL = 17 * MiB, CTL_BYTES = 64 * 1024;
constexpr size_t WS_ROPE = 18 * MiB, WS_WG2 = 18 * MiB + 64 * 1024, WS_GATES = 19 * MiB;
constexpr size_t WS_WIN = 22 * MiB, WS_WOUT = 38 * MiB, WS_H = 42 * MiB, WS_QG = 114 * MiB, WS_S2 = 258 * MiB, WS_S3 = 330 * MiB, WS_S4 = 402 * MiB, WS_END = 474 * MiB, WS_GATES2 = 474 * MiB  ,
    WS_SSQ = 477 * MiB  , WS_W2 = 480 * MiB  , WS_SHW = 500 * MiB  , WS_GATES3 = 503 * MiB, WS_GATES4 = 506 * MiB  ;
constexpr int CW_BAR = 1024;
constexpr int RING_BYTES = 131072, MISC_OFF = RING_BYTES + 320, LDS_BYTES = 147456;

typedef unsigned short bf16;
typedef float f32x4 __attribute__((ext_vector_type(4)));
typedef float f32x16 __attribute__((ext_vector_type(16)));
typedef short bf16x8 __attribute__((ext_vector_type(8)));
typedef short s16x4 __attribute__((ext_vector_type(4)));
typedef unsigned u32x4 __attribute__((ext_vector_type(4)));
typedef unsigned u32x2 __attribute__((ext_vector_type(2)));

__device__ __forceinline__ float silu(float x) { return x * __builtin_amdgcn_rcpf(1.f + __expf(-x)); }
__device__ __forceinline__ float bf2f(unsigned short b) { return __uint_as_float((unsigned)b << 16); }
__device__ __forceinline__ float bflo(unsigned w) { return __uint_as_float(w << 16); }
__device__ __forceinline__ float bfhi(unsigned w) { return __uint_as_float(w & 0xffff0000u); }
__device__ __forceinline__ float wave_sum(float v) {
#define MK_DPPF(x, ctrl) __uint_as_float((unsigned)__builtin_amdgcn_update_dpp(0, (int)__float_as_uint(x), ctrl, 0xf, 0xf, true))
    v += MK_DPPF(v, 0xB1);
    v += MK_DPPF(v, 0x4E);
    v += MK_DPPF(v, 0x124);
    v += MK_DPPF(v, 0x128);
#undef MK_DPPF
    { const auto rr = __builtin_amdgcn_permlane16_swap(__float_as_uint(v), __float_as_uint(v), false, false); v = __uint_as_float(rr[0]) + __uint_as_float(rr[1]); }
    { const auto rr = __builtin_amdgcn_permlane32_swap(__float_as_uint(v), __float_as_uint(v), false, false); v = __uint_as_float(rr[0]) + __uint_as_float(rr[1]); }
    return v;
}

struct Frame {
    LAS unsigned char* lds;
    int tid, lane, wave, vcu, G;
    void* const* dummy;
};
__device__ __forceinline__ Frame fresh(const Frame& F0) { Frame F = F0; const int l = pg8::hw_lane(); F.lane = l; F.tid = F0.wave * 64 + l; return F; }
struct Args { const float* in[32]; float* out; unsigned char* ws; int ph_lo, ph_hi; };

template <bool ROPE, bool AFFINE = false> struct EpiProj {
    static constexpr bool PERM = true, AFTER_DRAIN = false;
    bf16 *d0, *d1, *d2, *d3; int l0, l1, l2, l3; int t1, t2, t3; unsigned ropemask; float sc0; const float* rope;
    const float* ssq; const float* shw; int row_base;
    __device__ __forceinline__ void operator()(const pg8::f32x4 (&acc)[2][2][4][2], const pg8::Unit& u, int wr, int wc, int fr, int fq) const { run<false>(acc, u, wr, wc, fr, fq); }
    template <bool NOSTORE> __device__ __forceinline__ void run(const pg8::f32x4 (&acc)[2][2][4][2], const pg8::Unit& u, int wr, int wc, int fr, int fq) const {
        asm volatile("" : "+v"(fr), "+v"(fq));
        const int pn = u.pn;
        long long off = 0; int ld = l0, tb = 0, s = 0;
        if (pn >= t1) { off += (long long)(d1 - d0); ld += l1 - l0; tb = t1; s = 1; }
        if (pn >= t2) { off += (long long)(d2 - d1); ld += l2 - l1; tb = t2; s = 2; }
        if (pn >= t3) { off += (long long)(d3 - d2); ld += l3 - l2; tb = t3; s = 3; }
        bf16* base = d0 + off;
        const float sc = (pn >= t1) ? 1.f : sc0;
        const int rr0 = (u.pm * 256) % RB;
        const bool do_rope = ROPE && ((ropemask >> s) & 1u) && rr0 != 0;
        const int col0 = (pn - tb) * 256 + wc * 32 + 8 * fq;
        const int rloc = wr * 64 + fr;
        pg8::f32x4 sw[2][2];
        if (AFFINE) { const int gr0 = row_base + u.pm * 256; const float* sp = shw + (size_t)(rr0 == 0 ? 16 : gr0 / RB) * 8192 + pn * 256 + wc * 32 + 8 * fq;
#pragma unroll
            for (int bj = 0; bj < 2; ++bj) { sw[bj][0] = *(const pg8::f32x4*)(sp + bj * 128); sw[bj][1] = *(const pg8::f32x4*)(sp + bj * 128 + 4); } }
#pragma unroll
        for (int ai = 0; ai < 2; ++ai)
#pragma unroll
            for (int m = 0; m < 4; ++m) {
                const int rt = rloc + ai * 128 + m * 16;
                bf16* rowp = base + (size_t)(u.pm * 256 + rt) * ld + col0;
                float rstd = 1.f;
                if (AFFINE) { const pg8::f32x4* qp = (const pg8::f32x4*)(ssq + (size_t)(row_base + u.pm * 256 + rt) * 16); const pg8::f32x4 a0 = qp[0], a1 = qp[1], a2 = qp[2], a3 = qp[3];
                    const float tot = ((a0[0] + a0[1]) + (a0[2] + a0[3])) + ((a1[0] + a1[1]) + (a1[2] + a1[3])) + ((a2[0] + a2[1]) + (a2[2] + a2[3])) + ((a3[0] + a3[1]) + (a3[2] + a3[3]));
                    rstd = rsqrtf(tot * (1.f / D) + EPS); }
                f32x4 cs0 = {}, cs1 = {}, cs2 = {}, cs3 = {};
                if (ROPE && do_rope) { const int t = rr0 - CT + rt; const int pos = (wc & 1) ? (t & 63) : (t >> 6); const f32x4* tp = (const f32x4*)(rope + pos * 32 + 16 * (fq & 1));
                    cs0 = tp[0]; cs1 = tp[1]; cs2 = tp[2]; cs3 = tp[3]; }
#pragma unroll
                for (int bj = 0; bj < 2; ++bj) {
                    pg8::f32x4 v0 = acc[ai][bj][m][0], v1 = acc[ai][bj][m][1];
                    if (AFFINE) { v0 = v0 * rstd + sw[bj][0]; v1 = v1 * rstd + sw[bj][1]; }
                    if (ROPE && do_rope) {
                        const float sg = (fq & 2) ? 1.f : -1.f;
                        pg8::f32x4 p0, p1;
#pragma unroll
                        for (int i = 0; i < 4; ++i) {
                            const auto s0 = __builtin_amdgcn_permlane32_swap(__float_as_uint(v0[i]), __float_as_uint(v0[i]), false, false), s1 = __builtin_amdgcn_permlane32_swap(__float_as_uint(v1[i]), __float_as_uint(v1[i]), false, false);
                            p0[i] = __uint_as_float((fq & 2) ? s0[0] : s0[1]); p1[i] = __uint_as_float((fq & 2) ? s1[0] : s1[1]); }
                        v0[0] = v0[0] * cs0[0] + sg * p0[0] * cs0[1]; v0[1] = v0[1] * cs0[2] + sg * p0[1] * cs0[3];
                        v0[2] = v0[2] * cs1[0] + sg * p0[2] * cs1[1]; v0[3] = v0[3] * cs1[2] + sg * p0[3] * cs1[3];
                        v1[0] = v1[0] * cs2[0] + sg * p1[0] * cs2[1]; v1[1] = v1[1] * cs2[2] + sg * p1[1] * cs2[3];
                        v1[2] = v1[2] * cs3[0] + sg * p1[2] * cs3[1]; v1[3] = v1[3] * cs3[2] + sg * p1[3] * cs3[3];
                    }
                    v0 = v0 * sc; v1 = v1 * sc;
                    pg8::u32x4 w; w.x = pg8::cvt_pk_bf16(v0[0], v0[1]); w.y = pg8::cvt_pk_bf16(v0[2], v0[3]); w.z = pg8::cvt_pk_bf16(v1[0], v1[1]); w.w = pg8::cvt_pk_bf16(v1[2], v1[3]);
                    if (NOSTORE) asm volatile("" :: "v"(w)); else { *(pg8::u32x4*)(rowp + bj * 128) = w;
#ifdef MK_EXP_ST2
                        asm volatile("" ::: "memory"); *(volatile pg8::u32x4*)(rowp + bj * 128) = w;
#endif
                    }
                }
            }
    }
};
__device__ __forceinline__ pg8::f32x4 ld4(const float* p) { return *(const pg8::f32x4*)p; }
__device__ __forceinline__ pg8::f32x4 ld4(const bf16* p) { const u32x2 w = *(const u32x2*)p; pg8::f32x4 v; v[0] = bflo(w.x); v[1] = bfhi(w.x); v[2] = bflo(w.y); v[3] = bfhi(w.y); return v; }
__device__ __forceinline__ void st4(float* p, const pg8::f32x4& v) { *(pg8::f32x4*)p = v; }
__device__ __forceinline__ void st4(bf16* p, const pg8::f32x4& v) { u32x2 w; w.x = pg8::cvt_pk_bf16(v[0], v[1]); w.y = pg8::cvt_pk_bf16(v[2], v[3]); *(u32x2*)p = w; }
__device__ __forceinline__ void ld8(const float* p, pg8::f32x4& a, pg8::f32x4& b) { a = *(const pg8::f32x4*)p; b = *(const pg8::f32x4*)(p + 4); }
__device__ __forceinline__ void ld8(const bf16* p, pg8::f32x4& a, pg8::f32x4& b) { const u32x4 w = *(const u32x4*)p; a[0] = bflo(w.x); a[1] = bfhi(w.x); a[2] = bflo(w.y); a[3] = bfhi(w.y); b[0] = bflo(w.z); b[1] = bfhi(w.z); b[2] = bflo(w.w); b[3] = bfhi(w.w); }
__device__ __forceinline__ void st8(float* p, const pg8::f32x4& a, const pg8::f32x4& b) { *(pg8::f32x4*)p = a; *(pg8::f32x4*)(p + 4) = b; }
__device__ __forceinline__ void st8(bf16* p, const pg8::f32x4& a, const pg8::f32x4& b) { u32x4 w; w.x = pg8::cvt_pk_bf16(a[0], a[1]); w.y = pg8::cvt_pk_bf16(a[2], a[3]); w.z = pg8::cvt_pk_bf16(b[0], b[1]); w.w = pg8::cvt_pk_bf16(b[2], b[3]); *(u32x4*)p = w; }
template <class BT = float, class OT = float> struct EpiResidT {
    static constexpr bool PERM = true, AFTER_DRAIN = false;
    const BT* base_lat; const BT* base_ctx; OT* out_lat; OT* out_ctx; const float* mod_l; int need_ctx; int dry;
    bf16* Hn; const float* gnext; const float* modn; float* ssq;
    __device__ __forceinline__ void operator()(const pg8::f32x4 (&acc)[2][2][4][2], const pg8::Unit& u, int wr, int wc, int fr, int fq) const {
        asm volatile("" : "+v"(fr), "+v"(fq));
        const int r0 = u.pm * 256, b = r0 / RB, rr0 = r0 % RB; const bool ctx = rr0 == 0;
        if ((ctx && !need_ctx) || dry) return;
        const size_t ro = ctx ? (size_t)b * CT * D : ((size_t)b * S + (rr0 - CT)) * D;
        const BT* bp = (ctx ? base_ctx : base_lat) + ro; OT* op = (ctx ? out_ctx : out_lat) + ro;
        const float* gt = mod_l + (size_t)(ctx ? 16 : b) * 3072 + 2048;
        const int col0 = u.pn * 256 + wc * 32 + 8 * fq;
        pg8::f32x4 g[2][2];
#pragma unroll
        for (int bj = 0; bj < 2; ++bj)
#pragma unroll
            for (int n = 0; n < 2; ++n) g[bj][n] = *(const pg8::f32x4*)(gt + col0 + bj * 128 + n * 4);
#pragma unroll
        for (int ai = 0; ai < 2; ++ai)
#pragma unroll
            for (int m = 0; m < 4; ++m) { const size_t off = (size_t)(ai * 128 + wr * 64 + m * 16 + fr) * D + col0;
#pragma unroll
                for (int bj = 0; bj < 2; ++bj) { pg8::f32x4 b0, b1; ld8(bp + off + bj * 128, b0, b1);
                    st8(op + off + bj * 128, b0 + g[bj][0] * acc[ai][bj][m][0], b1 + g[bj][1] * acc[ai][bj][m][1]); } }
    }
};
using EpiResid = EpiResidT<float, float>;

struct LatOnlyOrder {
    pg8::StaticOrder lat;
    __device__ void init(int G_, int c_) { lat.init(128 * 256, D, G_, c_); }
    __device__ bool next(int i, pg8::Unit& u) const { const bool ok = lat.next(i, u); u.pm = (u.pm >> 3) * 9 + 1 + (u.pm & 7); return ok; }
    __device__ __forceinline__ void a_ready(const pg8::Unit&) const {}
    __device__ __forceinline__ void done(const pg8::Unit&) const {}
};
struct OutTailOrder {
    int c;
    __device__ void init(int, int c_) { c = c_; }
    __device__ bool next(int i, pg8::Unit& u) const { if (i > 0 || c >= 64) return false; const int x = c & 7, j = c >> 3; u.pm = 128 + 2 * x + (j >> 2); u.pn = j & 3; return true; }
    __device__ __forceinline__ void a_ready(const pg8::Unit&) const {}
    __device__ __forceinline__ void done(const pg8::Unit&) const {}
};
struct L3Order {
    pg8::StaticOrder lat; int G, c;
    __device__ void init(int G_, int c_) { lat.init(64 * 256, 18 * 256, G_, c_); G = G_; c = c_; }
    __device__ bool next(int i, pg8::Unit& u) const {
        const long L = (long)i * G + c;
        if (L < 1152) { const bool ok = lat.next(i, u); u.pm = (u.pm >> 3) * 9 + 1 + (u.pm & 7); return ok; }
        if (L >= 1168) return false;
        const int j = (int)L - 1152; u.pm = (j >> 1) * 9; u.pn = 8 + (j & 1); return true;
    }
    __device__ __forceinline__ void a_ready(const pg8::Unit&) const {}
    __device__ __forceinline__ void done(const pg8::Unit&) const {}
};

__device__ __forceinline__ void transpose_item(const float* W, int K, int N, bf16* WT, LAS float* scr, int item, int lane) {
    const int nblk = N / 32, kb = item / nblk, nb = item % nblk, k0 = 64 * kb, n0 = 32 * nb;
#pragma unroll 8
    for (int i = 0; i < 32; ++i) { const int kk = 2 * i + (lane >> 5); scr[kk * 33 + (lane & 31)] = W[(size_t)(k0 + kk) * N + n0 + (lane & 31)]; }
    LDS_WAIT(); asm volatile("" ::: "memory");
    const int c = lane & 7;
#pragma unroll
    for (int j = 0; j < 4; ++j) { const int n = (lane >> 3) + 8 * j; const LAS float* s = scr + (8 * c) * 33 + n;
        v4u o; o.x = pk2(s[0 * 33], s[1 * 33]); o.y = pk2(s[2 * 33], s[3 * 33]); o.z = pk2(s[4 * 33], s[5 * 33]); o.w = pk2(s[6 * 33], s[7 * 33]);
        *(GAS v4u*)(WT + (size_t)(n0 + n) * K + k0 + 8 * c) = o; }
    LDS_WAIT(); asm volatile("" ::: "memory");
}
__device__ __forceinline__ void wconv(Frame& F0, const float* Win, int Nin, const float* Wout, bf16* WinT, bf16* WoutT, int gw, int NGW) {
    Frame F = fresh(F0);
    LAS float* scr = (LAS float*)(F.lds + F.wave * 16384);
    const int I1 = (D / 64) * (Nin / 32), I2 = (DI / 64) * (D / 32);
    for (int it = gw; it < I1 + I2; it += NGW) { if (it < I1) transpose_item(Win, D, Nin, WinT, scr, it, F.lane); else transpose_item(Wout, DI, D, WoutT, scr, it - I1, F.lane); }
}
template <class XT>
__device__ __forceinline__ void norm_phase(Frame& F0, const XT* xlat, const XT* xctx, const float* g, const float* mod_l, bf16* H, int row_lo = 0, int row_hi = MT, int wg0 = 0) {
    Frame F = fresh(F0);
    const int gw = (wg0 ? (int)blockIdx.x - wg0 : F.vcu) * NWAVES + F.wave, NGW = (F.G - wg0) * NWAVES;
    pg8::f32x4 gg[4];
#pragma unroll
    for (int jj = 0; jj < 4; ++jj) gg[jj] = *(const pg8::f32x4*)(g + F.lane * 8 + 512 * (jj >> 1) + 4 * (jj & 1));
    for (int row0 = row_lo + gw; row0 < row_hi; row0 += 2 * NGW) {
        pg8::f32x4 v[2][4]; const float* mrow[2]; float ss[2] = {0.f, 0.f}; int rowi[2];
#pragma unroll
        for (int u = 0; u < 2; ++u) { int row = row0 + u * NGW; if (row >= row_hi) row = row0; rowi[u] = row;
            const int b = row / RB, rr = row % RB;
            const XT* src = rr < CT ? xctx + ((size_t)b * CT + rr) * D : xlat + ((size_t)b * S + (rr - CT)) * D;
            mrow[u] = mod_l + (size_t)(rr < CT ? 16 : b) * 3072;
#pragma unroll
            for (int j = 0; j < 2; ++j) ld8(src + F.lane * 8 + 512 * j, v[u][2 * j], v[u][2 * j + 1]); }
#pragma unroll
        for (int u = 0; u < 2; ++u) {
#pragma unroll
            for (int jj = 0; jj < 4; ++jj) ss[u] += (v[u][jj][0] * v[u][jj][0] + v[u][jj][1] * v[u][jj][1]) + (v[u][jj][2] * v[u][jj][2] + v[u][jj][3] * v[u][jj][3]);
            const float rstd = rsqrtf(wave_sum(ss[u]) * (1.f / D) + EPS);
#pragma unroll
            for (int j = 0; j < 2; ++j) { const int c = F.lane * 8 + 512 * j; pg8::f32x4 o2[2];
#pragma unroll
                for (int hf = 0; hf < 2; ++hf) { const pg8::f32x4 sc = *(const pg8::f32x4*)(mrow[u] + 1024 + c + 4 * hf), sh = *(const pg8::f32x4*)(mrow[u] + c + 4 * hf);
                    o2[hf] = v[u][2 * j + hf] * rstd * gg[2 * j + hf] * (sc + 1.0f) + sh; }
                st8(H + (size_t)rowi[u] * D + c, o2[0], o2[1]); }
        }
    }
}
__device__ __forceinline__ void final_norm_phase(Frame& F0, float* xs, const float* g) {
    Frame F = fresh(F0);
    const int gw = F.vcu * NWAVES + F.wave, NGW = F.G * NWAVES;
    f32x4 gg[4];
#pragma unroll
    for (int j = 0; j < 4; ++j) gg[j] = *(const f32x4*)(g + F.lane * 4 + 256 * j);
    for (int row0 = gw; row0 < NB * S; row0 += 2 * NGW) {
        f32x4 v[2][4]; float* p[2];
#pragma unroll
        for (int u = 0; u < 2; ++u) { int row = row0 + u * NGW; if (row >= NB * S) row = row0; p[u] = xs + (size_t)row * D;
#pragma unroll
            for (int j = 0; j < 4; ++j) v[u][j] = *(const f32x4*)(p[u] + F.lane * 4 + 256 * j); }
#pragma unroll
        for (int u = 0; u < 2; ++u) { float ss = 0.f;
#pragma unroll
            for (int j = 0; j < 4; ++j) ss += (v[u][j].x * v[u][j].x + v[u][j].y * v[u][j].y) + (v[u][j].z * v[u][j].z + v[u][j].w * v[u][j].w);
            const float rstd = rsqrtf(wave_sum(ss) * (1.f / D) + EPS);
#pragma unroll
            for (int j = 0; j < 4; ++j) { const int c = F.lane * 4 + 256 * j; *(f32x4*)(p[u] + c) = v[u][j] * rstd * gg[j]; } }
    }
}
__device__ __forceinline__ void shw_phase(Frame& F0, const Args& a) {
    Frame F = fresh(F0);
    const float* mod = (const float*)(a.ws + WS_MOD); float* shw = (float*)(a.ws + WS_SHW);
    LAS float* sh = (LAS float*)F.lds;
    LAS float* red = (LAS float*)(F.lds + 69632);
    int cur_l = -1;
    for (int it = blockIdx.x; it < 128 + 128 + 72; it += F.G) {
        const int l = it < 128 ? 0 : (it < 256 ? 1 : 2), cg = it - (l == 0 ? 0 : (l == 1 ? 128 : 256));
        const int N = l == 2 ? 4608 : 8192; const float* W = a.in[l == 0 ? 19 : (l == 1 ? 26 : 29)];
        __syncthreads();
        if (l != cur_l) { for (int i = F.tid; i < 17 * 1024; i += NTHR) sh[i] = mod[((size_t)(l + 1) * 17 + (i >> 10)) * 3072 + (i & 1023)]; cur_l = l; __syncthreads(); }
        float acc[17];
#pragma unroll
        for (int r = 0; r < 17; ++r) acc[r] = 0.f;
        const float* wp = W + (size_t)(F.wave * 128) * N + cg * 64 + F.lane;
#pragma unroll 8
        for (int kk = 0; kk < 128; ++kk) { const float w = wp[(size_t)kk * N];
#pragma unroll
            for (int r = 0; r < 17; ++r) acc[r] += sh[r * 1024 + F.wave * 128 + kk] * w; }
#pragma unroll
        for (int r = 0; r < 17; ++r) red[(F.wave * 17 + r) * 64 + F.lane] = acc[r];
        __syncthreads();
        for (int i = F.tid; i < 17 * 64; i += NTHR) { float sacc = 0.f;
#pragma unroll
            for (int w8 = 0; w8 < 8; ++w8) sacc += red[(w8 * 17 + (i >> 6)) * 64 + (i & 63)];
            shw[((size_t)l * 17 + (i >> 6)) * 8192 + cg * 64 + (i & 63)] = sacc; }
    }
    __syncthreads();
}
__device__ __forceinline__ void prologue_phase(Frame& F0, const Args& a) {
    Frame F = fresh(F0);
    const float* c = a.in[1]; const float* cctx = a.in[3]; const float* w_ada = a.in[5]; const float* b_ada = a.in[6]; float* mod = (float*)(a.ws + WS_MOD);
    if (blockIdx.x < 192) {
        LAS float* st = (LAS float*)F.lds;
        LAS float* red = st + 17 * 1024;
        for (int i = F.tid; i < 17 * 1024; i += NTHR) { const int r = i >> 10, k = i & 1023; st[i] = silu(r < 16 ? c[r * 1024 + k] : cctx[k]); }
        __syncthreads();
        const int l = (int)blockIdx.x / 48, cb = (int)blockIdx.x % 48;
        const float* wp = w_ada + ((size_t)l * 1024 + F.wave * 128) * 3072 + cb * 64 + F.lane;
        LAS const float* sp = st + F.wave * 128;
        float acc[17];
#pragma unroll
        for (int r = 0; r < 17; ++r) acc[r] = 0.f;
#pragma unroll 1
        for (int k0 = 0; k0 < 128; k0 += 16) { float w[16];
#pragma unroll
            for (int kk = 0; kk < 16; ++kk) w[kk] = wp[(size_t)(k0 + kk) * 3072];
#pragma unroll
            for (int kk = 0; kk < 16; kk += 4)
#pragma unroll
                for (int r = 0; r < 17; ++r) { const f32x4 s4 = *(LAS const f32x4*)(sp + r * 1024 + k0 + kk);
                    acc[r] += s4.x * w[kk]; acc[r] += s4.y * w[kk + 1]; acc[r] += s4.z * w[kk + 2]; acc[r] += s4.w * w[kk + 3]; } }
#pragma unroll
        for (int r = 0; r < 17; ++r) red[(F.wave * 17 + r) * 64 + F.lane] = acc[r];
        __syncthreads();
        for (int i = F.tid; i < 17 * 64; i += NTHR) { const int r = i >> 6, j = i & 63; float sacc = 0.f;
#pragma unroll
            for (int w8 = 0; w8 < 8; ++w8) sacc += red[(w8 * 17 + r) * 64 + j];
            mod[((size_t)l * 17 + r) * 3072 + cb * 64 + j] = sacc + b_ada[l * 3072 + cb * 64 + j]; }
    }
    if (blockIdx.x == 192) {
        float* rope = (float*)(a.ws + WS_ROPE);
        for (int i = F.tid; i < 64 * 16; i += NTHR) { const int pos = i >> 4, j = i & 15; const float inv = powf(10000.f, -(float)j / 16.f), ang = (float)pos * inv; rope[2 * i] = cosf(ang); rope[2 * i + 1] = sinf(ang); }
    } else if (blockIdx.x > 192 && blockIdx.x < 225) {
        bf16* W2 = (bf16*)(a.ws + WS_WG2); const float* wq = a.in[11]; const float* wk = a.in[12]; const float* wv = a.in[13]; const float* wg = a.in[14];
        for (int i = (blockIdx.x - 193) * NTHR + F.tid; i < 32 * 4096; i += 32 * NTHR) { const int n = i >> 12, k = i & 4095; float s = 0.f;
            if (k < 2048) { const int gq = k >> 2, ii = k & 3;
#pragma unroll
                for (int j = 0; j < 4; ++j) s += wq[(gq * 4 + ii) * 4 + j] * wg[(size_t)(gq * 4 + j) * 32 + n] + wk[(gq * 4 + ii) * 4 + j] * wg[(size_t)(2048 + gq * 4 + j) * 32 + n]; }
            else { const int kk = k - 2048, gq = kk >> 2, ii = kk & 3;
#pragma unroll
                for (int j = 0; j < 4; ++j) s += wv[(gq * 4 + ii) * 4 + j] * wg[(size_t)(4096 + gq * 4 + j) * 32 + n]; }
            W2[i] = (bf16)f2bf(s); }
    }
}
__device__ __forceinline__ void prologue2_phase(Frame& F0, const Args& a) {
    Frame F = fresh(F0);
    const float* part = (const float*)(a.ws + WS_QG); const float* b_ada = a.in[6]; float* mod = (float*)(a.ws + WS_MOD);
    for (int o = blockIdx.x * NTHR + F.tid; o < 4 * 17 * 3072; o += F.G * NTHR) {
        const int l = o / (17 * 3072), rn = o % (17 * 3072), n = rn % 3072;
        const float* pp = part + (size_t)l * 64 * 17 * 3072 + rn; float s0 = 0.f, s1 = 0.f, s2 = 0.f, s3 = 0.f;
#pragma unroll
        for (int sl = 0; sl < 64; sl += 16) { float v[16];
#pragma unroll
            for (int j = 0; j < 16; ++j) v[j] = pp[(size_t)(sl + j) * 17 * 3072];
#pragma unroll
            for (int j = 0; j < 16; j += 4) { s0 += v[j]; s1 += v[j + 1]; s2 += v[j + 2]; s3 += v[j + 3]; } }
        mod[o] = ((s0 + s1) + (s2 + s3)) + b_ada[l * 3072 + n];
    }
}
}
namespace att {
using mk::bf16; using mk::bf16x8; using mk::s16x4; using mk::f32x16; using mk::u32x4; using mk::u32x2;
typedef short v4i16_t __attribute__((ext_vector_type(4)));
typedef float f32x2_t __attribute__((ext_vector_type(2))); typedef __bf16 bf16x2_t __attribute__((ext_vector_type(2)));
__device__ __forceinline__ int crow(int r, int hi) { return (r & 3) + 8 * (r >> 2) + 4 * hi; }
__device__ __forceinline__ unsigned cvtpk(float lo, float hi) { f32x2_t v = {lo, hi}; bf16x2_t b = __builtin_convertvector(v, bf16x2_t); return __builtin_bit_cast(unsigned, b); }
__device__ __forceinline__ s16x4 vtr(LAS const unsigned char* p) { return __builtin_bit_cast(s16x4, __builtin_amdgcn_ds_read_tr16_b64_v4i16((LAS v4i16_t*)p)); }
__device__ __forceinline__ float ex2(float x) { return __builtin_amdgcn_exp2f(x); }
__device__ __forceinline__ float max3f(float a, float b, float c) { float r; asm("v_max3_f32 %0, %1, %2, %3" : "=v"(r) : "v"(a), "v"(b), "v"(c)); return r; }
#define ATT_SB() __builtin_amdgcn_sched_barrier(0)

struct Src { const bf16* K[2]; const bf16* V; int ldk, ldv; };

template <int DV, int NCOMP> struct Stage { u32x4 kr[NCOMP]; u32x4 vr[DV / 64]; };
template <int DV, int NCOMP>
__device__ __forceinline__ void stage_load(Stage<DV, NCOMP>& st, const Src& s, size_t row, int wid, int lane) {
#pragma unroll
    for (int c = 0; c < NCOMP; ++c) st.kr[c] = *(const u32x4*)(s.K[c] + (row + lane) * s.ldk + wid * 8);
#pragma unroll
    for (int i = 0; i < DV / 64; ++i) { const int p = wid + 8 * i, d0 = p >> 2, kg = p & 3; st.vr[i] = *(const u32x4*)(s.V + (row + 16 * kg + (lane >> 2)) * s.ldv + d0 * 32 + (lane & 3) * 8); }
}
template <int DV, int NCOMP>
__device__ __forceinline__ void stage_store(const Stage<DV, NCOMP>& st, LAS unsigned char* buf, int wid, int lane) {
#pragma unroll
    for (int c = 0; c < NCOMP; ++c) *(LAS u32x4*)(buf + c * 8192 + wid * 1024 + lane * 16) = st.kr[c];
#pragma unroll
    for (int i = 0; i < DV / 64; ++i) *(LAS u32x4*)(buf + NCOMP * 8192 + (wid + 8 * i) * 1024 + lane * 16) = st.vr[i];
}
__device__ __forceinline__ void glds16(const void* gsrc, unsigned lds_dst) { unsigned keep;
    asm volatile("s_mov_b32 %0, m0\n\ts_mov_b32 m0, %2\n\ts_nop 0\n\tglobal_load_lds_dwordx4 %1, off\n\ts_mov_b32 m0, %0" : "=&s"(keep) : "v"(gsrc), "s"(lds_dst) : "memory"); }
__device__ __forceinline__ unsigned long long uni64(const void* p) { const unsigned long long a = (unsigned long long)p;
    return ((unsigned long long)(unsigned)__builtin_amdgcn_readfirstlane((unsigned)(a >> 32)) << 32) | (unsigned)__builtin_amdgcn_readfirstlane((unsigned)a); }
__device__ __forceinline__ void glds16s(const void* sbase_, unsigned voff, unsigned lds_dst) { unsigned keep; const unsigned long long sbase = uni64(sbase_);
    asm volatile("s_mov_b32 %0, m0\n\ts_mov_b32 m0, %3\n\ts_nop 0\n\tglobal_load_lds_dwordx4 %1, %2\n\ts_mov_b32 m0, %0" : "=&s"(keep) : "v"(voff), "s"(sbase), "s"(lds_dst) : "memory"); }
template <int DV, int NCOMP>
__device__ __forceinline__ void dma_issue(const Src& s, size_t row, LAS unsigned char* buf, int wid, int lane) {
    const unsigned b0 = (unsigned)(size_t)buf;
    const int kl = lane >> 3;
    const unsigned ko = (unsigned)(kl * s.ldk + (((lane & 7) ^ ((4 * (wid & 1) + (kl >> 1)) & 7)) * 8)) * 2u, vo = (unsigned)((16 * (wid & 3) + (lane >> 2)) * s.ldv + (lane & 3) * 8) * 2u;
#pragma unroll
    for (int c = 0; c < NCOMP; ++c) glds16s(s.K[c] + (row + 8 * wid) * s.ldk, ko, (unsigned)__builtin_amdgcn_readfirstlane(b0 + c * 8192 + wid * 1024));
#pragma unroll
    for (int i = 0; i < DV / 64; ++i) { const int p = wid + 8 * i, d0 = p >> 2;
        glds16s(s.V + row * s.ldv + d0 * 32, vo, (unsigned)__builtin_amdgcn_readfirstlane(b0 + NCOMP * 8192 + p * 1024)); }
}
#define ATT_WAIT_BAR(N) asm volatile("s_waitcnt vmcnt(" #N ") lgkmcnt(0)\n\ts_barrier" ::: "memory")
template <int NL> __device__ __forceinline__ void wait_bar_keep() { if constexpr (NL == 2) ATT_WAIT_BAR(2); else if constexpr (NL == 4) ATT_WAIT_BAR(4); else static_assert(NL == 2 || NL == 4, "pieces per wave"); }
__device__ __forceinline__ void qk_tile(LAS const unsigned char* kimg, const bf16x8 (&qf)[4], int r32, int hi, f32x16& p0, f32x16& p1, const f32x16& z, const f32x16& z1  ) {
    const int sw = (r32 >> 1) & 7, u16 = (sw & 6) * 16;
    LAS const unsigned char* kb = kimg + r32 * 128 + ((hi ^ sw) & 1) * 16;
    LAS const unsigned char* ka[4] = {kb + (0 ^ u16), kb + (32 ^ u16), kb + (64 ^ u16), kb + (96 ^ u16)};
#define ATT_KRD(i) (*(LAS const bf16x8*)(ka[(i) >> 1] + ((i) & 1) * 4096))
    bf16x8 f0 = ATT_KRD(0), f1 = ATT_KRD(1), f2;
    f2 = ATT_KRD(2); ATT_SB(); p0 = __builtin_amdgcn_mfma_f32_32x32x16_bf16(f0, qf[0], z, 0, 0, 0);
    f0 = ATT_KRD(3); ATT_SB(); p1 = __builtin_amdgcn_mfma_f32_32x32x16_bf16(f1, qf[0], z1, 0, 0, 0);
    f1 = ATT_KRD(4); ATT_SB(); p0 = __builtin_amdgcn_mfma_f32_32x32x16_bf16(f2, qf[1], p0, 0, 0, 0);
    f2 = ATT_KRD(5); ATT_SB(); p1 = __builtin_amdgcn_mfma_f32_32x32x16_bf16(f0, qf[1], p1, 0, 0, 0);
    f0 = ATT_KRD(6); ATT_SB(); p0 = __builtin_amdgcn_mfma_f32_32x32x16_bf16(f1, qf[2], p0, 0, 0, 0);
    f1 = ATT_KRD(7); ATT_SB(); p1 = __builtin_amdgcn_mfma_f32_32x32x16_bf16(f2, qf[2], p1, 0, 0, 0);
    ATT_SB(); p0 = __builtin_amdgcn_mfma_f32_32x32x16_bf16(f0, qf[3], p0, 0, 0, 0);
    ATT_SB(); p1 = __builtin_amdgcn_mfma_f32_32x32x16_bf16(f1, qf[3], p1, 0, 0, 0);
#undef ATT_KRD
}
template <int DV>
__device__ __forceinline__ void softmax_tile(f32x16& p0, f32x16& p1, f32x16 (&o)[DV / 32], float& m, float& l, u32x4 (&pw)[4]) {
    float mxa = max3f(p0[0], p0[1], p1[0]), mxb = max3f(p0[2], p0[3], p1[1]); mxa = max3f(mxa, p1[2], p1[3]);
#pragma unroll
    for (int r = 4; r < 16; r += 4) { mxa = max3f(mxa, p0[r], p0[r + 1]); mxb = max3f(mxb, p0[r + 2], p0[r + 3]); mxa = max3f(mxa, p1[r], p1[r + 1]); mxb = max3f(mxb, p1[r + 2], p1[r + 3]); }
    const float mx0 = max3f(mxa, mxb, mxb);
    const float mn = max3f(m, mx0, __shfl_xor(mx0, 32)), alpha = ex2(m - mn);
    float ls = 0.f;
#pragma unroll
    for (int r = 0; r < 16; ++r) { p0[r] = ex2(p0[r] - mn); p1[r] = ex2(p1[r] - mn); ls += p0[r] + p1[r]; }
    l = l * alpha + ls;
    if (__any(mn != m)) {
#pragma unroll
        for (int d0 = 0; d0 < DV / 32; ++d0)
#pragma unroll
            for (int r = 0; r < 16; ++r) o[d0][r] *= alpha;
    }
    m = mn;
#pragma unroll
    for (int ks = 0; ks < 4; ++ks) { const int b = 8 * (ks & 1);
        if (ks < 2) { pw[ks].x = cvtpk(p0[b], p0[b + 1]); pw[ks].y = cvtpk(p0[b + 2], p0[b + 3]); pw[ks].z = cvtpk(p0[b + 4], p0[b + 5]); pw[ks].w = cvtpk(p0[b + 6], p0[b + 7]); }
        else { pw[ks].x = cvtpk(p1[b], p1[b + 1]); pw[ks].y = cvtpk(p1[b + 2], p1[b + 3]); pw[ks].z = cvtpk(p1[b + 4], p1[b + 5]); pw[ks].w = cvtpk(p1[b + 6], p1[b + 7]); } }
}
template <int DV>
__device__ __forceinline__ void pv_tile(LAS const unsigned char* vimg, int lane, int hi, const u32x4 (&pw)[4], f32x16 (&o)[DV / 32]) {
    LAS const unsigned char* vb = vimg + ((lane >> 4) & 1) * 32 + (lane & 3) * 8 + (4 * hi + ((lane & 15) >> 2)) * 64;
    constexpr int ND = DV / 32, NF = 4 * ND;
    constexpr int PD = 4, NB_ = PD + 1;
    s16x4 lo[NB_], hi4[NB_];
#define ATT_VRD(i, b) do { lo[b] = vtr(vb + ((i) % ND) * 4096 + ((i) / ND) * 1024); hi4[b] = vtr(vb + ((i) % ND) * 4096 + ((i) / ND) * 1024 + 512); } while (0)
#pragma unroll
    for (int i = 0; i < PD; ++i) ATT_VRD(i, i);
#pragma unroll
    for (int i = 0; i < NF; ++i) {
        if (i + PD < NF) ATT_VRD(i + PD, (i + PD) % NB_);
        ATT_SB();
        const int b = i % NB_;
        const bf16x8 vf = {lo[b][0], lo[b][1], lo[b][2], lo[b][3], hi4[b][0], hi4[b][1], hi4[b][2], hi4[b][3]};
        o[i % ND] = __builtin_amdgcn_mfma_f32_32x32x16_bf16(vf, __builtin_bit_cast(bf16x8, pw[i / ND]), o[i % ND], 0, 0, 0);
    }
#undef ATT_VRD
}

struct SmState { float mxa, mxb, mn, alpha, ls, delta; bool resc; };
template <int NM>
__device__ __forceinline__ void negm_shift(f32x16 (&negm)[NM], float delta) {
#pragma unroll
    for (int i = 0; i < NM; ++i)
#pragma unroll
        for (int r = 0; r < 16; ++r) negm[i][r] -= delta;
}
__device__ __forceinline__ float xmax32(float v) { auto rr = __builtin_amdgcn_permlane32_swap(__float_as_uint(v), __float_as_uint(v), false, false); return max3f(__uint_as_float(rr[0]), __uint_as_float(rr[1]), v); }
template <int SK> __device__ __forceinline__ constexpr bool sm_live0(int r) { return SK != 2 || r >= 12; }
template <int SK> __device__ __forceinline__ constexpr bool sm_live1(int r) { return SK != 1 || r < 4; }
template <int SK = 0>
__device__ __forceinline__ void sm_slice(int k, f32x16& p0, f32x16& p1, float& m, float& l, SmState& s, u32x4 (&pwn)[4]) {
    if (k <= 3) { const int r = 4 * k;
        if (SK == 0 && k == 0) { s.mxa = max3f(p0[0], p0[1], p1[0]); s.mxb = max3f(p0[2], p0[3], p1[1]); s.mxa = max3f(s.mxa, p1[2], p1[3]); }
        else { if (k == 0) { s.mxa = -INFINITY; s.mxb = -INFINITY; }
            if (sm_live0<SK>(r)) { s.mxa = max3f(s.mxa, p0[r], p0[r + 1]); s.mxb = max3f(s.mxb, p0[r + 2], p0[r + 3]); }
            if (sm_live1<SK>(r)) { s.mxa = max3f(s.mxa, p1[r], p1[r + 1]); s.mxb = max3f(s.mxb, p1[r + 2], p1[r + 3]); } }
        asm volatile("" : "+v"(s.mxa), "+v"(s.mxb)); }
    else if (k == 4) { const float mx0 = xmax32(max3f(s.mxa, s.mxb, s.mxb)); const bool first = m == -INFINITY;
        const float delta = (first || mx0 > 8.f) ? mx0 : 0.f; s.delta = delta; s.mn = first ? mx0 : m + delta; s.alpha = ex2(-delta); s.resc = __any(delta != 0.f); l *= s.alpha; s.ls = 0.f;
        if (s.resc) {
#pragma unroll
            for (int r = 0; r < 16; ++r) { p0[r] -= delta; p1[r] -= delta; }
        }
        asm volatile("" : "+v"(s.mn), "+v"(s.alpha), "+v"(l)); }
    else if (k <= 12) { const int j = 2 * (k - 5);
        if (sm_live0<SK>(j)) { p0[j] = ex2(p0[j]); p0[j + 1] = ex2(p0[j + 1]); s.ls += p0[j] + p0[j + 1]; }
        if (sm_live1<SK>(j)) { p1[j] = ex2(p1[j]); p1[j + 1] = ex2(p1[j + 1]); s.ls += p1[j] + p1[j + 1]; }
        asm volatile("" : "+v"(p0), "+v"(p1), "+v"(s.ls)); }
    else if (k == 13) {
        if (SK == 2) { pwn[0] = u32x4{0u, 0u, 0u, 0u}; pwn[1].x = 0u; pwn[1].y = 0u; }
        else { pwn[0].x = cvtpk(p0[0], p0[1]); pwn[0].y = cvtpk(p0[2], p0[3]); pwn[0].z = cvtpk(p0[4], p0[5]); pwn[0].w = cvtpk(p0[6], p0[7]); pwn[1].x = cvtpk(p0[8], p0[9]); pwn[1].y = cvtpk(p0[10], p0[11]); }
        pwn[1].z = cvtpk(p0[12], p0[13]); pwn[1].w = cvtpk(p0[14], p0[15]); asm volatile("" : "+v"(pwn[0]), "+v"(pwn[1])); }
    else if (k == 14) { pwn[2].x = cvtpk(p1[0], p1[1]); pwn[2].y = cvtpk(p1[2], p1[3]);
        if (SK == 1) { pwn[2].z = 0u; pwn[2].w = 0u; pwn[3] = u32x4{0u, 0u, 0u, 0u}; }
        else { pwn[2].z = cvtpk(p1[4], p1[5]); pwn[2].w = cvtpk(p1[6], p1[7]); pwn[3].x = cvtpk(p1[8], p1[9]); pwn[3].y = cvtpk(p1[10], p1[11]); pwn[3].z = cvtpk(p1[12], p1[13]); pwn[3].w = cvtpk(p1[14], p1[15]); }
        asm volatile("" : "+v"(pwn[2]), "+v"(pwn[3])); }
    else { l += s.ls; asm volatile("" : "+v"(l)); }
}
template <int DV, int NM, int SK = 0>
__device__ __forceinline__ void sm_alone(f32x16& p0, f32x16& p1, f32x16 (&o)[DV / 32], float& m, float& l, u32x4 (&pwn)[4], f32x16 (&negm)[NM]) {
    SmState s;
#pragma unroll
    for (int k = 0; k < 16; ++k) sm_slice<SK>(k, p0, p1, m, l, s, pwn);
    if (s.resc) {
#pragma unroll
        for (int d0 = 0; d0 < DV / 32; ++d0)
#pragma unroll
            for (int r = 0; r < 16; ++r) o[d0][r] *= s.alpha;
        negm_shift<NM>(negm, s.delta);
    }
    m = s.mn;
}
template <int DV, int NM, int SK = 0>
__device__ __forceinline__ void pv_sm_tile(LAS const unsigned char* vimg, int lane, int hi, const u32x4 (&pw)[4], f32x16 (&o)[DV / 32], f32x16& p0, f32x16& p1, float& m, float& l, u32x4 (&pwn)[4], f32x16 (&negm)[NM]) {
    LAS const unsigned char* vb = vimg + ((lane >> 4) & 1) * 32 + (lane & 3) * 8 + (4 * hi + ((lane & 15) >> 2)) * 64;
    constexpr int ND = DV / 32, NF = 4 * ND, PD = 3, NB_ = PD + 1, SPM = 16 / NF;
    s16x4 lo[NB_], hi4[NB_];
    SmState s;
#define ATT_VRD(i, b) do { lo[b] = vtr(vb + ((i) % ND) * 4096 + ((i) / ND) * 1024); hi4[b] = vtr(vb + ((i) % ND) * 4096 + ((i) / ND) * 1024 + 512); } while (0)
#pragma unroll
    for (int i = 0; i < PD; ++i) ATT_VRD(i, i);
#pragma unroll
    for (int i = 0; i < NF; ++i) {
        if (i + PD < NF) ATT_VRD(i + PD, (i + PD) % NB_);
        ATT_SB();
        const int b = i % NB_;
        const bf16x8 vf = {lo[b][0], lo[b][1], lo[b][2], lo[b][3], hi4[b][0], hi4[b][1], hi4[b][2], hi4[b][3]};
        o[i % ND] = __builtin_amdgcn_mfma_f32_32x32x16_bf16(vf, __builtin_bit_cast(bf16x8, pw[i / ND]), o[i % ND], 0, 0, 0);
#pragma unroll
        for (int k = i * SPM; k < (i + 1) * SPM; ++k) sm_slice<SK>(k, p0, p1, m, l, s, pwn);
        ATT_SB();
    }
#undef ATT_VRD
    if (s.resc) {
#pragma unroll
        for (int d0 = 0; d0 < ND; ++d0)
#pragma unroll
            for (int r = 0; r < 16; ++r) o[d0][r] *= s.alpha;
        negm_shift<NM>(negm, s.delta);
    }
    m = s.mn;
}

__device__ __forceinline__ void wait_bar_tiles2(int c) {
    if (c >= 5) ATT_WAIT_BAR(10); else if (c == 4) ATT_WAIT_BAR(8); else if (c == 3) ATT_WAIT_BAR(6); else if (c == 2) ATT_WAIT_BAR(4); else if (c == 1) ATT_WAIT_BAR(2); else ATT_WAIT_BAR(0);
}
template <int DV, class Pol, int NS = 4>
__device__ __forceinline__ void run_unit1(LAS unsigned char* lds, const Pol& P, const Src& src, const bf16* Q, int ldq, int wid, int lane) {
    const int r32 = lane & 31, hi = lane >> 5;
    constexpr int STG = 8192 + DV * 128, NL = 1 + DV / 64, LA = NS - 2;
    static_assert(NL == 2 && LA <= 6, "wait_bar_tiles2 counts two-piece tiles");
    const int nt = P.ntiles();
#pragma unroll
    for (int t = 0; t < LA; ++t) if (t < nt) dma_issue<DV, 1>(src, P.tile_row(t), lds + t * STG, wid, lane);
    bf16x8 qf[4];
    { const bf16* qp = Q + (size_t)(wid * 32 + r32) * ldq + hi * 8;
#pragma unroll
      for (int d0 = 0; d0 < 4; ++d0) qf[d0] = *(const bf16x8*)(qp + d0 * 16); }
    f32x16 o[DV / 32];
#pragma unroll
    for (int d0 = 0; d0 < DV / 32; ++d0) o[d0] = f32x16{};
    float m = -INFINITY, l = 0.f; f32x16 negm[1] = {f32x16{}};
    u32x4 pw[4], pwn[4]; bool pend = false;
    asm volatile("" : "+v"(qf[0]), "+v"(qf[1]), "+v"(qf[2]), "+v"(qf[3]));
    ATT_WAIT_BAR(0);
    int ic = 0;
    for (int ti = 0; ti < nt; ++ti) {
        LAS unsigned char* cur = lds + ic * STG; LAS unsigned char* prv = lds + ((ic + NS - 1) & (NS - 1)) * STG;
        if (ti + LA < nt) dma_issue<DV, 1>(src, P.tile_row(ti + LA), lds + ((ic + LA) & (NS - 1)) * STG, wid, lane);
        if (P.needs(ti, wid)) {
            f32x16 p0, p1;
            qk_tile(cur, qf, r32, hi, p0, p1, negm[0], negm[0]);
            P.mask(ti, wid, r32, hi, p0, p1);
            if (pend) pv_sm_tile<DV, 1>(prv + 8192, lane, hi, pw, o, p0, p1, m, l, pwn, negm); else sm_alone<DV, 1>(p0, p1, o, m, l, pwn, negm);
#pragma unroll
            for (int k = 0; k < 4; ++k) pw[k] = pwn[k];
            pend = true;
        } else if (pend) { pv_tile<DV>(prv + 8192, lane, hi, pw, o); pend = false; }
        wait_bar_tiles2(min(ti + LA, nt - 1) - (ti + 1));
        ic = (ic + 1) & (NS - 1);
    }
    if (pend) pv_tile<DV>(lds + ((ic + NS - 1) & (NS - 1)) * STG + 8192, lane, hi, pw, o);
    P.finish(o, m, l, wid, r32, hi);
    ATT_WAIT_BAR(0);
}
constexpr int ZQ_Z = 65536, ZQ_Q = 98304;
__device__ __forceinline__ void glds4s(const void* sbase_, unsigned voff, unsigned lds_dst) { unsigned keep; const unsigned long long sbase = uni64(sbase_);
    asm volatile("s_mov_b32 %0, m0\n\ts_mov_b32 m0, %3\n\ts_nop 0\n\tglobal_load_lds_dword %1, %2\n\ts_mov_b32 m0, %0" : "=&s"(keep) : "v"(voff), "s"(sbase), "s"(lds_dst) : "memory"); }
__device__ __forceinline__ void dma_rows64(const bf16* base, int ld, LAS unsigned char* dst, int lane) {
    const unsigned vo = (unsigned)((lane & 31) * ld + (lane >> 5) * 8) * 2u;
    const unsigned b0 = (unsigned)(size_t)dst;
#pragma unroll
    for (int j = 0; j < 4; ++j) glds16s(base + j * 16, vo, (unsigned)__builtin_amdgcn_readfirstlane(b0 + j * 1024));
}
template <class Pol, int SKL  , class Ctx, class Gen>
__device__ __forceinline__ void run_stream1(LAS unsigned char* lds, const Ctx& C, const Gen& gen, int wid_, int lane_) {
    constexpr int DV = 64, STG = 16384, EX = Pol::EXTRA;
    static_assert(EX == 4 || EX == 5, "first-step wait counts");
    int lane = lane_, wid = wid_;
#define ZL_ (lds + ZQ_Z + wid * 4096)
#define QL_ (lds + ZQ_Q + wid * 4096)
    Pol P;
    if (!gen(0, P)) return;
    dma_rows64(P.qrow(C, wid), mk::DI, QL_, lane);
    dma_issue<DV, 1>(P.src(C), P.tile_row(0), lds, wid, lane);
    dma_issue<DV, 1>(P.src(C), P.tile_row(1), lds + STG, wid, lane);
    ATT_WAIT_BAR(0);
    int ic = 0;
    for (int i = 0;; ++i) {
        Pol Pn; const bool hn = gen(i + 1, Pn);
        asm volatile("" : "+v"(lane), "+s"(wid));
        bf16x8 qf[4];
#pragma unroll
        for (int d0 = 0; d0 < 4; ++d0) qf[d0] = *(LAS const bf16x8*)(QL_ + d0 * 1024 + lane * 16);
        asm volatile("" : "+v"(qf[0]), "+v"(qf[1]), "+v"(qf[2]), "+v"(qf[3]));
        const int nt = P.ntiles();
        f32x16 o[2] = {f32x16{}, f32x16{}};
        float m = -INFINITY, l = 0.f; f32x16 negm[Pol::NM];
#pragma unroll
        for (int i_ = 0; i_ < Pol::NM; ++i_) negm[i_] = f32x16{};
        u32x4 pw[4], pwn[4]; bool pend = false;
        auto steps = [&](auto skc, int t0, int t1) {
          constexpr int SK_ = decltype(skc)::value;
          for (int ti = t0; ti < t1; ++ti) {
            LAS unsigned char* cur = lds + ic * STG; LAS unsigned char* prv = lds + ((ic + 3) & 3) * STG; LAS unsigned char* nxt = lds + ((ic + 2) & 3) * STG;
            asm volatile("" : "+v"(lane), "+s"(wid)); const int r32 = lane & 31, hi = lane >> 5;
            if (ti == 0) { P.stage_extra(C, ZL_, wid, lane); if (hn) dma_rows64(Pn.qrow(C, wid), mk::DI, QL_, lane); }
            bool issued = true;
            if (ti + 2 < nt) dma_issue<DV, 1>(P.src(C), P.tile_row(ti + 2), nxt, wid, lane);
            else if (hn) dma_issue<DV, 1>(Pn.src(C), Pn.tile_row(ti + 2 - nt), nxt, wid, lane);
            else issued = false;
            P.prep(ti, wid, r32, hi, negm);
            if (P.needs(ti, wid)) {
                f32x16 p0, p1;
                qk_tile(cur, qf, r32, hi, p0, p1, negm[0], negm[Pol::NM - 1]);
                P.template mask<SK_>(C, ti, wid, r32, hi, p0, p1);
                if (pend) pv_sm_tile<DV, Pol::NM, SK_>(prv + 8192, lane, hi, pw, o, p0, p1, m, l, pwn, negm); else sm_alone<DV, Pol::NM, SK_>(p0, p1, o, m, l, pwn, negm);
#pragma unroll
                for (int k = 0; k < 4; ++k) pw[k] = pwn[k];
                pend = true;
            } else if (pend) { pv_tile<DV>(prv + 8192, lane, hi, pw, o); pend = false; }
            if (ti == 0) { if constexpr (EX == 4) { if (hn) ATT_WAIT_BAR(10); else ATT_WAIT_BAR(6); } else { if (hn) ATT_WAIT_BAR(11); else ATT_WAIT_BAR(7); } }
            else if (issued) ATT_WAIT_BAR(2); else ATT_WAIT_BAR(0);
            ic = (ic + 1) & 3;
          }
        };
        if constexpr (SKL == 0) steps(std::integral_constant<int, 0>{}, 0, nt);
        else { steps(std::integral_constant<int, 0>{}, 0, 4);
            steps(std::integral_constant<int, SKL>{}, 4, nt); }
        asm volatile("" : "+v"(lane), "+s"(wid)); const int r32 = lane & 31, hi = lane >> 5;
        if (pend) pv_tile<DV>(lds + ((ic + 3) & 3) * STG + 8192, lane, hi, pw, o);
        P.finish(C, o, m, l, wid, r32, hi, ZL_);
        if (!hn) break;
        P = Pn;
    }
    ATT_WAIT_BAR(0);
#undef ZL_
#undef QL_
}
}
namespace mk {
using att::Src; using att::crow; using att::ex2;

template <int DV>
__device__ __forceinline__ void store_gated(const f32x16 (&o)[DV / 32], float inv, const bf16* zrow, bf16* grow, int hi) {
#pragma unroll
    for (int d0 = 0; d0 < DV / 32; ++d0)
#pragma unroll
        for (int i = 0; i < 4; ++i) { const int d = 32 * d0 + 8 * i + 4 * hi;
            const u32x2 zw = *(const u32x2*)(zrow + d);
            const float v0 = o[d0][4 * i] * inv * silu(bflo(zw.x)), v1 = o[d0][4 * i + 1] * inv * silu(bfhi(zw.x)), v2 = o[d0][4 * i + 2] * inv * silu(bflo(zw.y)), v3 = o[d0][4 * i + 3] * inv * silu(bfhi(zw.y));
            u32x2 w; w.x = att::cvtpk(v0, v1); w.y = att::cvtpk(v2, v3); *(u32x2*)(grow + d) = w; }
}

__device__ __forceinline__ void store_gated_l(const f32x16 (&o)[2], float inv, LAS unsigned char* zl, bf16* gwave  , int r32, int hi) {
#pragma unroll
    for (int d0 = 0; d0 < 2; ++d0)
#pragma unroll
        for (int i = 0; i < 4; ++i) {
            LAS u32x2* zp = (LAS u32x2*)(zl + (2 * d0 + (i >> 1)) * 1024 + (r32 + 32 * (i & 1)) * 16 + 8 * hi);
            const u32x2 zw = *zp;
            const float v0 = o[d0][4 * i] * inv * silu(bflo(zw.x)), v1 = o[d0][4 * i + 1] * inv * silu(bfhi(zw.x)), v2 = o[d0][4 * i + 2] * inv * silu(bflo(zw.y)), v3 = o[d0][4 * i + 3] * inv * silu(bfhi(zw.y));
            u32x2 w; w.x = att::cvtpk(v0, v1); w.y = att::cvtpk(v2, v3); *zp = w; }
    const int lane = r32 + 32 * hi, c8 = lane & 7;
#pragma unroll
    for (int k = 0; k < 4; ++k) { const int row = 8 * k + (lane >> 3);
        const u32x4 v = *(LAS const u32x4*)(zl + (c8 >> 1) * 1024 + (row + 32 * (c8 & 1)) * 16);
        *(u32x4*)(gwave + (size_t)row * DI + c8 * 8) = v; }
}

struct AttCtx { const bf16* QG; const bf16* Kb; const bf16* Vb; const bf16* Zb; const float* aux; LAS const float* tab; int dry; };
struct SwaPol {
    static constexpr int EXTRA = 4, NM = 1;
    int bl, hq, qb, tl0, ntl; float sinkl2;
    __device__ __forceinline__ size_t off() const { return ((size_t)bl * RB + CT + qb * 256) * DI + hq * 64; }
    __device__ __forceinline__ Src src(const AttCtx& C) const { Src s; s.K[0] = C.Kb + (hq >> 3) * 64; s.K[1] = nullptr; s.V = C.Vb + (hq >> 3) * 64; s.ldk = 256; s.ldv = 256; return s; }
    __device__ __forceinline__ void prep(int, int, int, int, f32x16 (&)[1]) const {}
    __device__ __forceinline__ int ntiles() const { return 4 + ntl; }
    __device__ __forceinline__ const bf16* qrow(const AttCtx& C, int wid) const { return C.QG + off() + (size_t)(wid * 32) * DI; }
    __device__ __forceinline__ void stage_extra(const AttCtx& C, LAS unsigned char* zl, int wid, int lane) const { att::dma_rows64(C.Zb + off() + (size_t)(wid * 32) * DI, DI, zl, lane); }
    __device__ __forceinline__ size_t tile_row(int ti) const { return (size_t)bl * RB + (ti < 4 ? 64 * ti : CT + 64 * (tl0 + ti - 4)); }
    __device__ __forceinline__ bool needs(int ti, int wid) const { if (ti < 4) return true; const int kt0 = 64 * (tl0 + ti - 4), qw0 = qb * 256 + 32 * wid; return kt0 <= qw0 + 31 + 128 && kt0 + 63 >= qw0 - 128; }
    __device__ __forceinline__ int skip(int, int) const { return 0; }
    template <int SK> __device__ __forceinline__ void mask(const AttCtx&, int ti, int wid, int r32, int hi, f32x16& p0, f32x16& p1) const {
        if (ti < 4) return;
        const int kt0 = 64 * (tl0 + ti - 4), qw0 = qb * 256 + 32 * wid;
        if (kt0 >= qw0 + 31 - 128 && kt0 + 63 <= qw0 + 128) return;
        const int qt = qw0 + r32;
#pragma unroll
        for (int r = 0; r < 16; ++r) { const int kt = kt0 + crow(r, hi); int d0 = kt - qt; d0 = d0 < 0 ? -d0 : d0; int d1 = kt + 32 - qt; d1 = d1 < 0 ? -d1 : d1;
            if (d0 > 128) p0[r] = -INFINITY; if (d1 > 128) p1[r] = -INFINITY; }
    }
    __device__ __forceinline__ void finish(const AttCtx& C, f32x16 (&o)[2], float m, float l, int wid, int r32, int hi, LAS unsigned char* zl) const {
        const float mn = fmaxf(m, sinkl2), alpha = ex2(m - mn);
        const float lt = (l + __shfl_xor(l, 32)) * alpha + ex2(sinkl2 - mn);
        const float inv = alpha * __builtin_amdgcn_rcpf(lt);
        if (!C.dry) store_gated_l(o, inv, zl, (bf16*)C.QG + off() + (size_t)(wid * 32) * DI, r32, hi);
    }
};
__device__ __forceinline__ void swa_phase(Frame& F, const Args& a, int g, int dry) {
    int lane_ = pg8::hw_lane(), wave_ = F.wave; asm volatile("" : "+v"(lane_), "+s"(wave_));
    AttCtx C; C.QG = (const bf16*)(a.ws + WS_QG) + (size_t)g * MH * DI; C.Kb = (const bf16*)(a.ws + WS_S2); C.Vb = C.Kb + (size_t)MH * 256; C.Zb = (const bf16*)(a.ws + WS_S4); C.aux = a.in[30]; C.tab = nullptr; C.dry = dry;
    const int G = F.G, vcu = F.vcu;
    auto gen = [&](int i, SwaPol& P) -> bool {
        const int id = i * G + vcu; if (id >= HB * 32 * 8) return false;
        P.qb = (id + i) & 7; P.hq = (id >> 3) & 31; P.bl = id >> 8;
        P.tl0 = max(0, 4 * P.qb - 2); P.ntl = min(31, 4 * P.qb + 5) - P.tl0 + 1; P.sinkl2 = C.aux[P.hq] * LOG2E;
        return true; };
    att::run_stream1<SwaPol, 0>(F.lds, C, gen, wave_, lane_);
}

constexpr int NA_TAB_OFF = RING_BYTES + 512;
struct NaPol {
    static constexpr int EXTRA = 5, NM = 2;
    int bl, hq, qb, krow0, ntl, isctx;
    __device__ __forceinline__ size_t off() const { return ((size_t)bl * RB + (isctx ? 0 : CT + qb * 256)) * DI + hq * 64; }
    __device__ __forceinline__ Src src(const AttCtx& C) const { Src s; s.K[0] = C.Kb + hq * 64; s.K[1] = nullptr; s.V = C.Vb + hq * 64; s.ldk = DI; s.ldv = DI; return s; }
    __device__ __forceinline__ void prep(int ti, int wid, int r32, int hi, f32x16 (&negm)[2]) const {
        if (ti != 4) return;
        const int gc = 32 * (wid & 1) + r32, cs = min(max(gc - 8, 0), 48);
#pragma unroll
        for (int r = 0; r < 16; ++r) { const int kc = crow(r, hi);
            if (!(kc >= cs && kc < cs + 16)) negm[0][r] = -INFINITY;
            if (!(kc + 32 >= cs && kc + 32 < cs + 16)) negm[1][r] = -INFINITY; }
    }
    __device__ __forceinline__ int ntiles() const { return 4 + ntl; }
    __device__ __forceinline__ const bf16* qrow(const AttCtx& C, int wid) const { return C.QG + off() + (size_t)(wid * 32) * DI; }
    __device__ __forceinline__ void stage_extra(const AttCtx& C, LAS unsigned char* zl, int wid, int lane) const {
        att::dma_rows64(C.Zb + off() + (size_t)(wid * 32) * DI, DI, zl, lane);
        att::glds4s(C.aux + hq * 465, (unsigned)min(wid * 64 + lane, 464) * 4u, (unsigned)__builtin_amdgcn_readfirstlane((unsigned)(size_t)C.tab + wid * 256));
    }
    __device__ __forceinline__ size_t tile_row(int ti) const { return (size_t)bl * RB + (ti < 4 ? 64 * ti : CT + 64 * (krow0 + ti - 4)); }
    __device__ __forceinline__ bool needs(int ti, int wid) const { if (ti < 4) return true; const int gr = 4 * qb + (wid >> 1), rs = min(max(gr - 4, 0), 24), kr = krow0 + ti - 4; return kr >= rs && kr < rs + 8; }
    __device__ __forceinline__ int skip(int ti, int wid) const { return ti < 4 ? 0 : 1 + (wid & 1); }
    template <int SK> __device__ __forceinline__ void mask(const AttCtx& C, int ti, int wid, int r32, int hi, f32x16& p0, f32x16& p1) const {
        if (ti < 4) return;
        const int gr = 4 * qb + (wid >> 1), gc = 32 * (wid & 1) + r32, kr = krow0 + ti - 4;
        LAS const float* trow = C.tab + (kr - gr + 7) * 31 + 15 - gc;
#pragma unroll
        for (int r = 0; r < 16; ++r) { const int kc = crow(r, hi);
            if (att::sm_live0<SK>(r)) p0[r] = fmaf(trow[kc], LOG2E, p0[r]);
            if (att::sm_live1<SK>(r)) p1[r] = fmaf(trow[kc + 32], LOG2E, p1[r]);
            if ((r & 3) == 3) __builtin_amdgcn_sched_barrier(0); }
    }
    __device__ __forceinline__ void finish(const AttCtx& C, f32x16 (&o)[2], float m, float l, int wid, int r32, int hi, LAS unsigned char* zl) const {
        const float inv = __builtin_amdgcn_rcpf(l + __shfl_xor(l, 32));
        if (!C.dry) store_gated_l(o, inv, zl, (bf16*)C.QG + off() + (size_t)(wid * 32) * DI, r32, hi);
    }
};
__device__ __forceinline__ void na_phase(Frame& F, const Args& a, int g, int dry) {
    int lane_ = pg8::hw_lane(), wave_ = F.wave; asm volatile("" : "+v"(lane_), "+s"(wave_));
    AttCtx C; C.QG = (const bf16*)(a.ws + WS_QG) + (size_t)g * MH * DI; C.Kb = (const bf16*)(a.ws + WS_S2); C.Vb = (const bf16*)(a.ws + WS_S3); C.Zb = (const bf16*)(a.ws + WS_S4); C.aux = a.in[27]; C.tab = (LAS const float*)(F.lds + NA_TAB_OFF); C.dry = dry;
    constexpr int NLAT = HB * 32 * 8, NCTX = HB * 32;
    const int G = F.G, vcu = F.vcu;
    auto gen = [&](int i, NaPol& P) -> bool {
        const int id = i * G + vcu; if (id >= NLAT + NCTX) return false;
        if (id < NLAT) { P.isctx = 0; P.qb = (id + i) & 7; P.hq = (id >> 3) & 31; P.bl = id >> 8; P.krow0 = min(max(4 * P.qb - 4, 0), 24); P.ntl = min(max(4 * P.qb + 3 - 4, 0), 24) + 7 - P.krow0 + 1; }
        else { const int j = id - NLAT; P.isctx = 1; P.qb = 0; P.hq = j & 31; P.bl = j >> 5; P.krow0 = 0; P.ntl = 0; }
        return true; };
    if (wave_ & 1) att::run_stream1<NaPol, 2>(F.lds, C, gen, wave_, lane_); else att::run_stream1<NaPol, 1>(F.lds, C, gen, wave_, lane_);
}

template <int COMP>
__device__ __forceinline__ void diff_unit(LAS unsigned char* lds, const Src& src, const bf16* Q  , const bf16* zb, bf16* gb, size_t trow0, int nt, float lam, float lam_init, const float* sg, int wid, int lane, int dry, bool first, bool hn, const Src& srcn, size_t trow0n) {
    const int r32 = lane & 31, hi = lane >> 5, wq = wid & 3; constexpr int comp = COMP;
    constexpr int STG = 32768;
    if (first) {
        att::dma_issue<128, 2>(src, trow0, lds, wid, lane);
        att::dma_issue<128, 2>(src, trow0 + 64, lds + STG, wid, lane); }
    bf16x8 qf[4];
    { const bf16* qp = Q + (size_t)(wq * 32 + r32) * DI + comp * 64 + hi * 8;
#pragma unroll
      for (int d0 = 0; d0 < 4; ++d0) qf[d0] = *(const bf16x8*)(qp + d0 * 16); }
    f32x16 o[4];
#pragma unroll
    for (int d0 = 0; d0 < 4; ++d0) o[d0] = f32x16{};
    float m = -INFINITY, l = 0.f; f32x16 negm[1] = {f32x16{}};
    u32x4 pw[4], pwn[4];
    asm volatile("" : "+v"(qf[0]), "+v"(qf[1]), "+v"(qf[2]), "+v"(qf[3]));
    ATT_WAIT_BAR(0);
    if constexpr (COMP == 0) {
        int ic = 0;
        for (int ti = 0; ti < nt; ++ti) {
            LAS unsigned char* cur = lds + ic * STG; LAS unsigned char* prv = lds + ((ic + 3) & 3) * STG;
            if (ti >= 1 && ti + 1 < nt) att::dma_issue<128, 2>(src, trow0 + 64 * (ti + 1), lds + ((ic + 1) & 3) * STG, wid, lane);
            { f32x16 p0, p1; att::qk_tile(cur, qf, r32, hi, p0, p1, negm[0], negm[0]);
              if (ti > 0) att::pv_sm_tile<128, 1>(prv + 16384, lane, hi, pw, o, p0, p1, m, l, pwn, negm); else att::sm_alone<128, 1>(p0, p1, o, m, l, pwn, negm); }
#pragma unroll
            for (int k = 0; k < 4; ++k) pw[k] = pwn[k];
            ATT_WAIT_BAR(0);
            ic = (ic + 1) & 3;
        }
        if (hn) { att::dma_issue<128, 2>(srcn, trow0n, lds, wid, lane); att::dma_issue<128, 2>(srcn, trow0n + 64, lds + STG, wid, lane); }
        att::pv_tile<128>(lds + ((ic + 3) & 3) * STG + 16384, lane, hi, pw, o);
    } else {
        f32x16 p0, p1;
        att::qk_tile(lds + 8192, qf, r32, hi, p0, p1, negm[0], negm[0]);
        ATT_WAIT_BAR(0);
        int ic = 1;
        for (int ti = 1; ti < nt; ++ti) {
            LAS unsigned char* cur = lds + ic * STG; LAS unsigned char* pv2 = lds + ((ic + 2) & 3) * STG;
            if (ti + 1 < nt) att::dma_issue<128, 2>(src, trow0 + 64 * (ti + 1), lds + ((ic + 1) & 3) * STG, wid, lane);
            if (ti >= 2) att::pv_sm_tile<128, 1>(pv2 + 16384, lane, hi, pw, o, p0, p1, m, l, pwn, negm); else att::sm_alone<128, 1>(p0, p1, o, m, l, pwn, negm);
#pragma unroll
            for (int k = 0; k < 4; ++k) pw[k] = pwn[k];
            att::qk_tile(cur + 8192, qf, r32, hi, p0, p1, negm[0], negm[0]);
            ATT_WAIT_BAR(0);
            ic = (ic + 1) & 3;
        }
        if (hn) { att::dma_issue<128, 2>(srcn, trow0n, lds, wid, lane); att::dma_issue<128, 2>(srcn, trow0n + 64, lds + STG, wid, lane); }
        if (nt >= 2) att::pv_sm_tile<128, 1>(lds + ((ic + 2) & 3) * STG + 16384, lane, hi, pw, o, p0, p1, m, l, pwn, negm); else att::sm_alone<128, 1>(p0, p1, o, m, l, pwn, negm);
#pragma unroll
        for (int k = 0; k < 4; ++k) pw[k] = pwn[k];
        att::pv_tile<128>(lds + ((ic + 3) & 3) * STG + 16384, lane, hi, pw, o);
    }
    asm volatile("s_waitcnt lgkmcnt(0)\n\ts_barrier" ::: "memory");
    const float inv = __builtin_amdgcn_rcpf(l + __shfl_xor(l, 32));
    LAS float* xb = (LAS float*)(lds + 65536);
    u32x4 zz8[8];
    if (comp == 0 && !dry) { const size_t roz = (size_t)(wq * 32 + r32) * DI;
#pragma unroll
        for (int q8 = 0; q8 < 8; ++q8) zz8[q8] = *(const u32x4*)(zb + roz + 16 * q8 + 8 * hi); }
    if (comp == 1) {
#pragma unroll
        for (int d0 = 0; d0 < 4; ++d0)
#pragma unroll
            for (int r = 0; r < 16; ++r) xb[((wq * 64 + d0 * 16 + r) * 64) + lane] = o[d0][r] * inv;
    }
    __syncthreads();
    if (comp == 0 && !dry) {
        float ss = 0.f;
#pragma unroll
        for (int d0 = 0; d0 < 4; ++d0)
#pragma unroll
            for (int r = 0; r < 16; ++r) { const float v = o[d0][r] * inv - lam * xb[((wq * 64 + d0 * 16 + r) * 64) + lane]; o[d0][r] = v; ss += v * v; }
        ss += __shfl_xor(ss, 32);
        const float rs = rsqrtf(ss * (1.f / 128.f) + EPS) * (1.f - lam_init);
        const size_t ro = (size_t)(wq * 32 + r32) * DI;
#pragma unroll
        for (int d0 = 0; d0 < 4; ++d0)
#pragma unroll
            for (int pr = 0; pr < 2; ++pr) { const int cb = 32 * d0 + 16 * pr;
                const u32x4 zz = zz8[2 * d0 + pr];
                const auto zx = __builtin_amdgcn_permlane32_swap(zz.x, zz.z, false, false), zy = __builtin_amdgcn_permlane32_swap(zz.y, zz.w, false, false);
                u32x2 wg_[2];
#pragma unroll
                for (int e = 0; e < 2; ++e) { const int i = 2 * pr + e, d = 32 * d0 + 8 * i + 4 * hi; const f32x4 gg = *(const f32x4*)(sg + d); const unsigned z0 = zx[e], z1 = zy[e];
                    const float v0 = o[d0][4 * i] * rs * gg.x * silu(bflo(z0)), v1 = o[d0][4 * i + 1] * rs * gg.y * silu(bfhi(z0)), v2 = o[d0][4 * i + 2] * rs * gg.z * silu(bflo(z1)), v3 = o[d0][4 * i + 3] * rs * gg.w * silu(bfhi(z1));
                    wg_[e].x = att::cvtpk(v0, v1); wg_[e].y = att::cvtpk(v2, v3); }
                const auto ox = __builtin_amdgcn_permlane32_swap(wg_[0].x, wg_[1].x, false, false), oy = __builtin_amdgcn_permlane32_swap(wg_[0].y, wg_[1].y, false, false);
                u32x4 w; w.x = ox[0]; w.y = oy[0]; w.z = ox[1]; w.w = oy[1];
                *(u32x4*)(gb + ro + cb + 8 * hi) = w; }
    }
    asm volatile("s_waitcnt lgkmcnt(0)\n\ts_barrier" ::: "memory");
}
__device__ __forceinline__ void diff_phase(Frame& F, const Args& a, int g, int dry) {
#ifdef MK_TOUCH2
    {
        const int j = F.vcu & 31; unsigned accv = 0u;
        for (size_t off = ((size_t)j * NTHR + F.wave * 64 + pg8::hw_lane()) * 4096; off < (size_t)216 * MiB; off += (size_t)32 * NTHR * 4096) accv += *(const unsigned*)(a.ws + WS_S2 + off);
        for (size_t off = ((size_t)j * NTHR + F.wave * 64 + pg8::hw_lane()) * 4096; off < (size_t)72 * MiB; off += (size_t)32 * NTHR * 4096) accv += *(const unsigned*)(a.ws + WS_QG + (size_t)g * MH * DI * 2 + off);
        asm volatile("" :: "v"(accv));
    }
#endif
    int lane_ = pg8::hw_lane(), wave_ = F.wave; asm volatile("" : "+v"(lane_), "+s"(wave_));
    const bf16* QG = (const bf16*)(a.ws + WS_QG) + (size_t)g * MH * DI; const bf16* Kb = (const bf16*)(a.ws + WS_S2); const bf16* Vb = (const bf16*)(a.ws + WS_S3); const bf16* Zb = (const bf16*)(a.ws + WS_S4);
    const float lam_init = 0.8f - 0.6f * expf(-0.3f);
    float sa = 0.f, sb = 0.f;
    for (int i = 0; i < 64; ++i) { sa += a.in[20][i] * a.in[21][i]; sb += a.in[22][i] * a.in[23][i]; }
    const float lam = expf(sa) - expf(sb) + lam_init;
    constexpr int NLAT = HB * 16 * 16, NCTX = HB * 16 * 2;
    const int G = F.G, vcu = F.vcu; LAS unsigned char* lds = F.lds; const float* sg = a.in[24];
    auto units = [&](auto cc) {
        constexpr int COMP = decltype(cc)::value;
        auto desc = [&](int id, int& bl, int& h, int& nt, size_t& row0) { int qb;
            if (id < NLAT) { qb = id & 15; h = (id >> 4) & 15; bl = id >> 8; nt = RB / 64; row0 = (size_t)bl * RB + CT + qb * 128; }
            else { const int j = id - NLAT; qb = j & 1; h = (j >> 1) & 15; bl = j >> 5; nt = CT / 64; row0 = (size_t)bl * RB + qb * 128; } };
        for (int i = 0;; ++i) {
            const int id = i * G + vcu; if (id >= NLAT + NCTX) break;
            int bl, h, nt; size_t row0; desc(id, bl, h, nt, row0);
            const int idn = id + G; const bool hn = idn < NLAT + NCTX; int bln = 0, hnx = 0, ntn = 0; size_t row0n = 0; if (hn) desc(idn, bln, hnx, ntn, row0n);
            Src s; s.K[0] = Kb + (2 * h) * 64; s.K[1] = Kb + (2 * h + 1) * 64; s.V = Vb + h * 128; s.ldk = DI; s.ldv = DI;
            Src sn; sn.K[0] = Kb + (2 * hnx) * 64; sn.K[1] = Kb + (2 * hnx + 1) * 64; sn.V = Vb + hnx * 128; sn.ldk = DI; sn.ldv = DI;
            diff_unit<COMP>(lds, s, QG + row0 * DI + h * 128, Zb + row0 * DI + h * 128, (bf16*)QG + row0 * DI + h * 128, (size_t)bl * RB, nt, lam, lam_init, sg, wave_, lane_, dry, i == 0, hn, sn, (size_t)bln * RB);
        }
    };
    if (wave_ >> 2) units(std::integral_constant<int, 1>{}); else units(std::integral_constant<int, 0>{});
}
}
namespace mk {
typedef float f32x4v __attribute__((ext_vector_type(4)));
__device__ __forceinline__ void seq_bounds(int row, int& lo, int& hi) { const int rr = row % RB, b0 = row - rr; if (rr < CT) { lo = b0; hi = b0 + CT; } else { lo = b0 + CT; hi = b0 + RB; } }

#ifndef MK_GATES_Q
#define MK_GATES_Q 4
#endif
__device__ __forceinline__ void mlstm_gates_phase(Frame& F, const Args& a, int g) {
    int lane = pg8::hw_lane(), wave = F.wave; asm volatile("" : "+v"(lane), "+s"(wave));
    const bf16* XM = (const bf16*)(a.ws + WS_S2); const bf16* W2 = (const bf16*)(a.ws + WS_WG2);
    bf16* XC = g == 0 ? (bf16*)(a.ws + WS_QG) + (size_t)MH * DI : (bf16*)(a.ws + WS_H);
    const float* cw = a.in[9]; const float* cb = a.in[10]; const float* bg = a.in[15];
    LAS float* T = (LAS float*)F.lds;
    constexpr int G_W2S = 12288, G_XS = G_W2S + 64 * 1040;
    const int khw = (int)blockIdx.x & 3;
    { const int tid = wave * 64 + lane;
      for (int i = tid; i < 5 * 128; i += NTHR) { const int j = i >> 7, c4 = (i & 127) * 4; *(LAS f32x4v*)(T + j * 512 + c4) = *(const f32x4v*)(cw + j * 2048 + khw * 512 + c4); }
      for (int i = tid; i < 128; i += NTHR) *(LAS f32x4v*)(T + 2560 + 4 * i) = *(const f32x4v*)(cb + khw * 512 + 4 * i);
      for (int i = tid; i < 64 * 64; i += NTHR) { const int rw = i >> 6, c8 = (i & 63) * 8;
          *(LAS u32x4*)(F.lds + G_W2S + (rw * 520 + c8) * 2) = *(const u32x4*)(W2 + (size_t)(rw & 31) * 4096 + (rw >> 5) * 2048 + khw * 512 + c8); }
      __syncthreads(); }
    const int r = lane & 15, kq = lane >> 4;
    LAS unsigned char* xs = F.lds + G_XS + wave * 5440;
    const int kh = khw;
    float* gates = (float*)(a.ws + (kh == 0 ? WS_GATES : kh == 1 ? WS_GATES2 : kh == 2 ? WS_GATES3 : WS_GATES4));
    for (int grp = ((int)blockIdx.x >> 2) + 64 * wave; grp < MH / 16; grp += 64 * NWAVES) {
        const int row0 = grp * 16, row = row0 + r; int lo, hi; seq_bounds(row0, lo, hi);
        pg8::f32x4 acc0 = {0.f, 0.f, 0.f, 0.f}, acc1 = {0.f, 0.f, 0.f, 0.f};
        u32x4 xg[5];
#define ML_GLOAD(sb_) do { _Pragma("unroll") for (int j = 0; j < 5; ++j) { const int sr = row0 - 2 + 4 * j + (lane >> 4); \
            xg[j] = (sr >= lo && sr < hi) ? *(const u32x4*)(XM + (size_t)sr * DI + kh * 512 + (sb_) * 128 + (lane & 15) * 8) : (u32x4){0u, 0u, 0u, 0u}; } } while (0)
        ML_GLOAD(0);
        for (int sb = 0; sb < 4; ++sb) {
#pragma unroll
            for (int j = 0; j < 5; ++j) *(LAS u32x4*)(xs + (4 * j + (lane >> 4)) * 272 + (lane & 15) * 16) = xg[j];
            if (sb + 1 < 4) ML_GLOAD(sb + 1);
#pragma unroll
            for (int q = 0; q < 4; ++q) { const int cl = sb * 128 + q * 32 + 8 * kq, c0 = kh * 512 + cl;
                LAS const unsigned char* wl = F.lds + G_W2S + cl * 2; LAS const unsigned char* xl = xs + r * 272 + (q * 32 + 8 * kq) * 2;
                const bf16x8 wf0 = *(LAS const bf16x8*)(wl + r * 1040), wf1 = *(LAS const bf16x8*)(wl + (r + 16) * 1040), wf2 = *(LAS const bf16x8*)(wl + (32 + r) * 1040), wf3 = *(LAS const bf16x8*)(wl + (48 + r) * 1040);
                const f32x4v b0 = *(LAS const f32x4v*)(T + 2560 + cl), b1 = *(LAS const f32x4v*)(T + 2560 + cl + 4);
                float av[8] = {b0.x, b0.y, b0.z, b0.w, b1.x, b1.y, b1.z, b1.w};
                u32x4 xmid;
#pragma unroll
                for (int j = 0; j < 5; ++j) { const u32x4 x = *(LAS const u32x4*)(xl + j * 272); if (j == 2) xmid = x;
                    const f32x4v w0 = *(LAS const f32x4v*)(T + j * 512 + cl), w1 = *(LAS const f32x4v*)(T + j * 512 + cl + 4);
                    av[0] += bflo(x.x) * w0.x; av[1] += bfhi(x.x) * w0.y; av[2] += bflo(x.y) * w0.z; av[3] += bfhi(x.y) * w0.w;
                    av[4] += bflo(x.z) * w1.x; av[5] += bfhi(x.z) * w1.y; av[6] += bflo(x.w) * w1.z; av[7] += bfhi(x.w) * w1.w; }
                u32x4 xcw; xcw.x = att::cvtpk(silu(av[0]), silu(av[1])); xcw.y = att::cvtpk(silu(av[2]), silu(av[3])); xcw.z = att::cvtpk(silu(av[4]), silu(av[5])); xcw.w = att::cvtpk(silu(av[6]), silu(av[7]));
                *(u32x4*)(XC + (size_t)row * DI + c0) = xcw;
                const bf16x8 axc = __builtin_bit_cast(bf16x8, xcw), axm = __builtin_bit_cast(bf16x8, xmid);
                acc0 = __builtin_amdgcn_mfma_f32_16x16x32_bf16(axc, wf0, acc0, 0, 0, 0); acc1 = __builtin_amdgcn_mfma_f32_16x16x32_bf16(axc, wf1, acc1, 0, 0, 0);
                acc0 = __builtin_amdgcn_mfma_f32_16x16x32_bf16(axm, wf2, acc0, 0, 0, 0); acc1 = __builtin_amdgcn_mfma_f32_16x16x32_bf16(axm, wf3, acc1, 0, 0, 0); }
            asm volatile("s_waitcnt lgkmcnt(0)" ::: "memory");
        }
#undef ML_GLOAD
        const float bg0 = kh == 0 ? bg[r] : 0.f, bg1 = kh == 0 ? bg[16 + r] : 0.f;
#pragma unroll
        for (int rg = 0; rg < 4; ++rg) { const size_t tk = (size_t)grp * 16 + 4 * kq + rg; gates[tk * 32 + r] = acc0[rg] + bg0; gates[tk * 32 + 16 + r] = acc1[rg] + bg1; }
    }
    __syncthreads();
}

#define ML_BAR() asm volatile("s_waitcnt lgkmcnt(0)\n\ts_barrier" ::: "memory")
#ifndef MK_SC_A
#define MK_SC_A 1
#endif
#ifndef MK_SC_B
#define MK_SC_B 1
#endif
constexpr int ML_QS = 0, ML_KS = 33792, ML_VS = 67584, ML_P = 84992, ML_HO = 94208, ML_F = 110592;
constexpr int ML_W1 = RING_BYTES + 512  , ML_WV = 115200  ;
constexpr int ML_KSTR = 528, ML_VSTR = 272, ML_PSTR = 144;
__device__ __forceinline__ int ml_row(int base, int dir, int s) { return base + (dir == 0 ? s : (s < CT ? CT - 1 - s : CT + (S - 1) - (s - CT))); }
__device__ __forceinline__ s16x4 ml_tr(LAS const unsigned char* p) { return __builtin_bit_cast(s16x4, __builtin_amdgcn_ds_read_tr16_b64_v4i16((LAS att::v4i16_t*)p)); }
__device__ __forceinline__ void mlstm_scan_phase(Frame& F, const Args& a, int g) {
    int tid0 = F.wave * 64 + pg8::hw_lane(); asm volatile("" : "+v"(tid0));
    const int wid = __builtin_amdgcn_readfirstlane(tid0 >> 6);
    const int u = F.vcu; if (u >= HB * 8 * 2 * 2) return;
    const int dvh = u & 1, dir = (u >> 1) & 1, h = (u >> 2) & 7, bl = u >> 5;
    const bf16* XM = (const bf16*)(a.ws + WS_S2); const float* gates = (const float*)(a.ws + WS_GATES); const float* gates2 = (const float*)(a.ws + WS_GATES2); const float* gates3 = (const float*)(a.ws + WS_GATES3); const float* gates4 = (const float*)(a.ws + WS_GATES4);
    const bf16* XC = g == 0 ? (const bf16*)(a.ws + WS_QG) + (size_t)MH * DI : (const bf16*)(a.ws + WS_H);
    bf16* Hd = dir == 0 ? (bf16*)(a.ws + WS_QG) + (size_t)g * MH * DI : (bf16*)(a.ws + WS_S4);
    const float* cw = a.in[9]; const float* cb = a.in[10]; const float* wq = a.in[11]; const float* wk = a.in[12]; const float* wv = a.in[13];
    LAS unsigned char* L = F.lds; LAS float* Ff = (LAS float*)(L + ML_F);
    pg8::f32x4 C[16];
#pragma unroll
    for (int i = 0; i < 16; ++i) C[i] = (pg8::f32x4){0.f, 0.f, 0.f, 0.f};
    int tid = tid0;
    if (tid < 256) { Ff[640 + tid] = 0.f; }
    {
        LAS float* W1 = (LAS float*)(L + ML_W1); LAS float* WV = (LAS float*)(L + ML_WV);
        for (int i = tid; i < 5 * 256; i += NTHR) W1[i] = cw[(i >> 8) * DI + h * 256 + (i & 255)];
        if (tid < 256) W1[1280 + tid] = cb[h * 256 + tid];
        for (int i = tid; i < 1024; i += NTHR) { W1[1536 + i] = wq[h * 1024 + i]; W1[2560 + i] = wk[h * 1024 + i]; WV[i] = wv[h * 1024 + i]; }
        __syncthreads();
    }
    LAS const float* W1 = (LAS const float*)(L + ML_W1); LAS const float* WV = (LAS const float*)(L + ML_WV);
    bf16x8 aq[2], ak[2], av_[2], aql[2], akl[2], avl[2];
    { const int o = tid0 & 15, g4 = (tid0 >> 4) & 3;
#pragma unroll
      for (int n = 0; n < 2; ++n) { const int bo = 4 * n + (o >> 2); u32x4 fq, fk, fv, lq, lk, lv; unsigned* pq = (unsigned*)&fq; unsigned* pk_ = (unsigned*)&fk; unsigned* pv_ = (unsigned*)&fv; unsigned* qq_ = (unsigned*)&lq; unsigned* qk_ = (unsigned*)&lk; unsigned* qv_ = (unsigned*)&lv;
#pragma unroll
          for (int jp = 0; jp < 4; ++jp) { float q2[2], k2[2], v2[2], q2l[2], k2l[2], v2l[2];
#pragma unroll
              for (int e = 0; e < 2; ++e) { const int j = 2 * jp + e, bi = 2 * g4 + (j >> 2); const bool nz = bi == bo; const int gb = wid * 8 + bo, idx = gb * 16 + (j & 3) * 4 + (o & 3);
                  q2[e] = nz ? W1[1536 + idx] : 0.f; k2[e] = nz ? W1[2560 + idx] * 0.0625f : 0.f; v2[e] = nz ? WV[idx] : 0.f;
                  q2l[e] = q2[e] - bf2f((unsigned short)f2bf(q2[e])); k2l[e] = k2[e] - bf2f((unsigned short)f2bf(k2[e])); v2l[e] = v2[e] - bf2f((unsigned short)f2bf(v2[e])); }
              pq[jp] = pk2(q2[0], q2[1]); pk_[jp] = pk2(k2[0], k2[1]); pv_[jp] = pk2(v2[0], v2[1]);
              qq_[jp] = pk2(q2l[0], q2l[1]); qk_[jp] = pk2(k2l[0], k2l[1]); qv_[jp] = pk2(v2l[0], v2l[1]); }
          aq[n] = __builtin_bit_cast(bf16x8, fq); ak[n] = __builtin_bit_cast(bf16x8, fk); av_[n] = __builtin_bit_cast(bf16x8, fv);
          aql[n] = __builtin_bit_cast(bf16x8, lq); akl[n] = __builtin_bit_cast(bf16x8, lk); avl[n] = __builtin_bit_cast(bf16x8, lv); } }
    const int base = bl * RB;
    u32x4 xw[8];
#define ML_LOADX(cc) do { const int rlo_ = dir ? ml_row(base, 1, (cc) * 64 + 63) : ml_row(base, 0, (cc) * 64); \
        const size_t o_ = (size_t)(rlo_ + (tid0 & 15)) * DI + h * 256 + wid * 32 + ((tid0 >> 4) & 3) * 8; \
        _Pragma("unroll") for (int i_ = 0; i_ < 4; ++i_) { xw[i_] = *(const u32x4*)(XM + o_ + (size_t)(16 * i_) * DI); xw[4 + i_] = *(const u32x4*)(XC + o_ + (size_t)(16 * i_) * DI); } } while (0)
    const int gwave = dvh == 0 ? 4 : 0;
    float gpre[8] = {0.f, 0.f, 0.f, 0.f, 0.f, 0.f, 0.f, 0.f};
#define ML_LOADG(cc) do { if (wid == gwave) { const size_t gi_ = (size_t)ml_row(base, dir, (cc) * 64 + (tid0 & 63)) * 32 + (2 * dir) * 8 + h; \
        gpre[0] = gates[gi_]; gpre[1] = gates2[gi_]; gpre[2] = gates3[gi_]; gpre[3] = gates4[gi_]; gpre[4] = gates[gi_ + 8]; gpre[5] = gates2[gi_ + 8]; gpre[6] = gates3[gi_ + 8]; gpre[7] = gates4[gi_ + 8]; } } while (0)
    ML_LOADX(0); ML_LOADG(0);
    for (int c = 0; c < RB / 64; ++c) {
        const int par = c & 1;
        tid = tid0; asm volatile("" : "+v"(tid));
        const int lane = tid & 63, l15 = lane & 15, gq = lane >> 4;
#pragma unroll 1
        for (int repA_ = 0; repA_ < MK_SC_A; ++repA_) {
        {
            const bool hasv = (wid >> 2) == dvh;
            const pg8::f32x4 z4 = {0.f, 0.f, 0.f, 0.f};
#pragma unroll
            for (int tt = 0; tt < 4; ++tt) {
                const bf16x8 bxm = __builtin_bit_cast(bf16x8, xw[tt]), bxc = __builtin_bit_cast(bf16x8, xw[4 + tt]);
                const int mrow = 16 * tt + l15, t = dir ? 63 - mrow : mrow;
#pragma unroll
                for (int n = 0; n < 2; ++n) {
                    const pg8::f32x4 dq = __builtin_amdgcn_mfma_f32_16x16x32_bf16(aq[n], bxc, __builtin_amdgcn_mfma_f32_16x16x32_bf16(aql[n], bxc, z4, 0, 0, 0), 0, 0, 0), dk = __builtin_amdgcn_mfma_f32_16x16x32_bf16(ak[n], bxc, __builtin_amdgcn_mfma_f32_16x16x32_bf16(akl[n], bxc, z4, 0, 0, 0), 0, 0, 0);
                    const int cl = wid * 32 + 16 * n + 4 * gq;
                    u32x2 w2; w2.x = att::cvtpk(dq[0], dq[1]); w2.y = att::cvtpk(dq[2], dq[3]); *(LAS u32x2*)(L + ML_QS + t * ML_KSTR + cl * 2) = w2;
                    w2.x = att::cvtpk(dk[0], dk[1]); w2.y = att::cvtpk(dk[2], dk[3]); *(LAS u32x2*)(L + ML_KS + t * ML_KSTR + cl * 2) = w2;
                    if (hasv) { const pg8::f32x4 dv = __builtin_amdgcn_mfma_f32_16x16x32_bf16(av_[n], bxm, __builtin_amdgcn_mfma_f32_16x16x32_bf16(avl[n], bxm, z4, 0, 0, 0), 0, 0, 0);
                        w2.x = att::cvtpk(dv[0], dv[1]); w2.y = att::cvtpk(dv[2], dv[3]); *(LAS u32x2*)(L + ML_VS + t * ML_VSTR + (cl & 127) * 2) = w2; }
                }
            }
        }
#if defined(MK_SC_G2)
        for (int repg_ = 0; repg_ < 2; ++repg_)
#endif
        if (wid == gwave) {
            const float gi = (gpre[0] + gpre[1]) + (gpre[2] + gpre[3]), gf = (gpre[4] + gpre[5]) + (gpre[6] + gpre[7]);
            const float lf = fminf(gf, 0.f) - __logf(1.f + __expf(-fabsf(gf)));
            float b = lf;
#define ML_DPP(x, ctrl, rmask) __uint_as_float((unsigned)__builtin_amdgcn_update_dpp(0, (int)__float_as_uint(x), ctrl, rmask, 0xf, true))
            b += ML_DPP(b, 0x111, 0xf); b += ML_DPP(b, 0x112, 0xf); b += ML_DPP(b, 0x114, 0xf); b += ML_DPP(b, 0x118, 0xf);
            b += ML_DPP(b, 0x142, 0xa);
            b += ML_DPP(b, 0x143, 0xc);
#undef ML_DPP
            const float bend = __shfl(b, 63);
            Ff[lane] = b * LOG2E; Ff[64 + lane] = (gi - b) * LOG2E; Ff[128 + lane] = __expf(b); Ff[192 + lane] = __expf(bend - b + gi);
            if (lane == 0) Ff[576] = __expf(bend);
        }
        }
        ML_BAR();
#if defined(MK_SC_L2)
        if (c + 1 < RB / 64) { ML_LOADX(c + 1); ML_LOADG(c + 1); asm volatile("" : "+v"(xw[0]), "+v"(xw[1]), "+v"(xw[2]), "+v"(xw[3]), "+v"(xw[4]), "+v"(xw[5]), "+v"(xw[6]), "+v"(xw[7])); }
#endif
        if (c + 1 < RB / 64) { ML_LOADX(c + 1); ML_LOADG(c + 1); }
        for (int repB_ = 0; repB_ < MK_SC_B; ++repB_) {
        {
            const int si = wid >> 1;
            pg8::f32x4 st[2] = {{0.f, 0.f, 0.f, 0.f}, {0.f, 0.f, 0.f, 0.f}};
            LAS const unsigned char* kp = L + ML_KS + (16 * si + l15) * ML_KSTR + gq * 16;
            LAS const unsigned char* qp0 = L + ML_QS + (16 * (2 * (wid & 1)) + l15) * ML_KSTR + gq * 16;
#pragma unroll
            for (int ks = 0; ks < 8; ++ks) {
                const bf16x8 ka = *(LAS const bf16x8*)(kp + ks * 64);
                const bf16x8 q0 = *(LAS const bf16x8*)(qp0 + ks * 64), q1 = *(LAS const bf16x8*)(qp0 + 16 * ML_KSTR + ks * 64);
                st[0] = __builtin_amdgcn_mfma_f32_16x16x32_bf16(ka, q0, st[0], 0, 0, 0);
                st[1] = __builtin_amdgcn_mfma_f32_16x16x32_bf16(ka, q1, st[1], 0, 0, 0);
            }
            const f32x4v al = *(LAS const f32x4v*)(Ff + 64 + 16 * si + 4 * gq);
            const float alv[4] = {al.x, al.y, al.z, al.w};
#pragma unroll
            for (int e = 0; e < 2; ++e) {
                const int ti = 2 * (wid & 1) + e, t = 16 * ti + l15; const float bt = Ff[t];
                float pv[4], rsum = 0.f;
#pragma unroll
                for (int r = 0; r < 4; ++r) { const int s = 16 * si + 4 * gq + r; const float wgt = (s <= t) ? att::ex2(bt + alv[r]) : 0.f; pv[r] = st[e][r] * wgt; rsum += pv[r]; }
                u32x2 w2; w2.x = att::cvtpk(pv[0], pv[1]); w2.y = att::cvtpk(pv[2], pv[3]);
                *(LAS u32x2*)(L + ML_P + t * ML_PSTR + (16 * si + 4 * gq) * 2) = w2;
                { const auto r16 = __builtin_amdgcn_permlane16_swap(__float_as_uint(rsum), __float_as_uint(rsum), false, false); rsum = __uint_as_float(r16[0]) + __uint_as_float(r16[1]);
                  const auto r32 = __builtin_amdgcn_permlane32_swap(__float_as_uint(rsum), __float_as_uint(rsum), false, false); rsum = __uint_as_float(r32[0]) + __uint_as_float(r32[1]); }
                if (gq == 0) Ff[320 + si * 64 + t] = rsum;
            }
        }
        {
            const int t = tid >> 3, part = tid & 7; LAS const float* np_ = Ff + 640 + par * 256 + part * 32; LAS const unsigned char* qrow = L + ML_QS + t * ML_KSTR + part * 64;
            float acc = 0.f;
#pragma unroll
            for (int i = 0; i < 4; ++i) { const u32x4 qw = *(LAS const u32x4*)(qrow + i * 16); const f32x4v n0 = *(LAS const f32x4v*)(np_ + i * 8), n1 = *(LAS const f32x4v*)(np_ + i * 8 + 4);
                acc += bflo(qw.x) * n0.x + bfhi(qw.x) * n0.y + bflo(qw.y) * n0.z + bfhi(qw.y) * n0.w + bflo(qw.z) * n1.x + bfhi(qw.z) * n1.y + bflo(qw.w) * n1.z + bfhi(qw.w) * n1.w; }
#define ML_DPPF(x, ctrl) __uint_as_float((unsigned)__builtin_amdgcn_update_dpp(0, (int)__float_as_uint(x), ctrl, 0xf, 0xf, true))
            acc += ML_DPPF(acc, 0xB1); acc += ML_DPPF(acc, 0x4E); acc += ML_DPPF(acc, 0x104);
#undef ML_DPPF
            if (part == 0) Ff[256 + t] = acc * Ff[128 + t];
        }
        if (tid < 256) {
            float nn = Ff[576] * Ff[640 + par * 256 + tid];
#pragma unroll
            for (int s = 0; s < 64; s += 4) { const f32x4v w4 = *(LAS const f32x4v*)(Ff + 192 + s); LAS const unsigned char* kc = L + ML_KS + s * ML_KSTR + tid * 2;
                nn += (w4.x * bf2f(*(LAS const unsigned short*)kc) + w4.y * bf2f(*(LAS const unsigned short*)(kc + ML_KSTR))) + (w4.z * bf2f(*(LAS const unsigned short*)(kc + 2 * ML_KSTR)) + w4.w * bf2f(*(LAS const unsigned short*)(kc + 3 * ML_KSTR))); }
            Ff[640 + (par ^ 1) * 256 + tid] = nn;
        }
        }
        ML_BAR();
        {
            pg8::f32x4 y[4];
#if defined(MK_SC_SYNC)
            ML_BAR(); __syncthreads(); __syncthreads();
#endif
#if defined(MK_SC_QC2)
            for (int repq_ = 0; repq_ < 2; ++repq_)
#endif
            {
#pragma unroll
            for (int tt = 0; tt < 4; ++tt) y[tt] = (pg8::f32x4){0.f, 0.f, 0.f, 0.f};
            {
                u32x2 qa[2][4], qb[2][4];
#define ML_QRD(ks_, b_) do { _Pragma("unroll") for (int tt = 0; tt < 4; ++tt) { LAS const unsigned char* qp = L + ML_QS + (16 * tt + l15) * ML_KSTR + (32 * (ks_) + 4 * gq) * 2; qa[b_][tt] = *(LAS const u32x2*)qp; qb[b_][tt] = *(LAS const u32x2*)(qp + 32); } } while (0)
                ML_QRD(0, 0);
#pragma unroll
                for (int ks = 0; ks < 8; ++ks) {
                    if (ks + 1 < 8) ML_QRD(ks + 1, (ks + 1) & 1);
                    u32x4 cw4; cw4.x = att::cvtpk(C[2 * ks][0], C[2 * ks][1]); cw4.y = att::cvtpk(C[2 * ks][2], C[2 * ks][3]); cw4.z = att::cvtpk(C[2 * ks + 1][0], C[2 * ks + 1][1]); cw4.w = att::cvtpk(C[2 * ks + 1][2], C[2 * ks + 1][3]);
                    const bf16x8 cf = __builtin_bit_cast(bf16x8, cw4);
                    __builtin_amdgcn_sched_barrier(0);
#pragma unroll
                    for (int tt = 0; tt < 4; ++tt) { const u32x4 qq = {qa[ks & 1][tt].x, qa[ks & 1][tt].y, qb[ks & 1][tt].x, qb[ks & 1][tt].y};
                        y[tt] = __builtin_amdgcn_mfma_f32_16x16x32_bf16(__builtin_bit_cast(bf16x8, qq), cf, y[tt], 0, 0, 0); }
                    __builtin_amdgcn_sched_barrier(0);
                }
#undef ML_QRD
            }
            }
#pragma unroll
            for (int tt = 0; tt < 4; ++tt) { const f32x4v e4 = *(LAS const f32x4v*)(Ff + 128 + 16 * tt + 4 * gq); y[tt][0] *= e4.x; y[tt][1] *= e4.y; y[tt][2] *= e4.z; y[tt][3] *= e4.w; }
            bf16x8 vf[2];
            { LAS const unsigned char* vb = L + ML_VS + (8 * gq + (l15 >> 2)) * ML_VSTR + (16 * wid + 4 * (lane & 3)) * 2;
#pragma unroll
              for (int k2 = 0; k2 < 2; ++k2) { const s16x4 lo = ml_tr(vb + k2 * 32 * ML_VSTR), hi4 = ml_tr(vb + k2 * 32 * ML_VSTR + 4 * ML_VSTR); vf[k2] = (bf16x8){lo[0], lo[1], lo[2], lo[3], hi4[0], hi4[1], hi4[2], hi4[3]}; } }
#pragma unroll
            for (int k2 = 0; k2 < 2; ++k2)
#pragma unroll
                for (int tt = 0; tt < 4; ++tt) { const bf16x8 pa = *(LAS const bf16x8*)(L + ML_P + (16 * tt + l15) * ML_PSTR + (32 * k2 + 8 * gq) * 2);
                    y[tt] = __builtin_amdgcn_mfma_f32_16x16x32_bf16(pa, vf[k2], y[tt], 0, 0, 0); }
#pragma unroll
            for (int tt = 0; tt < 4; ++tt)
#pragma unroll
                for (int r = 0; r < 4; ++r) { const int t = 16 * tt + 4 * gq + r;
                    *(LAS unsigned short*)(L + ML_HO + t * 256 + (16 * wid + l15) * 2) = (unsigned short)f2bf(y[tt][r]); }
            const float ebend = Ff[576];
#pragma unroll
            for (int i = 0; i < 16; ++i) C[i] = C[i] * ebend;
            bf16x8 vw[2];
#pragma unroll
            for (int k2 = 0; k2 < 2; ++k2) { const f32x4v w0 = *(LAS const f32x4v*)(Ff + 192 + 32 * k2 + 8 * gq), w1 = *(LAS const f32x4v*)(Ff + 192 + 32 * k2 + 8 * gq + 4);
                const u32x4 vv = __builtin_bit_cast(u32x4, vf[k2]); u32x4 o;
                o.x = att::cvtpk(bflo(vv.x) * w0.x, bfhi(vv.x) * w0.y); o.y = att::cvtpk(bflo(vv.y) * w0.z, bfhi(vv.y) * w0.w); o.z = att::cvtpk(bflo(vv.z) * w1.x, bfhi(vv.z) * w1.y); o.w = att::cvtpk(bflo(vv.w) * w1.z, bfhi(vv.w) * w1.w);
                vw[k2] = __builtin_bit_cast(bf16x8, o); }
            LAS const unsigned char* kb = L + ML_KS + (8 * gq + (l15 >> 2)) * ML_KSTR + (4 * (lane & 3)) * 2;
            {
                s16x4 klo[2][2], khi[2][2];
#define ML_KRD(dt_, b_) do { _Pragma("unroll") for (int k2 = 0; k2 < 2; ++k2) { klo[b_][k2] = ml_tr(kb + k2 * 32 * ML_KSTR + (dt_) * 32); khi[b_][k2] = ml_tr(kb + k2 * 32 * ML_KSTR + 4 * ML_KSTR + (dt_) * 32); } } while (0)
                ML_KRD(0, 0);
#pragma unroll
                for (int dt = 0; dt < 16; ++dt) {
                    if (dt + 1 < 16) ML_KRD(dt + 1, (dt + 1) & 1);
                    __builtin_amdgcn_sched_barrier(0);
#pragma unroll
                    for (int k2 = 0; k2 < 2; ++k2) { const s16x4 lo = klo[dt & 1][k2], hi4 = khi[dt & 1][k2];
                        const bf16x8 ka = {lo[0], lo[1], lo[2], lo[3], hi4[0], hi4[1], hi4[2], hi4[3]};
                        C[dt] = __builtin_amdgcn_mfma_f32_16x16x32_bf16(ka, vw[k2], C[dt], 0, 0, 0); }
                    __builtin_amdgcn_sched_barrier(0);
                }
#undef ML_KRD
            }
        }
        ML_BAR();
#if defined(MK_SC_W2)
        for (int repw_ = 0; repw_ < 2; ++repw_)
#endif
#pragma unroll
        for (int it = 0; it < 2; ++it) { const int idx = tid + it * NTHR, t = idx >> 4, pc = idx & 15; const int row = ml_row(base, dir, c * 64 + t);
            const float den = Ff[256 + t] + (Ff[320 + t] + Ff[384 + t]) + (Ff[448 + t] + Ff[512 + t]);
            const float rd = __builtin_amdgcn_rcpf(fmaxf(fabsf(den), 1.f));
            const u32x4 yv = *(LAS const u32x4*)(L + ML_HO + t * 256 + pc * 16); u32x4 hv;
            hv.x = att::cvtpk(bflo(yv.x) * rd, bfhi(yv.x) * rd); hv.y = att::cvtpk(bflo(yv.y) * rd, bfhi(yv.y) * rd); hv.z = att::cvtpk(bflo(yv.z) * rd, bfhi(yv.z) * rd); hv.w = att::cvtpk(bflo(yv.w) * rd, bfhi(yv.w) * rd);
            *(u32x4*)(Hd + (size_t)row * DI + h * 256 + dvh * 128 + pc * 8) = hv; }
    }
}

__device__ __forceinline__ void mlstm_out_phase(Frame& F, const Args& a, int g, int dry) {
    int lane = pg8::hw_lane(), wave = F.wave; asm volatile("" : "+v"(lane), "+s"(wave));
    const bf16* XC = g == 0 ? (const bf16*)(a.ws + WS_QG) + (size_t)MH * DI : (const bf16*)(a.ws + WS_H); const bf16* Z = (const bf16*)(a.ws + WS_S3); const bf16* HB2 = (const bf16*)(a.ws + WS_S4); bf16* HF = (bf16*)(a.ws + WS_QG) + (size_t)g * MH * DI;
    const float* ng = a.in[16]; const float* skip = a.in[17];
    const int gw = F.vcu * NWAVES + wave, NGW = F.G * NWAVES;
    for (int it0 = gw; it0 < MH * 8; it0 += 2 * NGW) {
        u32x2 hf[2], hb[2], xcw[2], zw[2]; f32x4v gg[2], sk[2]; size_t o[2];
#pragma unroll
        for (int u = 0; u < 2; ++u) { int it = it0 + u * NGW; if (it >= MH * 8) it = it0; const int row = it >> 3, h = it & 7, ch = h * 256 + lane * 4; o[u] = (size_t)row * DI + ch;
            hf[u] = *(const u32x2*)(HF + o[u]); hb[u] = *(const u32x2*)(HB2 + o[u]); xcw[u] = *(const u32x2*)(XC + o[u]); zw[u] = *(const u32x2*)(Z + o[u]);
            gg[u] = *(const f32x4v*)(ng + ch); sk[u] = *(const f32x4v*)(skip + ch); }
#pragma unroll
        for (int u = 0; u < 2; ++u) {
            const float hs[4] = {bflo(hf[u].x) + bflo(hb[u].x), bfhi(hf[u].x) + bfhi(hb[u].x), bflo(hf[u].y) + bflo(hb[u].y), bfhi(hf[u].y) + bfhi(hb[u].y)};
            const float mu = wave_sum((hs[0] + hs[1]) + (hs[2] + hs[3])) * (1.f / 256.f);
            const float d[4] = {hs[0] - mu, hs[1] - mu, hs[2] - mu, hs[3] - mu};
            const float rstd = rsqrtf(wave_sum((d[0] * d[0] + d[1] * d[1]) + (d[2] * d[2] + d[3] * d[3])) * (1.f / 256.f) + EPS);
            const float xcv[4] = {bflo(xcw[u].x), bfhi(xcw[u].x), bflo(xcw[u].y), bfhi(xcw[u].y)}, z[4] = {bflo(zw[u].x), bfhi(zw[u].x), bflo(zw[u].y), bfhi(zw[u].y)};
            const float ggv[4] = {gg[u].x, gg[u].y, gg[u].z, gg[u].w}, skv[4] = {sk[u].x, sk[u].y, sk[u].z, sk[u].w};
            float ov[4];
#pragma unroll
            for (int i = 0; i < 4; ++i) ov[i] = (d[i] * rstd * ggv[i] + skv[i] * xcv[i]) * silu(z[i]);
            u32x2 w; w.x = att::cvtpk(ov[0], ov[1]); w.y = att::cvtpk(ov[2], ov[3]); if (!dry && (u == 0 || it0 + NGW < MH * 8)) *(u32x2*)(HF + o[u]) = w;
        }
    }
}
}
namespace mk {
enum { P_PRO = 0, P_PRO2 = 1, P_NORM0 = 2, P_L0 = 3  , P_OUT0 = 11, P_NORM1 = 12, P_L1 = 13  , P_OUT1 = 17, P_NORM2 = 18, P_L2 = 19  , P_OUT2 = 23, P_NORM3 = 24, P_L3 = 25  , P_OUT3 = 29, P_FINAL = 30, P_END = 31 };

__global__ void __launch_bounds__(NTHR, 2) mega(Args a) {
    extern __shared__ __attribute__((aligned(16))) unsigned char lds_raw[];
    Frame F;
    F.lds = (LAS unsigned char*)lds_raw;
    F.wave = __builtin_amdgcn_readfirstlane((int)threadIdx.x >> 6); F.lane = pg8::hw_lane(); F.tid = F.wave * 64 + F.lane;
    F.G = gridDim.x; { const int bx = blockIdx.x; F.vcu = (F.G % 8 == 0) ? (bx % 8) * (F.G / 8) + bx / 8 : bx; }
    volatile LAS unsigned* MISC = (volatile LAS unsigned*)(F.lds + MISC_OFF);
    for (int u = F.tid; u < (LDS_BYTES - RING_BYTES) / 4; u += NTHR) ((LAS unsigned*)(F.lds + RING_BYTES))[u] = 0u;
    __syncthreads();
    XcdBarrier bar = xcd_barrier_post((unsigned*)(a.ws + WS_CTL) + CW_BAR, MISC + 8, (unsigned)F.wave);
    const int lo = a.ph_lo, hi = a.ph_hi;
#ifndef MK_REP_GEMM
#define MK_REP_GEMM 1
#endif
#ifndef MK_REP_ATT
#define MK_REP_ATT 1
#endif
#ifndef MK_REP_MISC
#define MK_REP_MISC 1
#endif
#ifndef MK_GEMM_ALIGN
#define MK_GEMM_ALIGN true
#endif
#ifndef MK_GEMM_SP2
#define MK_GEMM_SP2 true
#endif
#ifndef MK_REP_WC
#define MK_REP_WC 1
#endif
#ifndef MK_REP_SYNC
#define MK_REP_SYNC 0
#endif
#ifndef MK_REP_DIFF
#define MK_REP_DIFF MK_REP_ATT
#endif
#ifndef MK_REP_NA
#define MK_REP_NA MK_REP_ATT
#endif
#ifndef MK_REP_SWA
#define MK_REP_SWA MK_REP_ATT
#endif
#ifndef MK_REP_SCAN
#define MK_REP_SCAN 1
#endif
#ifndef MK_REP_GATES
#define MK_REP_GATES MK_REP_SCAN
#endif
#ifndef MK_SITES
#define MK_SITES 0xFFFFFFFFu
#endif
#define ON(b) (((MK_SITES) >> (b)) & 1u)
#ifdef MK_PARTIAL
#define IN(k) (lo <= (k) && (k) < hi)
#else
#define IN(k) true
#endif
#ifndef MK_REP_BAR
#define MK_REP_BAR 1
#endif
#ifdef MK_TP
    long long tp_acc = 0, tp_prev = wall_clock64(), tp_t0 = 0;
#define TP_PRE(k) tp_t0 = wall_clock64();
#define TP_POST(k) { long long n_ = wall_clock64(); if ((MK_TP_MASK >> (k)) & 1u) tp_acc += n_ - (MK_TP == 1 ? tp_t0 : tp_prev); tp_prev = n_; }
#else
#define TP_PRE(k)
#define TP_POST(k)
#endif
#define SEAM(k) do { if (IN(k) && IN((k) + 1)) { TP_PRE(k) for (int rb_ = 0; rb_ < MK_REP_BAR; ++rb_) xcd_barrier(bar); TP_POST(k) } } while (0)
    const int gw = F.vcu * NWAVES + F.wave, NGW = F.G * NWAVES;
#define WSB ([&]() { unsigned char* p_ = a.ws; asm volatile("" : "+s"(p_)); return p_; }())
#define xs (a.out)
#define ctxs ((float*)(WSB + WS_CTXS))
#define xsb ((bf16*)a.out)
#define ctxb ((bf16*)(WSB + WS_CTXS))
#define x3b ((bf16*)(WSB + WS_S3))
#define mod ((const float*)(WSB + WS_MOD))
#define WinA ((bf16*)(WSB + WS_WIN))
#define WoutA ((bf16*)(WSB + WS_WOUT))
#define WinB ((bf16*)(WSB + WS_W2))
#define WoutB ((bf16*)(WSB + WS_W2 + 16 * MiB))
#define H ((bf16*)(WSB + WS_H))
#define QG ((bf16*)(WSB + WS_QG))
#define ssq ((float*)(WSB + WS_SSQ))
#define shw ((const float*)(WSB + WS_SHW))
#define S2 ((bf16*)(WSB + WS_S2))
#define S3 ((bf16*)(WSB + WS_S3))
#define S4 ((bf16*)(WSB + WS_S4))
#define rope ((const float*)(WSB + WS_ROPE))
    const float QSC = 0.125f * LOG2E;

    if (ON(0) && IN(P_PRO)) { prologue_phase(F, a); __syncthreads(); for (int rw_ = 0; rw_ < MK_REP_WC; ++rw_) wconv(F, a.in[8], 4096, a.in[18], WinA, WoutA, gw, NGW); }
    SEAM(P_PRO2);
    if (ON(1) && IN(P_NORM0)) { for (int rep = 0; rep < MK_REP_MISC; ++rep) norm_phase(F, a.in[0], a.in[2], a.in[4], mod, H); }
    SEAM(P_NORM0);
#if MK_HAVE_L0
    for (int g = 0; g < 2; ++g) {
        if (ON(2) && IN(P_L0 + 4 * g)) {
            pg8::Gemm gm{H + (size_t)g * MH * D, WinA, MH, 4096, D}; pg8::StaticOrder So; So.init(MH, 4096, F.G, (int)blockIdx.x);
            EpiProj<false> E{S2, S3, S3, S3, DI, DI, DI, DI, 8, 16, 16, 0u, 1.f, rope, nullptr, nullptr, 0};
            for (int rep = 0; rep < MK_REP_GEMM; ++rep) { if (MK_REP_SYNC && rep) xcd_barrier(bar); pg8::gemm_phase<EpiProj<false>, pg8::StaticOrder, MK_GEMM_ALIGN, MK_GEMM_SP2>(F.lds, gm, So, E, F.wave); }
        }
        SEAM(P_L0 + 4 * g);
        if (ON(17) && IN(P_L0 + 4 * g + 1)) for (int rep = 0; rep < MK_REP_GATES; ++rep) mlstm_gates_phase(F, a, g);
        SEAM(P_L0 + 4 * g + 1);
        if (ON(18) && IN(P_L0 + 4 * g + 2)) for (int rep = 0; rep < MK_REP_SCAN; ++rep) mlstm_scan_phase(F, a, g);
        SEAM(P_L0 + 4 * g + 2);
        if (ON(19) && IN(P_L0 + 4 * g + 3)) for (int rep = 0; rep < MK_REP_MISC; ++rep) mlstm_out_phase(F, a, g, rep + 1 < MK_REP_MISC);
        SEAM(P_L0 + 4 * g + 3);
    }
#endif
    constexpr int RHEAD = 128 * 256;
    if (ON(3) && IN(P_OUT0)) {
        pg8::Gemm gm{QG, WoutA, MT, D, DI}; pg8::StaticOrder So; So.init(RHEAD, D, F.G, (int)blockIdx.x);
        for (int rep = 0; rep < MK_REP_GEMM; ++rep) { if (MK_REP_SYNC && rep) xcd_barrier(bar); EpiResidT<float, bf16> E{a.in[0], a.in[2], xsb, ctxb, mod, 1, rep + 1 < MK_REP_GEMM, nullptr, nullptr, nullptr, nullptr};
        pg8::gemm_phase<EpiResidT<float, bf16>, pg8::StaticOrder, MK_GEMM_ALIGN, MK_GEMM_SP2>(F.lds, gm, So, E, F.wave); }
    }
    SEAM(P_OUT0);
    if (ON(3) && IN(P_OUT0)) {
        if (blockIdx.x < 64) { pg8::Gemm gm{QG, WoutA, MT, D, DI}; OutTailOrder So; So.init(F.G, (int)blockIdx.x); EpiResidT<float, bf16> E{a.in[0], a.in[2], xsb, ctxb, mod, 1, 0, nullptr, nullptr, nullptr, nullptr};
            pg8::gemm_phase<EpiResidT<float, bf16>, OutTailOrder, MK_GEMM_ALIGN, MK_GEMM_SP2>(F.lds, gm, So, E, F.wave); }
        else { wconv(F, a.in[19], 8192, a.in[25], WinB, WoutB, ((int)blockIdx.x - 64) * NWAVES + F.wave, (F.G - 64) * NWAVES);
            if (ON(4)) norm_phase(F, xsb, ctxb, a.in[4] + 1024, mod + 17 * 3072, H, 0, RHEAD, 64); }
    }
    SEAM(P_OUT0);
    for (int g = 0; g < 2; ++g) {
        if (ON(5) && IN(P_L1 + 2 * g)) {
            if (g == 0 && ON(4)) norm_phase(F, xsb, ctxb, a.in[4] + 1024, mod + 17 * 3072, H, RHEAD, MT);
            pg8::Gemm gm{H + (size_t)g * MH * D, WinB, MH, 8192, D}; pg8::StaticOrder So; So.init(MH, 8192, F.G, (int)blockIdx.x);
            EpiProj<true, false> E{QG + (size_t)g * MH * DI, S2, S3, S4, DI, DI, DI, DI, 8, 16, 24, 3u, QSC, rope, ssq, shw, g * MH};
#ifdef MK_STAGGER
            if (blockIdx.x >= 128) { const long long t0_ = wall_clock64(); while (wall_clock64() - t0_ < MK_STAGGER) __builtin_amdgcn_s_sleep(8); }
#endif
            for (int rep = 0; rep < MK_REP_GEMM; ++rep) { if (MK_REP_SYNC && rep) xcd_barrier(bar); pg8::gemm_phase<EpiProj<true, false>, pg8::StaticOrder, MK_GEMM_ALIGN, MK_GEMM_SP2>(F.lds, gm, So, E, F.wave); }
        }
        SEAM(P_L1 + 2 * g);
        if (ON(6) && IN(P_L1 + 2 * g + 1)) for (int rep = 0; rep < MK_REP_DIFF; ++rep) { if (MK_REP_SYNC && rep) xcd_barrier(bar); diff_phase(F, a, g, rep + 1 < MK_REP_DIFF); }
        SEAM(P_L1 + 2 * g + 1);
    }
    if (ON(7) && IN(P_OUT1)) {
        pg8::Gemm gm{QG, WoutB, MT, D, DI}; pg8::StaticOrder So; So.init(RHEAD, D, F.G, (int)blockIdx.x);
        for (int rep = 0; rep < MK_REP_GEMM; ++rep) { if (MK_REP_SYNC && rep) xcd_barrier(bar); EpiResidT<bf16, bf16> E{xsb, ctxb, xsb, ctxb, mod + 17 * 3072, 1, rep + 1 < MK_REP_GEMM, nullptr, nullptr, nullptr, nullptr};
        pg8::gemm_phase<EpiResidT<bf16, bf16>, pg8::StaticOrder, MK_GEMM_ALIGN, MK_GEMM_SP2>(F.lds, gm, So, E, F.wave); }
    }
    SEAM(P_OUT1);
    if (ON(7) && IN(P_OUT1)) {
        if (blockIdx.x < 64) { pg8::Gemm gm{QG, WoutB, MT, D, DI}; OutTailOrder So; So.init(F.G, (int)blockIdx.x); EpiResidT<bf16, bf16> E{xsb, ctxb, xsb, ctxb, mod + 17 * 3072, 1, 0, nullptr, nullptr, nullptr, nullptr};
            pg8::gemm_phase<EpiResidT<bf16, bf16>, OutTailOrder, MK_GEMM_ALIGN, MK_GEMM_SP2>(F.lds, gm, So, E, F.wave); }
        else { wconv(F, a.in[26], 8192, a.in[28], WinA, WoutA, ((int)blockIdx.x - 64) * NWAVES + F.wave, (F.G - 64) * NWAVES);
            if (ON(8)) norm_phase(F, xsb, ctxb, a.in[4] + 2048, mod + 2 * 17 * 3072, H, 0, RHEAD, 64); }
    }
    SEAM(P_OUT1);
    for (int g = 0; g < 2; ++g) {
        if (ON(9) && IN(P_L2 + 2 * g)) {
            if (g == 0 && ON(8)) norm_phase(F, xsb, ctxb, a.in[4] + 2048, mod + 2 * 17 * 3072, H, RHEAD, MT);
            pg8::Gemm gm{H + (size_t)g * MH * D, WinA, MH, 8192, D}; pg8::StaticOrder So; So.init(MH, 8192, F.G, (int)blockIdx.x);
            EpiProj<false, false> E{QG + (size_t)g * MH * DI, S2, S3, S4, DI, DI, DI, DI, 8, 16, 24, 0u, QSC, rope, ssq, shw + 17 * 8192, g * MH};
#ifdef MK_STAGGER
            if (blockIdx.x >= 128) { const long long t0_ = wall_clock64(); while (wall_clock64() - t0_ < MK_STAGGER) __builtin_amdgcn_s_sleep(8); }
#endif
            for (int rep = 0; rep < MK_REP_GEMM; ++rep) { if (MK_REP_SYNC && rep) xcd_barrier(bar); pg8::gemm_phase<EpiProj<false, false>, pg8::StaticOrder, MK_GEMM_ALIGN, MK_GEMM_SP2>(F.lds, gm, So, E, F.wave); }
        }
        SEAM(P_L2 + 2 * g);
        if (ON(10) && IN(P_L2 + 2 * g + 1)) for (int rep = 0; rep < MK_REP_NA; ++rep) { if (MK_REP_SYNC && rep) xcd_barrier(bar); na_phase(F, a, g, rep + 1 < MK_REP_NA); }
        SEAM(P_L2 + 2 * g + 1);
    }
    if (ON(11) && IN(P_OUT2)) {
        pg8::Gemm gm{QG, WoutA, MT, D, DI}; pg8::StaticOrder So; So.init(RHEAD, D, F.G, (int)blockIdx.x);
        for (int rep = 0; rep < MK_REP_GEMM; ++rep) { if (MK_REP_SYNC && rep) xcd_barrier(bar); EpiResidT<bf16, bf16> E{xsb, ctxb, x3b, ctxb, mod + 2 * 17 * 3072, 1, rep + 1 < MK_REP_GEMM, nullptr, nullptr, nullptr, nullptr};
        pg8::gemm_phase<EpiResidT<bf16, bf16>, pg8::StaticOrder, MK_GEMM_ALIGN, MK_GEMM_SP2>(F.lds, gm, So, E, F.wave); }
    }
    SEAM(P_OUT2);
    if (ON(11) && IN(P_OUT2)) {
        if (blockIdx.x < 64) { pg8::Gemm gm{QG, WoutA, MT, D, DI}; OutTailOrder So; So.init(F.G, (int)blockIdx.x); EpiResidT<bf16, bf16> E{xsb, ctxb, x3b, ctxb, mod + 2 * 17 * 3072, 1, 0, nullptr, nullptr, nullptr, nullptr};
            pg8::gemm_phase<EpiResidT<bf16, bf16>, OutTailOrder, MK_GEMM_ALIGN, MK_GEMM_SP2>(F.lds, gm, So, E, F.wave); }
        else { wconv(F, a.in[29], 4608, a.in[31], WinB, WoutB, ((int)blockIdx.x - 64) * NWAVES + F.wave, (F.G - 64) * NWAVES);
            if (ON(12)) norm_phase(F, x3b, ctxb, a.in[4] + 3072, mod + 3 * 17 * 3072, H, 0, RHEAD, 64); }
    }
    SEAM(P_OUT2);
    for (int g = 0; g < 2; ++g) {
        if (ON(13) && IN(P_L3 + 2 * g)) {
            if (g == 0 && ON(12)) norm_phase(F, x3b, ctxb, a.in[4] + 3072, mod + 3 * 17 * 3072, H, RHEAD, MT);
            pg8::Gemm gm{H + (size_t)g * MH * D, WinB, MH, 4608, D}; L3Order So; So.init(F.G, (int)blockIdx.x);
            EpiProj<true, false> E{QG + (size_t)g * MH * DI, S2, S2 + (size_t)MH * 256, S4, DI, 256, 256, DI, 8, 9, 10, 3u, QSC, rope, ssq, shw + 2 * 17 * 8192, g * MH};
            for (int rep = 0; rep < MK_REP_GEMM; ++rep) { if (MK_REP_SYNC && rep) xcd_barrier(bar); pg8::gemm_phase<EpiProj<true, false>, L3Order, MK_GEMM_ALIGN, MK_GEMM_SP2>(F.lds, gm, So, E, F.wave); }
        }
        SEAM(P_L3 + 2 * g);
        if (ON(14) && IN(P_L3 + 2 * g + 1)) for (int rep = 0; rep < MK_REP_SWA; ++rep) { if (MK_REP_SYNC && rep) xcd_barrier(bar); swa_phase(F, a, g, rep + 1 < MK_REP_SWA); }
        SEAM(P_L3 + 2 * g + 1);
    }
    if (ON(15) && IN(P_OUT3)) {
        pg8::Gemm gm{QG, WoutB, MT, D, DI}; LatOnlyOrder So; So.init(F.G, (int)blockIdx.x);
        for (int rep = 0; rep < MK_REP_GEMM; ++rep) { if (MK_REP_SYNC && rep) xcd_barrier(bar); EpiResidT<bf16, float> E{x3b, ctxb, xs, ctxs, mod + 3 * 17 * 3072, 0, rep + 1 < MK_REP_GEMM, nullptr, nullptr, nullptr, nullptr};
        pg8::gemm_phase<EpiResidT<bf16, float>, LatOnlyOrder, MK_GEMM_ALIGN, MK_GEMM_SP2>(F.lds, gm, So, E, F.wave); }
    }
    SEAM(P_OUT3);
    if (ON(16) && IN(P_FINAL)) final_norm_phase(F, xs, a.in[7]);
#ifdef MK_TP
    {
        if (MK_TP == 2) TP_POST(P_FINAL)
        unsigned long long* tpw = (unsigned long long*)(a.ws + WS_CTL + 32768);
        if (F.wave == 0 && pg8::hw_lane() == 0) __hip_atomic_fetch_add(tpw, (unsigned long long)tp_acc, __ATOMIC_RELAXED, __HIP_MEMORY_SCOPE_AGENT);
        xcd_barrier(bar);
        const unsigned long long sum = __hip_atomic_load(tpw, __ATOMIC_RELAXED, __HIP_MEMORY_SCOPE_AGENT);
        const long long wait = (long long)(sum / 256) * MK_TP_K, ts = wall_clock64();
        while (wall_clock64() - ts < wait) __builtin_amdgcn_s_sleep(32);
    }
#endif
#undef IN
#undef SEAM
#undef WSB
#undef xs
#undef ctxs
#undef xsb
#undef ctxb
#undef x3b
#undef mod
#undef WinA
#undef WoutA
#undef WinB
#undef WoutB
#undef H
#undef QG
#undef ssq
#undef shw
#undef S2
#undef S3
#undef S4
#undef rope
}

inline void launch_mega(void* const* d_in, void* d_out, void* d_ws, int lo, int hi, hipStream_t stream) {
    static int inited = 0;
    if (!inited) { (void)hipFuncSetAttribute((const void*)mega, hipFuncAttributeMaxDynamicSharedMemorySize, LDS_BYTES); inited = 1; }
    (void)hipMemsetAsync((char*)d_ws + WS_CTL, 0, CTL_BYTES, stream);
    Args a{};
    for (int i = 0; i < 32; ++i) a.in[i] = (const float*)d_in[i];
    a.out = (float*)d_out; a.ws = (unsigned char*)d_ws; a.ph_lo = lo; a.ph_hi = hi;
    hipLaunchKernelGGL(mega, dim3(256), dim3(NTHR), LDS_BYTES, stream, a);
}
}
extern "C" void kernel_launch(void* const* d_in, const int* in_sizes, int n_in, void* d_out, int out_size, void* d_ws, size_t ws_size, hipStream_t stream) {
    mk::launch_mega(d_in, d_out, d_ws, mk::P_PRO, mk::P_END, stream);
}
```
